# Optimizing an MI355X kernel written in HIP

```python
import jax, jax.numpy as jnp
from jax import lax
import numpy as np

D_MODEL = 1024
BATCH = 4
SEQ = 4096
DEPTH = 2

N_DENSE = (DEPTH + 1) // 2
N_MOE = DEPTH // 2

MLA_HEADS = 8
MLA_NOPE = 64
MLA_ROPE = 32
MLA_QK = MLA_NOPE + MLA_ROPE
MLA_V = 64
MLA_Q_RANK = D_MODEL // 4
MLA_KV_RANK = D_MODEL // 4
ROPE_BASE = 10000.0
Q_BLOCK = 128
GLA_HEADS = 4
GLA_DK = 64
GLA_DV = 128
GLA_GATE_RANK = 16
GLA_TAU = 16.0
GLA_CHUNK = 16
POOL_WINDOWS = (2, 4, 8, 16)
POOL_GROUP = 128
POOL_WIDTH = 4 * POOL_GROUP
N_BRANCH = 3
BRANCH_WIDTH = 512
D_FF = 2816
N_EXPERTS = 8
TOP_K = 2
D_EXPERT = 1408
EPS = 1e-6

IN_SPLITS = (MLA_Q_RANK, MLA_KV_RANK, MLA_ROPE,
             GLA_HEADS * GLA_DK, GLA_HEADS * GLA_DK, GLA_HEADS * GLA_DV, GLA_GATE_RANK, GLA_HEADS * GLA_DV,
             POOL_WIDTH, N_BRANCH * D_MODEL)
D_IN = sum(IN_SPLITS)

kernel_name = 'hybrid_mla_gla_pool_gated_moe'


def rms_norm(x, g):
    xf = x.astype(jnp.float32)
    y = xf * lax.rsqrt(jnp.mean(xf * xf, axis=-1, keepdims=True) + EPS)
    return (y * g.astype(jnp.float32)).astype(x.dtype)


def rope(x, positions):
    half = x.shape[-1] // 2
    inv_freq = ROPE_BASE ** (-jnp.arange(half, dtype=jnp.float32) / half)
    ang = positions.astype(jnp.float32)[..., None] * inv_freq
    cos = jnp.cos(ang)[:, :, None, :]
    sin = jnp.sin(ang)[:, :, None, :]
    xf = x.astype(jnp.float32)
    x1, x2 = xf[..., :half], xf[..., half:]
    return jnp.concatenate([x1 * cos - x2 * sin, x2 * cos + x1 * sin], axis=-1).astype(x.dtype)


def causal_block_attention(q, k, v):
    B, S, H, Dq = q.shape
    nb = S // Q_BLOCK
    scale = Dq ** -0.5
    key_pos = jnp.arange(S)
    q_blocks = q.reshape(B, nb, Q_BLOCK, H, Dq).transpose(1, 0, 2, 3, 4)

    def one_block(args):
        i, qb = args
        s = jnp.einsum('bqhd,bkhd->bhqk', qb, k, preferred_element_type=jnp.float32) * scale
        q_pos = i * Q_BLOCK + jnp.arange(Q_BLOCK)
        s = jnp.where(key_pos[None, :] <= q_pos[:, None], s, -jnp.inf)
        p = jax.nn.softmax(s, axis=-1).astype(v.dtype)
        return jnp.einsum('bhqk,bkhv->bqhv', p, v)

    o = lax.map(one_block, (jnp.arange(nb), q_blocks))
    return o.transpose(1, 0, 2, 3, 4).reshape(B, S, H, v.shape[-1])


def mla_branch(c_q, c_kv, k_rope, positions, g_cq, w_uq, g_ckv, w_ukv, g_qk_q, g_qk_k):
    B, S, _ = c_q.shape
    q = (rms_norm(c_q, g_cq) @ w_uq).reshape(B, S, MLA_HEADS, MLA_QK)
    kv = (rms_norm(c_kv, g_ckv) @ w_ukv).reshape(B, S, MLA_HEADS, MLA_NOPE + MLA_V)
    k_nope, v = kv[..., :MLA_NOPE], kv[..., MLA_NOPE:]
    k_r = jnp.broadcast_to(k_rope[:, :, None, :], (B, S, MLA_HEADS, MLA_ROPE))
    k = jnp.concatenate([k_nope, k_r], axis=-1)
    q = rms_norm(q, g_qk_q)
    k = rms_norm(k, g_qk_k)
    q = jnp.concatenate([q[..., :MLA_NOPE], rope(q[..., MLA_NOPE:], positions)], axis=-1)
    k = jnp.concatenate([k[..., :MLA_NOPE], rope(k[..., MLA_NOPE:], positions)], axis=-1)
    o = causal_block_attention(q, k, v)
    return o.reshape(B, S, MLA_HEADS * MLA_V)


def gla_branch(q, k, v, gate_lr, out_gate, w_gate_up, b_gate, g_out):
    B, S, _ = q.shape
    N, C, H = S // GLA_CHUNK, GLA_CHUNK, GLA_HEADS
    f32 = jnp.float32
    log_a = jax.nn.log_sigmoid((gate_lr @ w_gate_up + b_gate).astype(f32)) / GLA_TAU
    qc = q.astype(f32).reshape(B, N, C, H, GLA_DK) * (GLA_DK ** -0.5)
    kc = k.astype(f32).reshape(B, N, C, H, GLA_DK)
    vc = v.astype(f32).reshape(B, N, C, H, GLA_DV)
    bc = jnp.cumsum(log_a.reshape(B, N, C, H, GLA_DK), axis=2)
    causal = jnp.tril(jnp.ones((C, C), dtype=bool))[None, None, :, :, None, None]
    diff = bc[:, :, :, None] - bc[:, :, None, :]
    decay = jnp.exp(jnp.where(causal, diff, -jnp.inf))
    attn = jnp.einsum('bnijhd,bnjhd->bnhij', qc[:, :, :, None] * decay, kc)
    o_intra = jnp.einsum('bnhij,bnjhv->bnihv', attn, vc)
    b_last = bc[:, :, -1]
    q_dec = qc * jnp.exp(bc)
    k_dec = kc * jnp.exp(b_last[:, :, None] - bc)
    a_last = jnp.exp(b_last)

    def step(state, xs):
        qd, kd, vv, al = xs
        o = jnp.einsum('bihd,bhdv->bihv', qd, state)
        state = al[..., None] * state + jnp.einsum('bjhd,bjhv->bhdv', kd, vv)
        return state, o

    xs = (jnp.moveaxis(q_dec, 1, 0), jnp.moveaxis(k_dec, 1, 0), jnp.moveaxis(vc, 1, 0), jnp.moveaxis(a_last, 1, 0))
    state0 = jnp.zeros((B, H, GLA_DK, GLA_DV), f32)
    _, o_inter = lax.scan(step, state0, xs)
    o = o_intra + jnp.moveaxis(o_inter, 0, 1)
    o = rms_norm(o.reshape(B, S, H, GLA_DV), g_out).astype(q.dtype)
    o = o * jax.nn.silu(out_gate.reshape(B, S, H, GLA_DV))
    return o.reshape(B, S, H * GLA_DV)


def pool_branch(u, w_pool, pool_scale):
    B, S, _ = u.shape
    uf = u.astype(jnp.float32).reshape(B, S, len(POOL_WINDOWS), POOL_GROUP)
    cs = jnp.cumsum(uf, axis=1)
    t1 = jnp.arange(1, S + 1, dtype=jnp.float32)
    outs = []
    for gi, w in enumerate(POOL_WINDOWS):
        c = cs[:, :, gi]
        c_shift = jnp.pad(c, ((0, 0), (w, 0), (0, 0)))[:, :S]
        mean = (c - c_shift) / jnp.minimum(t1, w)[None, :, None]
        outs.append(mean - uf[:, :, gi])
    pooled = jnp.stack(outs, axis=2).astype(u.dtype)
    y = jnp.einsum('bsgc,gcd->bsgd', pooled, w_pool).reshape(B, S, POOL_WIDTH)
    return y * pool_scale


def swiglu(h, w_gate, w_up, w_down):
    return (jax.nn.silu(h @ w_gate) * (h @ w_up)) @ w_down


def moe_ffn(h, w_router, w_e_gate, w_e_up, w_e_down):
    logits = jnp.einsum('bsd,de->bse', h, w_router, preferred_element_type=jnp.float32)
    top_vals, top_idx = lax.top_k(logits, TOP_K)
    top_w = jax.nn.softmax(top_vals, axis=-1)
    combine = jnp.sum(jax.nn.one_hot(top_idx, N_EXPERTS, dtype=jnp.float32) * top_w[..., None], axis=-2)
    combine = combine.astype(h.dtype)
    y = jnp.zeros_like(h)
    for e in range(N_EXPERTS):
        y = y + combine[..., e:e + 1] * swiglu(h, w_e_gate[e], w_e_up[e], w_e_down[e])
    return y


def setup_inputs(seed: int = 0) -> dict:
    key = jax.random.key(seed)
    ks = jax.random.split(key, 32)
    f32 = jnp.float32

    def w(k, shape, fan_in):
        return jax.random.normal(k, shape, f32) * fan_in ** -0.5

    def gain(k, shape):
        return 1.0 + 0.05 * jax.random.normal(k, shape, f32)

    x = jax.random.normal(ks[0], (BATCH, SEQ, D_MODEL), f32)
    offset = jax.random.randint(ks[1], (BATCH, 1), 0, 1024, dtype=jnp.int32)
    positions = jnp.arange(SEQ, dtype=jnp.int32)[None, :] + offset
    return {
        'x': x,
        'positions': positions,
        'g_mix': gain(ks[2], (DEPTH, D_MODEL)),
        'w_in': w(ks[3], (DEPTH, D_MODEL, D_IN), D_MODEL),
        'g_cq': gain(ks[4], (DEPTH, MLA_Q_RANK)),
        'w_uq': w(ks[5], (DEPTH, MLA_Q_RANK, MLA_HEADS * MLA_QK), MLA_Q_RANK),
        'g_ckv': gain(ks[6], (DEPTH, MLA_KV_RANK)),
        'w_ukv': w(ks[7], (DEPTH, MLA_KV_RANK, MLA_HEADS * (MLA_NOPE + MLA_V)), MLA_KV_RANK),
        'g_qk_q': gain(ks[8], (DEPTH, MLA_QK)),
        'g_qk_k': gain(ks[9], (DEPTH, MLA_QK)),
        'w_gla_gate_up': w(ks[10], (DEPTH, GLA_GATE_RANK, GLA_HEADS * GLA_DK), GLA_GATE_RANK),
        'b_gla_gate': 0.1 * jax.random.normal(ks[11], (DEPTH, GLA_HEADS * GLA_DK), f32),
        'g_gla_out': gain(ks[12], (DEPTH, GLA_DV)),
        'w_pool': w(ks[13], (DEPTH, len(POOL_WINDOWS), POOL_GROUP, POOL_GROUP), POOL_GROUP),
        'pool_scale': gain(ks[14], (DEPTH, POOL_WIDTH)),
        'w_branch': w(ks[15], (DEPTH, N_BRANCH, BRANCH_WIDTH, D_MODEL), BRANCH_WIDTH),
        'w_out': w(ks[16], (DEPTH, D_MODEL, D_MODEL), D_MODEL),
        'g_ffn': gain(ks[17], (DEPTH, D_MODEL)),
        'w_ffn_gate': w(ks[18], (N_DENSE, D_MODEL, D_FF), D_MODEL),
        'w_ffn_up': w(ks[19], (N_DENSE, D_MODEL, D_FF), D_MODEL),
        'w_ffn_down': w(ks[20], (N_DENSE, D_FF, D_MODEL), D_FF),
        'w_router': w(ks[21], (N_MOE, D_MODEL, N_EXPERTS), D_MODEL),
        'w_exp_gate': w(ks[22], (N_MOE, N_EXPERTS, D_MODEL, D_EXPERT), D_MODEL),
        'w_exp_up': w(ks[23], (N_MOE, N_EXPERTS, D_MODEL, D_EXPERT), D_MODEL),
        'w_exp_down': w(ks[24], (N_MOE, N_EXPERTS, D_EXPERT, D_MODEL), D_EXPERT),
    }


def reference(x, positions, g_mix, w_in, g_cq, w_uq, g_ckv, w_ukv, g_qk_q, g_qk_k, w_gla_gate_up, b_gla_gate,
              g_gla_out, w_pool, pool_scale, w_branch, w_out, g_ffn, w_ffn_gate, w_ffn_up, w_ffn_down,
              w_router, w_exp_gate, w_exp_up, w_exp_down):
    B, S, _ = x.shape
    split_points = np.cumsum(IN_SPLITS)[:-1].tolist()
    for layer in range(DEPTH):
        h = rms_norm(x, g_mix[layer])
        proj = h @ w_in[layer]
        (c_q, c_kv, k_rope, gla_q, gla_k, gla_v, gla_lr, gla_og, u_pool, gate_logits) = jnp.split(proj, split_points, axis=-1)
        y_a = mla_branch(c_q, c_kv, k_rope, positions, g_cq[layer], w_uq[layer], g_ckv[layer], w_ukv[layer],
                         g_qk_q[layer], g_qk_k[layer])
        y_b = gla_branch(gla_q, gla_k, gla_v, gla_lr, gla_og, w_gla_gate_up[layer], b_gla_gate[layer], g_gla_out[layer])
        y_c = pool_branch(u_pool, w_pool[layer], pool_scale[layer])
        ys = jnp.stack([y_a, y_b, y_c], axis=2)
        y_d = jnp.einsum('bsnc,ncd->bsnd', ys, w_branch[layer])
        gates = jax.nn.sigmoid(gate_logits.astype(jnp.float32).reshape(B, S, N_BRANCH, D_MODEL)).astype(x.dtype)
        merged = jnp.sum(gates * y_d, axis=2)
        x = x + merged @ w_out[layer]
        h = rms_norm(x, g_ffn[layer])
        i = layer // 2
        if layer % 2 == 0:
            x = x + swiglu(h, w_ffn_gate[i], w_ffn_up[i], w_ffn_down[i])
        else:
            x = x + moe_ffn(h, w_router[i], w_exp_gate[i], w_exp_up[i], w_exp_down[i])
    return x
```

```cpp
#include <hip/hip_runtime.h>
#include <cstdint>
#include <cstdio>

#define LAS __attribute__((address_space(3)))
#define CAS __attribute__((address_space(4)))
typedef const void* GPtr;
typedef unsigned short bf16_t;
typedef short bf16x8 __attribute__((ext_vector_type(8)));
typedef float f32x4 __attribute__((ext_vector_type(4)));
typedef float f32x16 __attribute__((ext_vector_type(16)));
typedef unsigned u32x4 __attribute__((ext_vector_type(4)));
typedef unsigned u32x2 __attribute__((ext_vector_type(2)));

constexpr int T = 16384, SEQ = 4096, NB = 4, D = 1024, DIN = 5680, DFF = 2816, DEXP = 1408, NEXP = 8;
constexpr int NPROJ = 2816;
constexpr float EPS = 1e-6f;
constexpr int MAXSLOT = 34816;

constexpr size_t MiB = 1u << 20;
constexpr size_t WS_CTL = 0, CTL_BYTES = 128 * 1024;
constexpr size_t WS_SLOT = 2 * MiB;
constexpr size_t WS_ROPE = 3 * MiB;
constexpr size_t WS_XB = 5 * MiB;
constexpr size_t WS_W1 = 37 * MiB;
constexpr size_t WS_W0 = 55 * MiB;
constexpr size_t WS_ACTS = 89 * MiB;
constexpr size_t WS_STATS = 283 * MiB;
constexpr size_t WS_END = 291 * MiB;
constexpr size_t WO_IN = 0, WO_G = 5632 * 1024, WO_UP = WO_G + 6 * MiB, WO_BR = WO_UP + 1792 * 256 * 2, WO_OUT = WO_BR + 3 * MiB, WO_FGU = WO_OUT + 2 * MiB, WO_FD = WO_FGU + 11 * MiB;
constexpr size_t WO_MGU = 0, WO_MD = 44 * MiB;
constexpr size_t A_OG = 0, A_GQKV = 16 * MiB, A_UP = 48 * MiB, A_MISC = 64 * MiB, A_CQKV = 72 * MiB, A_VT = 72 * MiB, A_QKVRAW = 88 * MiB;
constexpr size_t A_YSA = 96 * MiB, A_POOLED = 112 * MiB, A_YSB = 128 * MiB, A_QH = 144 * MiB, A_KH = 168 * MiB;
constexpr size_t A_G0 = 16 * MiB, A_G1 = 48 * MiB, A_G2 = 144 * MiB, A_ACT = 0;
constexpr size_t A_MERGED = 0;
constexpr long long MERGED_HI_DELTA = (long long)(64 * MiB);
constexpr size_t A_XG = 32 * MiB, A_ACTE = 100 * MiB, A_Y = 32 * MiB;
constexpr int CW_TMO = 0, CW_BAR = 4096, CW_QUEUE = 16384, CW_WGCNT = 20480;
static_assert((size_t)(CW_WGCNT + 2048) * 4 <= CTL_BYTES, "ctl");
constexpr size_t SF_SSQ = 0;
constexpr size_t SF_ROWSS = (size_t)2 * 2 * T * 4;
constexpr size_t SF_OSS = SF_ROWSS + (size_t)4 * T * 16;
constexpr size_t SF_EB = SF_OSS + (size_t)T * 32;
static_assert((SF_EB + (size_t)(T / 32) * 256) * 4 <= 8 * MiB, "stats");
constexpr size_t SL_TOK = 0, SL_SCALE = 139264, SL_COMB = 2 * 139264, SL_ROUTE = 3 * 139264;
constexpr size_t WS_TSLOT = 1 * MiB;

constexpr int RING_BYTES = 131072, LDSCTL_OFF = RING_BYTES, MISC_OFF = LDSCTL_OFF + 320, LDS_BYTES = 147456;
constexpr int RS_OFF = RING_BYTES + 1024;

#define LDS_WAIT() asm volatile("s_waitcnt lgkmcnt(0)" ::: "memory")
#define VM_WAIT() asm volatile("s_waitcnt vmcnt(0)" ::: "memory")
#define LDS_BARRIER() do { asm volatile("s_waitcnt lgkmcnt(0)" ::: "memory"); __builtin_amdgcn_s_barrier(); asm volatile("" ::: "memory"); } while (0)
#define RLX_AGENT __ATOMIC_RELAXED, __HIP_MEMORY_SCOPE_AGENT
typedef float f32x2_t __attribute__((ext_vector_type(2))); typedef __bf16 bf16x2_t __attribute__((ext_vector_type(2)));
__device__ __forceinline__ unsigned cvt_pk_bf16(float lo, float hi) { f32x2_t v = {lo, hi}; bf16x2_t b = __builtin_convertvector(v, bf16x2_t); return __builtin_bit_cast(unsigned, b); }
__device__ __forceinline__ float bflo(unsigned u) { return __uint_as_float(u << 16); }
__device__ __forceinline__ float bfhi(unsigned u) { return __uint_as_float(u & 0xffff0000u); }
__device__ __forceinline__ float wave_sum(float v) {
#pragma unroll
    for (int o = 1; o < 64; o <<= 1) v += __shfl_xor(v, o);
    return v;
}
__device__ __forceinline__ float sum16(const float* p) { const f32x4 a = *(const f32x4*)p, b = *(const f32x4*)(p + 4), c = *(const f32x4*)(p + 8), d = *(const f32x4*)(p + 12);
    return (((a[0] + a[1]) + (a[2] + a[3])) + ((b[0] + b[1]) + (b[2] + b[3]))) + (((c[0] + c[1]) + (c[2] + c[3])) + ((d[0] + d[1]) + (d[2] + d[3]))); }
__device__ __forceinline__ float sum4(const float* p) { const f32x4 a = *(const f32x4*)p; return (a[0] + a[1]) + (a[2] + a[3]); }
__device__ __forceinline__ float fast_sigmoid(float z) { return __builtin_amdgcn_rcpf(1.f + __builtin_amdgcn_exp2f(-1.4426950408889634f * z)); }

namespace pg8 {
constexpr int BM = 256, BK = 64, HALF = 128, HTB = HALF * BK * 2, STAGE_BYTES = 8 * HTB, NXCD = 8, WGM = 8;
__host__ __device__ __forceinline__ int lds_byte(int r, int c) { const int st = (r >> 4) * 2 + (c >> 5), rr = r & 15, cc = c & 31, ob = rr * 64 + cc * 2; return st * 1024 + (ob ^ (((ob >> 9) & 1) << 5)); }
__host__ __device__ __forceinline__ void stage_rc(int b, int& R, int& C) { const int st = b / 1024, sb = b % 1024, swz = sb ^ (((sb >> 9) & 1) << 5); R = (st >> 1) * 16 + swz / 64; C = (st & 1) * 32 + (swz % 64) / 2; }
__host__ __device__ __forceinline__ int perm32(int rho) { const int n = rho >> 4, i = rho & 15; return 8 * (i >> 2) + 4 * n + (i & 3); }

struct Unit { const char* a; const char* b; int pm, pn, kind, half; };
__device__ __forceinline__ void tile_map(int L, int nM, int nN, int& pm, int& pn) {
    const int nwg = nM * nN; int wgid = L;
    { const int q = nwg / NXCD, r = nwg % NXCD, xcd = wgid % NXCD, off = wgid / NXCD; wgid = (xcd < r ? xcd * (q + 1) : r * (q + 1) + (xcd - r) * q) + off; }
    const int nig = WGM * nN, gid = wgid / nig, fm = gid * WGM, gsz = (nM - fm) < WGM ? (nM - fm) : WGM;
    pm = fm + ((wgid % nig) % gsz); pn = (wgid % nig) / gsz;
}

template <class Epi, class Sched, bool ALIGN_EPI, bool SP2>
__device__ __forceinline__ void gemm_phase(LAS unsigned char* lds, const int wave_in, const int lda, const int K, const Sched& S, const Epi& E) {
    int ln_; asm volatile("v_mbcnt_lo_u32_b32 %0, -1, 0\n\tv_mbcnt_hi_u32_b32 %0, -1, %0" : "=v"(ln_));
    const int tid = wave_in * 64 + ln_, wid = __builtin_amdgcn_readfirstlane(tid >> 6), lane = tid & 63, wr = wid >> 2, wc = wid & 3, fr = lane & 15, fq = lane >> 4;
    const int nt = K / BK;
    unsigned voffA[2], voffB[2];
#pragma unroll
    for (int i = 0; i < 2; ++i) { int R, C; stage_rc(tid * 16 + i * 8192, R, C); const int Rb = Epi::PERM ? ((R & ~31) + perm32(R & 31)) : R;
        voffA[i] = (unsigned)(R * lda + C) * 2u; voffB[i] = (unsigned)(Rb * K + C) * 2u; }
    const size_t kstep = (size_t)(BK * 2);
    const size_t hstepA = (size_t)HALF * lda * 2, hstepB = (size_t)HALF * K * 2;
    const unsigned ldsw = (unsigned)wid * 1024u;
    const int aoff = lds_byte(wr * 64 + fr, fq * 8), boff = lds_byte(wc * 32 + fr, fq * 8);
#define PG8_SA(b, h) (((b) * 2 + (h)) * HTB)
#define PG8_SB(b, h) ((4 + (b) * 2 + (h)) * HTB)
#define PG8_STAGE(bufoff, gbase, voff) do { _Pragma("unroll") for (int _i = 0; _i < 2; ++_i) \
        __builtin_amdgcn_global_load_lds((const unsigned*)((const char*)(gbase) + (voff)[_i]), (LAS unsigned*)(lds + (bufoff) + ldsw + _i * 8192), 16, 0, 0); } while (0)
#define PG8_LDA(dst, b, h) do { _Pragma("unroll") for (int m = 0; m < 4; ++m) _Pragma("unroll") for (int k = 0; k < 2; ++k) dst[m][k] = *(const LAS bf16x8*)(lds + PG8_SA(b, h) + aoff + m * 2048 + k * 1024); } while (0)
#define PG8_LDB(dst, b, h) do { _Pragma("unroll") for (int n = 0; n < 2; ++n) _Pragma("unroll") for (int k = 0; k < 2; ++k) dst[n][k] = *(const LAS bf16x8*)(lds + PG8_SB(b, h) + boff + n * 2048 + k * 1024); } while (0)
#define PG8_MMA(ai, bj, At, Bt) do { __builtin_amdgcn_s_setprio(1); _Pragma("unroll") for (int m = 0; m < 4; ++m) _Pragma("unroll") for (int n = 0; n < 2; ++n) _Pragma("unroll") for (int k = 0; k < 2; ++k) \
        acc[ai][bj][m][n] = __builtin_amdgcn_mfma_f32_16x16x32_bf16(Bt[n][k], At[m][k], acc[ai][bj][m][n], 0, 0, 0); __builtin_amdgcn_s_setprio(0); } while (0)
#define PG8_WAIT_V(n) asm volatile("s_waitcnt vmcnt(" #n ")" ::: "memory")
#define PG8_WAIT_L(n) asm volatile("s_waitcnt lgkmcnt(" #n ")" ::: "memory")
#define PG8_BAR __builtin_amdgcn_s_barrier()
#define PG8_SCHED __builtin_amdgcn_sched_barrier(0)
    Unit cur, nxt; int ui = 0;
    if (!S.next(0, cur)) return;
    f32x4 acc[2][2][4][2];
#pragma unroll
    for (int a = 0; a < 2; ++a)
#pragma unroll
        for (int b = 0; b < 2; ++b)
#pragma unroll
            for (int m = 0; m < 4; ++m)
#pragma unroll
                for (int n = 0; n < 2; ++n) acc[a][b][m][n] = (f32x4){0.f, 0.f, 0.f, 0.f};
    bf16x8 At[4][2], B0[2][2], B1[2][2];
    const char* cA = cur.a; const char* cB = cur.b;
    if constexpr (SP2) {
        PG8_STAGE(PG8_SB(0, 0), cB, voffB); PG8_STAGE(PG8_SB(0, 1), cB + hstepB, voffB); PG8_STAGE(PG8_SA(0, 0), cA, voffA); PG8_STAGE(PG8_SA(0, 1), cA + hstepA, voffA);
        if (wr == 1) PG8_BAR;
        PG8_WAIT_V(2); PG8_BAR;
        PG8_STAGE(PG8_SB(1, 0), cB + kstep, voffB); PG8_STAGE(PG8_SA(1, 0), cA + kstep, voffA); PG8_STAGE(PG8_SB(1, 1), cB + hstepB + kstep, voffB);
        PG8_WAIT_V(6); PG8_BAR;
    } else {
        PG8_STAGE(PG8_SB(0, 0), cB, voffB); PG8_STAGE(PG8_SA(0, 0), cA, voffA); PG8_STAGE(PG8_SB(0, 1), cB + hstepB, voffB); PG8_STAGE(PG8_SA(0, 1), cA + hstepA, voffA);
        if (wr == 1) PG8_BAR;
        PG8_WAIT_V(4); PG8_BAR;
        PG8_STAGE(PG8_SB(1, 0), cB + kstep, voffB); PG8_STAGE(PG8_SA(1, 0), cA + kstep, voffA); PG8_STAGE(PG8_SB(1, 1), cB + hstepB + kstep, voffB);
        PG8_WAIT_V(6); PG8_BAR;
    }
    for (;;) {
        const bool has_next = S.next(ui + 1, nxt);
        const bool do0 = cur.half != 2, do1 = cur.half != 1;
        const char* nA = has_next ? nxt.a : cA; const char* nB = has_next ? nxt.b : cB;
#pragma unroll 1
        for (int t = 0; t < nt; t += 2) {
            const bool last = (t == nt - 2);
            const char* a1 = cA + (size_t)(t + 1) * kstep;
            const char* a2 = last ? nA : cA + (size_t)(t + 2) * kstep; const char* b2 = last ? nB : cB + (size_t)(t + 2) * kstep;
            const char* a3 = a2 + kstep; const char* b3 = b2 + kstep;
            if constexpr (SP2) {
            PG8_LDB(B0, 0, 0); PG8_LDB(B1, 0, 1); PG8_SCHED; PG8_LDA(At, 0, 0); PG8_STAGE(PG8_SA(1, 1), a1 + hstepA, voffA);
            PG8_WAIT_V(8); PG8_WAIT_L(0); PG8_BAR; if (do0) { PG8_MMA(0, 0, At, B0); PG8_MMA(0, 1, At, B1); } PG8_BAR; PG8_SCHED;
            PG8_LDA(At, 0, 1); PG8_STAGE(PG8_SB(0, 0), b2, voffB); PG8_STAGE(PG8_SB(0, 1), b2 + hstepB, voffB); PG8_STAGE(PG8_SA(0, 0), a2, voffA);
            PG8_WAIT_V(8); PG8_WAIT_L(0); PG8_BAR; if (do1) { PG8_MMA(1, 0, At, B0); PG8_MMA(1, 1, At, B1); } PG8_BAR; PG8_SCHED;
            PG8_LDB(B0, 1, 0); PG8_LDB(B1, 1, 1); PG8_SCHED; PG8_LDA(At, 1, 0); PG8_STAGE(PG8_SA(0, 1), a2 + hstepA, voffA);
            PG8_WAIT_V(8); PG8_WAIT_L(0); PG8_BAR; if (do0) { PG8_MMA(0, 0, At, B0); PG8_MMA(0, 1, At, B1); } PG8_BAR; PG8_SCHED;
            PG8_LDA(At, 1, 1); PG8_STAGE(PG8_SB(1, 0), b3, voffB); PG8_STAGE(PG8_SB(1, 1), b3 + hstepB, voffB); PG8_STAGE(PG8_SA(1, 0), a3, voffA);
            PG8_WAIT_V(8); PG8_WAIT_L(0); PG8_BAR; if (do1) { PG8_MMA(1, 0, At, B0); PG8_MMA(1, 1, At, B1); } PG8_BAR; PG8_SCHED;
            } else {
            PG8_LDB(B0, 0, 0); PG8_SCHED; PG8_LDA(At, 0, 0); PG8_STAGE(PG8_SA(1, 1), a1 + hstepA, voffA);
            PG8_WAIT_L(8); PG8_BAR; PG8_WAIT_L(0); PG8_MMA(0, 0, At, B0); PG8_BAR; PG8_SCHED;
            PG8_LDB(B1, 0, 1); PG8_STAGE(PG8_SB(0, 0), b2, voffB);
            PG8_BAR; PG8_WAIT_L(0); PG8_MMA(0, 1, At, B1); PG8_BAR;
            PG8_LDA(At, 0, 1); PG8_STAGE(PG8_SA(0, 0), a2, voffA);
            PG8_BAR; PG8_WAIT_L(0); PG8_MMA(1, 0, At, B0); PG8_BAR; PG8_SCHED;
            PG8_STAGE(PG8_SB(0, 1), b2 + hstepB, voffB);
            PG8_WAIT_V(6); PG8_BAR; PG8_MMA(1, 1, At, B1); PG8_BAR;
            PG8_LDB(B0, 1, 0); PG8_SCHED; PG8_LDA(At, 1, 0); PG8_STAGE(PG8_SA(0, 1), a2 + hstepA, voffA);
            PG8_WAIT_L(8); PG8_BAR; PG8_WAIT_L(0); PG8_MMA(0, 0, At, B0); PG8_BAR; PG8_SCHED;
            PG8_LDB(B1, 1, 1); PG8_STAGE(PG8_SB(1, 0), b3, voffB);
            PG8_BAR; PG8_WAIT_L(0); PG8_MMA(0, 1, At, B1); PG8_BAR;
            PG8_LDA(At, 1, 1); PG8_STAGE(PG8_SA(1, 0), a3, voffA);
            PG8_BAR; PG8_WAIT_L(0); PG8_MMA(1, 0, At, B0); PG8_BAR; PG8_SCHED;
            PG8_STAGE(PG8_SB(1, 1), b3 + hstepB, voffB);
            PG8_WAIT_V(6); PG8_BAR; PG8_MMA(1, 1, At, B1); PG8_BAR;
            }
        }
        if constexpr (ALIGN_EPI) { if (wr == 0) PG8_BAR; }
        E(acc, cur, wr, wc, fr, fq);
        if (!has_next) break;
        if (!E.keep(cur)) {
#pragma unroll
            for (int a = 0; a < 2; ++a)
#pragma unroll
                for (int b = 0; b < 2; ++b)
#pragma unroll
                    for (int m = 0; m < 4; ++m)
#pragma unroll
                        for (int n = 0; n < 2; ++n) acc[a][b][m][n] = (f32x4){0.f, 0.f, 0.f, 0.f};
        }
        cur = nxt; cA = nA; cB = nB; ++ui;
        if constexpr (ALIGN_EPI) { if (wr == 1) PG8_BAR; }
    }
    PG8_WAIT_V(0);
    if constexpr (!ALIGN_EPI) { if (wr == 0) PG8_BAR; }
    PG8_BAR;
#undef PG8_SA
#undef PG8_SB
#undef PG8_STAGE
#undef PG8_LDA
#undef PG8_LDB
#undef PG8_MMA
#undef PG8_WAIT_V
#undef PG8_WAIT_L
#undef PG8_BAR
#undef PG8_SCHED
}

typedef f32x4 Acc[2][2][4][2];

struct EpiProj {
    static constexpr bool PERM = true;
    bf16_t *cqkv, *gqkv, *og, *up, *misc; const LAS float* rs_tab; float* ssq;
    __device__ __forceinline__ bool keep(const Unit&) const { return false; }
    __device__ __forceinline__ void operator()(Acc& acc, const Unit& u, int wr, int wc, int fr, int fq) const {
        const int row0 = u.pm * BM + wr * 64 + fr;
        bf16_t* dst; int ld, coff; const int pn = u.pn;
        if (pn < 2) { dst = cqkv; ld = 512; coff = pn * 256; }
        else if (pn < 6) { dst = gqkv; ld = 1024; coff = (pn - 2) * 256; }
        else if (pn < 8) { dst = og; ld = 512; coff = (pn - 6) * 256; }
        else if (pn < 10) { dst = up; ld = 512; coff = (pn - 8) * 256; }
        else { dst = misc; ld = 256; coff = 0; }
        const int col0 = coff + wc * 32 + 8 * fq;
#pragma unroll
        for (int ai = 0; ai < 2; ++ai)
#pragma unroll
            for (int m = 0; m < 4; ++m) { if (u.half && ai != u.half - 1) continue;
                const int row = row0 + ai * HALF + m * 16;
                const float rs = rs_tab[wr * 64 + fr + ai * HALF + m * 16];
                float ss = 0.f;
#pragma unroll
                for (int bj = 0; bj < 2; ++bj) {
                    const f32x4 v0 = acc[ai][bj][m][0] * rs, v1 = acc[ai][bj][m][1] * rs;
                    ss += (v0[0] * v0[0] + v0[1] * v0[1]) + (v0[2] * v0[2] + v0[3] * v0[3]) + (v1[0] * v1[0] + v1[1] * v1[1]) + (v1[2] * v1[2] + v1[3] * v1[3]);
                    u32x4 w; w.x = cvt_pk_bf16(v0[0], v0[1]); w.y = cvt_pk_bf16(v0[2], v0[3]); w.z = cvt_pk_bf16(v1[0], v1[1]); w.w = cvt_pk_bf16(v1[2], v1[3]);
                    *(u32x4*)(dst + (size_t)row * ld + col0 + bj * HALF) = w;
                }
                if (pn < 2) { ss += __shfl_xor(ss, 16); ss += __shfl_xor(ss, 32); if (fq == 0) ssq[((size_t)pn * T + row) * 4 + wc] = ss; }
            }
    }
};
struct EpiUp {
    static constexpr bool PERM = true;
    bf16_t* out; const float* ssq;
    __device__ __forceinline__ bool keep(const Unit&) const { return false; }
    __device__ __forceinline__ void operator()(Acc& acc, const Unit& u, int wr, int wc, int fr, int fq) const {
        const int row0 = u.pm * BM + wr * 64 + fr, col0 = u.pn * BM + wc * 32 + 8 * fq;
        const float* sq = ssq + (u.pn < 3 ? (size_t)0 : (size_t)T * 4);
#pragma unroll
        for (int ai = 0; ai < 2; ++ai)
#pragma unroll
            for (int m = 0; m < 4; ++m) { if (u.half && ai != u.half - 1) continue;
                const int row = row0 + ai * HALF + m * 16;
                const float rs = rsqrtf(sum4(sq + (size_t)row * 4) * (1.f / 256.f) + EPS);
#pragma unroll
                for (int bj = 0; bj < 2; ++bj) {
                    const f32x4 v0 = acc[ai][bj][m][0] * rs, v1 = acc[ai][bj][m][1] * rs;
                    u32x4 w; w.x = cvt_pk_bf16(v0[0], v0[1]); w.y = cvt_pk_bf16(v0[2], v0[3]); w.z = cvt_pk_bf16(v1[0], v1[1]); w.w = cvt_pk_bf16(v1[2], v1[3]);
                    *(u32x4*)(out + (size_t)row * 1792 + col0 + bj * HALF) = w;
                }
            }
    }
};
struct EpiGate {
    static constexpr bool PERM = true;
    unsigned char* acts; const LAS float* rs_tab;
    __device__ __forceinline__ bool keep(const Unit&) const { return false; }
    __device__ __forceinline__ void operator()(Acc& acc, const Unit& u, int wr, int wc, int fr, int fq) const {
        const int row0 = u.pm * BM + wr * 64 + fr, pl = u.pn >> 2, col0 = (u.pn & 3) * BM + wc * 32 + 8 * fq;
        bf16_t* dst = (bf16_t*)(acts + ((long long)A_G0 + (long long)(pl == 1) * (long long)(A_G1 - A_G0) + (long long)(pl == 2) * (long long)(A_G2 - A_G0)));
#pragma unroll
        for (int ai = 0; ai < 2; ++ai)
#pragma unroll
            for (int m = 0; m < 4; ++m) { if (u.half && ai != u.half - 1) continue;
                const int row = row0 + ai * HALF + m * 16;
                const float rs = rs_tab[wr * 64 + fr + ai * HALF + m * 16];
#pragma unroll
                for (int bj = 0; bj < 2; ++bj) {
                    f32x4 v0 = acc[ai][bj][m][0] * rs, v1 = acc[ai][bj][m][1] * rs;
#ifndef DBG_NOSIG
#pragma unroll
                    for (int e = 0; e < 4; ++e) { v0[e] = fast_sigmoid(fminf(fmaxf(v0[e], -60.f), 60.f)); v1[e] = fast_sigmoid(fminf(fmaxf(v1[e], -60.f), 60.f)); }
#endif
                    u32x4 w; w.x = cvt_pk_bf16(v0[0], v0[1]); w.y = cvt_pk_bf16(v0[2], v0[3]); w.z = cvt_pk_bf16(v1[0], v1[1]); w.w = cvt_pk_bf16(v1[2], v1[3]);
                    *(u32x4*)(dst + (size_t)row * 1024 + col0 + bj * HALF) = w;
                }
            }
    }
};
struct EpiMerge {
    static constexpr bool PERM = true;
    const unsigned char* acts; bf16_t* merged;
    __device__ __forceinline__ bool keep(const Unit& u) const { return u.kind < 2; }
    __device__ __forceinline__ void operator()(Acc& acc, const Unit& u, int wr, int wc, int fr, int fq) const {
        const int row0 = u.pm * BM + wr * 64 + fr, col0 = u.pn * BM + wc * 32 + 8 * fq, n = u.kind;
        const bf16_t* gn = (const bf16_t*)(acts + ((long long)A_G0 + (long long)(n == 1) * (long long)(A_G1 - A_G0) + (long long)(n == 2) * (long long)(A_G2 - A_G0)));
        const bf16_t* gd = (const bf16_t*)(acts + ((long long)A_G1 + (long long)(n != 0) * (long long)(A_G2 - A_G1)));
#pragma unroll
        for (int ai = 0; ai < 2; ++ai)
#pragma unroll
            for (int m = 0; m < 4; ++m) { if (u.half && ai != u.half - 1) continue;
                const int row = row0 + ai * HALF + m * 16;
#pragma unroll
                for (int bj = 0; bj < 2; ++bj) {
                    const size_t off = (size_t)row * 1024 + col0 + bj * HALF;
                    const u32x4 sn = *(const u32x4*)(gn + off);
                    f32x4 f0 = {bflo(sn.x), bfhi(sn.x), bflo(sn.y), bfhi(sn.y)}, f1 = {bflo(sn.z), bfhi(sn.z), bflo(sn.w), bfhi(sn.w)};
                    if (n < 2) {
                        const u32x4 sd = *(const u32x4*)(gd + off);
                        const f32x4 d0 = {bflo(sd.x), bfhi(sd.x), bflo(sd.y), bfhi(sd.y)}, d1 = {bflo(sd.z), bfhi(sd.z), bflo(sd.w), bfhi(sd.w)};
#pragma unroll
                        for (int e = 0; e < 4; ++e) { f0[e] *= __builtin_amdgcn_rcpf(d0[e]); f1[e] *= __builtin_amdgcn_rcpf(d1[e]); }
                        acc[ai][bj][m][0] = acc[ai][bj][m][0] * f0; acc[ai][bj][m][1] = acc[ai][bj][m][1] * f1;
                    } else {
                        const f32x4 v0 = acc[ai][bj][m][0] * f0, v1 = acc[ai][bj][m][1] * f1;
                        u32x4 w; w.x = cvt_pk_bf16(v0[0], v0[1]); w.y = cvt_pk_bf16(v0[2], v0[3]); w.z = cvt_pk_bf16(v1[0], v1[1]); w.w = cvt_pk_bf16(v1[2], v1[3]);
                        *(u32x4*)((unsigned char*)(merged + off) + (row >= 8192 ? MERGED_HI_DELTA : 0)) = w;
                    }
                }
            }
    }
};
struct EpiResid {
    static constexpr bool PERM = true;
    bf16_t* xb; float* rowss_next;
    __device__ __forceinline__ bool keep(const Unit&) const { return false; }
    __device__ __forceinline__ void operator()(Acc& acc, const Unit& u, int wr, int wc, int fr, int fq) const {
        const int row0 = u.pm * BM + wr * 64 + fr, col0 = u.pn * BM + wc * 32 + 8 * fq;
#pragma unroll
        for (int ai = 0; ai < 2; ++ai)
#pragma unroll
            for (int m = 0; m < 4; ++m) { if (u.half && ai != u.half - 1) continue;
                const int row = row0 + ai * HALF + m * 16; float ss = 0.f;
#pragma unroll
                for (int bj = 0; bj < 2; ++bj) {
                    bf16_t* p = xb + (size_t)row * D + col0 + bj * HALF;
                    const u32x4 o = *(const u32x4*)p;
                    const f32x4 v0 = (f32x4){bflo(o.x), bfhi(o.x), bflo(o.y), bfhi(o.y)} + acc[ai][bj][m][0], v1 = (f32x4){bflo(o.z), bfhi(o.z), bflo(o.w), bfhi(o.w)} + acc[ai][bj][m][1];
                    ss += ((v0[0] * v0[0] + v0[1] * v0[1]) + (v0[2] * v0[2] + v0[3] * v0[3])) + ((v1[0] * v1[0] + v1[1] * v1[1]) + (v1[2] * v1[2] + v1[3] * v1[3]));
                    u32x4 w; w.x = cvt_pk_bf16(v0[0], v0[1]); w.y = cvt_pk_bf16(v0[2], v0[3]); w.z = cvt_pk_bf16(v1[0], v1[1]); w.w = cvt_pk_bf16(v1[2], v1[3]);
                    *(u32x4*)p = w;
                }
                ss += __shfl_xor(ss, 16); ss += __shfl_xor(ss, 32); if (fq == 0) rowss_next[(size_t)row * 16 + u.pn * 4 + wc] = ss;
            }
    }
};
template <bool MOE> struct EpiSwiglu {
    static constexpr bool PERM = true;
    bf16_t* act; int ld; const LAS float* rs_tab; const float* slot_scale; const float* slot_comb;
    __device__ __forceinline__ bool keep(const Unit&) const { return false; }
    __device__ __forceinline__ void operator()(Acc& acc, const Unit& u, int wr, int wc, int fr, int fq) const {
        const int row0 = u.pm * BM + wr * 64 + fr, col0 = u.pn * HALF + wc * 32 + 8 * fq;
#pragma unroll
        for (int ai = 0; ai < 2; ++ai)
#pragma unroll
            for (int m = 0; m < 4; ++m) { if (u.half && ai != u.half - 1) continue;
                const int row = row0 + ai * HALF + m * 16;
                float rs, cb;
                if (MOE) { rs = slot_scale[row]; cb = slot_comb[row]; } else { rs = rs_tab[wr * 64 + fr + ai * HALF + m * 16]; cb = 1.f; }
                f32x4 o[2];
#pragma unroll
                for (int n = 0; n < 2; ++n) {
                    const f32x4 g = acc[ai][0][m][n] * rs, uu = acc[ai][1][m][n] * rs;
#pragma unroll
                    for (int e = 0; e < 4; ++e) o[n][e] = g[e] * fast_sigmoid(g[e]) * uu[e] * cb;
                }
                u32x4 w; w.x = cvt_pk_bf16(o[0][0], o[0][1]); w.y = cvt_pk_bf16(o[0][2], o[0][3]); w.z = cvt_pk_bf16(o[1][0], o[1][1]); w.w = cvt_pk_bf16(o[1][2], o[1][3]);
                *(u32x4*)(act + (size_t)row * ld + col0) = w;
            }
    }
};
struct EpiMoeDown {
    static constexpr bool PERM = true;
    bf16_t* y;
    __device__ __forceinline__ bool keep(const Unit&) const { return false; }
    __device__ __forceinline__ void operator()(Acc& acc, const Unit& u, int wr, int wc, int fr, int fq) const {
        const int row0 = u.pm * BM + wr * 64 + fr, col0 = u.pn * BM + wc * 32 + 8 * fq;
#pragma unroll
        for (int ai = 0; ai < 2; ++ai)
#pragma unroll
            for (int m = 0; m < 4; ++m) { if (u.half && ai != u.half - 1) continue;
                const int row = row0 + ai * HALF + m * 16;
#pragma unroll
                for (int bj = 0; bj < 2; ++bj) {
                    const f32x4 v0 = acc[ai][bj][m][0], v1 = acc[ai][bj][m][1];
                    u32x4 w; w.x = cvt_pk_bf16(v0[0], v0[1]); w.y = cvt_pk_bf16(v0[2], v0[3]); w.z = cvt_pk_bf16(v1[0], v1[1]); w.w = cvt_pk_bf16(v1[2], v1[3]);
                    *(u32x4*)(y + (size_t)row * D + col0 + bj * HALF) = w;
                }
            }
    }
};

struct SchedGrid {
    const char* A; const char* B; size_t a_tile, b_tile, a_alt; int nM, nN, G, c, alt_from; long long a_hi = 0;
    int split_from = 1 << 30;
    __device__ __forceinline__ bool next(int i, Unit& u) const {
        int L = i * G + c, hf = 0;
        if (L >= split_from) { const int nl = nM * nN - split_from, j = L - split_from; if (j >= 2 * nl) return false; hf = 1 + j / nl; L = split_from + j % nl; }
        if (L >= nM * nN) return false;
        int pm, pn; tile_map(L, nM, nN, pm, pn);
        u.pm = pm; u.pn = pn; u.kind = 0; u.half = hf; u.a = A + (size_t)pm * a_tile + (pn >= alt_from ? a_alt : 0) + (pm >= 32 ? a_hi : 0); u.b = B + (size_t)pn * b_tile; return true;
    }
};
struct SchedMerge {
    const char* acts; const char* wbr; int G, c;
    __device__ __forceinline__ bool next(int i, Unit& u) const {
        const int ti = i / 3, n = i - ti * 3, L = ti * G + c; if (L >= 256) return false;
        int pm, pn; tile_map(L, 64, 4, pm, pn);
        u.pm = pm; u.pn = pn; u.kind = n; u.half = 0; u.a = acts + ((long long)A_YSA + (long long)(n == 1) * ((long long)A_YSB - (long long)A_YSA) + (long long)(n == 2) * ((long long)A_POOLED - (long long)A_YSA)) + (size_t)pm * (256 * 512 * 2); u.b = wbr + (size_t)n * (1024 * 512 * 2) + (size_t)pn * (256 * 512 * 2); return true;
    }
};
struct SchedMoe {
    const char* A; const char* B; size_t a_tile, b_tile, b_exp; int MT, nN, G, c; int t1, t2, t3, t4, t5, t6, t7;
    __device__ __forceinline__ bool next(int i, Unit& u) const {
        const int L = i * G + c; if (L >= MT * nN) return false;
        int pm, pn; tile_map(L, MT, nN, pm, pn);
        const int e = (pm >= t1) + (pm >= t2) + (pm >= t3) + (pm >= t4) + (pm >= t5) + (pm >= t6) + (pm >= t7);
        u.pm = pm; u.pn = pn; u.kind = e; u.half = 0; u.a = A + (size_t)pm * a_tile; u.b = B + (size_t)e * b_exp + (size_t)pn * b_tile; return true;
    }
};
}

#define XB_TMO      128
#define XB_XCNT(j)  (256  + 64 * (j))
#define XB_XSUB(j)  (1280 + 64 * (j))
#define XB_XGEN(j)  (2304 + 64 * (j))
#define XB_TOP      3328
#define XB_TOPGEN   3392
#define XCD_BAR_WORDS 3456
#define XB_SPIN_CAP (1u << 18)
__device__ __forceinline__ unsigned xb_ld(unsigned* p)              { return __hip_atomic_load(p, __ATOMIC_RELAXED, __HIP_MEMORY_SCOPE_AGENT); }
__device__ __forceinline__ unsigned xb_add(unsigned* p, unsigned v) { return __hip_atomic_fetch_add(p, v, __ATOMIC_RELAXED, __HIP_MEMORY_SCOPE_AGENT); }
__device__ __forceinline__ unsigned xb_xcc_id() { return (unsigned)__builtin_amdgcn_s_getreg((3 << 11) | 20) & 0xFu; }
#define XB_SPIN(cond, bar) do { unsigned _sp = 0; while (cond) { __builtin_amdgcn_s_sleep(1); \
    if ((++_sp & 255u) == 0u) { if (xb_ld(&(bar)[XB_TMO])) break; if (_sp > XB_SPIN_CAP) { atomicAdd(&(bar)[XB_TMO], 1u); break; } } } } while (0)
struct XcdBarrier { unsigned* bar; unsigned x; volatile LAS unsigned* st; };
__device__ __forceinline__ XcdBarrier xcd_barrier_post(unsigned* bar, volatile LAS unsigned* st) {
    XcdBarrier b; b.bar = bar; b.x = xb_xcc_id(); b.st = st;
    if (threadIdx.x == 0) (void)xb_add(&bar[XB_XCNT(b.x)], 1u);
    return b;
}
__device__ __forceinline__ void xcd_barrier_complete(unsigned* bar, unsigned x, unsigned& nloc, unsigned& nx) {
    const unsigned G = gridDim.x * gridDim.y * gridDim.z;
    unsigned sum, cnt, mine, sp = 0u;
    for (;;) {
        sum = 0u; cnt = 0u; mine = 0u;
#pragma unroll
        for (unsigned j = 0; j < 16; ++j) { const unsigned c = xb_ld(&bar[XB_XCNT(j)]); sum += c; cnt += (c > 0u) ? 1u : 0u; mine = (j == x) ? c : mine; }
        if (sum == G) break;
        __builtin_amdgcn_s_sleep(1);
        if ((++sp & 255u) == 0u) { if (xb_ld(&bar[XB_TMO])) break; if (sp > XB_SPIN_CAP) { atomicAdd(&bar[XB_TMO], 1u); break; } }
    }
    nloc = mine > 0u ? mine : 1u; nx = cnt > 0u ? cnt : 1u;
}
__device__ __forceinline__ void xcd_barrier(const XcdBarrier& b) {
    asm volatile("s_waitcnt vmcnt(0)" ::: "memory");
    __syncthreads();
    if (threadIdx.x == 0) {
        unsigned* bar = b.bar;
        __builtin_amdgcn_s_waitcnt(0);
        unsigned nloc = b.st[0], nx = b.st[1];
        if (nloc == 0u) { xcd_barrier_complete(bar, b.x, nloc, nx); b.st[0] = nloc; b.st[1] = nx; }
        const unsigned old = xb_add(&bar[XB_XSUB(b.x)], 1u);
        const unsigned gen = old / nloc;
        if (old + 1u == (gen + 1u) * nloc) {
            __builtin_amdgcn_fence(__ATOMIC_RELEASE, "agent");
            asm volatile("s_waitcnt vmcnt(0)" ::: "memory");
            const unsigned og = xb_add(&bar[XB_TOP], 1u);
            const unsigned tg = og / nx;
            if (og + 1u == (tg + 1u) * nx) xb_add(&bar[XB_TOPGEN], 1u);
            else XB_SPIN(xb_ld(&bar[XB_TOPGEN]) == tg, bar);
            __builtin_amdgcn_fence(__ATOMIC_ACQUIRE, "agent");
            xb_add(&bar[XB_XGEN(b.x)], 1u);
            asm volatile("s_waitcnt vmcnt(0)" ::: "memory");
        } else {
            XB_SPIN(xb_ld(&bar[XB_XGEN(b.x)]) == gen, bar);
            __builtin_amdgcn_fence(__ATOMIC_ACQUIRE, "agent");
            asm volatile("s_waitcnt vmcnt(0)" ::: "memory");
        }
    }
    __syncthreads();
}

struct Frame {
    LAS unsigned char* lds;
    volatile LAS unsigned* MISC;
    unsigned* ctl; float* ctlf; float* stats;
    unsigned char* ws;
    int tid, lane, wave, vcu, G;
    const CAS GPtr* inp;
    float* out;
    __device__ __forceinline__ const float* in(int i) const { return (const float*)inp[i]; }
};
enum { I_X = 0, I_POS, I_GMIX, I_WIN, I_GCQ, I_WUQ, I_GCKV, I_WUKV, I_GQKQ, I_GQKK, I_WGLA, I_BGLA, I_GGLAO, I_WPOOL, I_PSCALE, I_WBR, I_WOUT, I_GFFN, I_WFG, I_WFU, I_WFD, I_WROUTER, I_WEG, I_WEU, I_WED };

__device__ __forceinline__ bf16_t* act_ptr(const Frame& F, size_t off) { return (bf16_t*)(F.ws + WS_ACTS + off); }
__device__ __forceinline__ unsigned char* wblk(const Frame& F, int layer) { return F.ws + (layer == 0 ? WS_W0 : WS_W1); }

__device__ __forceinline__ void fill_rs(Frame& F, const float* rowss, int pm) {
    if (F.tid < 256) ((LAS float*)(F.lds + RS_OFF))[F.tid] = rsqrtf(sum16(rowss + ((size_t)pm * 256 + F.tid) * 16) * (1.f / 1024.f) + EPS);
    __syncthreads();
}
struct ConvSeg { const float* src; int ld, K, width, col0; bf16_t* dst; int row0, inter; const float* gain; };
typedef short v4i16c_t __attribute__((ext_vector_type(4)));
__device__ __forceinline__ int seg_items(const ConvSeg& s) { return (s.K >> 6) * ((s.width + 63) >> 6); }
__device__ __forceinline__ void conv_load(const ConvSeg& s, int item, int lane, f32x4 (&v)[16]) {
    const int nblk = (s.width + 63) >> 6, kb = item / nblk, nb = item - kb * nblk, k0 = kb * 64, n0 = nb * 64;
    const int kq = lane >> 4, n4 = (lane & 15) * 4; const bool ok = n0 + n4 < s.width;
    const float* p = s.src + (size_t)(k0 + kq) * s.ld + s.col0 + n0 + n4;
#pragma unroll
    for (int i = 0; i < 16; ++i) v[i] = ok ? *(const f32x4*)(p + (size_t)(4 * i) * s.ld) : (f32x4){0.f, 0.f, 0.f, 0.f};
}
__device__ __forceinline__ void conv_store(const ConvSeg& s, int item, LAS unsigned char* scr, int lane, const f32x4 (&v)[16]) {
    const int nblk = (s.width + 63) >> 6, kb = item / nblk, nb = item - kb * nblk, k0 = kb * 64, n0 = nb * 64;
    const int kq = lane >> 4, n4 = (lane & 15) * 4;
#pragma unroll
    for (int i = 0; i < 16; ++i) {
        f32x4 x = v[i]; if (s.gain) x = x * s.gain[k0 + 4 * i + kq];
        *(LAS u32x2*)(scr + (4 * i + kq) * 136 + n4 * 2) = (u32x2){cvt_pk_bf16(x[0], x[1]), cvt_pk_bf16(x[2], x[3])};
    }
    LDS_WAIT();
    const int g = lane >> 4, i16 = lane & 15;
#pragma unroll
    for (int nb16 = 0; nb16 < 4; ++nb16)
#pragma unroll
        for (int kh = 0; kh < 2; ++kh) {
            const int c = kh * 4 + g;
            const LAS unsigned char* a = scr + (8 * c + (i16 >> 2)) * 136 + (nb16 * 16 + (i16 & 3) * 4) * 2;
            const v4i16c_t lo = __builtin_amdgcn_ds_read_tr16_b64_v4i16((LAS v4i16c_t*)a), hi = __builtin_amdgcn_ds_read_tr16_b64_v4i16((LAS v4i16c_t*)(a + 4 * 136));
            const int nq = n0 + nb16 * 16 + i16;
            if (nq < s.width) {
                const int drow = s.row0 + (s.inter ? ((nq >> 7) * 256 + (nq & 127)) : nq);
                typedef short s16x8_t __attribute__((ext_vector_type(8)));
                *(s16x8_t*)(s.dst + (size_t)drow * s.K + k0 + 8 * c) = (s16x8_t){lo[0], lo[1], lo[2], lo[3], hi[0], hi[1], hi[2], hi[3]};
            }
        }
    LDS_WAIT();
}
__device__ __forceinline__ ConvSeg mixer_seg(const Frame& F, int l, int idx) {
    unsigned char* wb = wblk(F, l);
    ConvSeg s; s.inter = 0; s.row0 = 0; s.col0 = 0;
    if (idx < 10) {
        int c0, wd, r0;
        switch (idx) {
            case 0: c0 = 0; wd = 256; r0 = 0; break;
            case 1: c0 = 256; wd = 256; r0 = 256; break;
            case 2: c0 = 544; wd = 256; r0 = 512; break;
            case 3: c0 = 800; wd = 256; r0 = 768; break;
            case 4: c0 = 1056; wd = 512; r0 = 1024; break;
            case 5: c0 = 1584; wd = 512; r0 = 1536; break;
            case 6: c0 = 2096; wd = 512; r0 = 2048; break;
            case 7: c0 = 512; wd = 32; r0 = 2560; break;
            case 8: c0 = 1568; wd = 16; r0 = 2592; break;
            default: c0 = 2608; wd = 3072; r0 = 0; break;
        }
        s.src = F.in(I_WIN) + (size_t)l * D * DIN; s.ld = DIN; s.K = D; s.width = wd; s.col0 = c0;
        s.dst = (bf16_t*)(wb + (idx == 9 ? WO_G : WO_IN)); s.row0 = r0; s.gain = F.in(I_GMIX) + l * D;
    } else if (idx == 10) { s.src = F.in(I_WUQ) + (size_t)l * 256 * 768; s.ld = 768; s.K = 256; s.width = 768; s.dst = (bf16_t*)(wb + WO_UP); s.gain = F.in(I_GCQ) + l * 256; }
    else if (idx == 11) { s.src = F.in(I_WUKV) + (size_t)l * 256 * 1024; s.ld = 1024; s.K = 256; s.width = 1024; s.dst = (bf16_t*)(wb + WO_UP); s.row0 = 768; s.gain = F.in(I_GCKV) + l * 256; }
    else if (idx < 14) { const int n = idx - 12; s.src = F.in(I_WBR) + (size_t)(l * 3 + n) * 512 * D; s.ld = D; s.K = 512; s.width = D; s.dst = (bf16_t*)(wb + WO_BR) + (size_t)n * 1024 * 512; s.gain = nullptr; }
    else { s.src = F.in(I_WOUT) + (size_t)l * D * D; s.ld = D; s.K = D; s.width = D; s.dst = (bf16_t*)(wb + WO_OUT); s.gain = nullptr; }
    return s;
}
__device__ __forceinline__ ConvSeg ffn_seg(const Frame& F, int idx) {
    unsigned char* wb = F.ws + WS_W0; ConvSeg s; s.col0 = 0; s.inter = 0; s.row0 = 0;
    if (idx < 2) { s.src = F.in(idx == 0 ? I_WFG : I_WFU); s.ld = DFF; s.K = D; s.width = DFF; s.dst = (bf16_t*)(wb + WO_FGU); s.row0 = idx * 128; s.inter = 1; s.gain = F.in(I_GFFN); }
    else { s.src = F.in(I_WFD); s.ld = D; s.K = DFF; s.width = D; s.dst = (bf16_t*)(wb + WO_FD); s.gain = nullptr; }
    return s;
}
__device__ __forceinline__ ConvSeg moe_seg(const Frame& F, int idx) {
    unsigned char* wb = F.ws + WS_W0; const int e = idx / 3, k = idx - e * 3; ConvSeg s; s.col0 = 0; s.inter = 0; s.row0 = 0;
    if (k < 2) { s.src = F.in(k == 0 ? I_WEG : I_WEU) + (size_t)e * D * DEXP; s.ld = DEXP; s.K = D; s.width = DEXP; s.dst = (bf16_t*)(wb + WO_MGU) + (size_t)e * 2816 * 1024; s.row0 = k * 128; s.inter = 1; s.gain = F.in(I_GFFN) + D; }
    else { s.src = F.in(I_WED) + (size_t)e * DEXP * D; s.ld = D; s.K = DEXP; s.width = D; s.dst = (bf16_t*)(wb + WO_MD) + (size_t)e * 1024 * 1408; s.gain = nullptr; }
    return s;
}
#define CONV_LOCATE(NSEG, GETSEG, IT, SEGOUT, IDXOUT) do { int r_ = (IT); for (int si_ = 0; si_ < (NSEG); ++si_) { const ConvSeg sg_ = GETSEG; const int n_ = seg_items(sg_); SEGOUT = sg_; IDXOUT = r_; if (r_ < n_) break; r_ -= n_; } } while (0)
#define CONV_LOOP(NSEG, GETSEG) do { int total_ = 0; for (int si_ = 0; si_ < (NSEG); ++si_) { const ConvSeg sg_ = GETSEG; total_ += seg_items(sg_); } \
        int it_ = gw; if (it_ < total_) { ConvSeg cs_; int ci_ = 0; f32x4 va_[16]; CONV_LOCATE(NSEG, GETSEG, it_, cs_, ci_); conv_load(cs_, ci_, F.lane, va_); \
        for (;;) { const int nx_ = it_ + NGW; const bool hn_ = nx_ < total_; ConvSeg ns_; int ni_ = 0; f32x4 vb_[16]; CONV_LOCATE(NSEG, GETSEG, (hn_ ? nx_ : it_), ns_, ni_); conv_load(ns_, ni_, F.lane, vb_); \
            _Pragma("unroll") for (int q_ = 0; q_ < 16; ++q_) asm volatile("" : "+v"(va_[q_])); \
            conv_store(cs_, ci_, (LAS unsigned char*)scr, F.lane, va_); if (!hn_) break; \
            _Pragma("unroll") for (int q_ = 0; q_ < 16; ++q_) va_[q_] = vb_[q_]; cs_ = ns_; ci_ = ni_; it_ = nx_; } } } while (0)
__device__ __forceinline__ void fold_pool(const Frame& F, int l, int gw, int NGW) {
    const float* wp = F.in(I_WPOOL) + (size_t)l * 4 * 128 * 128; const float* ps = F.in(I_PSCALE) + l * 512; const float* wb2 = F.in(I_WBR) + (size_t)(l * 3 + 2) * 512 * D;
    bf16_t* dst = (bf16_t*)(wblk(F, l) + WO_BR) + (size_t)2 * 1024 * 512;
    for (int it = gw; it < 1024; it += NGW) {
        const int db = it & 15, g = (it >> 4) & 3, cb = it >> 6, d = db * 64 + F.lane, c0 = cb * 8;
        float a[8];
#pragma unroll
        for (int i = 0; i < 8; ++i) a[i] = 0.f;
        for (int j = 0; j < 128; ++j) {
            const float w = wb2[(size_t)(g * 128 + j) * D + d] * ps[g * 128 + j];
#pragma unroll
            for (int i = 0; i < 8; ++i) a[i] = fmaf(wp[(size_t)(g * 128 + c0 + i) * 128 + j], w, a[i]);
        }
        u32x4 o; o.x = cvt_pk_bf16(a[0], a[1]); o.y = cvt_pk_bf16(a[2], a[3]); o.z = cvt_pk_bf16(a[4], a[5]); o.w = cvt_pk_bf16(a[6], a[7]);
        *(u32x4*)(dst + (size_t)d * 512 + g * 128 + c0) = o;
    }
}

__device__ __forceinline__ void p0_prologue(Frame& F) {
    LAS float* scr = (LAS float*)(F.lds + F.wave * 16384);
    const int gw = F.vcu * 8 + F.wave, NGW = F.G * 8;
    { bf16_t* xb = (bf16_t*)(F.ws + WS_XB); float* rss = F.stats + SF_ROWSS;
      for (int m = gw; m < T; m += NGW) {
          const f32x4* xr = (const f32x4*)(F.in(I_X) + (size_t)m * D) + F.lane; float s = 0.f;
          unsigned long long* o8 = (unsigned long long*)(xb + (size_t)m * D) + F.lane;
#pragma unroll
          for (int j = 0; j < 4; ++j) { const f32x4 v = xr[64 * j]; s += (v[0] * v[0] + v[1] * v[1]) + (v[2] * v[2] + v[3] * v[3]);
              o8[64 * j] = (unsigned long long)cvt_pk_bf16(v[0], v[1]) | ((unsigned long long)cvt_pk_bf16(v[2], v[3]) << 32); }
          s = wave_sum(s); if (F.lane < 16) rss[(size_t)m * 16 + F.lane] = (F.lane == 0) ? s : 0.f;
      } }
    { float* rt = (float*)(F.ws + WS_ROPE); const int* pos = (const int*)F.in(I_POS);
      for (int i = F.vcu * 512 + F.tid; i < T * 16; i += F.G * 512) {
          const int t = i >> 4, k = i & 15; const float inv = powf(10000.f, -(float)k / 16.f), ang = (float)pos[t] * inv;
          rt[t * 32 + k] = cosf(ang); rt[t * 32 + 16 + k] = sinf(ang);
      } }
    CONV_LOOP(15, mixer_seg(F, 0, si_));
    fold_pool(F, 0, gw, NGW);
}

__device__ __forceinline__ void gla_prep(Frame& F, int l, int unit);
__device__ __forceinline__ void phase_prep(Frame& F, int l, int rpt = 0) {
    const bf16_t* raw = act_ptr(F, A_QKVRAW); const bf16_t* misc = act_ptr(F, A_MISC);
    bf16_t* QH = act_ptr(F, A_QH); bf16_t* KH = act_ptr(F, A_KH); bf16_t* VT = act_ptr(F, A_VT);
    const float* rope = (const float*)(F.ws + WS_ROPE);
    const float* gq = F.in(I_GQKQ) + l * 96; const float* gk = F.in(I_GQKK) + l * 96;
    LAS bf16_t* vt = (LAS bf16_t*)F.lds;
    for (int unit = F.vcu; unit < T / 64; unit += F.G) {
        const int t0 = unit * 64, b = t0 / SEQ, s0 = t0 % SEQ;
        if (!rpt) gla_prep(F, l, unit);
#pragma unroll 1
        for (int it = F.tid; it < 1024; it += 512) {
            const int which = it & 1, h = (it >> 1) & 7, tok = it >> 4, t = t0 + tok;
            const bf16_t* nope = raw + (size_t)t * 1792 + (which ? 768 + h * 128 : h * 96);
            const bf16_t* rp = which ? misc + (size_t)t * 256 : nope + 64;
            const float* g = which ? gk : gq;
            u32x4 c[12];
#pragma unroll
            for (int i = 0; i < 8; ++i) c[i] = *(const u32x4*)(nope + 8 * i);
#pragma unroll
            for (int i = 0; i < 4; ++i) c[8 + i] = *(const u32x4*)(rp + 8 * i);
            float ss = 0.f;
#pragma unroll
            for (int i = 0; i < 12; ++i) {
                const float a0 = bflo(c[i].x), a1 = bfhi(c[i].x), a2 = bflo(c[i].y), a3 = bfhi(c[i].y), a4 = bflo(c[i].z), a5 = bfhi(c[i].z), a6 = bflo(c[i].w), a7 = bfhi(c[i].w);
                ss += (a0 * a0 + a1 * a1) + (a2 * a2 + a3 * a3) + (a4 * a4 + a5 * a5) + (a6 * a6 + a7 * a7);
            }
            float r = rsqrtf(ss * (1.f / 96.f) + EPS);
            if (!which) r *= 0.14724444f;
            bf16_t* dst = (which ? KH : QH) + ((size_t)(b * 8 + h) * SEQ + s0 + tok) * 96;
#pragma unroll
            for (int i = 0; i < 8; ++i) {
                const f32x4 g0 = *(const f32x4*)(g + 8 * i), g1 = *(const f32x4*)(g + 8 * i + 4);
                u32x4 o; o.x = cvt_pk_bf16(bflo(c[i].x) * r * g0[0], bfhi(c[i].x) * r * g0[1]); o.y = cvt_pk_bf16(bflo(c[i].y) * r * g0[2], bfhi(c[i].y) * r * g0[3]);
                o.z = cvt_pk_bf16(bflo(c[i].z) * r * g1[0], bfhi(c[i].z) * r * g1[1]); o.w = cvt_pk_bf16(bflo(c[i].w) * r * g1[2], bfhi(c[i].w) * r * g1[3]);
                *(u32x4*)(dst + 8 * i) = o;
            }
#pragma unroll
            for (int hh = 0; hh < 2; ++hh) {
                const u32x4 x1c = c[8 + hh], x2c = c[10 + hh];
                float x1[8] = {bflo(x1c.x), bfhi(x1c.x), bflo(x1c.y), bfhi(x1c.y), bflo(x1c.z), bfhi(x1c.z), bflo(x1c.w), bfhi(x1c.w)};
                float x2[8] = {bflo(x2c.x), bfhi(x2c.x), bflo(x2c.y), bfhi(x2c.y), bflo(x2c.z), bfhi(x2c.z), bflo(x2c.w), bfhi(x2c.w)};
                float o1[8], o2[8];
#pragma unroll
                for (int i = 0; i < 8; ++i) {
                    const int k = hh * 8 + i; const float cs = rope[(size_t)t * 32 + k], sn = rope[(size_t)t * 32 + 16 + k];
                    const float a = x1[i] * r * g[64 + k], bb = x2[i] * r * g[80 + k];
                    o1[i] = a * cs - bb * sn; o2[i] = bb * cs + a * sn;
                }
                u32x4 w1, w2; w1.x = cvt_pk_bf16(o1[0], o1[1]); w1.y = cvt_pk_bf16(o1[2], o1[3]); w1.z = cvt_pk_bf16(o1[4], o1[5]); w1.w = cvt_pk_bf16(o1[6], o1[7]);
                w2.x = cvt_pk_bf16(o2[0], o2[1]); w2.y = cvt_pk_bf16(o2[2], o2[3]); w2.z = cvt_pk_bf16(o2[4], o2[5]); w2.w = cvt_pk_bf16(o2[6], o2[7]);
                *(u32x4*)(dst + 64 + hh * 8) = w1; *(u32x4*)(dst + 80 + hh * 8) = w2;
            }
        }
        {
            const int tok = F.tid >> 3, cc = F.tid & 7;
            u32x4 vr[8];
#pragma unroll
            for (int h = 0; h < 8; ++h) vr[h] = *(const u32x4*)(raw + (size_t)(t0 + tok) * 1792 + 768 + h * 128 + 64 + cc * 8);
#pragma unroll
            for (int h = 0; h < 8; ++h) *(LAS u32x4*)(F.lds + h * 9216 + tok * 144 + cc * 16) = vr[h];
            __syncthreads();
            const int db = F.wave & 3, c = (F.wave >> 2) * 4 + (F.lane >> 4), i16 = F.lane & 15;
#pragma unroll
            for (int h = 0; h < 8; ++h) {
                const LAS unsigned char* a = F.lds + h * 9216 + (8 * c + (i16 >> 2)) * 144 + (16 * db + (i16 & 3) * 4) * 2;
                const v4i16c_t lo = __builtin_amdgcn_ds_read_tr16_b64_v4i16((LAS v4i16c_t*)a), hi = __builtin_amdgcn_ds_read_tr16_b64_v4i16((LAS v4i16c_t*)(a + 4 * 144));
                typedef short s16x8_t __attribute__((ext_vector_type(8)));
                *(s16x8_t*)(VT + ((size_t)(b * 8 + h) * 64 + 16 * db + i16) * SEQ + s0 + 8 * c) = (s16x8_t){lo[0], lo[1], lo[2], lo[3], hi[0], hi[1], hi[2], hi[3]};
            }
            __syncthreads();
        }
    }
}

constexpr int AT_KROW = 208, AT_KT = 64 * AT_KROW, AT_VROW = 136, AT_VTB = 64 * AT_VROW, AT_VOFF = 2 * AT_KT;
__device__ __forceinline__ void attn_unit(Frame& F, int bh, int qb) {
    const int tid = F.tid, lane = F.lane, wid = F.wave, r32 = lane & 31, hi = lane >> 5;
    const bf16_t* QHp = act_ptr(F, A_QH) + ((size_t)bh * SEQ + qb * 256 + wid * 32) * 96;
    const bf16_t* Kb = act_ptr(F, A_KH) + (size_t)bh * SEQ * 96;
    const bf16_t* Vb = act_ptr(F, A_VT) + (size_t)bh * 64 * SEQ;
    LAS unsigned char* lds = F.lds;
    bf16x8 qr[6];
#pragma unroll
    for (int s = 0; s < 6; ++s) qr[s] = *(const bf16x8*)(QHp + (size_t)r32 * 96 + 16 * s + 8 * hi);
    const int NT = 4 * (qb + 1);
    const int kp1 = 512 + tid;
    const unsigned kl0 = (unsigned)((tid / 12) * AT_KROW + (tid % 12) * 16), kl1 = (unsigned)((kp1 / 12) * AT_KROW + (kp1 % 12) * 16);
    const int vd = tid >> 3, vc = tid & 7;
    const unsigned vl = (unsigned)(AT_VOFF + vd * AT_VROW + vc * 16);
    u32x4 k0r, k1r, vr;
    k1r = (u32x4){0u, 0u, 0u, 0u};
#define AT_LOAD(j) do { k0r = *(const u32x4*)(Kb + (size_t)(j) * 6144 + tid * 8); if (tid < 256) k1r = *(const u32x4*)(Kb + (size_t)(j) * 6144 + kp1 * 8); \
        vr = *(const u32x4*)(Vb + (size_t)vd * SEQ + (j) * 64 + vc * 8); } while (0)
#define AT_STORE(buf) do { *(LAS u32x4*)(lds + (buf) * AT_KT + kl0) = k0r; if (tid < 256) *(LAS u32x4*)(lds + (buf) * AT_KT + kl1) = k1r; \
        *(LAS u32x2*)(lds + (buf) * AT_VTB + vl) = (u32x2){vr.x, vr.y}; *(LAS u32x2*)(lds + (buf) * AT_VTB + vl + 8) = (u32x2){vr.z, vr.w}; } while (0)
    AT_LOAD(0); AT_STORE(0);
    __syncthreads();
    float m_run = -1e30f, l_run = 0.f;
    f32x16 o0, o1;
#pragma unroll
    for (int r = 0; r < 16; ++r) { o0[r] = 0.f; o1[r] = 0.f; }
    const unsigned kfr = (unsigned)(r32 * AT_KROW + hi * 16), vfr = (unsigned)(AT_VOFF + r32 * AT_VROW + hi * 8);
    for (int j = 0; j < NT; ++j) {
        const int buf = j & 1;
        if (j + 1 < NT) AT_LOAD(j + 1);
        const int jb = j - 4 * qb;
        if (!(jb >= 0 && 2 * jb > wid)) {
            f32x16 p0, p1;
#pragma unroll
            for (int r = 0; r < 16; ++r) { p0[r] = 0.f; p1[r] = 0.f; }
            const LAS unsigned char* kb = lds + buf * AT_KT + kfr;
            __builtin_amdgcn_s_setprio(1);
#pragma unroll
            for (int s = 0; s < 6; ++s) {
                const bf16x8 a0 = *(const LAS bf16x8*)(kb + s * 32), a1 = *(const LAS bf16x8*)(kb + 32 * AT_KROW + s * 32);
                p0 = __builtin_amdgcn_mfma_f32_32x32x16_bf16(a0, qr[s], p0, 0, 0, 0);
                p1 = __builtin_amdgcn_mfma_f32_32x32x16_bf16(a1, qr[s], p1, 0, 0, 0);
            }
            __builtin_amdgcn_s_setprio(0);
            if (jb >= 0 && wid < 2 * jb + 2) {
                const int qrel = 32 * wid + r32, kb0 = 64 * jb + 4 * hi;
#pragma unroll
                for (int r = 0; r < 16; ++r) { const int kv = kb0 + (r & 3) + 8 * (r >> 2); if (kv > qrel) p0[r] = -INFINITY; if (kv + 32 > qrel) p1[r] = -INFINITY; }
            }
            float mx = fmaxf(p0[0], p1[0]);
#pragma unroll
            for (int r = 1; r < 16; ++r) mx = fmaxf(mx, fmaxf(p0[r], p1[r]));
            mx = fmaxf(mx, __shfl_xor(mx, 32));
            if (!__all(mx - m_run <= 8.f)) {
                const float mnew = fmaxf(m_run, mx), alpha = __builtin_amdgcn_exp2f(m_run - mnew);
                m_run = mnew; l_run *= alpha;
#pragma unroll
                for (int r = 0; r < 16; ++r) { o0[r] *= alpha; o1[r] *= alpha; }
            }
            float ps = 0.f;
#pragma unroll
            for (int r = 0; r < 16; ++r) { p0[r] = __builtin_amdgcn_exp2f(p0[r] - m_run); p1[r] = __builtin_amdgcn_exp2f(p1[r] - m_run); ps += p0[r] + p1[r]; }
            l_run += ps;
            const LAS unsigned char* vb = lds + buf * AT_VTB + vfr;
#pragma unroll
            for (int s = 0; s < 4; ++s) {
                u32x4 pw;
                if (s < 2) { pw.x = cvt_pk_bf16(p0[8 * s + 0], p0[8 * s + 1]); pw.y = cvt_pk_bf16(p0[8 * s + 2], p0[8 * s + 3]); pw.z = cvt_pk_bf16(p0[8 * s + 4], p0[8 * s + 5]); pw.w = cvt_pk_bf16(p0[8 * s + 6], p0[8 * s + 7]); }
                else { const int q = s - 2; pw.x = cvt_pk_bf16(p1[8 * q + 0], p1[8 * q + 1]); pw.y = cvt_pk_bf16(p1[8 * q + 2], p1[8 * q + 3]); pw.z = cvt_pk_bf16(p1[8 * q + 4], p1[8 * q + 5]); pw.w = cvt_pk_bf16(p1[8 * q + 6], p1[8 * q + 7]); }
                const bf16x8 pb = __builtin_bit_cast(bf16x8, pw);
                const u32x2 va0 = *(const LAS u32x2*)(vb + s * 32), va1 = *(const LAS u32x2*)(vb + s * 32 + 16);
                const u32x2 vb0 = *(const LAS u32x2*)(vb + 32 * AT_VROW + s * 32), vb1 = *(const LAS u32x2*)(vb + 32 * AT_VROW + s * 32 + 16);
                const bf16x8 fa = __builtin_bit_cast(bf16x8, (u32x4){va0.x, va0.y, va1.x, va1.y});
                const bf16x8 fb = __builtin_bit_cast(bf16x8, (u32x4){vb0.x, vb0.y, vb1.x, vb1.y});
                o0 = __builtin_amdgcn_mfma_f32_32x32x16_bf16(fa, pb, o0, 0, 0, 0);
                o1 = __builtin_amdgcn_mfma_f32_32x32x16_bf16(fb, pb, o1, 0, 0, 0);
            }
        }
        if (j + 1 < NT) AT_STORE(buf ^ 1);
        __syncthreads();
    }
#undef AT_LOAD
#undef AT_STORE
    l_run += __shfl_xor(l_run, 32);
    const float inv = 1.f / l_run;
    const int b = bh >> 3, h = bh & 7;
    bf16_t* orow = act_ptr(F, A_YSA) + ((size_t)b * SEQ + qb * 256 + wid * 32 + r32) * 512 + h * 64;
#pragma unroll
    for (int g = 0; g < 4; ++g) {
        u32x2 w0, w1;
        w0.x = cvt_pk_bf16(o0[4 * g] * inv, o0[4 * g + 1] * inv); w0.y = cvt_pk_bf16(o0[4 * g + 2] * inv, o0[4 * g + 3] * inv);
        w1.x = cvt_pk_bf16(o1[4 * g] * inv, o1[4 * g + 1] * inv); w1.y = cvt_pk_bf16(o1[4 * g + 2] * inv, o1[4 * g + 3] * inv);
        *(u32x2*)(orow + 8 * g + 4 * hi) = w0; *(u32x2*)(orow + 32 + 8 * g + 4 * hi) = w1;
    }
}

__device__ __forceinline__ float row16_sum(float x) {
    x += __int_as_float(__builtin_amdgcn_update_dpp(0, __float_as_int(x), 0x128, 0xf, 0xf, false));
    x += __int_as_float(__builtin_amdgcn_update_dpp(0, __float_as_int(x), 0x124, 0xf, 0xf, false));
    x += __int_as_float(__builtin_amdgcn_update_dpp(0, __float_as_int(x), 0x122, 0xf, 0xf, false));
    x += __int_as_float(__builtin_amdgcn_update_dpp(0, __float_as_int(x), 0x121, 0xf, 0xf, false));
    return x;
}
__device__ __forceinline__ unsigned short f2bf1(float x) { return (unsigned short)(cvt_pk_bf16(x, 0.f) & 0xffffu); }
__device__ __forceinline__ void gla_prep(Frame& F, int l, int unit) {
    bf16_t* gqkv = act_ptr(F, A_GQKV); const bf16_t* misc = act_ptr(F, A_MISC); float* eb = F.stats + SF_EB;
    const int c = F.tid & 255, ch = unit * 2 + (F.tid >> 8);
    const float* wg = F.in(I_WGLA) + (size_t)l * 16 * 256 + c; const float bias = F.in(I_BGLA)[l * 256 + c];
    float wcol[16];
#pragma unroll
    for (int r = 0; r < 16; ++r) wcol[r] = wg[r * 256];
    float bc = 0.f;
#pragma unroll 8
    for (int i = 0; i < 32; ++i) {
        const size_t t = (size_t)ch * 32 + i;
        const u32x4 l0 = *(const u32x4*)(misc + t * 256 + 32), l1 = *(const u32x4*)(misc + t * 256 + 40);
        const float lr[16] = {bflo(l0.x), bfhi(l0.x), bflo(l0.y), bfhi(l0.y), bflo(l0.z), bfhi(l0.z), bflo(l0.w), bfhi(l0.w),
                              bflo(l1.x), bfhi(l1.x), bflo(l1.y), bfhi(l1.y), bflo(l1.z), bfhi(l1.z), bflo(l1.w), bfhi(l1.w)};
        float z = bias;
#pragma unroll
        for (int r = 0; r < 16; ++r) z = fmaf(lr[r], wcol[r], z);
        const float zl = z * 1.4426950408889634f;
        const float sp = fmaxf(-zl, 0.f) + __log2f(1.f + __builtin_amdgcn_exp2f(-fabsf(zl)));
        bc -= sp * 0.0625f;
        const float eq = __builtin_amdgcn_exp2f(bc) * 0.125f, ek = __builtin_amdgcn_exp2f(-bc);
        bf16_t* qp = gqkv + t * 1024 + c; bf16_t* kp = qp + 256;
        *qp = f2bf1(__uint_as_float((unsigned)*qp << 16) * eq);
        *kp = f2bf1(__uint_as_float((unsigned)*kp << 16) * ek);
    }
    eb[(size_t)ch * 256 + c] = __builtin_amdgcn_exp2f(bc);
}
typedef short v4i16_t __attribute__((ext_vector_type(4)));
__device__ __forceinline__ v4i16_t lds_tr16(const LAS unsigned char* p) { return __builtin_amdgcn_ds_read_tr16_b64_v4i16((LAS v4i16_t*)p); }
constexpr int GW_K = 0, GW_Q = 4608, GW_V = 9216, GW_BYTES = 10240;
__device__ __forceinline__ void gla_unit(Frame& F, int l, int unit) {
    const int half = unit & 1, h = (unit >> 1) & 3, b = unit >> 3;
    volatile LAS int* prog = (volatile LAS int*)(F.lds + 4 * GW_BYTES);
    if (F.wave >= 4) {
        const int pw = F.wave - 4, tok = F.lane & 31, li = (F.lane >> 5) + 2 * (pw & 1);
        const size_t lo_ = (li == 0) ? (size_t)h * 128 : (li == 1) ? (size_t)512 + h * 128 : (li == 2) ? (size_t)1024 + h * 256 + half * 128 : (size_t)1024 + h * 256 + half * 128 + 64;
        const unsigned char* base_ = (const unsigned char*)act_ptr(F, A_GQKV) + lo_;
        unsigned keep = 0u;
        for (int m = (pw >> 1); m < SEQ / 32; m += 2) {
            while (m > prog[0] + 8) __builtin_amdgcn_s_sleep(8);
            const unsigned char* pp = base_ + ((size_t)b * SEQ + (size_t)m * 32 + tok) * 2048;
            asm volatile("global_load_dword %0, %1, off" : "+v"(keep) : "v"(pp) : "memory");
        }
        asm volatile("s_waitcnt vmcnt(0)" : "+v"(keep) :: "memory");
        return;
    }
    const int lane = F.lane, w = half * 4 + F.wave, l15 = lane & 15, q4 = lane >> 4;
    const bf16_t* gqkv = act_ptr(F, A_GQKV); const float* ebg = F.stats + SF_EB;
    bf16_t* ysb = act_ptr(F, A_YSB);
    LAS unsigned char* wl = F.lds + F.wave * GW_BYTES;
    f32x4 S[4];
#pragma unroll
    for (int i = 0; i < 4; ++i) S[i] = (f32x4){0.f, 0.f, 0.f, 0.f};
    if (F.tid == 0) prog[0] = 0;
    constexpr int GW2 = 4 * GW_BYTES;
    u32x4 kimgX[4], qimgX[4], vimgX, kimgY[4], qimgY[4], vimgY; f32x4 ebvX[4], ebvY[4];
#define GLA_LOAD1(n_, KI, QI, VI, EBV) do { const size_t tb_ = (size_t)b * SEQ + (size_t)(n_) * 32; \
        _Pragma("unroll") for (int i = 0; i < 4; ++i) { const int p_ = lane + 64 * i; const bf16_t* r_ = gqkv + (tb_ + (p_ >> 3)) * 1024 + h * 64 + (p_ & 7) * 8; QI[i] = *(const u32x4*)r_; KI[i] = *(const u32x4*)(r_ + 256); } \
        VI = *(const u32x4*)(gqkv + (tb_ + (lane >> 1)) * 1024 + 512 + h * 128 + 16 * w + (lane & 1) * 8); \
        _Pragma("unroll") for (int db = 0; db < 4; ++db) EBV[db] = *(const f32x4*)(ebg + (tb_ >> 5) * 256 + h * 64 + 16 * db + 4 * q4); } while (0)
#define GLA_LOAD(n_) do { GLA_LOAD1((n_), kimgX, qimgX, vimgX, ebvX); GLA_LOAD1((n_) + 1, kimgY, qimgY, vimgY, ebvY); } while (0)
    bf16x8 pa0X, pa1X, vbnX, kanX[4], qpxX[2], qpyX[2], pa0Y, pa1Y, vbnY, kanY[4], qpxY[2], qpyY[2]; f32x4 o0pX, o1pX, e4X[4], o0pY, o1pY, e4Y[4];
#define GLA_IMG(WL, KI, QI, VI, EBV, E4) do { \
        _Pragma("unroll") for (int i = 0; i < 4; ++i) { asm volatile("" : "+v"(KI[i]), "+v"(QI[i]), "+v"(EBV[i])); } \
        asm volatile("" : "+v"(VI)); \
        _Pragma("unroll") for (int i = 0; i < 4; ++i) { const int p_ = lane + 64 * i; *(LAS u32x4*)((WL) + GW_K + (p_ >> 3) * 144 + (p_ & 7) * 16) = KI[i]; *(LAS u32x4*)((WL) + GW_Q + (p_ >> 3) * 144 + (p_ & 7) * 16) = QI[i]; } \
        *(LAS u32x4*)((WL) + GW_V + (lane >> 1) * 32 + (lane & 1) * 16) = VI; \
        _Pragma("unroll") for (int db = 0; db < 4; ++db) E4[db] = EBV[db]; } while (0)
#define GLA_STAGE_P(WL, PA0, PA1, VBN, KAN, QPX, QPY, O0P, O1P) do { \
        f32x4 pt00 = {0.f, 0.f, 0.f, 0.f}, pt01 = pt00, pt11 = pt00; \
        _Pragma("unroll") for (int ks = 0; ks < 2; ++ks) { \
            const bf16x8 a0 = *(const LAS bf16x8*)((WL) + GW_K + l15 * 144 + ks * 64 + q4 * 16), a1 = *(const LAS bf16x8*)((WL) + GW_K + (16 + l15) * 144 + ks * 64 + q4 * 16); \
            const bf16x8 b0 = *(const LAS bf16x8*)((WL) + GW_Q + l15 * 144 + ks * 64 + q4 * 16), b1 = *(const LAS bf16x8*)((WL) + GW_Q + (16 + l15) * 144 + ks * 64 + q4 * 16); \
            pt00 = __builtin_amdgcn_mfma_f32_16x16x32_bf16(a0, b0, pt00, 0, 0, 0); \
            pt01 = __builtin_amdgcn_mfma_f32_16x16x32_bf16(a0, b1, pt01, 0, 0, 0); \
            pt11 = __builtin_amdgcn_mfma_f32_16x16x32_bf16(a1, b1, pt11, 0, 0, 0); \
            const LAS unsigned char* q0p = (WL) + GW_Q + l15 * 144 + ks * 64 + q4 * 8; const LAS unsigned char* q1p = q0p + 16 * 144; \
            const u32x2 x0 = *(const LAS u32x2*)(q0p), x1 = *(const LAS u32x2*)(q0p + 32), y0 = *(const LAS u32x2*)(q1p), y1 = *(const LAS u32x2*)(q1p + 32); \
            QPX[ks] = __builtin_bit_cast(bf16x8, (u32x4){x0.x, x0.y, x1.x, x1.y}); QPY[ks] = __builtin_bit_cast(bf16x8, (u32x4){y0.x, y0.y, y1.x, y1.y}); } \
        _Pragma("unroll") for (int r = 0; r < 4; ++r) { if (4 * q4 + r > l15) { pt00[r] = 0.f; pt11[r] = 0.f; } } \
        PA0 = __builtin_bit_cast(bf16x8, (u32x4){cvt_pk_bf16(pt00[0], pt00[1]), cvt_pk_bf16(pt00[2], pt00[3]), 0u, 0u}); \
        PA1 = __builtin_bit_cast(bf16x8, (u32x4){cvt_pk_bf16(pt01[0], pt01[1]), cvt_pk_bf16(pt01[2], pt01[3]), cvt_pk_bf16(pt11[0], pt11[1]), cvt_pk_bf16(pt11[2], pt11[3])}); \
        const LAS unsigned char* vt_ = (WL) + GW_V + (l15 >> 2) * 32 + (l15 & 3) * 8; \
        const v4i16_t vp0 = lds_tr16(vt_ + (4 * q4) * 32), vp1 = lds_tr16(vt_ + (16 + 4 * q4) * 32); \
        const v4i16_t vn0 = lds_tr16(vt_ + (8 * q4) * 32), vn1 = lds_tr16(vt_ + (8 * q4 + 4) * 32); \
        const bf16x8 vbp = (bf16x8){vp0[0], vp0[1], vp0[2], vp0[3], vp1[0], vp1[1], vp1[2], vp1[3]}; \
        VBN = (bf16x8){vn0[0], vn0[1], vn0[2], vn0[3], vn1[0], vn1[1], vn1[2], vn1[3]}; \
        _Pragma("unroll") for (int db = 0; db < 4; ++db) { \
            const LAS unsigned char* kt = (WL) + GW_K + (8 * q4 + (l15 >> 2)) * 144 + (16 * db + (l15 & 3) * 4) * 2; \
            const v4i16_t k0 = lds_tr16(kt), k1 = lds_tr16(kt + 4 * 144); \
            KAN[db] = (bf16x8){k0[0], k0[1], k0[2], k0[3], k1[0], k1[1], k1[2], k1[3]}; } \
        O0P = __builtin_amdgcn_mfma_f32_16x16x32_bf16(PA0, vbp, (f32x4){0.f, 0.f, 0.f, 0.f}, 0, 0, 0); \
        O1P = __builtin_amdgcn_mfma_f32_16x16x32_bf16(PA1, vbp, (f32x4){0.f, 0.f, 0.f, 0.f}, 0, 0, 0); \
    } while (0)
#define GLA_STAGE_S(T0, VBN, KAN, QPX, QPY, O0P, O1P, E4) do { \
        f32x4 o0 = O0P, o1 = O1P; \
        _Pragma("unroll") for (int ks = 0; ks < 2; ++ks) { \
            const bf16x8 sb = __builtin_bit_cast(bf16x8, (u32x4){cvt_pk_bf16(S[2 * ks][0], S[2 * ks][1]), cvt_pk_bf16(S[2 * ks][2], S[2 * ks][3]), cvt_pk_bf16(S[2 * ks + 1][0], S[2 * ks + 1][1]), cvt_pk_bf16(S[2 * ks + 1][2], S[2 * ks + 1][3])}); \
            o0 = __builtin_amdgcn_mfma_f32_16x16x32_bf16(QPX[ks], sb, o0, 0, 0, 0); \
            o1 = __builtin_amdgcn_mfma_f32_16x16x32_bf16(QPY[ks], sb, o1, 0, 0, 0); } \
        _Pragma("unroll") for (int db = 0; db < 4; ++db) { S[db] = __builtin_amdgcn_mfma_f32_16x16x32_bf16(KAN[db], VBN, S[db], 0, 0, 0); S[db] = S[db] * E4[db]; } \
        _Pragma("unroll") for (int r = 0; r < 4; ++r) { const size_t ta = (T0) + 4 * q4 + r, tb2 = ta + 16; \
            ysb[ta * 512 + h * 128 + 16 * w + l15] = f2bf1(o0[r]); ysb[tb2 * 512 + h * 128 + 16 * w + l15] = f2bf1(o1[r]); } \
    } while (0)
    LAS unsigned char* wl2 = F.lds + GW2 + 64 + F.wave * GW_BYTES;
    GLA_LOAD(0);
    for (int n = 0; n < SEQ / 32; n += 2) {
        const size_t t0 = (size_t)b * SEQ + (size_t)n * 32;
        if (F.tid == 0) prog[0] = n;
        GLA_IMG(wl, kimgX, qimgX, vimgX, ebvX, e4X);
        GLA_IMG(wl2, kimgY, qimgY, vimgY, ebvY, e4Y);
        { const int nn = (n + 2 < SEQ / 32) ? n + 2 : n; GLA_LOAD(nn); }
        GLA_STAGE_P(wl, pa0X, pa1X, vbnX, kanX, qpxX, qpyX, o0pX, o1pX);
        GLA_STAGE_P(wl2, pa0Y, pa1Y, vbnY, kanY, qpxY, qpyY, o0pY, o1pY);
        GLA_STAGE_S(t0, vbnX, kanX, qpxX, qpyX, o0pX, o1pX, e4X);
        GLA_STAGE_S(t0 + 32, vbnY, kanY, qpxY, qpyY, o0pY, o1pY, e4Y);
        asm volatile("s_waitcnt lgkmcnt(0)" ::: "memory");
    }
#undef GLA_LOAD1
#undef GLA_IMG
#undef GLA_STAGE_P
#undef GLA_STAGE_S
#undef GLA_LOAD
}
__device__ __forceinline__ void gla_finalize(Frame& F, int l) {
    bf16_t* ysb = act_ptr(F, A_YSB); const bf16_t* og = act_ptr(F, A_OG);
    const float* go = F.in(I_GGLAO) + l * 128;
    for (int i = F.vcu * 512 + F.tid; i < T * 64; i += F.G * 512) {
        const int t = i >> 6, c8 = i & 63, h = c8 >> 4, v0 = (c8 & 15) * 8;
        const u32x4 o = *(const u32x4*)(ysb + (size_t)t * 512 + c8 * 8), gte = *(const u32x4*)(og + (size_t)t * 512 + c8 * 8);
        const f32x4 g0 = *(const f32x4*)(go + v0), g1 = *(const f32x4*)(go + v0 + 4);
        const float ov[8] = {bflo(o.x), bfhi(o.x), bflo(o.y), bfhi(o.y), bflo(o.z), bfhi(o.z), bflo(o.w), bfhi(o.w)};
        const float ssq = row16_sum(((ov[0] * ov[0] + ov[1] * ov[1]) + (ov[2] * ov[2] + ov[3] * ov[3])) + ((ov[4] * ov[4] + ov[5] * ov[5]) + (ov[6] * ov[6] + ov[7] * ov[7])));
        const float r = rsqrtf(ssq * (1.f / 128.f) + EPS);
        const float gv[8] = {bflo(gte.x), bfhi(gte.x), bflo(gte.y), bfhi(gte.y), bflo(gte.z), bfhi(gte.z), bflo(gte.w), bfhi(gte.w)};
        float y[8];
#pragma unroll
        for (int e = 0; e < 8; ++e) y[e] = ov[e] * r * (e < 4 ? g0[e] : g1[e - 4]) * gv[e] * fast_sigmoid(gv[e]);
        u32x4 wv; wv.x = cvt_pk_bf16(y[0], y[1]); wv.y = cvt_pk_bf16(y[2], y[3]); wv.z = cvt_pk_bf16(y[4], y[5]); wv.w = cvt_pk_bf16(y[6], y[7]);
        *(u32x4*)(ysb + (size_t)t * 512 + c8 * 8) = wv;
    }
}

template <int W> __device__ __forceinline__ void pool_rows(const bf16_t* up, bf16_t* pooled, int t0, int s0, int c8) {
    u32x4 row[8 + W - 1];
#pragma unroll
    for (int i = 0; i < 8 + W - 1; ++i) {
        const int dt = i - (W - 1);
        const bool ok = (s0 + dt) >= 0;
        const u32x4 v = *(const u32x4*)(up + (size_t)(t0 + (ok ? dt : 0)) * 512 + c8 * 8);
        row[i] = ok ? v : (u32x4){0u, 0u, 0u, 0u};
    }
#pragma unroll
    for (int k = 0; k < 8; ++k) {
        float acc[8];
#pragma unroll
        for (int e = 0; e < 8; ++e) acc[e] = 0.f;
#pragma unroll
        for (int j = 0; j < W; ++j) { const u32x4 v = row[k + W - 1 - j];
            acc[0] += bflo(v.x); acc[1] += bfhi(v.x); acc[2] += bflo(v.y); acc[3] += bfhi(v.y); acc[4] += bflo(v.z); acc[5] += bfhi(v.z); acc[6] += bflo(v.w); acc[7] += bfhi(v.w); }
        const int sk = s0 + k, n = (sk + 1 < W) ? sk + 1 : W;
        const float rn = 1.f / (float)n; const u32x4 self = row[k + W - 1];
        u32x4 o; o.x = cvt_pk_bf16(acc[0] * rn - bflo(self.x), acc[1] * rn - bfhi(self.x)); o.y = cvt_pk_bf16(acc[2] * rn - bflo(self.y), acc[3] * rn - bfhi(self.y));
        o.z = cvt_pk_bf16(acc[4] * rn - bflo(self.z), acc[5] * rn - bfhi(self.z)); o.w = cvt_pk_bf16(acc[6] * rn - bflo(self.w), acc[7] * rn - bfhi(self.w));
        *(u32x4*)(pooled + (size_t)(t0 + k) * 512 + c8 * 8) = o;
    }
}
__device__ __forceinline__ void pool_unit(Frame& F, int unit) {
    const bf16_t* up = act_ptr(F, A_UP); bf16_t* pooled = act_ptr(F, A_POOLED);
    const int g = F.wave & 3, c8 = g * 16 + (F.lane & 15), tb = (F.lane >> 4) + 4 * (F.wave >> 2);
    const int t0 = unit * 64 + tb * 8, s0 = t0 % SEQ;
    if (g == 0) pool_rows<2>(up, pooled, t0, s0, c8);
    else if (g == 1) pool_rows<4>(up, pooled, t0, s0, c8);
    else if (g == 2) pool_rows<8>(up, pooled, t0, s0, c8);
    else pool_rows<16>(up, pooled, t0, s0, c8);
}

__device__ __forceinline__ void phase_mix(Frame& F, int lq, int bx) {
    const int l = lq & 1;
#ifndef REP_DMASK
#define REP_DMASK 7
#endif
    const int dm = (lq >= 2) ? (REP_DMASK) : 7;
    if (bx < 32 && (dm & 1)) gla_unit(F, l, bx);
    unsigned* head = F.ctl + CW_QUEUE + 64 * lq;
    for (;;) {
        if (F.tid == 0) F.MISC[16] = __hip_atomic_fetch_add(head, 1u, RLX_AGENT);
        __syncthreads();
        const int idx = (int)F.MISC[16];
        __syncthreads();
        if (idx >= 512 + 256) break;
        if (idx < 512) { if (dm & 2) attn_unit(F, idx & 31, 15 - (idx >> 5)); }
        else { if (dm & 4) pool_unit(F, idx - 512); }
    }
    if (bx >= 32 && lq < 2) {
        LAS float* scr = (LAS float*)(F.lds + F.wave * 16384);
        const int gw = (bx - 32) * 8 + F.wave, NGW = (F.G - 32) * 8;
        if (l == 0) { CONV_LOOP(15, mixer_seg(F, 1, si_)); fold_pool(F, 1, gw, NGW); CONV_LOOP(3, ffn_seg(F, si_)); }
        else { CONV_LOOP(12, moe_seg(F, (si_ >> 1) * 3 + (si_ & 1))); }
    }
}

__device__ __forceinline__ void phase_route1(Frame& F) {
    const bf16_t* x = (const bf16_t*)(F.ws + WS_XB); const float* rss = F.stats + SF_ROWSS + (size_t)3 * T * 16; const float* gf = F.in(I_GFFN) + D; const float* wr = F.in(I_WROUTER);
    unsigned* route = (unsigned*)(F.ws + WS_SLOT + SL_ROUTE); unsigned* wgcnt = F.ctl + CW_WGCNT;
    LAS float* lsel = (LAS float*)(F.lds);
    LAS int* lpos = (LAS int*)(F.lds + 2048);
    for (int unit = F.vcu; unit < T / 64; unit += F.G) {
        for (int k = 0; k < 8; ++k) {
            const int tok = F.wave * 8 + k, t = unit * 64 + tok;
            float lg[8];
#pragma unroll
            for (int e = 0; e < 8; ++e) lg[e] = 0.f;
#pragma unroll
            for (int j = 0; j < 2; ++j) {
                const int c = 8 * F.lane + 512 * j;
                const u32x4 xr = *(const u32x4*)(x + (size_t)t * D + c);
                const f32x4 ga = *(const f32x4*)(gf + c), gb = *(const f32x4*)(gf + c + 4);
                const float xv[8] = {bflo(xr.x) * ga[0], bfhi(xr.x) * ga[1], bflo(xr.y) * ga[2], bfhi(xr.y) * ga[3], bflo(xr.z) * gb[0], bfhi(xr.z) * gb[1], bflo(xr.w) * gb[2], bfhi(xr.w) * gb[3]};
#pragma unroll
                for (int q = 0; q < 8; ++q) {
                    const float xg = xv[q];
                    const f32x4 w0 = *(const f32x4*)(wr + (size_t)(c + q) * 8), w1 = *(const f32x4*)(wr + (size_t)(c + q) * 8 + 4);
                    lg[0] = fmaf(xg, w0[0], lg[0]); lg[1] = fmaf(xg, w0[1], lg[1]); lg[2] = fmaf(xg, w0[2], lg[2]); lg[3] = fmaf(xg, w0[3], lg[3]);
                    lg[4] = fmaf(xg, w1[0], lg[4]); lg[5] = fmaf(xg, w1[1], lg[5]); lg[6] = fmaf(xg, w1[2], lg[6]); lg[7] = fmaf(xg, w1[3], lg[7]);
                }
            }
            const float rs = rsqrtf(sum16(rss + (size_t)t * 16) * (1.f / 1024.f) + EPS);
#pragma unroll
            for (int e = 0; e < 8; ++e) lg[e] = wave_sum(lg[e]) * rs;
            int i1 = 0; float v1 = lg[0];
#pragma unroll
            for (int e = 1; e < 8; ++e) if (lg[e] > v1) { v1 = lg[e]; i1 = e; }
            int i2 = -1; float v2 = -INFINITY;
#pragma unroll
            for (int e = 0; e < 8; ++e) if (e != i1 && lg[e] > v2) { v2 = lg[e]; i2 = e; }
            const float e2 = __expf(v2 - v1), w1 = 1.f / (1.f + e2), w2 = e2 / (1.f + e2);
            if (F.lane == 0) { lsel[tok * 4 + 0] = __int_as_float(i1); lsel[tok * 4 + 1] = __int_as_float(i2); lsel[tok * 4 + 2] = w1; lsel[tok * 4 + 3] = w2; }
        }
        __syncthreads();
        if (F.tid < 8) {
            int cnt = 0;
            for (int tok = 0; tok < 64; ++tok) {
                const int e1 = __float_as_int(lsel[tok * 4 + 0]), e2 = __float_as_int(lsel[tok * 4 + 1]);
                if (e1 == F.tid) { lpos[tok * 2 + 0] = cnt; ++cnt; }
                if (e2 == F.tid) { lpos[tok * 2 + 1] = cnt; ++cnt; }
            }
            wgcnt[unit * 8 + F.tid] = (unsigned)cnt;
        }
        __syncthreads();
        if (F.tid < 64) {
            const int t = unit * 64 + F.tid;
            u32x4 a, b2;
            a.x = (unsigned)__float_as_int(lsel[F.tid * 4 + 0]); a.y = (unsigned)__float_as_int(lsel[F.tid * 4 + 1]); a.z = __float_as_uint(lsel[F.tid * 4 + 2]); a.w = __float_as_uint(lsel[F.tid * 4 + 3]);
            b2.x = (unsigned)lpos[F.tid * 2 + 0]; b2.y = (unsigned)lpos[F.tid * 2 + 1]; b2.z = 0u; b2.w = 0u;
            *(u32x4*)(route + (size_t)t * 8) = a; *(u32x4*)(route + (size_t)t * 8 + 4) = b2;
        }
        __syncthreads();
    }
}
__device__ __forceinline__ void moe_geometry(Frame& F, int unit, LAS int* geo) {
    const unsigned* wgcnt = F.ctl + CW_WGCNT;
    if (F.tid < 8) {
        int tot = 0, pre = 0;
        for (int c = 0; c < 256; ++c) { const int v = (int)wgcnt[c * 8 + F.tid]; if (c < unit) pre += v; tot += v; }
        geo[9 + F.tid] = tot; geo[17 + F.tid] = pre;
    }
    __syncthreads();
    if (F.tid == 0) { int acc = 0; for (int e = 0; e < 8; ++e) { geo[e] = acc; acc += (geo[9 + e] + 255) >> 8; } geo[8] = acc; }
    __syncthreads();
}
__device__ __forceinline__ void phase_route2(Frame& F) {
    const unsigned* route = (const unsigned*)(F.ws + WS_SLOT + SL_ROUTE);
    int* slot_tok = (int*)(F.ws + WS_SLOT + SL_TOK); float* slot_scale = (float*)(F.ws + WS_SLOT + SL_SCALE); float* slot_comb = (float*)(F.ws + WS_SLOT + SL_COMB);
    const float* rss = F.stats + SF_ROWSS + (size_t)3 * T * 16;
    const bf16_t* xb = (const bf16_t*)(F.ws + WS_XB); bf16_t* xg = act_ptr(F, A_XG);
    LAS int* geo = (LAS int*)(F.lds);
    for (int unit = F.vcu; unit < T / 64; unit += F.G) {
        moe_geometry(F, unit, geo);
        for (int k = 0; k < 16; ++k) {
            const int rix = F.wave * 16 + k, tok = rix >> 1, ch = rix & 1, t = unit * 64 + tok;
            const unsigned e = route[(size_t)t * 8 + ch], pos = route[(size_t)t * 8 + 4 + ch];
            const float w = __uint_as_float(route[(size_t)t * 8 + 2 + ch]);
            const int slot = geo[e] * 256 + geo[17 + e] + (int)pos;
            const u32x4* src = (const u32x4*)(xb + (size_t)t * D); u32x4* dst = (u32x4*)(xg + (size_t)slot * D);
            dst[F.lane] = src[F.lane]; dst[64 + F.lane] = src[64 + F.lane];
            if (F.lane == 0) { ((int*)(F.ws + WS_TSLOT))[t * 2 + ch] = slot; slot_tok[slot] = t; slot_scale[slot] = rsqrtf(sum16(rss + (size_t)t * 16) * (1.f / 1024.f) + EPS); slot_comb[slot] = w; }
        }
        if (unit == 0) {
            for (int e = 0; e < 8; ++e) { const int s0 = geo[e] * 256 + geo[9 + e], s1 = geo[e + 1] * 256;
                for (int s = s0 + F.tid; s < s1; s += 512) { slot_tok[s] = -1; slot_scale[s] = 0.f; slot_comb[s] = 0.f; } }
        }
        __syncthreads();
    }
}

struct Args { const void* in[25]; float* out; unsigned char* ws; int ph_lo, ph_hi, li, pad; };
constexpr int NPHASE = 22;
#ifndef PH_MASK
#define PH_MASK 0xFFF
#endif
#define PON(b) (((PH_MASK) >> (b)) & 1)

__global__ void __launch_bounds__(512, 2) mega_fwd(Args args) {
    extern __shared__ __attribute__((aligned(16))) unsigned char lds_raw[];
    Frame F;
    F.lds = (LAS unsigned char*)lds_raw;
    F.MISC = (volatile LAS unsigned*)(F.lds + MISC_OFF);
    F.tid = threadIdx.x; F.lane = F.tid & 63; F.wave = __builtin_amdgcn_readfirstlane(F.tid >> 6);
    F.G = gridDim.x; { const int bx = blockIdx.x; F.vcu = (F.G % 8 == 0) ? (bx % 8) * (F.G / 8) + bx / 8 : bx; }
    { const CAS Args* ap0 = (const CAS Args*)__builtin_amdgcn_kernarg_segment_ptr(); F.ws = ap0->ws; F.ctl = (unsigned*)(F.ws + WS_CTL); F.ctlf = (float*)(F.ws + WS_CTL); F.stats = (float*)(F.ws + WS_STATS); }
    F.inp = nullptr; F.out = nullptr;
    for (int u = F.tid; u < (LDS_BYTES - LDSCTL_OFF) / 4; u += 512) ((LAS unsigned*)(F.lds + LDSCTL_OFF))[u] = 0u;
    __syncthreads();
    XcdBarrier bar = xcd_barrier_post(F.ctl + CW_BAR + args.li * XCD_BAR_WORDS, F.MISC + 8);
    const int lo = args.ph_lo, hi = args.ph_hi;
    const int cblk0 = (int)blockIdx.x, wave0 = F.wave, vcu0 = F.vcu, G0 = F.G;
#ifndef REP_MASK
#define REP_MASK 0
#endif
#pragma unroll 1
    for (int ph2 = 2 * lo; ph2 < 2 * hi; ++ph2) {
        const int ph = ph2 >> 1, rpt = ph2 & 1;
        if (rpt && !((REP_MASK >> ph) & 1)) continue;
        int cblk = cblk0; { int wv_ = wave0, vc_ = vcu0, g_ = G0; asm volatile("" : "+s"(wv_), "+s"(vc_), "+s"(g_), "+s"(cblk)); F.wave = wv_; F.vcu = vc_; F.G = g_; }
        { int ln_; asm volatile("v_mbcnt_lo_u32_b32 %0, -1, 0\n\tv_mbcnt_hi_u32_b32 %0, -1, %0" : "=v"(ln_)); F.lane = ln_; F.tid = F.wave * 64 + ln_; }
        { const CAS Args* ap = (const CAS Args*)__builtin_amdgcn_kernarg_segment_ptr(); asm volatile("" : "+s"(ap)); F.inp = ap->in; F.out = ap->out; unsigned char* w_ = ap->ws; F.ws = w_; F.ctl = (unsigned*)(w_ + WS_CTL); F.ctlf = (float*)(w_ + WS_CTL); F.stats = (float*)(w_ + WS_STATS); }
        const int l = ph >= 10 ? 1 : 0, q = ph == 0 ? -1 : (l ? ph - 10 : ph - 1);
        unsigned char* wb = wblk(F, l);
        float* ssq = F.stats + SF_SSQ + (size_t)l * 2 * T * 4;
        const float* rss_in = F.stats + SF_ROWSS + (size_t)(l == 0 ? 0 : 2) * T * 16;
        float* rss_mid = F.stats + SF_ROWSS + (size_t)(l == 0 ? 1 : 3) * T * 16;
        if (q == -1) {
            if (PON(11)) p0_prologue(F);
        } else if (q == 0 && PON(0)) {
            pg8::SchedGrid S{(const char*)(F.ws + WS_XB), (const char*)(wb + WO_IN), (size_t)256 * 1024 * 2, (size_t)256 * 1024 * 2, 0, 64, 11, F.G, cblk, 1 << 30};
            { pg8::Unit u0; if (S.next(0, u0)) fill_rs(F, rss_in, u0.pm); }
            pg8::EpiProj E{act_ptr(F, A_CQKV), act_ptr(F, A_GQKV), act_ptr(F, A_OG), act_ptr(F, A_UP), act_ptr(F, A_MISC), (const LAS float*)(F.lds + RS_OFF), ssq};
            pg8::gemm_phase<pg8::EpiProj, pg8::SchedGrid, true, true>(F.lds, F.wave, 1024, 1024, S, E);
        } else if (q == 1 && PON(1)) {
            pg8::SchedGrid S{(const char*)act_ptr(F, A_CQKV), (const char*)(wb + WO_UP), (size_t)256 * 512 * 2, (size_t)256 * 256 * 2, (size_t)256 * 2, 64, 7, F.G, cblk, 3};
            pg8::EpiUp E{act_ptr(F, A_QKVRAW), ssq};
            pg8::gemm_phase<pg8::EpiUp, pg8::SchedGrid, true, true>(F.lds, F.wave, 512, 256, S, E);
        } else if (q == 2 && PON(2)) {
            phase_prep(F, l, rpt);
        } else if (q == 3 && PON(3)) {
            phase_mix(F, l + 2 * rpt, cblk);
        } else if (q == 4 && PON(4)) {
            pg8::SchedGrid S{(const char*)(F.ws + WS_XB), (const char*)(wb + WO_G), (size_t)256 * 1024 * 2, (size_t)256 * 1024 * 2, 0, 64, 12, F.G, cblk, 1 << 30};
            { pg8::Unit u0; if (S.next(0, u0)) fill_rs(F, rss_in, u0.pm); }
            pg8::EpiGate E{F.ws + WS_ACTS, (const LAS float*)(F.lds + RS_OFF)};
            pg8::gemm_phase<pg8::EpiGate, pg8::SchedGrid, true, true>(F.lds, F.wave, 1024, 1024, S, E);
            if (!rpt) gla_finalize(F, l);
        } else if (q == 5 && PON(5)) {
            pg8::SchedMerge S{(const char*)(F.ws + WS_ACTS), (const char*)(wb + WO_BR), F.G, cblk};
            pg8::EpiMerge E{F.ws + WS_ACTS, act_ptr(F, A_MERGED)};
            pg8::gemm_phase<pg8::EpiMerge, pg8::SchedMerge, true, true>(F.lds, F.wave, 512, 512, S, E);
        } else if (q == 6 && PON(6)) {
            pg8::SchedGrid S{(const char*)act_ptr(F, A_MERGED), (const char*)(wb + WO_OUT), (size_t)256 * 1024 * 2, (size_t)256 * 1024 * 2, 0, 64, 4, F.G, cblk, 1 << 30, MERGED_HI_DELTA};
            pg8::EpiResid E{(bf16_t*)(F.ws + WS_XB), rss_mid};
            pg8::gemm_phase<pg8::EpiResid, pg8::SchedGrid, true, true>(F.lds, F.wave, 1024, 1024, S, E);
        } else if (l == 0 && q == 7 && PON(7)) {
            pg8::SchedGrid S{(const char*)(F.ws + WS_XB), (const char*)(wb + WO_FGU), (size_t)256 * 1024 * 2, (size_t)256 * 1024 * 2, 0, 64, 22, F.G, cblk, 1 << 30};
            if (F.G == 256) S.split_from = 1280;
            { pg8::Unit u0; if (S.next(0, u0)) fill_rs(F, rss_mid, u0.pm); }
            pg8::EpiSwiglu<false> E{act_ptr(F, A_ACT), DFF, (const LAS float*)(F.lds + RS_OFF), nullptr, nullptr};
            pg8::gemm_phase<pg8::EpiSwiglu<false>, pg8::SchedGrid, true, true>(F.lds, F.wave, 1024, 1024, S, E);
        } else if (l == 0 && q == 8 && PON(8)) {
            pg8::SchedGrid S{(const char*)act_ptr(F, A_ACT), (const char*)(wb + WO_FD), (size_t)256 * DFF * 2, (size_t)256 * DFF * 2, 0, 64, 4, F.G, cblk, 1 << 30};
            pg8::EpiResid E{(bf16_t*)(F.ws + WS_XB), F.stats + SF_ROWSS + (size_t)2 * T * 16};
            pg8::gemm_phase<pg8::EpiResid, pg8::SchedGrid, true, true>(F.lds, F.wave, DFF, DFF, S, E);
        } else if (q == 7 && PON(9)) {
            phase_route1(F);
            __syncthreads();
            LAS float* scr = (LAS float*)(F.lds + F.wave * 16384);
            const int gw = F.vcu * 8 + F.wave, NGW = F.G * 8;
            CONV_LOOP(12, moe_seg(F, (si_ < 4) ? (6 + (si_ >> 1)) * 3 + (si_ & 1) : (si_ - 4) * 3 + 2));
        } else if (q == 8 && PON(9)) {
            phase_route2(F);
        } else if (q == 9 && PON(10)) {
            unsigned char* wm = F.ws + WS_W0;
            LAS int* geo = (LAS int*)(F.lds + RING_BYTES + 512);
            moe_geometry(F, 0, geo);
            pg8::SchedMoe S; S.A = (const char*)act_ptr(F, A_XG); S.B = (const char*)(wm + WO_MGU); S.a_tile = (size_t)256 * 1024 * 2; S.b_tile = (size_t)256 * 1024 * 2; S.b_exp = (size_t)2816 * 1024 * 2;
            S.nN = 11; S.G = F.G; S.c = cblk;
            S.t1 = __builtin_amdgcn_readfirstlane(geo[1]); S.t2 = __builtin_amdgcn_readfirstlane(geo[2]); S.t3 = __builtin_amdgcn_readfirstlane(geo[3]); S.t4 = __builtin_amdgcn_readfirstlane(geo[4]);
            S.t5 = __builtin_amdgcn_readfirstlane(geo[5]); S.t6 = __builtin_amdgcn_readfirstlane(geo[6]); S.t7 = __builtin_amdgcn_readfirstlane(geo[7]); S.MT = __builtin_amdgcn_readfirstlane(geo[8]);
            pg8::EpiSwiglu<true> E{act_ptr(F, A_ACTE), DEXP, (const LAS float*)nullptr, (const float*)(F.ws + WS_SLOT + SL_SCALE), (const float*)(F.ws + WS_SLOT + SL_COMB)};
            pg8::gemm_phase<pg8::EpiSwiglu<true>, pg8::SchedMoe, true, true>(F.lds, F.wave, 1024, 1024, S, E);
        } else if (q == 10 && PON(10)) {
            unsigned char* wm = F.ws + WS_W0;
            LAS int* geo = (LAS int*)(F.lds + RING_BYTES + 512);
            moe_geometry(F, 0, geo);
            pg8::SchedMoe S; S.A = (const char*)act_ptr(F, A_ACTE); S.B = (const char*)(wm + WO_MD); S.a_tile = (size_t)256 * DEXP * 2; S.b_tile = (size_t)256 * DEXP * 2; S.b_exp = (size_t)1024 * DEXP * 2;
            S.nN = 4; S.G = F.G; S.c = cblk;
            S.t1 = __builtin_amdgcn_readfirstlane(geo[1]); S.t2 = __builtin_amdgcn_readfirstlane(geo[2]); S.t3 = __builtin_amdgcn_readfirstlane(geo[3]); S.t4 = __builtin_amdgcn_readfirstlane(geo[4]);
            S.t5 = __builtin_amdgcn_readfirstlane(geo[5]); S.t6 = __builtin_amdgcn_readfirstlane(geo[6]); S.t7 = __builtin_amdgcn_readfirstlane(geo[7]); S.MT = __builtin_amdgcn_readfirstlane(geo[8]);
            pg8::EpiMoeDown E{act_ptr(F, A_Y)};
            pg8::gemm_phase<pg8::EpiMoeDown, pg8::SchedMoe, true, true>(F.lds, F.wave, DEXP, DEXP, S, E);
        }
        else if (q == 11) {
            const int* tslot = (const int*)(F.ws + WS_TSLOT); const bf16_t* y = act_ptr(F, A_Y);
            for (int t = F.vcu * 8 + F.wave; t < T; t += F.G * 8) {
                const int s0 = tslot[t * 2], s1 = tslot[t * 2 + 1];
                f32x4* xo = (f32x4*)(F.out + (size_t)t * D) + F.lane * 2;
                const bf16_t* xbr = (const bf16_t*)(F.ws + WS_XB) + (size_t)t * D;
#pragma unroll
                for (int j = 0; j < 2; ++j) {
                    const u32x4 a = *((const u32x4*)(y + (size_t)s0 * D) + 64 * j + F.lane), bq = *((const u32x4*)(y + (size_t)s1 * D) + 64 * j + F.lane);
                    const u32x4 xv = *((const u32x4*)xbr + 64 * j + F.lane);
                    f32x4 x0 = {bflo(xv.x), bfhi(xv.x), bflo(xv.y), bfhi(xv.y)}, x1 = {bflo(xv.z), bfhi(xv.z), bflo(xv.w), bfhi(xv.w)};
                    x0[0] += bflo(a.x) + bflo(bq.x); x0[1] += bfhi(a.x) + bfhi(bq.x); x0[2] += bflo(a.y) + bflo(bq.y); x0[3] += bfhi(a.y) + bfhi(bq.y);
                    x1[0] += bflo(a.z) + bflo(bq.z); x1[1] += bfhi(a.z) + bfhi(bq.z); x1[2] += bflo(a.w) + bflo(bq.w); x1[3] += bfhi(a.w) + bfhi(bq.w);
                    xo[128 * j] = x0; xo[128 * j + 1] = x1;
                }
            }
        }
        if (ph + 1 < hi || (!rpt && ((REP_MASK >> ph) & 1))) xcd_barrier(bar);
    }
}


#ifdef DBG_PH
__global__ void dbg_dump(const unsigned char* ws, float* out) {
    const size_t i = (size_t)blockIdx.x * 256 + threadIdx.x;
    float v = 0.f;
    const bf16_t* a0 = (const bf16_t*)(ws + WS_ACTS + DBG_A0); const bf16_t* a1 = (const bf16_t*)(ws + WS_ACTS + DBG_A1);
    if (i < (size_t)DBG_N0) v += __uint_as_float((unsigned)a0[i] << 16);
    if (i < (size_t)DBG_N1) v += 3.f * __uint_as_float((unsigned)a1[i] << 16);
    out[i] = v;
}
#endif

extern "C" void kernel_launch(void* const* d_in, const int* in_sizes, int n_in, void* d_out, int out_size, void* d_ws, size_t ws_size, hipStream_t stream) {
    static int grid = 0;
    if (grid == 0) {
        if (n_in != 25 || out_size != T * D || ws_size < WS_END) { fprintf(stderr, "kernel_launch: unexpected sizes (n_in %d out %d ws %zu)\n", n_in, out_size, ws_size); grid = -1; return; }
        int dev = 0, cus = 0;
        if (hipGetDevice(&dev) != hipSuccess || hipDeviceGetAttribute(&cus, hipDeviceAttributeMultiprocessorCount, dev) != hipSuccess) { grid = -1; return; }
        if (hipFuncSetAttribute((const void*)mega_fwd, hipFuncAttributeMaxDynamicSharedMemorySize, LDS_BYTES) != hipSuccess) { grid = -1; return; }
        int per_cu = 0;
        (void)hipOccupancyMaxActiveBlocksPerMultiprocessor(&per_cu, (const void*)mega_fwd, 512, LDS_BYTES);
        (void)hipGetLastError();
        grid = cus;
    }
    if (grid < 0) return;
    (void)hipMemsetAsync((char*)d_ws + WS_CTL, 0, CTL_BYTES, stream);
    Args a{};
    for (int i = 0; i < 25; ++i) a.in[i] = d_in[i];
    a.out = (float*)d_out; a.ws = (unsigned char*)d_ws; a.ph_lo = 0; a.ph_hi = NPHASE; a.li = 0; a.pad = 0;
#ifdef DBG_PH
    a.ph_hi = DBG_PH;
#endif
    void* kargs[] = {&a};
    hipError_t e = hipLaunchCooperativeKernel((const void*)mega_fwd, dim3(grid), dim3(512), kargs, LDS_BYTES, stream);
    if (e != hipSuccess) fprintf(stderr, "cooperative launch failed: %s (grid %d)\n", hipGetErrorString(e), grid);
#ifdef DBG_PH
    hipLaunchKernelGGL(dbg_dump, dim3(T * 1024 / 256), dim3(256), 0, stream, (const unsigned char*)d_ws, (float*)d_out);
#endif
}
```

```cpp
#include <hip/hip_runtime.h>
#include <cstdint>
#include <cstdio>

#define LAS __attribute__((address_space(3)))
#define CAS __attribute__((address_space(4)))
typedef const void* GPtr;
typedef unsigned short bf16_t;
typedef short bf16x8 __attribute__((ext_vector_type(8)));
typedef float f32x4 __attribute__((ext_vector_type(4)));
typedef float f32x16 __attribute__((ext_vector_type(16)));
typedef unsigned u32x4 __attribute__((ext_vector_type(4)));
typedef unsigned u32x2 __attribute__((ext_vector_type(2)));

constexpr int T = 16384, SEQ = 4096, NB = 4, D = 1024, DIN = 5680, DFF = 2816, DEXP = 1408, NEXP = 8;
constexpr int NPROJ = 2816;
constexpr float EPS = 1e-6f;
constexpr int MAXSLOT = 34816;

constexpr size_t MiB = 1u << 20;
constexpr size_t WS_CTL = 0, CTL_BYTES = 128 * 1024;
constexpr size_t WS_SLOT = 2 * MiB;
constexpr size_t WS_ROPE = 3 * MiB;
constexpr size_t WS_XB = 5 * MiB;
constexpr size_t WS_W1 = 37 * MiB;
constexpr size_t WS_W0 = 55 * MiB;
constexpr size_t WS_ACTS = 89 * MiB;
constexpr size_t WS_STATS = 283 * MiB;
constexpr size_t WS_END = 291 * MiB;
constexpr size_t WO_IN = 0, WO_G = 5632 * 1024, WO_UP = WO_G + 6 * MiB, WO_BR = WO_UP + 1792 * 256 * 2, WO_OUT = WO_BR + 3 * MiB, WO_FGU = WO_OUT + 2 * MiB, WO_FD = WO_FGU + 11 * MiB;
constexpr size_t WO_MGU = 0, WO_MD = 44 * MiB;
constexpr size_t A_OG = 0, A_GQKV = 16 * MiB, A_UP = 48 * MiB, A_MISC = 64 * MiB, A_CQKV = 72 * MiB, A_VT = 72 * MiB, A_QKVRAW = 88 * MiB;
constexpr size_t A_YSA = 96 * MiB, A_POOLED = 112 * MiB, A_YSB = 128 * MiB, A_QH = 144 * MiB, A_KH = 168 * MiB;
constexpr size_t A_G0 = 16 * MiB, A_G1 = 48 * MiB, A_G2 = 144 * MiB, A_ACT = 0;
constexpr size_t A_MERGED = 0;
constexpr long long MERGED_HI_DELTA = (long long)(64 * MiB);
constexpr size_t A_XG = 32 * MiB, A_ACTE = 100 * MiB, A_Y = 32 * MiB;
constexpr int CW_TMO = 0, CW_BAR = 4096, CW_QUEUE = 16384, CW_WGCNT = 20480;
static_assert((size_t)(CW_WGCNT + 2048) * 4 <= CTL_BYTES, "ctl");
constexpr size_t SF_SSQ = 0;
constexpr size_t SF_ROWSS = (size_t)2 * 2 * T * 4;
constexpr size_t SF_OSS = SF_ROWSS + (size_t)4 * T * 16;
constexpr size_t SF_EB = SF_OSS + (size_t)T * 32;
static_assert((SF_EB + (size_t)(T / 32) * 256) * 4 <= 8 * MiB, "stats");
constexpr size_t SL_TOK = 0, SL_SCALE = 139264, SL_COMB = 2 * 139264, SL_ROUTE = 3 * 139264;
constexpr size_t WS_TSLOT = 1 * MiB;

constexpr int RING_BYTES = 131072, LDSCTL_OFF = RING_BYTES, MISC_OFF = LDSCTL_OFF + 320, LDS_BYTES = 147456;
constexpr int RS_OFF = RING_BYTES + 1024;

#define LDS_WAIT() asm volatile("s_waitcnt lgkmcnt(0)" ::: "memory")
#define VM_WAIT() asm volatile("s_waitcnt vmcnt(0)" ::: "memory")
#define LDS_BARRIER() do { asm volatile("s_waitcnt lgkmcnt(0)" ::: "memory"); __builtin_amdgcn_s_barrier(); asm volatile("" ::: "memory"); } while (0)
#define RLX_AGENT __ATOMIC_RELAXED, __HIP_MEMORY_SCOPE_AGENT
typedef float f32x2_t __attribute__((ext_vector_type(2))); typedef __bf16 bf16x2_t __attribute__((ext_vector_type(2)));
__device__ __forceinline__ unsigned cvt_pk_bf16(float lo, float hi) { f32x2_t v = {lo, hi}; bf16x2_t b = __builtin_convertvector(v, bf16x2_t); return __builtin_bit_cast(unsigned, b); }
__device__ __forceinline__ float bflo(unsigned u) { return __uint_as_float(u << 16); }
__device__ __forceinline__ float bfhi(unsigned u) { return __uint_as_float(u & 0xffff0000u); }
__device__ __forceinline__ float wave_sum(float v) {
#pragma unroll
    for (int o = 1; o < 64; o <<= 1) v += __shfl_xor(v, o);
    return v;
}
__device__ __forceinline__ float sum16(const float* p) { const f32x4 a = *(const f32x4*)p, b = *(const f32x4*)(p + 4), c = *(const f32x4*)(p + 8), d = *(const f32x4*)(p + 12);
    return (((a[0] + a[1]) + (a[2] + a[3])) + ((b[0] + b[1]) + (b[2] + b[3]))) + (((c[0] + c[1]) + (c[2] + c[3])) + ((d[0] + d[1]) + (d[2] + d[3]))); }
__device__ __forceinline__ float sum4(const float* p) { const f32x4 a = *(const f32x4*)p; return (a[0] + a[1]) + (a[2] + a[3]); }
__device__ __forceinline__ float fast_sigmoid(float z) { return __builtin_amdgcn_rcpf(1.f + __builtin_amdgcn_exp2f(-1.4426950408889634f * z)); }

namespace pg8 {
constexpr int BM = 256, BK = 64, HALF = 128, HTB = HALF * BK * 2, STAGE_BYTES = 8 * HTB, NXCD = 8, WGM = 8;
__host__ __device__ __forceinline__ int lds_byte(int r, int c) { const int st = (r >> 4) * 2 + (c >> 5), rr = r & 15, cc = c & 31, ob = rr * 64 + cc * 2; return st * 1024 + (ob ^ (((ob >> 9) & 1) << 5)); }
__host__ __device__ __forceinline__ void stage_rc(int b, int& R, int& C) { const int st = b / 1024, sb = b % 1024, swz = sb ^ (((sb >> 9) & 1) << 5); R = (st >> 1) * 16 + swz / 64; C = (st & 1) * 32 + (swz % 64) / 2; }
__host__ __device__ __forceinline__ int perm32(int rho) { const int n = rho >> 4, i = rho & 15; return 8 * (i >> 2) + 4 * n + (i & 3); }

struct Unit { const char* a; const char* b; int pm, pn, kind, half; };
__device__ __forceinline__ void tile_map(int L, int nM, int nN, int& pm, int& pn) {
    const int nwg = nM * nN; int wgid = L;
    { const int q = nwg / NXCD, r = nwg % NXCD, xcd = wgid % NXCD, off = wgid / NXCD; wgid = (xcd < r ? xcd * (q + 1) : r * (q + 1) + (xcd - r) * q) + off; }
    const int nig = WGM * nN, gid = wgid / nig, fm = gid * WGM, gsz = (nM - fm) < WGM ? (nM - fm) : WGM;
    pm = fm + ((wgid % nig) % gsz); pn = (wgid % nig) / gsz;
}

template <class Epi, class Sched, bool ALIGN_EPI, bool SP2>
__device__ __forceinline__ void gemm_phase(LAS unsigned char* lds, const int wave_in, const int lda, const int K, const Sched& S, const Epi& E) {
    int ln_; asm volatile("v_mbcnt_lo_u32_b32 %0, -1, 0\n\tv_mbcnt_hi_u32_b32 %0, -1, %0" : "=v"(ln_));
    const int tid = wave_in * 64 + ln_, wid = __builtin_amdgcn_readfirstlane(tid >> 6), lane = tid & 63, wr = wid >> 2, wc = wid & 3, fr = lane & 15, fq = lane >> 4;
    const int nt = K / BK;
    unsigned voffA[2], voffB[2];
#pragma unroll
    for (int i = 0; i < 2; ++i) { int R, C; stage_rc(tid * 16 + i * 8192, R, C); const int Rb = Epi::PERM ? ((R & ~31) + perm32(R & 31)) : R;
        voffA[i] = (unsigned)(R * lda + C) * 2u; voffB[i] = (unsigned)(Rb * K + C) * 2u; }
    const size_t kstep = (size_t)(BK * 2);
    const size_t hstepA = (size_t)HALF * lda * 2, hstepB = (size_t)HALF * K * 2;
    const unsigned ldsw = (unsigned)wid * 1024u;
    const int aoff = lds_byte(wr * 64 + fr, fq * 8), boff = lds_byte(wc * 32 + fr, fq * 8);
#define PG8_SA(b, h) (((b) * 2 + (h)) * HTB)
#define PG8_SB(b, h) ((4 + (b) * 2 + (h)) * HTB)
#define PG8_STAGE(bufoff, gbase, voff) do { _Pragma("unroll") for (int _i = 0; _i < 2; ++_i) \
        __builtin_amdgcn_global_load_lds((const unsigned*)((const char*)(gbase) + (voff)[_i]), (LAS unsigned*)(lds + (bufoff) + ldsw + _i * 8192), 16, 0, 0); } while (0)
#define PG8_LDA(dst, b, h) do { _Pragma("unroll") for (int m = 0; m < 4; ++m) _Pragma("unroll") for (int k = 0; k < 2; ++k) dst[m][k] = *(const LAS bf16x8*)(lds + PG8_SA(b, h) + aoff + m * 2048 + k * 1024); } while (0)
#define PG8_LDB(dst, b, h) do { _Pragma("unroll") for (int n = 0; n < 2; ++n) _Pragma("unroll") for (int k = 0; k < 2; ++k) dst[n][k] = *(const LAS bf16x8*)(lds + PG8_SB(b, h) + boff + n * 2048 + k * 1024); } while (0)
#define PG8_MMA(ai, bj, At, Bt) do { __builtin_amdgcn_s_setprio(1); _Pragma("unroll") for (int m = 0; m < 4; ++m) _Pragma("unroll") for (int n = 0; n < 2; ++n) _Pragma("unroll") for (int k = 0; k < 2; ++k) \
        acc[ai][bj][m][n] = __builtin_amdgcn_mfma_f32_16x16x32_bf16(Bt[n][k], At[m][k], acc[ai][bj][m][n], 0, 0, 0); __builtin_amdgcn_s_setprio(0); } while (0)
#define PG8_WAIT_V(n) asm volatile("s_waitcnt vmcnt(" #n ")" ::: "memory")
#define PG8_WAIT_L(n) asm volatile("s_waitcnt lgkmcnt(" #n ")" ::: "memory")
#define PG8_BAR __builtin_amdgcn_s_barrier()
#define PG8_SCHED __builtin_amdgcn_sched_barrier(0)
    Unit cur, nxt; int ui = 0;
    if (!S.next(0, cur)) return;
    f32x4 acc[2][2][4][2];
#pragma unroll
    for (int a = 0; a < 2; ++a)
#pragma unroll
        for (int b = 0; b < 2; ++b)
#pragma unroll
            for (int m = 0; m < 4; ++m)
#pragma unroll
                for (int n = 0; n < 2; ++n) acc[a][b][m][n] = (f32x4){0.f, 0.f, 0.f, 0.f};
    bf16x8 At[4][2], B0[2][2], B1[2][2];
    const char* cA = cur.a; const char* cB = cur.b;
    if constexpr (SP2) {
        PG8_STAGE(PG8_SB(0, 0), cB, voffB); PG8_STAGE(PG8_SB(0, 1), cB + hstepB, voffB); PG8_STAGE(PG8_SA(0, 0), cA, voffA); PG8_STAGE(PG8_SA(0, 1), cA + hstepA, voffA);
        if (wr == 1) PG8_BAR;
        PG8_WAIT_V(2); PG8_BAR;
        PG8_STAGE(PG8_SB(1, 0), cB + kstep, voffB); PG8_STAGE(PG8_SA(1, 0), cA + kstep, voffA); PG8_STAGE(PG8_SB(1, 1), cB + hstepB + kstep, voffB);
        PG8_WAIT_V(6); PG8_BAR;
    } else {
        PG8_STAGE(PG8_SB(0, 0), cB, voffB); PG8_STAGE(PG8_SA(0, 0), cA, voffA); PG8_STAGE(PG8_SB(0, 1), cB + hstepB, voffB); PG8_STAGE(PG8_SA(0, 1), cA + hstepA, voffA);
        if (wr == 1) PG8_BAR;
        PG8_WAIT_V(4); PG8_BAR;
        PG8_STAGE(PG8_SB(1, 0), cB + kstep, voffB); PG8_STAGE(PG8_SA(1, 0), cA + kstep, voffA); PG8_STAGE(PG8_SB(1, 1), cB + hstepB + kstep, voffB);
        PG8_WAIT_V(6); PG8_BAR;
    }
    for (;;) {
        const bool has_next = S.next(ui + 1, nxt);
        const bool do0 = cur.half != 2, do1 = cur.half != 1;
        const char* nA = has_next ? nxt.a : cA; const char* nB = has_next ? nxt.b : cB;
#pragma unroll 1
        for (int t = 0; t < nt; t += 2) {
            const bool last = (t == nt - 2);
            const char* a1 = cA + (size_t)(t + 1) * kstep;
            const char* a2 = last ? nA : cA + (size_t)(t + 2) * kstep; const char* b2 = last ? nB : cB + (size_t)(t + 2) * kstep;
            const char* a3 = a2 + kstep; const char* b3 = b2 + kstep;
            if constexpr (SP2) {
            PG8_LDB(B0, 0, 0); PG8_LDB(B1, 0, 1); PG8_SCHED; PG8_LDA(At, 0, 0); PG8_STAGE(PG8_SA(1, 1), a1 + hstepA, voffA);
            PG8_WAIT_V(8); PG8_WAIT_L(0); PG8_BAR; if (do0) { PG8_MMA(0, 0, At, B0); PG8_MMA(0, 1, At, B1); } PG8_BAR; PG8_SCHED;
            PG8_LDA(At, 0, 1); PG8_STAGE(PG8_SB(0, 0), b2, voffB); PG8_STAGE(PG8_SB(0, 1), b2 + hstepB, voffB); PG8_STAGE(PG8_SA(0, 0), a2, voffA);
            PG8_WAIT_V(8); PG8_WAIT_L(0); PG8_BAR; if (do1) { PG8_MMA(1, 0, At, B0); PG8_MMA(1, 1, At, B1); } PG8_BAR; PG8_SCHED;
            PG8_LDB(B0, 1, 0); PG8_LDB(B1, 1, 1); PG8_SCHED; PG8_LDA(At, 1, 0); PG8_STAGE(PG8_SA(0, 1), a2 + hstepA, voffA);
            PG8_WAIT_V(8); PG8_WAIT_L(0); PG8_BAR; if (do0) { PG8_MMA(0, 0, At, B0); PG8_MMA(0, 1, At, B1); } PG8_BAR; PG8_SCHED;
            PG8_LDA(At, 1, 1); PG8_STAGE(PG8_SB(1, 0), b3, voffB); PG8_STAGE(PG8_SB(1, 1), b3 + hstepB, voffB); PG8_STAGE(PG8_SA(1, 0), a3, voffA);
            PG8_WAIT_V(8); PG8_WAIT_L(0); PG8_BAR; if (do1) { PG8_MMA(1, 0, At, B0); PG8_MMA(1, 1, At, B1); } PG8_BAR; PG8_SCHED;
            } else {
            PG8_LDB(B0, 0, 0); PG8_SCHED; PG8_LDA(At, 0, 0); PG8_STAGE(PG8_SA(1, 1), a1 + hstepA, voffA);
            PG8_WAIT_L(8); PG8_BAR; PG8_WAIT_L(0); PG8_MMA(0, 0, At, B0); PG8_BAR; PG8_SCHED;
            PG8_LDB(B1, 0, 1); PG8_STAGE(PG8_SB(0, 0), b2, voffB);
            PG8_BAR; PG8_WAIT_L(0); PG8_MMA(0, 1, At, B1); PG8_BAR;
            PG8_LDA(At, 0, 1); PG8_STAGE(PG8_SA(0, 0), a2, voffA);
            PG8_BAR; PG8_WAIT_L(0); PG8_MMA(1, 0, At, B0); PG8_BAR; PG8_SCHED;
            PG8_STAGE(PG8_SB(0, 1), b2 + hstepB, voffB);
            PG8_WAIT_V(6); PG8_BAR; PG8_MMA(1, 1, At, B1); PG8_BAR;
            PG8_LDB(B0, 1, 0); PG8_SCHED; PG8_LDA(At, 1, 0); PG8_STAGE(PG8_SA(0, 1), a2 + hstepA, voffA);
            PG8_WAIT_L(8); PG8_BAR; PG8_WAIT_L(0); PG8_MMA(0, 0, At, B0); PG8_BAR; PG8_SCHED;
            PG8_LDB(B1, 1, 1); PG8_STAGE(PG8_SB(1, 0), b3, voffB);
            PG8_BAR; PG8_WAIT_L(0); PG8_MMA(0, 1, At, B1); PG8_BAR;
            PG8_LDA(At, 1, 1); PG8_STAGE(PG8_SA(1, 0), a3, voffA);
            PG8_BAR; PG8_WAIT_L(0); PG8_MMA(1, 0, At, B0); PG8_BAR; PG8_SCHED;
            PG8_STAGE(PG8_SB(1, 1), b3 + hstepB, voffB);
            PG8_WAIT_V(6); PG8_BAR; PG8_MMA(1, 1, At, B1); PG8_BAR;
            }
        }
        if constexpr (ALIGN_EPI) { if (wr == 0) PG8_BAR; }
        E(acc, cur, wr, wc, fr, fq);
        if (!has_next) break;
        if (!E.keep(cur)) {
#pragma unroll
            for (int a = 0; a < 2; ++a)
#pragma unroll
                for (int b = 0; b < 2; ++b)
#pragma unroll
                    for (int m = 0; m < 4; ++m)
#pragma unroll
                        for (int n = 0; n < 2; ++n) acc[a][b][m][n] = (f32x4){0.f, 0.f, 0.f, 0.f};
        }
        cur = nxt; cA = nA; cB = nB; ++ui;
        if constexpr (ALIGN_EPI) { if (wr == 1) PG8_BAR; }
    }
    PG8_WAIT_V(0);
    if constexpr (!ALIGN_EPI) { if (wr == 0) PG8_BAR; }
    PG8_BAR;
#undef PG8_SA
#undef PG8_SB
#undef PG8_STAGE
#undef PG8_LDA
#undef PG8_LDB
#undef PG8_MMA
#undef PG8_WAIT_V
#undef PG8_WAIT_L
#undef PG8_BAR
#undef PG8_SCHED
}

typedef f32x4 Acc[2][2][4][2];

struct EpiProj {
    static constexpr bool PERM = true;
    bf16_t *cqkv, *gqkv, *og, *up, *misc; const LAS float* rs_tab; float* ssq;
    __device__ __forceinline__ bool keep(const Unit&) const { return false; }
    __device__ __forceinline__ void operator()(Acc& acc, const Unit& u, int wr, int wc, int fr, int fq) const {
        const int row0 = u.pm * BM + wr * 64 + fr;
        bf16_t* dst; int ld, coff; const int pn = u.pn;
        if (pn < 2) { dst = cqkv; ld = 512; coff = pn * 256; }
        else if (pn < 6) { dst = gqkv; ld = 1024; coff = (pn - 2) * 256; }
        else if (pn < 8) { dst = og; ld = 512; coff = (pn - 6) * 256; }
        else if (pn < 10) { dst = up; ld = 512; coff = (pn - 8) * 256; }
        else { dst = misc; ld = 256; coff = 0; }
        const int col0 = coff + wc * 32 + 8 * fq;
#pragma unroll
        for (int ai = 0; ai < 2; ++ai)
#pragma unroll
            for (int m = 0; m < 4; ++m) { if (u.half && ai != u.half - 1) continue;
                const int row = row0 + ai * HALF + m * 16;
                const float rs = rs_tab[wr * 64 + fr + ai * HALF + m * 16];
                float ss = 0.f;
#pragma unroll
                for (int bj = 0; bj < 2; ++bj) {
                    const f32x4 v0 = acc[ai][bj][m][0] * rs, v1 = acc[ai][bj][m][1] * rs;
                    ss += (v0[0] * v0[0] + v0[1] * v0[1]) + (v0[2] * v0[2] + v0[3] * v0[3]) + (v1[0] * v1[0] + v1[1] * v1[1]) + (v1[2] * v1[2] + v1[3] * v1[3]);
                    u32x4 w; w.x = cvt_pk_bf16(v0[0], v0[1]); w.y = cvt_pk_bf16(v0[2], v0[3]); w.z = cvt_pk_bf16(v1[0], v1[1]); w.w = cvt_pk_bf16(v1[2], v1[3]);
                    *(u32x4*)(dst + (size_t)row * ld + col0 + bj * HALF) = w;
                }
                if (pn < 2) { ss += __shfl_xor(ss, 16); ss += __shfl_xor(ss, 32); if (fq == 0) ssq[((size_t)pn * T + row) * 4 + wc] = ss; }
            }
    }
};
struct EpiUp {
    static constexpr bool PERM = true;
    bf16_t* out; const float* ssq;
    __device__ __forceinline__ bool keep(const Unit&) const { return false; }
    __device__ __forceinline__ void operator()(Acc& acc, const Unit& u, int wr, int wc, int fr, int fq) const {
        const int row0 = u.pm * BM + wr * 64 + fr, col0 = u.pn * BM + wc * 32 + 8 * fq;
        const float* sq = ssq + (u.pn < 3 ? (size_t)0 : (size_t)T * 4);
#pragma unroll
        for (int ai = 0; ai < 2; ++ai)
#pragma unroll
            for (int m = 0; m < 4; ++m) { if (u.half && ai != u.half - 1) continue;
                const int row = row0 + ai * HALF + m * 16;
                const float rs = rsqrtf(sum4(sq + (size_t)row * 4) * (1.f / 256.f) + EPS);
#pragma unroll
                for (int bj = 0; bj < 2; ++bj) {
                    const f32x4 v0 = acc[ai][bj][m][0] * rs, v1 = acc[ai][bj][m][1] * rs;
                    u32x4 w; w.x = cvt_pk_bf16(v0[0], v0[1]); w.y = cvt_pk_bf16(v0[2], v0[3]); w.z = cvt_pk_bf16(v1[0], v1[1]); w.w = cvt_pk_bf16(v1[2], v1[3]);
                    *(u32x4*)(out + (size_t)row * 1792 + col0 + bj * HALF) = w;
                }
            }
    }
};
struct EpiGate {
    static constexpr bool PERM = true;
    unsigned char* acts; const LAS float* rs_tab;
    __device__ __forceinline__ bool keep(const Unit&) const { return false; }
    __device__ __forceinline__ void operator()(Acc& acc, const Unit& u, int wr, int wc, int fr, int fq) const {
        const int row0 = u.pm * BM + wr * 64 + fr, pl = u.pn >> 2, col0 = (u.pn & 3) * BM + wc * 32 + 8 * fq;
        bf16_t* dst = (bf16_t*)(acts + ((long long)A_G0 + (long long)(pl == 1) * (long long)(A_G1 - A_G0) + (long long)(pl == 2) * (long long)(A_G2 - A_G0)));
#pragma unroll
        for (int ai = 0; ai < 2; ++ai)
#pragma unroll
            for (int m = 0; m < 4; ++m) { if (u.half && ai != u.half - 1) continue;
                const int row = row0 + ai * HALF + m * 16;
                const float rs = rs_tab[wr * 64 + fr + ai * HALF + m * 16];
#pragma unroll
                for (int bj = 0; bj < 2; ++bj) {
                    f32x4 v0 = acc[ai][bj][m][0] * rs, v1 = acc[ai][bj][m][1] * rs;
#ifndef DBG_NOSIG
#pragma unroll
                    for (int e = 0; e < 4; ++e) { v0[e] = fast_sigmoid(fminf(fmaxf(v0[e], -60.f), 60.f)); v1[e] = fast_sigmoid(fminf(fmaxf(v1[e], -60.f), 60.f)); }
#endif
                    u32x4 w; w.x = cvt_pk_bf16(v0[0], v0[1]); w.y = cvt_pk_bf16(v0[2], v0[3]); w.z = cvt_pk_bf16(v1[0], v1[1]); w.w = cvt_pk_bf16(v1[2], v1[3]);
                    *(u32x4*)(dst + (size_t)row * 1024 + col0 + bj * HALF) = w;
                }
            }
    }
};
struct EpiMerge {
    static constexpr bool PERM = true;
    const unsigned char* acts; bf16_t* merged;
    __device__ __forceinline__ bool keep(const Unit& u) const { return u.kind < 2; }
    __device__ __forceinline__ void operator()(Acc& acc, const Unit& u, int wr, int wc, int fr, int fq) const {
        const int row0 = u.pm * BM + wr * 64 + fr, col0 = u.pn * BM + wc * 32 + 8 * fq, n = u.kind;
        const bf16_t* gn = (const bf16_t*)(acts + ((long long)A_G0 + (long long)(n == 1) * (long long)(A_G1 - A_G0) + (long long)(n == 2) * (long long)(A_G2 - A_G0)));
        const bf16_t* gd = (const bf16_t*)(acts + ((long long)A_G1 + (long long)(n != 0) * (long long)(A_G2 - A_G1)));
#pragma unroll
        for (int ai = 0; ai < 2; ++ai)
#pragma unroll
            for (int m = 0; m < 4; ++m) { if (u.half && ai != u.half - 1) continue;
                const int row = row0 + ai * HALF + m * 16;
#pragma unroll
                for (int bj = 0; bj < 2; ++bj) {
                    const size_t off = (size_t)row * 1024 + col0 + bj * HALF;
                    const u32x4 sn = *(const u32x4*)(gn + off);
                    f32x4 f0 = {bflo(sn.x), bfhi(sn.x), bflo(sn.y), bfhi(sn.y)}, f1 = {bflo(sn.z), bfhi(sn.z), bflo(sn.w), bfhi(sn.w)};
                    if (n < 2) {
                        const u32x4 sd = *(const u32x4*)(gd + off);
                        const f32x4 d0 = {bflo(sd.x), bfhi(sd.x), bflo(sd.y), bfhi(sd.y)}, d1 = {bflo(sd.z), bfhi(sd.z), bflo(sd.w), bfhi(sd.w)};
#pragma unroll
                        for (int e = 0; e < 4; ++e) { f0[e] *= __builtin_amdgcn_rcpf(d0[e]); f1[e] *= __builtin_amdgcn_rcpf(d1[e]); }
                        acc[ai][bj][m][0] = acc[ai][bj][m][0] * f0; acc[ai][bj][m][1] = acc[ai][bj][m][1] * f1;
                    } else {
                        const f32x4 v0 = acc[ai][bj][m][0] * f0, v1 = acc[ai][bj][m][1] * f1;
                        u32x4 w; w.x = cvt_pk_bf16(v0[0], v0[1]); w.y = cvt_pk_bf16(v0[2], v0[3]); w.z = cvt_pk_bf16(v1[0], v1[1]); w.w = cvt_pk_bf16(v1[2], v1[3]);
                        *(u32x4*)((unsigned char*)(merged + off) + (row >= 8192 ? MERGED_HI_DELTA : 0)) = w;
                    }
                }
            }
    }
};
struct EpiResid {
    static constexpr bool PERM = true;
    bf16_t* xb; float* rowss_next;
    __device__ __forceinline__ bool keep(const Unit&) const { return false; }
    __device__ __forceinline__ void operator()(Acc& acc, const Unit& u, int wr, int wc, int fr, int fq) const {
        const int row0 = u.pm * BM + wr * 64 + fr, col0 = u.pn * BM + wc * 32 + 8 * fq;
#pragma unroll
        for (int ai = 0; ai < 2; ++ai)
#pragma unroll
            for (int m = 0; m < 4; ++m) { if (u.half && ai != u.half - 1) continue;
                const int row = row0 + ai * HALF + m * 16; float ss = 0.f;
#pragma unroll
                for (int bj = 0; bj < 2; ++bj) {
                    bf16_t* p = xb + (size_t)row * D + col0 + bj * HALF;
                    const u32x4 o = *(const u32x4*)p;
                    const f32x4 v0 = (f32x4){bflo(o.x), bfhi(o.x), bflo(o.y), bfhi(o.y)} + acc[ai][bj][m][0], v1 = (f32x4){bflo(o.z), bfhi(o.z), bflo(o.w), bfhi(o.w)} + acc[ai][bj][m][1];
                    ss += ((v0[0] * v0[0] + v0[1] * v0[1]) + (v0[2] * v0[2] + v0[3] * v0[3])) + ((v1[0] * v1[0] + v1[1] * v1[1]) + (v1[2] * v1[2] + v1[3] * v1[3]));
                    u32x4 w; w.x = cvt_pk_bf16(v0[0], v0[1]); w.y = cvt_pk_bf16(v0[2], v0[3]); w.z = cvt_pk_bf16(v1[0], v1[1]); w.w = cvt_pk_bf16(v1[2], v1[3]);
                    *(u32x4*)p = w;
                }
                ss += __shfl_xor(ss, 16); ss += __shfl_xor(ss, 32); if (fq == 0) rowss_next[(size_t)row * 16 + u.pn * 4 + wc] = ss;
            }
    }
};
template <bool MOE> struct EpiSwiglu {
    static constexpr bool PERM = true;
    bf16_t* act; int ld; const LAS float* rs_tab; const float* slot_scale; const float* slot_comb;
    __device__ __forceinline__ bool keep(const Unit&) const { return false; }
    __device__ __forceinline__ void operator()(Acc& acc, const Unit& u, int wr, int wc, int fr, int fq) const {
        const int row0 = u.pm * BM + wr * 64 + fr, col0 = u.pn * HALF + wc * 32 + 8 * fq;
#pragma unroll
        for (int ai = 0; ai < 2; ++ai)
#pragma unroll
            for (int m = 0; m < 4; ++m) { if (u.half && ai != u.half - 1) continue;
                const int row = row0 + ai * HALF + m * 16;
                float rs, cb;
                if (MOE) { rs = slot_scale[row]; cb = slot_comb[row]; } else { rs = rs_tab[wr * 64 + fr + ai * HALF + m * 16]; cb = 1.f; }
                f32x4 o[2];
#pragma unroll
                for (int n = 0; n < 2; ++n) {
                    const f32x4 g = acc[ai][0][m][n] * rs, uu = acc[ai][1][m][n] * rs;
#pragma unroll
                    for (int e = 0; e < 4; ++e) o[n][e] = g[e] * fast_sigmoid(g[e]) * uu[e] * cb;
                }
                u32x4 w; w.x = cvt_pk_bf16(o[0][0], o[0][1]); w.y = cvt_pk_bf16(o[0][2], o[0][3]); w.z = cvt_pk_bf16(o[1][0], o[1][1]); w.w = cvt_pk_bf16(o[1][2], o[1][3]);
                *(u32x4*)(act + (size_t)row * ld + col0) = w;
            }
    }
};
struct EpiMoeDown {
    static constexpr bool PERM = true;
    bf16_t* y;
    __device__ __forceinline__ bool keep(const Unit&) const { return false; }
    __device__ __forceinline__ void operator()(Acc& acc, const Unit& u, int wr, int wc, int fr, int fq) const {
        const int row0 = u.pm * BM + wr * 64 + fr, col0 = u.pn * BM + wc * 32 + 8 * fq;
#pragma unroll
        for (int ai = 0; ai < 2; ++ai)
#pragma unroll
            for (int m = 0; m < 4; ++m) { if (u.half && ai != u.half - 1) continue;
                const int row = row0 + ai * HALF + m * 16;
#pragma unroll
                for (int bj = 0; bj < 2; ++bj) {
                    const f32x4 v0 = acc[ai][bj][m][0], v1 = acc[ai][bj][m][1];
                    u32x4 w; w.x = cvt_pk_bf16(v0[0], v0[1]); w.y = cvt_pk_bf16(v0[2], v0[3]); w.z = cvt_pk_bf16(v1[0], v1[1]); w.w = cvt_pk_bf16(v1[2], v1[3]);
                    *(u32x4*)(y + (size_t)row * D + col0 + bj * HALF) = w;
                }
            }
    }
};

struct SchedGrid {
    const char* A; const char* B; size_t a_tile, b_tile, a_alt; int nM, nN, G, c, alt_from; long long a_hi = 0;
    int split_from = 1 << 30;
    __device__ __forceinline__ bool next(int i, Unit& u) const {
        int L = i * G + c, hf = 0;
        if (L >= split_from) { const int nl = nM * nN - split_from, j = L - split_from; if (j >= 2 * nl) return false; hf = 1 + j / nl; L = split_from + j % nl; }
        if (L >= nM * nN) return false;
        int pm, pn; tile_map(L, nM, nN, pm, pn);
        u.pm = pm; u.pn = pn; u.kind = 0; u.half = hf; u.a = A + (size_t)pm * a_tile + (pn >= alt_from ? a_alt : 0) + (pm >= 32 ? a_hi : 0); u.b = B + (size_t)pn * b_tile; return true;
    }
};
struct SchedMerge {
    const char* acts; const char* wbr; int G, c;
    __device__ __forceinline__ bool next(int i, Unit& u) const {
        const int ti = i / 3, n = i - ti * 3, L = ti * G + c; if (L >= 256) return false;
        int pm, pn; tile_map(L, 64, 4, pm, pn);
        u.pm = pm; u.pn = pn; u.kind = n; u.half = 0; u.a = acts + ((long long)A_YSA + (long long)(n == 1) * ((long long)A_YSB - (long long)A_YSA) + (long long)(n == 2) * ((long long)A_POOLED - (long long)A_YSA)) + (size_t)pm * (256 * 512 * 2); u.b = wbr + (size_t)n * (1024 * 512 * 2) + (size_t)pn * (256 * 512 * 2); return true;
    }
};
struct SchedMoe {
    const char* A; const char* B; size_t a_tile, b_tile, b_exp; int MT, nN, G, c; int t1, t2, t3, t4, t5, t6, t7;
    __device__ __forceinline__ bool next(int i, Unit& u) const {
        const int L = i * G + c; if (L >= MT * nN) return false;
        int pm, pn; tile_map(L, MT, nN, pm, pn);
        const int e = (pm >= t1) + (pm >= t2) + (pm >= t3) + (pm >= t4) + (pm >= t5) + (pm >= t6) + (pm >= t7);
        u.pm = pm; u.pn = pn; u.kind = e; u.half = 0; u.a = A + (size_t)pm * a_tile; u.b = B + (size_t)e * b_exp + (size_t)pn * b_tile; return true;
    }
};
}

#define XB_TMO      128
#define XB_XCNT(j)  (256  + 64 * (j))
#define XB_XSUB(j)  (1280 + 64 * (j))
#define XB_XGEN(j)  (2304 + 64 * (j))
#define XB_TOP      3328
#define XB_TOPGEN   3392
#define XCD_BAR_WORDS 3456
#define XB_SPIN_CAP (1u << 18)
__device__ __forceinline__ unsigned xb_ld(unsigned* p)              { return __hip_atomic_load(p, __ATOMIC_RELAXED, __HIP_MEMORY_SCOPE_AGENT); }
__device__ __forceinline__ unsigned xb_add(unsigned* p, unsigned v) { return __hip_atomic_fetch_add(p, v, __ATOMIC_RELAXED, __HIP_MEMORY_SCOPE_AGENT); }
__device__ __forceinline__ unsigned xb_xcc_id() { return (unsigned)__builtin_amdgcn_s_getreg((3 << 11) | 20) & 0xFu; }
#define XB_SPIN(cond, bar) do { unsigned _sp = 0; while (cond) { __builtin_amdgcn_s_sleep(1); \
    if ((++_sp & 255u) == 0u) { if (xb_ld(&(bar)[XB_TMO])) break; if (_sp > XB_SPIN_CAP) { atomicAdd(&(bar)[XB_TMO], 1u); break; } } } } while (0)
struct XcdBarrier { unsigned* bar; unsigned x; volatile LAS unsigned* st; };
__device__ __forceinline__ XcdBarrier xcd_barrier_post(unsigned* bar, volatile LAS unsigned* st) {
    XcdBarrier b; b.bar = bar; b.x = xb_xcc_id(); b.st = st;
    if (threadIdx.x == 0) (void)xb_add(&bar[XB_XCNT(b.x)], 1u);
    return b;
}
__device__ __forceinline__ void xcd_barrier_complete(unsigned* bar, unsigned x, unsigned& nloc, unsigned& nx) {
    const unsigned G = gridDim.x * gridDim.y * gridDim.z;
    unsigned sum, cnt, mine, sp = 0u;
    for (;;) {
        sum = 0u; cnt = 0u; mine = 0u;
#pragma unroll
        for (unsigned j = 0; j < 16; ++j) { const unsigned c = xb_ld(&bar[XB_XCNT(j)]); sum += c; cnt += (c > 0u) ? 1u : 0u; mine = (j == x) ? c : mine; }
        if (sum == G) break;
        __builtin_amdgcn_s_sleep(1);
        if ((++sp & 255u) == 0u) { if (xb_ld(&bar[XB_TMO])) break; if (sp > XB_SPIN_CAP) { atomicAdd(&bar[XB_TMO], 1u); break; } }
    }
    nloc = mine > 0u ? mine : 1u; nx = cnt > 0u ? cnt : 1u;
}
__device__ __forceinline__ void xcd_barrier(const XcdBarrier& b) {
    asm volatile("s_waitcnt vmcnt(0)" ::: "memory");
    __syncthreads();
    if (threadIdx.x == 0) {
        unsigned* bar = b.bar;
        __builtin_amdgcn_s_waitcnt(0);
        unsigned nloc = b.st[0], nx = b.st[1];
        if (nloc == 0u) { xcd_barrier_complete(bar, b.x, nloc, nx); b.st[0] = nloc; b.st[1] = nx; }
        const unsigned old = xb_add(&bar[XB_XSUB(b.x)], 1u);
        const unsigned gen = old / nloc;
        if (old + 1u == (gen + 1u) * nloc) {
            __builtin_amdgcn_fence(__ATOMIC_RELEASE, "agent");
            asm volatile("s_waitcnt vmcnt(0)" ::: "memory");
            const unsigned og = xb_add(&bar[XB_TOP], 1u);
            const unsigned tg = og / nx;
            if (og + 1u == (tg + 1u) * nx) xb_add(&bar[XB_TOPGEN], 1u);
            else XB_SPIN(xb_ld(&bar[XB_TOPGEN]) == tg, bar);
            __builtin_amdgcn_fence(__ATOMIC_ACQUIRE, "agent");
            xb_add(&bar[XB_XGEN(b.x)], 1u);
            asm volatile("s_waitcnt vmcnt(0)" ::: "memory");
        } else {
            XB_SPIN(xb_ld(&bar[XB_XGEN(b.x)]) == gen, bar);
            __builtin_amdgcn_fence(__ATOMIC_ACQUIRE, "agent");
            asm volatile("s_waitcnt vmcnt(0)" ::: "memory");
        }
    }
    __syncthreads();
}

struct Frame {
    LAS unsigned char* lds;
    volatile LAS unsigned* MISC;
    unsigned* ctl; float* ctlf; float* stats;
    unsigned char* ws;
    int tid, lane, wave, vcu, G;
    const CAS GPtr* inp;
    float* out;
    __device__ __forceinline__ const float* in(int i) const { return (const float*)inp[i]; }
};
enum { I_X = 0, I_POS, I_GMIX, I_WIN, I_GCQ, I_WUQ, I_GCKV, I_WUKV, I_GQKQ, I_GQKK, I_WGLA, I_BGLA, I_GGLAO, I_WPOOL, I_PSCALE, I_WBR, I_WOUT, I_GFFN, I_WFG, I_WFU, I_WFD, I_WROUTER, I_WEG, I_WEU, I_WED };

__device__ __forceinline__ bf16_t* act_ptr(const Frame& F, size_t off) { return (bf16_t*)(F.ws + WS_ACTS + off); }
__device__ __forceinline__ unsigned char* wblk(const Frame& F, int layer) { return F.ws + (layer == 0 ? WS_W0 : WS_W1); }

__device__ __forceinline__ void fill_rs(Frame& F, const float* rowss, int pm) {
    if (F.tid < 256) ((LAS float*)(F.lds + RS_OFF))[F.tid] = rsqrtf(sum16(rowss + ((size_t)pm * 256 + F.tid) * 16) * (1.f / 1024.f) + EPS);
    __syncthreads();
}
struct ConvSeg { const float* src; int ld, K, width, col0; bf16_t* dst; int row0, inter; const float* gain; };
typedef short v4i16c_t __attribute__((ext_vector_type(4)));
__device__ __forceinline__ int seg_items(const ConvSeg& s) { return (s.K >> 6) * ((s.width + 63) >> 6); }
__device__ __forceinline__ void conv_load(const ConvSeg& s, int item, int lane, f32x4 (&v)[16]) {
    const int nblk = (s.width + 63) >> 6, kb = item / nblk, nb = item - kb * nblk, k0 = kb * 64, n0 = nb * 64;
    const int kq = lane >> 4, n4 = (lane & 15) * 4; const bool ok = n0 + n4 < s.width;
    const float* p = s.src + (size_t)(k0 + kq) * s.ld + s.col0 + n0 + n4;
#pragma unroll
    for (int i = 0; i < 16; ++i) v[i] = ok ? *(const f32x4*)(p + (size_t)(4 * i) * s.ld) : (f32x4){0.f, 0.f, 0.f, 0.f};
}
__device__ __forceinline__ void conv_store(const ConvSeg& s, int item, LAS unsigned char* scr, int lane, const f32x4 (&v)[16]) {
    const int nblk = (s.width + 63) >> 6, kb = item / nblk, nb = item - kb * nblk, k0 = kb * 64, n0 = nb * 64;
    const int kq = lane >> 4, n4 = (lane & 15) * 4;
#pragma unroll
    for (int i = 0; i < 16; ++i) {
        f32x4 x = v[i]; if (s.gain) x = x * s.gain[k0 + 4 * i + kq];
        *(LAS u32x2*)(scr + (4 * i + kq) * 136 + n4 * 2) = (u32x2){cvt_pk_bf16(x[0], x[1]), cvt_pk_bf16(x[2], x[3])};
    }
    LDS_WAIT();
    const int g = lane >> 4, i16 = lane & 15;
#pragma unroll
    for (int nb16 = 0; nb16 < 4; ++nb16)
#pragma unroll
        for (int kh = 0; kh < 2; ++kh) {
            const int c = kh * 4 + g;
            const LAS unsigned char* a = scr + (8 * c + (i16 >> 2)) * 136 + (nb16 * 16 + (i16 & 3) * 4) * 2;
            const v4i16c_t lo = __builtin_amdgcn_ds_read_tr16_b64_v4i16((LAS v4i16c_t*)a), hi = __builtin_amdgcn_ds_read_tr16_b64_v4i16((LAS v4i16c_t*)(a + 4 * 136));
            const int nq = n0 + nb16 * 16 + i16;
            if (nq < s.width) {
                const int drow = s.row0 + (s.inter ? ((nq >> 7) * 256 + (nq & 127)) : nq);
                typedef short s16x8_t __attribute__((ext_vector_type(8)));
                *(s16x8_t*)(s.dst + (size_t)drow * s.K + k0 + 8 * c) = (s16x8_t){lo[0], lo[1], lo[2], lo[3], hi[0], hi[1], hi[2], hi[3]};
            }
        }
    LDS_WAIT();
}
__device__ __forceinline__ ConvSeg mixer_seg(const Frame& F, int l, int idx) {
    unsigned char* wb = wblk(F, l);
    ConvSeg s; s.inter = 0; s.row0 = 0; s.col0 = 0;
    if (idx < 10) {
        int c0, wd, r0;
        switch (idx) {
            case 0: c0 = 0; wd = 256; r0 = 0; break;
            case 1: c0 = 256; wd = 256; r0 = 256; break;
            case 2: c0 = 544; wd = 256; r0 = 512; break;
            case 3: c0 = 800; wd = 256; r0 = 768; break;
            case 4: c0 = 1056; wd = 512; r0 = 1024; break;
            case 5: c0 = 1584; wd = 512; r0 = 1536; break;
            case 6: c0 = 2096; wd = 512; r0 = 2048; break;
            case 7: c0 = 512; wd = 32; r0 = 2560; break;
            case 8: c0 = 1568; wd = 16; r0 = 2592; break;
            default: c0 = 2608; wd = 3072; r0 = 0; break;
        }
        s.src = F.in(I_WIN) + (size_t)l * D * DIN; s.ld = DIN; s.K = D; s.width = wd; s.col0 = c0;
        s.dst = (bf16_t*)(wb + (idx == 9 ? WO_G : WO_IN)); s.row0 = r0; s.gain = F.in(I_GMIX) + l * D;
    } else if (idx == 10) { s.src = F.in(I_WUQ) + (size_t)l * 256 * 768; s.ld = 768; s.K = 256; s.width = 768; s.dst = (bf16_t*)(wb + WO_UP); s.gain = F.in(I_GCQ) + l * 256; }
    else if (idx == 11) { s.src = F.in(I_WUKV) + (size_t)l * 256 * 1024; s.ld = 1024; s.K = 256; s.width = 1024; s.dst = (bf16_t*)(wb + WO_UP); s.row0 = 768; s.gain = F.in(I_GCKV) + l * 256; }
    else if (idx < 14) { const int n = idx - 12; s.src = F.in(I_WBR) + (size_t)(l * 3 + n) * 512 * D; s.ld = D; s.K = 512; s.width = D; s.dst = (bf16_t*)(wb + WO_BR) + (size_t)n * 1024 * 512; s.gain = nullptr; }
    else { s.src = F.in(I_WOUT) + (size_t)l * D * D; s.ld = D; s.K = D; s.width = D; s.dst = (bf16_t*)(wb + WO_OUT); s.gain = nullptr; }
    return s;
}
__device__ __forceinline__ ConvSeg ffn_seg(const Frame& F, int idx) {
    unsigned char* wb = F.ws + WS_W0; ConvSeg s; s.col0 = 0; s.inter = 0; s.row0 = 0;
    if (idx < 2) { s.src = F.in(idx == 0 ? I_WFG : I_WFU); s.ld = DFF; s.K = D; s.width = DFF; s.dst = (bf16_t*)(wb + WO_FGU); s.row0 = idx * 128; s.inter = 1; s.gain = F.in(I_GFFN); }
    else { s.src = F.in(I_WFD); s.ld = D; s.K = DFF; s.width = D; s.dst = (bf16_t*)(wb + WO_FD); s.gain = nullptr; }
    return s;
}
__device__ __forceinline__ ConvSeg moe_seg(const Frame& F, int idx) {
    unsigned char* wb = F.ws + WS_W0; const int e = idx / 3, k = idx - e * 3; ConvSeg s; s.col0 = 0; s.inter = 0; s.row0 = 0;
    if (k < 2) { s.src = F.in(k == 0 ? I_WEG : I_WEU) + (size_t)e * D * DEXP; s.ld = DEXP; s.K = D; s.width = DEXP; s.dst = (bf16_t*)(wb + WO_MGU) + (size_t)e * 2816 * 1024; s.row0 = k * 128; s.inter = 1; s.gain = F.in(I_GFFN) + D; }
    else { s.src = F.in(I_WED) + (size_t)e * DEXP * D; s.ld = D; s.K = DEXP; s.width = D; s.dst = (bf16_t*)(wb + WO_MD) + (size_t)e * 1024 * 1408; s.gain = nullptr; }
    return s;
}
#define CONV_LOCATE(NSEG, GETSEG, IT, SEGOUT, IDXOUT) do { int r_ = (IT); for (int si_ = 0; si_ < (NSEG); ++si_) { const ConvSeg sg_ = GETSEG; const int n_ = seg_items(sg_); SEGOUT = sg_; IDXOUT = r_; if (r_ < n_) break; r_ -= n_; } } while (0)
#define CONV_LOOP(NSEG, GETSEG) do { int total_ = 0; for (int si_ = 0; si_ < (NSEG); ++si_) { const ConvSeg sg_ = GETSEG; total_ += seg_items(sg_); } \
        int it_ = gw; if (it_ < total_) { ConvSeg cs_; int ci_ = 0; f32x4 va_[16]; CONV_LOCATE(NSEG, GETSEG, it_, cs_, ci_); conv_load(cs_, ci_, F.lane, va_); \
        for (;;) { const int nx_ = it_ + NGW; const bool hn_ = nx_ < total_; ConvSeg ns_; int ni_ = 0; f32x4 vb_[16]; CONV_LOCATE(NSEG, GETSEG, (hn_ ? nx_ : it_), ns_, ni_); conv_load(ns_, ni_, F.lane, vb_); \
            _Pragma("unroll") for (int q_ = 0; q_ < 16; ++q_) asm volatile("" : "+v"(va_[q_])); \
            conv_store(cs_, ci_, (LAS unsigned char*)scr, F.lane, va_); if (!hn_) break; \
            _Pragma("unroll") for (int q_ = 0; q_ < 16; ++q_) va_[q_] = vb_[q_]; cs_ = ns_; ci_ = ni_; it_ = nx_; } } } while (0)
__device__ __forceinline__ void fold_pool(const Frame& F, int l, int gw, int NGW) {
    const float* wp = F.in(I_WPOOL) + (size_t)l * 4 * 128 * 128; const float* ps = F.in(I_PSCALE) + l * 512; const float* wb2 = F.in(I_WBR) + (size_t)(l * 3 + 2) * 512 * D;
    bf16_t* dst = (bf16_t*)(wblk(F, l) + WO_BR) + (size_t)2 * 1024 * 512;
    for (int it = gw; it < 1024; it += NGW) {
        const int db = it & 15, g = (it >> 4) & 3, cb = it >> 6, d = db * 64 + F.lane, c0 = cb * 8;
        float a[8];
#pragma unroll
        for (int i = 0; i < 8; ++i) a[i] = 0.f;
        for (int j = 0; j < 128; ++j) {
            const float w = wb2[(size_t)(g * 128 + j) * D + d] * ps[g * 128 + j];
#pragma unroll
            for (int i = 0; i < 8; ++i) a[i] = fmaf(wp[(size_t)(g * 128 + c0 + i) * 128 + j], w, a[i]);
        }
        u32x4 o; o.x = cvt_pk_bf16(a[0], a[1]); o.y = cvt_pk_bf16(a[2], a[3]); o.z = cvt_pk_bf16(a[4], a[5]); o.w = cvt_pk_bf16(a[6], a[7]);
        *(u32x4*)(dst + (size_t)d * 512 + g * 128 + c0) = o;
    }
}

__device__ __forceinline__ void p0_prologue(Frame& F) {
    LAS float* scr = (LAS float*)(F.lds + F.wave * 16384);
    const int gw = F.vcu * 8 + F.wave, NGW = F.G * 8;
    { bf16_t* xb = (bf16_t*)(F.ws + WS_XB); float* rss = F.stats + SF_ROWSS;
      for (int m = gw; m < T; m += NGW) {
          const f32x4* xr = (const f32x4*)(F.in(I_X) + (size_t)m * D) + F.lane; float s = 0.f;
          unsigned long long* o8 = (unsigned long long*)(xb + (size_t)m * D) + F.lane;
#pragma unroll
          for (int j = 0; j < 4; ++j) { const f32x4 v = xr[64 * j]; s += (v[0] * v[0] + v[1] * v[1]) + (v[2] * v[2] + v[3] * v[3]);
              o8[64 * j] = (unsigned long long)cvt_pk_bf16(v[0], v[1]) | ((unsigned long long)cvt_pk_bf16(v[2], v[3]) << 32); }
          s = wave_sum(s); if (F.lane < 16) rss[(size_t)m * 16 + F.lane] = (F.lane == 0) ? s : 0.f;
      } }
    { float* rt = (float*)(F.ws + WS_ROPE); const int* pos = (const int*)F.in(I_POS);
      for (int i = F.vcu * 512 + F.tid; i < T * 16; i += F.G * 512) {
          const int t = i >> 4, k = i & 15; const float inv = powf(10000.f, -(float)k / 16.f), ang = (float)pos[t] * inv;
          rt[t * 32 + k] = cosf(ang); rt[t * 32 + 16 + k] = sinf(ang);
      } }
    CONV_LOOP(15, mixer_seg(F, 0, si_));
    fold_pool(F, 0, gw, NGW);
}

__device__ __forceinline__ void gla_prep(Frame& F, int l, int unit);
__device__ __forceinline__ void phase_prep(Frame& F, int l, int rpt = 0) {
    const bf16_t* raw = act_ptr(F, A_QKVRAW); const bf16_t* misc = act_ptr(F, A_MISC);
    bf16_t* QH = act_ptr(F, A_QH); bf16_t* KH = act_ptr(F, A_KH); bf16_t* VT = act_ptr(F, A_VT);
    const float* rope = (const float*)(F.ws + WS_ROPE);
    const float* gq = F.in(I_GQKQ) + l * 96; const float* gk = F.in(I_GQKK) + l * 96;
    LAS bf16_t* vt = (LAS bf16_t*)F.lds;
    for (int unit = F.vcu; unit < T / 64; unit += F.G) {
        const int t0 = unit * 64, b = t0 / SEQ, s0 = t0 % SEQ;
        if (!rpt) gla_prep(F, l, unit);
#pragma unroll 1
        for (int it = F.tid; it < 1024; it += 512) {
            const int which = it & 1, h = (it >> 1) & 7, tok = it >> 4, t = t0 + tok;
            const bf16_t* nope = raw + (size_t)t * 1792 + (which ? 768 + h * 128 : h * 96);
            const bf16_t* rp = which ? misc + (size_t)t * 256 : nope + 64;
            const float* g = which ? gk : gq;
            u32x4 c[12];
#pragma unroll
            for (int i = 0; i < 8; ++i) c[i] = *(const u32x4*)(nope + 8 * i);
#pragma unroll
            for (int i = 0; i < 4; ++i) c[8 + i] = *(const u32x4*)(rp + 8 * i);
            float ss = 0.f;
#pragma unroll
            for (int i = 0; i < 12; ++i) {
                const float a0 = bflo(c[i].x), a1 = bfhi(c[i].x), a2 = bflo(c[i].y), a3 = bfhi(c[i].y), a4 = bflo(c[i].z), a5 = bfhi(c[i].z), a6 = bflo(c[i].w), a7 = bfhi(c[i].w);
                ss += (a0 * a0 + a1 * a1) + (a2 * a2 + a3 * a3) + (a4 * a4 + a5 * a5) + (a6 * a6 + a7 * a7);
            }
            float r = rsqrtf(ss * (1.f / 96.f) + EPS);
            if (!which) r *= 0.14724444f;
            bf16_t* dst = (which ? KH : QH) + ((size_t)(b * 8 + h) * SEQ + s0 + tok) * 96;
#pragma unroll
            for (int i = 0; i < 8; ++i) {
                const f32x4 g0 = *(const f32x4*)(g + 8 * i), g1 = *(const f32x4*)(g + 8 * i + 4);
                u32x4 o; o.x = cvt_pk_bf16(bflo(c[i].x) * r * g0[0], bfhi(c[i].x) * r * g0[1]); o.y = cvt_pk_bf16(bflo(c[i].y) * r * g0[2], bfhi(c[i].y) * r * g0[3]);
                o.z = cvt_pk_bf16(bflo(c[i].z) * r * g1[0], bfhi(c[i].z) * r * g1[1]); o.w = cvt_pk_bf16(bflo(c[i].w) * r * g1[2], bfhi(c[i].w) * r * g1[3]);
                *(u32x4*)(dst + 8 * i) = o;
            }
#pragma unroll
            for (int hh = 0; hh < 2; ++hh) {
                const u32x4 x1c = c[8 + hh], x2c = c[10 + hh];
                float x1[8] = {bflo(x1c.x), bfhi(x1c.x), bflo(x1c.y), bfhi(x1c.y), bflo(x1c.z), bfhi(x1c.z), bflo(x1c.w), bfhi(x1c.w)};
                float x2[8] = {bflo(x2c.x), bfhi(x2c.x), bflo(x2c.y), bfhi(x2c.y), bflo(x2c.z), bfhi(x2c.z), bflo(x2c.w), bfhi(x2c.w)};
                float o1[8], o2[8];
#pragma unroll
                for (int i = 0; i < 8; ++i) {
                    const int k = hh * 8 + i; const float cs = rope[(size_t)t * 32 + k], sn = rope[(size_t)t * 32 + 16 + k];
                    const float a = x1[i] * r * g[64 + k], bb = x2[i] * r * g[80 + k];
                    o1[i] = a * cs - bb * sn; o2[i] = bb * cs + a * sn;
                }
                u32x4 w1, w2; w1.x = cvt_pk_bf16(o1[0], o1[1]); w1.y = cvt_pk_bf16(o1[2], o1[3]); w1.z = cvt_pk_bf16(o1[4], o1[5]); w1.w = cvt_pk_bf16(o1[6], o1[7]);
                w2.x = cvt_pk_bf16(o2[0], o2[1]); w2.y = cvt_pk_bf16(o2[2], o2[3]); w2.z = cvt_pk_bf16(o2[4], o2[5]); w2.w = cvt_pk_bf16(o2[6], o2[7]);
                *(u32x4*)(dst + 64 + hh * 8) = w1; *(u32x4*)(dst + 80 + hh * 8) = w2;
            }
        }
        {
            const int tok = F.tid >> 3, cc = F.tid & 7;
            u32x4 vr[8];
#pragma unroll
            for (int h = 0; h < 8; ++h) vr[h] = *(const u32x4*)(raw + (size_t)(t0 + tok) * 1792 + 768 + h * 128 + 64 + cc * 8);
#pragma unroll
            for (int h = 0; h < 8; ++h) *(LAS u32x4*)(F.lds + h * 9216 + tok * 144 + cc * 16) = vr[h];
            __syncthreads();
            const int db = F.wave & 3, c = (F.wave >> 2) * 4 + (F.lane >> 4), i16 = F.lane & 15;
#pragma unroll
            for (int h = 0; h < 8; ++h) {
                const LAS unsigned char* a = F.lds + h * 9216 + (8 * c + (i16 >> 2)) * 144 + (16 * db + (i16 & 3) * 4) * 2;
                const v4i16c_t lo = __builtin_amdgcn_ds_read_tr16_b64_v4i16((LAS v4i16c_t*)a), hi = __builtin_amdgcn_ds_read_tr16_b64_v4i16((LAS v4i16c_t*)(a + 4 * 144));
                typedef short s16x8_t __attribute__((ext_vector_type(8)));
                bf16_t* vrow = VT + ((size_t)(b * 8 + h) * 64 + 16 * db + i16) * SEQ + s0;
                *(v4i16c_t*)(vrow + 4 * c) = lo; *(v4i16c_t*)(vrow + 32 + 4 * c) = hi;
            }
            __syncthreads();
        }
    }
}

constexpr int AT_KROW = 208, AT_KT = 64 * AT_KROW, AT_VROW = 144, AT_VTB = 64 * AT_VROW, AT_SLOT = AT_KT + AT_VTB, AT_NSLOT = 5;
static_assert(AT_KT == 13 * 1024 && AT_VTB == 9 * 1024 && AT_NSLOT * AT_SLOT <= RING_BYTES, "attention ring");
__device__ __forceinline__ void attn_unit(Frame& F, int bh, int qb) {
    const int lane = F.lane, wid = F.wave, r32 = lane & 31, hi = lane >> 5, grp = wid >> 2;
    const bf16_t* QHp = act_ptr(F, A_QH) + ((size_t)bh * SEQ + qb * 256 + wid * 32) * 96;
    const char* Kb = (const char*)(act_ptr(F, A_KH) + (size_t)bh * SEQ * 96);
    const char* Vb = (const char*)(act_ptr(F, A_VT) + (size_t)bh * 64 * SEQ);
    LAS unsigned char* lds = F.lds;
    bf16x8 qr[6];
#pragma unroll
    for (int s = 0; s < 6; ++s) qr[s] = *(const bf16x8*)(QHp + (size_t)r32 * 96 + 16 * s + 8 * hi);
    const int NT = 4 * (qb + 1);
    const char *dp0, *dp1, *dp2;
    { const int P = 64 * wid + lane, row = P / 13, col = P % 13; dp0 = Kb + row * 192 + (col == 12 ? 0 : col) * 16; }
    if (wid < 5) { const int P = 64 * (wid + 8) + lane, row = P / 13, col = P % 13; dp1 = Kb + row * 192 + (col == 12 ? 0 : col) * 16; }
    else { const int P = 64 * (wid - 5) + lane, d = P / 9, col = P % 9; dp1 = Vb + (size_t)d * (SEQ * 2) + (col == 8 ? 0 : col) * 16; }
    { const int P = 64 * (wid + 3) + lane, d = (P / 9) & 63, col = P % 9; dp2 = Vb + (size_t)d * (SEQ * 2) + (col == 8 ? 0 : col) * 16; }
    const unsigned st1 = wid < 5 ? 12288u : 128u;
    const bool w3 = wid < 6;
#define AT_DMA(j, sl) do { LAS unsigned char* d_ = lds + (sl) * AT_SLOT + wid * 1024; \
        __builtin_amdgcn_global_load_lds((const unsigned*)(dp0 + (size_t)(j) * 12288), (LAS unsigned*)d_, 16, 0, 0); \
        __builtin_amdgcn_global_load_lds((const unsigned*)(dp1 + (size_t)(j) * st1), (LAS unsigned*)(d_ + 8192), 16, 0, 0); \
        if (w3) __builtin_amdgcn_global_load_lds((const unsigned*)(dp2 + (size_t)(j) * 128), (LAS unsigned*)(d_ + 16384), 16, 0, 0); } while (0)
#define AT_WAIT2() do { if (w3) asm volatile("s_waitcnt vmcnt(6)" ::: "memory"); else asm volatile("s_waitcnt vmcnt(4)" ::: "memory"); } while (0)
    AT_DMA(0, 0); AT_DMA(1, 1); AT_DMA(2, 2); AT_DMA(3, 3);
    if (w3) asm volatile("s_waitcnt vmcnt(9)" ::: "memory"); else asm volatile("s_waitcnt vmcnt(6)" ::: "memory");
    LDS_BARRIER();
    float m_run = 0.f, l_run = 0.f;
    f32x16 o0, o1, negm;
#pragma unroll
    for (int r = 0; r < 16; ++r) { o0[r] = 0.f; o1[r] = 0.f; negm[r] = 0.f; }
    const unsigned kfr = (unsigned)(r32 * AT_KROW + hi * 16), vfr = (unsigned)(AT_KT + r32 * AT_VROW + hi * 64);
    if (grp) LDS_BARRIER();
    int slot = 0, wslot = 4;
    const int NTw = 4 * qb + (wid >> 1) + 1;
    for (int t = 0; t < NTw; ++t) {
        const int jb = t - 4 * qb;
        const LAS unsigned char* sb = lds + slot * AT_SLOT;
        f32x16 p0, p1;
        {
            const LAS unsigned char* kb = sb + kfr;
            bf16x8 ka[6], kc[6];
#pragma unroll
            for (int s = 0; s < 6; ++s) { ka[s] = *(const LAS bf16x8*)(kb + s * 32); kc[s] = *(const LAS bf16x8*)(kb + 32 * AT_KROW + s * 32); }
            __builtin_amdgcn_sched_barrier(0);
            __builtin_amdgcn_s_setprio(1);
            p0 = __builtin_amdgcn_mfma_f32_32x32x16_bf16(ka[0], qr[0], negm, 0, 0, 0);
            p1 = __builtin_amdgcn_mfma_f32_32x32x16_bf16(kc[0], qr[0], negm, 0, 0, 0);
#pragma unroll
            for (int s = 1; s < 6; ++s) {
                p0 = __builtin_amdgcn_mfma_f32_32x32x16_bf16(ka[s], qr[s], p0, 0, 0, 0);
                p1 = __builtin_amdgcn_mfma_f32_32x32x16_bf16(kc[s], qr[s], p1, 0, 0, 0);
            }
            __builtin_amdgcn_s_setprio(0);
            asm volatile("" : "+v"(p0), "+v"(p1));
        }
        AT_WAIT2();
        LDS_BARRIER();
        AT_DMA(min(t + 4, NT - 1), wslot);
        {
            const LAS unsigned char* vb = sb + vfr;
            bf16x8 va[4], vc2[4];
#pragma unroll
            for (int s = 0; s < 4; ++s) { va[s] = *(const LAS bf16x8*)(vb + s * 16); vc2[s] = *(const LAS bf16x8*)(vb + 32 * AT_VROW + s * 16); }
            if (jb >= 0 && wid < 2 * jb + 2) {
                const int qrel = 32 * wid + r32, kb0 = 64 * jb + 4 * hi;
#pragma unroll
                for (int r = 0; r < 16; ++r) { const int kv = kb0 + (r & 3) + 8 * (r >> 2); if (kv > qrel) p0[r] = -INFINITY; if (kv + 32 > qrel) p1[r] = -INFINITY; }
            }
            float mxa = __builtin_elementwise_maximum(p0[0], p0[1]), mxb = __builtin_elementwise_maximum(p1[0], p1[1]);
#pragma unroll
            for (int r = 2; r < 16; r += 2) {
                mxa = __builtin_elementwise_maximum(__builtin_elementwise_maximum(mxa, p0[r]), p0[r + 1]);
                mxb = __builtin_elementwise_maximum(__builtin_elementwise_maximum(mxb, p1[r]), p1[r + 1]);
            }
            float mx = __builtin_elementwise_maximum(mxa, mxb);
            {
                const u32x2 sw = __builtin_amdgcn_permlane32_swap(__float_as_uint(mx), __float_as_uint(mx), false, false);
                mx = __builtin_elementwise_maximum(__uint_as_float(sw.x), __uint_as_float(sw.y));
            }
            if (t == 0 || !__all(mx <= 8.f)) {
                const float delta = t == 0 ? mx : fmaxf(mx, 0.f), alpha = t == 0 ? 1.f : __builtin_amdgcn_exp2f(-delta);
                m_run += delta; l_run *= alpha;
#pragma unroll
                for (int r = 0; r < 16; ++r) { o0[r] *= alpha; o1[r] *= alpha; p0[r] -= delta; p1[r] -= delta; negm[r] = -m_run; }
            }
            float ps = 0.f;
#pragma unroll
            for (int r = 0; r < 16; ++r) { p0[r] = __builtin_amdgcn_exp2f(p0[r]); p1[r] = __builtin_amdgcn_exp2f(p1[r]); ps += p0[r]; ps += p1[r]; }
            l_run += ps;
#pragma unroll
            for (int s = 0; s < 4; ++s) {
                u32x4 pw;
                if (s < 2) { pw.x = cvt_pk_bf16(p0[8 * s + 0], p0[8 * s + 1]); pw.y = cvt_pk_bf16(p0[8 * s + 2], p0[8 * s + 3]); pw.z = cvt_pk_bf16(p0[8 * s + 4], p0[8 * s + 5]); pw.w = cvt_pk_bf16(p0[8 * s + 6], p0[8 * s + 7]); }
                else { const int q = s - 2; pw.x = cvt_pk_bf16(p1[8 * q + 0], p1[8 * q + 1]); pw.y = cvt_pk_bf16(p1[8 * q + 2], p1[8 * q + 3]); pw.z = cvt_pk_bf16(p1[8 * q + 4], p1[8 * q + 5]); pw.w = cvt_pk_bf16(p1[8 * q + 6], p1[8 * q + 7]); }
                const bf16x8 pb = __builtin_bit_cast(bf16x8, pw);
                o0 = __builtin_amdgcn_mfma_f32_32x32x16_bf16(va[s], pb, o0, 0, 0, 0);
                o1 = __builtin_amdgcn_mfma_f32_32x32x16_bf16(vc2[s], pb, o1, 0, 0, 0);
            }
        }
        LDS_BARRIER();
        slot = slot == AT_NSLOT - 1 ? 0 : slot + 1; wslot = wslot == AT_NSLOT - 1 ? 0 : wslot + 1;
    }
    for (int t = NTw; t < NT; ++t) {
        AT_WAIT2();
        LDS_BARRIER();
        AT_DMA(min(t + 4, NT - 1), wslot);
        LDS_BARRIER();
        wslot = wslot == AT_NSLOT - 1 ? 0 : wslot + 1;
    }
    if (!grp) LDS_BARRIER();
    VM_WAIT();
#undef AT_DMA
#undef AT_WAIT2
    l_run += __shfl_xor(l_run, 32);
    const float inv = 1.f / l_run;
    const int b = bh >> 3, h = bh & 7;
    bf16_t* orow = act_ptr(F, A_YSA) + ((size_t)b * SEQ + qb * 256 + wid * 32 + r32) * 512 + h * 64;
#pragma unroll
    for (int g = 0; g < 4; ++g) {
        u32x2 w0, w1;
        w0.x = cvt_pk_bf16(o0[4 * g] * inv, o0[4 * g + 1] * inv); w0.y = cvt_pk_bf16(o0[4 * g + 2] * inv, o0[4 * g + 3] * inv);
        w1.x = cvt_pk_bf16(o1[4 * g] * inv, o1[4 * g + 1] * inv); w1.y = cvt_pk_bf16(o1[4 * g + 2] * inv, o1[4 * g + 3] * inv);
        *(u32x2*)(orow + 8 * g + 4 * hi) = w0; *(u32x2*)(orow + 32 + 8 * g + 4 * hi) = w1;
    }
}

__device__ __forceinline__ float row16_sum(float x) {
    x += __int_as_float(__builtin_amdgcn_update_dpp(0, __float_as_int(x), 0x128, 0xf, 0xf, false));
    x += __int_as_float(__builtin_amdgcn_update_dpp(0, __float_as_int(x), 0x124, 0xf, 0xf, false));
    x += __int_as_float(__builtin_amdgcn_update_dpp(0, __float_as_int(x), 0x122, 0xf, 0xf, false));
    x += __int_as_float(__builtin_amdgcn_update_dpp(0, __float_as_int(x), 0x121, 0xf, 0xf, false));
    return x;
}
__device__ __forceinline__ unsigned short f2bf1(float x) { return (unsigned short)(cvt_pk_bf16(x, 0.f) & 0xffffu); }
__device__ __forceinline__ void gla_prep(Frame& F, int l, int unit) {
    bf16_t* gqkv = act_ptr(F, A_GQKV); const bf16_t* misc = act_ptr(F, A_MISC); float* eb = F.stats + SF_EB;
    const int c = F.tid & 255, ch = unit * 2 + (F.tid >> 8);
    const float* wg = F.in(I_WGLA) + (size_t)l * 16 * 256 + c; const float bias = F.in(I_BGLA)[l * 256 + c];
    float wcol[16];
#pragma unroll
    for (int r = 0; r < 16; ++r) wcol[r] = wg[r * 256];
    float bc = 0.f;
#pragma unroll 8
    for (int i = 0; i < 32; ++i) {
        const size_t t = (size_t)ch * 32 + i;
        const u32x4 l0 = *(const u32x4*)(misc + t * 256 + 32), l1 = *(const u32x4*)(misc + t * 256 + 40);
        const float lr[16] = {bflo(l0.x), bfhi(l0.x), bflo(l0.y), bfhi(l0.y), bflo(l0.z), bfhi(l0.z), bflo(l0.w), bfhi(l0.w),
                              bflo(l1.x), bfhi(l1.x), bflo(l1.y), bfhi(l1.y), bflo(l1.z), bfhi(l1.z), bflo(l1.w), bfhi(l1.w)};
        float z = bias;
#pragma unroll
        for (int r = 0; r < 16; ++r) z = fmaf(lr[r], wcol[r], z);
        const float zl = z * 1.4426950408889634f;
        const float sp = fmaxf(-zl, 0.f) + __log2f(1.f + __builtin_amdgcn_exp2f(-fabsf(zl)));
        bc -= sp * 0.0625f;
        const float eq = __builtin_amdgcn_exp2f(bc) * 0.125f, ek = __builtin_amdgcn_exp2f(-bc);
        bf16_t* qp = gqkv + t * 1024 + c; bf16_t* kp = qp + 256;
        *qp = f2bf1(__uint_as_float((unsigned)*qp << 16) * eq);
        *kp = f2bf1(__uint_as_float((unsigned)*kp << 16) * ek);
    }
    eb[(size_t)ch * 256 + c] = __builtin_amdgcn_exp2f(bc);
}
typedef short v4i16_t __attribute__((ext_vector_type(4)));
__device__ __forceinline__ v4i16_t lds_tr16(const LAS unsigned char* p) { return __builtin_amdgcn_ds_read_tr16_b64_v4i16((LAS v4i16_t*)p); }
constexpr int GW_K = 0, GW_Q = 4608, GW_V = 9216, GW_BYTES = 10240;
__device__ __forceinline__ void gla_unit(Frame& F, int l, int unit) {
    const int half = unit & 1, h = (unit >> 1) & 3, b = unit >> 3;
    volatile LAS int* prog = (volatile LAS int*)(F.lds + 4 * GW_BYTES);
    if (F.wave >= 4) {
        const int pw = F.wave - 4, tok = F.lane & 31, li = (F.lane >> 5) + 2 * (pw & 1);
        const size_t lo_ = (li == 0) ? (size_t)h * 128 : (li == 1) ? (size_t)512 + h * 128 : (li == 2) ? (size_t)1024 + h * 256 + half * 128 : (size_t)1024 + h * 256 + half * 128 + 64;
        const unsigned char* base_ = (const unsigned char*)act_ptr(F, A_GQKV) + lo_;
        unsigned keep = 0u;
        for (int m = (pw >> 1); m < SEQ / 32; m += 2) {
            while (m > prog[0] + 8) __builtin_amdgcn_s_sleep(8);
            const unsigned char* pp = base_ + ((size_t)b * SEQ + (size_t)m * 32 + tok) * 2048;
            asm volatile("global_load_dword %0, %1, off" : "+v"(keep) : "v"(pp) : "memory");
        }
        asm volatile("s_waitcnt vmcnt(0)" : "+v"(keep) :: "memory");
        return;
    }
    const int lane = F.lane, w = half * 4 + F.wave, l15 = lane & 15, q4 = lane >> 4;
    const bf16_t* gqkv = act_ptr(F, A_GQKV); const float* ebg = F.stats + SF_EB;
    bf16_t* ysb = act_ptr(F, A_YSB);
    LAS unsigned char* wl = F.lds + F.wave * GW_BYTES;
    f32x4 S[4];
#pragma unroll
    for (int i = 0; i < 4; ++i) S[i] = (f32x4){0.f, 0.f, 0.f, 0.f};
    if (F.tid == 0) prog[0] = 0;
    constexpr int GW2 = 4 * GW_BYTES;
    u32x4 kimgX[4], qimgX[4], vimgX, kimgY[4], qimgY[4], vimgY; f32x4 ebvX[4], ebvY[4];
#define GLA_LOAD1(n_, KI, QI, VI, EBV) do { const size_t tb_ = (size_t)b * SEQ + (size_t)(n_) * 32; \
        _Pragma("unroll") for (int i = 0; i < 4; ++i) { const int p_ = lane + 64 * i; const bf16_t* r_ = gqkv + (tb_ + (p_ >> 3)) * 1024 + h * 64 + (p_ & 7) * 8; QI[i] = *(const u32x4*)r_; KI[i] = *(const u32x4*)(r_ + 256); } \
        VI = *(const u32x4*)(gqkv + (tb_ + (lane >> 1)) * 1024 + 512 + h * 128 + 16 * w + (lane & 1) * 8); \
        _Pragma("unroll") for (int db = 0; db < 4; ++db) EBV[db] = *(const f32x4*)(ebg + (tb_ >> 5) * 256 + h * 64 + 16 * db + 4 * q4); } while (0)
#define GLA_LOAD(n_) do { GLA_LOAD1((n_), kimgX, qimgX, vimgX, ebvX); GLA_LOAD1((n_) + 1, kimgY, qimgY, vimgY, ebvY); } while (0)
    bf16x8 pa0X, pa1X, vbnX, kanX[4], qpxX[2], qpyX[2], pa0Y, pa1Y, vbnY, kanY[4], qpxY[2], qpyY[2]; f32x4 o0pX, o1pX, e4X[4], o0pY, o1pY, e4Y[4];
#define GLA_IMG(WL, KI, QI, VI, EBV, E4) do { \
        _Pragma("unroll") for (int i = 0; i < 4; ++i) { asm volatile("" : "+v"(KI[i]), "+v"(QI[i]), "+v"(EBV[i])); } \
        asm volatile("" : "+v"(VI)); \
        _Pragma("unroll") for (int i = 0; i < 4; ++i) { const int p_ = lane + 64 * i; *(LAS u32x4*)((WL) + GW_K + (p_ >> 3) * 144 + (p_ & 7) * 16) = KI[i]; *(LAS u32x4*)((WL) + GW_Q + (p_ >> 3) * 144 + (p_ & 7) * 16) = QI[i]; } \
        *(LAS u32x4*)((WL) + GW_V + (lane >> 1) * 32 + (lane & 1) * 16) = VI; \
        _Pragma("unroll") for (int db = 0; db < 4; ++db) E4[db] = EBV[db]; } while (0)
#define GLA_STAGE_P(WL, PA0, PA1, VBN, KAN, QPX, QPY, O0P, O1P) do { \
        f32x4 pt00 = {0.f, 0.f, 0.f, 0.f}, pt01 = pt00, pt11 = pt00; \
        _Pragma("unroll") for (int ks = 0; ks < 2; ++ks) { \
            const bf16x8 a0 = *(const LAS bf16x8*)((WL) + GW_K + l15 * 144 + ks * 64 + q4 * 16), a1 = *(const LAS bf16x8*)((WL) + GW_K + (16 + l15) * 144 + ks * 64 + q4 * 16); \
            const bf16x8 b0 = *(const LAS bf16x8*)((WL) + GW_Q + l15 * 144 + ks * 64 + q4 * 16), b1 = *(const LAS bf16x8*)((WL) + GW_Q + (16 + l15) * 144 + ks * 64 + q4 * 16); \
            pt00 = __builtin_amdgcn_mfma_f32_16x16x32_bf16(a0, b0, pt00, 0, 0, 0); \
            pt01 = __builtin_amdgcn_mfma_f32_16x16x32_bf16(a0, b1, pt01, 0, 0, 0); \
            pt11 = __builtin_amdgcn_mfma_f32_16x16x32_bf16(a1, b1, pt11, 0, 0, 0); \
            const LAS unsigned char* q0p = (WL) + GW_Q + l15 * 144 + ks * 64 + q4 * 8; const LAS unsigned char* q1p = q0p + 16 * 144; \
            const u32x2 x0 = *(const LAS u32x2*)(q0p), x1 = *(const LAS u32x2*)(q0p + 32), y0 = *(const LAS u32x2*)(q1p), y1 = *(const LAS u32x2*)(q1p + 32); \
            QPX[ks] = __builtin_bit_cast(bf16x8, (u32x4){x0.x, x0.y, x1.x, x1.y}); QPY[ks] = __builtin_bit_cast(bf16x8, (u32x4){y0.x, y0.y, y1.x, y1.y}); } \
        _Pragma("unroll") for (int r = 0; r < 4; ++r) { if (4 * q4 + r > l15) { pt00[r] = 0.f; pt11[r] = 0.f; } } \
        PA0 = __builtin_bit_cast(bf16x8, (u32x4){cvt_pk_bf16(pt00[0], pt00[1]), cvt_pk_bf16(pt00[2], pt00[3]), 0u, 0u}); \
        PA1 = __builtin_bit_cast(bf16x8, (u32x4){cvt_pk_bf16(pt01[0], pt01[1]), cvt_pk_bf16(pt01[2], pt01[3]), cvt_pk_bf16(pt11[0], pt11[1]), cvt_pk_bf16(pt11[2], pt11[3])}); \
        const LAS unsigned char* vt_ = (WL) + GW_V + (l15 >> 2) * 32 + (l15 & 3) * 8; \
        const v4i16_t vp0 = lds_tr16(vt_ + (4 * q4) * 32), vp1 = lds_tr16(vt_ + (16 + 4 * q4) * 32); \
        const v4i16_t vn0 = lds_tr16(vt_ + (8 * q4) * 32), vn1 = lds_tr16(vt_ + (8 * q4 + 4) * 32); \
        const bf16x8 vbp = (bf16x8){vp0[0], vp0[1], vp0[2], vp0[3], vp1[0], vp1[1], vp1[2], vp1[3]}; \
        VBN = (bf16x8){vn0[0], vn0[1], vn0[2], vn0[3], vn1[0], vn1[1], vn1[2], vn1[3]}; \
        _Pragma("unroll") for (int db = 0; db < 4; ++db) { \
            const LAS unsigned char* kt = (WL) + GW_K + (8 * q4 + (l15 >> 2)) * 144 + (16 * db + (l15 & 3) * 4) * 2; \
            const v4i16_t k0 = lds_tr16(kt), k1 = lds_tr16(kt + 4 * 144); \
            KAN[db] = (bf16x8){k0[0], k0[1], k0[2], k0[3], k1[0], k1[1], k1[2], k1[3]}; } \
        O0P = __builtin_amdgcn_mfma_f32_16x16x32_bf16(PA0, vbp, (f32x4){0.f, 0.f, 0.f, 0.f}, 0, 0, 0); \
        O1P = __builtin_amdgcn_mfma_f32_16x16x32_bf16(PA1, vbp, (f32x4){0.f, 0.f, 0.f, 0.f}, 0, 0, 0); \
    } while (0)
#define GLA_STAGE_S(T0, VBN, KAN, QPX, QPY, O0P, O1P, E4) do { \
        f32x4 o0 = O0P, o1 = O1P; \
        _Pragma("unroll") for (int ks = 0; ks < 2; ++ks) { \
            const bf16x8 sb = __builtin_bit_cast(bf16x8, (u32x4){cvt_pk_bf16(S[2 * ks][0], S[2 * ks][1]), cvt_pk_bf16(S[2 * ks][2], S[2 * ks][3]), cvt_pk_bf16(S[2 * ks + 1][0], S[2 * ks + 1][1]), cvt_pk_bf16(S[2 * ks + 1][2], S[2 * ks + 1][3])}); \
            o0 = __builtin_amdgcn_mfma_f32_16x16x32_bf16(QPX[ks], sb, o0, 0, 0, 0); \
            o1 = __builtin_amdgcn_mfma_f32_16x16x32_bf16(QPY[ks], sb, o1, 0, 0, 0); } \
        _Pragma("unroll") for (int db = 0; db < 4; ++db) { S[db] = __builtin_amdgcn_mfma_f32_16x16x32_bf16(KAN[db], VBN, S[db], 0, 0, 0); S[db] = S[db] * E4[db]; } \
        _Pragma("unroll") for (int r = 0; r < 4; ++r) { const size_t ta = (T0) + 4 * q4 + r, tb2 = ta + 16; \
            ysb[ta * 512 + h * 128 + 16 * w + l15] = f2bf1(o0[r]); ysb[tb2 * 512 + h * 128 + 16 * w + l15] = f2bf1(o1[r]); } \
    } while (0)
    LAS unsigned char* wl2 = F.lds + GW2 + 64 + F.wave * GW_BYTES;
    GLA_LOAD(0);
    for (int n = 0; n < SEQ / 32; n += 2) {
        const size_t t0 = (size_t)b * SEQ + (size_t)n * 32;
        if (F.tid == 0) prog[0] = n;
        GLA_IMG(wl, kimgX, qimgX, vimgX, ebvX, e4X);
        GLA_IMG(wl2, kimgY, qimgY, vimgY, ebvY, e4Y);
        { const int nn = (n + 2 < SEQ / 32) ? n + 2 : n; GLA_LOAD(nn); }
        GLA_STAGE_P(wl, pa0X, pa1X, vbnX, kanX, qpxX, qpyX, o0pX, o1pX);
        GLA_STAGE_P(wl2, pa0Y, pa1Y, vbnY, kanY, qpxY, qpyY, o0pY, o1pY);
        GLA_STAGE_S(t0, vbnX, kanX, qpxX, qpyX, o0pX, o1pX, e4X);
        GLA_STAGE_S(t0 + 32, vbnY, kanY, qpxY, qpyY, o0pY, o1pY, e4Y);
        asm volatile("s_waitcnt lgkmcnt(0)" ::: "memory");
    }
#undef GLA_LOAD1
#undef GLA_IMG
#undef GLA_STAGE_P
#undef GLA_STAGE_S
#undef GLA_LOAD
}
__device__ __forceinline__ void gla_finalize(Frame& F, int l) {
    bf16_t* ysb = act_ptr(F, A_YSB); const bf16_t* og = act_ptr(F, A_OG);
    const float* go = F.in(I_GGLAO) + l * 128;
    for (int i = F.vcu * 512 + F.tid; i < T * 64; i += F.G * 512) {
        const int t = i >> 6, c8 = i & 63, h = c8 >> 4, v0 = (c8 & 15) * 8;
        const u32x4 o = *(const u32x4*)(ysb + (size_t)t * 512 + c8 * 8), gte = *(const u32x4*)(og + (size_t)t * 512 + c8 * 8);
        const f32x4 g0 = *(const f32x4*)(go + v0), g1 = *(const f32x4*)(go + v0 + 4);
        const float ov[8] = {bflo(o.x), bfhi(o.x), bflo(o.y), bfhi(o.y), bflo(o.z), bfhi(o.z), bflo(o.w), bfhi(o.w)};
        const float ssq = row16_sum(((ov[0] * ov[0] + ov[1] * ov[1]) + (ov[2] * ov[2] + ov[3] * ov[3])) + ((ov[4] * ov[4] + ov[5] * ov[5]) + (ov[6] * ov[6] + ov[7] * ov[7])));
        const float r = rsqrtf(ssq * (1.f / 128.f) + EPS);
        const float gv[8] = {bflo(gte.x), bfhi(gte.x), bflo(gte.y), bfhi(gte.y), bflo(gte.z), bfhi(gte.z), bflo(gte.w), bfhi(gte.w)};
        float y[8];
#pragma unroll
        for (int e = 0; e < 8; ++e) y[e] = ov[e] * r * (e < 4 ? g0[e] : g1[e - 4]) * gv[e] * fast_sigmoid(gv[e]);
        u32x4 wv; wv.x = cvt_pk_bf16(y[0], y[1]); wv.y = cvt_pk_bf16(y[2], y[3]); wv.z = cvt_pk_bf16(y[4], y[5]); wv.w = cvt_pk_bf16(y[6], y[7]);
        *(u32x4*)(ysb + (size_t)t * 512 + c8 * 8) = wv;
    }
}

template <int W> __device__ __forceinline__ void pool_rows(const bf16_t* up, bf16_t* pooled, int t0, int s0, int c8) {
    u32x4 row[8 + W - 1];
#pragma unroll
    for (int i = 0; i < 8 + W - 1; ++i) {
        const int dt = i - (W - 1);
        const bool ok = (s0 + dt) >= 0;
        const u32x4 v = *(const u32x4*)(up + (size_t)(t0 + (ok ? dt : 0)) * 512 + c8 * 8);
        row[i] = ok ? v : (u32x4){0u, 0u, 0u, 0u};
    }
#pragma unroll
    for (int k = 0; k < 8; ++k) {
        float acc[8];
#pragma unroll
        for (int e = 0; e < 8; ++e) acc[e] = 0.f;
#pragma unroll
        for (int j = 0; j < W; ++j) { const u32x4 v = row[k + W - 1 - j];
            acc[0] += bflo(v.x); acc[1] += bfhi(v.x); acc[2] += bflo(v.y); acc[3] += bfhi(v.y); acc[4] += bflo(v.z); acc[5] += bfhi(v.z); acc[6] += bflo(v.w); acc[7] += bfhi(v.w); }
        const int sk = s0 + k, n = (sk + 1 < W) ? sk + 1 : W;
        const float rn = 1.f / (float)n; const u32x4 self = row[k + W - 1];
        u32x4 o; o.x = cvt_pk_bf16(acc[0] * rn - bflo(self.x), acc[1] * rn - bfhi(self.x)); o.y = cvt_pk_bf16(acc[2] * rn - bflo(self.y), acc[3] * rn - bfhi(self.y));
        o.z = cvt_pk_bf16(acc[4] * rn - bflo(self.z), acc[5] * rn - bfhi(self.z)); o.w = cvt_pk_bf16(acc[6] * rn - bflo(self.w), acc[7] * rn - bfhi(self.w));
        *(u32x4*)(pooled + (size_t)(t0 + k) * 512 + c8 * 8) = o;
    }
}
__device__ __forceinline__ void pool_unit(Frame& F, int unit) {
    const bf16_t* up = act_ptr(F, A_UP); bf16_t* pooled = act_ptr(F, A_POOLED);
    const int g = F.wave & 3, c8 = g * 16 + (F.lane & 15), tb = (F.lane >> 4) + 4 * (F.wave >> 2);
    const int t0 = unit * 64 + tb * 8, s0 = t0 % SEQ;
    if (g == 0) pool_rows<2>(up, pooled, t0, s0, c8);
    else if (g == 1) pool_rows<4>(up, pooled, t0, s0, c8);
    else if (g == 2) pool_rows<8>(up, pooled, t0, s0, c8);
    else pool_rows<16>(up, pooled, t0, s0, c8);
}

__device__ __forceinline__ void phase_mix(Frame& F, int lq, int bx) {
    const int l = lq & 1;
#ifndef REP_DMASK
#define REP_DMASK 7
#endif
    const int dm = (lq >= 2) ? (REP_DMASK) : 7;
    if (bx < 32 && (dm & 1)) gla_unit(F, l, bx);
    unsigned* head = F.ctl + CW_QUEUE + 64 * lq;
    for (;;) {
        if (F.tid == 0) F.MISC[16] = __hip_atomic_fetch_add(head, 1u, RLX_AGENT);
        __syncthreads();
        const int idx = (int)F.MISC[16];
        __syncthreads();
        if (idx >= 512 + 256) break;
        if (idx < 512) { if (dm & 2) attn_unit(F, idx & 31, 15 - (idx >> 5)); }
        else { if (dm & 4) pool_unit(F, idx - 512); }
    }
    if (bx >= 32 && lq < 2) {
        LAS float* scr = (LAS float*)(F.lds + F.wave * 16384);
        const int gw = (bx - 32) * 8 + F.wave, NGW = (F.G - 32) * 8;
        if (l == 0) { CONV_LOOP(15, mixer_seg(F, 1, si_)); fold_pool(F, 1, gw, NGW); CONV_LOOP(3, ffn_seg(F, si_)); }
        else { CONV_LOOP(12, moe_seg(F, (si_ >> 1) * 3 + (si_ & 1))); }
    }
}

__device__ __forceinline__ void phase_route1(Frame& F) {
    const bf16_t* x = (const bf16_t*)(F.ws + WS_XB); const float* rss = F.stats + SF_ROWSS + (size_t)3 * T * 16; const float* gf = F.in(I_GFFN) + D; const float* wr = F.in(I_WROUTER);
    unsigned* route = (unsigned*)(F.ws + WS_SLOT + SL_ROUTE); unsigned* wgcnt = F.ctl + CW_WGCNT;
    LAS float* lsel = (LAS float*)(F.lds);
    LAS int* lpos = (LAS int*)(F.lds + 2048);
    for (int unit = F.vcu; unit < T / 64; unit += F.G) {
        for (int k = 0; k < 8; ++k) {
            const int tok = F.wave * 8 + k, t = unit * 64 + tok;
            float lg[8];
#pragma unroll
            for (int e = 0; e < 8; ++e) lg[e] = 0.f;
#pragma unroll
            for (int j = 0; j < 2; ++j) {
                const int c = 8 * F.lane + 512 * j;
                const u32x4 xr = *(const u32x4*)(x + (size_t)t * D + c);
                const f32x4 ga = *(const f32x4*)(gf + c), gb = *(const f32x4*)(gf + c + 4);
                const float xv[8] = {bflo(xr.x) * ga[0], bfhi(xr.x) * ga[1], bflo(xr.y) * ga[2], bfhi(xr.y) * ga[3], bflo(xr.z) * gb[0], bfhi(xr.z) * gb[1], bflo(xr.w) * gb[2], bfhi(xr.w) * gb[3]};
#pragma unroll
                for (int q = 0; q < 8; ++q) {
                    const float xg = xv[q];
                    const f32x4 w0 = *(const f32x4*)(wr + (size_t)(c + q) * 8), w1 = *(const f32x4*)(wr + (size_t)(c + q) * 8 + 4);
                    lg[0] = fmaf(xg, w0[0], lg[0]); lg[1] = fmaf(xg, w0[1], lg[1]); lg[2] = fmaf(xg, w0[2], lg[2]); lg[3] = fmaf(xg, w0[3], lg[3]);
                    lg[4] = fmaf(xg, w1[0], lg[4]); lg[5] = fmaf(xg, w1[1], lg[5]); lg[6] = fmaf(xg, w1[2], lg[6]); lg[7] = fmaf(xg, w1[3], lg[7]);
                }
            }
            const float rs = rsqrtf(sum16(rss + (size_t)t * 16) * (1.f / 1024.f) + EPS);
#pragma unroll
            for (int e = 0; e < 8; ++e) lg[e] = wave_sum(lg[e]) * rs;
            int i1 = 0; float v1 = lg[0];
#pragma unroll
            for (int e = 1; e < 8; ++e) if (lg[e] > v1) { v1 = lg[e]; i1 = e; }
            int i2 = -1; float v2 = -INFINITY;
#pragma unroll
            for (int e = 0; e < 8; ++e) if (e != i1 && lg[e] > v2) { v2 = lg[e]; i2 = e; }
            const float e2 = __expf(v2 - v1), w1 = 1.f / (1.f + e2), w2 = e2 / (1.f + e2);
            if (F.lane == 0) { lsel[tok * 4 + 0] = __int_as_float(i1); lsel[tok * 4 + 1] = __int_as_float(i2); lsel[tok * 4 + 2] = w1; lsel[tok * 4 + 3] = w2; }
        }
        __syncthreads();
        if (F.tid < 8) {
            int cnt = 0;
            for (int tok = 0; tok < 64; ++tok) {
                const int e1 = __float_as_int(lsel[tok * 4 + 0]), e2 = __float_as_int(lsel[tok * 4 + 1]);
                if (e1 == F.tid) { lpos[tok * 2 + 0] = cnt; ++cnt; }
                if (e2 == F.tid) { lpos[tok * 2 + 1] = cnt; ++cnt; }
            }
            wgcnt[unit * 8 + F.tid] = (unsigned)cnt;
        }
        __syncthreads();
        if (F.tid < 64) {
            const int t = unit * 64 + F.tid;
            u32x4 a, b2;
            a.x = (unsigned)__float_as_int(lsel[F.tid * 4 + 0]); a.y = (unsigned)__float_as_int(lsel[F.tid * 4 + 1]); a.z = __float_as_uint(lsel[F.tid * 4 + 2]); a.w = __float_as_uint(lsel[F.tid * 4 + 3]);
            b2.x = (unsigned)lpos[F.tid * 2 + 0]; b2.y = (unsigned)lpos[F.tid * 2 + 1]; b2.z = 0u; b2.w = 0u;
            *(u32x4*)(route + (size_t)t * 8) = a; *(u32x4*)(route + (size_t)t * 8 + 4) = b2;
        }
        __syncthreads();
    }
}
__device__ __forceinline__ void moe_geometry(Frame& F, int unit, LAS int* geo) {
    const unsigned* wgcnt = F.ctl + CW_WGCNT;
    if (F.tid < 8) {
        int tot = 0, pre = 0;
        for (int c = 0; c < 256; ++c) { const int v = (int)wgcnt[c * 8 + F.tid]; if (c < unit) pre += v; tot += v; }
        geo[9 + F.tid] = tot; geo[17 + F.tid] = pre;
    }
    __syncthreads();
    if (F.tid == 0) { int acc = 0; for (int e = 0; e < 8; ++e) { geo[e] = acc; acc += (geo[9 + e] + 255) >> 8; } geo[8] = acc; }
    __syncthreads();
}
__device__ __forceinline__ void phase_route2(Frame& F) {
    const unsigned* route = (const unsigned*)(F.ws + WS_SLOT + SL_ROUTE);
    int* slot_tok = (int*)(F.ws + WS_SLOT + SL_TOK); float* slot_scale = (float*)(F.ws + WS_SLOT + SL_SCALE); float* slot_comb = (float*)(F.ws + WS_SLOT + SL_COMB);
    const float* rss = F.stats + SF_ROWSS + (size_t)3 * T * 16;
    const bf16_t* xb = (const bf16_t*)(F.ws + WS_XB); bf16_t* xg = act_ptr(F, A_XG);
    LAS int* geo = (LAS int*)(F.lds);
    for (int unit = F.vcu; unit < T / 64; unit += F.G) {
        moe_geometry(F, unit, geo);
        for (int k = 0; k < 16; ++k) {
            const int rix = F.wave * 16 + k, tok = rix >> 1, ch = rix & 1, t = unit * 64 + tok;
            const unsigned e = route[(size_t)t * 8 + ch], pos = route[(size_t)t * 8 + 4 + ch];
            const float w = __uint_as_float(route[(size_t)t * 8 + 2 + ch]);
            const int slot = geo[e] * 256 + geo[17 + e] + (int)pos;
            const u32x4* src = (const u32x4*)(xb + (size_t)t * D); u32x4* dst = (u32x4*)(xg + (size_t)slot * D);
            dst[F.lane] = src[F.lane]; dst[64 + F.lane] = src[64 + F.lane];
            if (F.lane == 0) { ((int*)(F.ws + WS_TSLOT))[t * 2 + ch] = slot; slot_tok[slot] = t; slot_scale[slot] = rsqrtf(sum16(rss + (size_t)t * 16) * (1.f / 1024.f) + EPS); slot_comb[slot] = w; }
        }
        if (unit == 0) {
            for (int e = 0; e < 8; ++e) { const int s0 = geo[e] * 256 + geo[9 + e], s1 = geo[e + 1] * 256;
                for (int s = s0 + F.tid; s < s1; s += 512) { slot_tok[s] = -1; slot_scale[s] = 0.f; slot_comb[s] = 0.f; } }
        }
        __syncthreads();
    }
}

struct Args { const void* in[25]; float* out; unsigned char* ws; int ph_lo, ph_hi, li, pad; };
constexpr int NPHASE = 22;
#ifndef PH_MASK
#define PH_MASK 0xFFF
#endif
#define PON(b) (((PH_MASK) >> (b)) & 1)

__global__ void __launch_bounds__(512, 2) mega_fwd(Args args) {
    extern __shared__ __attribute__((aligned(16))) unsigned char lds_raw[];
    Frame F;
    F.lds = (LAS unsigned char*)lds_raw;
    F.MISC = (volatile LAS unsigned*)(F.lds + MISC_OFF);
    F.tid = threadIdx.x; F.lane = F.tid & 63; F.wave = __builtin_amdgcn_readfirstlane(F.tid >> 6);
    F.G = gridDim.x; { const int bx = blockIdx.x; F.vcu = (F.G % 8 == 0) ? (bx % 8) * (F.G / 8) + bx / 8 : bx; }
    { const CAS Args* ap0 = (const CAS Args*)__builtin_amdgcn_kernarg_segment_ptr(); F.ws = ap0->ws; F.ctl = (unsigned*)(F.ws + WS_CTL); F.ctlf = (float*)(F.ws + WS_CTL); F.stats = (float*)(F.ws + WS_STATS); }
    F.inp = nullptr; F.out = nullptr;
    for (int u = F.tid; u < (LDS_BYTES - LDSCTL_OFF) / 4; u += 512) ((LAS unsigned*)(F.lds + LDSCTL_OFF))[u] = 0u;
    __syncthreads();
    XcdBarrier bar = xcd_barrier_post(F.ctl + CW_BAR + args.li * XCD_BAR_WORDS, F.MISC + 8);
    const int lo = args.ph_lo, hi = args.ph_hi;
    const int cblk0 = (int)blockIdx.x, wave0 = F.wave, vcu0 = F.vcu, G0 = F.G;
#ifndef REP_MASK
#define REP_MASK 0
#endif
#pragma unroll 1
    for (int ph2 = 2 * lo; ph2 < 2 * hi; ++ph2) {
        const int ph = ph2 >> 1, rpt = ph2 & 1;
        if (rpt && !((REP_MASK >> ph) & 1)) continue;
        int cblk = cblk0; { int wv_ = wave0, vc_ = vcu0, g_ = G0; asm volatile("" : "+s"(wv_), "+s"(vc_), "+s"(g_), "+s"(cblk)); F.wave = wv_; F.vcu = vc_; F.G = g_; }
        { int ln_; asm volatile("v_mbcnt_lo_u32_b32 %0, -1, 0\n\tv_mbcnt_hi_u32_b32 %0, -1, %0" : "=v"(ln_)); F.lane = ln_; F.tid = F.wave * 64 + ln_; }
        { const CAS Args* ap = (const CAS Args*)__builtin_amdgcn_kernarg_segment_ptr(); asm volatile("" : "+s"(ap)); F.inp = ap->in; F.out = ap->out; unsigned char* w_ = ap->ws; F.ws = w_; F.ctl = (unsigned*)(w_ + WS_CTL); F.ctlf = (float*)(w_ + WS_CTL); F.stats = (float*)(w_ + WS_STATS); }
        const int l = ph >= 10 ? 1 : 0, q = ph == 0 ? -1 : (l ? ph - 10 : ph - 1);
        unsigned char* wb = wblk(F, l);
        float* ssq = F.stats + SF_SSQ + (size_t)l * 2 * T * 4;
        const float* rss_in = F.stats + SF_ROWSS + (size_t)(l == 0 ? 0 : 2) * T * 16;
        float* rss_mid = F.stats + SF_ROWSS + (size_t)(l == 0 ? 1 : 3) * T * 16;
        if (q == -1) {
            if (PON(11)) p0_prologue(F);
        } else if (q == 0 && PON(0)) {
            pg8::SchedGrid S{(const char*)(F.ws + WS_XB), (const char*)(wb + WO_IN), (size_t)256 * 1024 * 2, (size_t)256 * 1024 * 2, 0, 64, 11, F.G, cblk, 1 << 30};
            { pg8::Unit u0; if (S.next(0, u0)) fill_rs(F, rss_in, u0.pm); }
            pg8::EpiProj E{act_ptr(F, A_CQKV), act_ptr(F, A_GQKV), act_ptr(F, A_OG), act_ptr(F, A_UP), act_ptr(F, A_MISC), (const LAS float*)(F.lds + RS_OFF), ssq};
            pg8::gemm_phase<pg8::EpiProj, pg8::SchedGrid, true, true>(F.lds, F.wave, 1024, 1024, S, E);
        } else if (q == 1 && PON(1)) {
            pg8::SchedGrid S{(const char*)act_ptr(F, A_CQKV), (const char*)(wb + WO_UP), (size_t)256 * 512 * 2, (size_t)256 * 256 * 2, (size_t)256 * 2, 64, 7, F.G, cblk, 3};
            pg8::EpiUp E{act_ptr(F, A_QKVRAW), ssq};
            pg8::gemm_phase<pg8::EpiUp, pg8::SchedGrid, true, true>(F.lds, F.wave, 512, 256, S, E);
        } else if (q == 2 && PON(2)) {
            phase_prep(F, l, rpt);
        } else if (q == 3 && PON(3)) {
            phase_mix(F, l + 2 * rpt, cblk);
        } else if (q == 4 && PON(4)) {
            pg8::SchedGrid S{(const char*)(F.ws + WS_XB), (const char*)(wb + WO_G), (size_t)256 * 1024 * 2, (size_t)256 * 1024 * 2, 0, 64, 12, F.G, cblk, 1 << 30};
            { pg8::Unit u0; if (S.next(0, u0)) fill_rs(F, rss_in, u0.pm); }
            pg8::EpiGate E{F.ws + WS_ACTS, (const LAS float*)(F.lds + RS_OFF)};
            pg8::gemm_phase<pg8::EpiGate, pg8::SchedGrid, true, true>(F.lds, F.wave, 1024, 1024, S, E);
            if (!rpt) gla_finalize(F, l);
        } else if (q == 5 && PON(5)) {
            pg8::SchedMerge S{(const char*)(F.ws + WS_ACTS), (const char*)(wb + WO_BR), F.G, cblk};
            pg8::EpiMerge E{F.ws + WS_ACTS, act_ptr(F, A_MERGED)};
            pg8::gemm_phase<pg8::EpiMerge, pg8::SchedMerge, true, true>(F.lds, F.wave, 512, 512, S, E);
        } else if (q == 6 && PON(6)) {
            pg8::SchedGrid S{(const char*)act_ptr(F, A_MERGED), (const char*)(wb + WO_OUT), (size_t)256 * 1024 * 2, (size_t)256 * 1024 * 2, 0, 64, 4, F.G, cblk, 1 << 30, MERGED_HI_DELTA};
            pg8::EpiResid E{(bf16_t*)(F.ws + WS_XB), rss_mid};
            pg8::gemm_phase<pg8::EpiResid, pg8::SchedGrid, true, true>(F.lds, F.wave, 1024, 1024, S, E);
        } else if (l == 0 && q == 7 && PON(7)) {
            pg8::SchedGrid S{(const char*)(F.ws + WS_XB), (const char*)(wb + WO_FGU), (size_t)256 * 1024 * 2, (size_t)256 * 1024 * 2, 0, 64, 22, F.G, cblk, 1 << 30};
            if (F.G == 256) S.split_from = 1280;
            { pg8::Unit u0; if (S.next(0, u0)) fill_rs(F, rss_mid, u0.pm); }
            pg8::EpiSwiglu<false> E{act_ptr(F, A_ACT), DFF, (const LAS float*)(F.lds + RS_OFF), nullptr, nullptr};
            pg8::gemm_phase<pg8::EpiSwiglu<false>, pg8::SchedGrid, true, true>(F.lds, F.wave, 1024, 1024, S, E);
        } else if (l == 0 && q == 8 && PON(8)) {
            pg8::SchedGrid S{(const char*)act_ptr(F, A_ACT), (const char*)(wb + WO_FD), (size_t)256 * DFF * 2, (size_t)256 * DFF * 2, 0, 64, 4, F.G, cblk, 1 << 30};
            pg8::EpiResid E{(bf16_t*)(F.ws + WS_XB), F.stats + SF_ROWSS + (size_t)2 * T * 16};
            pg8::gemm_phase<pg8::EpiResid, pg8::SchedGrid, true, true>(F.lds, F.wave, DFF, DFF, S, E);
        } else if (q == 7 && PON(9)) {
            phase_route1(F);
            __syncthreads();
            LAS float* scr = (LAS float*)(F.lds + F.wave * 16384);
            const int gw = F.vcu * 8 + F.wave, NGW = F.G * 8;
            CONV_LOOP(12, moe_seg(F, (si_ < 4) ? (6 + (si_ >> 1)) * 3 + (si_ & 1) : (si_ - 4) * 3 + 2));
        } else if (q == 8 && PON(9)) {
            phase_route2(F);
        } else if (q == 9 && PON(10)) {
            unsigned char* wm = F.ws + WS_W0;
            LAS int* geo = (LAS int*)(F.lds + RING_BYTES + 512);
            moe_geometry(F, 0, geo);
            pg8::SchedMoe S; S.A = (const char*)act_ptr(F, A_XG); S.B = (const char*)(wm + WO_MGU); S.a_tile = (size_t)256 * 1024 * 2; S.b_tile = (size_t)256 * 1024 * 2; S.b_exp = (size_t)2816 * 1024 * 2;
            S.nN = 11; S.G = F.G; S.c = cblk;
            S.t1 = __builtin_amdgcn_readfirstlane(geo[1]); S.t2 = __builtin_amdgcn_readfirstlane(geo[2]); S.t3 = __builtin_amdgcn_readfirstlane(geo[3]); S.t4 = __builtin_amdgcn_readfirstlane(geo[4]);
            S.t5 = __builtin_amdgcn_readfirstlane(geo[5]); S.t6 = __builtin_amdgcn_readfirstlane(geo[6]); S.t7 = __builtin_amdgcn_readfirstlane(geo[7]); S.MT = __builtin_amdgcn_readfirstlane(geo[8]);
            pg8::EpiSwiglu<true> E{act_ptr(F, A_ACTE), DEXP, (const LAS float*)nullptr, (const float*)(F.ws + WS_SLOT + SL_SCALE), (const float*)(F.ws + WS_SLOT + SL_COMB)};
            pg8::gemm_phase<pg8::EpiSwiglu<true>, pg8::SchedMoe, true, true>(F.lds, F.wave, 1024, 1024, S, E);
        } else if (q == 10 && PON(10)) {
            unsigned char* wm = F.ws + WS_W0;
            LAS int* geo = (LAS int*)(F.lds + RING_BYTES + 512);
            moe_geometry(F, 0, geo);
            pg8::SchedMoe S; S.A = (const char*)act_ptr(F, A_ACTE); S.B = (const char*)(wm + WO_MD); S.a_tile = (size_t)256 * DEXP * 2; S.b_tile = (size_t)256 * DEXP * 2; S.b_exp = (size_t)1024 * DEXP * 2;
            S.nN = 4; S.G = F.G; S.c = cblk;
            S.t1 = __builtin_amdgcn_readfirstlane(geo[1]); S.t2 = __builtin_amdgcn_readfirstlane(geo[2]); S.t3 = __builtin_amdgcn_readfirstlane(geo[3]); S.t4 = __builtin_amdgcn_readfirstlane(geo[4]);
            S.t5 = __builtin_amdgcn_readfirstlane(geo[5]); S.t6 = __builtin_amdgcn_readfirstlane(geo[6]); S.t7 = __builtin_amdgcn_readfirstlane(geo[7]); S.MT = __builtin_amdgcn_readfirstlane(geo[8]);
            pg8::EpiMoeDown E{act_ptr(F, A_Y)};
            pg8::gemm_phase<pg8::EpiMoeDown, pg8::SchedMoe, true, true>(F.lds, F.wave, DEXP, DEXP, S, E);
        }
        else if (q == 11) {
            const int* tslot = (const int*)(F.ws + WS_TSLOT); const bf16_t* y = act_ptr(F, A_Y);
            for (int t = F.vcu * 8 + F.wave; t < T; t += F.G * 8) {
                const int s0 = tslot[t * 2], s1 = tslot[t * 2 + 1];
                f32x4* xo = (f32x4*)(F.out + (size_t)t * D) + F.lane * 2;
                const bf16_t* xbr = (const bf16_t*)(F.ws + WS_XB) + (size_t)t * D;
#pragma unroll
                for (int j = 0; j < 2; ++j) {
                    const u32x4 a = *((const u32x4*)(y + (size_t)s0 * D) + 64 * j + F.lane), bq = *((const u32x4*)(y + (size_t)s1 * D) + 64 * j + F.lane);
                    const u32x4 xv = *((const u32x4*)xbr + 64 * j + F.lane);
                    f32x4 x0 = {bflo(xv.x), bfhi(xv.x), bflo(xv.y), bfhi(xv.y)}, x1 = {bflo(xv.z), bfhi(xv.z), bflo(xv.w), bfhi(xv.w)};
                    x0[0] += bflo(a.x) + bflo(bq.x); x0[1] += bfhi(a.x) + bfhi(bq.x); x0[2] += bflo(a.y) + bflo(bq.y); x0[3] += bfhi(a.y) + bfhi(bq.y);
                    x1[0] += bflo(a.z) + bflo(bq.z); x1[1] += bfhi(a.z) + bfhi(bq.z); x1[2] += bflo(a.w) + bflo(bq.w); x1[3] += bfhi(a.w) + bfhi(bq.w);
                    xo[128 * j] = x0; xo[128 * j + 1] = x1;
                }
            }
        }
        if (ph + 1 < hi || (!rpt && ((REP_MASK >> ph) & 1))) xcd_barrier(bar);
    }
}


#ifdef DBG_PH
__global__ void dbg_dump(const unsigned char* ws, float* out) {
    const size_t i = (size_t)blockIdx.x * 256 + threadIdx.x;
    float v = 0.f;
    const bf16_t* a0 = (const bf16_t*)(ws + WS_ACTS + DBG_A0); const bf16_t* a1 = (const bf16_t*)(ws + WS_ACTS + DBG_A1);
    if (i < (size_t)DBG_N0) v += __uint_as_float((unsigned)a0[i] << 16);
    if (i < (size_t)DBG_N1) v += 3.f * __uint_as_float((unsigned)a1[i] << 16);
    out[i] = v;
}
#endif

extern "C" void kernel_launch(void* const* d_in, const int* in_sizes, int n_in, void* d_out, int out_size, void* d_ws, size_t ws_size, hipStream_t stream) {
    static int grid = 0;
    if (grid == 0) {
        if (n_in != 25 || out_size != T * D || ws_size < WS_END) { fprintf(stderr, "kernel_launch: unexpected sizes (n_in %d out %d ws %zu)\n", n_in, out_size, ws_size); grid = -1; return; }
        int dev = 0, cus = 0;
        if (hipGetDevice(&dev) != hipSuccess || hipDeviceGetAttribute(&cus, hipDeviceAttributeMultiprocessorCount, dev) != hipSuccess) { grid = -1; return; }
        if (hipFuncSetAttribute((const void*)mega_fwd, hipFuncAttributeMaxDynamicSharedMemorySize, LDS_BYTES) != hipSuccess) { grid = -1; return; }
        int per_cu = 0;
        (void)hipOccupancyMaxActiveBlocksPerMultiprocessor(&per_cu, (const void*)mega_fwd, 512, LDS_BYTES);
        (void)hipGetLastError();
        grid = cus;
    }
    if (grid < 0) return;
    (void)hipMemsetAsync((char*)d_ws + WS_CTL, 0, CTL_BYTES, stream);
    Args a{};
    for (int i = 0; i < 25; ++i) a.in[i] = d_in[i];
    a.out = (float*)d_out; a.ws = (unsigned char*)d_ws; a.ph_lo = 0; a.ph_hi = NPHASE; a.li = 0; a.pad = 0;
#ifdef DBG_PH
    a.ph_hi = DBG_PH;
#endif
    void* kargs[] = {&a};
    hipError_t e = hipLaunchCooperativeKernel((const void*)mega_fwd, dim3(grid), dim3(512), kargs, LDS_BYTES, stream);
    if (e != hipSuccess) fprintf(stderr, "cooperative launch failed: %s (grid %d)\n", hipGetErrorString(e), grid);
#ifdef DBG_PH
    hipLaunchKernelGGL(dbg_dump, dim3(T * 1024 / 256), dim3(256), 0, stream, (const unsigned char*)d_ws, (float*)d_out);
#endif
}
```

```cpp
#include <hip/hip_runtime.h>
#include <cstdint>
#include <cstdio>

#define LAS __attribute__((address_space(3)))
#define CAS __attribute__((address_space(4)))
typedef const void* GPtr;
typedef unsigned short bf16_t;
typedef short bf16x8 __attribute__((ext_vector_type(8)));
typedef float f32x4 __attribute__((ext_vector_type(4)));
typedef float f32x16 __attribute__((ext_vector_type(16)));
typedef unsigned u32x4 __attribute__((ext_vector_type(4)));
typedef unsigned u32x2 __attribute__((ext_vector_type(2)));

constexpr int T = 16384, SEQ = 4096, NB = 4, D = 1024, DIN = 5680, DFF = 2816, DEXP = 1408, NEXP = 8;
constexpr int NPROJ = 2816;
constexpr float EPS = 1e-6f;
constexpr int MAXSLOT = 34816;

constexpr size_t MiB = 1u << 20;
constexpr size_t WS_CTL = 0, CTL_BYTES = 128 * 1024;
constexpr size_t WS_SLOT = 2 * MiB;
constexpr size_t WS_ROPE = 3 * MiB;
constexpr size_t WS_XB = 5 * MiB;
constexpr size_t WS_W1 = 37 * MiB;
constexpr size_t WS_W0 = 55 * MiB;
constexpr size_t WS_ACTS = 89 * MiB;
constexpr size_t WS_STATS = 283 * MiB;
constexpr size_t WS_END = 291 * MiB;
constexpr size_t WO_IN = 0, WO_G = 5632 * 1024, WO_UP = WO_G + 6 * MiB, WO_BR = WO_UP + 1792 * 256 * 2, WO_OUT = WO_BR + 3 * MiB, WO_FGU = WO_OUT + 2 * MiB, WO_FD = WO_FGU + 11 * MiB;
constexpr size_t WO_MGU = 0, WO_MD = 44 * MiB;
constexpr size_t A_OG = 0, A_GQKV = 16 * MiB, A_UP = 48 * MiB, A_MISC = 64 * MiB, A_CQKV = 72 * MiB, A_VT = 72 * MiB, A_QKVRAW = 88 * MiB;
constexpr size_t A_YSA = 96 * MiB, A_POOLED = 112 * MiB, A_YSB = 128 * MiB, A_QH = 144 * MiB, A_KH = 168 * MiB;
constexpr size_t A_G0 = 16 * MiB, A_G1 = 48 * MiB, A_G2 = 144 * MiB, A_ACT = 0;
constexpr size_t A_MERGED = 0;
constexpr long long MERGED_HI_DELTA = (long long)(64 * MiB);
constexpr size_t A_XG = 32 * MiB, A_ACTE = 100 * MiB, A_Y = 32 * MiB;
constexpr int CW_TMO = 0, CW_BAR = 4096, CW_QUEUE = 16384, CW_WGCNT = 20480;
static_assert((size_t)(CW_WGCNT + 2048) * 4 <= CTL_BYTES, "ctl");
constexpr size_t SF_SSQ = 0;
constexpr size_t SF_ROWSS = (size_t)2 * 2 * T * 4;
constexpr size_t SF_OSS = SF_ROWSS + (size_t)4 * T * 16;
constexpr size_t SF_EB = SF_OSS + (size_t)T * 32;
static_assert((SF_EB + (size_t)(T / 32) * 256) * 4 <= 8 * MiB, "stats");
constexpr size_t SL_TOK = 0, SL_SCALE = 139264, SL_COMB = 2 * 139264, SL_ROUTE = 3 * 139264;
constexpr size_t WS_TSLOT = 1 * MiB;

constexpr int RING_BYTES = 131072, LDSCTL_OFF = RING_BYTES, MISC_OFF = LDSCTL_OFF + 320, LDS_BYTES = 147456;
constexpr int RS_OFF = RING_BYTES + 1024;

#define LDS_WAIT() asm volatile("s_waitcnt lgkmcnt(0)" ::: "memory")
#define VM_WAIT() asm volatile("s_waitcnt vmcnt(0)" ::: "memory")
#define LDS_BARRIER() do { asm volatile("s_waitcnt lgkmcnt(0)" ::: "memory"); __builtin_amdgcn_s_barrier(); asm volatile("" ::: "memory"); } while (0)
#define RLX_AGENT __ATOMIC_RELAXED, __HIP_MEMORY_SCOPE_AGENT
typedef float f32x2_t __attribute__((ext_vector_type(2))); typedef __bf16 bf16x2_t __attribute__((ext_vector_type(2)));
__device__ __forceinline__ unsigned cvt_pk_bf16(float lo, float hi) { f32x2_t v = {lo, hi}; bf16x2_t b = __builtin_convertvector(v, bf16x2_t); return __builtin_bit_cast(unsigned, b); }
__device__ __forceinline__ float bflo(unsigned u) { return __uint_as_float(u << 16); }
__device__ __forceinline__ float bfhi(unsigned u) { return __uint_as_float(u & 0xffff0000u); }
__device__ __forceinline__ float wave_sum(float v) {
#pragma unroll
    for (int o = 1; o < 64; o <<= 1) v += __shfl_xor(v, o);
    return v;
}
__device__ __forceinline__ float sum16(const float* p) { const f32x4 a = *(const f32x4*)p, b = *(const f32x4*)(p + 4), c = *(const f32x4*)(p + 8), d = *(const f32x4*)(p + 12);
    return (((a[0] + a[1]) + (a[2] + a[3])) + ((b[0] + b[1]) + (b[2] + b[3]))) + (((c[0] + c[1]) + (c[2] + c[3])) + ((d[0] + d[1]) + (d[2] + d[3]))); }
__device__ __forceinline__ float sum4(const float* p) { const f32x4 a = *(const f32x4*)p; return (a[0] + a[1]) + (a[2] + a[3]); }
__device__ __forceinline__ float fast_sigmoid(float z) { return __builtin_amdgcn_rcpf(1.f + __builtin_amdgcn_exp2f(-1.4426950408889634f * z)); }

namespace pg8 {
constexpr int BM = 256, BK = 64, HALF = 128, HTB = HALF * BK * 2, STAGE_BYTES = 8 * HTB, NXCD = 8, WGM = 8;
__host__ __device__ __forceinline__ int lds_byte(int r, int c) { const int st = (r >> 4) * 2 + (c >> 5), rr = r & 15, cc = c & 31, ob = rr * 64 + cc * 2; return st * 1024 + (ob ^ (((ob >> 9) & 1) << 5)); }
__host__ __device__ __forceinline__ void stage_rc(int b, int& R, int& C) { const int st = b / 1024, sb = b % 1024, swz = sb ^ (((sb >> 9) & 1) << 5); R = (st >> 1) * 16 + swz / 64; C = (st & 1) * 32 + (swz % 64) / 2; }
__host__ __device__ __forceinline__ int perm32(int rho) { const int n = rho >> 4, i = rho & 15; return 8 * (i >> 2) + 4 * n + (i & 3); }

struct Unit { const char* a; const char* b; int pm, pn, kind, half; };
__device__ __forceinline__ void tile_map(int L, int nM, int nN, int& pm, int& pn) {
    const int nwg = nM * nN; int wgid = L;
    { const int q = nwg / NXCD, r = nwg % NXCD, xcd = wgid % NXCD, off = wgid / NXCD; wgid = (xcd < r ? xcd * (q + 1) : r * (q + 1) + (xcd - r) * q) + off; }
    const int nig = WGM * nN, gid = wgid / nig, fm = gid * WGM, gsz = (nM - fm) < WGM ? (nM - fm) : WGM;
    pm = fm + ((wgid % nig) % gsz); pn = (wgid % nig) / gsz;
}

template <class Epi, class Sched, bool ALIGN_EPI, bool SP2>
__device__ __forceinline__ void gemm_phase(LAS unsigned char* lds, const int wave_in, const int lda, const int K, const Sched& S, const Epi& E) {
    int ln_; asm volatile("v_mbcnt_lo_u32_b32 %0, -1, 0\n\tv_mbcnt_hi_u32_b32 %0, -1, %0" : "=v"(ln_));
    const int tid = wave_in * 64 + ln_, wid = __builtin_amdgcn_readfirstlane(tid >> 6), lane = tid & 63, wr = wid >> 2, wc = wid & 3, fr = lane & 15, fq = lane >> 4;
    const int nt = K / BK;
    unsigned voffA[2], voffB[2];
#pragma unroll
    for (int i = 0; i < 2; ++i) { int R, C; stage_rc(tid * 16 + i * 8192, R, C); const int Rb = Epi::PERM ? ((R & ~31) + perm32(R & 31)) : R;
        voffA[i] = (unsigned)(R * lda + C) * 2u; voffB[i] = (unsigned)(Rb * K + C) * 2u; }
    const size_t kstep = (size_t)(BK * 2);
    const size_t hstepA = (size_t)HALF * lda * 2, hstepB = (size_t)HALF * K * 2;
    const unsigned ldsw = (unsigned)wid * 1024u;
    const int aoff = lds_byte(wr * 64 + fr, fq * 8), boff = lds_byte(wc * 32 + fr, fq * 8);
#define PG8_SA(b, h) (((b) * 2 + (h)) * HTB)
#define PG8_SB(b, h) ((4 + (b) * 2 + (h)) * HTB)
#define PG8_STAGE(bufoff, gbase, voff) do { _Pragma("unroll") for (int _i = 0; _i < 2; ++_i) \
        __builtin_amdgcn_global_load_lds((const unsigned*)((const char*)(gbase) + (voff)[_i]), (LAS unsigned*)(lds + (bufoff) + ldsw + _i * 8192), 16, 0, 0); } while (0)
#define PG8_LDA(dst, b, h) do { _Pragma("unroll") for (int m = 0; m < 4; ++m) _Pragma("unroll") for (int k = 0; k < 2; ++k) dst[m][k] = *(const LAS bf16x8*)(lds + PG8_SA(b, h) + aoff + m * 2048 + k * 1024); } while (0)
#define PG8_LDB(dst, b, h) do { _Pragma("unroll") for (int n = 0; n < 2; ++n) _Pragma("unroll") for (int k = 0; k < 2; ++k) dst[n][k] = *(const LAS bf16x8*)(lds + PG8_SB(b, h) + boff + n * 2048 + k * 1024); } while (0)
#define PG8_MMA(ai, bj, At, Bt) do { __builtin_amdgcn_s_setprio(1); _Pragma("unroll") for (int m = 0; m < 4; ++m) _Pragma("unroll") for (int n = 0; n < 2; ++n) _Pragma("unroll") for (int k = 0; k < 2; ++k) \
        acc[ai][bj][m][n] = __builtin_amdgcn_mfma_f32_16x16x32_bf16(Bt[n][k], At[m][k], acc[ai][bj][m][n], 0, 0, 0); __builtin_amdgcn_s_setprio(0); } while (0)
#define PG8_WAIT_V(n) asm volatile("s_waitcnt vmcnt(" #n ")" ::: "memory")
#define PG8_WAIT_L(n) asm volatile("s_waitcnt lgkmcnt(" #n ")" ::: "memory")
#define PG8_BAR __builtin_amdgcn_s_barrier()
#define PG8_SCHED __builtin_amdgcn_sched_barrier(0)
    Unit cur, nxt; int ui = 0;
    if (!S.next(0, cur)) return;
    f32x4 acc[2][2][4][2];
#pragma unroll
    for (int a = 0; a < 2; ++a)
#pragma unroll
        for (int b = 0; b < 2; ++b)
#pragma unroll
            for (int m = 0; m < 4; ++m)
#pragma unroll
                for (int n = 0; n < 2; ++n) acc[a][b][m][n] = (f32x4){0.f, 0.f, 0.f, 0.f};
    bf16x8 At[4][2], B0[2][2], B1[2][2];
    const char* cA = cur.a; const char* cB = cur.b;
    if constexpr (SP2) {
        PG8_STAGE(PG8_SB(0, 0), cB, voffB); PG8_STAGE(PG8_SB(0, 1), cB + hstepB, voffB); PG8_STAGE(PG8_SA(0, 0), cA, voffA); PG8_STAGE(PG8_SA(0, 1), cA + hstepA, voffA);
        if (wr == 1) PG8_BAR;
        PG8_WAIT_V(2); PG8_BAR;
        PG8_STAGE(PG8_SB(1, 0), cB + kstep, voffB); PG8_STAGE(PG8_SA(1, 0), cA + kstep, voffA); PG8_STAGE(PG8_SB(1, 1), cB + hstepB + kstep, voffB);
        PG8_WAIT_V(6); PG8_BAR;
    } else {
        PG8_STAGE(PG8_SB(0, 0), cB, voffB); PG8_STAGE(PG8_SA(0, 0), cA, voffA); PG8_STAGE(PG8_SB(0, 1), cB + hstepB, voffB); PG8_STAGE(PG8_SA(0, 1), cA + hstepA, voffA);
        if (wr == 1) PG8_BAR;
        PG8_WAIT_V(4); PG8_BAR;
        PG8_STAGE(PG8_SB(1, 0), cB + kstep, voffB); PG8_STAGE(PG8_SA(1, 0), cA + kstep, voffA); PG8_STAGE(PG8_SB(1, 1), cB + hstepB + kstep, voffB);
        PG8_WAIT_V(6); PG8_BAR;
    }
    for (;;) {
        const bool has_next = S.next(ui + 1, nxt);
        const bool do0 = cur.half != 2, do1 = cur.half != 1;
        const char* nA = has_next ? nxt.a : cA; const char* nB = has_next ? nxt.b : cB;
#pragma unroll 1
        for (int t = 0; t < nt; t += 2) {
            const bool last = (t == nt - 2);
            const char* a1 = cA + (size_t)(t + 1) * kstep;
            const char* a2 = last ? nA : cA + (size_t)(t + 2) * kstep; const char* b2 = last ? nB : cB + (size_t)(t + 2) * kstep;
            const char* a3 = a2 + kstep; const char* b3 = b2 + kstep;
            if constexpr (SP2) {
            PG8_LDB(B0, 0, 0); PG8_LDB(B1, 0, 1); PG8_SCHED; PG8_LDA(At, 0, 0); PG8_STAGE(PG8_SA(1, 1), a1 + hstepA, voffA);
            PG8_WAIT_V(8); PG8_WAIT_L(0); PG8_BAR; if (do0) { PG8_MMA(0, 0, At, B0); PG8_MMA(0, 1, At, B1); } PG8_BAR; PG8_SCHED;
            PG8_LDA(At, 0, 1); PG8_STAGE(PG8_SB(0, 0), b2, voffB); PG8_STAGE(PG8_SB(0, 1), b2 + hstepB, voffB); PG8_STAGE(PG8_SA(0, 0), a2, voffA);
            PG8_WAIT_V(8); PG8_WAIT_L(0); PG8_BAR; if (do1) { PG8_MMA(1, 0, At, B0); PG8_MMA(1, 1, At, B1); } PG8_BAR; PG8_SCHED;
            PG8_LDB(B0, 1, 0); PG8_LDB(B1, 1, 1); PG8_SCHED; PG8_LDA(At, 1, 0); PG8_STAGE(PG8_SA(0, 1), a2 + hstepA, voffA);
            PG8_WAIT_V(8); PG8_WAIT_L(0); PG8_BAR; if (do0) { PG8_MMA(0, 0, At, B0); PG8_MMA(0, 1, At, B1); } PG8_BAR; PG8_SCHED;
            PG8_LDA(At, 1, 1); PG8_STAGE(PG8_SB(1, 0), b3, voffB); PG8_STAGE(PG8_SB(1, 1), b3 + hstepB, voffB); PG8_STAGE(PG8_SA(1, 0), a3, voffA);
            PG8_WAIT_V(8); PG8_WAIT_L(0); PG8_BAR; if (do1) { PG8_MMA(1, 0, At, B0); PG8_MMA(1, 1, At, B1); } PG8_BAR; PG8_SCHED;
            } else {
            PG8_LDB(B0, 0, 0); PG8_SCHED; PG8_LDA(At, 0, 0); PG8_STAGE(PG8_SA(1, 1), a1 + hstepA, voffA);
            PG8_WAIT_L(8); PG8_BAR; PG8_WAIT_L(0); PG8_MMA(0, 0, At, B0); PG8_BAR; PG8_SCHED;
            PG8_LDB(B1, 0, 1); PG8_STAGE(PG8_SB(0, 0), b2, voffB);
            PG8_BAR; PG8_WAIT_L(0); PG8_MMA(0, 1, At, B1); PG8_BAR;
            PG8_LDA(At, 0, 1); PG8_STAGE(PG8_SA(0, 0), a2, voffA);
            PG8_BAR; PG8_WAIT_L(0); PG8_MMA(1, 0, At, B0); PG8_BAR; PG8_SCHED;
            PG8_STAGE(PG8_SB(0, 1), b2 + hstepB, voffB);
            PG8_WAIT_V(6); PG8_BAR; PG8_MMA(1, 1, At, B1); PG8_BAR;
            PG8_LDB(B0, 1, 0); PG8_SCHED; PG8_LDA(At, 1, 0); PG8_STAGE(PG8_SA(0, 1), a2 + hstepA, voffA);
            PG8_WAIT_L(8); PG8_BAR; PG8_WAIT_L(0); PG8_MMA(0, 0, At, B0); PG8_BAR; PG8_SCHED;
            PG8_LDB(B1, 1, 1); PG8_STAGE(PG8_SB(1, 0), b3, voffB);
            PG8_BAR; PG8_WAIT_L(0); PG8_MMA(0, 1, At, B1); PG8_BAR;
            PG8_LDA(At, 1, 1); PG8_STAGE(PG8_SA(1, 0), a3, voffA);
            PG8_BAR; PG8_WAIT_L(0); PG8_MMA(1, 0, At, B0); PG8_BAR; PG8_SCHED;
            PG8_STAGE(PG8_SB(1, 1), b3 + hstepB, voffB);
            PG8_WAIT_V(6); PG8_BAR; PG8_MMA(1, 1, At, B1); PG8_BAR;
            }
        }
        if constexpr (ALIGN_EPI) { if (wr == 0) PG8_BAR; }
        E(acc, cur, wr, wc, fr, fq);
        if (!has_next) break;
        if (!E.keep(cur)) {
#pragma unroll
            for (int a = 0; a < 2; ++a)
#pragma unroll
                for (int b = 0; b < 2; ++b)
#pragma unroll
                    for (int m = 0; m < 4; ++m)
#pragma unroll
                        for (int n = 0; n < 2; ++n) acc[a][b][m][n] = (f32x4){0.f, 0.f, 0.f, 0.f};
        }
        cur = nxt; cA = nA; cB = nB; ++ui;
        if constexpr (ALIGN_EPI) { if (wr == 1) PG8_BAR; }
    }
    PG8_WAIT_V(0);
    if constexpr (!ALIGN_EPI) { if (wr == 0) PG8_BAR; }
    PG8_BAR;
#undef PG8_SA
#undef PG8_SB
#undef PG8_STAGE
#undef PG8_LDA
#undef PG8_LDB
#undef PG8_MMA
#undef PG8_WAIT_V
#undef PG8_WAIT_L
#undef PG8_BAR
#undef PG8_SCHED
}

typedef f32x4 Acc[2][2][4][2];

struct EpiProj {
    static constexpr bool PERM = true;
    bf16_t *cqkv, *gqkv, *og, *up, *misc; const LAS float* rs_tab; float* ssq;
    __device__ __forceinline__ bool keep(const Unit&) const { return false; }
    __device__ __forceinline__ void operator()(Acc& acc, const Unit& u, int wr, int wc, int fr, int fq) const {
        const int row0 = u.pm * BM + wr * 64 + fr;
        bf16_t* dst; int ld, coff; const int pn = u.pn;
        if (pn < 2) { dst = cqkv; ld = 512; coff = pn * 256; }
        else if (pn < 6) { dst = gqkv; ld = 1024; coff = (pn - 2) * 256; }
        else if (pn < 8) { dst = og; ld = 512; coff = (pn - 6) * 256; }
        else if (pn < 10) { dst = up; ld = 512; coff = (pn - 8) * 256; }
        else { dst = misc; ld = 256; coff = 0; }
        const int col0 = coff + wc * 32 + 8 * fq;
#pragma unroll
        for (int ai = 0; ai < 2; ++ai)
#pragma unroll
            for (int m = 0; m < 4; ++m) { if (u.half && ai != u.half - 1) continue;
                const int row = row0 + ai * HALF + m * 16;
                const float rs = rs_tab[wr * 64 + fr + ai * HALF + m * 16];
                float ss = 0.f;
#pragma unroll
                for (int bj = 0; bj < 2; ++bj) {
                    const f32x4 v0 = acc[ai][bj][m][0] * rs, v1 = acc[ai][bj][m][1] * rs;
                    ss += (v0[0] * v0[0] + v0[1] * v0[1]) + (v0[2] * v0[2] + v0[3] * v0[3]) + (v1[0] * v1[0] + v1[1] * v1[1]) + (v1[2] * v1[2] + v1[3] * v1[3]);
                    u32x4 w; w.x = cvt_pk_bf16(v0[0], v0[1]); w.y = cvt_pk_bf16(v0[2], v0[3]); w.z = cvt_pk_bf16(v1[0], v1[1]); w.w = cvt_pk_bf16(v1[2], v1[3]);
                    *(u32x4*)(dst + (size_t)row * ld + col0 + bj * HALF) = w;
                }
                if (pn < 2) { ss += __shfl_xor(ss, 16); ss += __shfl_xor(ss, 32); if (fq == 0) ssq[((size_t)pn * T + row) * 4 + wc] = ss; }
            }
    }
};
struct EpiUp {
    static constexpr bool PERM = true;
    bf16_t* out; const float* ssq;
    __device__ __forceinline__ bool keep(const Unit&) const { return false; }
    __device__ __forceinline__ void operator()(Acc& acc, const Unit& u, int wr, int wc, int fr, int fq) const {
        const int row0 = u.pm * BM + wr * 64 + fr, col0 = u.pn * BM + wc * 32 + 8 * fq;
        const float* sq = ssq + (u.pn < 3 ? (size_t)0 : (size_t)T * 4);
#pragma unroll
        for (int ai = 0; ai < 2; ++ai)
#pragma unroll
            for (int m = 0; m < 4; ++m) { if (u.half && ai != u.half - 1) continue;
                const int row = row0 + ai * HALF + m * 16;
                const float rs = rsqrtf(sum4(sq + (size_t)row * 4) * (1.f / 256.f) + EPS);
#pragma unroll
                for (int bj = 0; bj < 2; ++bj) {
                    const f32x4 v0 = acc[ai][bj][m][0] * rs, v1 = acc[ai][bj][m][1] * rs;
                    u32x4 w; w.x = cvt_pk_bf16(v0[0], v0[1]); w.y = cvt_pk_bf16(v0[2], v0[3]); w.z = cvt_pk_bf16(v1[0], v1[1]); w.w = cvt_pk_bf16(v1[2], v1[3]);
                    *(u32x4*)(out + (size_t)row * 1792 + col0 + bj * HALF) = w;
                }
            }
    }
};
struct EpiGate {
    static constexpr bool PERM = true;
    unsigned char* acts; const LAS float* rs_tab;
    __device__ __forceinline__ bool keep(const Unit&) const { return false; }
    __device__ __forceinline__ void operator()(Acc& acc, const Unit& u, int wr, int wc, int fr, int fq) const {
        const int row0 = u.pm * BM + wr * 64 + fr, pl = u.pn >> 2, col0 = (u.pn & 3) * BM + wc * 32 + 8 * fq;
        bf16_t* dst = (bf16_t*)(acts + ((long long)A_G0 + (long long)(pl == 1) * (long long)(A_G1 - A_G0) + (long long)(pl == 2) * (long long)(A_G2 - A_G0)));
#pragma unroll
        for (int ai = 0; ai < 2; ++ai)
#pragma unroll
            for (int m = 0; m < 4; ++m) { if (u.half && ai != u.half - 1) continue;
                const int row = row0 + ai * HALF + m * 16;
                const float rs = rs_tab[wr * 64 + fr + ai * HALF + m * 16];
#pragma unroll
                for (int bj = 0; bj < 2; ++bj) {
                    f32x4 v0 = acc[ai][bj][m][0] * rs, v1 = acc[ai][bj][m][1] * rs;
#ifndef DBG_NOSIG
#pragma unroll
                    for (int e = 0; e < 4; ++e) { v0[e] = fast_sigmoid(fminf(fmaxf(v0[e], -60.f), 60.f)); v1[e] = fast_sigmoid(fminf(fmaxf(v1[e], -60.f), 60.f)); }
#endif
                    u32x4 w; w.x = cvt_pk_bf16(v0[0], v0[1]); w.y = cvt_pk_bf16(v0[2], v0[3]); w.z = cvt_pk_bf16(v1[0], v1[1]); w.w = cvt_pk_bf16(v1[2], v1[3]);
                    *(u32x4*)(dst + (size_t)row * 1024 + col0 + bj * HALF) = w;
                }
            }
    }
};
struct EpiMerge {
    static constexpr bool PERM = true;
    const unsigned char* acts; bf16_t* merged;
    __device__ __forceinline__ bool keep(const Unit& u) const { return u.kind < 2; }
    __device__ __forceinline__ void operator()(Acc& acc, const Unit& u, int wr, int wc, int fr, int fq) const {
        const int row0 = u.pm * BM + wr * 64 + fr, col0 = u.pn * BM + wc * 32 + 8 * fq, n = u.kind;
        const bf16_t* gn = (const bf16_t*)(acts + ((long long)A_G0 + (long long)(n == 1) * (long long)(A_G1 - A_G0) + (long long)(n == 2) * (long long)(A_G2 - A_G0)));
        const bf16_t* gd = (const bf16_t*)(acts + ((long long)A_G1 + (long long)(n != 0) * (long long)(A_G2 - A_G1)));
#pragma unroll
        for (int ai = 0; ai < 2; ++ai)
#pragma unroll
            for (int m = 0; m < 4; ++m) { if (u.half && ai != u.half - 1) continue;
                const int row = row0 + ai * HALF + m * 16;
#pragma unroll
                for (int bj = 0; bj < 2; ++bj) {
                    const size_t off = (size_t)row * 1024 + col0 + bj * HALF;
                    const u32x4 sn = *(const u32x4*)(gn + off);
                    f32x4 f0 = {bflo(sn.x), bfhi(sn.x), bflo(sn.y), bfhi(sn.y)}, f1 = {bflo(sn.z), bfhi(sn.z), bflo(sn.w), bfhi(sn.w)};
                    if (n < 2) {
                        const u32x4 sd = *(const u32x4*)(gd + off);
                        const f32x4 d0 = {bflo(sd.x), bfhi(sd.x), bflo(sd.y), bfhi(sd.y)}, d1 = {bflo(sd.z), bfhi(sd.z), bflo(sd.w), bfhi(sd.w)};
#pragma unroll
                        for (int e = 0; e < 4; ++e) { f0[e] *= __builtin_amdgcn_rcpf(d0[e]); f1[e] *= __builtin_amdgcn_rcpf(d1[e]); }
                        acc[ai][bj][m][0] = acc[ai][bj][m][0] * f0; acc[ai][bj][m][1] = acc[ai][bj][m][1] * f1;
                    } else {
                        const f32x4 v0 = acc[ai][bj][m][0] * f0, v1 = acc[ai][bj][m][1] * f1;
                        u32x4 w; w.x = cvt_pk_bf16(v0[0], v0[1]); w.y = cvt_pk_bf16(v0[2], v0[3]); w.z = cvt_pk_bf16(v1[0], v1[1]); w.w = cvt_pk_bf16(v1[2], v1[3]);
                        *(u32x4*)((unsigned char*)(merged + off) + (row >= 8192 ? MERGED_HI_DELTA : 0)) = w;
                    }
                }
            }
    }
};
struct EpiResid {
    static constexpr bool PERM = true;
    bf16_t* xb; float* rowss_next;
    __device__ __forceinline__ bool keep(const Unit&) const { return false; }
    __device__ __forceinline__ void operator()(Acc& acc, const Unit& u, int wr, int wc, int fr, int fq) const {
        const int row0 = u.pm * BM + wr * 64 + fr, col0 = u.pn * BM + wc * 32 + 8 * fq;
#pragma unroll
        for (int ai = 0; ai < 2; ++ai)
#pragma unroll
            for (int m = 0; m < 4; ++m) { if (u.half && ai != u.half - 1) continue;
                const int row = row0 + ai * HALF + m * 16; float ss = 0.f;
#pragma unroll
                for (int bj = 0; bj < 2; ++bj) {
                    bf16_t* p = xb + (size_t)row * D + col0 + bj * HALF;
                    const u32x4 o = *(const u32x4*)p;
                    const f32x4 v0 = (f32x4){bflo(o.x), bfhi(o.x), bflo(o.y), bfhi(o.y)} + acc[ai][bj][m][0], v1 = (f32x4){bflo(o.z), bfhi(o.z), bflo(o.w), bfhi(o.w)} + acc[ai][bj][m][1];
                    ss += ((v0[0] * v0[0] + v0[1] * v0[1]) + (v0[2] * v0[2] + v0[3] * v0[3])) + ((v1[0] * v1[0] + v1[1] * v1[1]) + (v1[2] * v1[2] + v1[3] * v1[3]));
                    u32x4 w; w.x = cvt_pk_bf16(v0[0], v0[1]); w.y = cvt_pk_bf16(v0[2], v0[3]); w.z = cvt_pk_bf16(v1[0], v1[1]); w.w = cvt_pk_bf16(v1[2], v1[3]);
                    *(u32x4*)p = w;
                }
                ss += __shfl_xor(ss, 16); ss += __shfl_xor(ss, 32); if (fq == 0) rowss_next[(size_t)row * 16 + u.pn * 4 + wc] = ss;
            }
    }
};
template <bool MOE> struct EpiSwiglu {
    static constexpr bool PERM = true;
    bf16_t* act; int ld; const LAS float* rs_tab; const float* slot_scale; const float* slot_comb;
    __device__ __forceinline__ bool keep(const Unit&) const { return false; }
    __device__ __forceinline__ void operator()(Acc& acc, const Unit& u, int wr, int wc, int fr, int fq) const {
        const int row0 = u.pm * BM + wr * 64 + fr, col0 = u.pn * HALF + wc * 32 + 8 * fq;
#pragma unroll
        for (int ai = 0; ai < 2; ++ai)
#pragma unroll
            for (int m = 0; m < 4; ++m) { if (u.half && ai != u.half - 1) continue;
                const int row = row0 + ai * HALF + m * 16;
                float rs, cb;
                if (MOE) { rs = slot_scale[row]; cb = slot_comb[row]; } else { rs = rs_tab[wr * 64 + fr + ai * HALF + m * 16]; cb = 1.f; }
                f32x4 o[2];
#pragma unroll
                for (int n = 0; n < 2; ++n) {
                    const f32x4 g = acc[ai][0][m][n] * rs, uu = acc[ai][1][m][n] * rs;
#pragma unroll
                    for (int e = 0; e < 4; ++e) o[n][e] = g[e] * fast_sigmoid(g[e]) * uu[e] * cb;
                }
                u32x4 w; w.x = cvt_pk_bf16(o[0][0], o[0][1]); w.y = cvt_pk_bf16(o[0][2], o[0][3]); w.z = cvt_pk_bf16(o[1][0], o[1][1]); w.w = cvt_pk_bf16(o[1][2], o[1][3]);
                *(u32x4*)(act + (size_t)row * ld + col0) = w;
            }
    }
};
struct EpiMoeDown {
    static constexpr bool PERM = true;
    bf16_t* y;
    __device__ __forceinline__ bool keep(const Unit&) const { return false; }
    __device__ __forceinline__ void operator()(Acc& acc, const Unit& u, int wr, int wc, int fr, int fq) const {
        const int row0 = u.pm * BM + wr * 64 + fr, col0 = u.pn * BM + wc * 32 + 8 * fq;
#pragma unroll
        for (int ai = 0; ai < 2; ++ai)
#pragma unroll
            for (int m = 0; m < 4; ++m) { if (u.half && ai != u.half - 1) continue;
                const int row = row0 + ai * HALF + m * 16;
#pragma unroll
                for (int bj = 0; bj < 2; ++bj) {
                    const f32x4 v0 = acc[ai][bj][m][0], v1 = acc[ai][bj][m][1];
                    u32x4 w; w.x = cvt_pk_bf16(v0[0], v0[1]); w.y = cvt_pk_bf16(v0[2], v0[3]); w.z = cvt_pk_bf16(v1[0], v1[1]); w.w = cvt_pk_bf16(v1[2], v1[3]);
                    *(u32x4*)(y + (size_t)row * D + col0 + bj * HALF) = w;
                }
            }
    }
};

struct SchedGrid {
    const char* A; const char* B; size_t a_tile, b_tile, a_alt; int nM, nN, G, c, alt_from; long long a_hi = 0;
    int split_from = 1 << 30;
    __device__ __forceinline__ bool next(int i, Unit& u) const {
        int L = i * G + c, hf = 0;
        if (L >= split_from) { const int nl = nM * nN - split_from, j = L - split_from; if (j >= 2 * nl) return false; hf = 1 + j / nl; L = split_from + j % nl; }
        if (L >= nM * nN) return false;
        int pm, pn; tile_map(L, nM, nN, pm, pn);
        u.pm = pm; u.pn = pn; u.kind = 0; u.half = hf; u.a = A + (size_t)pm * a_tile + (pn >= alt_from ? a_alt : 0) + (pm >= 32 ? a_hi : 0); u.b = B + (size_t)pn * b_tile; return true;
    }
};
struct SchedMerge {
    const char* acts; const char* wbr; int G, c;
    __device__ __forceinline__ bool next(int i, Unit& u) const {
        const int ti = i / 3, n = i - ti * 3, L = ti * G + c; if (L >= 256) return false;
        int pm, pn; tile_map(L, 64, 4, pm, pn);
        u.pm = pm; u.pn = pn; u.kind = n; u.half = 0; u.a = acts + ((long long)A_YSA + (long long)(n == 1) * ((long long)A_YSB - (long long)A_YSA) + (long long)(n == 2) * ((long long)A_POOLED - (long long)A_YSA)) + (size_t)pm * (256 * 512 * 2); u.b = wbr + (size_t)n * (1024 * 512 * 2) + (size_t)pn * (256 * 512 * 2); return true;
    }
};
struct SchedMoe {
    const char* A; const char* B; size_t a_tile, b_tile, b_exp; int MT, nN, G, c; int t1, t2, t3, t4, t5, t6, t7;
    int split_from = 1 << 30;
    __device__ __forceinline__ bool next(int i, Unit& u) const {
        int L = i * G + c, hf = 0;
        if (L >= split_from) { const int nl = MT * nN - split_from, j = L - split_from; if (j >= 2 * nl) return false; hf = 1 + j / nl; L = split_from + j % nl; }
        if (L >= MT * nN) return false;
        int pm, pn; tile_map(L, MT, nN, pm, pn);
        const int e = (pm >= t1) + (pm >= t2) + (pm >= t3) + (pm >= t4) + (pm >= t5) + (pm >= t6) + (pm >= t7);
        u.pm = pm; u.pn = pn; u.kind = e; u.half = hf; u.a = A + (size_t)pm * a_tile; u.b = B + (size_t)e * b_exp + (size_t)pn * b_tile; return true;
    }
};
}

#define XB_TMO      128
#define XB_XCNT(j)  (256  + 64 * (j))
#define XB_XSUB(j)  (1280 + 64 * (j))
#define XB_XGEN(j)  (2304 + 64 * (j))
#define XB_TOP      3328
#define XB_TOPGEN   3392
#define XCD_BAR_WORDS 3456
#define XB_SPIN_CAP (1u << 18)
__device__ __forceinline__ unsigned xb_ld(unsigned* p)              { return __hip_atomic_load(p, __ATOMIC_RELAXED, __HIP_MEMORY_SCOPE_AGENT); }
__device__ __forceinline__ unsigned xb_add(unsigned* p, unsigned v) { return __hip_atomic_fetch_add(p, v, __ATOMIC_RELAXED, __HIP_MEMORY_SCOPE_AGENT); }
__device__ __forceinline__ unsigned xb_xcc_id() { return (unsigned)__builtin_amdgcn_s_getreg((3 << 11) | 20) & 0xFu; }
#define XB_SPIN(cond, bar) do { unsigned _sp = 0; while (cond) { __builtin_amdgcn_s_sleep(1); \
    if ((++_sp & 255u) == 0u) { if (xb_ld(&(bar)[XB_TMO])) break; if (_sp > XB_SPIN_CAP) { atomicAdd(&(bar)[XB_TMO], 1u); break; } } } } while (0)
struct XcdBarrier { unsigned* bar; unsigned x; volatile LAS unsigned* st; };
__device__ __forceinline__ XcdBarrier xcd_barrier_post(unsigned* bar, volatile LAS unsigned* st) {
    XcdBarrier b; b.bar = bar; b.x = xb_xcc_id(); b.st = st;
    if (threadIdx.x == 0) (void)xb_add(&bar[XB_XCNT(b.x)], 1u);
    return b;
}
__device__ __forceinline__ void xcd_barrier_complete(unsigned* bar, unsigned x, unsigned& nloc, unsigned& nx) {
    const unsigned G = gridDim.x * gridDim.y * gridDim.z;
    unsigned sum, cnt, mine, sp = 0u;
    for (;;) {
        sum = 0u; cnt = 0u; mine = 0u;
#pragma unroll
        for (unsigned j = 0; j < 16; ++j) { const unsigned c = xb_ld(&bar[XB_XCNT(j)]); sum += c; cnt += (c > 0u) ? 1u : 0u; mine = (j == x) ? c : mine; }
        if (sum == G) break;
        __builtin_amdgcn_s_sleep(1);
        if ((++sp & 255u) == 0u) { if (xb_ld(&bar[XB_TMO])) break; if (sp > XB_SPIN_CAP) { atomicAdd(&bar[XB_TMO], 1u); break; } }
    }
    nloc = mine > 0u ? mine : 1u; nx = cnt > 0u ? cnt : 1u;
}
__device__ __forceinline__ void xcd_barrier(const XcdBarrier& b) {
    asm volatile("s_waitcnt vmcnt(0)" ::: "memory");
    __syncthreads();
    if (threadIdx.x == 0) {
        unsigned* bar = b.bar;
        __builtin_amdgcn_s_waitcnt(0);
        unsigned nloc = b.st[0], nx = b.st[1];
        if (nloc == 0u) { xcd_barrier_complete(bar, b.x, nloc, nx); b.st[0] = nloc; b.st[1] = nx; }
        const unsigned old = xb_add(&bar[XB_XSUB(b.x)], 1u);
        const unsigned gen = old / nloc;
        if (old + 1u == (gen + 1u) * nloc) {
            __builtin_amdgcn_fence(__ATOMIC_RELEASE, "agent");
            asm volatile("s_waitcnt vmcnt(0)" ::: "memory");
            const unsigned og = xb_add(&bar[XB_TOP], 1u);
            const unsigned tg = og / nx;
            if (og + 1u == (tg + 1u) * nx) xb_add(&bar[XB_TOPGEN], 1u);
            else XB_SPIN(xb_ld(&bar[XB_TOPGEN]) == tg, bar);
            __builtin_amdgcn_fence(__ATOMIC_ACQUIRE, "agent");
            xb_add(&bar[XB_XGEN(b.x)], 1u);
            asm volatile("s_waitcnt vmcnt(0)" ::: "memory");
        } else {
            XB_SPIN(xb_ld(&bar[XB_XGEN(b.x)]) == gen, bar);
            __builtin_amdgcn_fence(__ATOMIC_ACQUIRE, "agent");
            asm volatile("s_waitcnt vmcnt(0)" ::: "memory");
        }
    }
    __syncthreads();
}

struct Frame {
    LAS unsigned char* lds;
    volatile LAS unsigned* MISC;
    unsigned* ctl; float* ctlf; float* stats;
    unsigned char* ws;
    int tid, lane, wave, vcu, G;
    const CAS GPtr* inp;
    float* out;
    __device__ __forceinline__ const float* in(int i) const { return (const float*)inp[i]; }
};
enum { I_X = 0, I_POS, I_GMIX, I_WIN, I_GCQ, I_WUQ, I_GCKV, I_WUKV, I_GQKQ, I_GQKK, I_WGLA, I_BGLA, I_GGLAO, I_WPOOL, I_PSCALE, I_WBR, I_WOUT, I_GFFN, I_WFG, I_WFU, I_WFD, I_WROUTER, I_WEG, I_WEU, I_WED };

__device__ __forceinline__ bf16_t* act_ptr(const Frame& F, size_t off) { return (bf16_t*)(F.ws + WS_ACTS + off); }
__device__ __forceinline__ unsigned char* wblk(const Frame& F, int layer) { return F.ws + (layer == 0 ? WS_W0 : WS_W1); }

__device__ __forceinline__ void fill_rs(Frame& F, const float* rowss, int pm) {
    if (F.tid < 256) ((LAS float*)(F.lds + RS_OFF))[F.tid] = rsqrtf(sum16(rowss + ((size_t)pm * 256 + F.tid) * 16) * (1.f / 1024.f) + EPS);
    __syncthreads();
}
struct ConvSeg { const float* src; int ld, K, width, col0; bf16_t* dst; int row0, inter; const float* gain; };
typedef short v4i16c_t __attribute__((ext_vector_type(4)));
__device__ __forceinline__ int seg_items(const ConvSeg& s) { return (s.K >> 6) * ((s.width + 63) >> 6); }
__device__ __forceinline__ void conv_load(const ConvSeg& s, int item, int lane, f32x4 (&v)[16]) {
    const int nblk = (s.width + 63) >> 6, kb = item / nblk, nb = item - kb * nblk, k0 = kb * 64, n0 = nb * 64;
    const int kq = lane >> 4, n4 = (lane & 15) * 4; const bool ok = n0 + n4 < s.width;
    const float* p = s.src + (size_t)(k0 + kq) * s.ld + s.col0 + n0 + n4;
#pragma unroll
    for (int i = 0; i < 16; ++i) v[i] = ok ? *(const f32x4*)(p + (size_t)(4 * i) * s.ld) : (f32x4){0.f, 0.f, 0.f, 0.f};
}
__device__ __forceinline__ void conv_store(const ConvSeg& s, int item, LAS unsigned char* scr, int lane, const f32x4 (&v)[16]) {
    const int nblk = (s.width + 63) >> 6, kb = item / nblk, nb = item - kb * nblk, k0 = kb * 64, n0 = nb * 64;
    const int kq = lane >> 4, n4 = (lane & 15) * 4;
#pragma unroll
    for (int i = 0; i < 16; ++i) {
        f32x4 x = v[i]; if (s.gain) x = x * s.gain[k0 + 4 * i + kq];
        *(LAS u32x2*)(scr + (4 * i + kq) * 136 + n4 * 2) = (u32x2){cvt_pk_bf16(x[0], x[1]), cvt_pk_bf16(x[2], x[3])};
    }
    LDS_WAIT();
    const int g = lane >> 4, i16 = lane & 15;
#pragma unroll
    for (int nb16 = 0; nb16 < 4; ++nb16)
#pragma unroll
        for (int kh = 0; kh < 2; ++kh) {
            const int c = kh * 4 + g;
            const LAS unsigned char* a = scr + (8 * c + (i16 >> 2)) * 136 + (nb16 * 16 + (i16 & 3) * 4) * 2;
            const v4i16c_t lo = __builtin_amdgcn_ds_read_tr16_b64_v4i16((LAS v4i16c_t*)a), hi = __builtin_amdgcn_ds_read_tr16_b64_v4i16((LAS v4i16c_t*)(a + 4 * 136));
            const int nq = n0 + nb16 * 16 + i16;
            if (nq < s.width) {
                const int drow = s.row0 + (s.inter ? ((nq >> 7) * 256 + (nq & 127)) : nq);
                typedef short s16x8_t __attribute__((ext_vector_type(8)));
                *(s16x8_t*)(s.dst + (size_t)drow * s.K + k0 + 8 * c) = (s16x8_t){lo[0], lo[1], lo[2], lo[3], hi[0], hi[1], hi[2], hi[3]};
            }
        }
    LDS_WAIT();
}
__device__ __forceinline__ ConvSeg mixer_seg(const Frame& F, int l, int idx) {
    unsigned char* wb = wblk(F, l);
    ConvSeg s; s.inter = 0; s.row0 = 0; s.col0 = 0;
    if (idx < 10) {
        int c0, wd, r0;
        switch (idx) {
            case 0: c0 = 0; wd = 256; r0 = 0; break;
            case 1: c0 = 256; wd = 256; r0 = 256; break;
            case 2: c0 = 544; wd = 256; r0 = 512; break;
            case 3: c0 = 800; wd = 256; r0 = 768; break;
            case 4: c0 = 1056; wd = 512; r0 = 1024; break;
            case 5: c0 = 1584; wd = 512; r0 = 1536; break;
            case 6: c0 = 2096; wd = 512; r0 = 2048; break;
            case 7: c0 = 512; wd = 32; r0 = 2560; break;
            case 8: c0 = 1568; wd = 16; r0 = 2592; break;
            default: c0 = 2608; wd = 3072; r0 = 0; break;
        }
        s.src = F.in(I_WIN) + (size_t)l * D * DIN; s.ld = DIN; s.K = D; s.width = wd; s.col0 = c0;
        s.dst = (bf16_t*)(wb + (idx == 9 ? WO_G : WO_IN)); s.row0 = r0; s.gain = F.in(I_GMIX) + l * D;
    } else if (idx == 10) { s.src = F.in(I_WUQ) + (size_t)l * 256 * 768; s.ld = 768; s.K = 256; s.width = 768; s.dst = (bf16_t*)(wb + WO_UP); s.gain = F.in(I_GCQ) + l * 256; }
    else if (idx == 11) { s.src = F.in(I_WUKV) + (size_t)l * 256 * 1024; s.ld = 1024; s.K = 256; s.width = 1024; s.dst = (bf16_t*)(wb + WO_UP); s.row0 = 768; s.gain = F.in(I_GCKV) + l * 256; }
    else if (idx < 14) { const int n = idx - 12; s.src = F.in(I_WBR) + (size_t)(l * 3 + n) * 512 * D; s.ld = D; s.K = 512; s.width = D; s.dst = (bf16_t*)(wb + WO_BR) + (size_t)n * 1024 * 512; s.gain = nullptr; }
    else { s.src = F.in(I_WOUT) + (size_t)l * D * D; s.ld = D; s.K = D; s.width = D; s.dst = (bf16_t*)(wb + WO_OUT); s.gain = nullptr; }
    return s;
}
__device__ __forceinline__ ConvSeg ffn_seg(const Frame& F, int idx) {
    unsigned char* wb = F.ws + WS_W0; ConvSeg s; s.col0 = 0; s.inter = 0; s.row0 = 0;
    if (idx < 2) { s.src = F.in(idx == 0 ? I_WFG : I_WFU); s.ld = DFF; s.K = D; s.width = DFF; s.dst = (bf16_t*)(wb + WO_FGU); s.row0 = idx * 128; s.inter = 1; s.gain = F.in(I_GFFN); }
    else { s.src = F.in(I_WFD); s.ld = D; s.K = DFF; s.width = D; s.dst = (bf16_t*)(wb + WO_FD); s.gain = nullptr; }
    return s;
}
__device__ __forceinline__ ConvSeg moe_seg(const Frame& F, int idx) {
    unsigned char* wb = F.ws + WS_W0; const int e = idx / 3, k = idx - e * 3; ConvSeg s; s.col0 = 0; s.inter = 0; s.row0 = 0;
    if (k < 2) { s.src = F.in(k == 0 ? I_WEG : I_WEU) + (size_t)e * D * DEXP; s.ld = DEXP; s.K = D; s.width = DEXP; s.dst = (bf16_t*)(wb + WO_MGU) + (size_t)e * 2816 * 1024; s.row0 = k * 128; s.inter = 1; s.gain = F.in(I_GFFN) + D; }
    else { s.src = F.in(I_WED) + (size_t)e * DEXP * D; s.ld = D; s.K = DEXP; s.width = D; s.dst = (bf16_t*)(wb + WO_MD) + (size_t)e * 1024 * 1408; s.gain = nullptr; }
    return s;
}
#define CONV_LOCATE(NSEG, GETSEG, IT, SEGOUT, IDXOUT) do { int r_ = (IT); for (int si_ = 0; si_ < (NSEG); ++si_) { const ConvSeg sg_ = GETSEG; const int n_ = seg_items(sg_); SEGOUT = sg_; IDXOUT = r_; if (r_ < n_) break; r_ -= n_; } } while (0)
#define CONV_LOOP(NSEG, GETSEG) do { int total_ = 0; for (int si_ = 0; si_ < (NSEG); ++si_) { const ConvSeg sg_ = GETSEG; total_ += seg_items(sg_); } \
        int it_ = gw; if (it_ < total_) { ConvSeg cs_; int ci_ = 0; f32x4 va_[16]; CONV_LOCATE(NSEG, GETSEG, it_, cs_, ci_); conv_load(cs_, ci_, F.lane, va_); \
        for (;;) { const int nx_ = it_ + NGW; const bool hn_ = nx_ < total_; ConvSeg ns_; int ni_ = 0; f32x4 vb_[16]; CONV_LOCATE(NSEG, GETSEG, (hn_ ? nx_ : it_), ns_, ni_); conv_load(ns_, ni_, F.lane, vb_); \
            _Pragma("unroll") for (int q_ = 0; q_ < 16; ++q_) asm volatile("" : "+v"(va_[q_])); \
            conv_store(cs_, ci_, (LAS unsigned char*)scr, F.lane, va_); if (!hn_) break; \
            _Pragma("unroll") for (int q_ = 0; q_ < 16; ++q_) va_[q_] = vb_[q_]; cs_ = ns_; ci_ = ni_; it_ = nx_; } } } while (0)
__device__ __forceinline__ void fold_pool(const Frame& F, int l, int gw, int NGW) {
    const float* wp = F.in(I_WPOOL) + (size_t)l * 4 * 128 * 128; const float* ps = F.in(I_PSCALE) + l * 512; const float* wb2 = F.in(I_WBR) + (size_t)(l * 3 + 2) * 512 * D;
    bf16_t* dst = (bf16_t*)(wblk(F, l) + WO_BR) + (size_t)2 * 1024 * 512;
    for (int it = gw; it < 1024; it += NGW) {
        const int db = it & 15, g = (it >> 4) & 3, cb = it >> 6, d = db * 64 + F.lane, c0 = cb * 8;
        float a[8];
#pragma unroll
        for (int i = 0; i < 8; ++i) a[i] = 0.f;
        for (int j = 0; j < 128; ++j) {
            const float w = wb2[(size_t)(g * 128 + j) * D + d] * ps[g * 128 + j];
#pragma unroll
            for (int i = 0; i < 8; ++i) a[i] = fmaf(wp[(size_t)(g * 128 + c0 + i) * 128 + j], w, a[i]);
        }
        u32x4 o; o.x = cvt_pk_bf16(a[0], a[1]); o.y = cvt_pk_bf16(a[2], a[3]); o.z = cvt_pk_bf16(a[4], a[5]); o.w = cvt_pk_bf16(a[6], a[7]);
        *(u32x4*)(dst + (size_t)d * 512 + g * 128 + c0) = o;
    }
}

__device__ __forceinline__ void p0_prologue(Frame& F) {
    LAS float* scr = (LAS float*)(F.lds + F.wave * 16384);
    const int gw = F.vcu * 8 + F.wave, NGW = F.G * 8;
    { bf16_t* xb = (bf16_t*)(F.ws + WS_XB); float* rss = F.stats + SF_ROWSS;
      for (int m = gw; m < T; m += NGW) {
          const f32x4* xr = (const f32x4*)(F.in(I_X) + (size_t)m * D) + F.lane; float s = 0.f;
          unsigned long long* o8 = (unsigned long long*)(xb + (size_t)m * D) + F.lane;
#pragma unroll
          for (int j = 0; j < 4; ++j) { const f32x4 v = xr[64 * j]; s += (v[0] * v[0] + v[1] * v[1]) + (v[2] * v[2] + v[3] * v[3]);
              o8[64 * j] = (unsigned long long)cvt_pk_bf16(v[0], v[1]) | ((unsigned long long)cvt_pk_bf16(v[2], v[3]) << 32); }
          s = wave_sum(s); if (F.lane < 16) rss[(size_t)m * 16 + F.lane] = (F.lane == 0) ? s : 0.f;
      } }
    { float* rt = (float*)(F.ws + WS_ROPE); const int* pos = (const int*)F.in(I_POS);
      for (int i = F.vcu * 512 + F.tid; i < T * 16; i += F.G * 512) {
          const int t = i >> 4, k = i & 15; const float inv = powf(10000.f, -(float)k / 16.f), ang = (float)pos[t] * inv;
          rt[t * 32 + k] = cosf(ang); rt[t * 32 + 16 + k] = sinf(ang);
      } }
    CONV_LOOP(15, mixer_seg(F, 0, si_));
    fold_pool(F, 0, gw, NGW);
}

__device__ __forceinline__ void gla_prep(Frame& F, int l, int unit);
__device__ __forceinline__ void phase_prep(Frame& F, int l, int rpt = 0) {
    const bf16_t* raw = act_ptr(F, A_QKVRAW); const bf16_t* misc = act_ptr(F, A_MISC);
    bf16_t* QH = act_ptr(F, A_QH); bf16_t* KH = act_ptr(F, A_KH); bf16_t* VT = act_ptr(F, A_VT);
    const float* rope = (const float*)(F.ws + WS_ROPE);
    const float* gq = F.in(I_GQKQ) + l * 96; const float* gk = F.in(I_GQKK) + l * 96;
    LAS bf16_t* vt = (LAS bf16_t*)F.lds;
    for (int unit = F.vcu; unit < T / 64; unit += F.G) {
        const int t0 = unit * 64, b = t0 / SEQ, s0 = t0 % SEQ;
        if (!rpt) gla_prep(F, l, unit);
#pragma unroll 1
        for (int it = F.tid; it < 1024; it += 512) {
            const int which = it & 1, h = (it >> 1) & 7, tok = it >> 4, t = t0 + tok;
            const bf16_t* nope = raw + (size_t)t * 1792 + (which ? 768 + h * 128 : h * 96);
            const bf16_t* rp = which ? misc + (size_t)t * 256 : nope + 64;
            const float* g = which ? gk : gq;
            u32x4 c[12];
#pragma unroll
            for (int i = 0; i < 8; ++i) c[i] = *(const u32x4*)(nope + 8 * i);
#pragma unroll
            for (int i = 0; i < 4; ++i) c[8 + i] = *(const u32x4*)(rp + 8 * i);
            float ss = 0.f;
#pragma unroll
            for (int i = 0; i < 12; ++i) {
                const float a0 = bflo(c[i].x), a1 = bfhi(c[i].x), a2 = bflo(c[i].y), a3 = bfhi(c[i].y), a4 = bflo(c[i].z), a5 = bfhi(c[i].z), a6 = bflo(c[i].w), a7 = bfhi(c[i].w);
                ss += (a0 * a0 + a1 * a1) + (a2 * a2 + a3 * a3) + (a4 * a4 + a5 * a5) + (a6 * a6 + a7 * a7);
            }
            float r = rsqrtf(ss * (1.f / 96.f) + EPS);
            if (!which) r *= 0.14724444f;
            bf16_t* dst = (which ? KH : QH) + ((size_t)(b * 8 + h) * SEQ + s0 + tok) * 96;
#pragma unroll
            for (int i = 0; i < 8; ++i) {
                const f32x4 g0 = *(const f32x4*)(g + 8 * i), g1 = *(const f32x4*)(g + 8 * i + 4);
                u32x4 o; o.x = cvt_pk_bf16(bflo(c[i].x) * r * g0[0], bfhi(c[i].x) * r * g0[1]); o.y = cvt_pk_bf16(bflo(c[i].y) * r * g0[2], bfhi(c[i].y) * r * g0[3]);
                o.z = cvt_pk_bf16(bflo(c[i].z) * r * g1[0], bfhi(c[i].z) * r * g1[1]); o.w = cvt_pk_bf16(bflo(c[i].w) * r * g1[2], bfhi(c[i].w) * r * g1[3]);
                *(u32x4*)(dst + 8 * i) = o;
            }
#pragma unroll
            for (int hh = 0; hh < 2; ++hh) {
                const u32x4 x1c = c[8 + hh], x2c = c[10 + hh];
                float x1[8] = {bflo(x1c.x), bfhi(x1c.x), bflo(x1c.y), bfhi(x1c.y), bflo(x1c.z), bfhi(x1c.z), bflo(x1c.w), bfhi(x1c.w)};
                float x2[8] = {bflo(x2c.x), bfhi(x2c.x), bflo(x2c.y), bfhi(x2c.y), bflo(x2c.z), bfhi(x2c.z), bflo(x2c.w), bfhi(x2c.w)};
                float o1[8], o2[8];
#pragma unroll
                for (int i = 0; i < 8; ++i) {
                    const int k = hh * 8 + i; const float cs = rope[(size_t)t * 32 + k], sn = rope[(size_t)t * 32 + 16 + k];
                    const float a = x1[i] * r * g[64 + k], bb = x2[i] * r * g[80 + k];
                    o1[i] = a * cs - bb * sn; o2[i] = bb * cs + a * sn;
                }
                u32x4 w1, w2; w1.x = cvt_pk_bf16(o1[0], o1[1]); w1.y = cvt_pk_bf16(o1[2], o1[3]); w1.z = cvt_pk_bf16(o1[4], o1[5]); w1.w = cvt_pk_bf16(o1[6], o1[7]);
                w2.x = cvt_pk_bf16(o2[0], o2[1]); w2.y = cvt_pk_bf16(o2[2], o2[3]); w2.z = cvt_pk_bf16(o2[4], o2[5]); w2.w = cvt_pk_bf16(o2[6], o2[7]);
                *(u32x4*)(dst + 64 + hh * 8) = w1; *(u32x4*)(dst + 80 + hh * 8) = w2;
            }
        }
        {
            const int tok = F.tid >> 3, cc = F.tid & 7;
            u32x4 vr[8];
#pragma unroll
            for (int h = 0; h < 8; ++h) vr[h] = *(const u32x4*)(raw + (size_t)(t0 + tok) * 1792 + 768 + h * 128 + 64 + cc * 8);
#pragma unroll
            for (int h = 0; h < 8; ++h) *(LAS u32x4*)(F.lds + h * 9216 + tok * 144 + cc * 16) = vr[h];
            __syncthreads();
            const int db = F.wave & 3, c = (F.wave >> 2) * 4 + (F.lane >> 4), i16 = F.lane & 15;
#pragma unroll
            for (int h = 0; h < 8; ++h) {
                const LAS unsigned char* a = F.lds + h * 9216 + (8 * c + (i16 >> 2)) * 144 + (16 * db + (i16 & 3) * 4) * 2;
                const v4i16c_t lo = __builtin_amdgcn_ds_read_tr16_b64_v4i16((LAS v4i16c_t*)a), hi = __builtin_amdgcn_ds_read_tr16_b64_v4i16((LAS v4i16c_t*)(a + 4 * 144));
                typedef short s16x8_t __attribute__((ext_vector_type(8)));
                bf16_t* vrow = VT + (((size_t)(b * 8 + h) * (SEQ / 64) + (s0 >> 6)) * 64 + 16 * db + i16) * 64;
                *(v4i16c_t*)(vrow + 4 * c) = lo; *(v4i16c_t*)(vrow + 32 + 4 * c) = hi;
            }
            __syncthreads();
        }
    }
}

constexpr int AT_KROW = 208, AT_KT = 64 * AT_KROW, AT_VROW = 144, AT_VTB = 64 * AT_VROW, AT_SLOT = AT_KT + AT_VTB, AT_NSLOT = 5, AT_DUMMY = AT_NSLOT * AT_SLOT;
static_assert(AT_KT == 13 * 1024 && AT_VTB == 9 * 1024 && AT_DUMMY + 8 * 1024 <= RING_BYTES, "attention ring");
#ifdef AT_TPROBE
#define TP_B(k) do { if (AT_TPROBE == (k)) tp0 = __builtin_readcyclecounter(); } while (0)
#define TP_E(k) do { if (AT_TPROBE == (k)) tpacc += __builtin_readcyclecounter() - tp0; } while (0)
#else
#define TP_B(k) do {} while (0)
#define TP_E(k) do {} while (0)
#endif
__device__ __forceinline__ void attn_unit(Frame& F, int bh, int qb, unsigned long long& tpacc) {
#ifdef AT_TPROBE
    unsigned long long tp0 = 0;
#endif
    TP_B(0);
    const int lane = F.lane, wid = F.wave, r32 = lane & 31, hi = lane >> 5, grp = wid >> 2;
    const bf16_t* QHp = act_ptr(F, A_QH) + ((size_t)bh * SEQ + qb * 256 + wid * 32) * 96;
    const char* Kb = (const char*)(act_ptr(F, A_KH) + (size_t)bh * SEQ * 96);
    const char* Vb = (const char*)(act_ptr(F, A_VT) + (size_t)bh * 64 * SEQ);
    LAS unsigned char* lds = F.lds;
    bf16x8 qr[6];
#pragma unroll
    for (int s = 0; s < 6; ++s) qr[s] = *(const bf16x8*)(QHp + (size_t)r32 * 96 + 16 * s + 8 * hi);
    const int NT = 4 * (qb + 1);
    const char *dp0, *dp1, *dp2;
    { const int P = 64 * wid + lane, row = P / 13, col = P % 13; dp0 = Kb + row * 192 + (col == 12 ? 0 : col) * 16; }
    if (wid < 5) { const int P = 64 * (wid + 8) + lane, row = P / 13, col = P % 13; dp1 = Kb + row * 192 + (col == 12 ? 0 : col) * 16; }
    else { const int P = 64 * (wid - 5) + lane, d = P / 9, col = P % 9; dp1 = Vb + d * 128 + (col == 8 ? 0 : col) * 16; }
    { const int P = 64 * (wid + 3) + lane, d = (P / 9) & 63, col = P % 9; dp2 = Vb + d * 128 + (col == 8 ? 0 : col) * 16; }
    const unsigned st1 = wid < 5 ? 12288u : 8192u;
    const bool w3 = wid < 6;
#define AT_DMA_ONE(j, sl) do { const int sl_ = (sl); LAS unsigned char* d_ = lds + sl_ + wid * 1024; const int c1_ = sl_ == AT_DUMMY ? 0 : 8192; \
        __builtin_amdgcn_global_load_lds((const unsigned*)(dp0 + (size_t)(j) * 12288), (LAS unsigned*)d_, 16, 0, 0); \
        __builtin_amdgcn_global_load_lds((const unsigned*)(dp1 + (size_t)(j) * st1), (LAS unsigned*)(d_ + c1_), 16, 0, 0); \
        if (w3) __builtin_amdgcn_global_load_lds((const unsigned*)(dp2 + (size_t)(j) * 8192), (LAS unsigned*)(d_ + 2 * c1_), 16, 0, 0); } while (0)
#ifdef AT_PROBE_DMA2
#define AT_DMA(j, sl) do { AT_DMA_ONE(j, sl); AT_DMA_ONE(j, sl); } while (0)
#define AT_WAIT2() do { if (w3) asm volatile("s_waitcnt vmcnt(12)" ::: "memory"); else asm volatile("s_waitcnt vmcnt(8)" ::: "memory"); } while (0)
#else
#define AT_DMA(j, sl) AT_DMA_ONE(j, sl)
#define AT_WAIT2() do { if (w3) asm volatile("s_waitcnt vmcnt(6)" ::: "memory"); else asm volatile("s_waitcnt vmcnt(4)" ::: "memory"); } while (0)
#endif
#define AT_WAIT1() do { if (w3) asm volatile("s_waitcnt vmcnt(3)" ::: "memory"); else asm volatile("s_waitcnt vmcnt(2)" ::: "memory"); } while (0)
#define AT_WAIT_NEXT(t) do { if ((t) + 3 < NT) AT_WAIT2(); else if ((t) + 3 == NT) AT_WAIT1(); else VM_WAIT(); } while (0)
    AT_DMA(0, 0); AT_DMA(1, AT_SLOT); AT_DMA(2, 2 * AT_SLOT); AT_DMA(3, 3 * AT_SLOT);
#ifdef AT_PROBE_DMA2
    if (w3) asm volatile("s_waitcnt vmcnt(18)" ::: "memory"); else asm volatile("s_waitcnt vmcnt(12)" ::: "memory");
#else
    if (w3) asm volatile("s_waitcnt vmcnt(9)" ::: "memory"); else asm volatile("s_waitcnt vmcnt(6)" ::: "memory");
#endif
    LDS_BARRIER();
    float m_run = 0.f, l_run = 0.f;
    f32x16 o0, o1, negm;
#pragma unroll
    for (int r = 0; r < 16; ++r) { o0[r] = 0.f; o1[r] = 0.f; negm[r] = 0.f; }
    const unsigned kfr = (unsigned)(r32 * AT_KROW + hi * 16), vfr = (unsigned)(AT_KT + r32 * AT_VROW + hi * 64);
    if (grp) LDS_BARRIER();
    int slot = 0, wslot = 4;
    const int NTw = 4 * qb + (wid >> 1) + 1;
    TP_B(1);
    for (int t = 0; t < NTw; ++t) {
        const int jb = t - 4 * qb;
        const LAS unsigned char* sb = lds + slot * AT_SLOT;
        f32x16 p0, p1;
        TP_B(2);
        {
            const LAS unsigned char* kb = sb + kfr;
            bf16x8 ka[6], kc[6];
#pragma unroll
            for (int s = 0; s < 6; ++s) { ka[s] = *(const LAS bf16x8*)(kb + s * 32); kc[s] = *(const LAS bf16x8*)(kb + 32 * AT_KROW + s * 32); }
            __builtin_amdgcn_sched_barrier(0);
            __builtin_amdgcn_s_setprio(1);
            p0 = __builtin_amdgcn_mfma_f32_32x32x16_bf16(ka[0], qr[0], negm, 0, 0, 0);
            p1 = __builtin_amdgcn_mfma_f32_32x32x16_bf16(kc[0], qr[0], negm, 0, 0, 0);
#pragma unroll
            for (int s = 1; s < 6; ++s) {
                p0 = __builtin_amdgcn_mfma_f32_32x32x16_bf16(ka[s], qr[s], p0, 0, 0, 0);
                p1 = __builtin_amdgcn_mfma_f32_32x32x16_bf16(kc[s], qr[s], p1, 0, 0, 0);
            }
            __builtin_amdgcn_s_setprio(0);
#ifdef AT_PROBE_SEG1X2
            asm volatile("" : "+v"(p0), "+v"(p1));
            p0 = __builtin_amdgcn_mfma_f32_32x32x16_bf16(ka[0], qr[0], negm, 0, 0, 0);
            p1 = __builtin_amdgcn_mfma_f32_32x32x16_bf16(kc[0], qr[0], negm, 0, 0, 0);
#pragma unroll
            for (int s = 1; s < 6; ++s) {
                p0 = __builtin_amdgcn_mfma_f32_32x32x16_bf16(ka[s], qr[s], p0, 0, 0, 0);
                p1 = __builtin_amdgcn_mfma_f32_32x32x16_bf16(kc[s], qr[s], p1, 0, 0, 0);
            }
#endif
            asm volatile("" : "+v"(p0), "+v"(p1));
        }
        TP_E(2);
        TP_B(3);
        AT_WAIT2();
        TP_E(3);
        TP_B(4);
        LDS_BARRIER();
        TP_E(4);
        AT_DMA(min(t + 4, NT - 1), t + 4 < NT ? wslot * AT_SLOT : AT_DUMMY);
        TP_B(5);
        {
            const LAS unsigned char* vb = sb + vfr;
            bf16x8 va[4], vc2[4];
#pragma unroll
            for (int s = 0; s < 4; ++s) { va[s] = *(const LAS bf16x8*)(vb + s * 16); vc2[s] = *(const LAS bf16x8*)(vb + 32 * AT_VROW + s * 16); }
            if (jb >= 0 && wid < 2 * jb + 2) {
                const int qrel = 32 * wid + r32, kb0 = 64 * jb + 4 * hi;
#pragma unroll
                for (int r = 0; r < 16; ++r) { const int kv = kb0 + (r & 3) + 8 * (r >> 2); if (kv > qrel) p0[r] = -INFINITY; if (kv + 32 > qrel) p1[r] = -INFINITY; }
            }
            float mxa = __builtin_elementwise_maximum(p0[0], p0[1]), mxb = __builtin_elementwise_maximum(p1[0], p1[1]);
#pragma unroll
            for (int r = 2; r < 16; r += 2) {
                mxa = __builtin_elementwise_maximum(__builtin_elementwise_maximum(mxa, p0[r]), p0[r + 1]);
                mxb = __builtin_elementwise_maximum(__builtin_elementwise_maximum(mxb, p1[r]), p1[r + 1]);
            }
            float mx = __builtin_elementwise_maximum(mxa, mxb);
            {
                const u32x2 sw = __builtin_amdgcn_permlane32_swap(__float_as_uint(mx), __float_as_uint(mx), false, false);
                mx = __builtin_elementwise_maximum(__uint_as_float(sw.x), __uint_as_float(sw.y));
            }
            if (t == 0 || !__all(mx <= 8.f)) {
                const float delta = t == 0 ? mx : fmaxf(mx, 0.f), alpha = t == 0 ? 1.f : __builtin_amdgcn_exp2f(-delta);
                m_run += delta; l_run *= alpha;
#pragma unroll
                for (int r = 0; r < 16; ++r) { o0[r] *= alpha; o1[r] *= alpha; p0[r] -= delta; p1[r] -= delta; negm[r] = -m_run; }
            }
            float ps = 0.f;
#pragma unroll
            for (int r = 0; r < 16; ++r) { p0[r] = __builtin_amdgcn_exp2f(p0[r]); p1[r] = __builtin_amdgcn_exp2f(p1[r]); ps += p0[r]; ps += p1[r]; }
            l_run += ps;
#pragma unroll
            for (int s = 0; s < 4; ++s) {
                u32x4 pw;
                if (s < 2) { pw.x = cvt_pk_bf16(p0[8 * s + 0], p0[8 * s + 1]); pw.y = cvt_pk_bf16(p0[8 * s + 2], p0[8 * s + 3]); pw.z = cvt_pk_bf16(p0[8 * s + 4], p0[8 * s + 5]); pw.w = cvt_pk_bf16(p0[8 * s + 6], p0[8 * s + 7]); }
                else { const int q = s - 2; pw.x = cvt_pk_bf16(p1[8 * q + 0], p1[8 * q + 1]); pw.y = cvt_pk_bf16(p1[8 * q + 2], p1[8 * q + 3]); pw.z = cvt_pk_bf16(p1[8 * q + 4], p1[8 * q + 5]); pw.w = cvt_pk_bf16(p1[8 * q + 6], p1[8 * q + 7]); }
                const bf16x8 pb = __builtin_bit_cast(bf16x8, pw);
                o0 = __builtin_amdgcn_mfma_f32_32x32x16_bf16(va[s], pb, o0, 0, 0, 0);
                o1 = __builtin_amdgcn_mfma_f32_32x32x16_bf16(vc2[s], pb, o1, 0, 0, 0);
            }
        }
        TP_E(5);
        TP_B(6);
        LDS_BARRIER();
        TP_E(6);
        slot = slot == AT_NSLOT - 1 ? 0 : slot + 1; wslot = wslot == AT_NSLOT - 1 ? 0 : wslot + 1;
    }
    TP_E(1);
    for (int t = NTw; t < NT; ++t) {
        AT_WAIT2();
        LDS_BARRIER();
        AT_DMA(min(t + 4, NT - 1), t + 4 < NT ? wslot * AT_SLOT : AT_DUMMY);
        LDS_BARRIER();
        wslot = wslot == AT_NSLOT - 1 ? 0 : wslot + 1;
    }
    if (!grp) LDS_BARRIER();
    VM_WAIT();
#undef AT_DMA
#undef AT_DMA_ONE
#undef AT_WAIT2
#undef AT_WAIT1
#undef AT_WAIT_NEXT
    l_run += __shfl_xor(l_run, 32);
    const float inv = 1.f / l_run;
    const int b = bh >> 3, h = bh & 7;
    bf16_t* orow = act_ptr(F, A_YSA) + ((size_t)b * SEQ + qb * 256 + wid * 32 + r32) * 512 + h * 64;
#pragma unroll
    for (int g = 0; g < 4; ++g) {
        u32x2 w0, w1;
        w0.x = cvt_pk_bf16(o0[4 * g] * inv, o0[4 * g + 1] * inv); w0.y = cvt_pk_bf16(o0[4 * g + 2] * inv, o0[4 * g + 3] * inv);
        w1.x = cvt_pk_bf16(o1[4 * g] * inv, o1[4 * g + 1] * inv); w1.y = cvt_pk_bf16(o1[4 * g + 2] * inv, o1[4 * g + 3] * inv);
#ifdef AT_WT_STORE
        asm volatile("global_store_dwordx2 %0, %1, off sc0 sc1" :: "v"(orow + 8 * g + 4 * hi), "v"(w0) : "memory");
        asm volatile("global_store_dwordx2 %0, %1, off sc0 sc1" :: "v"(orow + 32 + 8 * g + 4 * hi), "v"(w1) : "memory");
#else
        *(u32x2*)(orow + 8 * g + 4 * hi) = w0; *(u32x2*)(orow + 32 + 8 * g + 4 * hi) = w1;
#endif
    }
    TP_E(0);
}

__device__ __forceinline__ float row16_sum(float x) {
    x += __int_as_float(__builtin_amdgcn_update_dpp(0, __float_as_int(x), 0x128, 0xf, 0xf, false));
    x += __int_as_float(__builtin_amdgcn_update_dpp(0, __float_as_int(x), 0x124, 0xf, 0xf, false));
    x += __int_as_float(__builtin_amdgcn_update_dpp(0, __float_as_int(x), 0x122, 0xf, 0xf, false));
    x += __int_as_float(__builtin_amdgcn_update_dpp(0, __float_as_int(x), 0x121, 0xf, 0xf, false));
    return x;
}
__device__ __forceinline__ unsigned short f2bf1(float x) { return (unsigned short)(cvt_pk_bf16(x, 0.f) & 0xffffu); }
__device__ __forceinline__ void gla_prep(Frame& F, int l, int unit) {
    bf16_t* gqkv = act_ptr(F, A_GQKV); const bf16_t* misc = act_ptr(F, A_MISC); float* eb = F.stats + SF_EB;
    const int c = F.tid & 255, ch = unit * 2 + (F.tid >> 8);
    const float* wg = F.in(I_WGLA) + (size_t)l * 16 * 256 + c; const float bias = F.in(I_BGLA)[l * 256 + c];
    float wcol[16];
#pragma unroll
    for (int r = 0; r < 16; ++r) wcol[r] = wg[r * 256];
    float bc = 0.f;
#pragma unroll 8
    for (int i = 0; i < 32; ++i) {
        const size_t t = (size_t)ch * 32 + i;
        const u32x4 l0 = *(const u32x4*)(misc + t * 256 + 32), l1 = *(const u32x4*)(misc + t * 256 + 40);
        const float lr[16] = {bflo(l0.x), bfhi(l0.x), bflo(l0.y), bfhi(l0.y), bflo(l0.z), bfhi(l0.z), bflo(l0.w), bfhi(l0.w),
                              bflo(l1.x), bfhi(l1.x), bflo(l1.y), bfhi(l1.y), bflo(l1.z), bfhi(l1.z), bflo(l1.w), bfhi(l1.w)};
        float z = bias;
#pragma unroll
        for (int r = 0; r < 16; ++r) z = fmaf(lr[r], wcol[r], z);
        const float zl = z * 1.4426950408889634f;
        const float sp = fmaxf(-zl, 0.f) + __log2f(1.f + __builtin_amdgcn_exp2f(-fabsf(zl)));
        bc -= sp * 0.0625f;
        const float eq = __builtin_amdgcn_exp2f(bc) * 0.125f, ek = __builtin_amdgcn_exp2f(-bc);
        bf16_t* qp = gqkv + t * 1024 + c; bf16_t* kp = qp + 256;
        *qp = f2bf1(__uint_as_float((unsigned)*qp << 16) * eq);
        *kp = f2bf1(__uint_as_float((unsigned)*kp << 16) * ek);
    }
    eb[(size_t)ch * 256 + c] = __builtin_amdgcn_exp2f(bc);
}
typedef short v4i16_t __attribute__((ext_vector_type(4)));
__device__ __forceinline__ v4i16_t lds_tr16(const LAS unsigned char* p) { return __builtin_amdgcn_ds_read_tr16_b64_v4i16((LAS v4i16_t*)p); }
constexpr int GW_K = 0, GW_Q = 4608, GW_V = 9216, GW_BYTES = 10240;
__device__ __forceinline__ void gla_unit(Frame& F, int l, int unit) {
    const int half = unit & 1, h = (unit >> 1) & 3, b = unit >> 3;
    volatile LAS int* prog = (volatile LAS int*)(F.lds + 4 * GW_BYTES);
    if (F.wave >= 4) {
        const int pw = F.wave - 4, tok = F.lane & 31, li = (F.lane >> 5) + 2 * (pw & 1);
        const size_t lo_ = (li == 0) ? (size_t)h * 128 : (li == 1) ? (size_t)512 + h * 128 : (li == 2) ? (size_t)1024 + h * 256 + half * 128 : (size_t)1024 + h * 256 + half * 128 + 64;
        const unsigned char* base_ = (const unsigned char*)act_ptr(F, A_GQKV) + lo_;
        unsigned keep = 0u;
        for (int m = (pw >> 1); m < SEQ / 32; m += 2) {
            while (m > prog[0] + 8) __builtin_amdgcn_s_sleep(8);
            const unsigned char* pp = base_ + ((size_t)b * SEQ + (size_t)m * 32 + tok) * 2048;
            asm volatile("global_load_dword %0, %1, off" : "+v"(keep) : "v"(pp) : "memory");
        }
        asm volatile("s_waitcnt vmcnt(0)" : "+v"(keep) :: "memory");
        return;
    }
    const int lane = F.lane, w = half * 4 + F.wave, l15 = lane & 15, q4 = lane >> 4;
    const bf16_t* gqkv = act_ptr(F, A_GQKV); const float* ebg = F.stats + SF_EB;
    bf16_t* ysb = act_ptr(F, A_YSB);
    LAS unsigned char* wl = F.lds + F.wave * GW_BYTES;
    f32x4 S[4];
#pragma unroll
    for (int i = 0; i < 4; ++i) S[i] = (f32x4){0.f, 0.f, 0.f, 0.f};
    if (F.tid == 0) prog[0] = 0;
    constexpr int GW2 = 4 * GW_BYTES;
    u32x4 kimgX[4], qimgX[4], vimgX, kimgY[4], qimgY[4], vimgY; f32x4 ebvX[4], ebvY[4];
#define GLA_LOAD1(n_, KI, QI, VI, EBV) do { const size_t tb_ = (size_t)b * SEQ + (size_t)(n_) * 32; \
        _Pragma("unroll") for (int i = 0; i < 4; ++i) { const int p_ = lane + 64 * i; const bf16_t* r_ = gqkv + (tb_ + (p_ >> 3)) * 1024 + h * 64 + (p_ & 7) * 8; QI[i] = *(const u32x4*)r_; KI[i] = *(const u32x4*)(r_ + 256); } \
        VI = *(const u32x4*)(gqkv + (tb_ + (lane >> 1)) * 1024 + 512 + h * 128 + 16 * w + (lane & 1) * 8); \
        _Pragma("unroll") for (int db = 0; db < 4; ++db) EBV[db] = *(const f32x4*)(ebg + (tb_ >> 5) * 256 + h * 64 + 16 * db + 4 * q4); } while (0)
#define GLA_LOAD(n_) do { GLA_LOAD1((n_), kimgX, qimgX, vimgX, ebvX); GLA_LOAD1((n_) + 1, kimgY, qimgY, vimgY, ebvY); } while (0)
    bf16x8 pa0X, pa1X, vbnX, kanX[4], qpxX[2], qpyX[2], pa0Y, pa1Y, vbnY, kanY[4], qpxY[2], qpyY[2]; f32x4 o0pX, o1pX, e4X[4], o0pY, o1pY, e4Y[4];
#define GLA_IMG(WL, KI, QI, VI, EBV, E4) do { \
        _Pragma("unroll") for (int i = 0; i < 4; ++i) { asm volatile("" : "+v"(KI[i]), "+v"(QI[i]), "+v"(EBV[i])); } \
        asm volatile("" : "+v"(VI)); \
        _Pragma("unroll") for (int i = 0; i < 4; ++i) { const int p_ = lane + 64 * i; *(LAS u32x4*)((WL) + GW_K + (p_ >> 3) * 144 + (p_ & 7) * 16) = KI[i]; *(LAS u32x4*)((WL) + GW_Q + (p_ >> 3) * 144 + (p_ & 7) * 16) = QI[i]; } \
        *(LAS u32x4*)((WL) + GW_V + (lane >> 1) * 32 + (lane & 1) * 16) = VI; \
        _Pragma("unroll") for (int db = 0; db < 4; ++db) E4[db] = EBV[db]; } while (0)
#define GLA_STAGE_P(WL, PA0, PA1, VBN, KAN, QPX, QPY, O0P, O1P) do { \
        f32x4 pt00 = {0.f, 0.f, 0.f, 0.f}, pt01 = pt00, pt11 = pt00; \
        _Pragma("unroll") for (int ks = 0; ks < 2; ++ks) { \
            const bf16x8 a0 = *(const LAS bf16x8*)((WL) + GW_K + l15 * 144 + ks * 64 + q4 * 16), a1 = *(const LAS bf16x8*)((WL) + GW_K + (16 + l15) * 144 + ks * 64 + q4 * 16); \
            const bf16x8 b0 = *(const LAS bf16x8*)((WL) + GW_Q + l15 * 144 + ks * 64 + q4 * 16), b1 = *(const LAS bf16x8*)((WL) + GW_Q + (16 + l15) * 144 + ks * 64 + q4 * 16); \
            pt00 = __builtin_amdgcn_mfma_f32_16x16x32_bf16(a0, b0, pt00, 0, 0, 0); \
            pt01 = __builtin_amdgcn_mfma_f32_16x16x32_bf16(a0, b1, pt01, 0, 0, 0); \
            pt11 = __builtin_amdgcn_mfma_f32_16x16x32_bf16(a1, b1, pt11, 0, 0, 0); \
            const LAS unsigned char* q0p = (WL) + GW_Q + l15 * 144 + ks * 64 + q4 * 8; const LAS unsigned char* q1p = q0p + 16 * 144; \
            const u32x2 x0 = *(const LAS u32x2*)(q0p), x1 = *(const LAS u32x2*)(q0p + 32), y0 = *(const LAS u32x2*)(q1p), y1 = *(const LAS u32x2*)(q1p + 32); \
            QPX[ks] = __builtin_bit_cast(bf16x8, (u32x4){x0.x, x0.y, x1.x, x1.y}); QPY[ks] = __builtin_bit_cast(bf16x8, (u32x4){y0.x, y0.y, y1.x, y1.y}); } \
        _Pragma("unroll") for (int r = 0; r < 4; ++r) { if (4 * q4 + r > l15) { pt00[r] = 0.f; pt11[r] = 0.f; } } \
        PA0 = __builtin_bit_cast(bf16x8, (u32x4){cvt_pk_bf16(pt00[0], pt00[1]), cvt_pk_bf16(pt00[2], pt00[3]), 0u, 0u}); \
        PA1 = __builtin_bit_cast(bf16x8, (u32x4){cvt_pk_bf16(pt01[0], pt01[1]), cvt_pk_bf16(pt01[2], pt01[3]), cvt_pk_bf16(pt11[0], pt11[1]), cvt_pk_bf16(pt11[2], pt11[3])}); \
        const LAS unsigned char* vt_ = (WL) + GW_V + (l15 >> 2) * 32 + (l15 & 3) * 8; \
        const v4i16_t vp0 = lds_tr16(vt_ + (4 * q4) * 32), vp1 = lds_tr16(vt_ + (16 + 4 * q4) * 32); \
        const v4i16_t vn0 = lds_tr16(vt_ + (8 * q4) * 32), vn1 = lds_tr16(vt_ + (8 * q4 + 4) * 32); \
        const bf16x8 vbp = (bf16x8){vp0[0], vp0[1], vp0[2], vp0[3], vp1[0], vp1[1], vp1[2], vp1[3]}; \
        VBN = (bf16x8){vn0[0], vn0[1], vn0[2], vn0[3], vn1[0], vn1[1], vn1[2], vn1[3]}; \
        _Pragma("unroll") for (int db = 0; db < 4; ++db) { \
            const LAS unsigned char* kt = (WL) + GW_K + (8 * q4 + (l15 >> 2)) * 144 + (16 * db + (l15 & 3) * 4) * 2; \
            const v4i16_t k0 = lds_tr16(kt), k1 = lds_tr16(kt + 4 * 144); \
            KAN[db] = (bf16x8){k0[0], k0[1], k0[2], k0[3], k1[0], k1[1], k1[2], k1[3]}; } \
        O0P = __builtin_amdgcn_mfma_f32_16x16x32_bf16(PA0, vbp, (f32x4){0.f, 0.f, 0.f, 0.f}, 0, 0, 0); \
        O1P = __builtin_amdgcn_mfma_f32_16x16x32_bf16(PA1, vbp, (f32x4){0.f, 0.f, 0.f, 0.f}, 0, 0, 0); \
    } while (0)
#define GLA_STAGE_S(T0, VBN, KAN, QPX, QPY, O0P, O1P, E4) do { \
        f32x4 o0 = O0P, o1 = O1P; \
        _Pragma("unroll") for (int ks = 0; ks < 2; ++ks) { \
            const bf16x8 sb = __builtin_bit_cast(bf16x8, (u32x4){cvt_pk_bf16(S[2 * ks][0], S[2 * ks][1]), cvt_pk_bf16(S[2 * ks][2], S[2 * ks][3]), cvt_pk_bf16(S[2 * ks + 1][0], S[2 * ks + 1][1]), cvt_pk_bf16(S[2 * ks + 1][2], S[2 * ks + 1][3])}); \
            o0 = __builtin_amdgcn_mfma_f32_16x16x32_bf16(QPX[ks], sb, o0, 0, 0, 0); \
            o1 = __builtin_amdgcn_mfma_f32_16x16x32_bf16(QPY[ks], sb, o1, 0, 0, 0); } \
        _Pragma("unroll") for (int db = 0; db < 4; ++db) { S[db] = __builtin_amdgcn_mfma_f32_16x16x32_bf16(KAN[db], VBN, S[db], 0, 0, 0); S[db] = S[db] * E4[db]; } \
        _Pragma("unroll") for (int r = 0; r < 4; ++r) { const size_t ta = (T0) + 4 * q4 + r, tb2 = ta + 16; \
            ysb[ta * 512 + h * 128 + 16 * w + l15] = f2bf1(o0[r]); ysb[tb2 * 512 + h * 128 + 16 * w + l15] = f2bf1(o1[r]); } \
    } while (0)
    LAS unsigned char* wl2 = F.lds + GW2 + 64 + F.wave * GW_BYTES;
    GLA_LOAD(0);
    for (int n = 0; n < SEQ / 32; n += 2) {
        const size_t t0 = (size_t)b * SEQ + (size_t)n * 32;
        if (F.tid == 0) prog[0] = n;
        GLA_IMG(wl, kimgX, qimgX, vimgX, ebvX, e4X);
        GLA_IMG(wl2, kimgY, qimgY, vimgY, ebvY, e4Y);
        { const int nn = (n + 2 < SEQ / 32) ? n + 2 : n; GLA_LOAD(nn); }
        GLA_STAGE_P(wl, pa0X, pa1X, vbnX, kanX, qpxX, qpyX, o0pX, o1pX);
        GLA_STAGE_P(wl2, pa0Y, pa1Y, vbnY, kanY, qpxY, qpyY, o0pY, o1pY);
        GLA_STAGE_S(t0, vbnX, kanX, qpxX, qpyX, o0pX, o1pX, e4X);
        GLA_STAGE_S(t0 + 32, vbnY, kanY, qpxY, qpyY, o0pY, o1pY, e4Y);
        asm volatile("s_waitcnt lgkmcnt(0)" ::: "memory");
    }
#undef GLA_LOAD1
#undef GLA_IMG
#undef GLA_STAGE_P
#undef GLA_STAGE_S
#undef GLA_LOAD
}
__device__ __forceinline__ void gla_finalize(Frame& F, int l) {
    bf16_t* ysb = act_ptr(F, A_YSB); const bf16_t* og = act_ptr(F, A_OG);
    const float* go = F.in(I_GGLAO) + l * 128;
    for (int i = F.vcu * 512 + F.tid; i < T * 64; i += F.G * 512) {
        const int t = i >> 6, c8 = i & 63, h = c8 >> 4, v0 = (c8 & 15) * 8;
        const u32x4 o = *(const u32x4*)(ysb + (size_t)t * 512 + c8 * 8), gte = *(const u32x4*)(og + (size_t)t * 512 + c8 * 8);
        const f32x4 g0 = *(const f32x4*)(go + v0), g1 = *(const f32x4*)(go + v0 + 4);
        const float ov[8] = {bflo(o.x), bfhi(o.x), bflo(o.y), bfhi(o.y), bflo(o.z), bfhi(o.z), bflo(o.w), bfhi(o.w)};
        const float ssq = row16_sum(((ov[0] * ov[0] + ov[1] * ov[1]) + (ov[2] * ov[2] + ov[3] * ov[3])) + ((ov[4] * ov[4] + ov[5] * ov[5]) + (ov[6] * ov[6] + ov[7] * ov[7])));
        const float r = rsqrtf(ssq * (1.f / 128.f) + EPS);
        const float gv[8] = {bflo(gte.x), bfhi(gte.x), bflo(gte.y), bfhi(gte.y), bflo(gte.z), bfhi(gte.z), bflo(gte.w), bfhi(gte.w)};
        float y[8];
#pragma unroll
        for (int e = 0; e < 8; ++e) y[e] = ov[e] * r * (e < 4 ? g0[e] : g1[e - 4]) * gv[e] * fast_sigmoid(gv[e]);
        u32x4 wv; wv.x = cvt_pk_bf16(y[0], y[1]); wv.y = cvt_pk_bf16(y[2], y[3]); wv.z = cvt_pk_bf16(y[4], y[5]); wv.w = cvt_pk_bf16(y[6], y[7]);
        *(u32x4*)(ysb + (size_t)t * 512 + c8 * 8) = wv;
    }
}

template <int W> __device__ __forceinline__ void pool_rows(const bf16_t* up, bf16_t* pooled, int t0, int s0, int c8) {
    u32x4 row[8 + W - 1];
#pragma unroll
    for (int i = 0; i < 8 + W - 1; ++i) {
        const int dt = i - (W - 1);
        const bool ok = (s0 + dt) >= 0;
        const u32x4 v = *(const u32x4*)(up + (size_t)(t0 + (ok ? dt : 0)) * 512 + c8 * 8);
        row[i] = ok ? v : (u32x4){0u, 0u, 0u, 0u};
    }
#pragma unroll
    for (int k = 0; k < 8; ++k) {
        float acc[8];
#pragma unroll
        for (int e = 0; e < 8; ++e) acc[e] = 0.f;
#pragma unroll
        for (int j = 0; j < W; ++j) { const u32x4 v = row[k + W - 1 - j];
            acc[0] += bflo(v.x); acc[1] += bfhi(v.x); acc[2] += bflo(v.y); acc[3] += bfhi(v.y); acc[4] += bflo(v.z); acc[5] += bfhi(v.z); acc[6] += bflo(v.w); acc[7] += bfhi(v.w); }
        const int sk = s0 + k, n = (sk + 1 < W) ? sk + 1 : W;
        const float rn = 1.f / (float)n; const u32x4 self = row[k + W - 1];
        u32x4 o; o.x = cvt_pk_bf16(acc[0] * rn - bflo(self.x), acc[1] * rn - bfhi(self.x)); o.y = cvt_pk_bf16(acc[2] * rn - bflo(self.y), acc[3] * rn - bfhi(self.y));
        o.z = cvt_pk_bf16(acc[4] * rn - bflo(self.z), acc[5] * rn - bfhi(self.z)); o.w = cvt_pk_bf16(acc[6] * rn - bflo(self.w), acc[7] * rn - bfhi(self.w));
        *(u32x4*)(pooled + (size_t)(t0 + k) * 512 + c8 * 8) = o;
    }
}
__device__ __forceinline__ void pool_unit(Frame& F, int unit) {
    const bf16_t* up = act_ptr(F, A_UP); bf16_t* pooled = act_ptr(F, A_POOLED);
    const int g = F.wave & 3, c8 = g * 16 + (F.lane & 15), tb = (F.lane >> 4) + 4 * (F.wave >> 2);
    const int t0 = unit * 64 + tb * 8, s0 = t0 % SEQ;
    if (g == 0) pool_rows<2>(up, pooled, t0, s0, c8);
    else if (g == 1) pool_rows<4>(up, pooled, t0, s0, c8);
    else if (g == 2) pool_rows<8>(up, pooled, t0, s0, c8);
    else pool_rows<16>(up, pooled, t0, s0, c8);
}

__device__ __forceinline__ void phase_mix(Frame& F, int lq, int bx) {
    const int l = lq & 1;
#ifndef REP_DMASK
#define REP_DMASK 7
#endif
    const int dm = (lq >= 2) ? (REP_DMASK) : 7;
    if (bx < 32 && (dm & 1)) gla_unit(F, l, bx);
    unsigned* head = F.ctl + CW_QUEUE + 64 * lq;
    unsigned long long tpsum = 0;
#ifdef AT_TPROBE
    const unsigned long long tq0 = __builtin_readcyclecounter();
#endif
    for (;;) {
        if (F.tid == 0) F.MISC[16] = __hip_atomic_fetch_add(head, 1u, RLX_AGENT);
        __syncthreads();
        const int idx = (int)F.MISC[16];
        __syncthreads();
        if (idx >= 512 + 256) break;
        if (idx < 512) { if (dm & 2) attn_unit(F, idx & 31, 15 - (idx >> 5), tpsum); }
        else { if (dm & 4) pool_unit(F, idx - 512); }
    }
#ifdef AT_TPROBE
    if (AT_TPROBE == 7) tpsum = __builtin_readcyclecounter() - tq0;
    if (lq >= 2 && (AT_TPWG < 0 || bx == AT_TPWG) && F.wave == AT_TPWAVE) { const unsigned long long ts = __builtin_readcyclecounter(); while (__builtin_readcyclecounter() - ts < 4ull * tpsum) __builtin_amdgcn_s_sleep(8); }
#endif
    if (bx >= 32 && lq < 2) {
        LAS float* scr = (LAS float*)(F.lds + F.wave * 16384);
        const int gw = (bx - 32) * 8 + F.wave, NGW = (F.G - 32) * 8;
        if (l == 0) { CONV_LOOP(15, mixer_seg(F, 1, si_)); fold_pool(F, 1, gw, NGW); CONV_LOOP(3, ffn_seg(F, si_)); }
        else { CONV_LOOP(12, moe_seg(F, (si_ >> 1) * 3 + (si_ & 1))); }
    }
}

__device__ __forceinline__ void phase_route1(Frame& F) {
    const bf16_t* x = (const bf16_t*)(F.ws + WS_XB); const float* rss = F.stats + SF_ROWSS + (size_t)3 * T * 16; const float* gf = F.in(I_GFFN) + D; const float* wr = F.in(I_WROUTER);
    unsigned* route = (unsigned*)(F.ws + WS_SLOT + SL_ROUTE); unsigned* wgcnt = F.ctl + CW_WGCNT;
    LAS float* lsel = (LAS float*)(F.lds);
    LAS int* lpos = (LAS int*)(F.lds + 2048);
    for (int unit = F.vcu; unit < T / 64; unit += F.G) {
        for (int k = 0; k < 8; ++k) {
            const int tok = F.wave * 8 + k, t = unit * 64 + tok;
            float lg[8];
#pragma unroll
            for (int e = 0; e < 8; ++e) lg[e] = 0.f;
#pragma unroll
            for (int j = 0; j < 2; ++j) {
                const int c = 8 * F.lane + 512 * j;
                const u32x4 xr = *(const u32x4*)(x + (size_t)t * D + c);
                const f32x4 ga = *(const f32x4*)(gf + c), gb = *(const f32x4*)(gf + c + 4);
                const float xv[8] = {bflo(xr.x) * ga[0], bfhi(xr.x) * ga[1], bflo(xr.y) * ga[2], bfhi(xr.y) * ga[3], bflo(xr.z) * gb[0], bfhi(xr.z) * gb[1], bflo(xr.w) * gb[2], bfhi(xr.w) * gb[3]};
#pragma unroll
                for (int q = 0; q < 8; ++q) {
                    const float xg = xv[q];
                    const f32x4 w0 = *(const f32x4*)(wr + (size_t)(c + q) * 8), w1 = *(const f32x4*)(wr + (size_t)(c + q) * 8 + 4);
                    lg[0] = fmaf(xg, w0[0], lg[0]); lg[1] = fmaf(xg, w0[1], lg[1]); lg[2] = fmaf(xg, w0[2], lg[2]); lg[3] = fmaf(xg, w0[3], lg[3]);
                    lg[4] = fmaf(xg, w1[0], lg[4]); lg[5] = fmaf(xg, w1[1], lg[5]); lg[6] = fmaf(xg, w1[2], lg[6]); lg[7] = fmaf(xg, w1[3], lg[7]);
                }
            }
            const float rs = rsqrtf(sum16(rss + (size_t)t * 16) * (1.f / 1024.f) + EPS);
#pragma unroll
            for (int e = 0; e < 8; ++e) lg[e] = wave_sum(lg[e]) * rs;
            int i1 = 0; float v1 = lg[0];
#pragma unroll
            for (int e = 1; e < 8; ++e) if (lg[e] > v1) { v1 = lg[e]; i1 = e; }
            int i2 = -1; float v2 = -INFINITY;
#pragma unroll
            for (int e = 0; e < 8; ++e) if (e != i1 && lg[e] > v2) { v2 = lg[e]; i2 = e; }
            const float e2 = __expf(v2 - v1), w1 = 1.f / (1.f + e2), w2 = e2 / (1.f + e2);
            if (F.lane == 0) { lsel[tok * 4 + 0] = __int_as_float(i1); lsel[tok * 4 + 1] = __int_as_float(i2); lsel[tok * 4 + 2] = w1; lsel[tok * 4 + 3] = w2; }
        }
        __syncthreads();
        if (F.tid < 8) {
            int cnt = 0;
            for (int tok = 0; tok < 64; ++tok) {
                const int e1 = __float_as_int(lsel[tok * 4 + 0]), e2 = __float_as_int(lsel[tok * 4 + 1]);
                if (e1 == F.tid) { lpos[tok * 2 + 0] = cnt; ++cnt; }
                if (e2 == F.tid) { lpos[tok * 2 + 1] = cnt; ++cnt; }
            }
            wgcnt[unit * 8 + F.tid] = (unsigned)cnt;
        }
        __syncthreads();
        if (F.tid < 64) {
            const int t = unit * 64 + F.tid;
            u32x4 a, b2;
            a.x = (unsigned)__float_as_int(lsel[F.tid * 4 + 0]); a.y = (unsigned)__float_as_int(lsel[F.tid * 4 + 1]); a.z = __float_as_uint(lsel[F.tid * 4 + 2]); a.w = __float_as_uint(lsel[F.tid * 4 + 3]);
            b2.x = (unsigned)lpos[F.tid * 2 + 0]; b2.y = (unsigned)lpos[F.tid * 2 + 1]; b2.z = 0u; b2.w = 0u;
            *(u32x4*)(route + (size_t)t * 8) = a; *(u32x4*)(route + (size_t)t * 8 + 4) = b2;
        }
        __syncthreads();
    }
}
__device__ __forceinline__ void moe_geometry(Frame& F, int unit, LAS int* geo) {
    const unsigned* wgcnt = F.ctl + CW_WGCNT;
    if (F.tid < 8) {
        int tot = 0, pre = 0;
        for (int c = 0; c < 256; ++c) { const int v = (int)wgcnt[c * 8 + F.tid]; if (c < unit) pre += v; tot += v; }
        geo[9 + F.tid] = tot; geo[17 + F.tid] = pre;
    }
    __syncthreads();
    if (F.tid == 0) { int acc = 0; for (int e = 0; e < 8; ++e) { geo[e] = acc; acc += (geo[9 + e] + 255) >> 8; } geo[8] = acc; }
    __syncthreads();
}
__device__ __forceinline__ void phase_route2(Frame& F) {
    const unsigned* route = (const unsigned*)(F.ws + WS_SLOT + SL_ROUTE);
    int* slot_tok = (int*)(F.ws + WS_SLOT + SL_TOK); float* slot_scale = (float*)(F.ws + WS_SLOT + SL_SCALE); float* slot_comb = (float*)(F.ws + WS_SLOT + SL_COMB);
    const float* rss = F.stats + SF_ROWSS + (size_t)3 * T * 16;
    const bf16_t* xb = (const bf16_t*)(F.ws + WS_XB); bf16_t* xg = act_ptr(F, A_XG);
    LAS int* geo = (LAS int*)(F.lds);
    for (int unit = F.vcu; unit < T / 64; unit += F.G) {
        moe_geometry(F, unit, geo);
        for (int k = 0; k < 16; ++k) {
            const int rix = F.wave * 16 + k, tok = rix >> 1, ch = rix & 1, t = unit * 64 + tok;
            const unsigned e = route[(size_t)t * 8 + ch], pos = route[(size_t)t * 8 + 4 + ch];
            const float w = __uint_as_float(route[(size_t)t * 8 + 2 + ch]);
            const int slot = geo[e] * 256 + geo[17 + e] + (int)pos;
            const u32x4* src = (const u32x4*)(xb + (size_t)t * D); u32x4* dst = (u32x4*)(xg + (size_t)slot * D);
            dst[F.lane] = src[F.lane]; dst[64 + F.lane] = src[64 + F.lane];
            if (F.lane == 0) { ((int*)(F.ws + WS_TSLOT))[t * 2 + ch] = slot; slot_tok[slot] = t; slot_scale[slot] = rsqrtf(sum16(rss + (size_t)t * 16) * (1.f / 1024.f) + EPS); slot_comb[slot] = w; }
        }
        if (unit == 0) {
            for (int e = 0; e < 8; ++e) { const int s0 = geo[e] * 256 + geo[9 + e], s1 = geo[e + 1] * 256;
                for (int s = s0 + F.tid; s < s1; s += 512) { slot_tok[s] = -1; slot_scale[s] = 0.f; slot_comb[s] = 0.f; } }
        }
        __syncthreads();
    }
}

struct Args { const void* in[25]; float* out; unsigned char* ws; int ph_lo, ph_hi, li, pad; };
constexpr int NPHASE = 22;
#ifndef PH_MASK
#define PH_MASK 0xFFF
#endif
#define PON(b) (((PH_MASK) >> (b)) & 1)

__global__ void __launch_bounds__(512, 2) mega_fwd(Args args) {
    extern __shared__ __attribute__((aligned(16))) unsigned char lds_raw[];
    Frame F;
    F.lds = (LAS unsigned char*)lds_raw;
    F.MISC = (volatile LAS unsigned*)(F.lds + MISC_OFF);
    F.tid = threadIdx.x; F.lane = F.tid & 63; F.wave = __builtin_amdgcn_readfirstlane(F.tid >> 6);
    F.G = gridDim.x; { const int bx = blockIdx.x; F.vcu = (F.G % 8 == 0) ? (bx % 8) * (F.G / 8) + bx / 8 : bx; }
    { const CAS Args* ap0 = (const CAS Args*)__builtin_amdgcn_kernarg_segment_ptr(); F.ws = ap0->ws; F.ctl = (unsigned*)(F.ws + WS_CTL); F.ctlf = (float*)(F.ws + WS_CTL); F.stats = (float*)(F.ws + WS_STATS); }
    F.inp = nullptr; F.out = nullptr;
    for (int u = F.tid; u < (LDS_BYTES - LDSCTL_OFF) / 4; u += 512) ((LAS unsigned*)(F.lds + LDSCTL_OFF))[u] = 0u;
    __syncthreads();
    XcdBarrier bar = xcd_barrier_post(F.ctl + CW_BAR + args.li * XCD_BAR_WORDS, F.MISC + 8);
    const int lo = args.ph_lo, hi = args.ph_hi;
    const int cblk0 = (int)blockIdx.x, wave0 = F.wave, vcu0 = F.vcu, G0 = F.G;
#ifndef REP_MASK
#define REP_MASK 0
#endif
#pragma unroll 1
    for (int ph2 = 2 * lo; ph2 < 2 * hi; ++ph2) {
        const int ph = ph2 >> 1, rpt = ph2 & 1;
        if (rpt && !((REP_MASK >> ph) & 1)) continue;
        int cblk = cblk0; { int wv_ = wave0, vc_ = vcu0, g_ = G0; asm volatile("" : "+s"(wv_), "+s"(vc_), "+s"(g_), "+s"(cblk)); F.wave = wv_; F.vcu = vc_; F.G = g_; }
        { int ln_; asm volatile("v_mbcnt_lo_u32_b32 %0, -1, 0\n\tv_mbcnt_hi_u32_b32 %0, -1, %0" : "=v"(ln_)); F.lane = ln_; F.tid = F.wave * 64 + ln_; }
        { const CAS Args* ap = (const CAS Args*)__builtin_amdgcn_kernarg_segment_ptr(); asm volatile("" : "+s"(ap)); F.inp = ap->in; F.out = ap->out; unsigned char* w_ = ap->ws; F.ws = w_; F.ctl = (unsigned*)(w_ + WS_CTL); F.ctlf = (float*)(w_ + WS_CTL); F.stats = (float*)(w_ + WS_STATS); }
        const int l = ph >= 10 ? 1 : 0, q = ph == 0 ? -1 : (l ? ph - 10 : ph - 1);
        unsigned char* wb = wblk(F, l);
        float* ssq = F.stats + SF_SSQ + (size_t)l * 2 * T * 4;
        const float* rss_in = F.stats + SF_ROWSS + (size_t)(l == 0 ? 0 : 2) * T * 16;
        float* rss_mid = F.stats + SF_ROWSS + (size_t)(l == 0 ? 1 : 3) * T * 16;
        if (q == -1) {
            if (PON(11)) p0_prologue(F);
        } else if (q == 0 && PON(0)) {
            pg8::SchedGrid S{(const char*)(F.ws + WS_XB), (const char*)(wb + WO_IN), (size_t)256 * 1024 * 2, (size_t)256 * 1024 * 2, 0, 64, 11, F.G, cblk, 1 << 30};
            { pg8::Unit u0; if (S.next(0, u0)) fill_rs(F, rss_in, u0.pm); }
            pg8::EpiProj E{act_ptr(F, A_CQKV), act_ptr(F, A_GQKV), act_ptr(F, A_OG), act_ptr(F, A_UP), act_ptr(F, A_MISC), (const LAS float*)(F.lds + RS_OFF), ssq};
            pg8::gemm_phase<pg8::EpiProj, pg8::SchedGrid, true, true>(F.lds, F.wave, 1024, 1024, S, E);
        } else if (q == 1 && PON(1)) {
            pg8::SchedGrid S{(const char*)act_ptr(F, A_CQKV), (const char*)(wb + WO_UP), (size_t)256 * 512 * 2, (size_t)256 * 256 * 2, (size_t)256 * 2, 64, 7, F.G, cblk, 3};
            pg8::EpiUp E{act_ptr(F, A_QKVRAW), ssq};
            pg8::gemm_phase<pg8::EpiUp, pg8::SchedGrid, true, true>(F.lds, F.wave, 512, 256, S, E);
        } else if (q == 2 && PON(2)) {
            phase_prep(F, l, rpt);
        } else if (q == 3 && PON(3)) {
            phase_mix(F, l + 2 * rpt, cblk);
        } else if (q == 4 && PON(4)) {
            pg8::SchedGrid S{(const char*)(F.ws + WS_XB), (const char*)(wb + WO_G), (size_t)256 * 1024 * 2, (size_t)256 * 1024 * 2, 0, 64, 12, F.G, cblk, 1 << 30};
            { pg8::Unit u0; if (S.next(0, u0)) fill_rs(F, rss_in, u0.pm); }
            pg8::EpiGate E{F.ws + WS_ACTS, (const LAS float*)(F.lds + RS_OFF)};
            pg8::gemm_phase<pg8::EpiGate, pg8::SchedGrid, true, true>(F.lds, F.wave, 1024, 1024, S, E);
            if (!rpt) gla_finalize(F, l);
        } else if (q == 5 && PON(5)) {
            pg8::SchedMerge S{(const char*)(F.ws + WS_ACTS), (const char*)(wb + WO_BR), F.G, cblk};
            pg8::EpiMerge E{F.ws + WS_ACTS, act_ptr(F, A_MERGED)};
            pg8::gemm_phase<pg8::EpiMerge, pg8::SchedMerge, true, true>(F.lds, F.wave, 512, 512, S, E);
        } else if (q == 6 && PON(6)) {
            pg8::SchedGrid S{(const char*)act_ptr(F, A_MERGED), (const char*)(wb + WO_OUT), (size_t)256 * 1024 * 2, (size_t)256 * 1024 * 2, 0, 64, 4, F.G, cblk, 1 << 30, MERGED_HI_DELTA};
            pg8::EpiResid E{(bf16_t*)(F.ws + WS_XB), rss_mid};
            pg8::gemm_phase<pg8::EpiResid, pg8::SchedGrid, true, true>(F.lds, F.wave, 1024, 1024, S, E);
        } else if (l == 0 && q == 7 && PON(7)) {
            pg8::SchedGrid S{(const char*)(F.ws + WS_XB), (const char*)(wb + WO_FGU), (size_t)256 * 1024 * 2, (size_t)256 * 1024 * 2, 0, 64, 22, F.G, cblk, 1 << 30};
            if (F.G == 256) S.split_from = 1280;
            { pg8::Unit u0; if (S.next(0, u0)) fill_rs(F, rss_mid, u0.pm); }
            pg8::EpiSwiglu<false> E{act_ptr(F, A_ACT), DFF, (const LAS float*)(F.lds + RS_OFF), nullptr, nullptr};
            pg8::gemm_phase<pg8::EpiSwiglu<false>, pg8::SchedGrid, true, true>(F.lds, F.wave, 1024, 1024, S, E);
        } else if (l == 0 && q == 8 && PON(8)) {
            pg8::SchedGrid S{(const char*)act_ptr(F, A_ACT), (const char*)(wb + WO_FD), (size_t)256 * DFF * 2, (size_t)256 * DFF * 2, 0, 64, 4, F.G, cblk, 1 << 30};
            pg8::EpiResid E{(bf16_t*)(F.ws + WS_XB), F.stats + SF_ROWSS + (size_t)2 * T * 16};
            pg8::gemm_phase<pg8::EpiResid, pg8::SchedGrid, true, true>(F.lds, F.wave, DFF, DFF, S, E);
        } else if (q == 7 && PON(9)) {
            phase_route1(F);
            __syncthreads();
            LAS float* scr = (LAS float*)(F.lds + F.wave * 16384);
            const int gw = F.vcu * 8 + F.wave, NGW = F.G * 8;
            CONV_LOOP(12, moe_seg(F, (si_ < 4) ? (6 + (si_ >> 1)) * 3 + (si_ & 1) : (si_ - 4) * 3 + 2));
        } else if (q == 8 && PON(9)) {
            phase_route2(F);
        } else if (q == 9 && PON(10)) {
            unsigned char* wm = F.ws + WS_W0;
            LAS int* geo = (LAS int*)(F.lds + RING_BYTES + 512);
            moe_geometry(F, 0, geo);
            pg8::SchedMoe S; S.A = (const char*)act_ptr(F, A_XG); S.B = (const char*)(wm + WO_MGU); S.a_tile = (size_t)256 * 1024 * 2; S.b_tile = (size_t)256 * 1024 * 2; S.b_exp = (size_t)2816 * 1024 * 2;
            S.nN = 11; S.G = F.G; S.c = cblk;
            S.t1 = __builtin_amdgcn_readfirstlane(geo[1]); S.t2 = __builtin_amdgcn_readfirstlane(geo[2]); S.t3 = __builtin_amdgcn_readfirstlane(geo[3]); S.t4 = __builtin_amdgcn_readfirstlane(geo[4]);
            S.t5 = __builtin_amdgcn_readfirstlane(geo[5]); S.t6 = __builtin_amdgcn_readfirstlane(geo[6]); S.t7 = __builtin_amdgcn_readfirstlane(geo[7]); S.MT = __builtin_amdgcn_readfirstlane(geo[8]);
            pg8::EpiSwiglu<true> E{act_ptr(F, A_ACTE), DEXP, (const LAS float*)nullptr, (const float*)(F.ws + WS_SLOT + SL_SCALE), (const float*)(F.ws + WS_SLOT + SL_COMB)};
            pg8::gemm_phase<pg8::EpiSwiglu<true>, pg8::SchedMoe, true, true>(F.lds, F.wave, 1024, 1024, S, E);
        } else if (q == 10 && PON(10)) {
            unsigned char* wm = F.ws + WS_W0;
            LAS int* geo = (LAS int*)(F.lds + RING_BYTES + 512);
            moe_geometry(F, 0, geo);
            pg8::SchedMoe S; S.A = (const char*)act_ptr(F, A_ACTE); S.B = (const char*)(wm + WO_MD); S.a_tile = (size_t)256 * DEXP * 2; S.b_tile = (size_t)256 * DEXP * 2; S.b_exp = (size_t)1024 * DEXP * 2;
            S.nN = 4; S.G = F.G; S.c = cblk;
            S.t1 = __builtin_amdgcn_readfirstlane(geo[1]); S.t2 = __builtin_amdgcn_readfirstlane(geo[2]); S.t3 = __builtin_amdgcn_readfirstlane(geo[3]); S.t4 = __builtin_amdgcn_readfirstlane(geo[4]);
            S.t5 = __builtin_amdgcn_readfirstlane(geo[5]); S.t6 = __builtin_amdgcn_readfirstlane(geo[6]); S.t7 = __builtin_amdgcn_readfirstlane(geo[7]); S.MT = __builtin_amdgcn_readfirstlane(geo[8]);
            { const int nt = S.MT * 4, rem = nt % F.G; if (rem > 0 && 2 * rem <= F.G) S.split_from = nt - rem; }
            pg8::EpiMoeDown E{act_ptr(F, A_Y)};
            pg8::gemm_phase<pg8::EpiMoeDown, pg8::SchedMoe, true, true>(F.lds, F.wave, DEXP, DEXP, S, E);
        }
        else if (q == 11) {
            const int* tslot = (const int*)(F.ws + WS_TSLOT); const bf16_t* y = act_ptr(F, A_Y);
            for (int t = F.vcu * 8 + F.wave; t < T; t += F.G * 8) {
                const int s0 = tslot[t * 2], s1 = tslot[t * 2 + 1];
                f32x4* xo = (f32x4*)(F.out + (size_t)t * D) + F.lane * 2;
                const bf16_t* xbr = (const bf16_t*)(F.ws + WS_XB) + (size_t)t * D;
#pragma unroll
                for (int j = 0; j < 2; ++j) {
                    const u32x4 a = *((const u32x4*)(y + (size_t)s0 * D) + 64 * j + F.lane), bq = *((const u32x4*)(y + (size_t)s1 * D) + 64 * j + F.lane);
                    const u32x4 xv = *((const u32x4*)xbr + 64 * j + F.lane);
                    f32x4 x0 = {bflo(xv.x), bfhi(xv.x), bflo(xv.y), bfhi(xv.y)}, x1 = {bflo(xv.z), bfhi(xv.z), bflo(xv.w), bfhi(xv.w)};
                    x0[0] += bflo(a.x) + bflo(bq.x); x0[1] += bfhi(a.x) + bfhi(bq.x); x0[2] += bflo(a.y) + bflo(bq.y); x0[3] += bfhi(a.y) + bfhi(bq.y);
                    x1[0] += bflo(a.z) + bflo(bq.z); x1[1] += bfhi(a.z) + bfhi(bq.z); x1[2] += bflo(a.w) + bflo(bq.w); x1[3] += bfhi(a.w) + bfhi(bq.w);
                    xo[128 * j] = x0; xo[128 * j + 1] = x1;
                }
            }
        }
        if (ph + 1 < hi || (!rpt && ((REP_MASK >> ph) & 1))) xcd_barrier(bar);
    }
}


#ifdef DBG_PH
__global__ void dbg_dump(const unsigned char* ws, float* out) {
    const size_t i = (size_t)blockIdx.x * 256 + threadIdx.x;
    float v = 0.f;
    const bf16_t* a0 = (const bf16_t*)(ws + WS_ACTS + DBG_A0); const bf16_t* a1 = (const bf16_t*)(ws + WS_ACTS + DBG_A1);
    if (i < (size_t)DBG_N0) v += __uint_as_float((unsigned)a0[i] << 16);
    if (i < (size_t)DBG_N1) v += 3.f * __uint_as_float((unsigned)a1[i] << 16);
    out[i] = v;
}
#endif

extern "C" void kernel_launch(void* const* d_in, const int* in_sizes, int n_in, void* d_out, int out_size, void* d_ws, size_t ws_size, hipStream_t stream) {
    static int grid = 0;
    if (grid == 0) {
        if (n_in != 25 || out_size != T * D || ws_size < WS_END) { fprintf(stderr, "kernel_launch: unexpected sizes (n_in %d out %d ws %zu)\n", n_in, out_size, ws_size); grid = -1; return; }
        int dev = 0, cus = 0;
        if (hipGetDevice(&dev) != hipSuccess || hipDeviceGetAttribute(&cus, hipDeviceAttributeMultiprocessorCount, dev) != hipSuccess) { grid = -1; return; }
        if (hipFuncSetAttribute((const void*)mega_fwd, hipFuncAttributeMaxDynamicSharedMemorySize, LDS_BYTES) != hipSuccess) { grid = -1; return; }
        int per_cu = 0;
        (void)hipOccupancyMaxActiveBlocksPerMultiprocessor(&per_cu, (const void*)mega_fwd, 512, LDS_BYTES);
        (void)hipGetLastError();
        grid = cus;
    }
    if (grid < 0) return;
    (void)hipMemsetAsync((char*)d_ws + WS_CTL, 0, CTL_BYTES, stream);
    Args a{};
    for (int i = 0; i < 25; ++i) a.in[i] = d_in[i];
    a.out = (float*)d_out; a.ws = (unsigned char*)d_ws; a.ph_lo = 0; a.ph_hi = NPHASE; a.li = 0; a.pad = 0;
#ifdef DBG_PH
    a.ph_hi = DBG_PH;
#endif
    void* kargs[] = {&a};
    hipError_t e = hipLaunchCooperativeKernel((const void*)mega_fwd, dim3(grid), dim3(512), kargs, LDS_BYTES, stream);
    if (e != hipSuccess) fprintf(stderr, "cooperative launch failed: %s (grid %d)\n", hipGetErrorString(e), grid);
#ifdef DBG_PH
    hipLaunchKernelGGL(dbg_dump, dim3(T * 1024 / 256), dim3(256), 0, stream, (const unsigned char*)d_ws, (float*)d_out);
#endif
}
```

```cpp
#include <hip/hip_runtime.h>
#include <cstdint>
#include <cstdio>

#define LAS __attribute__((address_space(3)))
#define CAS __attribute__((address_space(4)))
typedef const void* GPtr;
typedef unsigned short bf16_t;
typedef short bf16x8 __attribute__((ext_vector_type(8)));
typedef float f32x4 __attribute__((ext_vector_type(4)));
typedef float f32x16 __attribute__((ext_vector_type(16)));
typedef unsigned u32x4 __attribute__((ext_vector_type(4)));
typedef unsigned u32x2 __attribute__((ext_vector_type(2)));

constexpr int T = 16384, SEQ = 4096, NB = 4, D = 1024, DIN = 5680, DFF = 2816, DEXP = 1408, NEXP = 8;
constexpr int NPROJ = 2816;
constexpr float EPS = 1e-6f;
constexpr int MAXSLOT = 34816;

constexpr size_t MiB = 1u << 20;
constexpr size_t WS_CTL = 0, CTL_BYTES = 128 * 1024;
constexpr size_t WS_SLOT = 2 * MiB;
constexpr size_t WS_ROPE = 3 * MiB;
constexpr size_t WS_XB = 5 * MiB;
constexpr size_t WS_W1 = 37 * MiB;
constexpr size_t WS_W0 = 55 * MiB;
constexpr size_t WS_ACTS = 89 * MiB;
constexpr size_t WS_STATS = 283 * MiB;
constexpr size_t WS_END = 291 * MiB;
constexpr size_t WO_IN = 0, WO_G = 5632 * 1024, WO_UP = WO_G + 6 * MiB, WO_BR = WO_UP + 1792 * 256 * 2, WO_OUT = WO_BR + 3 * MiB, WO_FGU = WO_OUT + 2 * MiB, WO_FD = WO_FGU + 11 * MiB;
constexpr size_t WO_MGU = 0, WO_MD = 44 * MiB;
constexpr size_t A_OG = 0, A_GQKV = 16 * MiB, A_UP = 48 * MiB, A_MISC = 64 * MiB, A_CQKV = 72 * MiB, A_VT = 72 * MiB, A_QKVRAW = 88 * MiB;
constexpr size_t A_YSA = 96 * MiB, A_POOLED = 112 * MiB, A_YSB = 128 * MiB, A_QH = 144 * MiB, A_KH = 168 * MiB;
constexpr size_t A_G0 = 16 * MiB, A_G1 = 48 * MiB, A_G2 = 144 * MiB, A_ACT = 0;
constexpr size_t A_MERGED = 0;
constexpr long long MERGED_HI_DELTA = (long long)(64 * MiB);
constexpr size_t A_XG = 32 * MiB, A_ACTE = 100 * MiB, A_Y = 32 * MiB;
constexpr int CW_TMO = 0, CW_BAR = 4096, CW_QUEUE = 16384, CW_WGCNT = 20480;
static_assert((size_t)(CW_WGCNT + 2048) * 4 <= CTL_BYTES, "ctl");
constexpr size_t SF_SSQ = 0;
constexpr size_t SF_ROWSS = (size_t)2 * 2 * T * 4;
constexpr size_t SF_OSS = SF_ROWSS + (size_t)4 * T * 16;
constexpr size_t SF_EB = SF_OSS + (size_t)T * 32;
static_assert((SF_EB + (size_t)(T / 32) * 256) * 4 <= 8 * MiB, "stats");
constexpr size_t SL_TOK = 0, SL_SCALE = 139264, SL_COMB = 2 * 139264, SL_ROUTE = 3 * 139264;
constexpr size_t WS_TSLOT = 1 * MiB;

constexpr int RING_BYTES = 131072, LDSCTL_OFF = RING_BYTES, MISC_OFF = LDSCTL_OFF + 320, LDS_BYTES = 147456;
constexpr int RS_OFF = RING_BYTES + 1024;

#define LDS_WAIT() asm volatile("s_waitcnt lgkmcnt(0)" ::: "memory")
#define VM_WAIT() asm volatile("s_waitcnt vmcnt(0)" ::: "memory")
#define LDS_BARRIER() do { asm volatile("s_waitcnt lgkmcnt(0)" ::: "memory"); __builtin_amdgcn_s_barrier(); asm volatile("" ::: "memory"); } while (0)
#define RLX_AGENT __ATOMIC_RELAXED, __HIP_MEMORY_SCOPE_AGENT
typedef float f32x2_t __attribute__((ext_vector_type(2))); typedef __bf16 bf16x2_t __attribute__((ext_vector_type(2)));
__device__ __forceinline__ unsigned cvt_pk_bf16(float lo, float hi) { f32x2_t v = {lo, hi}; bf16x2_t b = __builtin_convertvector(v, bf16x2_t); return __builtin_bit_cast(unsigned, b); }
__device__ __forceinline__ float bflo(unsigned u) { return __uint_as_float(u << 16); }
__device__ __forceinline__ float bfhi(unsigned u) { return __uint_as_float(u & 0xffff0000u); }
__device__ __forceinline__ float wave_sum(float v) {
#pragma unroll
    for (int o = 1; o < 64; o <<= 1) v += __shfl_xor(v, o);
    return v;
}
__device__ __forceinline__ float sum16(const float* p) { const f32x4 a = *(const f32x4*)p, b = *(const f32x4*)(p + 4), c = *(const f32x4*)(p + 8), d = *(const f32x4*)(p + 12);
    return (((a[0] + a[1]) + (a[2] + a[3])) + ((b[0] + b[1]) + (b[2] + b[3]))) + (((c[0] + c[1]) + (c[2] + c[3])) + ((d[0] + d[1]) + (d[2] + d[3]))); }
__device__ __forceinline__ float sum4(const float* p) { const f32x4 a = *(const f32x4*)p; return (a[0] + a[1]) + (a[2] + a[3]); }
__device__ __forceinline__ float fast_sigmoid(float z) { return __builtin_amdgcn_rcpf(1.f + __builtin_amdgcn_exp2f(-1.4426950408889634f * z)); }

namespace pg8 {
constexpr int BM = 256, BK = 64, HALF = 128, HTB = HALF * BK * 2, STAGE_BYTES = 8 * HTB, NXCD = 8, WGM = 8;
__host__ __device__ __forceinline__ int lds_byte(int r, int c) { const int st = (r >> 4) * 2 + (c >> 5), rr = r & 15, cc = c & 31, ob = rr * 64 + cc * 2; return st * 1024 + (ob ^ (((ob >> 9) & 1) << 5)); }
__host__ __device__ __forceinline__ void stage_rc(int b, int& R, int& C) { const int st = b / 1024, sb = b % 1024, swz = sb ^ (((sb >> 9) & 1) << 5); R = (st >> 1) * 16 + swz / 64; C = (st & 1) * 32 + (swz % 64) / 2; }
__host__ __device__ __forceinline__ int perm32(int rho) { const int n = rho >> 4, i = rho & 15; return 8 * (i >> 2) + 4 * n + (i & 3); }

struct Unit { const char* a; const char* b; int pm, pn, kind, half; };
__device__ __forceinline__ void tile_map(int L, int nM, int nN, int& pm, int& pn) {
    const int nwg = nM * nN; int wgid = L;
    { const int q = nwg / NXCD, r = nwg % NXCD, xcd = wgid % NXCD, off = wgid / NXCD; wgid = (xcd < r ? xcd * (q + 1) : r * (q + 1) + (xcd - r) * q) + off; }
    const int nig = WGM * nN, gid = wgid / nig, fm = gid * WGM, gsz = (nM - fm) < WGM ? (nM - fm) : WGM;
    pm = fm + ((wgid % nig) % gsz); pn = (wgid % nig) / gsz;
}

template <class Epi, class Sched, bool ALIGN_EPI, bool SP2>
__device__ __forceinline__ void gemm_phase(LAS unsigned char* lds, const int wave_in, const int lda, const int K, const Sched& S, const Epi& E) {
    int ln_; asm volatile("v_mbcnt_lo_u32_b32 %0, -1, 0\n\tv_mbcnt_hi_u32_b32 %0, -1, %0" : "=v"(ln_));
    const int tid = wave_in * 64 + ln_, wid = __builtin_amdgcn_readfirstlane(tid >> 6), lane = tid & 63, wr = wid >> 2, wc = wid & 3, fr = lane & 15, fq = lane >> 4;
    const int nt = K / BK;
    unsigned voffA[2], voffB[2];
#pragma unroll
    for (int i = 0; i < 2; ++i) { int R, C; stage_rc(tid * 16 + i * 8192, R, C); const int Rb = Epi::PERM ? ((R & ~31) + perm32(R & 31)) : R;
        voffA[i] = (unsigned)(R * lda + C) * 2u; voffB[i] = (unsigned)(Rb * K + C) * 2u; }
    const size_t kstep = (size_t)(BK * 2);
    const size_t hstepA = (size_t)HALF * lda * 2, hstepB = (size_t)HALF * K * 2;
    const unsigned ldsw = (unsigned)wid * 1024u;
    const int aoff = lds_byte(wr * 64 + fr, fq * 8), boff = lds_byte(wc * 32 + fr, fq * 8);
#define PG8_SA(b, h) (((b) * 2 + (h)) * HTB)
#define PG8_SB(b, h) ((4 + (b) * 2 + (h)) * HTB)
#define PG8_STAGE(bufoff, gbase, voff) do { _Pragma("unroll") for (int _i = 0; _i < 2; ++_i) \
        __builtin_amdgcn_global_load_lds((const unsigned*)((const char*)(gbase) + (voff)[_i]), (LAS unsigned*)(lds + (bufoff) + ldsw + _i * 8192), 16, 0, 0); } while (0)
#define PG8_LDA(dst, b, h) do { _Pragma("unroll") for (int m = 0; m < 4; ++m) _Pragma("unroll") for (int k = 0; k < 2; ++k) dst[m][k] = *(const LAS bf16x8*)(lds + PG8_SA(b, h) + aoff + m * 2048 + k * 1024); } while (0)
#define PG8_LDB(dst, b, h) do { _Pragma("unroll") for (int n = 0; n < 2; ++n) _Pragma("unroll") for (int k = 0; k < 2; ++k) dst[n][k] = *(const LAS bf16x8*)(lds + PG8_SB(b, h) + boff + n * 2048 + k * 1024); } while (0)
#define PG8_MMA(ai, bj, At, Bt) do { __builtin_amdgcn_s_setprio(1); _Pragma("unroll") for (int m = 0; m < 4; ++m) _Pragma("unroll") for (int n = 0; n < 2; ++n) _Pragma("unroll") for (int k = 0; k < 2; ++k) \
        acc[ai][bj][m][n] = __builtin_amdgcn_mfma_f32_16x16x32_bf16(Bt[n][k], At[m][k], acc[ai][bj][m][n], 0, 0, 0); __builtin_amdgcn_s_setprio(0); } while (0)
#define PG8_WAIT_V(n) asm volatile("s_waitcnt vmcnt(" #n ")" ::: "memory")
#define PG8_WAIT_L(n) asm volatile("s_waitcnt lgkmcnt(" #n ")" ::: "memory")
#define PG8_BAR __builtin_amdgcn_s_barrier()
#define PG8_SCHED __builtin_amdgcn_sched_barrier(0)
    Unit cur, nxt; int ui = 0;
    if (!S.next(0, cur)) return;
    f32x4 acc[2][2][4][2];
#pragma unroll
    for (int a = 0; a < 2; ++a)
#pragma unroll
        for (int b = 0; b < 2; ++b)
#pragma unroll
            for (int m = 0; m < 4; ++m)
#pragma unroll
                for (int n = 0; n < 2; ++n) acc[a][b][m][n] = (f32x4){0.f, 0.f, 0.f, 0.f};
    bf16x8 At[4][2], B0[2][2], B1[2][2];
    const char* cA = cur.a; const char* cB = cur.b;
    if constexpr (SP2) {
        PG8_STAGE(PG8_SB(0, 0), cB, voffB); PG8_STAGE(PG8_SB(0, 1), cB + hstepB, voffB); PG8_STAGE(PG8_SA(0, 0), cA, voffA); PG8_STAGE(PG8_SA(0, 1), cA + hstepA, voffA);
        if (wr == 1) PG8_BAR;
        PG8_WAIT_V(2); PG8_BAR;
        PG8_STAGE(PG8_SB(1, 0), cB + kstep, voffB); PG8_STAGE(PG8_SA(1, 0), cA + kstep, voffA); PG8_STAGE(PG8_SB(1, 1), cB + hstepB + kstep, voffB);
        PG8_WAIT_V(6); PG8_BAR;
    } else {
        PG8_STAGE(PG8_SB(0, 0), cB, voffB); PG8_STAGE(PG8_SA(0, 0), cA, voffA); PG8_STAGE(PG8_SB(0, 1), cB + hstepB, voffB); PG8_STAGE(PG8_SA(0, 1), cA + hstepA, voffA);
        if (wr == 1) PG8_BAR;
        PG8_WAIT_V(4); PG8_BAR;
        PG8_STAGE(PG8_SB(1, 0), cB + kstep, voffB); PG8_STAGE(PG8_SA(1, 0), cA + kstep, voffA); PG8_STAGE(PG8_SB(1, 1), cB + hstepB + kstep, voffB);
        PG8_WAIT_V(6); PG8_BAR;
    }
    for (;;) {
        const bool has_next = S.next(ui + 1, nxt);
        const bool do0 = cur.half != 2, do1 = cur.half != 1;
        const char* nA = has_next ? nxt.a : cA; const char* nB = has_next ? nxt.b : cB;
#pragma unroll 1
        for (int t = 0; t < nt; t += 2) {
            const bool last = (t == nt - 2);
            const char* a1 = cA + (size_t)(t + 1) * kstep;
            const char* a2 = last ? nA : cA + (size_t)(t + 2) * kstep; const char* b2 = last ? nB : cB + (size_t)(t + 2) * kstep;
            const char* a3 = a2 + kstep; const char* b3 = b2 + kstep;
            if constexpr (SP2) {
            PG8_LDB(B0, 0, 0); PG8_LDB(B1, 0, 1); PG8_SCHED; PG8_LDA(At, 0, 0); PG8_STAGE(PG8_SA(1, 1), a1 + hstepA, voffA);
            PG8_WAIT_V(8); PG8_WAIT_L(0); PG8_BAR; if (do0) { PG8_MMA(0, 0, At, B0); PG8_MMA(0, 1, At, B1); } PG8_BAR; PG8_SCHED;
            PG8_LDA(At, 0, 1); PG8_STAGE(PG8_SB(0, 0), b2, voffB); PG8_STAGE(PG8_SB(0, 1), b2 + hstepB, voffB); PG8_STAGE(PG8_SA(0, 0), a2, voffA);
            PG8_WAIT_V(8); PG8_WAIT_L(0); PG8_BAR; if (do1) { PG8_MMA(1, 0, At, B0); PG8_MMA(1, 1, At, B1); } PG8_BAR; PG8_SCHED;
            PG8_LDB(B0, 1, 0); PG8_LDB(B1, 1, 1); PG8_SCHED; PG8_LDA(At, 1, 0); PG8_STAGE(PG8_SA(0, 1), a2 + hstepA, voffA);
            PG8_WAIT_V(8); PG8_WAIT_L(0); PG8_BAR; if (do0) { PG8_MMA(0, 0, At, B0); PG8_MMA(0, 1, At, B1); } PG8_BAR; PG8_SCHED;
            PG8_LDA(At, 1, 1); PG8_STAGE(PG8_SB(1, 0), b3, voffB); PG8_STAGE(PG8_SB(1, 1), b3 + hstepB, voffB); PG8_STAGE(PG8_SA(1, 0), a3, voffA);
            PG8_WAIT_V(8); PG8_WAIT_L(0); PG8_BAR; if (do1) { PG8_MMA(1, 0, At, B0); PG8_MMA(1, 1, At, B1); } PG8_BAR; PG8_SCHED;
            } else {
            PG8_LDB(B0, 0, 0); PG8_SCHED; PG8_LDA(At, 0, 0); PG8_STAGE(PG8_SA(1, 1), a1 + hstepA, voffA);
            PG8_WAIT_L(8); PG8_BAR; PG8_WAIT_L(0); PG8_MMA(0, 0, At, B0); PG8_BAR; PG8_SCHED;
            PG8_LDB(B1, 0, 1); PG8_STAGE(PG8_SB(0, 0), b2, voffB);
            PG8_BAR; PG8_WAIT_L(0); PG8_MMA(0, 1, At, B1); PG8_BAR;
            PG8_LDA(At, 0, 1); PG8_STAGE(PG8_SA(0, 0), a2, voffA);
            PG8_BAR; PG8_WAIT_L(0); PG8_MMA(1, 0, At, B0); PG8_BAR; PG8_SCHED;
            PG8_STAGE(PG8_SB(0, 1), b2 + hstepB, voffB);
            PG8_WAIT_V(6); PG8_BAR; PG8_MMA(1, 1, At, B1); PG8_BAR;
            PG8_LDB(B0, 1, 0); PG8_SCHED; PG8_LDA(At, 1, 0); PG8_STAGE(PG8_SA(0, 1), a2 + hstepA, voffA);
            PG8_WAIT_L(8); PG8_BAR; PG8_WAIT_L(0); PG8_MMA(0, 0, At, B0); PG8_BAR; PG8_SCHED;
            PG8_LDB(B1, 1, 1); PG8_STAGE(PG8_SB(1, 0), b3, voffB);
            PG8_BAR; PG8_WAIT_L(0); PG8_MMA(0, 1, At, B1); PG8_BAR;
            PG8_LDA(At, 1, 1); PG8_STAGE(PG8_SA(1, 0), a3, voffA);
            PG8_BAR; PG8_WAIT_L(0); PG8_MMA(1, 0, At, B0); PG8_BAR; PG8_SCHED;
            PG8_STAGE(PG8_SB(1, 1), b3 + hstepB, voffB);
            PG8_WAIT_V(6); PG8_BAR; PG8_MMA(1, 1, At, B1); PG8_BAR;
            }
        }
        if constexpr (ALIGN_EPI) { if (wr == 0) PG8_BAR; }
        E(acc, cur, wr, wc, fr, fq);
        if (!has_next) break;
        if (!E.keep(cur)) {
#pragma unroll
            for (int a = 0; a < 2; ++a)
#pragma unroll
                for (int b = 0; b < 2; ++b)
#pragma unroll
                    for (int m = 0; m < 4; ++m)
#pragma unroll
                        for (int n = 0; n < 2; ++n) acc[a][b][m][n] = (f32x4){0.f, 0.f, 0.f, 0.f};
        }
        cur = nxt; cA = nA; cB = nB; ++ui;
        if constexpr (ALIGN_EPI) { if (wr == 1) PG8_BAR; }
    }
    PG8_WAIT_V(0);
    if constexpr (!ALIGN_EPI) { if (wr == 0) PG8_BAR; }
    PG8_BAR;
#undef PG8_SA
#undef PG8_SB
#undef PG8_STAGE
#undef PG8_LDA
#undef PG8_LDB
#undef PG8_MMA
#undef PG8_WAIT_V
#undef PG8_WAIT_L
#undef PG8_BAR
#undef PG8_SCHED
}

typedef f32x4 Acc[2][2][4][2];

struct EpiProj {
    static constexpr bool PERM = true;
    bf16_t *cqkv, *gqkv, *og, *up, *misc; const LAS float* rs_tab; float* ssq;
    __device__ __forceinline__ bool keep(const Unit&) const { return false; }
    __device__ __forceinline__ void operator()(Acc& acc, const Unit& u, int wr, int wc, int fr, int fq) const {
        const int row0 = u.pm * BM + wr * 64 + fr;
        bf16_t* dst; int ld, coff; const int pn = u.pn;
        if (pn < 2) { dst = cqkv; ld = 512; coff = pn * 256; }
        else if (pn < 6) { dst = gqkv; ld = 1024; coff = (pn - 2) * 256; }
        else if (pn < 8) { dst = og; ld = 512; coff = (pn - 6) * 256; }
        else if (pn < 10) { dst = up; ld = 512; coff = (pn - 8) * 256; }
        else { dst = misc; ld = 256; coff = 0; }
        const int col0 = coff + wc * 32 + 8 * fq;
#pragma unroll
        for (int ai = 0; ai < 2; ++ai)
#pragma unroll
            for (int m = 0; m < 4; ++m) { if (u.half && ai != u.half - 1) continue;
                const int row = row0 + ai * HALF + m * 16;
                const float rs = rs_tab[wr * 64 + fr + ai * HALF + m * 16];
                float ss = 0.f;
#pragma unroll
                for (int bj = 0; bj < 2; ++bj) {
                    const f32x4 v0 = acc[ai][bj][m][0] * rs, v1 = acc[ai][bj][m][1] * rs;
                    ss += (v0[0] * v0[0] + v0[1] * v0[1]) + (v0[2] * v0[2] + v0[3] * v0[3]) + (v1[0] * v1[0] + v1[1] * v1[1]) + (v1[2] * v1[2] + v1[3] * v1[3]);
                    u32x4 w; w.x = cvt_pk_bf16(v0[0], v0[1]); w.y = cvt_pk_bf16(v0[2], v0[3]); w.z = cvt_pk_bf16(v1[0], v1[1]); w.w = cvt_pk_bf16(v1[2], v1[3]);
                    *(u32x4*)(dst + (size_t)row * ld + col0 + bj * HALF) = w;
                }
                if (pn < 2) { ss += __shfl_xor(ss, 16); ss += __shfl_xor(ss, 32); if (fq == 0) ssq[((size_t)pn * T + row) * 4 + wc] = ss; }
            }
    }
};
struct EpiUp {
    static constexpr bool PERM = true;
    bf16_t* out; const float* ssq;
    __device__ __forceinline__ bool keep(const Unit&) const { return false; }
    __device__ __forceinline__ void operator()(Acc& acc, const Unit& u, int wr, int wc, int fr, int fq) const {
        const int row0 = u.pm * BM + wr * 64 + fr, col0 = u.pn * BM + wc * 32 + 8 * fq;
        const float* sq = ssq + (u.pn < 3 ? (size_t)0 : (size_t)T * 4);
        f32x4 sqv[2][4];
#pragma unroll
        for (int ai = 0; ai < 2; ++ai)
#pragma unroll
            for (int m = 0; m < 4; ++m) sqv[ai][m] = *(const f32x4*)(sq + (size_t)(row0 + ai * HALF + m * 16) * 4);
#pragma unroll
        for (int ai = 0; ai < 2; ++ai)
#pragma unroll
            for (int m = 0; m < 4; ++m) { if (u.half && ai != u.half - 1) continue;
                const int row = row0 + ai * HALF + m * 16;
                const float rs = rsqrtf(((sqv[ai][m][0] + sqv[ai][m][1]) + (sqv[ai][m][2] + sqv[ai][m][3])) * (1.f / 256.f) + EPS);
#pragma unroll
                for (int bj = 0; bj < 2; ++bj) {
                    const f32x4 v0 = acc[ai][bj][m][0] * rs, v1 = acc[ai][bj][m][1] * rs;
                    u32x4 w; w.x = cvt_pk_bf16(v0[0], v0[1]); w.y = cvt_pk_bf16(v0[2], v0[3]); w.z = cvt_pk_bf16(v1[0], v1[1]); w.w = cvt_pk_bf16(v1[2], v1[3]);
                    *(u32x4*)(out + (size_t)row * 1792 + col0 + bj * HALF) = w;
                }
            }
    }
};
struct EpiGate {
    static constexpr bool PERM = true;
    unsigned char* acts; const LAS float* rs_tab;
    __device__ __forceinline__ bool keep(const Unit&) const { return false; }
    __device__ __forceinline__ void operator()(Acc& acc, const Unit& u, int wr, int wc, int fr, int fq) const {
        const int row0 = u.pm * BM + wr * 64 + fr, pl = u.pn >> 2, col0 = (u.pn & 3) * BM + wc * 32 + 8 * fq;
        bf16_t* dst = (bf16_t*)(acts + ((long long)A_G0 + (long long)(pl == 1) * (long long)(A_G1 - A_G0) + (long long)(pl == 2) * (long long)(A_G2 - A_G0)));
#pragma unroll
        for (int ai = 0; ai < 2; ++ai)
#pragma unroll
            for (int m = 0; m < 4; ++m) { if (u.half && ai != u.half - 1) continue;
                const int row = row0 + ai * HALF + m * 16;
                const float rs = rs_tab[wr * 64 + fr + ai * HALF + m * 16];
#pragma unroll
                for (int bj = 0; bj < 2; ++bj) {
                    f32x4 v0 = acc[ai][bj][m][0] * rs, v1 = acc[ai][bj][m][1] * rs;
#ifndef DBG_NOSIG
#pragma unroll
                    for (int e = 0; e < 4; ++e) { v0[e] = fast_sigmoid(fminf(fmaxf(v0[e], -60.f), 60.f)); v1[e] = fast_sigmoid(fminf(fmaxf(v1[e], -60.f), 60.f)); }
#endif
                    u32x4 w; w.x = cvt_pk_bf16(v0[0], v0[1]); w.y = cvt_pk_bf16(v0[2], v0[3]); w.z = cvt_pk_bf16(v1[0], v1[1]); w.w = cvt_pk_bf16(v1[2], v1[3]);
                    *(u32x4*)(dst + (size_t)row * 1024 + col0 + bj * HALF) = w;
                }
            }
    }
};
struct EpiMerge {
    static constexpr bool PERM = true;
    const unsigned char* acts; bf16_t* merged;
    __device__ __forceinline__ bool keep(const Unit& u) const { return u.kind < 2; }
    __device__ __forceinline__ void operator()(Acc& acc, const Unit& u, int wr, int wc, int fr, int fq) const {
        const int row0 = u.pm * BM + wr * 64 + fr, col0 = u.pn * BM + wc * 32 + 8 * fq, n = u.kind;
        const bf16_t* gn = (const bf16_t*)(acts + ((long long)A_G0 + (long long)(n == 1) * (long long)(A_G1 - A_G0) + (long long)(n == 2) * (long long)(A_G2 - A_G0)));
        const bf16_t* gd = (const bf16_t*)(acts + ((long long)A_G1 + (long long)(n != 0) * (long long)(A_G2 - A_G1)));
        if (n < 2) {
#pragma unroll
            for (int ai = 0; ai < 2; ++ai) {
                if (u.half && ai != u.half - 1) continue;
                u32x4 sn[4][2], sd[4][2];
#pragma unroll
                for (int m = 0; m < 4; ++m)
#pragma unroll
                    for (int bj = 0; bj < 2; ++bj) {
                        const size_t off = (size_t)(row0 + ai * HALF + m * 16) * 1024 + col0 + bj * HALF;
                        sn[m][bj] = *(const u32x4*)(gn + off); sd[m][bj] = *(const u32x4*)(gd + off);
                    }
#pragma unroll
                for (int m = 0; m < 4; ++m)
#pragma unroll
                    for (int bj = 0; bj < 2; ++bj) {
                        const u32x4 s = sn[m][bj], d = sd[m][bj];
                        f32x4 f0 = {bflo(s.x), bfhi(s.x), bflo(s.y), bfhi(s.y)}, f1 = {bflo(s.z), bfhi(s.z), bflo(s.w), bfhi(s.w)};
                        const f32x4 d0 = {bflo(d.x), bfhi(d.x), bflo(d.y), bfhi(d.y)}, d1 = {bflo(d.z), bfhi(d.z), bflo(d.w), bfhi(d.w)};
#pragma unroll
                        for (int e = 0; e < 4; ++e) { f0[e] *= __builtin_amdgcn_rcpf(d0[e]); f1[e] *= __builtin_amdgcn_rcpf(d1[e]); }
                        acc[ai][bj][m][0] = acc[ai][bj][m][0] * f0; acc[ai][bj][m][1] = acc[ai][bj][m][1] * f1;
                    }
            }
        } else {
#pragma unroll
            for (int ai = 0; ai < 2; ++ai) {
                if (u.half && ai != u.half - 1) continue;
                u32x4 sn[4][2];
#pragma unroll
                for (int m = 0; m < 4; ++m)
#pragma unroll
                    for (int bj = 0; bj < 2; ++bj) sn[m][bj] = *(const u32x4*)(gn + (size_t)(row0 + ai * HALF + m * 16) * 1024 + col0 + bj * HALF);
#pragma unroll
                for (int m = 0; m < 4; ++m)
#pragma unroll
                    for (int bj = 0; bj < 2; ++bj) {
                        const int row = row0 + ai * HALF + m * 16; const size_t off = (size_t)row * 1024 + col0 + bj * HALF;
                        const u32x4 s = sn[m][bj];
                        const f32x4 f0 = {bflo(s.x), bfhi(s.x), bflo(s.y), bfhi(s.y)}, f1 = {bflo(s.z), bfhi(s.z), bflo(s.w), bfhi(s.w)};
                        const f32x4 v0 = acc[ai][bj][m][0] * f0, v1 = acc[ai][bj][m][1] * f1;
                        u32x4 w; w.x = cvt_pk_bf16(v0[0], v0[1]); w.y = cvt_pk_bf16(v0[2], v0[3]); w.z = cvt_pk_bf16(v1[0], v1[1]); w.w = cvt_pk_bf16(v1[2], v1[3]);
                        *(u32x4*)((unsigned char*)(merged + off) + (row >= 8192 ? MERGED_HI_DELTA : 0)) = w;
                    }
            }
        }
    }
};
struct EpiResid {
    static constexpr bool PERM = true;
    bf16_t* xb; float* rowss_next;
    __device__ __forceinline__ bool keep(const Unit&) const { return false; }
    __device__ __forceinline__ void operator()(Acc& acc, const Unit& u, int wr, int wc, int fr, int fq) const {
        const int row0 = u.pm * BM + wr * 64 + fr, col0 = u.pn * BM + wc * 32 + 8 * fq;
#pragma unroll
        for (int ai = 0; ai < 2; ++ai) {
            if (u.half && ai != u.half - 1) continue;
            u32x4 ov[4][2];
#pragma unroll
            for (int m = 0; m < 4; ++m)
#pragma unroll
                for (int bj = 0; bj < 2; ++bj) ov[m][bj] = *(const u32x4*)(xb + (size_t)(row0 + ai * HALF + m * 16) * D + col0 + bj * HALF);
#pragma unroll
            for (int m = 0; m < 4; ++m) {
                const int row = row0 + ai * HALF + m * 16; float ss = 0.f;
#pragma unroll
                for (int bj = 0; bj < 2; ++bj) {
                    bf16_t* p = xb + (size_t)row * D + col0 + bj * HALF;
                    const u32x4 o = ov[m][bj];
                    const f32x4 v0 = (f32x4){bflo(o.x), bfhi(o.x), bflo(o.y), bfhi(o.y)} + acc[ai][bj][m][0], v1 = (f32x4){bflo(o.z), bfhi(o.z), bflo(o.w), bfhi(o.w)} + acc[ai][bj][m][1];
                    ss += ((v0[0] * v0[0] + v0[1] * v0[1]) + (v0[2] * v0[2] + v0[3] * v0[3])) + ((v1[0] * v1[0] + v1[1] * v1[1]) + (v1[2] * v1[2] + v1[3] * v1[3]));
                    u32x4 w; w.x = cvt_pk_bf16(v0[0], v0[1]); w.y = cvt_pk_bf16(v0[2], v0[3]); w.z = cvt_pk_bf16(v1[0], v1[1]); w.w = cvt_pk_bf16(v1[2], v1[3]);
                    *(u32x4*)p = w;
                }
                ss += __shfl_xor(ss, 16); ss += __shfl_xor(ss, 32); if (fq == 0) rowss_next[(size_t)row * 16 + u.pn * 4 + wc] = ss;
            }
        }
    }
};
template <bool MOE> struct EpiSwiglu {
    static constexpr bool PERM = true;
    bf16_t* act; int ld; const LAS float* rs_tab; const float* slot_scale; const float* slot_comb;
    __device__ __forceinline__ bool keep(const Unit&) const { return false; }
    __device__ __forceinline__ void operator()(Acc& acc, const Unit& u, int wr, int wc, int fr, int fq) const {
        const int row0 = u.pm * BM + wr * 64 + fr, col0 = u.pn * HALF + wc * 32 + 8 * fq;
        float rsv[2][4], cbv[2][4];
#pragma unroll
        for (int ai = 0; ai < 2; ++ai)
#pragma unroll
            for (int m = 0; m < 4; ++m) {
                if (MOE) { rsv[ai][m] = slot_scale[row0 + ai * HALF + m * 16]; cbv[ai][m] = slot_comb[row0 + ai * HALF + m * 16]; }
                else { rsv[ai][m] = rs_tab[wr * 64 + fr + ai * HALF + m * 16]; cbv[ai][m] = 1.f; }
            }
#pragma unroll
        for (int ai = 0; ai < 2; ++ai)
#pragma unroll
            for (int m = 0; m < 4; ++m) { if (u.half && ai != u.half - 1) continue;
                const int row = row0 + ai * HALF + m * 16;
                const float rs = rsv[ai][m], cb = cbv[ai][m];
                f32x4 o[2];
#pragma unroll
                for (int n = 0; n < 2; ++n) {
                    const f32x4 g = acc[ai][0][m][n] * rs, uu = acc[ai][1][m][n] * rs;
#pragma unroll
                    for (int e = 0; e < 4; ++e) o[n][e] = g[e] * fast_sigmoid(g[e]) * uu[e] * cb;
                }
                u32x4 w; w.x = cvt_pk_bf16(o[0][0], o[0][1]); w.y = cvt_pk_bf16(o[0][2], o[0][3]); w.z = cvt_pk_bf16(o[1][0], o[1][1]); w.w = cvt_pk_bf16(o[1][2], o[1][3]);
                *(u32x4*)(act + (size_t)row * ld + col0) = w;
            }
    }
};
struct EpiMoeDown {
    static constexpr bool PERM = true;
    bf16_t* y;
    __device__ __forceinline__ bool keep(const Unit&) const { return false; }
    __device__ __forceinline__ void operator()(Acc& acc, const Unit& u, int wr, int wc, int fr, int fq) const {
        const int row0 = u.pm * BM + wr * 64 + fr, col0 = u.pn * BM + wc * 32 + 8 * fq;
#pragma unroll
        for (int ai = 0; ai < 2; ++ai)
#pragma unroll
            for (int m = 0; m < 4; ++m) { if (u.half && ai != u.half - 1) continue;
                const int row = row0 + ai * HALF + m * 16;
#pragma unroll
                for (int bj = 0; bj < 2; ++bj) {
                    const f32x4 v0 = acc[ai][bj][m][0], v1 = acc[ai][bj][m][1];
                    u32x4 w; w.x = cvt_pk_bf16(v0[0], v0[1]); w.y = cvt_pk_bf16(v0[2], v0[3]); w.z = cvt_pk_bf16(v1[0], v1[1]); w.w = cvt_pk_bf16(v1[2], v1[3]);
                    *(u32x4*)(y + (size_t)row * D + col0 + bj * HALF) = w;
                }
            }
    }
};

struct SchedGrid {
    const char* A; const char* B; size_t a_tile, b_tile, a_alt; int nM, nN, G, c, alt_from; long long a_hi = 0;
    int split_from = 1 << 30;
    __device__ __forceinline__ bool next(int i, Unit& u) const {
        int L = i * G + c, hf = 0;
        if (L >= split_from) { const int nl = nM * nN - split_from, j = L - split_from; if (j >= 2 * nl) return false; hf = 1 + j / nl; L = split_from + j % nl; }
        if (L >= nM * nN) return false;
        int pm, pn; tile_map(L, nM, nN, pm, pn);
        u.pm = pm; u.pn = pn; u.kind = 0; u.half = hf; u.a = A + (size_t)pm * a_tile + (pn >= alt_from ? a_alt : 0) + (pm >= 32 ? a_hi : 0); u.b = B + (size_t)pn * b_tile; return true;
    }
};
struct SchedMerge {
    const char* acts; const char* wbr; int G, c;
    __device__ __forceinline__ bool next(int i, Unit& u) const {
        const int ti = i / 3, n = i - ti * 3, L = ti * G + c; if (L >= 256) return false;
        int pm, pn; tile_map(L, 64, 4, pm, pn);
        u.pm = pm; u.pn = pn; u.kind = n; u.half = 0; u.a = acts + ((long long)A_YSA + (long long)(n == 1) * ((long long)A_YSB - (long long)A_YSA) + (long long)(n == 2) * ((long long)A_POOLED - (long long)A_YSA)) + (size_t)pm * (256 * 512 * 2); u.b = wbr + (size_t)n * (1024 * 512 * 2) + (size_t)pn * (256 * 512 * 2); return true;
    }
};
struct SchedMoe {
    const char* A; const char* B; size_t a_tile, b_tile, b_exp; int MT, nN, G, c; int t1, t2, t3, t4, t5, t6, t7;
    int split_from = 1 << 30;
    __device__ __forceinline__ bool next(int i, Unit& u) const {
        int L = i * G + c, hf = 0;
        if (L >= split_from) { const int nl = MT * nN - split_from, j = L - split_from; if (j >= 2 * nl) return false; hf = 1 + j / nl; L = split_from + j % nl; }
        if (L >= MT * nN) return false;
        int pm, pn; tile_map(L, MT, nN, pm, pn);
        const int e = (pm >= t1) + (pm >= t2) + (pm >= t3) + (pm >= t4) + (pm >= t5) + (pm >= t6) + (pm >= t7);
        u.pm = pm; u.pn = pn; u.kind = e; u.half = hf; u.a = A + (size_t)pm * a_tile; u.b = B + (size_t)e * b_exp + (size_t)pn * b_tile; return true;
    }
};
}

#define XB_TMO      128
#define XB_XCNT(j)  (256  + 64 * (j))
#define XB_XSUB(j)  (1280 + 64 * (j))
#define XB_XGEN(j)  (2304 + 64 * (j))
#define XB_TOP      3328
#define XB_TOPGEN   3392
#define XCD_BAR_WORDS 3456
#define XB_SPIN_CAP (1u << 18)
__device__ __forceinline__ unsigned xb_ld(unsigned* p)              { return __hip_atomic_load(p, __ATOMIC_RELAXED, __HIP_MEMORY_SCOPE_AGENT); }
__device__ __forceinline__ unsigned xb_add(unsigned* p, unsigned v) { return __hip_atomic_fetch_add(p, v, __ATOMIC_RELAXED, __HIP_MEMORY_SCOPE_AGENT); }
__device__ __forceinline__ unsigned xb_xcc_id() { return (unsigned)__builtin_amdgcn_s_getreg((3 << 11) | 20) & 0xFu; }
#define XB_SPIN(cond, bar) do { unsigned _sp = 0; while (cond) { __builtin_amdgcn_s_sleep(1); \
    if ((++_sp & 255u) == 0u) { if (xb_ld(&(bar)[XB_TMO])) break; if (_sp > XB_SPIN_CAP) { atomicAdd(&(bar)[XB_TMO], 1u); break; } } } } while (0)
struct XcdBarrier { unsigned* bar; unsigned x; volatile LAS unsigned* st; };
__device__ __forceinline__ XcdBarrier xcd_barrier_post(unsigned* bar, volatile LAS unsigned* st) {
    XcdBarrier b; b.bar = bar; b.x = xb_xcc_id(); b.st = st;
    if (threadIdx.x == 0) (void)xb_add(&bar[XB_XCNT(b.x)], 1u);
    return b;
}
__device__ __forceinline__ void xcd_barrier_complete(unsigned* bar, unsigned x, unsigned& nloc, unsigned& nx) {
    const unsigned G = gridDim.x * gridDim.y * gridDim.z;
    unsigned sum, cnt, mine, sp = 0u;
    for (;;) {
        sum = 0u; cnt = 0u; mine = 0u;
#pragma unroll
        for (unsigned j = 0; j < 16; ++j) { const unsigned c = xb_ld(&bar[XB_XCNT(j)]); sum += c; cnt += (c > 0u) ? 1u : 0u; mine = (j == x) ? c : mine; }
        if (sum == G) break;
        __builtin_amdgcn_s_sleep(1);
        if ((++sp & 255u) == 0u) { if (xb_ld(&bar[XB_TMO])) break; if (sp > XB_SPIN_CAP) { atomicAdd(&bar[XB_TMO], 1u); break; } }
    }
    nloc = mine > 0u ? mine : 1u; nx = cnt > 0u ? cnt : 1u;
}
__device__ __forceinline__ void xcd_barrier(const XcdBarrier& b) {
    asm volatile("s_waitcnt vmcnt(0)" ::: "memory");
    __syncthreads();
    if (threadIdx.x == 0) {
        unsigned* bar = b.bar;
        __builtin_amdgcn_s_waitcnt(0);
        unsigned nloc = b.st[0], nx = b.st[1];
        if (nloc == 0u) { xcd_barrier_complete(bar, b.x, nloc, nx); b.st[0] = nloc; b.st[1] = nx; }
        const unsigned old = xb_add(&bar[XB_XSUB(b.x)], 1u);
        const unsigned gen = old / nloc;
        if (old + 1u == (gen + 1u) * nloc) {
            __builtin_amdgcn_fence(__ATOMIC_RELEASE, "agent");
            asm volatile("s_waitcnt vmcnt(0)" ::: "memory");
            const unsigned og = xb_add(&bar[XB_TOP], 1u);
            const unsigned tg = og / nx;
            if (og + 1u == (tg + 1u) * nx) xb_add(&bar[XB_TOPGEN], 1u);
            else XB_SPIN(xb_ld(&bar[XB_TOPGEN]) == tg, bar);
            __builtin_amdgcn_fence(__ATOMIC_ACQUIRE, "agent");
            xb_add(&bar[XB_XGEN(b.x)], 1u);
            asm volatile("s_waitcnt vmcnt(0)" ::: "memory");
        } else {
            XB_SPIN(xb_ld(&bar[XB_XGEN(b.x)]) == gen, bar);
            __builtin_amdgcn_fence(__ATOMIC_ACQUIRE, "agent");
            asm volatile("s_waitcnt vmcnt(0)" ::: "memory");
        }
    }
    __syncthreads();
}

struct Frame {
    LAS unsigned char* lds;
    volatile LAS unsigned* MISC;
    unsigned* ctl; float* ctlf; float* stats;
    unsigned char* ws;
    int tid, lane, wave, vcu, G;
    const CAS GPtr* inp;
    float* out;
    __device__ __forceinline__ const float* in(int i) const { return (const float*)inp[i]; }
};
enum { I_X = 0, I_POS, I_GMIX, I_WIN, I_GCQ, I_WUQ, I_GCKV, I_WUKV, I_GQKQ, I_GQKK, I_WGLA, I_BGLA, I_GGLAO, I_WPOOL, I_PSCALE, I_WBR, I_WOUT, I_GFFN, I_WFG, I_WFU, I_WFD, I_WROUTER, I_WEG, I_WEU, I_WED };

__device__ __forceinline__ bf16_t* act_ptr(const Frame& F, size_t off) { return (bf16_t*)(F.ws + WS_ACTS + off); }
__device__ __forceinline__ unsigned char* wblk(const Frame& F, int layer) { return F.ws + (layer == 0 ? WS_W0 : WS_W1); }

__device__ __forceinline__ void fill_rs(Frame& F, const float* rowss, int pm) {
    if (F.tid < 256) ((LAS float*)(F.lds + RS_OFF))[F.tid] = rsqrtf(sum16(rowss + ((size_t)pm * 256 + F.tid) * 16) * (1.f / 1024.f) + EPS);
    __syncthreads();
}
struct ConvSeg { const float* src; int ld, K, width, col0; bf16_t* dst; int row0, inter; const float* gain; };
typedef short v4i16c_t __attribute__((ext_vector_type(4)));
__device__ __forceinline__ int seg_items(const ConvSeg& s) { return (s.K >> 6) * ((s.width + 63) >> 6); }
__device__ __forceinline__ void conv_load(const ConvSeg& s, int item, int lane, f32x4 (&v)[16], float (&gv)[16]) {
    const int nblk = (s.width + 63) >> 6, kb = item / nblk, nb = item - kb * nblk, k0 = kb * 64, n0 = nb * 64;
    const int kq = lane >> 4, n4 = (lane & 15) * 4; const bool ok = n0 + n4 < s.width;
    const float* p = s.src + (size_t)(k0 + kq) * s.ld + s.col0 + n0 + n4;
#pragma unroll
    for (int i = 0; i < 16; ++i) v[i] = ok ? *(const f32x4*)(p + (size_t)(4 * i) * s.ld) : (f32x4){0.f, 0.f, 0.f, 0.f};
    const bool hg = s.gain != nullptr; const float* gp = hg ? s.gain + k0 + kq : s.src;
#pragma unroll
    for (int i = 0; i < 16; ++i) { const float g = gp[hg ? 4 * i : 0]; gv[i] = hg ? g : 1.f; }
}
__device__ __forceinline__ void conv_store(const ConvSeg& s, int item, LAS unsigned char* scr, int lane, const f32x4 (&v)[16], const float (&gv)[16]) {
    const int nblk = (s.width + 63) >> 6, kb = item / nblk, nb = item - kb * nblk, k0 = kb * 64, n0 = nb * 64;
    const int kq = lane >> 4, n4 = (lane & 15) * 4;
#pragma unroll
    for (int i = 0; i < 16; ++i) {
        const f32x4 x = v[i] * gv[i];
        *(LAS u32x2*)(scr + (4 * i + kq) * 136 + n4 * 2) = (u32x2){cvt_pk_bf16(x[0], x[1]), cvt_pk_bf16(x[2], x[3])};
    }
    LDS_WAIT();
    const int g = lane >> 4, i16 = lane & 15;
#pragma unroll
    for (int nb16 = 0; nb16 < 4; ++nb16)
#pragma unroll
        for (int kh = 0; kh < 2; ++kh) {
            const int c = kh * 4 + g;
            const LAS unsigned char* a = scr + (8 * c + (i16 >> 2)) * 136 + (nb16 * 16 + (i16 & 3) * 4) * 2;
            const v4i16c_t lo = __builtin_amdgcn_ds_read_tr16_b64_v4i16((LAS v4i16c_t*)a), hi = __builtin_amdgcn_ds_read_tr16_b64_v4i16((LAS v4i16c_t*)(a + 4 * 136));
            const int nq = n0 + nb16 * 16 + i16;
            if (nq < s.width) {
                const int drow = s.row0 + (s.inter ? ((nq >> 7) * 256 + (nq & 127)) : nq);
                typedef short s16x8_t __attribute__((ext_vector_type(8)));
                *(s16x8_t*)(s.dst + (size_t)drow * s.K + k0 + 8 * c) = (s16x8_t){lo[0], lo[1], lo[2], lo[3], hi[0], hi[1], hi[2], hi[3]};
            }
        }
    LDS_WAIT();
}
__device__ __forceinline__ ConvSeg mixer_seg(const Frame& F, int l, int idx) {
    unsigned char* wb = wblk(F, l);
    ConvSeg s; s.inter = 0; s.row0 = 0; s.col0 = 0;
    if (idx < 10) {
        int c0, wd, r0;
        switch (idx) {
            case 0: c0 = 0; wd = 256; r0 = 0; break;
            case 1: c0 = 256; wd = 256; r0 = 256; break;
            case 2: c0 = 544; wd = 256; r0 = 512; break;
            case 3: c0 = 800; wd = 256; r0 = 768; break;
            case 4: c0 = 1056; wd = 512; r0 = 1024; break;
            case 5: c0 = 1584; wd = 512; r0 = 1536; break;
            case 6: c0 = 2096; wd = 512; r0 = 2048; break;
            case 7: c0 = 512; wd = 32; r0 = 2560; break;
            case 8: c0 = 1568; wd = 16; r0 = 2592; break;
            default: c0 = 2608; wd = 3072; r0 = 0; break;
        }
        s.src = F.in(I_WIN) + (size_t)l * D * DIN; s.ld = DIN; s.K = D; s.width = wd; s.col0 = c0;
        s.dst = (bf16_t*)(wb + (idx == 9 ? WO_G : WO_IN)); s.row0 = r0; s.gain = F.in(I_GMIX) + l * D;
    } else if (idx == 10) { s.src = F.in(I_WUQ) + (size_t)l * 256 * 768; s.ld = 768; s.K = 256; s.width = 768; s.dst = (bf16_t*)(wb + WO_UP); s.gain = F.in(I_GCQ) + l * 256; }
    else if (idx == 11) { s.src = F.in(I_WUKV) + (size_t)l * 256 * 1024; s.ld = 1024; s.K = 256; s.width = 1024; s.dst = (bf16_t*)(wb + WO_UP); s.row0 = 768; s.gain = F.in(I_GCKV) + l * 256; }
    else if (idx < 14) { const int n = idx - 12; s.src = F.in(I_WBR) + (size_t)(l * 3 + n) * 512 * D; s.ld = D; s.K = 512; s.width = D; s.dst = (bf16_t*)(wb + WO_BR) + (size_t)n * 1024 * 512; s.gain = nullptr; }
    else { s.src = F.in(I_WOUT) + (size_t)l * D * D; s.ld = D; s.K = D; s.width = D; s.dst = (bf16_t*)(wb + WO_OUT); s.gain = nullptr; }
    return s;
}
__device__ __forceinline__ ConvSeg ffn_seg(const Frame& F, int idx) {
    unsigned char* wb = F.ws + WS_W0; ConvSeg s; s.col0 = 0; s.inter = 0; s.row0 = 0;
    if (idx < 2) { s.src = F.in(idx == 0 ? I_WFG : I_WFU); s.ld = DFF; s.K = D; s.width = DFF; s.dst = (bf16_t*)(wb + WO_FGU); s.row0 = idx * 128; s.inter = 1; s.gain = F.in(I_GFFN); }
    else { s.src = F.in(I_WFD); s.ld = D; s.K = DFF; s.width = D; s.dst = (bf16_t*)(wb + WO_FD); s.gain = nullptr; }
    return s;
}
__device__ __forceinline__ ConvSeg moe_seg(const Frame& F, int idx) {
    unsigned char* wb = F.ws + WS_W0; const int e = idx / 3, k = idx - e * 3; ConvSeg s; s.col0 = 0; s.inter = 0; s.row0 = 0;
    if (k < 2) { s.src = F.in(k == 0 ? I_WEG : I_WEU) + (size_t)e * D * DEXP; s.ld = DEXP; s.K = D; s.width = DEXP; s.dst = (bf16_t*)(wb + WO_MGU) + (size_t)e * 2816 * 1024; s.row0 = k * 128; s.inter = 1; s.gain = F.in(I_GFFN) + D; }
    else { s.src = F.in(I_WED) + (size_t)e * DEXP * D; s.ld = D; s.K = DEXP; s.width = D; s.dst = (bf16_t*)(wb + WO_MD) + (size_t)e * 1024 * 1408; s.gain = nullptr; }
    return s;
}
#define CONV_LOCATE(NSEG, GETSEG, IT, SEGOUT, IDXOUT) do { int r_ = (IT); for (int si_ = 0; si_ < (NSEG); ++si_) { const ConvSeg sg_ = GETSEG; const int n_ = seg_items(sg_); SEGOUT = sg_; IDXOUT = r_; if (r_ < n_) break; r_ -= n_; } } while (0)
#define CONV_LOOP(NSEG, GETSEG) do { int total_ = 0; for (int si_ = 0; si_ < (NSEG); ++si_) { const ConvSeg sg_ = GETSEG; total_ += seg_items(sg_); } \
        int it_ = gw; if (it_ < total_) { ConvSeg cs_; int ci_ = 0; f32x4 va_[16]; float ga_[16]; CONV_LOCATE(NSEG, GETSEG, it_, cs_, ci_); conv_load(cs_, ci_, F.lane, va_, ga_); \
        for (;;) { const int nx_ = it_ + NGW; const bool hn_ = nx_ < total_; ConvSeg ns_; int ni_ = 0; f32x4 vb_[16]; float gb_[16]; CONV_LOCATE(NSEG, GETSEG, (hn_ ? nx_ : it_), ns_, ni_); conv_load(ns_, ni_, F.lane, vb_, gb_); \
            _Pragma("unroll") for (int q_ = 0; q_ < 16; ++q_) { asm volatile("" : "+v"(va_[q_])); asm volatile("" : "+v"(ga_[q_])); } \
            conv_store(cs_, ci_, (LAS unsigned char*)scr, F.lane, va_, ga_); if (!hn_) break; \
            _Pragma("unroll") for (int q_ = 0; q_ < 16; ++q_) { va_[q_] = vb_[q_]; ga_[q_] = gb_[q_]; } cs_ = ns_; ci_ = ni_; it_ = nx_; } } } while (0)
__device__ __forceinline__ void fold_pool(const Frame& F, int l, int gw, int NGW) {
    const float* wp = F.in(I_WPOOL) + (size_t)l * 4 * 128 * 128; const float* ps = F.in(I_PSCALE) + l * 512; const float* wb2 = F.in(I_WBR) + (size_t)(l * 3 + 2) * 512 * D;
    bf16_t* dst = (bf16_t*)(wblk(F, l) + WO_BR) + (size_t)2 * 1024 * 512;
    for (int it = gw; it < 1024; it += NGW) {
        const int db = it & 15, g = (it >> 4) & 3, cb = it >> 6, d = db * 64 + F.lane, c0 = cb * 8;
        float a[8];
#pragma unroll
        for (int i = 0; i < 8; ++i) a[i] = 0.f;
        for (int j = 0; j < 128; ++j) {
            const float w = wb2[(size_t)(g * 128 + j) * D + d] * ps[g * 128 + j];
#pragma unroll
            for (int i = 0; i < 8; ++i) a[i] = fmaf(wp[(size_t)(g * 128 + c0 + i) * 128 + j], w, a[i]);
        }
        u32x4 o; o.x = cvt_pk_bf16(a[0], a[1]); o.y = cvt_pk_bf16(a[2], a[3]); o.z = cvt_pk_bf16(a[4], a[5]); o.w = cvt_pk_bf16(a[6], a[7]);
        *(u32x4*)(dst + (size_t)d * 512 + g * 128 + c0) = o;
    }
}

__device__ __forceinline__ void p0_prologue(Frame& F) {
    LAS float* scr = (LAS float*)(F.lds + F.wave * 16384);
    const int gw = F.vcu * 8 + F.wave, NGW = F.G * 8;
    { bf16_t* xb = (bf16_t*)(F.ws + WS_XB); float* rss = F.stats + SF_ROWSS;
      for (int m = gw; m < T; m += NGW) {
          const f32x4* xr = (const f32x4*)(F.in(I_X) + (size_t)m * D) + F.lane; float s = 0.f;
          unsigned long long* o8 = (unsigned long long*)(xb + (size_t)m * D) + F.lane;
#pragma unroll
          for (int j = 0; j < 4; ++j) { const f32x4 v = xr[64 * j]; s += (v[0] * v[0] + v[1] * v[1]) + (v[2] * v[2] + v[3] * v[3]);
              o8[64 * j] = (unsigned long long)cvt_pk_bf16(v[0], v[1]) | ((unsigned long long)cvt_pk_bf16(v[2], v[3]) << 32); }
          s = wave_sum(s); if (F.lane < 16) rss[(size_t)m * 16 + F.lane] = (F.lane == 0) ? s : 0.f;
      } }
    { float* rt = (float*)(F.ws + WS_ROPE); const int* pos = (const int*)F.in(I_POS);
      for (int i = F.vcu * 512 + F.tid; i < T * 16; i += F.G * 512) {
          const int t = i >> 4, k = i & 15; const float inv = powf(10000.f, -(float)k / 16.f), ang = (float)pos[t] * inv;
          rt[t * 32 + k] = cosf(ang); rt[t * 32 + 16 + k] = sinf(ang);
      } }
    CONV_LOOP(15, mixer_seg(F, 0, si_));
    fold_pool(F, 0, gw, NGW);
}

__device__ __forceinline__ void gla_prep(Frame& F, int l, int unit);
__device__ __forceinline__ void phase_prep(Frame& F, int l, int rpt = 0) {
    const bf16_t* raw = act_ptr(F, A_QKVRAW); const bf16_t* misc = act_ptr(F, A_MISC);
    bf16_t* QH = act_ptr(F, A_QH); bf16_t* KH = act_ptr(F, A_KH); bf16_t* VT = act_ptr(F, A_VT);
    const float* rope = (const float*)(F.ws + WS_ROPE);
    const float* gq = F.in(I_GQKQ) + l * 96; const float* gk = F.in(I_GQKK) + l * 96;
    LAS bf16_t* vt = (LAS bf16_t*)F.lds;
    for (int unit = F.vcu; unit < T / 64; unit += F.G) {
        const int t0 = unit * 64, b = t0 / SEQ, s0 = t0 % SEQ;
        if (!rpt) gla_prep(F, l, unit);
#pragma unroll 1
        for (int it = F.tid; it < 1024; it += 512) {
            const int which = it & 1, h = (it >> 1) & 7, tok = it >> 4, t = t0 + tok;
            const bf16_t* nope = raw + (size_t)t * 1792 + (which ? 768 + h * 128 : h * 96);
            const bf16_t* rp = which ? misc + (size_t)t * 256 : nope + 64;
            const float* g = which ? gk : gq;
            u32x4 c[12];
#pragma unroll
            for (int i = 0; i < 8; ++i) c[i] = *(const u32x4*)(nope + 8 * i);
#pragma unroll
            for (int i = 0; i < 4; ++i) c[8 + i] = *(const u32x4*)(rp + 8 * i);
            float ss = 0.f;
#pragma unroll
            for (int i = 0; i < 12; ++i) {
                const float a0 = bflo(c[i].x), a1 = bfhi(c[i].x), a2 = bflo(c[i].y), a3 = bfhi(c[i].y), a4 = bflo(c[i].z), a5 = bfhi(c[i].z), a6 = bflo(c[i].w), a7 = bfhi(c[i].w);
                ss += (a0 * a0 + a1 * a1) + (a2 * a2 + a3 * a3) + (a4 * a4 + a5 * a5) + (a6 * a6 + a7 * a7);
            }
            float r = rsqrtf(ss * (1.f / 96.f) + EPS);
            if (!which) r *= 0.14724444f;
            bf16_t* dst = (which ? KH : QH) + ((size_t)(b * 8 + h) * SEQ + s0 + tok) * 96;
#pragma unroll
            for (int i = 0; i < 8; ++i) {
                const f32x4 g0 = *(const f32x4*)(g + 8 * i), g1 = *(const f32x4*)(g + 8 * i + 4);
                u32x4 o; o.x = cvt_pk_bf16(bflo(c[i].x) * r * g0[0], bfhi(c[i].x) * r * g0[1]); o.y = cvt_pk_bf16(bflo(c[i].y) * r * g0[2], bfhi(c[i].y) * r * g0[3]);
                o.z = cvt_pk_bf16(bflo(c[i].z) * r * g1[0], bfhi(c[i].z) * r * g1[1]); o.w = cvt_pk_bf16(bflo(c[i].w) * r * g1[2], bfhi(c[i].w) * r * g1[3]);
                *(u32x4*)(dst + 8 * i) = o;
            }
#pragma unroll
            for (int hh = 0; hh < 2; ++hh) {
                const u32x4 x1c = c[8 + hh], x2c = c[10 + hh];
                float x1[8] = {bflo(x1c.x), bfhi(x1c.x), bflo(x1c.y), bfhi(x1c.y), bflo(x1c.z), bfhi(x1c.z), bflo(x1c.w), bfhi(x1c.w)};
                float x2[8] = {bflo(x2c.x), bfhi(x2c.x), bflo(x2c.y), bfhi(x2c.y), bflo(x2c.z), bfhi(x2c.z), bflo(x2c.w), bfhi(x2c.w)};
                float o1[8], o2[8];
#pragma unroll
                for (int i = 0; i < 8; ++i) {
                    const int k = hh * 8 + i; const float cs = rope[(size_t)t * 32 + k], sn = rope[(size_t)t * 32 + 16 + k];
                    const float a = x1[i] * r * g[64 + k], bb = x2[i] * r * g[80 + k];
                    o1[i] = a * cs - bb * sn; o2[i] = bb * cs + a * sn;
                }
                u32x4 w1, w2; w1.x = cvt_pk_bf16(o1[0], o1[1]); w1.y = cvt_pk_bf16(o1[2], o1[3]); w1.z = cvt_pk_bf16(o1[4], o1[5]); w1.w = cvt_pk_bf16(o1[6], o1[7]);
                w2.x = cvt_pk_bf16(o2[0], o2[1]); w2.y = cvt_pk_bf16(o2[2], o2[3]); w2.z = cvt_pk_bf16(o2[4], o2[5]); w2.w = cvt_pk_bf16(o2[6], o2[7]);
                *(u32x4*)(dst + 64 + hh * 8) = w1; *(u32x4*)(dst + 80 + hh * 8) = w2;
            }
        }
        {
            const int tok = F.tid >> 3, cc = F.tid & 7;
            u32x4 vr[8];
#pragma unroll
            for (int h = 0; h < 8; ++h) vr[h] = *(const u32x4*)(raw + (size_t)(t0 + tok) * 1792 + 768 + h * 128 + 64 + cc * 8);
#pragma unroll
            for (int h = 0; h < 8; ++h) *(LAS u32x4*)(F.lds + h * 9216 + tok * 144 + cc * 16) = vr[h];
            __syncthreads();
            const int db = F.wave & 3, c = (F.wave >> 2) * 4 + (F.lane >> 4), i16 = F.lane & 15;
#pragma unroll
            for (int h = 0; h < 8; ++h) {
                const LAS unsigned char* a = F.lds + h * 9216 + (8 * c + (i16 >> 2)) * 144 + (16 * db + (i16 & 3) * 4) * 2;
                const v4i16c_t lo = __builtin_amdgcn_ds_read_tr16_b64_v4i16((LAS v4i16c_t*)a), hi = __builtin_amdgcn_ds_read_tr16_b64_v4i16((LAS v4i16c_t*)(a + 4 * 144));
                typedef short s16x8_t __attribute__((ext_vector_type(8)));
                bf16_t* vrow = VT + (((size_t)(b * 8 + h) * (SEQ / 64) + (s0 >> 6)) * 64 + 16 * db + i16) * 64;
                *(v4i16c_t*)(vrow + 4 * c) = lo; *(v4i16c_t*)(vrow + 32 + 4 * c) = hi;
            }
            __syncthreads();
        }
    }
}

constexpr int AT_KROW = 208, AT_KT = 64 * AT_KROW, AT_VROW = 144, AT_VTB = 64 * AT_VROW, AT_SLOT = AT_KT + AT_VTB, AT_NSLOT = 5, AT_DUMMY = AT_NSLOT * AT_SLOT;
static_assert(AT_KT == 13 * 1024 && AT_VTB == 9 * 1024 && AT_DUMMY + 8 * 1024 <= RING_BYTES, "attention ring");
#ifdef AT_TPROBE
#define TP_B(k) do { if (AT_TPROBE == (k)) tp0 = __builtin_readcyclecounter(); } while (0)
#define TP_E(k) do { if (AT_TPROBE == (k)) tpacc += __builtin_readcyclecounter() - tp0; } while (0)
#else
#define TP_B(k) do {} while (0)
#define TP_E(k) do {} while (0)
#endif
__device__ __forceinline__ void attn_unit(Frame& F, int bh, int qb, unsigned long long& tpacc) {
#ifdef AT_TPROBE
    unsigned long long tp0 = 0;
#endif
    TP_B(0);
    const int lane = F.lane, wid = F.wave, r32 = lane & 31, hi = lane >> 5, grp = wid >> 2;
    const bf16_t* QHp = act_ptr(F, A_QH) + ((size_t)bh * SEQ + qb * 256 + wid * 32) * 96;
    const char* Kb = (const char*)(act_ptr(F, A_KH) + (size_t)bh * SEQ * 96);
    const char* Vb = (const char*)(act_ptr(F, A_VT) + (size_t)bh * 64 * SEQ);
    LAS unsigned char* lds = F.lds;
    bf16x8 qr[6];
#pragma unroll
    for (int s = 0; s < 6; ++s) qr[s] = *(const bf16x8*)(QHp + (size_t)r32 * 96 + 16 * s + 8 * hi);
    const int NT = 4 * (qb + 1);
    const char *dp0, *dp1, *dp2;
    { const int P = 64 * wid + lane, row = P / 13, col = P % 13; dp0 = Kb + row * 192 + (col == 12 ? 0 : col) * 16; }
    if (wid < 5) { const int P = 64 * (wid + 8) + lane, row = P / 13, col = P % 13; dp1 = Kb + row * 192 + (col == 12 ? 0 : col) * 16; }
    else { const int P = 64 * (wid - 5) + lane, d = P / 9, col = P % 9; dp1 = Vb + d * 128 + (col == 8 ? 0 : col) * 16; }
    { const int P = 64 * (wid + 3) + lane, d = (P / 9) & 63, col = P % 9; dp2 = Vb + d * 128 + (col == 8 ? 0 : col) * 16; }
    const unsigned st1 = wid < 5 ? 12288u : 8192u;
    const bool w3 = wid < 6;
#define AT_DMA_ONE(j, sl) do { const int sl_ = (sl); LAS unsigned char* d_ = lds + sl_ + wid * 1024; const int c1_ = sl_ == AT_DUMMY ? 0 : 8192; \
        __builtin_amdgcn_global_load_lds((const unsigned*)(dp0 + (size_t)(j) * 12288), (LAS unsigned*)d_, 16, 0, 0); \
        __builtin_amdgcn_global_load_lds((const unsigned*)(dp1 + (size_t)(j) * st1), (LAS unsigned*)(d_ + c1_), 16, 0, 0); \
        if (w3) __builtin_amdgcn_global_load_lds((const unsigned*)(dp2 + (size_t)(j) * 8192), (LAS unsigned*)(d_ + 2 * c1_), 16, 0, 0); } while (0)
#ifdef AT_PROBE_DMA2
#define AT_DMA(j, sl) do { AT_DMA_ONE(j, sl); AT_DMA_ONE(j, sl); } while (0)
#define AT_WAIT2() do { if (w3) asm volatile("s_waitcnt vmcnt(12)" ::: "memory"); else asm volatile("s_waitcnt vmcnt(8)" ::: "memory"); } while (0)
#else
#define AT_DMA(j, sl) AT_DMA_ONE(j, sl)
#define AT_WAIT2() do { if (w3) asm volatile("s_waitcnt vmcnt(6)" ::: "memory"); else asm volatile("s_waitcnt vmcnt(4)" ::: "memory"); } while (0)
#endif
#define AT_WAIT1() do { if (w3) asm volatile("s_waitcnt vmcnt(3)" ::: "memory"); else asm volatile("s_waitcnt vmcnt(2)" ::: "memory"); } while (0)
#define AT_WAIT_NEXT(t) do { if ((t) + 3 < NT) AT_WAIT2(); else if ((t) + 3 == NT) AT_WAIT1(); else VM_WAIT(); } while (0)
    AT_DMA(0, 0); AT_DMA(1, AT_SLOT); AT_DMA(2, 2 * AT_SLOT); AT_DMA(3, 3 * AT_SLOT);
#ifdef AT_PROBE_DMA2
    if (w3) asm volatile("s_waitcnt vmcnt(18)" ::: "memory"); else asm volatile("s_waitcnt vmcnt(12)" ::: "memory");
#else
    if (w3) asm volatile("s_waitcnt vmcnt(9)" ::: "memory"); else asm volatile("s_waitcnt vmcnt(6)" ::: "memory");
#endif
    LDS_BARRIER();
    float m_run = 0.f, l_run = 0.f;
    f32x16 o0, o1, negm;
#pragma unroll
    for (int r = 0; r < 16; ++r) { o0[r] = 0.f; o1[r] = 0.f; negm[r] = 0.f; }
    const unsigned kfr = (unsigned)(r32 * AT_KROW + hi * 16), vfr = (unsigned)(AT_KT + r32 * AT_VROW + hi * 64);
    if (grp) LDS_BARRIER();
    int slot = 0, wslot = 4;
    const int NTw = 4 * qb + (wid >> 1) + 1;
    TP_B(1);
    for (int t = 0; t < NTw; ++t) {
        const int jb = t - 4 * qb;
        const LAS unsigned char* sb = lds + slot * AT_SLOT;
        f32x16 p0, p1;
        TP_B(2);
        {
            const LAS unsigned char* kb = sb + kfr;
            bf16x8 ka[6], kc[6];
#pragma unroll
            for (int s = 0; s < 6; ++s) { ka[s] = *(const LAS bf16x8*)(kb + s * 32); kc[s] = *(const LAS bf16x8*)(kb + 32 * AT_KROW + s * 32); }
            __builtin_amdgcn_sched_barrier(0);
            __builtin_amdgcn_s_setprio(1);
            p0 = __builtin_amdgcn_mfma_f32_32x32x16_bf16(ka[0], qr[0], negm, 0, 0, 0);
            p1 = __builtin_amdgcn_mfma_f32_32x32x16_bf16(kc[0], qr[0], negm, 0, 0, 0);
#pragma unroll
            for (int s = 1; s < 6; ++s) {
                p0 = __builtin_amdgcn_mfma_f32_32x32x16_bf16(ka[s], qr[s], p0, 0, 0, 0);
                p1 = __builtin_amdgcn_mfma_f32_32x32x16_bf16(kc[s], qr[s], p1, 0, 0, 0);
            }
            __builtin_amdgcn_s_setprio(0);
#ifdef AT_PROBE_SEG1X2
            asm volatile("" : "+v"(p0), "+v"(p1));
            p0 = __builtin_amdgcn_mfma_f32_32x32x16_bf16(ka[0], qr[0], negm, 0, 0, 0);
            p1 = __builtin_amdgcn_mfma_f32_32x32x16_bf16(kc[0], qr[0], negm, 0, 0, 0);
#pragma unroll
            for (int s = 1; s < 6; ++s) {
                p0 = __builtin_amdgcn_mfma_f32_32x32x16_bf16(ka[s], qr[s], p0, 0, 0, 0);
                p1 = __builtin_amdgcn_mfma_f32_32x32x16_bf16(kc[s], qr[s], p1, 0, 0, 0);
            }
#endif
            asm volatile("" : "+v"(p0), "+v"(p1));
        }
        TP_E(2);
        TP_B(3);
        AT_WAIT2();
        TP_E(3);
        TP_B(4);
        LDS_BARRIER();
        TP_E(4);
        AT_DMA(min(t + 4, NT - 1), t + 4 < NT ? wslot * AT_SLOT : AT_DUMMY);
        TP_B(5);
        {
            const LAS unsigned char* vb = sb + vfr;
            bf16x8 va[4], vc2[4];
#pragma unroll
            for (int s = 0; s < 4; ++s) { va[s] = *(const LAS bf16x8*)(vb + s * 16); vc2[s] = *(const LAS bf16x8*)(vb + 32 * AT_VROW + s * 16); }
            if (jb >= 0 && wid < 2 * jb + 2) {
                const int qrel = 32 * wid + r32, kb0 = 64 * jb + 4 * hi;
#pragma unroll
                for (int r = 0; r < 16; ++r) { const int kv = kb0 + (r & 3) + 8 * (r >> 2); if (kv > qrel) p0[r] = -INFINITY; if (kv + 32 > qrel) p1[r] = -INFINITY; }
            }
            float mxa = __builtin_elementwise_maximum(p0[0], p0[1]), mxb = __builtin_elementwise_maximum(p1[0], p1[1]);
#pragma unroll
            for (int r = 2; r < 16; r += 2) {
                mxa = __builtin_elementwise_maximum(__builtin_elementwise_maximum(mxa, p0[r]), p0[r + 1]);
                mxb = __builtin_elementwise_maximum(__builtin_elementwise_maximum(mxb, p1[r]), p1[r + 1]);
            }
            float mx = __builtin_elementwise_maximum(mxa, mxb);
            {
                const u32x2 sw = __builtin_amdgcn_permlane32_swap(__float_as_uint(mx), __float_as_uint(mx), false, false);
                mx = __builtin_elementwise_maximum(__uint_as_float(sw.x), __uint_as_float(sw.y));
            }
            if (t == 0 || !__all(mx <= 8.f)) {
                const float delta = t == 0 ? mx : fmaxf(mx, 0.f), alpha = t == 0 ? 1.f : __builtin_amdgcn_exp2f(-delta);
                m_run += delta; l_run *= alpha;
#pragma unroll
                for (int r = 0; r < 16; ++r) { o0[r] *= alpha; o1[r] *= alpha; p0[r] -= delta; p1[r] -= delta; negm[r] = -m_run; }
            }
            float ps = 0.f;
#pragma unroll
            for (int r = 0; r < 16; ++r) { p0[r] = __builtin_amdgcn_exp2f(p0[r]); p1[r] = __builtin_amdgcn_exp2f(p1[r]); ps += p0[r]; ps += p1[r]; }
            l_run += ps;
#pragma unroll
            for (int s = 0; s < 4; ++s) {
                u32x4 pw;
                if (s < 2) { pw.x = cvt_pk_bf16(p0[8 * s + 0], p0[8 * s + 1]); pw.y = cvt_pk_bf16(p0[8 * s + 2], p0[8 * s + 3]); pw.z = cvt_pk_bf16(p0[8 * s + 4], p0[8 * s + 5]); pw.w = cvt_pk_bf16(p0[8 * s + 6], p0[8 * s + 7]); }
                else { const int q = s - 2; pw.x = cvt_pk_bf16(p1[8 * q + 0], p1[8 * q + 1]); pw.y = cvt_pk_bf16(p1[8 * q + 2], p1[8 * q + 3]); pw.z = cvt_pk_bf16(p1[8 * q + 4], p1[8 * q + 5]); pw.w = cvt_pk_bf16(p1[8 * q + 6], p1[8 * q + 7]); }
                const bf16x8 pb = __builtin_bit_cast(bf16x8, pw);
                o0 = __builtin_amdgcn_mfma_f32_32x32x16_bf16(va[s], pb, o0, 0, 0, 0);
                o1 = __builtin_amdgcn_mfma_f32_32x32x16_bf16(vc2[s], pb, o1, 0, 0, 0);
            }
        }
        TP_E(5);
        TP_B(6);
        LDS_BARRIER();
        TP_E(6);
        slot = slot == AT_NSLOT - 1 ? 0 : slot + 1; wslot = wslot == AT_NSLOT - 1 ? 0 : wslot + 1;
    }
    TP_E(1);
    for (int t = NTw; t < NT; ++t) {
        AT_WAIT2();
        LDS_BARRIER();
        AT_DMA(min(t + 4, NT - 1), t + 4 < NT ? wslot * AT_SLOT : AT_DUMMY);
        LDS_BARRIER();
        wslot = wslot == AT_NSLOT - 1 ? 0 : wslot + 1;
    }
    if (!grp) LDS_BARRIER();
    VM_WAIT();
#undef AT_DMA
#undef AT_DMA_ONE
#undef AT_WAIT2
#undef AT_WAIT1
#undef AT_WAIT_NEXT
    l_run += __shfl_xor(l_run, 32);
    const float inv = 1.f / l_run;
    const int b = bh >> 3, h = bh & 7;
    bf16_t* orow = act_ptr(F, A_YSA) + ((size_t)b * SEQ + qb * 256 + wid * 32 + r32) * 512 + h * 64;
#pragma unroll
    for (int g = 0; g < 4; ++g) {
        u32x2 w0, w1;
        w0.x = cvt_pk_bf16(o0[4 * g] * inv, o0[4 * g + 1] * inv); w0.y = cvt_pk_bf16(o0[4 * g + 2] * inv, o0[4 * g + 3] * inv);
        w1.x = cvt_pk_bf16(o1[4 * g] * inv, o1[4 * g + 1] * inv); w1.y = cvt_pk_bf16(o1[4 * g + 2] * inv, o1[4 * g + 3] * inv);
#ifdef AT_WT_STORE
        asm volatile("global_store_dwordx2 %0, %1, off sc0 sc1" :: "v"(orow + 8 * g + 4 * hi), "v"(w0) : "memory");
        asm volatile("global_store_dwordx2 %0, %1, off sc0 sc1" :: "v"(orow + 32 + 8 * g + 4 * hi), "v"(w1) : "memory");
#else
        *(u32x2*)(orow + 8 * g + 4 * hi) = w0; *(u32x2*)(orow + 32 + 8 * g + 4 * hi) = w1;
#endif
    }
    TP_E(0);
}

__device__ __forceinline__ float row16_sum(float x) {
    x += __int_as_float(__builtin_amdgcn_update_dpp(0, __float_as_int(x), 0x128, 0xf, 0xf, false));
    x += __int_as_float(__builtin_amdgcn_update_dpp(0, __float_as_int(x), 0x124, 0xf, 0xf, false));
    x += __int_as_float(__builtin_amdgcn_update_dpp(0, __float_as_int(x), 0x122, 0xf, 0xf, false));
    x += __int_as_float(__builtin_amdgcn_update_dpp(0, __float_as_int(x), 0x121, 0xf, 0xf, false));
    return x;
}
__device__ __forceinline__ unsigned short f2bf1(float x) { return (unsigned short)(cvt_pk_bf16(x, 0.f) & 0xffffu); }
__device__ __forceinline__ void gla_prep(Frame& F, int l, int unit) {
    bf16_t* gqkv = act_ptr(F, A_GQKV); const bf16_t* misc = act_ptr(F, A_MISC); float* eb = F.stats + SF_EB;
    const int c = F.tid & 255, ch = unit * 2 + (F.tid >> 8);
    const float* wg = F.in(I_WGLA) + (size_t)l * 16 * 256 + c; const float bias = F.in(I_BGLA)[l * 256 + c];
    float wcol[16];
#pragma unroll
    for (int r = 0; r < 16; ++r) wcol[r] = wg[r * 256];
    float bc = 0.f;
#pragma unroll 8
    for (int i = 0; i < 32; ++i) {
        const size_t t = (size_t)ch * 32 + i;
        const u32x4 l0 = *(const u32x4*)(misc + t * 256 + 32), l1 = *(const u32x4*)(misc + t * 256 + 40);
        const float lr[16] = {bflo(l0.x), bfhi(l0.x), bflo(l0.y), bfhi(l0.y), bflo(l0.z), bfhi(l0.z), bflo(l0.w), bfhi(l0.w),
                              bflo(l1.x), bfhi(l1.x), bflo(l1.y), bfhi(l1.y), bflo(l1.z), bfhi(l1.z), bflo(l1.w), bfhi(l1.w)};
        float z = bias;
#pragma unroll
        for (int r = 0; r < 16; ++r) z = fmaf(lr[r], wcol[r], z);
        const float zl = z * 1.4426950408889634f;
        const float sp = fmaxf(-zl, 0.f) + __log2f(1.f + __builtin_amdgcn_exp2f(-fabsf(zl)));
        bc -= sp * 0.0625f;
        const float eq = __builtin_amdgcn_exp2f(bc) * 0.125f, ek = __builtin_amdgcn_exp2f(-bc);
        bf16_t* qp = gqkv + t * 1024 + c; bf16_t* kp = qp + 256;
        *qp = f2bf1(__uint_as_float((unsigned)*qp << 16) * eq);
        *kp = f2bf1(__uint_as_float((unsigned)*kp << 16) * ek);
    }
    eb[(size_t)ch * 256 + c] = __builtin_amdgcn_exp2f(bc);
}
typedef short v4i16_t __attribute__((ext_vector_type(4)));
__device__ __forceinline__ v4i16_t lds_tr16(const LAS unsigned char* p) { return __builtin_amdgcn_ds_read_tr16_b64_v4i16((LAS v4i16_t*)p); }
constexpr int GW_K = 0, GW_Q = 4608, GW_V = 9216, GW_BYTES = 10240;
__device__ __forceinline__ void gla_unit(Frame& F, int l, int unit) {
    const int half = unit & 1, h = (unit >> 1) & 3, b = unit >> 3;
    volatile LAS int* prog = (volatile LAS int*)(F.lds + 4 * GW_BYTES);
    if (F.wave >= 4) {
        const int pw = F.wave - 4, tok = F.lane & 31, li = (F.lane >> 5) + 2 * (pw & 1);
        const size_t lo_ = (li == 0) ? (size_t)h * 128 : (li == 1) ? (size_t)512 + h * 128 : (li == 2) ? (size_t)1024 + h * 256 + half * 128 : (size_t)1024 + h * 256 + half * 128 + 64;
        const unsigned char* base_ = (const unsigned char*)act_ptr(F, A_GQKV) + lo_;
        unsigned keep = 0u;
        for (int m = (pw >> 1); m < SEQ / 32; m += 2) {
            while (m > prog[0] + 8) __builtin_amdgcn_s_sleep(8);
            const unsigned char* pp = base_ + ((size_t)b * SEQ + (size_t)m * 32 + tok) * 2048;
            asm volatile("global_load_dword %0, %1, off" : "+v"(keep) : "v"(pp) : "memory");
        }
        asm volatile("s_waitcnt vmcnt(0)" : "+v"(keep) :: "memory");
        return;
    }
    const int lane = F.lane, w = half * 4 + F.wave, l15 = lane & 15, q4 = lane >> 4;
    const bf16_t* gqkv = act_ptr(F, A_GQKV); const float* ebg = F.stats + SF_EB;
    bf16_t* ysb = act_ptr(F, A_YSB);
    LAS unsigned char* wl = F.lds + F.wave * GW_BYTES;
    f32x4 S[4];
#pragma unroll
    for (int i = 0; i < 4; ++i) S[i] = (f32x4){0.f, 0.f, 0.f, 0.f};
    if (F.tid == 0) prog[0] = 0;
    constexpr int GW2 = 4 * GW_BYTES;
    u32x4 kimgX[4], qimgX[4], vimgX, kimgY[4], qimgY[4], vimgY; f32x4 ebvX[4], ebvY[4];
#define GLA_LOAD1(n_, KI, QI, VI, EBV) do { const size_t tb_ = (size_t)b * SEQ + (size_t)(n_) * 32; \
        _Pragma("unroll") for (int i = 0; i < 4; ++i) { const int p_ = lane + 64 * i; const bf16_t* r_ = gqkv + (tb_ + (p_ >> 3)) * 1024 + h * 64 + (p_ & 7) * 8; QI[i] = *(const u32x4*)r_; KI[i] = *(const u32x4*)(r_ + 256); } \
        VI = *(const u32x4*)(gqkv + (tb_ + (lane >> 1)) * 1024 + 512 + h * 128 + 16 * w + (lane & 1) * 8); \
        _Pragma("unroll") for (int db = 0; db < 4; ++db) EBV[db] = *(const f32x4*)(ebg + (tb_ >> 5) * 256 + h * 64 + 16 * db + 4 * q4); } while (0)
#define GLA_LOAD(n_) do { GLA_LOAD1((n_), kimgX, qimgX, vimgX, ebvX); GLA_LOAD1((n_) + 1, kimgY, qimgY, vimgY, ebvY); } while (0)
    bf16x8 pa0X, pa1X, vbnX, kanX[4], qpxX[2], qpyX[2], pa0Y, pa1Y, vbnY, kanY[4], qpxY[2], qpyY[2]; f32x4 o0pX, o1pX, e4X[4], o0pY, o1pY, e4Y[4];
#define GLA_IMG(WL, KI, QI, VI, EBV, E4) do { \
        _Pragma("unroll") for (int i = 0; i < 4; ++i) { asm volatile("" : "+v"(KI[i]), "+v"(QI[i]), "+v"(EBV[i])); } \
        asm volatile("" : "+v"(VI)); \
        _Pragma("unroll") for (int i = 0; i < 4; ++i) { const int p_ = lane + 64 * i; *(LAS u32x4*)((WL) + GW_K + (p_ >> 3) * 144 + (p_ & 7) * 16) = KI[i]; *(LAS u32x4*)((WL) + GW_Q + (p_ >> 3) * 144 + (p_ & 7) * 16) = QI[i]; } \
        *(LAS u32x4*)((WL) + GW_V + (lane >> 1) * 32 + (lane & 1) * 16) = VI; \
        _Pragma("unroll") for (int db = 0; db < 4; ++db) E4[db] = EBV[db]; } while (0)
#define GLA_STAGE_P(WL, PA0, PA1, VBN, KAN, QPX, QPY, O0P, O1P) do { \
        f32x4 pt00 = {0.f, 0.f, 0.f, 0.f}, pt01 = pt00, pt11 = pt00; \
        _Pragma("unroll") for (int ks = 0; ks < 2; ++ks) { \
            const bf16x8 a0 = *(const LAS bf16x8*)((WL) + GW_K + l15 * 144 + ks * 64 + q4 * 16), a1 = *(const LAS bf16x8*)((WL) + GW_K + (16 + l15) * 144 + ks * 64 + q4 * 16); \
            const bf16x8 b0 = *(const LAS bf16x8*)((WL) + GW_Q + l15 * 144 + ks * 64 + q4 * 16), b1 = *(const LAS bf16x8*)((WL) + GW_Q + (16 + l15) * 144 + ks * 64 + q4 * 16); \
            pt00 = __builtin_amdgcn_mfma_f32_16x16x32_bf16(a0, b0, pt00, 0, 0, 0); \
            pt01 = __builtin_amdgcn_mfma_f32_16x16x32_bf16(a0, b1, pt01, 0, 0, 0); \
            pt11 = __builtin_amdgcn_mfma_f32_16x16x32_bf16(a1, b1, pt11, 0, 0, 0); \
            const LAS unsigned char* q0p = (WL) + GW_Q + l15 * 144 + ks * 64 + q4 * 8; const LAS unsigned char* q1p = q0p + 16 * 144; \
            const u32x2 x0 = *(const LAS u32x2*)(q0p), x1 = *(const LAS u32x2*)(q0p + 32), y0 = *(const LAS u32x2*)(q1p), y1 = *(const LAS u32x2*)(q1p + 32); \
            QPX[ks] = __builtin_bit_cast(bf16x8, (u32x4){x0.x, x0.y, x1.x, x1.y}); QPY[ks] = __builtin_bit_cast(bf16x8, (u32x4){y0.x, y0.y, y1.x, y1.y}); } \
        _Pragma("unroll") for (int r = 0; r < 4; ++r) { if (4 * q4 + r > l15) { pt00[r] = 0.f; pt11[r] = 0.f; } } \
        PA0 = __builtin_bit_cast(bf16x8, (u32x4){cvt_pk_bf16(pt00[0], pt00[1]), cvt_pk_bf16(pt00[2], pt00[3]), 0u, 0u}); \
        PA1 = __builtin_bit_cast(bf16x8, (u32x4){cvt_pk_bf16(pt01[0], pt01[1]), cvt_pk_bf16(pt01[2], pt01[3]), cvt_pk_bf16(pt11[0], pt11[1]), cvt_pk_bf16(pt11[2], pt11[3])}); \
        const LAS unsigned char* vt_ = (WL) + GW_V + (l15 >> 2) * 32 + (l15 & 3) * 8; \
        const v4i16_t vp0 = lds_tr16(vt_ + (4 * q4) * 32), vp1 = lds_tr16(vt_ + (16 + 4 * q4) * 32); \
        const v4i16_t vn0 = lds_tr16(vt_ + (8 * q4) * 32), vn1 = lds_tr16(vt_ + (8 * q4 + 4) * 32); \
        const bf16x8 vbp = (bf16x8){vp0[0], vp0[1], vp0[2], vp0[3], vp1[0], vp1[1], vp1[2], vp1[3]}; \
        VBN = (bf16x8){vn0[0], vn0[1], vn0[2], vn0[3], vn1[0], vn1[1], vn1[2], vn1[3]}; \
        _Pragma("unroll") for (int db = 0; db < 4; ++db) { \
            const LAS unsigned char* kt = (WL) + GW_K + (8 * q4 + (l15 >> 2)) * 144 + (16 * db + (l15 & 3) * 4) * 2; \
            const v4i16_t k0 = lds_tr16(kt), k1 = lds_tr16(kt + 4 * 144); \
            KAN[db] = (bf16x8){k0[0], k0[1], k0[2], k0[3], k1[0], k1[1], k1[2], k1[3]}; } \
        O0P = __builtin_amdgcn_mfma_f32_16x16x32_bf16(PA0, vbp, (f32x4){0.f, 0.f, 0.f, 0.f}, 0, 0, 0); \
        O1P = __builtin_amdgcn_mfma_f32_16x16x32_bf16(PA1, vbp, (f32x4){0.f, 0.f, 0.f, 0.f}, 0, 0, 0); \
    } while (0)
#define GLA_STAGE_S(T0, VBN, KAN, QPX, QPY, O0P, O1P, E4) do { \
        f32x4 o0 = O0P, o1 = O1P; \
        _Pragma("unroll") for (int ks = 0; ks < 2; ++ks) { \
            const bf16x8 sb = __builtin_bit_cast(bf16x8, (u32x4){cvt_pk_bf16(S[2 * ks][0], S[2 * ks][1]), cvt_pk_bf16(S[2 * ks][2], S[2 * ks][3]), cvt_pk_bf16(S[2 * ks + 1][0], S[2 * ks + 1][1]), cvt_pk_bf16(S[2 * ks + 1][2], S[2 * ks + 1][3])}); \
            o0 = __builtin_amdgcn_mfma_f32_16x16x32_bf16(QPX[ks], sb, o0, 0, 0, 0); \
            o1 = __builtin_amdgcn_mfma_f32_16x16x32_bf16(QPY[ks], sb, o1, 0, 0, 0); } \
        _Pragma("unroll") for (int db = 0; db < 4; ++db) { S[db] = __builtin_amdgcn_mfma_f32_16x16x32_bf16(KAN[db], VBN, S[db], 0, 0, 0); S[db] = S[db] * E4[db]; } \
        _Pragma("unroll") for (int r = 0; r < 4; ++r) { const size_t ta = (T0) + 4 * q4 + r, tb2 = ta + 16; \
            ysb[ta * 512 + h * 128 + 16 * w + l15] = f2bf1(o0[r]); ysb[tb2 * 512 + h * 128 + 16 * w + l15] = f2bf1(o1[r]); } \
    } while (0)
    LAS unsigned char* wl2 = F.lds + GW2 + 64 + F.wave * GW_BYTES;
    GLA_LOAD(0);
    for (int n = 0; n < SEQ / 32; n += 2) {
        const size_t t0 = (size_t)b * SEQ + (size_t)n * 32;
        if (F.tid == 0) prog[0] = n;
        GLA_IMG(wl, kimgX, qimgX, vimgX, ebvX, e4X);
        GLA_IMG(wl2, kimgY, qimgY, vimgY, ebvY, e4Y);
        { const int nn = (n + 2 < SEQ / 32) ? n + 2 : n; GLA_LOAD(nn); }
        GLA_STAGE_P(wl, pa0X, pa1X, vbnX, kanX, qpxX, qpyX, o0pX, o1pX);
        GLA_STAGE_P(wl2, pa0Y, pa1Y, vbnY, kanY, qpxY, qpyY, o0pY, o1pY);
        GLA_STAGE_S(t0, vbnX, kanX, qpxX, qpyX, o0pX, o1pX, e4X);
        GLA_STAGE_S(t0 + 32, vbnY, kanY, qpxY, qpyY, o0pY, o1pY, e4Y);
        asm volatile("s_waitcnt lgkmcnt(0)" ::: "memory");
    }
#undef GLA_LOAD1
#undef GLA_IMG
#undef GLA_STAGE_P
#undef GLA_STAGE_S
#undef GLA_LOAD
}
__device__ __forceinline__ void gla_finalize(Frame& F, int l) {
    bf16_t* ysb = act_ptr(F, A_YSB); const bf16_t* og = act_ptr(F, A_OG);
    const float* go = F.in(I_GGLAO) + l * 128;
    for (int i = F.vcu * 512 + F.tid; i < T * 64; i += F.G * 512) {
        const int t = i >> 6, c8 = i & 63, h = c8 >> 4, v0 = (c8 & 15) * 8;
        const u32x4 o = *(const u32x4*)(ysb + (size_t)t * 512 + c8 * 8), gte = *(const u32x4*)(og + (size_t)t * 512 + c8 * 8);
        const f32x4 g0 = *(const f32x4*)(go + v0), g1 = *(const f32x4*)(go + v0 + 4);
        const float ov[8] = {bflo(o.x), bfhi(o.x), bflo(o.y), bfhi(o.y), bflo(o.z), bfhi(o.z), bflo(o.w), bfhi(o.w)};
        const float ssq = row16_sum(((ov[0] * ov[0] + ov[1] * ov[1]) + (ov[2] * ov[2] + ov[3] * ov[3])) + ((ov[4] * ov[4] + ov[5] * ov[5]) + (ov[6] * ov[6] + ov[7] * ov[7])));
        const float r = rsqrtf(ssq * (1.f / 128.f) + EPS);
        const float gv[8] = {bflo(gte.x), bfhi(gte.x), bflo(gte.y), bfhi(gte.y), bflo(gte.z), bfhi(gte.z), bflo(gte.w), bfhi(gte.w)};
        float y[8];
#pragma unroll
        for (int e = 0; e < 8; ++e) y[e] = ov[e] * r * (e < 4 ? g0[e] : g1[e - 4]) * gv[e] * fast_sigmoid(gv[e]);
        u32x4 wv; wv.x = cvt_pk_bf16(y[0], y[1]); wv.y = cvt_pk_bf16(y[2], y[3]); wv.z = cvt_pk_bf16(y[4], y[5]); wv.w = cvt_pk_bf16(y[6], y[7]);
        *(u32x4*)(ysb + (size_t)t * 512 + c8 * 8) = wv;
    }
}

template <int W> __device__ __forceinline__ void pool_rows(const bf16_t* up, bf16_t* pooled, int t0, int s0, int c8) {
    u32x4 row[8 + W - 1];
#pragma unroll
    for (int i = 0; i < 8 + W - 1; ++i) {
        const int dt = i - (W - 1);
        const bool ok = (s0 + dt) >= 0;
        const u32x4 v = *(const u32x4*)(up + (size_t)(t0 + (ok ? dt : 0)) * 512 + c8 * 8);
        row[i] = ok ? v : (u32x4){0u, 0u, 0u, 0u};
    }
#pragma unroll
    for (int k = 0; k < 8; ++k) {
        float acc[8];
#pragma unroll
        for (int e = 0; e < 8; ++e) acc[e] = 0.f;
#pragma unroll
        for (int j = 0; j < W; ++j) { const u32x4 v = row[k + W - 1 - j];
            acc[0] += bflo(v.x); acc[1] += bfhi(v.x); acc[2] += bflo(v.y); acc[3] += bfhi(v.y); acc[4] += bflo(v.z); acc[5] += bfhi(v.z); acc[6] += bflo(v.w); acc[7] += bfhi(v.w); }
        const int sk = s0 + k, n = (sk + 1 < W) ? sk + 1 : W;
        const float rn = 1.f / (float)n; const u32x4 self = row[k + W - 1];
        u32x4 o; o.x = cvt_pk_bf16(acc[0] * rn - bflo(self.x), acc[1] * rn - bfhi(self.x)); o.y = cvt_pk_bf16(acc[2] * rn - bflo(self.y), acc[3] * rn - bfhi(self.y));
        o.z = cvt_pk_bf16(acc[4] * rn - bflo(self.z), acc[5] * rn - bfhi(self.z)); o.w = cvt_pk_bf16(acc[6] * rn - bflo(self.w), acc[7] * rn - bfhi(self.w));
        *(u32x4*)(pooled + (size_t)(t0 + k) * 512 + c8 * 8) = o;
    }
}
__device__ __forceinline__ void pool_unit(Frame& F, int unit) {
    const bf16_t* up = act_ptr(F, A_UP); bf16_t* pooled = act_ptr(F, A_POOLED);
    const int g = F.wave & 3, c8 = g * 16 + (F.lane & 15), tb = (F.lane >> 4) + 4 * (F.wave >> 2);
    const int t0 = unit * 64 + tb * 8, s0 = t0 % SEQ;
    if (g == 0) pool_rows<2>(up, pooled, t0, s0, c8);
    else if (g == 1) pool_rows<4>(up, pooled, t0, s0, c8);
    else if (g == 2) pool_rows<8>(up, pooled, t0, s0, c8);
    else pool_rows<16>(up, pooled, t0, s0, c8);
}

__device__ __forceinline__ void phase_mix(Frame& F, int lq, int bx) {
    const int l = lq & 1;
#ifndef REP_DMASK
#define REP_DMASK 7
#endif
    const int dm = (lq >= 2) ? (REP_DMASK) : 7;
    if (bx < 32 && (dm & 1)) gla_unit(F, l, bx);
    unsigned* head = F.ctl + CW_QUEUE + 64 * lq;
    unsigned long long tpsum = 0;
#ifdef AT_TPROBE
    const unsigned long long tq0 = __builtin_readcyclecounter();
#endif
    for (;;) {
        if (F.tid == 0) F.MISC[16] = __hip_atomic_fetch_add(head, 1u, RLX_AGENT);
        __syncthreads();
        const int idx = (int)F.MISC[16];
        __syncthreads();
        if (idx >= 512 + 256) break;
        if (idx < 512) { if (dm & 2) attn_unit(F, idx & 31, 15 - (idx >> 5), tpsum); }
        else { if (dm & 4) pool_unit(F, idx - 512); }
    }
#ifdef AT_TPROBE
    if (AT_TPROBE == 7) tpsum = __builtin_readcyclecounter() - tq0;
    if (lq >= 2 && (AT_TPWG < 0 || bx == AT_TPWG) && F.wave == AT_TPWAVE) { const unsigned long long ts = __builtin_readcyclecounter(); while (__builtin_readcyclecounter() - ts < 4ull * tpsum) __builtin_amdgcn_s_sleep(8); }
#endif
    if (bx >= 32 && lq < 2) {
        LAS float* scr = (LAS float*)(F.lds + F.wave * 16384);
        const int gw = (bx - 32) * 8 + F.wave, NGW = (F.G - 32) * 8;
        if (l == 0) { CONV_LOOP(15, mixer_seg(F, 1, si_)); fold_pool(F, 1, gw, NGW); CONV_LOOP(3, ffn_seg(F, si_)); }
        else { CONV_LOOP(12, moe_seg(F, (si_ >> 1) * 3 + (si_ & 1))); }
    }
}

__device__ __forceinline__ void phase_route1(Frame& F) {
    const bf16_t* x = (const bf16_t*)(F.ws + WS_XB); const float* rss = F.stats + SF_ROWSS + (size_t)3 * T * 16; const float* gf = F.in(I_GFFN) + D; const float* wr = F.in(I_WROUTER);
    unsigned* route = (unsigned*)(F.ws + WS_SLOT + SL_ROUTE); unsigned* wgcnt = F.ctl + CW_WGCNT;
    LAS float* lsel = (LAS float*)(F.lds);
    LAS int* lpos = (LAS int*)(F.lds + 2048);
    for (int unit = F.vcu; unit < T / 64; unit += F.G) {
        for (int k = 0; k < 8; ++k) {
            const int tok = F.wave * 8 + k, t = unit * 64 + tok;
            float lg[8];
#pragma unroll
            for (int e = 0; e < 8; ++e) lg[e] = 0.f;
#pragma unroll
            for (int j = 0; j < 2; ++j) {
                const int c = 8 * F.lane + 512 * j;
                const u32x4 xr = *(const u32x4*)(x + (size_t)t * D + c);
                const f32x4 ga = *(const f32x4*)(gf + c), gb = *(const f32x4*)(gf + c + 4);
                const float xv[8] = {bflo(xr.x) * ga[0], bfhi(xr.x) * ga[1], bflo(xr.y) * ga[2], bfhi(xr.y) * ga[3], bflo(xr.z) * gb[0], bfhi(xr.z) * gb[1], bflo(xr.w) * gb[2], bfhi(xr.w) * gb[3]};
#pragma unroll
                for (int q = 0; q < 8; ++q) {
                    const float xg = xv[q];
                    const f32x4 w0 = *(const f32x4*)(wr + (size_t)(c + q) * 8), w1 = *(const f32x4*)(wr + (size_t)(c + q) * 8 + 4);
                    lg[0] = fmaf(xg, w0[0], lg[0]); lg[1] = fmaf(xg, w0[1], lg[1]); lg[2] = fmaf(xg, w0[2], lg[2]); lg[3] = fmaf(xg, w0[3], lg[3]);
                    lg[4] = fmaf(xg, w1[0], lg[4]); lg[5] = fmaf(xg, w1[1], lg[5]); lg[6] = fmaf(xg, w1[2], lg[6]); lg[7] = fmaf(xg, w1[3], lg[7]);
                }
            }
            const float rs = rsqrtf(sum16(rss + (size_t)t * 16) * (1.f / 1024.f) + EPS);
#pragma unroll
            for (int e = 0; e < 8; ++e) lg[e] = wave_sum(lg[e]) * rs;
            int i1 = 0; float v1 = lg[0];
#pragma unroll
            for (int e = 1; e < 8; ++e) if (lg[e] > v1) { v1 = lg[e]; i1 = e; }
            int i2 = -1; float v2 = -INFINITY;
#pragma unroll
            for (int e = 0; e < 8; ++e) if (e != i1 && lg[e] > v2) { v2 = lg[e]; i2 = e; }
            const float e2 = __expf(v2 - v1), w1 = 1.f / (1.f + e2), w2 = e2 / (1.f + e2);
            if (F.lane == 0) { lsel[tok * 4 + 0] = __int_as_float(i1); lsel[tok * 4 + 1] = __int_as_float(i2); lsel[tok * 4 + 2] = w1; lsel[tok * 4 + 3] = w2; }
        }
        __syncthreads();
        if (F.tid < 8) {
            int cnt = 0;
            for (int tok = 0; tok < 64; ++tok) {
                const int e1 = __float_as_int(lsel[tok * 4 + 0]), e2 = __float_as_int(lsel[tok * 4 + 1]);
                if (e1 == F.tid) { lpos[tok * 2 + 0] = cnt; ++cnt; }
                if (e2 == F.tid) { lpos[tok * 2 + 1] = cnt; ++cnt; }
            }
            wgcnt[unit * 8 + F.tid] = (unsigned)cnt;
        }
        __syncthreads();
        if (F.tid < 64) {
            const int t = unit * 64 + F.tid;
            u32x4 a, b2;
            a.x = (unsigned)__float_as_int(lsel[F.tid * 4 + 0]); a.y = (unsigned)__float_as_int(lsel[F.tid * 4 + 1]); a.z = __float_as_uint(lsel[F.tid * 4 + 2]); a.w = __float_as_uint(lsel[F.tid * 4 + 3]);
            b2.x = (unsigned)lpos[F.tid * 2 + 0]; b2.y = (unsigned)lpos[F.tid * 2 + 1]; b2.z = 0u; b2.w = 0u;
            *(u32x4*)(route + (size_t)t * 8) = a; *(u32x4*)(route + (size_t)t * 8 + 4) = b2;
        }
        __syncthreads();
    }
}
__device__ __forceinline__ void moe_geometry(Frame& F, int unit, LAS int* geo) {
    const unsigned* wgcnt = F.ctl + CW_WGCNT;
    if (F.tid < 8) {
        int tot = 0, pre = 0;
        for (int c = 0; c < 256; ++c) { const int v = (int)wgcnt[c * 8 + F.tid]; if (c < unit) pre += v; tot += v; }
        geo[9 + F.tid] = tot; geo[17 + F.tid] = pre;
    }
    __syncthreads();
    if (F.tid == 0) { int acc = 0; for (int e = 0; e < 8; ++e) { geo[e] = acc; acc += (geo[9 + e] + 255) >> 8; } geo[8] = acc; }
    __syncthreads();
}
__device__ __forceinline__ void phase_route2(Frame& F) {
    const unsigned* route = (const unsigned*)(F.ws + WS_SLOT + SL_ROUTE);
    int* slot_tok = (int*)(F.ws + WS_SLOT + SL_TOK); float* slot_scale = (float*)(F.ws + WS_SLOT + SL_SCALE); float* slot_comb = (float*)(F.ws + WS_SLOT + SL_COMB);
    const float* rss = F.stats + SF_ROWSS + (size_t)3 * T * 16;
    const bf16_t* xb = (const bf16_t*)(F.ws + WS_XB); bf16_t* xg = act_ptr(F, A_XG);
    LAS int* geo = (LAS int*)(F.lds);
    for (int unit = F.vcu; unit < T / 64; unit += F.G) {
        moe_geometry(F, unit, geo);
        for (int k = 0; k < 16; ++k) {
            const int rix = F.wave * 16 + k, tok = rix >> 1, ch = rix & 1, t = unit * 64 + tok;
            const unsigned e = route[(size_t)t * 8 + ch], pos = route[(size_t)t * 8 + 4 + ch];
            const float w = __uint_as_float(route[(size_t)t * 8 + 2 + ch]);
            const int slot = geo[e] * 256 + geo[17 + e] + (int)pos;
            const u32x4* src = (const u32x4*)(xb + (size_t)t * D); u32x4* dst = (u32x4*)(xg + (size_t)slot * D);
            dst[F.lane] = src[F.lane]; dst[64 + F.lane] = src[64 + F.lane];
            if (F.lane == 0) { ((int*)(F.ws + WS_TSLOT))[t * 2 + ch] = slot; slot_tok[slot] = t; slot_scale[slot] = rsqrtf(sum16(rss + (size_t)t * 16) * (1.f / 1024.f) + EPS); slot_comb[slot] = w; }
        }
        if (unit == 0) {
            for (int e = 0; e < 8; ++e) { const int s0 = geo[e] * 256 + geo[9 + e], s1 = geo[e + 1] * 256;
                for (int s = s0 + F.tid; s < s1; s += 512) { slot_tok[s] = -1; slot_scale[s] = 0.f; slot_comb[s] = 0.f; } }
        }
        __syncthreads();
    }
}

struct Args { const void* in[25]; float* out; unsigned char* ws; int ph_lo, ph_hi, li, pad; };
constexpr int NPHASE = 22;
#ifndef PH_MASK
#define PH_MASK 0xFFF
#endif
#define PON(b) (((PH_MASK) >> (b)) & 1)

__global__ void __launch_bounds__(512, 2) mega_fwd(Args args) {
    extern __shared__ __attribute__((aligned(16))) unsigned char lds_raw[];
    Frame F;
    F.lds = (LAS unsigned char*)lds_raw;
    F.MISC = (volatile LAS unsigned*)(F.lds + MISC_OFF);
    F.tid = threadIdx.x; F.lane = F.tid & 63; F.wave = __builtin_amdgcn_readfirstlane(F.tid >> 6);
    F.G = gridDim.x; { const int bx = blockIdx.x; F.vcu = (F.G % 8 == 0) ? (bx % 8) * (F.G / 8) + bx / 8 : bx; }
    { const CAS Args* ap0 = (const CAS Args*)__builtin_amdgcn_kernarg_segment_ptr(); F.ws = ap0->ws; F.ctl = (unsigned*)(F.ws + WS_CTL); F.ctlf = (float*)(F.ws + WS_CTL); F.stats = (float*)(F.ws + WS_STATS); }
    F.inp = nullptr; F.out = nullptr;
    for (int u = F.tid; u < (LDS_BYTES - LDSCTL_OFF) / 4; u += 512) ((LAS unsigned*)(F.lds + LDSCTL_OFF))[u] = 0u;
    __syncthreads();
    XcdBarrier bar = xcd_barrier_post(F.ctl + CW_BAR + args.li * XCD_BAR_WORDS, F.MISC + 8);
    const int lo = args.ph_lo, hi = args.ph_hi;
    const int cblk0 = (int)blockIdx.x, wave0 = F.wave, vcu0 = F.vcu, G0 = F.G;
#ifndef REP_MASK
#define REP_MASK 0
#endif
#pragma unroll 1
    for (int ph2 = 2 * lo; ph2 < 2 * hi; ++ph2) {
        const int ph = ph2 >> 1, rpt = ph2 & 1;
        if (rpt && !((REP_MASK >> ph) & 1)) continue;
        int cblk = cblk0; { int wv_ = wave0, vc_ = vcu0, g_ = G0; asm volatile("" : "+s"(wv_), "+s"(vc_), "+s"(g_), "+s"(cblk)); F.wave = wv_; F.vcu = vc_; F.G = g_; }
        { int ln_; asm volatile("v_mbcnt_lo_u32_b32 %0, -1, 0\n\tv_mbcnt_hi_u32_b32 %0, -1, %0" : "=v"(ln_)); F.lane = ln_; F.tid = F.wave * 64 + ln_; }
        { const CAS Args* ap = (const CAS Args*)__builtin_amdgcn_kernarg_segment_ptr(); asm volatile("" : "+s"(ap)); F.inp = ap->in; F.out = ap->out; unsigned char* w_ = ap->ws; F.ws = w_; F.ctl = (unsigned*)(w_ + WS_CTL); F.ctlf = (float*)(w_ + WS_CTL); F.stats = (float*)(w_ + WS_STATS); }
        const int l = ph >= 10 ? 1 : 0, q = ph == 0 ? -1 : (l ? ph - 10 : ph - 1);
        unsigned char* wb = wblk(F, l);
        float* ssq = F.stats + SF_SSQ + (size_t)l * 2 * T * 4;
        const float* rss_in = F.stats + SF_ROWSS + (size_t)(l == 0 ? 0 : 2) * T * 16;
        float* rss_mid = F.stats + SF_ROWSS + (size_t)(l == 0 ? 1 : 3) * T * 16;
        if (q == -1) {
            if (PON(11)) p0_prologue(F);
        } else if (q == 0 && PON(0)) {
            pg8::SchedGrid S{(const char*)(F.ws + WS_XB), (const char*)(wb + WO_IN), (size_t)256 * 1024 * 2, (size_t)256 * 1024 * 2, 0, 64, 11, F.G, cblk, 1 << 30};
            { pg8::Unit u0; if (S.next(0, u0)) fill_rs(F, rss_in, u0.pm); }
            pg8::EpiProj E{act_ptr(F, A_CQKV), act_ptr(F, A_GQKV), act_ptr(F, A_OG), act_ptr(F, A_UP), act_ptr(F, A_MISC), (const LAS float*)(F.lds + RS_OFF), ssq};
            pg8::gemm_phase<pg8::EpiProj, pg8::SchedGrid, true, true>(F.lds, F.wave, 1024, 1024, S, E);
        } else if (q == 1 && PON(1)) {
            pg8::SchedGrid S{(const char*)act_ptr(F, A_CQKV), (const char*)(wb + WO_UP), (size_t)256 * 512 * 2, (size_t)256 * 256 * 2, (size_t)256 * 2, 64, 7, F.G, cblk, 3};
            pg8::EpiUp E{act_ptr(F, A_QKVRAW), ssq};
            pg8::gemm_phase<pg8::EpiUp, pg8::SchedGrid, true, true>(F.lds, F.wave, 512, 256, S, E);
        } else if (q == 2 && PON(2)) {
            phase_prep(F, l, rpt);
        } else if (q == 3 && PON(3)) {
            phase_mix(F, l + 2 * rpt, cblk);
        } else if (q == 4 && PON(4)) {
            pg8::SchedGrid S{(const char*)(F.ws + WS_XB), (const char*)(wb + WO_G), (size_t)256 * 1024 * 2, (size_t)256 * 1024 * 2, 0, 64, 12, F.G, cblk, 1 << 30};
            { pg8::Unit u0; if (S.next(0, u0)) fill_rs(F, rss_in, u0.pm); }
            pg8::EpiGate E{F.ws + WS_ACTS, (const LAS float*)(F.lds + RS_OFF)};
            pg8::gemm_phase<pg8::EpiGate, pg8::SchedGrid, true, true>(F.lds, F.wave, 1024, 1024, S, E);
            if (!rpt) gla_finalize(F, l);
        } else if (q == 5 && PON(5)) {
            pg8::SchedMerge S{(const char*)(F.ws + WS_ACTS), (const char*)(wb + WO_BR), F.G, cblk};
            pg8::EpiMerge E{F.ws + WS_ACTS, act_ptr(F, A_MERGED)};
            pg8::gemm_phase<pg8::EpiMerge, pg8::SchedMerge, true, true>(F.lds, F.wave, 512, 512, S, E);
        } else if (q == 6 && PON(6)) {
            pg8::SchedGrid S{(const char*)act_ptr(F, A_MERGED), (const char*)(wb + WO_OUT), (size_t)256 * 1024 * 2, (size_t)256 * 1024 * 2, 0, 64, 4, F.G, cblk, 1 << 30, MERGED_HI_DELTA};
            pg8::EpiResid E{(bf16_t*)(F.ws + WS_XB), rss_mid};
            pg8::gemm_phase<pg8::EpiResid, pg8::SchedGrid, true, true>(F.lds, F.wave, 1024, 1024, S, E);
        } else if (l == 0 && q == 7 && PON(7)) {
            pg8::SchedGrid S{(const char*)(F.ws + WS_XB), (const char*)(wb + WO_FGU), (size_t)256 * 1024 * 2, (size_t)256 * 1024 * 2, 0, 64, 22, F.G, cblk, 1 << 30};
            if (F.G == 256) S.split_from = 1280;
            { pg8::Unit u0; if (S.next(0, u0)) fill_rs(F, rss_mid, u0.pm); }
            pg8::EpiSwiglu<false> E{act_ptr(F, A_ACT), DFF, (const LAS float*)(F.lds + RS_OFF), nullptr, nullptr};
            pg8::gemm_phase<pg8::EpiSwiglu<false>, pg8::SchedGrid, true, true>(F.lds, F.wave, 1024, 1024, S, E);
        } else if (l == 0 && q == 8 && PON(8)) {
            pg8::SchedGrid S{(const char*)act_ptr(F, A_ACT), (const char*)(wb + WO_FD), (size_t)256 * DFF * 2, (size_t)256 * DFF * 2, 0, 64, 4, F.G, cblk, 1 << 30};
            pg8::EpiResid E{(bf16_t*)(F.ws + WS_XB), F.stats + SF_ROWSS + (size_t)2 * T * 16};
            pg8::gemm_phase<pg8::EpiResid, pg8::SchedGrid, true, true>(F.lds, F.wave, DFF, DFF, S, E);
        } else if (q == 7 && PON(9)) {
            phase_route1(F);
            __syncthreads();
            LAS float* scr = (LAS float*)(F.lds + F.wave * 16384);
            const int gw = F.vcu * 8 + F.wave, NGW = F.G * 8;
            CONV_LOOP(12, moe_seg(F, (si_ < 4) ? (6 + (si_ >> 1)) * 3 + (si_ & 1) : (si_ - 4) * 3 + 2));
        } else if (q == 8 && PON(9)) {
            phase_route2(F);
        } else if (q == 9 && PON(10)) {
            unsigned char* wm = F.ws + WS_W0;
            LAS int* geo = (LAS int*)(F.lds + RING_BYTES + 512);
            moe_geometry(F, 0, geo);
            pg8::SchedMoe S; S.A = (const char*)act_ptr(F, A_XG); S.B = (const char*)(wm + WO_MGU); S.a_tile = (size_t)256 * 1024 * 2; S.b_tile = (size_t)256 * 1024 * 2; S.b_exp = (size_t)2816 * 1024 * 2;
            S.nN = 11; S.G = F.G; S.c = cblk;
            S.t1 = __builtin_amdgcn_readfirstlane(geo[1]); S.t2 = __builtin_amdgcn_readfirstlane(geo[2]); S.t3 = __builtin_amdgcn_readfirstlane(geo[3]); S.t4 = __builtin_amdgcn_readfirstlane(geo[4]);
            S.t5 = __builtin_amdgcn_readfirstlane(geo[5]); S.t6 = __builtin_amdgcn_readfirstlane(geo[6]); S.t7 = __builtin_amdgcn_readfirstlane(geo[7]); S.MT = __builtin_amdgcn_readfirstlane(geo[8]);
            pg8::EpiSwiglu<true> E{act_ptr(F, A_ACTE), DEXP, (const LAS float*)nullptr, (const float*)(F.ws + WS_SLOT + SL_SCALE), (const float*)(F.ws + WS_SLOT + SL_COMB)};
            pg8::gemm_phase<pg8::EpiSwiglu<true>, pg8::SchedMoe, true, true>(F.lds, F.wave, 1024, 1024, S, E);
        } else if (q == 10 && PON(10)) {
            unsigned char* wm = F.ws + WS_W0;
            LAS int* geo = (LAS int*)(F.lds + RING_BYTES + 512);
            moe_geometry(F, 0, geo);
            pg8::SchedMoe S; S.A = (const char*)act_ptr(F, A_ACTE); S.B = (const char*)(wm + WO_MD); S.a_tile = (size_t)256 * DEXP * 2; S.b_tile = (size_t)256 * DEXP * 2; S.b_exp = (size_t)1024 * DEXP * 2;
            S.nN = 4; S.G = F.G; S.c = cblk;
            S.t1 = __builtin_amdgcn_readfirstlane(geo[1]); S.t2 = __builtin_amdgcn_readfirstlane(geo[2]); S.t3 = __builtin_amdgcn_readfirstlane(geo[3]); S.t4 = __builtin_amdgcn_readfirstlane(geo[4]);
            S.t5 = __builtin_amdgcn_readfirstlane(geo[5]); S.t6 = __builtin_amdgcn_readfirstlane(geo[6]); S.t7 = __builtin_amdgcn_readfirstlane(geo[7]); S.MT = __builtin_amdgcn_readfirstlane(geo[8]);
            { const int nt = S.MT * 4, rem = nt % F.G; if (rem > 0 && 2 * rem <= F.G) S.split_from = nt - rem; }
            pg8::EpiMoeDown E{act_ptr(F, A_Y)};
            pg8::gemm_phase<pg8::EpiMoeDown, pg8::SchedMoe, true, true>(F.lds, F.wave, DEXP, DEXP, S, E);
        }
        else if (q == 11) {
            const int* tslot = (const int*)(F.ws + WS_TSLOT); const bf16_t* y = act_ptr(F, A_Y);
            for (int t = F.vcu * 8 + F.wave; t < T; t += F.G * 8) {
                const int s0 = tslot[t * 2], s1 = tslot[t * 2 + 1];
                f32x4* xo = (f32x4*)(F.out + (size_t)t * D) + F.lane * 2;
                const bf16_t* xbr = (const bf16_t*)(F.ws + WS_XB) + (size_t)t * D;
#pragma unroll
                for (int j = 0; j < 2; ++j) {
                    const u32x4 a = *((const u32x4*)(y + (size_t)s0 * D) + 64 * j + F.lane), bq = *((const u32x4*)(y + (size_t)s1 * D) + 64 * j + F.lane);
                    const u32x4 xv = *((const u32x4*)xbr + 64 * j + F.lane);
                    f32x4 x0 = {bflo(xv.x), bfhi(xv.x), bflo(xv.y), bfhi(xv.y)}, x1 = {bflo(xv.z), bfhi(xv.z), bflo(xv.w), bfhi(xv.w)};
                    x0[0] += bflo(a.x) + bflo(bq.x); x0[1] += bfhi(a.x) + bfhi(bq.x); x0[2] += bflo(a.y) + bflo(bq.y); x0[3] += bfhi(a.y) + bfhi(bq.y);
                    x1[0] += bflo(a.z) + bflo(bq.z); x1[1] += bfhi(a.z) + bfhi(bq.z); x1[2] += bflo(a.w) + bflo(bq.w); x1[3] += bfhi(a.w) + bfhi(bq.w);
                    xo[128 * j] = x0; xo[128 * j + 1] = x1;
                }
            }
        }
        if (ph + 1 < hi || (!rpt && ((REP_MASK >> ph) & 1))) xcd_barrier(bar);
    }
}


#ifdef DBG_PH
__global__ void dbg_dump(const unsigned char* ws, float* out) {
    const size_t i = (size_t)blockIdx.x * 256 + threadIdx.x;
    float v = 0.f;
    const bf16_t* a0 = (const bf16_t*)(ws + WS_ACTS + DBG_A0); const bf16_t* a1 = (const bf16_t*)(ws + WS_ACTS + DBG_A1);
    if (i < (size_t)DBG_N0) v += __uint_as_float((unsigned)a0[i] << 16);
    if (i < (size_t)DBG_N1) v += 3.f * __uint_as_float((unsigned)a1[i] << 16);
    out[i] = v;
}
#endif

extern "C" void kernel_launch(void* const* d_in, const int* in_sizes, int n_in, void* d_out, int out_size, void* d_ws, size_t ws_size, hipStream_t stream) {
    static int grid = 0;
    if (grid == 0) {
        if (n_in != 25 || out_size != T * D || ws_size < WS_END) { fprintf(stderr, "kernel_launch: unexpected sizes (n_in %d out %d ws %zu)\n", n_in, out_size, ws_size); grid = -1; return; }
        int dev = 0, cus = 0;
        if (hipGetDevice(&dev) != hipSuccess || hipDeviceGetAttribute(&cus, hipDeviceAttributeMultiprocessorCount, dev) != hipSuccess) { grid = -1; return; }
        if (hipFuncSetAttribute((const void*)mega_fwd, hipFuncAttributeMaxDynamicSharedMemorySize, LDS_BYTES) != hipSuccess) { grid = -1; return; }
        int per_cu = 0;
        (void)hipOccupancyMaxActiveBlocksPerMultiprocessor(&per_cu, (const void*)mega_fwd, 512, LDS_BYTES);
        (void)hipGetLastError();
        grid = cus;
    }
    if (grid < 0) return;
    (void)hipMemsetAsync((char*)d_ws + WS_CTL, 0, CTL_BYTES, stream);
    Args a{};
    for (int i = 0; i < 25; ++i) a.in[i] = d_in[i];
    a.out = (float*)d_out; a.ws = (unsigned char*)d_ws; a.ph_lo = 0; a.ph_hi = NPHASE; a.li = 0; a.pad = 0;
#ifdef DBG_PH
    a.ph_hi = DBG_PH;
#endif
    void* kargs[] = {&a};
    hipError_t e = hipLaunchCooperativeKernel((const void*)mega_fwd, dim3(grid), dim3(512), kargs, LDS_BYTES, stream);
    if (e != hipSuccess) fprintf(stderr, "cooperative launch failed: %s (grid %d)\n", hipGetErrorString(e), grid);
#ifdef DBG_PH
    hipLaunchKernelGGL(dbg_dump, dim3(T * 1024 / 256), dim3(256), 0, stream, (const unsigned char*)d_ws, (float*)d_out);
#endif
}
```

```cpp
#include <hip/hip_runtime.h>
#include <cstdint>
#include <cstdio>

#define LAS __attribute__((address_space(3)))
#define CAS __attribute__((address_space(4)))
typedef const void* GPtr;
typedef unsigned short bf16_t;
typedef short bf16x8 __attribute__((ext_vector_type(8)));
typedef float f32x4 __attribute__((ext_vector_type(4)));
typedef float f32x16 __attribute__((ext_vector_type(16)));
typedef unsigned u32x4 __attribute__((ext_vector_type(4)));
typedef unsigned u32x2 __attribute__((ext_vector_type(2)));

constexpr int T = 16384, SEQ = 4096, NB = 4, D = 1024, DIN = 5680, DFF = 2816, DEXP = 1408, NEXP = 8;
constexpr int NPROJ = 2816;
constexpr float EPS = 1e-6f;
constexpr int MAXSLOT = 34816;

constexpr size_t MiB = 1u << 20;
constexpr size_t WS_CTL = 0, CTL_BYTES = 128 * 1024;
constexpr size_t WS_SLOT = 2 * MiB;
constexpr size_t WS_ROPE = 3 * MiB;
constexpr size_t WS_XB = 5 * MiB;
constexpr size_t WS_W1 = 37 * MiB;
constexpr size_t WS_W0 = 55 * MiB;
constexpr size_t WS_ACTS = 89 * MiB;
constexpr size_t WS_STATS = 283 * MiB;
constexpr size_t WS_END = 291 * MiB;
constexpr size_t WO_IN = 0, WO_G = 5632 * 1024, WO_UP = WO_G + 6 * MiB, WO_BR = WO_UP + 1792 * 256 * 2, WO_OUT = WO_BR + 3 * MiB, WO_FGU = WO_OUT + 2 * MiB, WO_FD = WO_FGU + 11 * MiB;
constexpr size_t WO_MGU = 0, WO_MD = 44 * MiB;
constexpr size_t A_OG = 0, A_GQKV = 16 * MiB, A_UP = 48 * MiB, A_MISC = 64 * MiB, A_CQKV = 72 * MiB, A_VT = 72 * MiB, A_QKVRAW = 88 * MiB;
constexpr size_t A_YSA = 96 * MiB, A_POOLED = 112 * MiB, A_YSB = 128 * MiB, A_QH = 144 * MiB, A_KH = 168 * MiB;
constexpr size_t A_G0 = 16 * MiB, A_G1 = 48 * MiB, A_G2 = 144 * MiB, A_ACT = 0;
constexpr size_t A_MERGED = 0;
constexpr long long MERGED_HI_DELTA = (long long)(64 * MiB);
constexpr size_t A_XG = 32 * MiB, A_ACTE = 100 * MiB, A_Y = 32 * MiB;
constexpr int CW_TMO = 0, CW_BAR = 4096, CW_QUEUE = 16384, CW_WGCNT = 20480;
static_assert((size_t)(CW_WGCNT + 2048) * 4 <= CTL_BYTES, "ctl");
constexpr size_t SF_SSQ = 0;
constexpr size_t SF_ROWSS = (size_t)2 * 2 * T * 4;
constexpr size_t SF_OSS = SF_ROWSS + (size_t)4 * T * 16;
constexpr size_t SF_EB = SF_OSS + (size_t)T * 32;
static_assert((SF_EB + (size_t)(T / 32) * 256) * 4 <= 8 * MiB, "stats");
constexpr size_t SL_TOK = 0, SL_SCALE = 139264, SL_COMB = 2 * 139264, SL_ROUTE = 3 * 139264;
constexpr size_t WS_TSLOT = 1 * MiB;

constexpr int RING_BYTES = 131072, LDSCTL_OFF = RING_BYTES, MISC_OFF = LDSCTL_OFF + 320, LDS_BYTES = 147456;
constexpr int RS_OFF = RING_BYTES + 1024;

#define LDS_WAIT() asm volatile("s_waitcnt lgkmcnt(0)" ::: "memory")
#define VM_WAIT() asm volatile("s_waitcnt vmcnt(0)" ::: "memory")
#define LDS_BARRIER() do { asm volatile("s_waitcnt lgkmcnt(0)" ::: "memory"); __builtin_amdgcn_s_barrier(); asm volatile("" ::: "memory"); } while (0)
#define RLX_AGENT __ATOMIC_RELAXED, __HIP_MEMORY_SCOPE_AGENT
typedef float f32x2_t __attribute__((ext_vector_type(2))); typedef __bf16 bf16x2_t __attribute__((ext_vector_type(2)));
__device__ __forceinline__ unsigned cvt_pk_bf16(float lo, float hi) { f32x2_t v = {lo, hi}; bf16x2_t b = __builtin_convertvector(v, bf16x2_t); return __builtin_bit_cast(unsigned, b); }
__device__ __forceinline__ float bflo(unsigned u) { return __uint_as_float(u << 16); }
__device__ __forceinline__ float bfhi(unsigned u) { return __uint_as_float(u & 0xffff0000u); }
__device__ __forceinline__ float wave_sum(float v) {
#pragma unroll
    for (int o = 1; o < 64; o <<= 1) v += __shfl_xor(v, o);
    return v;
}
__device__ __forceinline__ float sum16(const float* p) { const f32x4 a = *(const f32x4*)p, b = *(const f32x4*)(p + 4), c = *(const f32x4*)(p + 8), d = *(const f32x4*)(p + 12);
    return (((a[0] + a[1]) + (a[2] + a[3])) + ((b[0] + b[1]) + (b[2] + b[3]))) + (((c[0] + c[1]) + (c[2] + c[3])) + ((d[0] + d[1]) + (d[2] + d[3]))); }
__device__ __forceinline__ float sum4(const float* p) { const f32x4 a = *(const f32x4*)p; return (a[0] + a[1]) + (a[2] + a[3]); }
__device__ __forceinline__ float fast_sigmoid(float z) { return __builtin_amdgcn_rcpf(1.f + __builtin_amdgcn_exp2f(-1.4426950408889634f * z)); }

namespace pg8 {
constexpr int BM = 256, BK = 64, HALF = 128, HTB = HALF * BK * 2, STAGE_BYTES = 8 * HTB, NXCD = 8, WGM = 8;
__host__ __device__ __forceinline__ int lds_byte(int r, int c) { const int st = (r >> 4) * 2 + (c >> 5), rr = r & 15, cc = c & 31, ob = rr * 64 + cc * 2; return st * 1024 + (ob ^ (((ob >> 9) & 1) << 5)); }
__host__ __device__ __forceinline__ void stage_rc(int b, int& R, int& C) { const int st = b / 1024, sb = b % 1024, swz = sb ^ (((sb >> 9) & 1) << 5); R = (st >> 1) * 16 + swz / 64; C = (st & 1) * 32 + (swz % 64) / 2; }
__host__ __device__ __forceinline__ int perm32(int rho) { const int n = rho >> 4, i = rho & 15; return 8 * (i >> 2) + 4 * n + (i & 3); }

struct Unit { const char* a; const char* b; int pm, pn, kind, half; };
__device__ __forceinline__ void tile_map(int L, int nM, int nN, int& pm, int& pn) {
    const int nwg = nM * nN; int wgid = L;
    { const int q = nwg / NXCD, r = nwg % NXCD, xcd = wgid % NXCD, off = wgid / NXCD; wgid = (xcd < r ? xcd * (q + 1) : r * (q + 1) + (xcd - r) * q) + off; }
    const int nig = WGM * nN, gid = wgid / nig, fm = gid * WGM, gsz = (nM - fm) < WGM ? (nM - fm) : WGM;
    pm = fm + ((wgid % nig) % gsz); pn = (wgid % nig) / gsz;
}

template <class Epi, class Sched, bool ALIGN_EPI, bool SP2>
__device__ __forceinline__ void gemm_phase(LAS unsigned char* lds, const int wave_in, const int lda, const int K, const Sched& S, const Epi& E) {
    int ln_; asm volatile("v_mbcnt_lo_u32_b32 %0, -1, 0\n\tv_mbcnt_hi_u32_b32 %0, -1, %0" : "=v"(ln_));
    const int tid = wave_in * 64 + ln_, wid = __builtin_amdgcn_readfirstlane(tid >> 6), lane = tid & 63, wr = wid >> 2, wc = wid & 3, fr = lane & 15, fq = lane >> 4;
    const int nt = K / BK;
    unsigned voffA[2], voffB[2];
#pragma unroll
    for (int i = 0; i < 2; ++i) { int R, C; stage_rc(tid * 16 + i * 8192, R, C); const int Rb = Epi::PERM ? ((R & ~31) + perm32(R & 31)) : R;
        voffA[i] = (unsigned)(R * lda + C) * 2u; voffB[i] = (unsigned)(Rb * K + C) * 2u; }
    const size_t kstep = (size_t)(BK * 2);
    const size_t hstepA = (size_t)HALF * lda * 2, hstepB = (size_t)HALF * K * 2;
    const unsigned ldsw = (unsigned)wid * 1024u;
    const int aoff = lds_byte(wr * 64 + fr, fq * 8), boff = lds_byte(wc * 32 + fr, fq * 8);
#define PG8_SA(b, h) (((b) * 2 + (h)) * HTB)
#define PG8_SB(b, h) ((4 + (b) * 2 + (h)) * HTB)
#define PG8_STAGE(bufoff, gbase, voff) do { _Pragma("unroll") for (int _i = 0; _i < 2; ++_i) \
        __builtin_amdgcn_global_load_lds((const unsigned*)((const char*)(gbase) + (voff)[_i]), (LAS unsigned*)(lds + (bufoff) + ldsw + _i * 8192), 16, 0, 0); } while (0)
#define PG8_LDA(dst, b, h) do { _Pragma("unroll") for (int m = 0; m < 4; ++m) _Pragma("unroll") for (int k = 0; k < 2; ++k) dst[m][k] = *(const LAS bf16x8*)(lds + PG8_SA(b, h) + aoff + m * 2048 + k * 1024); } while (0)
#define PG8_LDB(dst, b, h) do { _Pragma("unroll") for (int n = 0; n < 2; ++n) _Pragma("unroll") for (int k = 0; k < 2; ++k) dst[n][k] = *(const LAS bf16x8*)(lds + PG8_SB(b, h) + boff + n * 2048 + k * 1024); } while (0)
#define PG8_MMA(ai, bj, At, Bt) do { __builtin_amdgcn_s_setprio(1); _Pragma("unroll") for (int m = 0; m < 4; ++m) _Pragma("unroll") for (int n = 0; n < 2; ++n) _Pragma("unroll") for (int k = 0; k < 2; ++k) \
        acc[ai][bj][m][n] = __builtin_amdgcn_mfma_f32_16x16x32_bf16(Bt[n][k], At[m][k], acc[ai][bj][m][n], 0, 0, 0); __builtin_amdgcn_s_setprio(0); } while (0)
#define PG8_WAIT_V(n) asm volatile("s_waitcnt vmcnt(" #n ")" ::: "memory")
#define PG8_WAIT_L(n) asm volatile("s_waitcnt lgkmcnt(" #n ")" ::: "memory")
#define PG8_BAR __builtin_amdgcn_s_barrier()
#define PG8_SCHED __builtin_amdgcn_sched_barrier(0)
    Unit cur, nxt; int ui = 0;
    if (!S.next(0, cur)) return;
    f32x4 acc[2][2][4][2];
#pragma unroll
    for (int a = 0; a < 2; ++a)
#pragma unroll
        for (int b = 0; b < 2; ++b)
#pragma unroll
            for (int m = 0; m < 4; ++m)
#pragma unroll
                for (int n = 0; n < 2; ++n) acc[a][b][m][n] = (f32x4){0.f, 0.f, 0.f, 0.f};
    bf16x8 At[4][2], B0[2][2], B1[2][2];
    const char* cA = cur.a; const char* cB = cur.b;
    if constexpr (SP2) {
        PG8_STAGE(PG8_SB(0, 0), cB, voffB); PG8_STAGE(PG8_SB(0, 1), cB + hstepB, voffB); PG8_STAGE(PG8_SA(0, 0), cA, voffA); PG8_STAGE(PG8_SA(0, 1), cA + hstepA, voffA);
        if (wr == 1) PG8_BAR;
        PG8_WAIT_V(2); PG8_BAR;
        PG8_STAGE(PG8_SB(1, 0), cB + kstep, voffB); PG8_STAGE(PG8_SA(1, 0), cA + kstep, voffA); PG8_STAGE(PG8_SB(1, 1), cB + hstepB + kstep, voffB);
        PG8_WAIT_V(6); PG8_BAR;
    } else {
        PG8_STAGE(PG8_SB(0, 0), cB, voffB); PG8_STAGE(PG8_SA(0, 0), cA, voffA); PG8_STAGE(PG8_SB(0, 1), cB + hstepB, voffB); PG8_STAGE(PG8_SA(0, 1), cA + hstepA, voffA);
        if (wr == 1) PG8_BAR;
        PG8_WAIT_V(4); PG8_BAR;
        PG8_STAGE(PG8_SB(1, 0), cB + kstep, voffB); PG8_STAGE(PG8_SA(1, 0), cA + kstep, voffA); PG8_STAGE(PG8_SB(1, 1), cB + hstepB + kstep, voffB);
        PG8_WAIT_V(6); PG8_BAR;
    }
    for (;;) {
        const bool has_next = S.next(ui + 1, nxt);
        const bool do0 = cur.half != 2, do1 = cur.half != 1;
        const char* nA = has_next ? nxt.a : cA; const char* nB = has_next ? nxt.b : cB;
#pragma unroll 1
        for (int t = 0; t < nt; t += 2) {
            const bool last = (t == nt - 2);
            const char* a1 = cA + (size_t)(t + 1) * kstep;
            const char* a2 = last ? nA : cA + (size_t)(t + 2) * kstep; const char* b2 = last ? nB : cB + (size_t)(t + 2) * kstep;
            const char* a3 = a2 + kstep; const char* b3 = b2 + kstep;
            if constexpr (SP2) {
            PG8_LDB(B0, 0, 0); PG8_LDB(B1, 0, 1); PG8_SCHED; PG8_LDA(At, 0, 0); PG8_STAGE(PG8_SA(1, 1), a1 + hstepA, voffA);
            PG8_WAIT_V(8); PG8_WAIT_L(0); PG8_BAR; if (do0) { PG8_MMA(0, 0, At, B0); PG8_MMA(0, 1, At, B1); } PG8_BAR; PG8_SCHED;
            PG8_LDA(At, 0, 1); PG8_STAGE(PG8_SB(0, 0), b2, voffB); PG8_STAGE(PG8_SB(0, 1), b2 + hstepB, voffB); PG8_STAGE(PG8_SA(0, 0), a2, voffA);
            PG8_WAIT_V(8); PG8_WAIT_L(0); PG8_BAR; if (do1) { PG8_MMA(1, 0, At, B0); PG8_MMA(1, 1, At, B1); } PG8_BAR; PG8_SCHED;
            PG8_LDB(B0, 1, 0); PG8_LDB(B1, 1, 1); PG8_SCHED; PG8_LDA(At, 1, 0); PG8_STAGE(PG8_SA(0, 1), a2 + hstepA, voffA);
            PG8_WAIT_V(8); PG8_WAIT_L(0); PG8_BAR; if (do0) { PG8_MMA(0, 0, At, B0); PG8_MMA(0, 1, At, B1); } PG8_BAR; PG8_SCHED;
            PG8_LDA(At, 1, 1); PG8_STAGE(PG8_SB(1, 0), b3, voffB); PG8_STAGE(PG8_SB(1, 1), b3 + hstepB, voffB); PG8_STAGE(PG8_SA(1, 0), a3, voffA);
            PG8_WAIT_V(8); PG8_WAIT_L(0); PG8_BAR; if (do1) { PG8_MMA(1, 0, At, B0); PG8_MMA(1, 1, At, B1); } PG8_BAR; PG8_SCHED;
            } else {
            PG8_LDB(B0, 0, 0); PG8_SCHED; PG8_LDA(At, 0, 0); PG8_STAGE(PG8_SA(1, 1), a1 + hstepA, voffA);
            PG8_WAIT_L(8); PG8_BAR; PG8_WAIT_L(0); PG8_MMA(0, 0, At, B0); PG8_BAR; PG8_SCHED;
            PG8_LDB(B1, 0, 1); PG8_STAGE(PG8_SB(0, 0), b2, voffB);
            PG8_BAR; PG8_WAIT_L(0); PG8_MMA(0, 1, At, B1); PG8_BAR;
            PG8_LDA(At, 0, 1); PG8_STAGE(PG8_SA(0, 0), a2, voffA);
            PG8_BAR; PG8_WAIT_L(0); PG8_MMA(1, 0, At, B0); PG8_BAR; PG8_SCHED;
            PG8_STAGE(PG8_SB(0, 1), b2 + hstepB, voffB);
            PG8_WAIT_V(6); PG8_BAR; PG8_MMA(1, 1, At, B1); PG8_BAR;
            PG8_LDB(B0, 1, 0); PG8_SCHED; PG8_LDA(At, 1, 0); PG8_STAGE(PG8_SA(0, 1), a2 + hstepA, voffA);
            PG8_WAIT_L(8); PG8_BAR; PG8_WAIT_L(0); PG8_MMA(0, 0, At, B0); PG8_BAR; PG8_SCHED;
            PG8_LDB(B1, 1, 1); PG8_STAGE(PG8_SB(1, 0), b3, voffB);
            PG8_BAR; PG8_WAIT_L(0); PG8_MMA(0, 1, At, B1); PG8_BAR;
            PG8_LDA(At, 1, 1); PG8_STAGE(PG8_SA(1, 0), a3, voffA);
            PG8_BAR; PG8_WAIT_L(0); PG8_MMA(1, 0, At, B0); PG8_BAR; PG8_SCHED;
            PG8_STAGE(PG8_SB(1, 1), b3 + hstepB, voffB);
            PG8_WAIT_V(6); PG8_BAR; PG8_MMA(1, 1, At, B1); PG8_BAR;
            }
        }
        if constexpr (ALIGN_EPI) { if (wr == 0) PG8_BAR; }
        E(acc, cur, wr, wc, fr, fq);
        if (!has_next) break;
        if (!E.keep(cur)) {
#pragma unroll
            for (int a = 0; a < 2; ++a)
#pragma unroll
                for (int b = 0; b < 2; ++b)
#pragma unroll
                    for (int m = 0; m < 4; ++m)
#pragma unroll
                        for (int n = 0; n < 2; ++n) acc[a][b][m][n] = (f32x4){0.f, 0.f, 0.f, 0.f};
        }
        cur = nxt; cA = nA; cB = nB; ++ui;
        if constexpr (ALIGN_EPI) { if (wr == 1) PG8_BAR; }
    }
    PG8_WAIT_V(0);
    if constexpr (!ALIGN_EPI) { if (wr == 0) PG8_BAR; }
    PG8_BAR;
#undef PG8_SA
#undef PG8_SB
#undef PG8_STAGE
#undef PG8_LDA
#undef PG8_LDB
#undef PG8_MMA
#undef PG8_WAIT_V
#undef PG8_WAIT_L
#undef PG8_BAR
#undef PG8_SCHED
}

typedef f32x4 Acc[2][2][4][2];

struct EpiProj {
    static constexpr bool PERM = true;
    bf16_t *cqkv, *gqkv, *og, *up, *misc; const LAS float* rs_tab; float* ssq;
    __device__ __forceinline__ bool keep(const Unit&) const { return false; }
    __device__ __forceinline__ void operator()(Acc& acc, const Unit& u, int wr, int wc, int fr, int fq) const {
        const int row0 = u.pm * BM + wr * 64 + fr;
        bf16_t* dst; int ld, coff; const int pn = u.pn;
        if (pn < 2) { dst = cqkv; ld = 512; coff = pn * 256; }
        else if (pn < 6) { dst = gqkv; ld = 1024; coff = (pn - 2) * 256; }
        else if (pn < 8) { dst = og; ld = 512; coff = (pn - 6) * 256; }
        else if (pn < 10) { dst = up; ld = 512; coff = (pn - 8) * 256; }
        else { dst = misc; ld = 256; coff = 0; }
        const int col0 = coff + wc * 32 + 8 * fq;
#pragma unroll
        for (int ai = 0; ai < 2; ++ai)
#pragma unroll
            for (int m = 0; m < 4; ++m) { if (u.half && ai != u.half - 1) continue;
                const int row = row0 + ai * HALF + m * 16;
                const float rs = rs_tab[wr * 64 + fr + ai * HALF + m * 16];
                float ss = 0.f;
#pragma unroll
                for (int bj = 0; bj < 2; ++bj) {
                    const f32x4 v0 = acc[ai][bj][m][0] * rs, v1 = acc[ai][bj][m][1] * rs;
                    ss += (v0[0] * v0[0] + v0[1] * v0[1]) + (v0[2] * v0[2] + v0[3] * v0[3]) + (v1[0] * v1[0] + v1[1] * v1[1]) + (v1[2] * v1[2] + v1[3] * v1[3]);
                    u32x4 w; w.x = cvt_pk_bf16(v0[0], v0[1]); w.y = cvt_pk_bf16(v0[2], v0[3]); w.z = cvt_pk_bf16(v1[0], v1[1]); w.w = cvt_pk_bf16(v1[2], v1[3]);
                    *(u32x4*)(dst + (size_t)row * ld + col0 + bj * HALF) = w;
                }
                if (pn < 2) { ss += __shfl_xor(ss, 16); ss += __shfl_xor(ss, 32); if (fq == 0) ssq[((size_t)pn * T + row) * 4 + wc] = ss; }
            }
    }
};
struct EpiUp {
    static constexpr bool PERM = true;
    bf16_t* out; const float* ssq;
    __device__ __forceinline__ bool keep(const Unit&) const { return false; }
    __device__ __forceinline__ void operator()(Acc& acc, const Unit& u, int wr, int wc, int fr, int fq) const {
        const int row0 = u.pm * BM + wr * 64 + fr, col0 = u.pn * BM + wc * 32 + 8 * fq;
        const float* sq = ssq + (u.pn < 3 ? (size_t)0 : (size_t)T * 4);
        f32x4 sqv[2][4];
#pragma unroll
        for (int ai = 0; ai < 2; ++ai)
#pragma unroll
            for (int m = 0; m < 4; ++m) sqv[ai][m] = *(const f32x4*)(sq + (size_t)(row0 + ai * HALF + m * 16) * 4);
#pragma unroll
        for (int ai = 0; ai < 2; ++ai)
#pragma unroll
            for (int m = 0; m < 4; ++m) { if (u.half && ai != u.half - 1) continue;
                const int row = row0 + ai * HALF + m * 16;
                const float rs = rsqrtf(((sqv[ai][m][0] + sqv[ai][m][1]) + (sqv[ai][m][2] + sqv[ai][m][3])) * (1.f / 256.f) + EPS);
#pragma unroll
                for (int bj = 0; bj < 2; ++bj) {
                    const f32x4 v0 = acc[ai][bj][m][0] * rs, v1 = acc[ai][bj][m][1] * rs;
                    u32x4 w; w.x = cvt_pk_bf16(v0[0], v0[1]); w.y = cvt_pk_bf16(v0[2], v0[3]); w.z = cvt_pk_bf16(v1[0], v1[1]); w.w = cvt_pk_bf16(v1[2], v1[3]);
                    *(u32x4*)(out + (size_t)row * 1792 + col0 + bj * HALF) = w;
                }
            }
    }
};
struct EpiGate {
    static constexpr bool PERM = true;
    unsigned char* acts; const LAS float* rs_tab;
    __device__ __forceinline__ bool keep(const Unit&) const { return false; }
    __device__ __forceinline__ void operator()(Acc& acc, const Unit& u, int wr, int wc, int fr, int fq) const {
        const int row0 = u.pm * BM + wr * 64 + fr, pl = u.pn >> 2, col0 = (u.pn & 3) * BM + wc * 32 + 8 * fq;
        bf16_t* dst = (bf16_t*)(acts + ((long long)A_G0 + (long long)(pl == 1) * (long long)(A_G1 - A_G0) + (long long)(pl == 2) * (long long)(A_G2 - A_G0)));
#pragma unroll
        for (int ai = 0; ai < 2; ++ai)
#pragma unroll
            for (int m = 0; m < 4; ++m) { if (u.half && ai != u.half - 1) continue;
                const int row = row0 + ai * HALF + m * 16;
                const float rs = rs_tab[wr * 64 + fr + ai * HALF + m * 16];
#pragma unroll
                for (int bj = 0; bj < 2; ++bj) {
                    f32x4 v0 = acc[ai][bj][m][0] * rs, v1 = acc[ai][bj][m][1] * rs;
#ifndef DBG_NOSIG
#pragma unroll
                    for (int e = 0; e < 4; ++e) { v0[e] = fast_sigmoid(fminf(fmaxf(v0[e], -60.f), 60.f)); v1[e] = fast_sigmoid(fminf(fmaxf(v1[e], -60.f), 60.f)); }
#endif
                    u32x4 w; w.x = cvt_pk_bf16(v0[0], v0[1]); w.y = cvt_pk_bf16(v0[2], v0[3]); w.z = cvt_pk_bf16(v1[0], v1[1]); w.w = cvt_pk_bf16(v1[2], v1[3]);
                    *(u32x4*)(dst + (size_t)row * 1024 + col0 + bj * HALF) = w;
                }
            }
    }
};
struct EpiMerge {
    static constexpr bool PERM = true;
    const unsigned char* acts; bf16_t* merged;
    __device__ __forceinline__ bool keep(const Unit& u) const { return u.kind < 2; }
    __device__ __forceinline__ void operator()(Acc& acc, const Unit& u, int wr, int wc, int fr, int fq) const {
        const int row0 = u.pm * BM + wr * 64 + fr, col0 = u.pn * BM + wc * 32 + 8 * fq, n = u.kind;
        const bf16_t* gn = (const bf16_t*)(acts + ((long long)A_G0 + (long long)(n == 1) * (long long)(A_G1 - A_G0) + (long long)(n == 2) * (long long)(A_G2 - A_G0)));
        const bf16_t* gd = (const bf16_t*)(acts + ((long long)A_G1 + (long long)(n != 0) * (long long)(A_G2 - A_G1)));
        if (n < 2) {
#pragma unroll
            for (int ai = 0; ai < 2; ++ai) {
                if (u.half && ai != u.half - 1) continue;
                u32x4 sn[4][2], sd[4][2];
#pragma unroll
                for (int m = 0; m < 4; ++m)
#pragma unroll
                    for (int bj = 0; bj < 2; ++bj) {
                        const size_t off = (size_t)(row0 + ai * HALF + m * 16) * 1024 + col0 + bj * HALF;
                        sn[m][bj] = *(const u32x4*)(gn + off); sd[m][bj] = *(const u32x4*)(gd + off);
                    }
#pragma unroll
                for (int m = 0; m < 4; ++m)
#pragma unroll
                    for (int bj = 0; bj < 2; ++bj) {
                        const u32x4 s = sn[m][bj], d = sd[m][bj];
                        f32x4 f0 = {bflo(s.x), bfhi(s.x), bflo(s.y), bfhi(s.y)}, f1 = {bflo(s.z), bfhi(s.z), bflo(s.w), bfhi(s.w)};
                        const f32x4 d0 = {bflo(d.x), bfhi(d.x), bflo(d.y), bfhi(d.y)}, d1 = {bflo(d.z), bfhi(d.z), bflo(d.w), bfhi(d.w)};
#pragma unroll
                        for (int e = 0; e < 4; ++e) { f0[e] *= __builtin_amdgcn_rcpf(d0[e]); f1[e] *= __builtin_amdgcn_rcpf(d1[e]); }
                        acc[ai][bj][m][0] = acc[ai][bj][m][0] * f0; acc[ai][bj][m][1] = acc[ai][bj][m][1] * f1;
                    }
            }
        } else {
#pragma unroll
            for (int ai = 0; ai < 2; ++ai) {
                if (u.half && ai != u.half - 1) continue;
                u32x4 sn[4][2];
#pragma unroll
                for (int m = 0; m < 4; ++m)
#pragma unroll
                    for (int bj = 0; bj < 2; ++bj) sn[m][bj] = *(const u32x4*)(gn + (size_t)(row0 + ai * HALF + m * 16) * 1024 + col0 + bj * HALF);
#pragma unroll
                for (int m = 0; m < 4; ++m)
#pragma unroll
                    for (int bj = 0; bj < 2; ++bj) {
                        const int row = row0 + ai * HALF + m * 16; const size_t off = (size_t)row * 1024 + col0 + bj * HALF;
                        const u32x4 s = sn[m][bj];
                        const f32x4 f0 = {bflo(s.x), bfhi(s.x), bflo(s.y), bfhi(s.y)}, f1 = {bflo(s.z), bfhi(s.z), bflo(s.w), bfhi(s.w)};
                        const f32x4 v0 = acc[ai][bj][m][0] * f0, v1 = acc[ai][bj][m][1] * f1;
                        u32x4 w; w.x = cvt_pk_bf16(v0[0], v0[1]); w.y = cvt_pk_bf16(v0[2], v0[3]); w.z = cvt_pk_bf16(v1[0], v1[1]); w.w = cvt_pk_bf16(v1[2], v1[3]);
                        *(u32x4*)((unsigned char*)(merged + off) + (row >= 8192 ? MERGED_HI_DELTA : 0)) = w;
                    }
            }
        }
    }
};
struct EpiResid {
    static constexpr bool PERM = true;
    bf16_t* xb; float* rowss_next;
    __device__ __forceinline__ bool keep(const Unit&) const { return false; }
    __device__ __forceinline__ void operator()(Acc& acc, const Unit& u, int wr, int wc, int fr, int fq) const {
        const int row0 = u.pm * BM + wr * 64 + fr, col0 = u.pn * BM + wc * 32 + 8 * fq;
#pragma unroll
        for (int ai = 0; ai < 2; ++ai) {
            if (u.half && ai != u.half - 1) continue;
            u32x4 ov[4][2];
#pragma unroll
            for (int m = 0; m < 4; ++m)
#pragma unroll
                for (int bj = 0; bj < 2; ++bj) ov[m][bj] = *(const u32x4*)(xb + (size_t)(row0 + ai * HALF + m * 16) * D + col0 + bj * HALF);
#pragma unroll
            for (int m = 0; m < 4; ++m) {
                const int row = row0 + ai * HALF + m * 16; float ss = 0.f;
#pragma unroll
                for (int bj = 0; bj < 2; ++bj) {
                    bf16_t* p = xb + (size_t)row * D + col0 + bj * HALF;
                    const u32x4 o = ov[m][bj];
                    const f32x4 v0 = (f32x4){bflo(o.x), bfhi(o.x), bflo(o.y), bfhi(o.y)} + acc[ai][bj][m][0], v1 = (f32x4){bflo(o.z), bfhi(o.z), bflo(o.w), bfhi(o.w)} + acc[ai][bj][m][1];
                    ss += ((v0[0] * v0[0] + v0[1] * v0[1]) + (v0[2] * v0[2] + v0[3] * v0[3])) + ((v1[0] * v1[0] + v1[1] * v1[1]) + (v1[2] * v1[2] + v1[3] * v1[3]));
                    u32x4 w; w.x = cvt_pk_bf16(v0[0], v0[1]); w.y = cvt_pk_bf16(v0[2], v0[3]); w.z = cvt_pk_bf16(v1[0], v1[1]); w.w = cvt_pk_bf16(v1[2], v1[3]);
                    *(u32x4*)p = w;
                }
                ss += __shfl_xor(ss, 16); ss += __shfl_xor(ss, 32); if (fq == 0) rowss_next[(size_t)row * 16 + u.pn * 4 + wc] = ss;
            }
        }
    }
};
template <bool MOE> struct EpiSwiglu {
    static constexpr bool PERM = true;
    bf16_t* act; int ld; const LAS float* rs_tab; const float* slot_scale; const float* slot_comb;
    __device__ __forceinline__ bool keep(const Unit&) const { return false; }
    __device__ __forceinline__ void operator()(Acc& acc, const Unit& u, int wr, int wc, int fr, int fq) const {
        const int row0 = u.pm * BM + wr * 64 + fr, col0 = u.pn * HALF + wc * 32 + 8 * fq;
        float rsv[2][4], cbv[2][4];
#pragma unroll
        for (int ai = 0; ai < 2; ++ai)
#pragma unroll
            for (int m = 0; m < 4; ++m) {
                if (MOE) { rsv[ai][m] = slot_scale[row0 + ai * HALF + m * 16]; cbv[ai][m] = slot_comb[row0 + ai * HALF + m * 16]; }
                else { rsv[ai][m] = rs_tab[wr * 64 + fr + ai * HALF + m * 16]; cbv[ai][m] = 1.f; }
            }
#pragma unroll
        for (int ai = 0; ai < 2; ++ai)
#pragma unroll
            for (int m = 0; m < 4; ++m) { if (u.half && ai != u.half - 1) continue;
                const int row = row0 + ai * HALF + m * 16;
                const float rs = rsv[ai][m], cb = cbv[ai][m];
                f32x4 o[2];
#pragma unroll
                for (int n = 0; n < 2; ++n) {
                    const f32x4 g = acc[ai][0][m][n] * rs, uu = acc[ai][1][m][n] * rs;
#pragma unroll
                    for (int e = 0; e < 4; ++e) o[n][e] = g[e] * fast_sigmoid(g[e]) * uu[e] * cb;
                }
                u32x4 w; w.x = cvt_pk_bf16(o[0][0], o[0][1]); w.y = cvt_pk_bf16(o[0][2], o[0][3]); w.z = cvt_pk_bf16(o[1][0], o[1][1]); w.w = cvt_pk_bf16(o[1][2], o[1][3]);
                *(u32x4*)(act + (size_t)row * ld + col0) = w;
            }
    }
};
struct EpiMoeDown {
    static constexpr bool PERM = true;
    bf16_t* y;
    __device__ __forceinline__ bool keep(const Unit&) const { return false; }
    __device__ __forceinline__ void operator()(Acc& acc, const Unit& u, int wr, int wc, int fr, int fq) const {
        const int row0 = u.pm * BM + wr * 64 + fr, col0 = u.pn * BM + wc * 32 + 8 * fq;
#pragma unroll
        for (int ai = 0; ai < 2; ++ai)
#pragma unroll
            for (int m = 0; m < 4; ++m) { if (u.half && ai != u.half - 1) continue;
                const int row = row0 + ai * HALF + m * 16;
#pragma unroll
                for (int bj = 0; bj < 2; ++bj) {
                    const f32x4 v0 = acc[ai][bj][m][0], v1 = acc[ai][bj][m][1];
                    u32x4 w; w.x = cvt_pk_bf16(v0[0], v0[1]); w.y = cvt_pk_bf16(v0[2], v0[3]); w.z = cvt_pk_bf16(v1[0], v1[1]); w.w = cvt_pk_bf16(v1[2], v1[3]);
                    *(u32x4*)(y + (size_t)row * D + col0 + bj * HALF) = w;
                }
            }
    }
};

struct SchedGrid {
    const char* A; const char* B; size_t a_tile, b_tile, a_alt; int nM, nN, G, c, alt_from; long long a_hi = 0;
    int split_from = 1 << 30;
    __device__ __forceinline__ bool next(int i, Unit& u) const {
        int L = i * G + c, hf = 0;
        if (L >= split_from) { const int nl = nM * nN - split_from, j = L - split_from; if (j >= 2 * nl) return false; hf = 1 + j / nl; L = split_from + j % nl; }
        if (L >= nM * nN) return false;
        int pm, pn; tile_map(L, nM, nN, pm, pn);
        u.pm = pm; u.pn = pn; u.kind = 0; u.half = hf; u.a = A + (size_t)pm * a_tile + (pn >= alt_from ? a_alt : 0) + (pm >= 32 ? a_hi : 0); u.b = B + (size_t)pn * b_tile; return true;
    }
};
struct SchedMerge {
    const char* acts; const char* wbr; int G, c;
    __device__ __forceinline__ bool next(int i, Unit& u) const {
        const int ti = i / 3, n = i - ti * 3, L = ti * G + c; if (L >= 256) return false;
        int pm, pn; tile_map(L, 64, 4, pm, pn);
        u.pm = pm; u.pn = pn; u.kind = n; u.half = 0; u.a = acts + ((long long)A_YSA + (long long)(n == 1) * ((long long)A_YSB - (long long)A_YSA) + (long long)(n == 2) * ((long long)A_POOLED - (long long)A_YSA)) + (size_t)pm * (256 * 512 * 2); u.b = wbr + (size_t)n * (1024 * 512 * 2) + (size_t)pn * (256 * 512 * 2); return true;
    }
};
struct SchedMoe {
    const char* A; const char* B; size_t a_tile, b_tile, b_exp; int MT, nN, G, c; int t1, t2, t3, t4, t5, t6, t7;
    int split_from = 1 << 30;
    __device__ __forceinline__ bool next(int i, Unit& u) const {
        int L = i * G + c, hf = 0;
        if (L >= split_from) { const int nl = MT * nN - split_from, j = L - split_from; if (j >= 2 * nl) return false; hf = 1 + j / nl; L = split_from + j % nl; }
        if (L >= MT * nN) return false;
        int pm, pn; tile_map(L, MT, nN, pm, pn);
        const int e = (pm >= t1) + (pm >= t2) + (pm >= t3) + (pm >= t4) + (pm >= t5) + (pm >= t6) + (pm >= t7);
        u.pm = pm; u.pn = pn; u.kind = e; u.half = hf; u.a = A + (size_t)pm * a_tile; u.b = B + (size_t)e * b_exp + (size_t)pn * b_tile; return true;
    }
};
}

#define XB_TMO      128
#define XB_XCNT(j)  (256  + 64 * (j))
#define XB_XSUB(j)  (1280 + 64 * (j))
#define XB_XGEN(j)  (2304 + 64 * (j))
#define XB_TOP      3328
#define XB_TOPGEN   3392
#define XCD_BAR_WORDS 3456
#define XB_SPIN_CAP (1u << 18)
__device__ __forceinline__ unsigned xb_ld(unsigned* p)              { return __hip_atomic_load(p, __ATOMIC_RELAXED, __HIP_MEMORY_SCOPE_AGENT); }
__device__ __forceinline__ unsigned xb_add(unsigned* p, unsigned v) { return __hip_atomic_fetch_add(p, v, __ATOMIC_RELAXED, __HIP_MEMORY_SCOPE_AGENT); }
__device__ __forceinline__ unsigned xb_xcc_id() { return (unsigned)__builtin_amdgcn_s_getreg((3 << 11) | 20) & 0xFu; }
#define XB_SPIN(cond, bar) do { unsigned _sp = 0; while (cond) { __builtin_amdgcn_s_sleep(1); \
    if ((++_sp & 255u) == 0u) { if (xb_ld(&(bar)[XB_TMO])) break; if (_sp > XB_SPIN_CAP) { atomicAdd(&(bar)[XB_TMO], 1u); break; } } } } while (0)
struct XcdBarrier { unsigned* bar; unsigned x; volatile LAS unsigned* st; };
__device__ __forceinline__ XcdBarrier xcd_barrier_post(unsigned* bar, volatile LAS unsigned* st) {
    XcdBarrier b; b.bar = bar; b.x = xb_xcc_id(); b.st = st;
    if (threadIdx.x == 0) (void)xb_add(&bar[XB_XCNT(b.x)], 1u);
    return b;
}
__device__ __forceinline__ void xcd_barrier_complete(unsigned* bar, unsigned x, unsigned& nloc, unsigned& nx) {
    const unsigned G = gridDim.x * gridDim.y * gridDim.z;
    unsigned sum, cnt, mine, sp = 0u;
    for (;;) {
        sum = 0u; cnt = 0u; mine = 0u;
#pragma unroll
        for (unsigned j = 0; j < 16; ++j) { const unsigned c = xb_ld(&bar[XB_XCNT(j)]); sum += c; cnt += (c > 0u) ? 1u : 0u; mine = (j == x) ? c : mine; }
        if (sum == G) break;
        __builtin_amdgcn_s_sleep(1);
        if ((++sp & 255u) == 0u) { if (xb_ld(&bar[XB_TMO])) break; if (sp > XB_SPIN_CAP) { atomicAdd(&bar[XB_TMO], 1u); break; } }
    }
    nloc = mine > 0u ? mine : 1u; nx = cnt > 0u ? cnt : 1u;
}
__device__ __forceinline__ void xcd_barrier(const XcdBarrier& b) {
    asm volatile("s_waitcnt vmcnt(0)" ::: "memory");
    __syncthreads();
    if (threadIdx.x == 0) {
        unsigned* bar = b.bar;
        __builtin_amdgcn_s_waitcnt(0);
        unsigned nloc = b.st[0], nx = b.st[1];
        if (nloc == 0u) { xcd_barrier_complete(bar, b.x, nloc, nx); b.st[0] = nloc; b.st[1] = nx; }
        const unsigned old = xb_add(&bar[XB_XSUB(b.x)], 1u);
        const unsigned gen = old / nloc;
        if (old + 1u == (gen + 1u) * nloc) {
            __builtin_amdgcn_fence(__ATOMIC_RELEASE, "agent");
            asm volatile("s_waitcnt vmcnt(0)" ::: "memory");
            const unsigned og = xb_add(&bar[XB_TOP], 1u);
            const unsigned tg = og / nx;
            if (og + 1u == (tg + 1u) * nx) xb_add(&bar[XB_TOPGEN], 1u);
            else XB_SPIN(xb_ld(&bar[XB_TOPGEN]) == tg, bar);
            __builtin_amdgcn_fence(__ATOMIC_ACQUIRE, "agent");
            xb_add(&bar[XB_XGEN(b.x)], 1u);
            asm volatile("s_waitcnt vmcnt(0)" ::: "memory");
        } else {
            XB_SPIN(xb_ld(&bar[XB_XGEN(b.x)]) == gen, bar);
            __builtin_amdgcn_fence(__ATOMIC_ACQUIRE, "agent");
            asm volatile("s_waitcnt vmcnt(0)" ::: "memory");
        }
    }
    __syncthreads();
}

struct Frame {
    LAS unsigned char* lds;
    volatile LAS unsigned* MISC;
    unsigned* ctl; float* ctlf; float* stats;
    unsigned char* ws;
    int tid, lane, wave, vcu, G;
    const CAS GPtr* inp;
    float* out;
    __device__ __forceinline__ const float* in(int i) const { return (const float*)inp[i]; }
};
enum { I_X = 0, I_POS, I_GMIX, I_WIN, I_GCQ, I_WUQ, I_GCKV, I_WUKV, I_GQKQ, I_GQKK, I_WGLA, I_BGLA, I_GGLAO, I_WPOOL, I_PSCALE, I_WBR, I_WOUT, I_GFFN, I_WFG, I_WFU, I_WFD, I_WROUTER, I_WEG, I_WEU, I_WED };

__device__ __forceinline__ bf16_t* act_ptr(const Frame& F, size_t off) { return (bf16_t*)(F.ws + WS_ACTS + off); }
__device__ __forceinline__ unsigned char* wblk(const Frame& F, int layer) { return F.ws + (layer == 0 ? WS_W0 : WS_W1); }

__device__ __forceinline__ void fill_rs(Frame& F, const float* rowss, int pm) {
    if (F.tid < 256) ((LAS float*)(F.lds + RS_OFF))[F.tid] = rsqrtf(sum16(rowss + ((size_t)pm * 256 + F.tid) * 16) * (1.f / 1024.f) + EPS);
    __syncthreads();
}
struct ConvSeg { const float* src; int ld, K, width, col0; bf16_t* dst; int row0, inter; const float* gain; };
typedef short v4i16c_t __attribute__((ext_vector_type(4)));
__device__ __forceinline__ int seg_items(const ConvSeg& s) { return (s.K >> 6) * ((s.width + 63) >> 6); }
__device__ __forceinline__ void conv_load(const ConvSeg& s, int item, int lane, f32x4 (&v)[16], float (&gv)[16]) {
    const int nblk = (s.width + 63) >> 6, kb = item / nblk, nb = item - kb * nblk, k0 = kb * 64, n0 = nb * 64;
    const int kq = lane >> 4, n4 = (lane & 15) * 4; const bool ok = n0 + n4 < s.width;
    const float* p = s.src + (size_t)(k0 + kq) * s.ld + s.col0 + n0 + n4;
#pragma unroll
    for (int i = 0; i < 16; ++i) v[i] = ok ? *(const f32x4*)(p + (size_t)(4 * i) * s.ld) : (f32x4){0.f, 0.f, 0.f, 0.f};
    const bool hg = s.gain != nullptr; const float* gp = hg ? s.gain + k0 + kq : s.src;
#pragma unroll
    for (int i = 0; i < 16; ++i) { const float g = gp[hg ? 4 * i : 0]; gv[i] = hg ? g : 1.f; }
}
__device__ __forceinline__ void conv_store(const ConvSeg& s, int item, LAS unsigned char* scr, int lane, const f32x4 (&v)[16], const float (&gv)[16]) {
    const int nblk = (s.width + 63) >> 6, kb = item / nblk, nb = item - kb * nblk, k0 = kb * 64, n0 = nb * 64;
    const int kq = lane >> 4, n4 = (lane & 15) * 4;
#pragma unroll
    for (int i = 0; i < 16; ++i) {
        const f32x4 x = v[i] * gv[i];
        *(LAS u32x2*)(scr + (4 * i + kq) * 136 + n4 * 2) = (u32x2){cvt_pk_bf16(x[0], x[1]), cvt_pk_bf16(x[2], x[3])};
    }
    LDS_WAIT();
    const int g = lane >> 4, i16 = lane & 15;
#pragma unroll
    for (int nb16 = 0; nb16 < 4; ++nb16)
#pragma unroll
        for (int kh = 0; kh < 2; ++kh) {
            const int c = kh * 4 + g;
            const LAS unsigned char* a = scr + (8 * c + (i16 >> 2)) * 136 + (nb16 * 16 + (i16 & 3) * 4) * 2;
            const v4i16c_t lo = __builtin_amdgcn_ds_read_tr16_b64_v4i16((LAS v4i16c_t*)a), hi = __builtin_amdgcn_ds_read_tr16_b64_v4i16((LAS v4i16c_t*)(a + 4 * 136));
            const int nq = n0 + nb16 * 16 + i16;
            if (nq < s.width) {
                const int drow = s.row0 + (s.inter ? ((nq >> 7) * 256 + (nq & 127)) : nq);
                typedef short s16x8_t __attribute__((ext_vector_type(8)));
                *(s16x8_t*)(s.dst + (size_t)drow * s.K + k0 + 8 * c) = (s16x8_t){lo[0], lo[1], lo[2], lo[3], hi[0], hi[1], hi[2], hi[3]};
            }
        }
    LDS_WAIT();
}
__device__ __forceinline__ ConvSeg mixer_seg(const Frame& F, int l, int idx) {
    unsigned char* wb = wblk(F, l);
    ConvSeg s; s.inter = 0; s.row0 = 0; s.col0 = 0;
    if (idx < 10) {
        int c0, wd, r0;
        switch (idx) {
            case 0: c0 = 0; wd = 256; r0 = 0; break;
            case 1: c0 = 256; wd = 256; r0 = 256; break;
            case 2: c0 = 544; wd = 256; r0 = 512; break;
            case 3: c0 = 800; wd = 256; r0 = 768; break;
            case 4: c0 = 1056; wd = 512; r0 = 1024; break;
            case 5: c0 = 1584; wd = 512; r0 = 1536; break;
            case 6: c0 = 2096; wd = 512; r0 = 2048; break;
            case 7: c0 = 512; wd = 32; r0 = 2560; break;
            case 8: c0 = 1568; wd = 16; r0 = 2592; break;
            default: c0 = 2608; wd = 3072; r0 = 0; break;
        }
        s.src = F.in(I_WIN) + (size_t)l * D * DIN; s.ld = DIN; s.K = D; s.width = wd; s.col0 = c0;
        s.dst = (bf16_t*)(wb + (idx == 9 ? WO_G : WO_IN)); s.row0 = r0; s.gain = F.in(I_GMIX) + l * D;
    } else if (idx == 10) { s.src = F.in(I_WUQ) + (size_t)l * 256 * 768; s.ld = 768; s.K = 256; s.width = 768; s.dst = (bf16_t*)(wb + WO_UP); s.gain = F.in(I_GCQ) + l * 256; }
    else if (idx == 11) { s.src = F.in(I_WUKV) + (size_t)l * 256 * 1024; s.ld = 1024; s.K = 256; s.width = 1024; s.dst = (bf16_t*)(wb + WO_UP); s.row0 = 768; s.gain = F.in(I_GCKV) + l * 256; }
    else if (idx < 14) { const int n = idx - 12; s.src = F.in(I_WBR) + (size_t)(l * 3 + n) * 512 * D; s.ld = D; s.K = 512; s.width = D; s.dst = (bf16_t*)(wb + WO_BR) + (size_t)n * 1024 * 512; s.gain = nullptr; }
    else { s.src = F.in(I_WOUT) + (size_t)l * D * D; s.ld = D; s.K = D; s.width = D; s.dst = (bf16_t*)(wb + WO_OUT); s.gain = nullptr; }
    return s;
}
__device__ __forceinline__ ConvSeg ffn_seg(const Frame& F, int idx) {
    unsigned char* wb = F.ws + WS_W0; ConvSeg s; s.col0 = 0; s.inter = 0; s.row0 = 0;
    if (idx < 2) { s.src = F.in(idx == 0 ? I_WFG : I_WFU); s.ld = DFF; s.K = D; s.width = DFF; s.dst = (bf16_t*)(wb + WO_FGU); s.row0 = idx * 128; s.inter = 1; s.gain = F.in(I_GFFN); }
    else { s.src = F.in(I_WFD); s.ld = D; s.K = DFF; s.width = D; s.dst = (bf16_t*)(wb + WO_FD); s.gain = nullptr; }
    return s;
}
__device__ __forceinline__ ConvSeg moe_seg(const Frame& F, int idx) {
    unsigned char* wb = F.ws + WS_W0; const int e = idx / 3, k = idx - e * 3; ConvSeg s; s.col0 = 0; s.inter = 0; s.row0 = 0;
    if (k < 2) { s.src = F.in(k == 0 ? I_WEG : I_WEU) + (size_t)e * D * DEXP; s.ld = DEXP; s.K = D; s.width = DEXP; s.dst = (bf16_t*)(wb + WO_MGU) + (size_t)e * 2816 * 1024; s.row0 = k * 128; s.inter = 1; s.gain = F.in(I_GFFN) + D; }
    else { s.src = F.in(I_WED) + (size_t)e * DEXP * D; s.ld = D; s.K = DEXP; s.width = D; s.dst = (bf16_t*)(wb + WO_MD) + (size_t)e * 1024 * 1408; s.gain = nullptr; }
    return s;
}
#define CONV_LOCATE(NSEG, GETSEG, IT, SEGOUT, IDXOUT) do { int r_ = (IT); for (int si_ = 0; si_ < (NSEG); ++si_) { const ConvSeg sg_ = GETSEG; const int n_ = seg_items(sg_); SEGOUT = sg_; IDXOUT = r_; if (r_ < n_) break; r_ -= n_; } } while (0)
#define CONV_LOOP(NSEG, GETSEG) do { int total_ = 0; for (int si_ = 0; si_ < (NSEG); ++si_) { const ConvSeg sg_ = GETSEG; total_ += seg_items(sg_); } \
        int it_ = gw; if (it_ < total_) { ConvSeg cs_; int ci_ = 0; f32x4 va_[16]; float ga_[16]; CONV_LOCATE(NSEG, GETSEG, it_, cs_, ci_); conv_load(cs_, ci_, F.lane, va_, ga_); \
        for (;;) { const int nx_ = it_ + NGW; const bool hn_ = nx_ < total_; ConvSeg ns_; int ni_ = 0; f32x4 vb_[16]; float gb_[16]; CONV_LOCATE(NSEG, GETSEG, (hn_ ? nx_ : it_), ns_, ni_); conv_load(ns_, ni_, F.lane, vb_, gb_); \
            _Pragma("unroll") for (int q_ = 0; q_ < 16; ++q_) { asm volatile("" : "+v"(va_[q_])); asm volatile("" : "+v"(ga_[q_])); } \
            conv_store(cs_, ci_, (LAS unsigned char*)scr, F.lane, va_, ga_); if (!hn_) break; \
            _Pragma("unroll") for (int q_ = 0; q_ < 16; ++q_) { va_[q_] = vb_[q_]; ga_[q_] = gb_[q_]; } cs_ = ns_; ci_ = ni_; it_ = nx_; } } } while (0)
__device__ __forceinline__ void fold_pool(const Frame& F, int l, int gw, int NGW) {
    const float* wp = F.in(I_WPOOL) + (size_t)l * 4 * 128 * 128; const float* ps = F.in(I_PSCALE) + l * 512; const float* wb2 = F.in(I_WBR) + (size_t)(l * 3 + 2) * 512 * D;
    bf16_t* dst = (bf16_t*)(wblk(F, l) + WO_BR) + (size_t)2 * 1024 * 512;
    for (int it = gw; it < 1024; it += NGW) {
        const int db = it & 15, g = (it >> 4) & 3, cb = it >> 6, d = db * 64 + F.lane, c0 = cb * 8;
        float a[8];
#pragma unroll
        for (int i = 0; i < 8; ++i) a[i] = 0.f;
        for (int j = 0; j < 128; ++j) {
            const float w = wb2[(size_t)(g * 128 + j) * D + d] * ps[g * 128 + j];
#pragma unroll
            for (int i = 0; i < 8; ++i) a[i] = fmaf(wp[(size_t)(g * 128 + c0 + i) * 128 + j], w, a[i]);
        }
        u32x4 o; o.x = cvt_pk_bf16(a[0], a[1]); o.y = cvt_pk_bf16(a[2], a[3]); o.z = cvt_pk_bf16(a[4], a[5]); o.w = cvt_pk_bf16(a[6], a[7]);
        *(u32x4*)(dst + (size_t)d * 512 + g * 128 + c0) = o;
    }
}

__device__ __forceinline__ void p0_prologue(Frame& F) {
    LAS float* scr = (LAS float*)(F.lds + F.wave * 16384);
    const int gw = F.vcu * 8 + F.wave, NGW = F.G * 8;
    { bf16_t* xb = (bf16_t*)(F.ws + WS_XB); float* rss = F.stats + SF_ROWSS;
      for (int m0 = gw; m0 < T; m0 += 4 * NGW) {
          f32x4 v[4][4];
#pragma unroll
          for (int r = 0; r < 4; ++r) { const int m = m0 + r * NGW < T ? m0 + r * NGW : m0; const f32x4* xr = (const f32x4*)(F.in(I_X) + (size_t)m * D) + F.lane;
#pragma unroll
              for (int j = 0; j < 4; ++j) v[r][j] = xr[64 * j]; }
#pragma unroll
          for (int r = 0; r < 4; ++r)
#pragma unroll
              for (int j = 0; j < 4; ++j) asm volatile("" : "+v"(v[r][j]));
#pragma unroll
          for (int r = 0; r < 4; ++r) { const int m = m0 + r * NGW; if (m >= T) break; float s = 0.f;
              unsigned long long* o8 = (unsigned long long*)(xb + (size_t)m * D) + F.lane;
#pragma unroll
              for (int j = 0; j < 4; ++j) { const f32x4 w = v[r][j]; s += (w[0] * w[0] + w[1] * w[1]) + (w[2] * w[2] + w[3] * w[3]);
                  o8[64 * j] = (unsigned long long)cvt_pk_bf16(w[0], w[1]) | ((unsigned long long)cvt_pk_bf16(w[2], w[3]) << 32); }
              s = wave_sum(s); if (F.lane < 16) rss[(size_t)m * 16 + F.lane] = (F.lane == 0) ? s : 0.f; }
      } }
    { float* rt = (float*)(F.ws + WS_ROPE); const int* pos = (const int*)F.in(I_POS);
      for (int i = F.vcu * 512 + F.tid; i < T * 16; i += F.G * 512) {
          const int t = i >> 4, k = i & 15; const float inv = powf(10000.f, -(float)k / 16.f), ang = (float)pos[t] * inv;
          rt[t * 32 + k] = cosf(ang); rt[t * 32 + 16 + k] = sinf(ang);
      } }
    CONV_LOOP(15, mixer_seg(F, 0, si_));
    fold_pool(F, 0, gw, NGW);
}

__device__ __forceinline__ void gla_prep(Frame& F, int l, int unit);
__device__ __forceinline__ void phase_prep(Frame& F, int l, int rpt = 0) {
    const bf16_t* raw = act_ptr(F, A_QKVRAW); const bf16_t* misc = act_ptr(F, A_MISC);
    bf16_t* QH = act_ptr(F, A_QH); bf16_t* KH = act_ptr(F, A_KH); bf16_t* VT = act_ptr(F, A_VT);
    const float* rope = (const float*)(F.ws + WS_ROPE);
    const float* gq = F.in(I_GQKQ) + l * 96; const float* gk = F.in(I_GQKK) + l * 96;
    LAS bf16_t* vt = (LAS bf16_t*)F.lds;
    for (int unit = F.vcu; unit < T / 64; unit += F.G) {
        const int t0 = unit * 64, b = t0 / SEQ, s0 = t0 % SEQ;
        if (!rpt) gla_prep(F, l, unit);
#pragma unroll 1
        for (int it = F.tid; it < 1024; it += 512) {
            const int which = it & 1, h = (it >> 1) & 7, tok = it >> 4, t = t0 + tok;
            const bf16_t* nope = raw + (size_t)t * 1792 + (which ? 768 + h * 128 : h * 96);
            const bf16_t* rp = which ? misc + (size_t)t * 256 : nope + 64;
            const float* g = which ? gk : gq;
            u32x4 c[12];
#pragma unroll
            for (int i = 0; i < 8; ++i) c[i] = *(const u32x4*)(nope + 8 * i);
#pragma unroll
            for (int i = 0; i < 4; ++i) c[8 + i] = *(const u32x4*)(rp + 8 * i);
            float ss = 0.f;
#pragma unroll
            for (int i = 0; i < 12; ++i) {
                const float a0 = bflo(c[i].x), a1 = bfhi(c[i].x), a2 = bflo(c[i].y), a3 = bfhi(c[i].y), a4 = bflo(c[i].z), a5 = bfhi(c[i].z), a6 = bflo(c[i].w), a7 = bfhi(c[i].w);
                ss += (a0 * a0 + a1 * a1) + (a2 * a2 + a3 * a3) + (a4 * a4 + a5 * a5) + (a6 * a6 + a7 * a7);
            }
            float r = rsqrtf(ss * (1.f / 96.f) + EPS);
            if (!which) r *= 0.14724444f;
            bf16_t* dst = (which ? KH : QH) + ((size_t)(b * 8 + h) * SEQ + s0 + tok) * 96;
#pragma unroll
            for (int i = 0; i < 8; ++i) {
                const f32x4 g0 = *(const f32x4*)(g + 8 * i), g1 = *(const f32x4*)(g + 8 * i + 4);
                u32x4 o; o.x = cvt_pk_bf16(bflo(c[i].x) * r * g0[0], bfhi(c[i].x) * r * g0[1]); o.y = cvt_pk_bf16(bflo(c[i].y) * r * g0[2], bfhi(c[i].y) * r * g0[3]);
                o.z = cvt_pk_bf16(bflo(c[i].z) * r * g1[0], bfhi(c[i].z) * r * g1[1]); o.w = cvt_pk_bf16(bflo(c[i].w) * r * g1[2], bfhi(c[i].w) * r * g1[3]);
                *(u32x4*)(dst + 8 * i) = o;
            }
#pragma unroll
            for (int hh = 0; hh < 2; ++hh) {
                const u32x4 x1c = c[8 + hh], x2c = c[10 + hh];
                float x1[8] = {bflo(x1c.x), bfhi(x1c.x), bflo(x1c.y), bfhi(x1c.y), bflo(x1c.z), bfhi(x1c.z), bflo(x1c.w), bfhi(x1c.w)};
                float x2[8] = {bflo(x2c.x), bfhi(x2c.x), bflo(x2c.y), bfhi(x2c.y), bflo(x2c.z), bfhi(x2c.z), bflo(x2c.w), bfhi(x2c.w)};
                float o1[8], o2[8];
#pragma unroll
                for (int i = 0; i < 8; ++i) {
                    const int k = hh * 8 + i; const float cs = rope[(size_t)t * 32 + k], sn = rope[(size_t)t * 32 + 16 + k];
                    const float a = x1[i] * r * g[64 + k], bb = x2[i] * r * g[80 + k];
                    o1[i] = a * cs - bb * sn; o2[i] = bb * cs + a * sn;
                }
                u32x4 w1, w2; w1.x = cvt_pk_bf16(o1[0], o1[1]); w1.y = cvt_pk_bf16(o1[2], o1[3]); w1.z = cvt_pk_bf16(o1[4], o1[5]); w1.w = cvt_pk_bf16(o1[6], o1[7]);
                w2.x = cvt_pk_bf16(o2[0], o2[1]); w2.y = cvt_pk_bf16(o2[2], o2[3]); w2.z = cvt_pk_bf16(o2[4], o2[5]); w2.w = cvt_pk_bf16(o2[6], o2[7]);
                *(u32x4*)(dst + 64 + hh * 8) = w1; *(u32x4*)(dst + 80 + hh * 8) = w2;
            }
        }
        {
            const int tok = F.tid >> 3, cc = F.tid & 7;
            u32x4 vr[8];
#pragma unroll
            for (int h = 0; h < 8; ++h) vr[h] = *(const u32x4*)(raw + (size_t)(t0 + tok) * 1792 + 768 + h * 128 + 64 + cc * 8);
#pragma unroll
            for (int h = 0; h < 8; ++h) *(LAS u32x4*)(F.lds + h * 9216 + tok * 144 + cc * 16) = vr[h];
            __syncthreads();
            const int db = F.wave & 3, c = (F.wave >> 2) * 4 + (F.lane >> 4), i16 = F.lane & 15;
#pragma unroll
            for (int h = 0; h < 8; ++h) {
                const LAS unsigned char* a = F.lds + h * 9216 + (8 * c + (i16 >> 2)) * 144 + (16 * db + (i16 & 3) * 4) * 2;
                const v4i16c_t lo = __builtin_amdgcn_ds_read_tr16_b64_v4i16((LAS v4i16c_t*)a), hi = __builtin_amdgcn_ds_read_tr16_b64_v4i16((LAS v4i16c_t*)(a + 4 * 144));
                typedef short s16x8_t __attribute__((ext_vector_type(8)));
                bf16_t* vrow = VT + (((size_t)(b * 8 + h) * (SEQ / 64) + (s0 >> 6)) * 64 + 16 * db + i16) * 64;
                *(v4i16c_t*)(vrow + 4 * c) = lo; *(v4i16c_t*)(vrow + 32 + 4 * c) = hi;
            }
            __syncthreads();
        }
    }
}

constexpr int AT_KROW = 208, AT_KT = 64 * AT_KROW, AT_VROW = 144, AT_VTB = 64 * AT_VROW, AT_SLOT = AT_KT + AT_VTB, AT_NSLOT = 5, AT_DUMMY = AT_NSLOT * AT_SLOT;
static_assert(AT_KT == 13 * 1024 && AT_VTB == 9 * 1024 && AT_DUMMY + 8 * 1024 <= RING_BYTES, "attention ring");
#ifdef AT_TPROBE
#define TP_B(k) do { if (AT_TPROBE == (k)) tp0 = __builtin_readcyclecounter(); } while (0)
#define TP_E(k) do { if (AT_TPROBE == (k)) tpacc += __builtin_readcyclecounter() - tp0; } while (0)
#else
#define TP_B(k) do {} while (0)
#define TP_E(k) do {} while (0)
#endif
__device__ __forceinline__ void attn_unit(Frame& F, int bh, int qb, unsigned long long& tpacc) {
#ifdef AT_TPROBE
    unsigned long long tp0 = 0;
#endif
    TP_B(0);
    const int lane = F.lane, wid = F.wave, r32 = lane & 31, hi = lane >> 5, grp = wid >> 2;
    const bf16_t* QHp = act_ptr(F, A_QH) + ((size_t)bh * SEQ + qb * 256 + wid * 32) * 96;
    const char* Kb = (const char*)(act_ptr(F, A_KH) + (size_t)bh * SEQ * 96);
    const char* Vb = (const char*)(act_ptr(F, A_VT) + (size_t)bh * 64 * SEQ);
    LAS unsigned char* lds = F.lds;
    bf16x8 qr[6];
#pragma unroll
    for (int s = 0; s < 6; ++s) qr[s] = *(const bf16x8*)(QHp + (size_t)r32 * 96 + 16 * s + 8 * hi);
    const int NT = 4 * (qb + 1);
    const char *dp0, *dp1, *dp2;
    { const int P = 64 * wid + lane, row = P / 13, col = P % 13; dp0 = Kb + row * 192 + (col == 12 ? 0 : col) * 16; }
    if (wid < 5) { const int P = 64 * (wid + 8) + lane, row = P / 13, col = P % 13; dp1 = Kb + row * 192 + (col == 12 ? 0 : col) * 16; }
    else { const int P = 64 * (wid - 5) + lane, d = P / 9, col = P % 9; dp1 = Vb + d * 128 + (col == 8 ? 0 : col) * 16; }
    { const int P = 64 * (wid + 3) + lane, d = (P / 9) & 63, col = P % 9; dp2 = Vb + d * 128 + (col == 8 ? 0 : col) * 16; }
    const unsigned st1 = wid < 5 ? 12288u : 8192u;
    const bool w3 = wid < 6;
#define AT_DMA_ONE(j, sl) do { const int sl_ = (sl); LAS unsigned char* d_ = lds + sl_ + wid * 1024; const int c1_ = sl_ == AT_DUMMY ? 0 : 8192; \
        __builtin_amdgcn_global_load_lds((const unsigned*)(dp0 + (size_t)(j) * 12288), (LAS unsigned*)d_, 16, 0, 0); \
        __builtin_amdgcn_global_load_lds((const unsigned*)(dp1 + (size_t)(j) * st1), (LAS unsigned*)(d_ + c1_), 16, 0, 0); \
        if (w3) __builtin_amdgcn_global_load_lds((const unsigned*)(dp2 + (size_t)(j) * 8192), (LAS unsigned*)(d_ + 2 * c1_), 16, 0, 0); } while (0)
#ifdef AT_PROBE_DMA2
#define AT_DMA(j, sl) do { AT_DMA_ONE(j, sl); AT_DMA_ONE(j, sl); } while (0)
#define AT_WAIT2() do { if (w3) asm volatile("s_waitcnt vmcnt(12)" ::: "memory"); else asm volatile("s_waitcnt vmcnt(8)" ::: "memory"); } while (0)
#else
#define AT_DMA(j, sl) AT_DMA_ONE(j, sl)
#define AT_WAIT2() do { if (w3) asm volatile("s_waitcnt vmcnt(6)" ::: "memory"); else asm volatile("s_waitcnt vmcnt(4)" ::: "memory"); } while (0)
#endif
#define AT_WAIT1() do { if (w3) asm volatile("s_waitcnt vmcnt(3)" ::: "memory"); else asm volatile("s_waitcnt vmcnt(2)" ::: "memory"); } while (0)
#define AT_WAIT_NEXT(t) do { if ((t) + 3 < NT) AT_WAIT2(); else if ((t) + 3 == NT) AT_WAIT1(); else VM_WAIT(); } while (0)
    AT_DMA(0, 0); AT_DMA(1, AT_SLOT); AT_DMA(2, 2 * AT_SLOT); AT_DMA(3, 3 * AT_SLOT);
#ifdef AT_PROBE_DMA2
    if (w3) asm volatile("s_waitcnt vmcnt(18)" ::: "memory"); else asm volatile("s_waitcnt vmcnt(12)" ::: "memory");
#else
    if (w3) asm volatile("s_waitcnt vmcnt(9)" ::: "memory"); else asm volatile("s_waitcnt vmcnt(6)" ::: "memory");
#endif
    LDS_BARRIER();
    float m_run = 0.f, l_run = 0.f;
    f32x16 o0, o1, negm;
#pragma unroll
    for (int r = 0; r < 16; ++r) { o0[r] = 0.f; o1[r] = 0.f; negm[r] = 0.f; }
    const unsigned kfr = (unsigned)(r32 * AT_KROW + hi * 16), vfr = (unsigned)(AT_KT + r32 * AT_VROW + hi * 64);
    if (grp) LDS_BARRIER();
    int slot = 0, wslot = 4;
    const int NTw = 4 * qb + (wid >> 1) + 1;
    TP_B(1);
    for (int t = 0; t < NTw; ++t) {
        const int jb = t - 4 * qb;
        const LAS unsigned char* sb = lds + slot * AT_SLOT;
        f32x16 p0, p1;
        TP_B(2);
        {
            const LAS unsigned char* kb = sb + kfr;
            bf16x8 ka[6], kc[6];
#pragma unroll
            for (int s = 0; s < 6; ++s) { ka[s] = *(const LAS bf16x8*)(kb + s * 32); kc[s] = *(const LAS bf16x8*)(kb + 32 * AT_KROW + s * 32); }
            __builtin_amdgcn_sched_barrier(0);
            __builtin_amdgcn_s_setprio(1);
            p0 = __builtin_amdgcn_mfma_f32_32x32x16_bf16(ka[0], qr[0], negm, 0, 0, 0);
            p1 = __builtin_amdgcn_mfma_f32_32x32x16_bf16(kc[0], qr[0], negm, 0, 0, 0);
#pragma unroll
            for (int s = 1; s < 6; ++s) {
                p0 = __builtin_amdgcn_mfma_f32_32x32x16_bf16(ka[s], qr[s], p0, 0, 0, 0);
                p1 = __builtin_amdgcn_mfma_f32_32x32x16_bf16(kc[s], qr[s], p1, 0, 0, 0);
            }
            __builtin_amdgcn_s_setprio(0);
#ifdef AT_PROBE_SEG1X2
            asm volatile("" : "+v"(p0), "+v"(p1));
            p0 = __builtin_amdgcn_mfma_f32_32x32x16_bf16(ka[0], qr[0], negm, 0, 0, 0);
            p1 = __builtin_amdgcn_mfma_f32_32x32x16_bf16(kc[0], qr[0], negm, 0, 0, 0);
#pragma unroll
            for (int s = 1; s < 6; ++s) {
                p0 = __builtin_amdgcn_mfma_f32_32x32x16_bf16(ka[s], qr[s], p0, 0, 0, 0);
                p1 = __builtin_amdgcn_mfma_f32_32x32x16_bf16(kc[s], qr[s], p1, 0, 0, 0);
            }
#endif
            asm volatile("" : "+v"(p0), "+v"(p1));
        }
        TP_E(2);
        TP_B(3);
        AT_WAIT2();
        TP_E(3);
        TP_B(4);
        LDS_BARRIER();
        TP_E(4);
        AT_DMA(min(t + 4, NT - 1), t + 4 < NT ? wslot * AT_SLOT : AT_DUMMY);
        TP_B(5);
        {
            const LAS unsigned char* vb = sb + vfr;
            bf16x8 va[4], vc2[4];
#pragma unroll
            for (int s = 0; s < 4; ++s) { va[s] = *(const LAS bf16x8*)(vb + s * 16); vc2[s] = *(const LAS bf16x8*)(vb + 32 * AT_VROW + s * 16); }
            if (jb >= 0 && wid < 2 * jb + 2) {
                const int qrel = 32 * wid + r32, kb0 = 64 * jb + 4 * hi;
#pragma unroll
                for (int r = 0; r < 16; ++r) { const int kv = kb0 + (r & 3) + 8 * (r >> 2); if (kv > qrel) p0[r] = -INFINITY; if (kv + 32 > qrel) p1[r] = -INFINITY; }
            }
            float mxa = __builtin_elementwise_maximum(p0[0], p0[1]), mxb = __builtin_elementwise_maximum(p1[0], p1[1]);
#pragma unroll
            for (int r = 2; r < 16; r += 2) {
                mxa = __builtin_elementwise_maximum(__builtin_elementwise_maximum(mxa, p0[r]), p0[r + 1]);
                mxb = __builtin_elementwise_maximum(__builtin_elementwise_maximum(mxb, p1[r]), p1[r + 1]);
            }
            float mx = __builtin_elementwise_maximum(mxa, mxb);
            {
                const u32x2 sw = __builtin_amdgcn_permlane32_swap(__float_as_uint(mx), __float_as_uint(mx), false, false);
                mx = __builtin_elementwise_maximum(__uint_as_float(sw.x), __uint_as_float(sw.y));
            }
            if (t == 0 || !__all(mx <= 8.f)) {
                const float delta = t == 0 ? mx : fmaxf(mx, 0.f), alpha = t == 0 ? 1.f : __builtin_amdgcn_exp2f(-delta);
                m_run += delta; l_run *= alpha;
#pragma unroll
                for (int r = 0; r < 16; ++r) { o0[r] *= alpha; o1[r] *= alpha; p0[r] -= delta; p1[r] -= delta; negm[r] = -m_run; }
            }
            float ps = 0.f;
#pragma unroll
            for (int r = 0; r < 16; ++r) { p0[r] = __builtin_amdgcn_exp2f(p0[r]); p1[r] = __builtin_amdgcn_exp2f(p1[r]); ps += p0[r]; ps += p1[r]; }
            l_run += ps;
#pragma unroll
            for (int s = 0; s < 4; ++s) {
                u32x4 pw;
                if (s < 2) { pw.x = cvt_pk_bf16(p0[8 * s + 0], p0[8 * s + 1]); pw.y = cvt_pk_bf16(p0[8 * s + 2], p0[8 * s + 3]); pw.z = cvt_pk_bf16(p0[8 * s + 4], p0[8 * s + 5]); pw.w = cvt_pk_bf16(p0[8 * s + 6], p0[8 * s + 7]); }
                else { const int q = s - 2; pw.x = cvt_pk_bf16(p1[8 * q + 0], p1[8 * q + 1]); pw.y = cvt_pk_bf16(p1[8 * q + 2], p1[8 * q + 3]); pw.z = cvt_pk_bf16(p1[8 * q + 4], p1[8 * q + 5]); pw.w = cvt_pk_bf16(p1[8 * q + 6], p1[8 * q + 7]); }
                const bf16x8 pb = __builtin_bit_cast(bf16x8, pw);
                o0 = __builtin_amdgcn_mfma_f32_32x32x16_bf16(va[s], pb, o0, 0, 0, 0);
                o1 = __builtin_amdgcn_mfma_f32_32x32x16_bf16(vc2[s], pb, o1, 0, 0, 0);
            }
        }
        TP_E(5);
        TP_B(6);
        LDS_BARRIER();
        TP_E(6);
        slot = slot == AT_NSLOT - 1 ? 0 : slot + 1; wslot = wslot == AT_NSLOT - 1 ? 0 : wslot + 1;
    }
    TP_E(1);
    for (int t = NTw; t < NT; ++t) {
        AT_WAIT2();
        LDS_BARRIER();
        AT_DMA(min(t + 4, NT - 1), t + 4 < NT ? wslot * AT_SLOT : AT_DUMMY);
        LDS_BARRIER();
        wslot = wslot == AT_NSLOT - 1 ? 0 : wslot + 1;
    }
    if (!grp) LDS_BARRIER();
    VM_WAIT();
#undef AT_DMA
#undef AT_DMA_ONE
#undef AT_WAIT2
#undef AT_WAIT1
#undef AT_WAIT_NEXT
    l_run += __shfl_xor(l_run, 32);
    const float inv = 1.f / l_run;
    const int b = bh >> 3, h = bh & 7;
    bf16_t* orow = act_ptr(F, A_YSA) + ((size_t)b * SEQ + qb * 256 + wid * 32 + r32) * 512 + h * 64;
#pragma unroll
    for (int g = 0; g < 4; ++g) {
        u32x2 w0, w1;
        w0.x = cvt_pk_bf16(o0[4 * g] * inv, o0[4 * g + 1] * inv); w0.y = cvt_pk_bf16(o0[4 * g + 2] * inv, o0[4 * g + 3] * inv);
        w1.x = cvt_pk_bf16(o1[4 * g] * inv, o1[4 * g + 1] * inv); w1.y = cvt_pk_bf16(o1[4 * g + 2] * inv, o1[4 * g + 3] * inv);
#ifdef AT_WT_STORE
        asm volatile("global_store_dwordx2 %0, %1, off sc0 sc1" :: "v"(orow + 8 * g + 4 * hi), "v"(w0) : "memory");
        asm volatile("global_store_dwordx2 %0, %1, off sc0 sc1" :: "v"(orow + 32 + 8 * g + 4 * hi), "v"(w1) : "memory");
#else
        *(u32x2*)(orow + 8 * g + 4 * hi) = w0; *(u32x2*)(orow + 32 + 8 * g + 4 * hi) = w1;
#endif
    }
    TP_E(0);
}

__device__ __forceinline__ float row16_sum(float x) {
    x += __int_as_float(__builtin_amdgcn_update_dpp(0, __float_as_int(x), 0x128, 0xf, 0xf, false));
    x += __int_as_float(__builtin_amdgcn_update_dpp(0, __float_as_int(x), 0x124, 0xf, 0xf, false));
    x += __int_as_float(__builtin_amdgcn_update_dpp(0, __float_as_int(x), 0x122, 0xf, 0xf, false));
    x += __int_as_float(__builtin_amdgcn_update_dpp(0, __float_as_int(x), 0x121, 0xf, 0xf, false));
    return x;
}
__device__ __forceinline__ unsigned short f2bf1(float x) { return (unsigned short)(cvt_pk_bf16(x, 0.f) & 0xffffu); }
__device__ __forceinline__ void gla_prep(Frame& F, int l, int unit) {
    bf16_t* gqkv = act_ptr(F, A_GQKV); const bf16_t* misc = act_ptr(F, A_MISC); float* eb = F.stats + SF_EB;
    const int c = F.tid & 255, ch = unit * 2 + (F.tid >> 8);
    const float* wg = F.in(I_WGLA) + (size_t)l * 16 * 256 + c; const float bias = F.in(I_BGLA)[l * 256 + c];
    float wcol[16];
#pragma unroll
    for (int r = 0; r < 16; ++r) wcol[r] = wg[r * 256];
    float bc = 0.f;
#pragma unroll 1
    for (int i0 = 0; i0 < 32; i0 += 8) {
        u32x4 l0[8], l1[8]; unsigned qv[8], kv[8];
#pragma unroll
        for (int i = 0; i < 8; ++i) {
            const size_t t = (size_t)ch * 32 + i0 + i;
            l0[i] = *(const u32x4*)(misc + t * 256 + 32); l1[i] = *(const u32x4*)(misc + t * 256 + 40);
            qv[i] = *(const unsigned short*)(gqkv + t * 1024 + c); kv[i] = *(const unsigned short*)(gqkv + t * 1024 + c + 256);
        }
#pragma unroll
        for (int i = 0; i < 8; ++i) asm volatile("" : "+v"(qv[i]), "+v"(kv[i]));
        unsigned short qo[8], ko[8];
#pragma unroll
        for (int i = 0; i < 8; ++i) {
            const float lr[16] = {bflo(l0[i].x), bfhi(l0[i].x), bflo(l0[i].y), bfhi(l0[i].y), bflo(l0[i].z), bfhi(l0[i].z), bflo(l0[i].w), bfhi(l0[i].w),
                                  bflo(l1[i].x), bfhi(l1[i].x), bflo(l1[i].y), bfhi(l1[i].y), bflo(l1[i].z), bfhi(l1[i].z), bflo(l1[i].w), bfhi(l1[i].w)};
            float z = bias;
#pragma unroll
            for (int r = 0; r < 16; ++r) z = fmaf(lr[r], wcol[r], z);
            const float zl = z * 1.4426950408889634f;
            const float sp = fmaxf(-zl, 0.f) + __log2f(1.f + __builtin_amdgcn_exp2f(-fabsf(zl)));
            bc -= sp * 0.0625f;
            const float eq = __builtin_amdgcn_exp2f(bc) * 0.125f, ek = __builtin_amdgcn_exp2f(-bc);
            qo[i] = f2bf1(__uint_as_float(qv[i] << 16) * eq);
            ko[i] = f2bf1(__uint_as_float(kv[i] << 16) * ek);
        }
#pragma unroll
        for (int i = 0; i < 8; ++i) {
            const size_t t = (size_t)ch * 32 + i0 + i;
            *(unsigned short*)(gqkv + t * 1024 + c) = qo[i]; *(unsigned short*)(gqkv + t * 1024 + c + 256) = ko[i];
        }
    }
    eb[(size_t)ch * 256 + c] = __builtin_amdgcn_exp2f(bc);
}
typedef short v4i16_t __attribute__((ext_vector_type(4)));
__device__ __forceinline__ v4i16_t lds_tr16(const LAS unsigned char* p) { return __builtin_amdgcn_ds_read_tr16_b64_v4i16((LAS v4i16_t*)p); }
constexpr int GW_K = 0, GW_Q = 4608, GW_V = 9216, GW_BYTES = 10240;
__device__ __forceinline__ void gla_unit(Frame& F, int l, int unit) {
    const int half = unit & 1, h = (unit >> 1) & 3, b = unit >> 3;
    volatile LAS int* prog = (volatile LAS int*)(F.lds + 4 * GW_BYTES);
    if (F.wave >= 4) {
        const int pw = F.wave - 4, tok = F.lane & 31, li = (F.lane >> 5) + 2 * (pw & 1);
        const size_t lo_ = (li == 0) ? (size_t)h * 128 : (li == 1) ? (size_t)512 + h * 128 : (li == 2) ? (size_t)1024 + h * 256 + half * 128 : (size_t)1024 + h * 256 + half * 128 + 64;
        const unsigned char* base_ = (const unsigned char*)act_ptr(F, A_GQKV) + lo_;
        unsigned keep = 0u;
        for (int m = (pw >> 1); m < SEQ / 32; m += 2) {
            while (m > prog[0] + 8) __builtin_amdgcn_s_sleep(8);
            const unsigned char* pp = base_ + ((size_t)b * SEQ + (size_t)m * 32 + tok) * 2048;
            asm volatile("global_load_dword %0, %1, off" : "+v"(keep) : "v"(pp) : "memory");
        }
        asm volatile("s_waitcnt vmcnt(0)" : "+v"(keep) :: "memory");
        return;
    }
    const int lane = F.lane, w = half * 4 + F.wave, l15 = lane & 15, q4 = lane >> 4;
    const bf16_t* gqkv = act_ptr(F, A_GQKV); const float* ebg = F.stats + SF_EB;
    bf16_t* ysb = act_ptr(F, A_YSB);
    LAS unsigned char* wl = F.lds + F.wave * GW_BYTES;
    f32x4 S[4];
#pragma unroll
    for (int i = 0; i < 4; ++i) S[i] = (f32x4){0.f, 0.f, 0.f, 0.f};
    if (F.tid == 0) prog[0] = 0;
    constexpr int GW2 = 4 * GW_BYTES;
    u32x4 kimgX[4], qimgX[4], vimgX, kimgY[4], qimgY[4], vimgY; f32x4 ebvX[4], ebvY[4];
#define GLA_LOAD1(n_, KI, QI, VI, EBV) do { const size_t tb_ = (size_t)b * SEQ + (size_t)(n_) * 32; \
        _Pragma("unroll") for (int i = 0; i < 4; ++i) { const int p_ = lane + 64 * i; const bf16_t* r_ = gqkv + (tb_ + (p_ >> 3)) * 1024 + h * 64 + (p_ & 7) * 8; QI[i] = *(const u32x4*)r_; KI[i] = *(const u32x4*)(r_ + 256); } \
        VI = *(const u32x4*)(gqkv + (tb_ + (lane >> 1)) * 1024 + 512 + h * 128 + 16 * w + (lane & 1) * 8); \
        _Pragma("unroll") for (int db = 0; db < 4; ++db) EBV[db] = *(const f32x4*)(ebg + (tb_ >> 5) * 256 + h * 64 + 16 * db + 4 * q4); } while (0)
#define GLA_LOAD(n_) do { GLA_LOAD1((n_), kimgX, qimgX, vimgX, ebvX); GLA_LOAD1((n_) + 1, kimgY, qimgY, vimgY, ebvY); } while (0)
    bf16x8 pa0X, pa1X, vbnX, kanX[4], qpxX[2], qpyX[2], pa0Y, pa1Y, vbnY, kanY[4], qpxY[2], qpyY[2]; f32x4 o0pX, o1pX, e4X[4], o0pY, o1pY, e4Y[4];
#define GLA_IMG(WL, KI, QI, VI, EBV, E4) do { \
        _Pragma("unroll") for (int i = 0; i < 4; ++i) { asm volatile("" : "+v"(KI[i]), "+v"(QI[i]), "+v"(EBV[i])); } \
        asm volatile("" : "+v"(VI)); \
        _Pragma("unroll") for (int i = 0; i < 4; ++i) { const int p_ = lane + 64 * i; *(LAS u32x4*)((WL) + GW_K + (p_ >> 3) * 144 + (p_ & 7) * 16) = KI[i]; *(LAS u32x4*)((WL) + GW_Q + (p_ >> 3) * 144 + (p_ & 7) * 16) = QI[i]; } \
        *(LAS u32x4*)((WL) + GW_V + (lane >> 1) * 32 + (lane & 1) * 16) = VI; \
        _Pragma("unroll") for (int db = 0; db < 4; ++db) E4[db] = EBV[db]; } while (0)
#define GLA_STAGE_P(WL, PA0, PA1, VBN, KAN, QPX, QPY, O0P, O1P) do { \
        f32x4 pt00 = {0.f, 0.f, 0.f, 0.f}, pt01 = pt00, pt11 = pt00; \
        _Pragma("unroll") for (int ks = 0; ks < 2; ++ks) { \
            const bf16x8 a0 = *(const LAS bf16x8*)((WL) + GW_K + l15 * 144 + ks * 64 + q4 * 16), a1 = *(const LAS bf16x8*)((WL) + GW_K + (16 + l15) * 144 + ks * 64 + q4 * 16); \
            const bf16x8 b0 = *(const LAS bf16x8*)((WL) + GW_Q + l15 * 144 + ks * 64 + q4 * 16), b1 = *(const LAS bf16x8*)((WL) + GW_Q + (16 + l15) * 144 + ks * 64 + q4 * 16); \
            pt00 = __builtin_amdgcn_mfma_f32_16x16x32_bf16(a0, b0, pt00, 0, 0, 0); \
            pt01 = __builtin_amdgcn_mfma_f32_16x16x32_bf16(a0, b1, pt01, 0, 0, 0); \
            pt11 = __builtin_amdgcn_mfma_f32_16x16x32_bf16(a1, b1, pt11, 0, 0, 0); \
            const LAS unsigned char* q0p = (WL) + GW_Q + l15 * 144 + ks * 64 + q4 * 8; const LAS unsigned char* q1p = q0p + 16 * 144; \
            const u32x2 x0 = *(const LAS u32x2*)(q0p), x1 = *(const LAS u32x2*)(q0p + 32), y0 = *(const LAS u32x2*)(q1p), y1 = *(const LAS u32x2*)(q1p + 32); \
            QPX[ks] = __builtin_bit_cast(bf16x8, (u32x4){x0.x, x0.y, x1.x, x1.y}); QPY[ks] = __builtin_bit_cast(bf16x8, (u32x4){y0.x, y0.y, y1.x, y1.y}); } \
        _Pragma("unroll") for (int r = 0; r < 4; ++r) { if (4 * q4 + r > l15) { pt00[r] = 0.f; pt11[r] = 0.f; } } \
        PA0 = __builtin_bit_cast(bf16x8, (u32x4){cvt_pk_bf16(pt00[0], pt00[1]), cvt_pk_bf16(pt00[2], pt00[3]), 0u, 0u}); \
        PA1 = __builtin_bit_cast(bf16x8, (u32x4){cvt_pk_bf16(pt01[0], pt01[1]), cvt_pk_bf16(pt01[2], pt01[3]), cvt_pk_bf16(pt11[0], pt11[1]), cvt_pk_bf16(pt11[2], pt11[3])}); \
        const LAS unsigned char* vt_ = (WL) + GW_V + (l15 >> 2) * 32 + (l15 & 3) * 8; \
        const v4i16_t vp0 = lds_tr16(vt_ + (4 * q4) * 32), vp1 = lds_tr16(vt_ + (16 + 4 * q4) * 32); \
        const v4i16_t vn0 = lds_tr16(vt_ + (8 * q4) * 32), vn1 = lds_tr16(vt_ + (8 * q4 + 4) * 32); \
        const bf16x8 vbp = (bf16x8){vp0[0], vp0[1], vp0[2], vp0[3], vp1[0], vp1[1], vp1[2], vp1[3]}; \
        VBN = (bf16x8){vn0[0], vn0[1], vn0[2], vn0[3], vn1[0], vn1[1], vn1[2], vn1[3]}; \
        _Pragma("unroll") for (int db = 0; db < 4; ++db) { \
            const LAS unsigned char* kt = (WL) + GW_K + (8 * q4 + (l15 >> 2)) * 144 + (16 * db + (l15 & 3) * 4) * 2; \
            const v4i16_t k0 = lds_tr16(kt), k1 = lds_tr16(kt + 4 * 144); \
            KAN[db] = (bf16x8){k0[0], k0[1], k0[2], k0[3], k1[0], k1[1], k1[2], k1[3]}; } \
        O0P = __builtin_amdgcn_mfma_f32_16x16x32_bf16(PA0, vbp, (f32x4){0.f, 0.f, 0.f, 0.f}, 0, 0, 0); \
        O1P = __builtin_amdgcn_mfma_f32_16x16x32_bf16(PA1, vbp, (f32x4){0.f, 0.f, 0.f, 0.f}, 0, 0, 0); \
    } while (0)
#define GLA_STAGE_S(T0, VBN, KAN, QPX, QPY, O0P, O1P, E4) do { \
        f32x4 o0 = O0P, o1 = O1P; \
        _Pragma("unroll") for (int ks = 0; ks < 2; ++ks) { \
            const bf16x8 sb = __builtin_bit_cast(bf16x8, (u32x4){cvt_pk_bf16(S[2 * ks][0], S[2 * ks][1]), cvt_pk_bf16(S[2 * ks][2], S[2 * ks][3]), cvt_pk_bf16(S[2 * ks + 1][0], S[2 * ks + 1][1]), cvt_pk_bf16(S[2 * ks + 1][2], S[2 * ks + 1][3])}); \
            o0 = __builtin_amdgcn_mfma_f32_16x16x32_bf16(QPX[ks], sb, o0, 0, 0, 0); \
            o1 = __builtin_amdgcn_mfma_f32_16x16x32_bf16(QPY[ks], sb, o1, 0, 0, 0); } \
        _Pragma("unroll") for (int db = 0; db < 4; ++db) { S[db] = __builtin_amdgcn_mfma_f32_16x16x32_bf16(KAN[db], VBN, S[db], 0, 0, 0); S[db] = S[db] * E4[db]; } \
        _Pragma("unroll") for (int r = 0; r < 4; ++r) { const size_t ta = (T0) + 4 * q4 + r, tb2 = ta + 16; \
            ysb[ta * 512 + h * 128 + 16 * w + l15] = f2bf1(o0[r]); ysb[tb2 * 512 + h * 128 + 16 * w + l15] = f2bf1(o1[r]); } \
    } while (0)
    LAS unsigned char* wl2 = F.lds + GW2 + 64 + F.wave * GW_BYTES;
    GLA_LOAD(0);
    for (int n = 0; n < SEQ / 32; n += 2) {
        const size_t t0 = (size_t)b * SEQ + (size_t)n * 32;
        if (F.tid == 0) prog[0] = n;
        GLA_IMG(wl, kimgX, qimgX, vimgX, ebvX, e4X);
        GLA_IMG(wl2, kimgY, qimgY, vimgY, ebvY, e4Y);
        { const int nn = (n + 2 < SEQ / 32) ? n + 2 : n; GLA_LOAD(nn); }
        GLA_STAGE_P(wl, pa0X, pa1X, vbnX, kanX, qpxX, qpyX, o0pX, o1pX);
        GLA_STAGE_P(wl2, pa0Y, pa1Y, vbnY, kanY, qpxY, qpyY, o0pY, o1pY);
        GLA_STAGE_S(t0, vbnX, kanX, qpxX, qpyX, o0pX, o1pX, e4X);
        GLA_STAGE_S(t0 + 32, vbnY, kanY, qpxY, qpyY, o0pY, o1pY, e4Y);
        asm volatile("s_waitcnt lgkmcnt(0)" ::: "memory");
    }
#undef GLA_LOAD1
#undef GLA_IMG
#undef GLA_STAGE_P
#undef GLA_STAGE_S
#undef GLA_LOAD
}
__device__ __forceinline__ void gla_finalize(Frame& F, int l) {
    bf16_t* ysb = act_ptr(F, A_YSB); const bf16_t* og = act_ptr(F, A_OG);
    const float* go = F.in(I_GGLAO) + l * 128;
    for (int i = F.vcu * 512 + F.tid; i < T * 64; i += F.G * 512) {
        const int t = i >> 6, c8 = i & 63, h = c8 >> 4, v0 = (c8 & 15) * 8;
        const u32x4 o = *(const u32x4*)(ysb + (size_t)t * 512 + c8 * 8), gte = *(const u32x4*)(og + (size_t)t * 512 + c8 * 8);
        const f32x4 g0 = *(const f32x4*)(go + v0), g1 = *(const f32x4*)(go + v0 + 4);
        const float ov[8] = {bflo(o.x), bfhi(o.x), bflo(o.y), bfhi(o.y), bflo(o.z), bfhi(o.z), bflo(o.w), bfhi(o.w)};
        const float ssq = row16_sum(((ov[0] * ov[0] + ov[1] * ov[1]) + (ov[2] * ov[2] + ov[3] * ov[3])) + ((ov[4] * ov[4] + ov[5] * ov[5]) + (ov[6] * ov[6] + ov[7] * ov[7])));
        const float r = rsqrtf(ssq * (1.f / 128.f) + EPS);
        const float gv[8] = {bflo(gte.x), bfhi(gte.x), bflo(gte.y), bfhi(gte.y), bflo(gte.z), bfhi(gte.z), bflo(gte.w), bfhi(gte.w)};
        float y[8];
#pragma unroll
        for (int e = 0; e < 8; ++e) y[e] = ov[e] * r * (e < 4 ? g0[e] : g1[e - 4]) * gv[e] * fast_sigmoid(gv[e]);
        u32x4 wv; wv.x = cvt_pk_bf16(y[0], y[1]); wv.y = cvt_pk_bf16(y[2], y[3]); wv.z = cvt_pk_bf16(y[4], y[5]); wv.w = cvt_pk_bf16(y[6], y[7]);
        *(u32x4*)(ysb + (size_t)t * 512 + c8 * 8) = wv;
    }
}

template <int W> __device__ __forceinline__ void pool_rows(const bf16_t* up, bf16_t* pooled, int t0, int s0, int c8) {
    u32x4 row[8 + W - 1];
#pragma unroll
    for (int i = 0; i < 8 + W - 1; ++i) {
        const int dt = i - (W - 1);
        const bool ok = (s0 + dt) >= 0;
        const u32x4 v = *(const u32x4*)(up + (size_t)(t0 + (ok ? dt : 0)) * 512 + c8 * 8);
        row[i] = ok ? v : (u32x4){0u, 0u, 0u, 0u};
    }
#pragma unroll
    for (int k = 0; k < 8; ++k) {
        float acc[8];
#pragma unroll
        for (int e = 0; e < 8; ++e) acc[e] = 0.f;
#pragma unroll
        for (int j = 0; j < W; ++j) { const u32x4 v = row[k + W - 1 - j];
            acc[0] += bflo(v.x); acc[1] += bfhi(v.x); acc[2] += bflo(v.y); acc[3] += bfhi(v.y); acc[4] += bflo(v.z); acc[5] += bfhi(v.z); acc[6] += bflo(v.w); acc[7] += bfhi(v.w); }
        const int sk = s0 + k, n = (sk + 1 < W) ? sk + 1 : W;
        const float rn = 1.f / (float)n; const u32x4 self = row[k + W - 1];
        u32x4 o; o.x = cvt_pk_bf16(acc[0] * rn - bflo(self.x), acc[1] * rn - bfhi(self.x)); o.y = cvt_pk_bf16(acc[2] * rn - bflo(self.y), acc[3] * rn - bfhi(self.y));
        o.z = cvt_pk_bf16(acc[4] * rn - bflo(self.z), acc[5] * rn - bfhi(self.z)); o.w = cvt_pk_bf16(acc[6] * rn - bflo(self.w), acc[7] * rn - bfhi(self.w));
        *(u32x4*)(pooled + (size_t)(t0 + k) * 512 + c8 * 8) = o;
    }
}
__device__ __forceinline__ void pool_unit(Frame& F, int unit) {
    const bf16_t* up = act_ptr(F, A_UP); bf16_t* pooled = act_ptr(F, A_POOLED);
    const int g = F.wave & 3, c8 = g * 16 + (F.lane & 15), tb = (F.lane >> 4) + 4 * (F.wave >> 2);
    const int t0 = unit * 64 + tb * 8, s0 = t0 % SEQ;
    if (g == 0) pool_rows<2>(up, pooled, t0, s0, c8);
    else if (g == 1) pool_rows<4>(up, pooled, t0, s0, c8);
    else if (g == 2) pool_rows<8>(up, pooled, t0, s0, c8);
    else pool_rows<16>(up, pooled, t0, s0, c8);
}

__device__ __forceinline__ void phase_mix(Frame& F, int lq, int bx) {
    const int l = lq & 1;
#ifndef REP_DMASK
#define REP_DMASK 7
#endif
    const int dm = (lq >= 2) ? (REP_DMASK) : 7;
    if (bx < 32 && (dm & 1)) gla_unit(F, l, bx);
    unsigned* head = F.ctl + CW_QUEUE + 64 * lq;
    unsigned long long tpsum = 0;
#ifdef AT_TPROBE
    const unsigned long long tq0 = __builtin_readcyclecounter();
#endif
    for (;;) {
        if (F.tid == 0) F.MISC[16] = __hip_atomic_fetch_add(head, 1u, RLX_AGENT);
        __syncthreads();
        const int idx = (int)F.MISC[16];
        __syncthreads();
        if (idx >= 512 + 256) break;
        if (idx < 512) { if (dm & 2) attn_unit(F, idx & 31, 15 - (idx >> 5), tpsum); }
        else { if (dm & 4) pool_unit(F, idx - 512); }
    }
#ifdef AT_TPROBE
    if (AT_TPROBE == 7) tpsum = __builtin_readcyclecounter() - tq0;
    if (lq >= 2 && (AT_TPWG < 0 || bx == AT_TPWG) && F.wave == AT_TPWAVE) { const unsigned long long ts = __builtin_readcyclecounter(); while (__builtin_readcyclecounter() - ts < 4ull * tpsum) __builtin_amdgcn_s_sleep(8); }
#endif
    if (bx >= 32 && lq < 2) {
        LAS float* scr = (LAS float*)(F.lds + F.wave * 16384);
        const int gw = (bx - 32) * 8 + F.wave, NGW = (F.G - 32) * 8;
        if (l == 0) { CONV_LOOP(15, mixer_seg(F, 1, si_)); fold_pool(F, 1, gw, NGW); CONV_LOOP(3, ffn_seg(F, si_)); }
        else { CONV_LOOP(12, moe_seg(F, (si_ >> 1) * 3 + (si_ & 1))); }
    }
}

__device__ __forceinline__ void phase_route1(Frame& F) {
    const bf16_t* x = (const bf16_t*)(F.ws + WS_XB); const float* rss = F.stats + SF_ROWSS + (size_t)3 * T * 16; const float* gf = F.in(I_GFFN) + D; const float* wr = F.in(I_WROUTER);
    unsigned* route = (unsigned*)(F.ws + WS_SLOT + SL_ROUTE); unsigned* wgcnt = F.ctl + CW_WGCNT;
    LAS float* lsel = (LAS float*)(F.lds);
    LAS int* lpos = (LAS int*)(F.lds + 2048);
    float wgt[2][8][8];
    {
        f32x4 wl[2][8][2], gl[2][2];
#pragma unroll
        for (int j = 0; j < 2; ++j) {
            const int c = 8 * F.lane + 512 * j;
            gl[j][0] = *(const f32x4*)(gf + c); gl[j][1] = *(const f32x4*)(gf + c + 4);
#pragma unroll
            for (int q = 0; q < 8; ++q) { wl[j][q][0] = *(const f32x4*)(wr + (size_t)(c + q) * 8); wl[j][q][1] = *(const f32x4*)(wr + (size_t)(c + q) * 8 + 4); }
        }
#pragma unroll
        for (int j = 0; j < 2; ++j)
#pragma unroll
            for (int q = 0; q < 8; ++q) { asm volatile("" : "+v"(wl[j][q][0]), "+v"(wl[j][q][1])); }
#pragma unroll
        for (int j = 0; j < 2; ++j)
#pragma unroll
            for (int q = 0; q < 8; ++q) {
                const float g = q < 4 ? gl[j][0][q] : gl[j][1][q - 4];
#pragma unroll
                for (int e = 0; e < 4; ++e) { wgt[j][q][e] = wl[j][q][0][e] * g; wgt[j][q][4 + e] = wl[j][q][1][e] * g; }
            }
    }
    for (int unit = F.vcu; unit < T / 64; unit += F.G) {
        const float rs_l = rsqrtf(sum16(rss + (size_t)(unit * 64 + F.wave * 8 + (F.lane & 7)) * 16) * (1.f / 1024.f) + EPS);
#pragma unroll 1
        for (int k0 = 0; k0 < 8; k0 += 4) {
        u32x4 xr[4][2];
#pragma unroll
        for (int k = 0; k < 4; ++k)
#pragma unroll
            for (int j = 0; j < 2; ++j) xr[k][j] = *(const u32x4*)(x + (size_t)(unit * 64 + F.wave * 8 + k0 + k) * D + 8 * F.lane + 512 * j);
#pragma unroll
        for (int kk = 0; kk < 4; ++kk) {
            const int k = k0 + kk, tok = F.wave * 8 + k;
            float lg[8];
#pragma unroll
            for (int e = 0; e < 8; ++e) lg[e] = 0.f;
#pragma unroll
            for (int j = 0; j < 2; ++j) {
                const u32x4 v = xr[kk][j];
                const float xv[8] = {bflo(v.x), bfhi(v.x), bflo(v.y), bfhi(v.y), bflo(v.z), bfhi(v.z), bflo(v.w), bfhi(v.w)};
#pragma unroll
                for (int q = 0; q < 8; ++q)
#pragma unroll
                    for (int e = 0; e < 8; ++e) lg[e] = fmaf(xv[q], wgt[j][q][e], lg[e]);
            }
            const float rs = __shfl(rs_l, k);
#pragma unroll
            for (int e = 0; e < 8; ++e) lg[e] = wave_sum(lg[e]) * rs;
            int i1 = 0; float v1 = lg[0];
#pragma unroll
            for (int e = 1; e < 8; ++e) if (lg[e] > v1) { v1 = lg[e]; i1 = e; }
            int i2 = -1; float v2 = -INFINITY;
#pragma unroll
            for (int e = 0; e < 8; ++e) if (e != i1 && lg[e] > v2) { v2 = lg[e]; i2 = e; }
            const float e2 = __expf(v2 - v1), w1 = 1.f / (1.f + e2), w2 = e2 / (1.f + e2);
            if (F.lane == 0) { lsel[tok * 4 + 0] = __int_as_float(i1); lsel[tok * 4 + 1] = __int_as_float(i2); lsel[tok * 4 + 2] = w1; lsel[tok * 4 + 3] = w2; }
        }
        }
        __syncthreads();
        if (F.tid < 8) {
            int cnt = 0;
            for (int tok = 0; tok < 64; ++tok) {
                const int e1 = __float_as_int(lsel[tok * 4 + 0]), e2 = __float_as_int(lsel[tok * 4 + 1]);
                if (e1 == F.tid) { lpos[tok * 2 + 0] = cnt; ++cnt; }
                if (e2 == F.tid) { lpos[tok * 2 + 1] = cnt; ++cnt; }
            }
            wgcnt[unit * 8 + F.tid] = (unsigned)cnt;
        }
        __syncthreads();
        if (F.tid < 64) {
            const int t = unit * 64 + F.tid;
            u32x4 a, b2;
            a.x = (unsigned)__float_as_int(lsel[F.tid * 4 + 0]); a.y = (unsigned)__float_as_int(lsel[F.tid * 4 + 1]); a.z = __float_as_uint(lsel[F.tid * 4 + 2]); a.w = __float_as_uint(lsel[F.tid * 4 + 3]);
            b2.x = (unsigned)lpos[F.tid * 2 + 0]; b2.y = (unsigned)lpos[F.tid * 2 + 1]; b2.z = 0u; b2.w = 0u;
            *(u32x4*)(route + (size_t)t * 8) = a; *(u32x4*)(route + (size_t)t * 8 + 4) = b2;
        }
        __syncthreads();
    }
}
__device__ __forceinline__ void moe_geometry(Frame& F, int unit, LAS int* geo) {
    const unsigned* wgcnt = F.ctl + CW_WGCNT;
    if (F.tid < 8) {
        int tot = 0, pre = 0;
        for (int c = 0; c < 256; ++c) { const int v = (int)wgcnt[c * 8 + F.tid]; if (c < unit) pre += v; tot += v; }
        geo[9 + F.tid] = tot; geo[17 + F.tid] = pre;
    }
    __syncthreads();
    if (F.tid == 0) { int acc = 0; for (int e = 0; e < 8; ++e) { geo[e] = acc; acc += (geo[9 + e] + 255) >> 8; } geo[8] = acc; }
    __syncthreads();
}
__device__ __forceinline__ void phase_route2(Frame& F) {
    const unsigned* route = (const unsigned*)(F.ws + WS_SLOT + SL_ROUTE);
    int* slot_tok = (int*)(F.ws + WS_SLOT + SL_TOK); float* slot_scale = (float*)(F.ws + WS_SLOT + SL_SCALE); float* slot_comb = (float*)(F.ws + WS_SLOT + SL_COMB);
    const float* rss = F.stats + SF_ROWSS + (size_t)3 * T * 16;
    const bf16_t* xb = (const bf16_t*)(F.ws + WS_XB); bf16_t* xg = act_ptr(F, A_XG);
    LAS int* geo = (LAS int*)(F.lds);
    for (int unit = F.vcu; unit < T / 64; unit += F.G) {
        moe_geometry(F, unit, geo);
        int slot_l = 0;
        if (F.lane < 16) {
            const int rix = F.wave * 16 + F.lane, tok = rix >> 1, ch = rix & 1, t = unit * 64 + tok;
            const unsigned e = route[(size_t)t * 8 + ch], pos = route[(size_t)t * 8 + 4 + ch];
            const float w = __uint_as_float(route[(size_t)t * 8 + 2 + ch]);
            const float sc = rsqrtf(sum16(rss + (size_t)t * 16) * (1.f / 1024.f) + EPS);
            slot_l = geo[e] * 256 + geo[17 + e] + (int)pos;
            ((int*)(F.ws + WS_TSLOT))[t * 2 + ch] = slot_l; slot_tok[slot_l] = t; slot_scale[slot_l] = sc; slot_comb[slot_l] = w;
        }
#pragma unroll
        for (int k0 = 0; k0 < 16; k0 += 8) {
            u32x4 r0[8], r1[8];
#pragma unroll
            for (int k = 0; k < 8; ++k) {
                const u32x4* src = (const u32x4*)(xb + (size_t)(unit * 64 + ((F.wave * 16 + k0 + k) >> 1)) * D);
                r0[k] = src[F.lane]; r1[k] = src[64 + F.lane];
            }
#pragma unroll
            for (int k = 0; k < 8; ++k) {
                const int slot = __shfl(slot_l, k0 + k);
                u32x4* dst = (u32x4*)(xg + (size_t)slot * D);
                dst[F.lane] = r0[k]; dst[64 + F.lane] = r1[k];
            }
        }
        if (unit == 0) {
            for (int e = 0; e < 8; ++e) { const int s0 = geo[e] * 256 + geo[9 + e], s1 = geo[e + 1] * 256;
                for (int s = s0 + F.tid; s < s1; s += 512) { slot_tok[s] = -1; slot_scale[s] = 0.f; slot_comb[s] = 0.f; } }
        }
        __syncthreads();
    }
}

struct Args { const void* in[25]; float* out; unsigned char* ws; int ph_lo, ph_hi, li, pad; };
constexpr int NPHASE = 22;
#ifndef PH_MASK
#define PH_MASK 0xFFF
#endif
#define PON(b) (((PH_MASK) >> (b)) & 1)

__global__ void __launch_bounds__(512, 2) mega_fwd(Args args) {
    extern __shared__ __attribute__((aligned(16))) unsigned char lds_raw[];
    Frame F;
    F.lds = (LAS unsigned char*)lds_raw;
    F.MISC = (volatile LAS unsigned*)(F.lds + MISC_OFF);
    F.tid = threadIdx.x; F.lane = F.tid & 63; F.wave = __builtin_amdgcn_readfirstlane(F.tid >> 6);
    F.G = gridDim.x; { const int bx = blockIdx.x; F.vcu = (F.G % 8 == 0) ? (bx % 8) * (F.G / 8) + bx / 8 : bx; }
    { const CAS Args* ap0 = (const CAS Args*)__builtin_amdgcn_kernarg_segment_ptr(); F.ws = ap0->ws; F.ctl = (unsigned*)(F.ws + WS_CTL); F.ctlf = (float*)(F.ws + WS_CTL); F.stats = (float*)(F.ws + WS_STATS); }
    F.inp = nullptr; F.out = nullptr;
    for (int u = F.tid; u < (LDS_BYTES - LDSCTL_OFF) / 4; u += 512) ((LAS unsigned*)(F.lds + LDSCTL_OFF))[u] = 0u;
    __syncthreads();
    XcdBarrier bar = xcd_barrier_post(F.ctl + CW_BAR + args.li * XCD_BAR_WORDS, F.MISC + 8);
    const int lo = args.ph_lo, hi = args.ph_hi;
    const int cblk0 = (int)blockIdx.x, wave0 = F.wave, vcu0 = F.vcu, G0 = F.G;
#ifndef REP_MASK
#define REP_MASK 0
#endif
#pragma unroll 1
    for (int ph2 = 2 * lo; ph2 < 2 * hi; ++ph2) {
        const int ph = ph2 >> 1, rpt = ph2 & 1;
        if (rpt && !((REP_MASK >> ph) & 1)) continue;
        int cblk = cblk0; { int wv_ = wave0, vc_ = vcu0, g_ = G0; asm volatile("" : "+s"(wv_), "+s"(vc_), "+s"(g_), "+s"(cblk)); F.wave = wv_; F.vcu = vc_; F.G = g_; }
        { int ln_; asm volatile("v_mbcnt_lo_u32_b32 %0, -1, 0\n\tv_mbcnt_hi_u32_b32 %0, -1, %0" : "=v"(ln_)); F.lane = ln_; F.tid = F.wave * 64 + ln_; }
        { const CAS Args* ap = (const CAS Args*)__builtin_amdgcn_kernarg_segment_ptr(); asm volatile("" : "+s"(ap)); F.inp = ap->in; F.out = ap->out; unsigned char* w_ = ap->ws; F.ws = w_; F.ctl = (unsigned*)(w_ + WS_CTL); F.ctlf = (float*)(w_ + WS_CTL); F.stats = (float*)(w_ + WS_STATS); }
        const int l = ph >= 10 ? 1 : 0, q = ph == 0 ? -1 : (l ? ph - 10 : ph - 1);
        unsigned char* wb = wblk(F, l);
        float* ssq = F.stats + SF_SSQ + (size_t)l * 2 * T * 4;
        const float* rss_in = F.stats + SF_ROWSS + (size_t)(l == 0 ? 0 : 2) * T * 16;
        float* rss_mid = F.stats + SF_ROWSS + (size_t)(l == 0 ? 1 : 3) * T * 16;
        if (q == -1) {
            if (PON(11)) p0_prologue(F);
        } else if (q == 0 && PON(0)) {
            pg8::SchedGrid S{(const char*)(F.ws + WS_XB), (const char*)(wb + WO_IN), (size_t)256 * 1024 * 2, (size_t)256 * 1024 * 2, 0, 64, 11, F.G, cblk, 1 << 30};
            { pg8::Unit u0; if (S.next(0, u0)) fill_rs(F, rss_in, u0.pm); }
            pg8::EpiProj E{act_ptr(F, A_CQKV), act_ptr(F, A_GQKV), act_ptr(F, A_OG), act_ptr(F, A_UP), act_ptr(F, A_MISC), (const LAS float*)(F.lds + RS_OFF), ssq};
            pg8::gemm_phase<pg8::EpiProj, pg8::SchedGrid, true, true>(F.lds, F.wave, 1024, 1024, S, E);
        } else if (q == 1 && PON(1)) {
            pg8::SchedGrid S{(const char*)act_ptr(F, A_CQKV), (const char*)(wb + WO_UP), (size_t)256 * 512 * 2, (size_t)256 * 256 * 2, (size_t)256 * 2, 64, 7, F.G, cblk, 3};
            pg8::EpiUp E{act_ptr(F, A_QKVRAW), ssq};
            pg8::gemm_phase<pg8::EpiUp, pg8::SchedGrid, true, true>(F.lds, F.wave, 512, 256, S, E);
        } else if (q == 2 && PON(2)) {
            phase_prep(F, l, rpt);
        } else if (q == 3 && PON(3)) {
            phase_mix(F, l + 2 * rpt, cblk);
        } else if (q == 4 && PON(4)) {
            pg8::SchedGrid S{(const char*)(F.ws + WS_XB), (const char*)(wb + WO_G), (size_t)256 * 1024 * 2, (size_t)256 * 1024 * 2, 0, 64, 12, F.G, cblk, 1 << 30};
            { pg8::Unit u0; if (S.next(0, u0)) fill_rs(F, rss_in, u0.pm); }
            pg8::EpiGate E{F.ws + WS_ACTS, (const LAS float*)(F.lds + RS_OFF)};
            pg8::gemm_phase<pg8::EpiGate, pg8::SchedGrid, true, true>(F.lds, F.wave, 1024, 1024, S, E);
            if (!rpt) gla_finalize(F, l);
        } else if (q == 5 && PON(5)) {
            pg8::SchedMerge S{(const char*)(F.ws + WS_ACTS), (const char*)(wb + WO_BR), F.G, cblk};
            pg8::EpiMerge E{F.ws + WS_ACTS, act_ptr(F, A_MERGED)};
            pg8::gemm_phase<pg8::EpiMerge, pg8::SchedMerge, true, true>(F.lds, F.wave, 512, 512, S, E);
        } else if (q == 6 && PON(6)) {
            pg8::SchedGrid S{(const char*)act_ptr(F, A_MERGED), (const char*)(wb + WO_OUT), (size_t)256 * 1024 * 2, (size_t)256 * 1024 * 2, 0, 64, 4, F.G, cblk, 1 << 30, MERGED_HI_DELTA};
            pg8::EpiResid E{(bf16_t*)(F.ws + WS_XB), rss_mid};
            pg8::gemm_phase<pg8::EpiResid, pg8::SchedGrid, true, true>(F.lds, F.wave, 1024, 1024, S, E);
        } else if (l == 0 && q == 7 && PON(7)) {
            pg8::SchedGrid S{(const char*)(F.ws + WS_XB), (const char*)(wb + WO_FGU), (size_t)256 * 1024 * 2, (size_t)256 * 1024 * 2, 0, 64, 22, F.G, cblk, 1 << 30};
            if (F.G == 256) S.split_from = 1280;
            { pg8::Unit u0; if (S.next(0, u0)) fill_rs(F, rss_mid, u0.pm); }
            pg8::EpiSwiglu<false> E{act_ptr(F, A_ACT), DFF, (const LAS float*)(F.lds + RS_OFF), nullptr, nullptr};
            pg8::gemm_phase<pg8::EpiSwiglu<false>, pg8::SchedGrid, true, true>(F.lds, F.wave, 1024, 1024, S, E);
        } else if (l == 0 && q == 8 && PON(8)) {
            pg8::SchedGrid S{(const char*)act_ptr(F, A_ACT), (const char*)(wb + WO_FD), (size_t)256 * DFF * 2, (size_t)256 * DFF * 2, 0, 64, 4, F.G, cblk, 1 << 30};
            pg8::EpiResid E{(bf16_t*)(F.ws + WS_XB), F.stats + SF_ROWSS + (size_t)2 * T * 16};
            pg8::gemm_phase<pg8::EpiResid, pg8::SchedGrid, true, true>(F.lds, F.wave, DFF, DFF, S, E);
        } else if (q == 7 && PON(9)) {
            phase_route1(F);
            __syncthreads();
            LAS float* scr = (LAS float*)(F.lds + F.wave * 16384);
            const int gw = F.vcu * 8 + F.wave, NGW = F.G * 8;
            CONV_LOOP(12, moe_seg(F, (si_ < 4) ? (6 + (si_ >> 1)) * 3 + (si_ & 1) : (si_ - 4) * 3 + 2));
        } else if (q == 8 && PON(9)) {
            phase_route2(F);
        } else if (q == 9 && PON(10)) {
            unsigned char* wm = F.ws + WS_W0;
            LAS int* geo = (LAS int*)(F.lds + RING_BYTES + 512);
            moe_geometry(F, 0, geo);
            pg8::SchedMoe S; S.A = (const char*)act_ptr(F, A_XG); S.B = (const char*)(wm + WO_MGU); S.a_tile = (size_t)256 * 1024 * 2; S.b_tile = (size_t)256 * 1024 * 2; S.b_exp = (size_t)2816 * 1024 * 2;
            S.nN = 11; S.G = F.G; S.c = cblk;
            S.t1 = __builtin_amdgcn_readfirstlane(geo[1]); S.t2 = __builtin_amdgcn_readfirstlane(geo[2]); S.t3 = __builtin_amdgcn_readfirstlane(geo[3]); S.t4 = __builtin_amdgcn_readfirstlane(geo[4]);
            S.t5 = __builtin_amdgcn_readfirstlane(geo[5]); S.t6 = __builtin_amdgcn_readfirstlane(geo[6]); S.t7 = __builtin_amdgcn_readfirstlane(geo[7]); S.MT = __builtin_amdgcn_readfirstlane(geo[8]);
            pg8::EpiSwiglu<true> E{act_ptr(F, A_ACTE), DEXP, (const LAS float*)nullptr, (const float*)(F.ws + WS_SLOT + SL_SCALE), (const float*)(F.ws + WS_SLOT + SL_COMB)};
            pg8::gemm_phase<pg8::EpiSwiglu<true>, pg8::SchedMoe, true, true>(F.lds, F.wave, 1024, 1024, S, E);
        } else if (q == 10 && PON(10)) {
            unsigned char* wm = F.ws + WS_W0;
            LAS int* geo = (LAS int*)(F.lds + RING_BYTES + 512);
            moe_geometry(F, 0, geo);
            pg8::SchedMoe S; S.A = (const char*)act_ptr(F, A_ACTE); S.B = (const char*)(wm + WO_MD); S.a_tile = (size_t)256 * DEXP * 2; S.b_tile = (size_t)256 * DEXP * 2; S.b_exp = (size_t)1024 * DEXP * 2;
            S.nN = 4; S.G = F.G; S.c = cblk;
            S.t1 = __builtin_amdgcn_readfirstlane(geo[1]); S.t2 = __builtin_amdgcn_readfirstlane(geo[2]); S.t3 = __builtin_amdgcn_readfirstlane(geo[3]); S.t4 = __builtin_amdgcn_readfirstlane(geo[4]);
            S.t5 = __builtin_amdgcn_readfirstlane(geo[5]); S.t6 = __builtin_amdgcn_readfirstlane(geo[6]); S.t7 = __builtin_amdgcn_readfirstlane(geo[7]); S.MT = __builtin_amdgcn_readfirstlane(geo[8]);
            { const int nt = S.MT * 4, rem = nt % F.G; if (rem > 0 && 2 * rem <= F.G) S.split_from = nt - rem; }
            pg8::EpiMoeDown E{act_ptr(F, A_Y)};
            pg8::gemm_phase<pg8::EpiMoeDown, pg8::SchedMoe, true, true>(F.lds, F.wave, DEXP, DEXP, S, E);
        }
        else if (q == 11) {
            const int* tslot = (const int*)(F.ws + WS_TSLOT); const bf16_t* y = act_ptr(F, A_Y);
            const int tstep = F.G * 8;
            for (int tb = F.vcu * 8 + F.wave; tb < T; tb += 4 * tstep) {
                int sl = 0;
                { const int tt = tb + (F.lane >> 1) * tstep; if (F.lane < 8 && tt < T) sl = tslot[tt * 2 + (F.lane & 1)]; }
                u32x4 av[4][2], bv[4][2], xv4[4][2];
#pragma unroll
                for (int k = 0; k < 4; ++k) {
                    const int t = tb + k * tstep, tc = t < T ? t : tb;
                    const int s0 = __shfl(sl, 2 * k), s1 = __shfl(sl, 2 * k + 1);
                    const bf16_t* xbr = (const bf16_t*)(F.ws + WS_XB) + (size_t)tc * D;
#pragma unroll
                    for (int j = 0; j < 2; ++j) {
                        av[k][j] = *((const u32x4*)(y + (size_t)s0 * D) + 64 * j + F.lane); bv[k][j] = *((const u32x4*)(y + (size_t)s1 * D) + 64 * j + F.lane);
                        xv4[k][j] = *((const u32x4*)xbr + 64 * j + F.lane);
                    }
                }
#pragma unroll
                for (int k = 0; k < 4; ++k) {
                    const int t = tb + k * tstep; if (t >= T) break;
                    f32x4* xo = (f32x4*)(F.out + (size_t)t * D) + F.lane * 2;
#pragma unroll
                    for (int j = 0; j < 2; ++j) {
                        const u32x4 a = av[k][j], bq = bv[k][j], xv = xv4[k][j];
                        f32x4 x0 = {bflo(xv.x), bfhi(xv.x), bflo(xv.y), bfhi(xv.y)}, x1 = {bflo(xv.z), bfhi(xv.z), bflo(xv.w), bfhi(xv.w)};
                        x0[0] += bflo(a.x) + bflo(bq.x); x0[1] += bfhi(a.x) + bfhi(bq.x); x0[2] += bflo(a.y) + bflo(bq.y); x0[3] += bfhi(a.y) + bfhi(bq.y);
                        x1[0] += bflo(a.z) + bflo(bq.z); x1[1] += bfhi(a.z) + bfhi(bq.z); x1[2] += bflo(a.w) + bflo(bq.w); x1[3] += bfhi(a.w) + bfhi(bq.w);
                        xo[128 * j] = x0; xo[128 * j + 1] = x1;
                    }
                }
            }
        }
        if (ph + 1 < hi || (!rpt && ((REP_MASK >> ph) & 1))) xcd_barrier(bar);
    }
}


#ifdef DBG_PH
__global__ void dbg_dump(const unsigned char* ws, float* out) {
    const size_t i = (size_t)blockIdx.x * 256 + threadIdx.x;
    float v = 0.f;
    const bf16_t* a0 = (const bf16_t*)(ws + WS_ACTS + DBG_A0); const bf16_t* a1 = (const bf16_t*)(ws + WS_ACTS + DBG_A1);
    if (i < (size_t)DBG_N0) v += __uint_as_float((unsigned)a0[i] << 16);
    if (i < (size_t)DBG_N1) v += 3.f * __uint_as_float((unsigned)a1[i] << 16);
    out[i] = v;
}
#endif

extern "C" void kernel_launch(void* const* d_in, const int* in_sizes, int n_in, void* d_out, int out_size, void* d_ws, size_t ws_size, hipStream_t stream) {
    static int grid = 0;
    if (grid == 0) {
        if (n_in != 25 || out_size != T * D || ws_size < WS_END) { fprintf(stderr, "kernel_launch: unexpected sizes (n_in %d out %d ws %zu)\n", n_in, out_size, ws_size); grid = -1; return; }
        int dev = 0, cus = 0;
        if (hipGetDevice(&dev) != hipSuccess || hipDeviceGetAttribute(&cus, hipDeviceAttributeMultiprocessorCount, dev) != hipSuccess) { grid = -1; return; }
        if (hipFuncSetAttribute((const void*)mega_fwd, hipFuncAttributeMaxDynamicSharedMemorySize, LDS_BYTES) != hipSuccess) { grid = -1; return; }
        int per_cu = 0;
        (void)hipOccupancyMaxActiveBlocksPerMultiprocessor(&per_cu, (const void*)mega_fwd, 512, LDS_BYTES);
        (void)hipGetLastError();
        grid = cus;
    }
    if (grid < 0) return;
    (void)hipMemsetAsync((char*)d_ws + WS_CTL, 0, CTL_BYTES, stream);
    Args a{};
    for (int i = 0; i < 25; ++i) a.in[i] = d_in[i];
    a.out = (float*)d_out; a.ws = (unsigned char*)d_ws; a.ph_lo = 0; a.ph_hi = NPHASE; a.li = 0; a.pad = 0;
#ifdef DBG_PH
    a.ph_hi = DBG_PH;
#endif
    void* kargs[] = {&a};
    hipError_t e = hipLaunchCooperativeKernel((const void*)mega_fwd, dim3(grid), dim3(512), kargs, LDS_BYTES, stream);
    if (e != hipSuccess) fprintf(stderr, "cooperative launch failed: %s (grid %d)\n", hipGetErrorString(e), grid);
#ifdef DBG_PH
    hipLaunchKernelGGL(dbg_dump, dim3(T * 1024 / 256), dim3(256), 0, stream, (const unsigned char*)d_ws, (float*)d_out);
#endif
}
```

```cpp
#include <hip/hip_runtime.h>
#include <cstdint>
#include <cstdio>

#define LAS __attribute__((address_space(3)))
#define CAS __attribute__((address_space(4)))
typedef const void* GPtr;
typedef unsigned short bf16_t;
typedef short bf16x8 __attribute__((ext_vector_type(8)));
typedef float f32x4 __attribute__((ext_vector_type(4)));
typedef float f32x16 __attribute__((ext_vector_type(16)));
typedef unsigned u32x4 __attribute__((ext_vector_type(4)));
typedef unsigned u32x2 __attribute__((ext_vector_type(2)));

constexpr int T = 16384, SEQ = 4096, NB = 4, D = 1024, DIN = 5680, DFF = 2816, DEXP = 1408, NEXP = 8;
constexpr int NPROJ = 2816;
constexpr float EPS = 1e-6f;
constexpr int MAXSLOT = 34816;

constexpr size_t MiB = 1u << 20;
constexpr size_t WS_CTL = 0, CTL_BYTES = 128 * 1024;
constexpr size_t WS_SLOT = 2 * MiB;
constexpr size_t WS_ROPE = 3 * MiB;
constexpr size_t WS_XB = 5 * MiB;
constexpr size_t WS_W1 = 37 * MiB;
constexpr size_t WS_W0 = 55 * MiB;
constexpr size_t WS_ACTS = 89 * MiB;
constexpr size_t WS_STATS = 283 * MiB;
constexpr size_t WS_END = 291 * MiB;
constexpr size_t WO_IN = 0, WO_G = 5632 * 1024, WO_UP = WO_G + 6 * MiB, WO_BR = WO_UP + 1792 * 256 * 2, WO_OUT = WO_BR + 3 * MiB, WO_FGU = WO_OUT + 2 * MiB, WO_FD = WO_FGU + 11 * MiB;
constexpr size_t WO_MGU = 0, WO_MD = 44 * MiB;
constexpr size_t A_OG = 0, A_GQKV = 16 * MiB, A_UP = 48 * MiB, A_MISC = 64 * MiB, A_CQKV = 72 * MiB, A_VT = 72 * MiB, A_QKVRAW = 88 * MiB;
constexpr size_t A_YSA = 96 * MiB, A_POOLED = 112 * MiB, A_YSB = 128 * MiB, A_QH = 144 * MiB, A_KH = 168 * MiB;
constexpr size_t A_G0 = 16 * MiB, A_G1 = 48 * MiB, A_G2 = 144 * MiB, A_ACT = 0;
constexpr size_t A_MERGED = 0;
constexpr long long MERGED_HI_DELTA = (long long)(64 * MiB);
constexpr size_t A_XG = 32 * MiB, A_ACTE = 100 * MiB, A_Y = 32 * MiB;
constexpr int CW_TMO = 0, CW_BAR = 4096, CW_QUEUE = 16384, CW_WGCNT = 20480;
static_assert((size_t)(CW_WGCNT + 2048) * 4 <= CTL_BYTES, "ctl");
constexpr size_t SF_SSQ = 0;
constexpr size_t SF_ROWSS = (size_t)2 * 2 * T * 4;
constexpr size_t SF_OSS = SF_ROWSS + (size_t)4 * T * 16;
constexpr size_t SF_EB = SF_OSS + (size_t)T * 32;
static_assert((SF_EB + (size_t)(T / 32) * 256) * 4 <= 8 * MiB, "stats");
constexpr size_t SL_TOK = 0, SL_SCALE = 139264, SL_COMB = 2 * 139264, SL_ROUTE = 3 * 139264;
constexpr size_t WS_TSLOT = 1 * MiB;

constexpr int RING_BYTES = 131072, LDSCTL_OFF = RING_BYTES, MISC_OFF = LDSCTL_OFF + 320, LDS_BYTES = 147456;
constexpr int RS_OFF = RING_BYTES + 1024;

#define LDS_WAIT() asm volatile("s_waitcnt lgkmcnt(0)" ::: "memory")
#define VM_WAIT() asm volatile("s_waitcnt vmcnt(0)" ::: "memory")
#define LDS_BARRIER() do { asm volatile("s_waitcnt lgkmcnt(0)" ::: "memory"); __builtin_amdgcn_s_barrier(); asm volatile("" ::: "memory"); } while (0)
#define RLX_AGENT __ATOMIC_RELAXED, __HIP_MEMORY_SCOPE_AGENT
typedef float f32x2_t __attribute__((ext_vector_type(2))); typedef __bf16 bf16x2_t __attribute__((ext_vector_type(2)));
__device__ __forceinline__ unsigned cvt_pk_bf16(float lo, float hi) { f32x2_t v = {lo, hi}; bf16x2_t b = __builtin_convertvector(v, bf16x2_t); return __builtin_bit_cast(unsigned, b); }
__device__ __forceinline__ float bflo(unsigned u) { return __uint_as_float(u << 16); }
__device__ __forceinline__ float bfhi(unsigned u) { return __uint_as_float(u & 0xffff0000u); }
__device__ __forceinline__ float wave_sum(float v) {
#pragma unroll
    for (int o = 1; o < 64; o <<= 1) v += __shfl_xor(v, o);
    return v;
}
__device__ __forceinline__ float sum16(const float* p) { const f32x4 a = *(const f32x4*)p, b = *(const f32x4*)(p + 4), c = *(const f32x4*)(p + 8), d = *(const f32x4*)(p + 12);
    return (((a[0] + a[1]) + (a[2] + a[3])) + ((b[0] + b[1]) + (b[2] + b[3]))) + (((c[0] + c[1]) + (c[2] + c[3])) + ((d[0] + d[1]) + (d[2] + d[3]))); }
__device__ __forceinline__ float sum4(const float* p) { const f32x4 a = *(const f32x4*)p; return (a[0] + a[1]) + (a[2] + a[3]); }
__device__ __forceinline__ float fast_sigmoid(float z) { return __builtin_amdgcn_rcpf(1.f + __builtin_amdgcn_exp2f(-1.4426950408889634f * z)); }

namespace pg8 {
constexpr int BM = 256, BK = 64, HALF = 128, HTB = HALF * BK * 2, STAGE_BYTES = 8 * HTB, NXCD = 8, WGM = 8;
__host__ __device__ __forceinline__ int lds_byte(int r, int c) { const int st = (r >> 4) * 2 + (c >> 5), rr = r & 15, cc = c & 31, ob = rr * 64 + cc * 2; return st * 1024 + (ob ^ (((ob >> 9) & 1) << 5)); }
__host__ __device__ __forceinline__ void stage_rc(int b, int& R, int& C) { const int st = b / 1024, sb = b % 1024, swz = sb ^ (((sb >> 9) & 1) << 5); R = (st >> 1) * 16 + swz / 64; C = (st & 1) * 32 + (swz % 64) / 2; }
__host__ __device__ __forceinline__ int perm32(int rho) { const int n = rho >> 4, i = rho & 15; return 8 * (i >> 2) + 4 * n + (i & 3); }

struct Unit { const char* a; const char* b; int pm, pn, kind, half; };
__device__ __forceinline__ void tile_map(int L, int nM, int nN, int& pm, int& pn) {
    const int nwg = nM * nN; int wgid = L;
    { const int q = nwg / NXCD, r = nwg % NXCD, xcd = wgid % NXCD, off = wgid / NXCD; wgid = (xcd < r ? xcd * (q + 1) : r * (q + 1) + (xcd - r) * q) + off; }
    const int nig = WGM * nN, gid = wgid / nig, fm = gid * WGM, gsz = (nM - fm) < WGM ? (nM - fm) : WGM;
    pm = fm + ((wgid % nig) % gsz); pn = (wgid % nig) / gsz;
}

template <class Epi, class Sched, bool ALIGN_EPI, bool SP2>
__device__ __forceinline__ void gemm_phase(LAS unsigned char* lds, const int wave_in, const int lda, const int K, const Sched& S, const Epi& E) {
    int ln_; asm volatile("v_mbcnt_lo_u32_b32 %0, -1, 0\n\tv_mbcnt_hi_u32_b32 %0, -1, %0" : "=v"(ln_));
    const int tid = wave_in * 64 + ln_, wid = __builtin_amdgcn_readfirstlane(tid >> 6), lane = tid & 63, wr = wid >> 2, wc = wid & 3, fr = lane & 15, fq = lane >> 4;
    const int nt = K / BK;
    unsigned voffA[2], voffB[2];
#pragma unroll
    for (int i = 0; i < 2; ++i) { int R, C; stage_rc(tid * 16 + i * 8192, R, C); const int Rb = Epi::PERM ? ((R & ~31) + perm32(R & 31)) : R;
        voffA[i] = (unsigned)(R * lda + C) * 2u; voffB[i] = (unsigned)(Rb * K + C) * 2u; }
    const size_t kstep = (size_t)(BK * 2);
    const size_t hstepA = (size_t)HALF * lda * 2, hstepB = (size_t)HALF * K * 2;
    const unsigned ldsw = (unsigned)wid * 1024u;
    const int aoff = lds_byte(wr * 64 + fr, fq * 8), boff = lds_byte(wc * 32 + fr, fq * 8);
#define PG8_SA(b, h) (((b) * 2 + (h)) * HTB)
#define PG8_SB(b, h) ((4 + (b) * 2 + (h)) * HTB)
#define PG8_STAGE(bufoff, gbase, voff) do { _Pragma("unroll") for (int _i = 0; _i < 2; ++_i) \
        __builtin_amdgcn_global_load_lds((const unsigned*)((const char*)(gbase) + (voff)[_i]), (LAS unsigned*)(lds + (bufoff) + ldsw + _i * 8192), 16, 0, 0); } while (0)
#define PG8_LDA(dst, b, h) do { _Pragma("unroll") for (int m = 0; m < 4; ++m) _Pragma("unroll") for (int k = 0; k < 2; ++k) dst[m][k] = *(const LAS bf16x8*)(lds + PG8_SA(b, h) + aoff + m * 2048 + k * 1024); } while (0)
#define PG8_LDB(dst, b, h) do { _Pragma("unroll") for (int n = 0; n < 2; ++n) _Pragma("unroll") for (int k = 0; k < 2; ++k) dst[n][k] = *(const LAS bf16x8*)(lds + PG8_SB(b, h) + boff + n * 2048 + k * 1024); } while (0)
#define PG8_MMA(ai, bj, At, Bt) do { __builtin_amdgcn_s_setprio(1); _Pragma("unroll") for (int m = 0; m < 4; ++m) _Pragma("unroll") for (int n = 0; n < 2; ++n) _Pragma("unroll") for (int k = 0; k < 2; ++k) \
        acc[ai][bj][m][n] = __builtin_amdgcn_mfma_f32_16x16x32_bf16(Bt[n][k], At[m][k], acc[ai][bj][m][n], 0, 0, 0); __builtin_amdgcn_s_setprio(0); } while (0)
#define PG8_WAIT_V(n) asm volatile("s_waitcnt vmcnt(" #n ")" ::: "memory")
#define PG8_WAIT_L(n) asm volatile("s_waitcnt lgkmcnt(" #n ")" ::: "memory")
#define PG8_BAR __builtin_amdgcn_s_barrier()
#define PG8_SCHED __builtin_amdgcn_sched_barrier(0)
    Unit cur, nxt; int ui = 0;
    if (!S.next(0, cur)) return;
    f32x4 acc[2][2][4][2];
#pragma unroll
    for (int a = 0; a < 2; ++a)
#pragma unroll
        for (int b = 0; b < 2; ++b)
#pragma unroll
            for (int m = 0; m < 4; ++m)
#pragma unroll
                for (int n = 0; n < 2; ++n) acc[a][b][m][n] = (f32x4){0.f, 0.f, 0.f, 0.f};
    bf16x8 At[4][2], B0[2][2], B1[2][2];
    const char* cA = cur.a; const char* cB = cur.b;
    if constexpr (SP2) {
        PG8_STAGE(PG8_SB(0, 0), cB, voffB); PG8_STAGE(PG8_SB(0, 1), cB + hstepB, voffB); PG8_STAGE(PG8_SA(0, 0), cA, voffA); PG8_STAGE(PG8_SA(0, 1), cA + hstepA, voffA);
        if (wr == 1) PG8_BAR;
        PG8_WAIT_V(2); PG8_BAR;
        PG8_STAGE(PG8_SB(1, 0), cB + kstep, voffB); PG8_STAGE(PG8_SA(1, 0), cA + kstep, voffA); PG8_STAGE(PG8_SB(1, 1), cB + hstepB + kstep, voffB);
        PG8_WAIT_V(6); PG8_BAR;
    } else {
        PG8_STAGE(PG8_SB(0, 0), cB, voffB); PG8_STAGE(PG8_SA(0, 0), cA, voffA); PG8_STAGE(PG8_SB(0, 1), cB + hstepB, voffB); PG8_STAGE(PG8_SA(0, 1), cA + hstepA, voffA);
        if (wr == 1) PG8_BAR;
        PG8_WAIT_V(4); PG8_BAR;
        PG8_STAGE(PG8_SB(1, 0), cB + kstep, voffB); PG8_STAGE(PG8_SA(1, 0), cA + kstep, voffA); PG8_STAGE(PG8_SB(1, 1), cB + hstepB + kstep, voffB);
        PG8_WAIT_V(6); PG8_BAR;
    }
    for (;;) {
        const bool has_next = S.next(ui + 1, nxt);
        const bool do0 = cur.half != 2, do1 = cur.half != 1;
        const char* nA = has_next ? nxt.a : cA; const char* nB = has_next ? nxt.b : cB;
#pragma unroll 1
        for (int t = 0; t < nt; t += 2) {
            const bool last = (t == nt - 2);
            const char* a1 = cA + (size_t)(t + 1) * kstep;
            const char* a2 = last ? nA : cA + (size_t)(t + 2) * kstep; const char* b2 = last ? nB : cB + (size_t)(t + 2) * kstep;
            const char* a3 = a2 + kstep; const char* b3 = b2 + kstep;
            if constexpr (SP2) {
            PG8_LDB(B0, 0, 0); PG8_LDB(B1, 0, 1); PG8_SCHED; PG8_LDA(At, 0, 0); PG8_STAGE(PG8_SA(1, 1), a1 + hstepA, voffA);
            PG8_WAIT_V(8); PG8_WAIT_L(0); PG8_BAR; if (do0) { PG8_MMA(0, 0, At, B0); PG8_MMA(0, 1, At, B1); } PG8_BAR; PG8_SCHED;
            PG8_LDA(At, 0, 1); PG8_STAGE(PG8_SB(0, 0), b2, voffB); PG8_STAGE(PG8_SB(0, 1), b2 + hstepB, voffB); PG8_STAGE(PG8_SA(0, 0), a2, voffA);
            PG8_WAIT_V(8); PG8_WAIT_L(0); PG8_BAR; if (do1) { PG8_MMA(1, 0, At, B0); PG8_MMA(1, 1, At, B1); } PG8_BAR; PG8_SCHED;
            PG8_LDB(B0, 1, 0); PG8_LDB(B1, 1, 1); PG8_SCHED; PG8_LDA(At, 1, 0); PG8_STAGE(PG8_SA(0, 1), a2 + hstepA, voffA);
            PG8_WAIT_V(8); PG8_WAIT_L(0); PG8_BAR; if (do0) { PG8_MMA(0, 0, At, B0); PG8_MMA(0, 1, At, B1); } PG8_BAR; PG8_SCHED;
            PG8_LDA(At, 1, 1); PG8_STAGE(PG8_SB(1, 0), b3, voffB); PG8_STAGE(PG8_SB(1, 1), b3 + hstepB, voffB); PG8_STAGE(PG8_SA(1, 0), a3, voffA);
            PG8_WAIT_V(8); PG8_WAIT_L(0); PG8_BAR; if (do1) { PG8_MMA(1, 0, At, B0); PG8_MMA(1, 1, At, B1); } PG8_BAR; PG8_SCHED;
            } else {
            PG8_LDB(B0, 0, 0); PG8_SCHED; PG8_LDA(At, 0, 0); PG8_STAGE(PG8_SA(1, 1), a1 + hstepA, voffA);
            PG8_WAIT_L(8); PG8_BAR; PG8_WAIT_L(0); PG8_MMA(0, 0, At, B0); PG8_BAR; PG8_SCHED;
            PG8_LDB(B1, 0, 1); PG8_STAGE(PG8_SB(0, 0), b2, voffB);
            PG8_BAR; PG8_WAIT_L(0); PG8_MMA(0, 1, At, B1); PG8_BAR;
            PG8_LDA(At, 0, 1); PG8_STAGE(PG8_SA(0, 0), a2, voffA);
            PG8_BAR; PG8_WAIT_L(0); PG8_MMA(1, 0, At, B0); PG8_BAR; PG8_SCHED;
            PG8_STAGE(PG8_SB(0, 1), b2 + hstepB, voffB);
            PG8_WAIT_V(6); PG8_BAR; PG8_MMA(1, 1, At, B1); PG8_BAR;
            PG8_LDB(B0, 1, 0); PG8_SCHED; PG8_LDA(At, 1, 0); PG8_STAGE(PG8_SA(0, 1), a2 + hstepA, voffA);
            PG8_WAIT_L(8); PG8_BAR; PG8_WAIT_L(0); PG8_MMA(0, 0, At, B0); PG8_BAR; PG8_SCHED;
            PG8_LDB(B1, 1, 1); PG8_STAGE(PG8_SB(1, 0), b3, voffB);
            PG8_BAR; PG8_WAIT_L(0); PG8_MMA(0, 1, At, B1); PG8_BAR;
            PG8_LDA(At, 1, 1); PG8_STAGE(PG8_SA(1, 0), a3, voffA);
            PG8_BAR; PG8_WAIT_L(0); PG8_MMA(1, 0, At, B0); PG8_BAR; PG8_SCHED;
            PG8_STAGE(PG8_SB(1, 1), b3 + hstepB, voffB);
            PG8_WAIT_V(6); PG8_BAR; PG8_MMA(1, 1, At, B1); PG8_BAR;
            }
        }
        if constexpr (ALIGN_EPI) { if (wr == 0) PG8_BAR; }
        E(acc, cur, wr, wc, fr, fq);
        if (!has_next) break;
        if (!E.keep(cur)) {
#pragma unroll
            for (int a = 0; a < 2; ++a)
#pragma unroll
                for (int b = 0; b < 2; ++b)
#pragma unroll
                    for (int m = 0; m < 4; ++m)
#pragma unroll
                        for (int n = 0; n < 2; ++n) acc[a][b][m][n] = (f32x4){0.f, 0.f, 0.f, 0.f};
        }
        cur = nxt; cA = nA; cB = nB; ++ui;
        if constexpr (ALIGN_EPI) { if (wr == 1) PG8_BAR; }
    }
    PG8_WAIT_V(0);
    if constexpr (!ALIGN_EPI) { if (wr == 0) PG8_BAR; }
    PG8_BAR;
#undef PG8_SA
#undef PG8_SB
#undef PG8_STAGE
#undef PG8_LDA
#undef PG8_LDB
#undef PG8_MMA
#undef PG8_WAIT_V
#undef PG8_WAIT_L
#undef PG8_BAR
#undef PG8_SCHED
}

typedef f32x4 Acc[2][2][4][2];

struct EpiProj {
    static constexpr bool PERM = true;
    bf16_t *cqkv, *gqkv, *og, *up, *misc; const LAS float* rs_tab; float* ssq;
    __device__ __forceinline__ bool keep(const Unit&) const { return false; }
    __device__ __forceinline__ void operator()(Acc& acc, const Unit& u, int wr, int wc, int fr, int fq) const {
        const int row0 = u.pm * BM + wr * 64 + fr;
        bf16_t* dst; int ld, coff; const int pn = u.pn;
        if (pn < 2) { dst = cqkv; ld = 512; coff = pn * 256; }
        else if (pn < 6) { dst = gqkv; ld = 1024; coff = (pn - 2) * 256; }
        else if (pn < 8) { dst = og; ld = 512; coff = (pn - 6) * 256; }
        else if (pn < 10) { dst = up; ld = 512; coff = (pn - 8) * 256; }
        else { dst = misc; ld = 256; coff = 0; }
        const int col0 = coff + wc * 32 + 8 * fq;
#pragma unroll
        for (int ai = 0; ai < 2; ++ai)
#pragma unroll
            for (int m = 0; m < 4; ++m) { if (u.half && ai != u.half - 1) continue;
                const int row = row0 + ai * HALF + m * 16;
                const float rs = rs_tab[wr * 64 + fr + ai * HALF + m * 16];
                float ss = 0.f;
#pragma unroll
                for (int bj = 0; bj < 2; ++bj) {
                    const f32x4 v0 = acc[ai][bj][m][0] * rs, v1 = acc[ai][bj][m][1] * rs;
                    ss += (v0[0] * v0[0] + v0[1] * v0[1]) + (v0[2] * v0[2] + v0[3] * v0[3]) + (v1[0] * v1[0] + v1[1] * v1[1]) + (v1[2] * v1[2] + v1[3] * v1[3]);
                    u32x4 w; w.x = cvt_pk_bf16(v0[0], v0[1]); w.y = cvt_pk_bf16(v0[2], v0[3]); w.z = cvt_pk_bf16(v1[0], v1[1]); w.w = cvt_pk_bf16(v1[2], v1[3]);
                    *(u32x4*)(dst + (size_t)row * ld + col0 + bj * HALF) = w;
                }
                if (pn < 2) { ss += __shfl_xor(ss, 16); ss += __shfl_xor(ss, 32); if (fq == 0) ssq[((size_t)pn * T + row) * 4 + wc] = ss; }
            }
    }
};
struct EpiUp {
    static constexpr bool PERM = true;
    bf16_t* out; const float* ssq;
    __device__ __forceinline__ bool keep(const Unit&) const { return false; }
    __device__ __forceinline__ void operator()(Acc& acc, const Unit& u, int wr, int wc, int fr, int fq) const {
        const int row0 = u.pm * BM + wr * 64 + fr, col0 = u.pn * BM + wc * 32 + 8 * fq;
        const float* sq = ssq + (u.pn < 3 ? (size_t)0 : (size_t)T * 4);
        f32x4 sqv[2][4];
#pragma unroll
        for (int ai = 0; ai < 2; ++ai)
#pragma unroll
            for (int m = 0; m < 4; ++m) sqv[ai][m] = *(const f32x4*)(sq + (size_t)(row0 + ai * HALF + m * 16) * 4);
#pragma unroll
        for (int ai = 0; ai < 2; ++ai)
#pragma unroll
            for (int m = 0; m < 4; ++m) { if (u.half && ai != u.half - 1) continue;
                const int row = row0 + ai * HALF + m * 16;
                const float rs = rsqrtf(((sqv[ai][m][0] + sqv[ai][m][1]) + (sqv[ai][m][2] + sqv[ai][m][3])) * (1.f / 256.f) + EPS);
#pragma unroll
                for (int bj = 0; bj < 2; ++bj) {
                    const f32x4 v0 = acc[ai][bj][m][0] * rs, v1 = acc[ai][bj][m][1] * rs;
                    u32x4 w; w.x = cvt_pk_bf16(v0[0], v0[1]); w.y = cvt_pk_bf16(v0[2], v0[3]); w.z = cvt_pk_bf16(v1[0], v1[1]); w.w = cvt_pk_bf16(v1[2], v1[3]);
                    *(u32x4*)(out + (size_t)row * 1792 + col0 + bj * HALF) = w;
                }
            }
    }
};
struct EpiGate {
    static constexpr bool PERM = true;
    unsigned char* acts; const LAS float* rs_tab;
    __device__ __forceinline__ bool keep(const Unit&) const { return false; }
    __device__ __forceinline__ void operator()(Acc& acc, const Unit& u, int wr, int wc, int fr, int fq) const {
        const int row0 = u.pm * BM + wr * 64 + fr, pl = u.pn >> 2, col0 = (u.pn & 3) * BM + wc * 32 + 8 * fq;
        bf16_t* dst = (bf16_t*)(acts + ((long long)A_G0 + (long long)(pl == 1) * (long long)(A_G1 - A_G0) + (long long)(pl == 2) * (long long)(A_G2 - A_G0)));
#pragma unroll
        for (int ai = 0; ai < 2; ++ai)
#pragma unroll
            for (int m = 0; m < 4; ++m) { if (u.half && ai != u.half - 1) continue;
                const int row = row0 + ai * HALF + m * 16;
                const float rs = rs_tab[wr * 64 + fr + ai * HALF + m * 16];
#pragma unroll
                for (int bj = 0; bj < 2; ++bj) {
                    f32x4 v0 = acc[ai][bj][m][0] * rs, v1 = acc[ai][bj][m][1] * rs;
#ifndef DBG_NOSIG
#pragma unroll
                    for (int e = 0; e < 4; ++e) { v0[e] = fast_sigmoid(fminf(fmaxf(v0[e], -60.f), 60.f)); v1[e] = fast_sigmoid(fminf(fmaxf(v1[e], -60.f), 60.f)); }
#endif
                    u32x4 w; w.x = cvt_pk_bf16(v0[0], v0[1]); w.y = cvt_pk_bf16(v0[2], v0[3]); w.z = cvt_pk_bf16(v1[0], v1[1]); w.w = cvt_pk_bf16(v1[2], v1[3]);
                    *(u32x4*)(dst + (size_t)row * 1024 + col0 + bj * HALF) = w;
                }
            }
    }
};
struct EpiMerge {
    static constexpr bool PERM = true;
    const unsigned char* acts; bf16_t* merged;
    __device__ __forceinline__ bool keep(const Unit& u) const { return u.kind < 2; }
    __device__ __forceinline__ void operator()(Acc& acc, const Unit& u, int wr, int wc, int fr, int fq) const {
        const int row0 = u.pm * BM + wr * 64 + fr, col0 = u.pn * BM + wc * 32 + 8 * fq, n = u.kind;
        const bf16_t* gn = (const bf16_t*)(acts + ((long long)A_G0 + (long long)(n == 1) * (long long)(A_G1 - A_G0) + (long long)(n == 2) * (long long)(A_G2 - A_G0)));
        const bf16_t* gd = (const bf16_t*)(acts + ((long long)A_G1 + (long long)(n != 0) * (long long)(A_G2 - A_G1)));
        if (n < 2) {
#pragma unroll
            for (int ai = 0; ai < 2; ++ai) {
                if (u.half && ai != u.half - 1) continue;
                u32x4 sn[4][2], sd[4][2];
#pragma unroll
                for (int m = 0; m < 4; ++m)
#pragma unroll
                    for (int bj = 0; bj < 2; ++bj) {
                        const size_t off = (size_t)(row0 + ai * HALF + m * 16) * 1024 + col0 + bj * HALF;
                        sn[m][bj] = *(const u32x4*)(gn + off); sd[m][bj] = *(const u32x4*)(gd + off);
                    }
#pragma unroll
                for (int m = 0; m < 4; ++m)
#pragma unroll
                    for (int bj = 0; bj < 2; ++bj) {
                        const u32x4 s = sn[m][bj], d = sd[m][bj];
                        f32x4 f0 = {bflo(s.x), bfhi(s.x), bflo(s.y), bfhi(s.y)}, f1 = {bflo(s.z), bfhi(s.z), bflo(s.w), bfhi(s.w)};
                        const f32x4 d0 = {bflo(d.x), bfhi(d.x), bflo(d.y), bfhi(d.y)}, d1 = {bflo(d.z), bfhi(d.z), bflo(d.w), bfhi(d.w)};
#pragma unroll
                        for (int e = 0; e < 4; ++e) { f0[e] *= __builtin_amdgcn_rcpf(d0[e]); f1[e] *= __builtin_amdgcn_rcpf(d1[e]); }
                        acc[ai][bj][m][0] = acc[ai][bj][m][0] * f0; acc[ai][bj][m][1] = acc[ai][bj][m][1] * f1;
                    }
            }
        } else {
#pragma unroll
            for (int ai = 0; ai < 2; ++ai) {
                if (u.half && ai != u.half - 1) continue;
                u32x4 sn[4][2];
#pragma unroll
                for (int m = 0; m < 4; ++m)
#pragma unroll
                    for (int bj = 0; bj < 2; ++bj) sn[m][bj] = *(const u32x4*)(gn + (size_t)(row0 + ai * HALF + m * 16) * 1024 + col0 + bj * HALF);
#pragma unroll
                for (int m = 0; m < 4; ++m)
#pragma unroll
                    for (int bj = 0; bj < 2; ++bj) {
                        const int row = row0 + ai * HALF + m * 16; const size_t off = (size_t)row * 1024 + col0 + bj * HALF;
                        const u32x4 s = sn[m][bj];
                        const f32x4 f0 = {bflo(s.x), bfhi(s.x), bflo(s.y), bfhi(s.y)}, f1 = {bflo(s.z), bfhi(s.z), bflo(s.w), bfhi(s.w)};
                        const f32x4 v0 = acc[ai][bj][m][0] * f0, v1 = acc[ai][bj][m][1] * f1;
                        u32x4 w; w.x = cvt_pk_bf16(v0[0], v0[1]); w.y = cvt_pk_bf16(v0[2], v0[3]); w.z = cvt_pk_bf16(v1[0], v1[1]); w.w = cvt_pk_bf16(v1[2], v1[3]);
                        *(u32x4*)((unsigned char*)(merged + off) + (row >= 8192 ? MERGED_HI_DELTA : 0)) = w;
                    }
            }
        }
    }
};
struct EpiResid {
    static constexpr bool PERM = true;
    bf16_t* xb; float* rowss_next;
    __device__ __forceinline__ bool keep(const Unit&) const { return false; }
    __device__ __forceinline__ void operator()(Acc& acc, const Unit& u, int wr, int wc, int fr, int fq) const {
        const int row0 = u.pm * BM + wr * 64 + fr, col0 = u.pn * BM + wc * 32 + 8 * fq;
#pragma unroll
        for (int ai = 0; ai < 2; ++ai) {
            if (u.half && ai != u.half - 1) continue;
            u32x4 ov[4][2];
#pragma unroll
            for (int m = 0; m < 4; ++m)
#pragma unroll
                for (int bj = 0; bj < 2; ++bj) ov[m][bj] = *(const u32x4*)(xb + (size_t)(row0 + ai * HALF + m * 16) * D + col0 + bj * HALF);
#pragma unroll
            for (int m = 0; m < 4; ++m) {
                const int row = row0 + ai * HALF + m * 16; float ss = 0.f;
#pragma unroll
                for (int bj = 0; bj < 2; ++bj) {
                    bf16_t* p = xb + (size_t)row * D + col0 + bj * HALF;
                    const u32x4 o = ov[m][bj];
                    const f32x4 v0 = (f32x4){bflo(o.x), bfhi(o.x), bflo(o.y), bfhi(o.y)} + acc[ai][bj][m][0], v1 = (f32x4){bflo(o.z), bfhi(o.z), bflo(o.w), bfhi(o.w)} + acc[ai][bj][m][1];
                    ss += ((v0[0] * v0[0] + v0[1] * v0[1]) + (v0[2] * v0[2] + v0[3] * v0[3])) + ((v1[0] * v1[0] + v1[1] * v1[1]) + (v1[2] * v1[2] + v1[3] * v1[3]));
                    u32x4 w; w.x = cvt_pk_bf16(v0[0], v0[1]); w.y = cvt_pk_bf16(v0[2], v0[3]); w.z = cvt_pk_bf16(v1[0], v1[1]); w.w = cvt_pk_bf16(v1[2], v1[3]);
                    *(u32x4*)p = w;
                }
                ss += __shfl_xor(ss, 16); ss += __shfl_xor(ss, 32); if (fq == 0) rowss_next[(size_t)row * 16 + u.pn * 4 + wc] = ss;
            }
        }
    }
};
template <bool MOE> struct EpiSwiglu {
    static constexpr bool PERM = true;
    bf16_t* act; int ld; const LAS float* rs_tab; const float* slot_scale; const float* slot_comb;
    __device__ __forceinline__ bool keep(const Unit&) const { return false; }
    __device__ __forceinline__ void operator()(Acc& acc, const Unit& u, int wr, int wc, int fr, int fq) const {
        const int row0 = u.pm * BM + wr * 64 + fr, col0 = u.pn * HALF + wc * 32 + 8 * fq;
        float rsv[2][4], cbv[2][4];
#pragma unroll
        for (int ai = 0; ai < 2; ++ai)
#pragma unroll
            for (int m = 0; m < 4; ++m) {
                if (MOE) { rsv[ai][m] = slot_scale[row0 + ai * HALF + m * 16]; cbv[ai][m] = slot_comb[row0 + ai * HALF + m * 16]; }
                else { rsv[ai][m] = rs_tab[wr * 64 + fr + ai * HALF + m * 16]; cbv[ai][m] = 1.f; }
            }
#pragma unroll
        for (int ai = 0; ai < 2; ++ai)
#pragma unroll
            for (int m = 0; m < 4; ++m) { if (u.half && ai != u.half - 1) continue;
                const int row = row0 + ai * HALF + m * 16;
                const float rs = rsv[ai][m], cb = cbv[ai][m];
                f32x4 o[2];
#pragma unroll
                for (int n = 0; n < 2; ++n) {
                    const f32x4 g = acc[ai][0][m][n] * rs, uu = acc[ai][1][m][n] * rs;
#pragma unroll
                    for (int e = 0; e < 4; ++e) o[n][e] = g[e] * fast_sigmoid(g[e]) * uu[e] * cb;
                }
                u32x4 w; w.x = cvt_pk_bf16(o[0][0], o[0][1]); w.y = cvt_pk_bf16(o[0][2], o[0][3]); w.z = cvt_pk_bf16(o[1][0], o[1][1]); w.w = cvt_pk_bf16(o[1][2], o[1][3]);
                *(u32x4*)(act + (size_t)row * ld + col0) = w;
            }
    }
};
struct EpiMoeDown {
    static constexpr bool PERM = true;
    bf16_t* y;
    __device__ __forceinline__ bool keep(const Unit&) const { return false; }
    __device__ __forceinline__ void operator()(Acc& acc, const Unit& u, int wr, int wc, int fr, int fq) const {
        const int row0 = u.pm * BM + wr * 64 + fr, col0 = u.pn * BM + wc * 32 + 8 * fq;
#pragma unroll
        for (int ai = 0; ai < 2; ++ai)
#pragma unroll
            for (int m = 0; m < 4; ++m) { if (u.half && ai != u.half - 1) continue;
                const int row = row0 + ai * HALF + m * 16;
#pragma unroll
                for (int bj = 0; bj < 2; ++bj) {
                    const f32x4 v0 = acc[ai][bj][m][0], v1 = acc[ai][bj][m][1];
                    u32x4 w; w.x = cvt_pk_bf16(v0[0], v0[1]); w.y = cvt_pk_bf16(v0[2], v0[3]); w.z = cvt_pk_bf16(v1[0], v1[1]); w.w = cvt_pk_bf16(v1[2], v1[3]);
                    *(u32x4*)(y + (size_t)row * D + col0 + bj * HALF) = w;
                }
            }
    }
};

struct SchedGrid {
    const char* A; const char* B; size_t a_tile, b_tile, a_alt; int nM, nN, G, c, alt_from; long long a_hi = 0;
    int split_from = 1 << 30;
    __device__ __forceinline__ bool next(int i, Unit& u) const {
        int L = i * G + c, hf = 0;
        if (L >= split_from) { const int nl = nM * nN - split_from, j = L - split_from; if (j >= 2 * nl) return false; hf = 1 + j / nl; L = split_from + j % nl; }
        if (L >= nM * nN) return false;
        int pm, pn; tile_map(L, nM, nN, pm, pn);
        u.pm = pm; u.pn = pn; u.kind = 0; u.half = hf; u.a = A + (size_t)pm * a_tile + (pn >= alt_from ? a_alt : 0) + (pm >= 32 ? a_hi : 0); u.b = B + (size_t)pn * b_tile; return true;
    }
};
struct SchedMerge {
    const char* acts; const char* wbr; int G, c;
    __device__ __forceinline__ bool next(int i, Unit& u) const {
        const int ti = i / 3, n = i - ti * 3, L = ti * G + c; if (L >= 256) return false;
        int pm, pn; tile_map(L, 64, 4, pm, pn);
        u.pm = pm; u.pn = pn; u.kind = n; u.half = 0; u.a = acts + ((long long)A_YSA + (long long)(n == 1) * ((long long)A_YSB - (long long)A_YSA) + (long long)(n == 2) * ((long long)A_POOLED - (long long)A_YSA)) + (size_t)pm * (256 * 512 * 2); u.b = wbr + (size_t)n * (1024 * 512 * 2) + (size_t)pn * (256 * 512 * 2); return true;
    }
};
struct SchedMoe {
    const char* A; const char* B; size_t a_tile, b_tile, b_exp; int MT, nN, G, c; int t1, t2, t3, t4, t5, t6, t7;
    int split_from = 1 << 30;
    __device__ __forceinline__ bool next(int i, Unit& u) const {
        int L = i * G + c, hf = 0;
        if (L >= split_from) { const int nl = MT * nN - split_from, j = L - split_from; if (j >= 2 * nl) return false; hf = 1 + j / nl; L = split_from + j % nl; }
        if (L >= MT * nN) return false;
        int pm, pn; tile_map(L, MT, nN, pm, pn);
        const int e = (pm >= t1) + (pm >= t2) + (pm >= t3) + (pm >= t4) + (pm >= t5) + (pm >= t6) + (pm >= t7);
        u.pm = pm; u.pn = pn; u.kind = e; u.half = hf; u.a = A + (size_t)pm * a_tile; u.b = B + (size_t)e * b_exp + (size_t)pn * b_tile; return true;
    }
};
}

#define XB_TMO      128
#define XB_XCNT(j)  (256  + 64 * (j))
#define XB_XSUB(j)  (1280 + 64 * (j))
#define XB_XGEN(j)  (2304 + 64 * (j))
#define XB_TOP      3328
#define XB_TOPGEN   3392
#define XCD_BAR_WORDS 3456
#define XB_SPIN_CAP (1u << 18)
__device__ __forceinline__ unsigned xb_ld(unsigned* p)              { return __hip_atomic_load(p, __ATOMIC_RELAXED, __HIP_MEMORY_SCOPE_AGENT); }
__device__ __forceinline__ unsigned xb_add(unsigned* p, unsigned v) { return __hip_atomic_fetch_add(p, v, __ATOMIC_RELAXED, __HIP_MEMORY_SCOPE_AGENT); }
__device__ __forceinline__ unsigned xb_xcc_id() { return (unsigned)__builtin_amdgcn_s_getreg((3 << 11) | 20) & 0xFu; }
#define XB_SPIN(cond, bar) do { unsigned _sp = 0; while (cond) { __builtin_amdgcn_s_sleep(1); \
    if ((++_sp & 255u) == 0u) { if (xb_ld(&(bar)[XB_TMO])) break; if (_sp > XB_SPIN_CAP) { atomicAdd(&(bar)[XB_TMO], 1u); break; } } } } while (0)
struct XcdBarrier { unsigned* bar; unsigned x; volatile LAS unsigned* st; };
__device__ __forceinline__ XcdBarrier xcd_barrier_post(unsigned* bar, volatile LAS unsigned* st) {
    XcdBarrier b; b.bar = bar; b.x = xb_xcc_id(); b.st = st;
    if (threadIdx.x == 0) (void)xb_add(&bar[XB_XCNT(b.x)], 1u);
    return b;
}
__device__ __forceinline__ void xcd_barrier_complete(unsigned* bar, unsigned x, unsigned& nloc, unsigned& nx) {
    const unsigned G = gridDim.x * gridDim.y * gridDim.z;
    unsigned sum, cnt, mine, sp = 0u;
    for (;;) {
        sum = 0u; cnt = 0u; mine = 0u;
#pragma unroll
        for (unsigned j = 0; j < 16; ++j) { const unsigned c = xb_ld(&bar[XB_XCNT(j)]); sum += c; cnt += (c > 0u) ? 1u : 0u; mine = (j == x) ? c : mine; }
        if (sum == G) break;
        __builtin_amdgcn_s_sleep(1);
        if ((++sp & 255u) == 0u) { if (xb_ld(&bar[XB_TMO])) break; if (sp > XB_SPIN_CAP) { atomicAdd(&bar[XB_TMO], 1u); break; } }
    }
    nloc = mine > 0u ? mine : 1u; nx = cnt > 0u ? cnt : 1u;
}
__device__ __forceinline__ void xcd_barrier(const XcdBarrier& b) {
    asm volatile("s_waitcnt vmcnt(0)" ::: "memory");
    __syncthreads();
    if (threadIdx.x == 0) {
        unsigned* bar = b.bar;
        __builtin_amdgcn_s_waitcnt(0);
        unsigned nloc = b.st[0], nx = b.st[1];
        if (nloc == 0u) { xcd_barrier_complete(bar, b.x, nloc, nx); b.st[0] = nloc; b.st[1] = nx; }
        const unsigned old = xb_add(&bar[XB_XSUB(b.x)], 1u);
        const unsigned gen = old / nloc;
        if (old + 1u == (gen + 1u) * nloc) {
            __builtin_amdgcn_fence(__ATOMIC_RELEASE, "agent");
            asm volatile("s_waitcnt vmcnt(0)" ::: "memory");
            const unsigned og = xb_add(&bar[XB_TOP], 1u);
            const unsigned tg = og / nx;
            if (og + 1u == (tg + 1u) * nx) xb_add(&bar[XB_TOPGEN], 1u);
            else XB_SPIN(xb_ld(&bar[XB_TOPGEN]) == tg, bar);
            __builtin_amdgcn_fence(__ATOMIC_ACQUIRE, "agent");
            xb_add(&bar[XB_XGEN(b.x)], 1u);
            asm volatile("s_waitcnt vmcnt(0)" ::: "memory");
        } else {
            XB_SPIN(xb_ld(&bar[XB_XGEN(b.x)]) == gen, bar);
            __builtin_amdgcn_fence(__ATOMIC_ACQUIRE, "agent");
            asm volatile("s_waitcnt vmcnt(0)" ::: "memory");
        }
    }
    __syncthreads();
}

struct Frame {
    LAS unsigned char* lds;
    volatile LAS unsigned* MISC;
    unsigned* ctl; float* ctlf; float* stats;
    unsigned char* ws;
    int tid, lane, wave, vcu, G;
    const CAS GPtr* inp;
    float* out;
    __device__ __forceinline__ const float* in(int i) const { return (const float*)inp[i]; }
};
enum { I_X = 0, I_POS, I_GMIX, I_WIN, I_GCQ, I_WUQ, I_GCKV, I_WUKV, I_GQKQ, I_GQKK, I_WGLA, I_BGLA, I_GGLAO, I_WPOOL, I_PSCALE, I_WBR, I_WOUT, I_GFFN, I_WFG, I_WFU, I_WFD, I_WROUTER, I_WEG, I_WEU, I_WED };

__device__ __forceinline__ bf16_t* act_ptr(const Frame& F, size_t off) { return (bf16_t*)(F.ws + WS_ACTS + off); }
__device__ __forceinline__ unsigned char* wblk(const Frame& F, int layer) { return F.ws + (layer == 0 ? WS_W0 : WS_W1); }

__device__ __forceinline__ void fill_rs(Frame& F, const float* rowss, int pm) {
    if (F.tid < 256) ((LAS float*)(F.lds + RS_OFF))[F.tid] = rsqrtf(sum16(rowss + ((size_t)pm * 256 + F.tid) * 16) * (1.f / 1024.f) + EPS);
    __syncthreads();
}
struct ConvSeg { const float* src; int ld, K, width, col0; bf16_t* dst; int row0, inter; const float* gain; };
typedef short v4i16c_t __attribute__((ext_vector_type(4)));
__device__ __forceinline__ int seg_items(const ConvSeg& s) { return (s.K >> 6) * ((s.width + 63) >> 6); }
__device__ __forceinline__ void conv_load(const ConvSeg& s, int item, int lane, f32x4 (&v)[16], float (&gv)[16]) {
    const int nblk = (s.width + 63) >> 6, kb = item / nblk, nb = item - kb * nblk, k0 = kb * 64, n0 = nb * 64;
    const int kq = lane >> 4, n4 = (lane & 15) * 4; const bool ok = n0 + n4 < s.width;
    const float* p = s.src + (size_t)(k0 + kq) * s.ld + s.col0 + n0 + n4;
#pragma unroll
    for (int i = 0; i < 16; ++i) v[i] = ok ? *(const f32x4*)(p + (size_t)(4 * i) * s.ld) : (f32x4){0.f, 0.f, 0.f, 0.f};
    const bool hg = s.gain != nullptr; const float* gp = hg ? s.gain + k0 + kq : s.src;
#pragma unroll
    for (int i = 0; i < 16; ++i) { const float g = gp[hg ? 4 * i : 0]; gv[i] = hg ? g : 1.f; }
}
__device__ __forceinline__ void conv_store(const ConvSeg& s, int item, LAS unsigned char* scr, int lane, const f32x4 (&v)[16], const float (&gv)[16]) {
    const int nblk = (s.width + 63) >> 6, kb = item / nblk, nb = item - kb * nblk, k0 = kb * 64, n0 = nb * 64;
    const int kq = lane >> 4, n4 = (lane & 15) * 4;
#pragma unroll
    for (int i = 0; i < 16; ++i) {
        const f32x4 x = v[i] * gv[i];
        *(LAS u32x2*)(scr + (4 * i + kq) * 136 + n4 * 2) = (u32x2){cvt_pk_bf16(x[0], x[1]), cvt_pk_bf16(x[2], x[3])};
    }
    LDS_WAIT();
    const int g = lane >> 4, i16 = lane & 15;
#pragma unroll
    for (int nb16 = 0; nb16 < 4; ++nb16)
#pragma unroll
        for (int kh = 0; kh < 2; ++kh) {
            const int c = kh * 4 + g;
            const LAS unsigned char* a = scr + (8 * c + (i16 >> 2)) * 136 + (nb16 * 16 + (i16 & 3) * 4) * 2;
            const v4i16c_t lo = __builtin_amdgcn_ds_read_tr16_b64_v4i16((LAS v4i16c_t*)a), hi = __builtin_amdgcn_ds_read_tr16_b64_v4i16((LAS v4i16c_t*)(a + 4 * 136));
            const int nq = n0 + nb16 * 16 + i16;
            if (nq < s.width) {
                const int drow = s.row0 + (s.inter ? ((nq >> 7) * 256 + (nq & 127)) : nq);
                typedef short s16x8_t __attribute__((ext_vector_type(8)));
                *(s16x8_t*)(s.dst + (size_t)drow * s.K + k0 + 8 * c) = (s16x8_t){lo[0], lo[1], lo[2], lo[3], hi[0], hi[1], hi[2], hi[3]};
            }
        }
    LDS_WAIT();
}
__device__ __forceinline__ ConvSeg mixer_seg(const Frame& F, int l, int idx) {
    unsigned char* wb = wblk(F, l);
    ConvSeg s; s.inter = 0; s.row0 = 0; s.col0 = 0;
    if (idx < 10) {
        int c0, wd, r0;
        switch (idx) {
            case 0: c0 = 0; wd = 256; r0 = 0; break;
            case 1: c0 = 256; wd = 256; r0 = 256; break;
            case 2: c0 = 544; wd = 256; r0 = 512; break;
            case 3: c0 = 800; wd = 256; r0 = 768; break;
            case 4: c0 = 1056; wd = 512; r0 = 1024; break;
            case 5: c0 = 1584; wd = 512; r0 = 1536; break;
            case 6: c0 = 2096; wd = 512; r0 = 2048; break;
            case 7: c0 = 512; wd = 32; r0 = 2560; break;
            case 8: c0 = 1568; wd = 16; r0 = 2592; break;
            default: c0 = 2608; wd = 3072; r0 = 0; break;
        }
        s.src = F.in(I_WIN) + (size_t)l * D * DIN; s.ld = DIN; s.K = D; s.width = wd; s.col0 = c0;
        s.dst = (bf16_t*)(wb + (idx == 9 ? WO_G : WO_IN)); s.row0 = r0; s.gain = F.in(I_GMIX) + l * D;
    } else if (idx == 10) { s.src = F.in(I_WUQ) + (size_t)l * 256 * 768; s.ld = 768; s.K = 256; s.width = 768; s.dst = (bf16_t*)(wb + WO_UP); s.gain = F.in(I_GCQ) + l * 256; }
    else if (idx == 11) { s.src = F.in(I_WUKV) + (size_t)l * 256 * 1024; s.ld = 1024; s.K = 256; s.width = 1024; s.dst = (bf16_t*)(wb + WO_UP); s.row0 = 768; s.gain = F.in(I_GCKV) + l * 256; }
    else if (idx < 14) { const int n = idx - 12; s.src = F.in(I_WBR) + (size_t)(l * 3 + n) * 512 * D; s.ld = D; s.K = 512; s.width = D; s.dst = (bf16_t*)(wb + WO_BR) + (size_t)n * 1024 * 512; s.gain = nullptr; }
    else { s.src = F.in(I_WOUT) + (size_t)l * D * D; s.ld = D; s.K = D; s.width = D; s.dst = (bf16_t*)(wb + WO_OUT); s.gain = nullptr; }
    return s;
}
__device__ __forceinline__ ConvSeg ffn_seg(const Frame& F, int idx) {
    unsigned char* wb = F.ws + WS_W0; ConvSeg s; s.col0 = 0; s.inter = 0; s.row0 = 0;
    if (idx < 2) { s.src = F.in(idx == 0 ? I_WFG : I_WFU); s.ld = DFF; s.K = D; s.width = DFF; s.dst = (bf16_t*)(wb + WO_FGU); s.row0 = idx * 128; s.inter = 1; s.gain = F.in(I_GFFN); }
    else { s.src = F.in(I_WFD); s.ld = D; s.K = DFF; s.width = D; s.dst = (bf16_t*)(wb + WO_FD); s.gain = nullptr; }
    return s;
}
__device__ __forceinline__ ConvSeg moe_seg(const Frame& F, int idx) {
    unsigned char* wb = F.ws + WS_W0; const int e = idx / 3, k = idx - e * 3; ConvSeg s; s.col0 = 0; s.inter = 0; s.row0 = 0;
    if (k < 2) { s.src = F.in(k == 0 ? I_WEG : I_WEU) + (size_t)e * D * DEXP; s.ld = DEXP; s.K = D; s.width = DEXP; s.dst = (bf16_t*)(wb + WO_MGU) + (size_t)e * 2816 * 1024; s.row0 = k * 128; s.inter = 1; s.gain = F.in(I_GFFN) + D; }
    else { s.src = F.in(I_WED) + (size_t)e * DEXP * D; s.ld = D; s.K = DEXP; s.width = D; s.dst = (bf16_t*)(wb + WO_MD) + (size_t)e * 1024 * 1408; s.gain = nullptr; }
    return s;
}
#define CONV_LOCATE(NSEG, GETSEG, IT, SEGOUT, IDXOUT) do { int r_ = (IT); for (int si_ = 0; si_ < (NSEG); ++si_) { const ConvSeg sg_ = GETSEG; const int n_ = seg_items(sg_); SEGOUT = sg_; IDXOUT = r_; if (r_ < n_) break; r_ -= n_; } } while (0)
#define CONV_LOOP(NSEG, GETSEG) do { int total_ = 0; for (int si_ = 0; si_ < (NSEG); ++si_) { const ConvSeg sg_ = GETSEG; total_ += seg_items(sg_); } \
        int it_ = gw; if (it_ < total_) { ConvSeg cs_; int ci_ = 0; f32x4 va_[16]; float ga_[16]; CONV_LOCATE(NSEG, GETSEG, it_, cs_, ci_); conv_load(cs_, ci_, F.lane, va_, ga_); \
        for (;;) { const int nx_ = it_ + NGW; const bool hn_ = nx_ < total_; ConvSeg ns_; int ni_ = 0; f32x4 vb_[16]; float gb_[16]; CONV_LOCATE(NSEG, GETSEG, (hn_ ? nx_ : it_), ns_, ni_); conv_load(ns_, ni_, F.lane, vb_, gb_); \
            _Pragma("unroll") for (int q_ = 0; q_ < 16; ++q_) { asm volatile("" : "+v"(va_[q_])); asm volatile("" : "+v"(ga_[q_])); } \
            conv_store(cs_, ci_, (LAS unsigned char*)scr, F.lane, va_, ga_); if (!hn_) break; \
            _Pragma("unroll") for (int q_ = 0; q_ < 16; ++q_) { va_[q_] = vb_[q_]; ga_[q_] = gb_[q_]; } cs_ = ns_; ci_ = ni_; it_ = nx_; } } } while (0)
__device__ __forceinline__ void fold_pool(const Frame& F, int l, int gw, int NGW) {
    const float* wp = F.in(I_WPOOL) + (size_t)l * 4 * 128 * 128; const float* ps = F.in(I_PSCALE) + l * 512; const float* wb2 = F.in(I_WBR) + (size_t)(l * 3 + 2) * 512 * D;
    bf16_t* dst = (bf16_t*)(wblk(F, l) + WO_BR) + (size_t)2 * 1024 * 512;
    LAS float* sw = (LAS float*)(F.lds + F.wave * 16384);
    for (int it = gw; it < 1024; it += NGW) {
        const int db = it & 15, g = (it >> 4) & 3, cb = it >> 6, d = db * 64 + F.lane, c0 = cb * 8;
        {
            const float* wrow = wp + (size_t)(g * 128 + c0) * 128 + F.lane * 16;
            const f32x4 r0 = *(const f32x4*)wrow, r1 = *(const f32x4*)(wrow + 4), r2 = *(const f32x4*)(wrow + 8), r3 = *(const f32x4*)(wrow + 12);
            const float p0 = ps[g * 128 + 2 * F.lane], p1 = ps[g * 128 + 2 * F.lane + 1];
            LAS f32x4* o = (LAS f32x4*)(sw + F.lane * 16); o[0] = r0; o[1] = r1; o[2] = r2; o[3] = r3;
            sw[1024 + 2 * F.lane] = p0; sw[1024 + 2 * F.lane + 1] = p1;
        }
        LDS_WAIT();
        float a[8];
#pragma unroll
        for (int i = 0; i < 8; ++i) a[i] = 0.f;
#pragma unroll 1
        for (int j0 = 0; j0 < 128; j0 += 16) {
            float wv[16];
#pragma unroll
            for (int jj = 0; jj < 16; ++jj) wv[jj] = wb2[(size_t)(g * 128 + j0 + jj) * D + d];
#pragma unroll
            for (int jj = 0; jj < 16; ++jj) asm volatile("" : "+v"(wv[jj]));
#pragma unroll
            for (int j4 = 0; j4 < 16; j4 += 4) {
                const f32x4 sc = *(const LAS f32x4*)(sw + 1024 + j0 + j4);
                f32x4 w4;
#pragma unroll
                for (int e = 0; e < 4; ++e) w4[e] = wv[j4 + e] * sc[e];
#pragma unroll
                for (int i = 0; i < 8; ++i) {
                    const f32x4 pr = *(const LAS f32x4*)(sw + i * 128 + j0 + j4);
#pragma unroll
                    for (int e = 0; e < 4; ++e) a[i] = fmaf(pr[e], w4[e], a[i]);
                }
            }
        }
        u32x4 o; o.x = cvt_pk_bf16(a[0], a[1]); o.y = cvt_pk_bf16(a[2], a[3]); o.z = cvt_pk_bf16(a[4], a[5]); o.w = cvt_pk_bf16(a[6], a[7]);
        *(u32x4*)(dst + (size_t)d * 512 + g * 128 + c0) = o;
        LDS_WAIT();
    }
}

__device__ __forceinline__ void p0_prologue(Frame& F) {
    LAS float* scr = (LAS float*)(F.lds + F.wave * 16384);
    const int gw = F.vcu * 8 + F.wave, NGW = F.G * 8;
    { bf16_t* xb = (bf16_t*)(F.ws + WS_XB); float* rss = F.stats + SF_ROWSS;
      for (int m0 = gw; m0 < T; m0 += 4 * NGW) {
          f32x4 v[4][4];
#pragma unroll
          for (int r = 0; r < 4; ++r) { const int m = m0 + r * NGW < T ? m0 + r * NGW : m0; const f32x4* xr = (const f32x4*)(F.in(I_X) + (size_t)m * D) + F.lane;
#pragma unroll
              for (int j = 0; j < 4; ++j) v[r][j] = xr[64 * j]; }
#pragma unroll
          for (int r = 0; r < 4; ++r)
#pragma unroll
              for (int j = 0; j < 4; ++j) asm volatile("" : "+v"(v[r][j]));
#pragma unroll
          for (int r = 0; r < 4; ++r) { const int m = m0 + r * NGW; if (m >= T) break; float s = 0.f;
              unsigned long long* o8 = (unsigned long long*)(xb + (size_t)m * D) + F.lane;
#pragma unroll
              for (int j = 0; j < 4; ++j) { const f32x4 w = v[r][j]; s += (w[0] * w[0] + w[1] * w[1]) + (w[2] * w[2] + w[3] * w[3]);
                  o8[64 * j] = (unsigned long long)cvt_pk_bf16(w[0], w[1]) | ((unsigned long long)cvt_pk_bf16(w[2], w[3]) << 32); }
              s = wave_sum(s); if (F.lane < 16) rss[(size_t)m * 16 + F.lane] = (F.lane == 0) ? s : 0.f; }
      } }
    { float* rt = (float*)(F.ws + WS_ROPE); const int* pos = (const int*)F.in(I_POS);
      for (int i = F.vcu * 512 + F.tid; i < T * 16; i += F.G * 512) {
          const int t = i >> 4, k = i & 15; const float inv = powf(10000.f, -(float)k / 16.f), ang = (float)pos[t] * inv;
          rt[t * 32 + k] = cosf(ang); rt[t * 32 + 16 + k] = sinf(ang);
      } }
    CONV_LOOP(15, mixer_seg(F, 0, si_));
    fold_pool(F, 0, gw, NGW);
}

__device__ __forceinline__ void gla_prep(Frame& F, int l, int unit);
__device__ __forceinline__ void phase_prep(Frame& F, int l, int rpt = 0) {
    const bf16_t* raw = act_ptr(F, A_QKVRAW); const bf16_t* misc = act_ptr(F, A_MISC);
    bf16_t* QH = act_ptr(F, A_QH); bf16_t* KH = act_ptr(F, A_KH); bf16_t* VT = act_ptr(F, A_VT);
    const float* rope = (const float*)(F.ws + WS_ROPE);
    const float* gq = F.in(I_GQKQ) + l * 96; const float* gk = F.in(I_GQKK) + l * 96;
    LAS bf16_t* vt = (LAS bf16_t*)F.lds;
    for (int unit = F.vcu; unit < T / 64; unit += F.G) {
        const int t0 = unit * 64, b = t0 / SEQ, s0 = t0 % SEQ;
        if (!rpt) gla_prep(F, l, unit);
#pragma unroll 1
        for (int it = F.tid; it < 1024; it += 512) {
            const int which = it & 1, h = (it >> 1) & 7, tok = it >> 4, t = t0 + tok;
            const bf16_t* nope = raw + (size_t)t * 1792 + (which ? 768 + h * 128 : h * 96);
            const bf16_t* rp = which ? misc + (size_t)t * 256 : nope + 64;
            const float* g = which ? gk : gq;
            u32x4 c[12];
#pragma unroll
            for (int i = 0; i < 8; ++i) c[i] = *(const u32x4*)(nope + 8 * i);
#pragma unroll
            for (int i = 0; i < 4; ++i) c[8 + i] = *(const u32x4*)(rp + 8 * i);
            float ss = 0.f;
#pragma unroll
            for (int i = 0; i < 12; ++i) {
                const float a0 = bflo(c[i].x), a1 = bfhi(c[i].x), a2 = bflo(c[i].y), a3 = bfhi(c[i].y), a4 = bflo(c[i].z), a5 = bfhi(c[i].z), a6 = bflo(c[i].w), a7 = bfhi(c[i].w);
                ss += (a0 * a0 + a1 * a1) + (a2 * a2 + a3 * a3) + (a4 * a4 + a5 * a5) + (a6 * a6 + a7 * a7);
            }
            float r = rsqrtf(ss * (1.f / 96.f) + EPS);
            if (!which) r *= 0.14724444f;
            bf16_t* dst = (which ? KH : QH) + ((size_t)(b * 8 + h) * SEQ + s0 + tok) * 96;
#pragma unroll
            for (int i = 0; i < 8; ++i) {
                const f32x4 g0 = *(const f32x4*)(g + 8 * i), g1 = *(const f32x4*)(g + 8 * i + 4);
                u32x4 o; o.x = cvt_pk_bf16(bflo(c[i].x) * r * g0[0], bfhi(c[i].x) * r * g0[1]); o.y = cvt_pk_bf16(bflo(c[i].y) * r * g0[2], bfhi(c[i].y) * r * g0[3]);
                o.z = cvt_pk_bf16(bflo(c[i].z) * r * g1[0], bfhi(c[i].z) * r * g1[1]); o.w = cvt_pk_bf16(bflo(c[i].w) * r * g1[2], bfhi(c[i].w) * r * g1[3]);
                *(u32x4*)(dst + 8 * i) = o;
            }
#pragma unroll
            for (int hh = 0; hh < 2; ++hh) {
                const u32x4 x1c = c[8 + hh], x2c = c[10 + hh];
                float x1[8] = {bflo(x1c.x), bfhi(x1c.x), bflo(x1c.y), bfhi(x1c.y), bflo(x1c.z), bfhi(x1c.z), bflo(x1c.w), bfhi(x1c.w)};
                float x2[8] = {bflo(x2c.x), bfhi(x2c.x), bflo(x2c.y), bfhi(x2c.y), bflo(x2c.z), bfhi(x2c.z), bflo(x2c.w), bfhi(x2c.w)};
                float o1[8], o2[8];
#pragma unroll
                for (int i = 0; i < 8; ++i) {
                    const int k = hh * 8 + i; const float cs = rope[(size_t)t * 32 + k], sn = rope[(size_t)t * 32 + 16 + k];
                    const float a = x1[i] * r * g[64 + k], bb = x2[i] * r * g[80 + k];
                    o1[i] = a * cs - bb * sn; o2[i] = bb * cs + a * sn;
                }
                u32x4 w1, w2; w1.x = cvt_pk_bf16(o1[0], o1[1]); w1.y = cvt_pk_bf16(o1[2], o1[3]); w1.z = cvt_pk_bf16(o1[4], o1[5]); w1.w = cvt_pk_bf16(o1[6], o1[7]);
                w2.x = cvt_pk_bf16(o2[0], o2[1]); w2.y = cvt_pk_bf16(o2[2], o2[3]); w2.z = cvt_pk_bf16(o2[4], o2[5]); w2.w = cvt_pk_bf16(o2[6], o2[7]);
                *(u32x4*)(dst + 64 + hh * 8) = w1; *(u32x4*)(dst + 80 + hh * 8) = w2;
            }
        }
        {
            const int tok = F.tid >> 3, cc = F.tid & 7;
            u32x4 vr[8];
#pragma unroll
            for (int h = 0; h < 8; ++h) vr[h] = *(const u32x4*)(raw + (size_t)(t0 + tok) * 1792 + 768 + h * 128 + 64 + cc * 8);
#pragma unroll
            for (int h = 0; h < 8; ++h) *(LAS u32x4*)(F.lds + h * 9216 + tok * 144 + cc * 16) = vr[h];
            __syncthreads();
            const int db = F.wave & 3, c = (F.wave >> 2) * 4 + (F.lane >> 4), i16 = F.lane & 15;
#pragma unroll
            for (int h = 0; h < 8; ++h) {
                const LAS unsigned char* a = F.lds + h * 9216 + (8 * c + (i16 >> 2)) * 144 + (16 * db + (i16 & 3) * 4) * 2;
                const v4i16c_t lo = __builtin_amdgcn_ds_read_tr16_b64_v4i16((LAS v4i16c_t*)a), hi = __builtin_amdgcn_ds_read_tr16_b64_v4i16((LAS v4i16c_t*)(a + 4 * 144));
                typedef short s16x8_t __attribute__((ext_vector_type(8)));
                bf16_t* vrow = VT + (((size_t)(b * 8 + h) * (SEQ / 64) + (s0 >> 6)) * 64 + 16 * db + i16) * 64;
                *(v4i16c_t*)(vrow + 4 * c) = lo; *(v4i16c_t*)(vrow + 32 + 4 * c) = hi;
            }
            __syncthreads();
        }
    }
}

constexpr int AT_KROW = 208, AT_KT = 64 * AT_KROW, AT_VROW = 144, AT_VTB = 64 * AT_VROW, AT_SLOT = AT_KT + AT_VTB, AT_NSLOT = 5, AT_DUMMY = AT_NSLOT * AT_SLOT;
static_assert(AT_KT == 13 * 1024 && AT_VTB == 9 * 1024 && AT_DUMMY + 8 * 1024 <= RING_BYTES, "attention ring");
#ifdef AT_TPROBE
#define TP_B(k) do { if (AT_TPROBE == (k)) tp0 = __builtin_readcyclecounter(); } while (0)
#define TP_E(k) do { if (AT_TPROBE == (k)) tpacc += __builtin_readcyclecounter() - tp0; } while (0)
#else
#define TP_B(k) do {} while (0)
#define TP_E(k) do {} while (0)
#endif
__device__ __forceinline__ void attn_unit(Frame& F, int bh, int qb, unsigned long long& tpacc) {
#ifdef AT_TPROBE
    unsigned long long tp0 = 0;
#endif
    TP_B(0);
    const int lane = F.lane, wid = F.wave, r32 = lane & 31, hi = lane >> 5, grp = wid >> 2;
    const bf16_t* QHp = act_ptr(F, A_QH) + ((size_t)bh * SEQ + qb * 256 + wid * 32) * 96;
    const char* Kb = (const char*)(act_ptr(F, A_KH) + (size_t)bh * SEQ * 96);
    const char* Vb = (const char*)(act_ptr(F, A_VT) + (size_t)bh * 64 * SEQ);
    LAS unsigned char* lds = F.lds;
    bf16x8 qr[6];
#pragma unroll
    for (int s = 0; s < 6; ++s) qr[s] = *(const bf16x8*)(QHp + (size_t)r32 * 96 + 16 * s + 8 * hi);
    const int NT = 4 * (qb + 1);
    const char *dp0, *dp1, *dp2;
    { const int P = 64 * wid + lane, row = P / 13, col = P % 13; dp0 = Kb + row * 192 + (col == 12 ? 0 : col) * 16; }
    if (wid < 5) { const int P = 64 * (wid + 8) + lane, row = P / 13, col = P % 13; dp1 = Kb + row * 192 + (col == 12 ? 0 : col) * 16; }
    else { const int P = 64 * (wid - 5) + lane, d = P / 9, col = P % 9; dp1 = Vb + d * 128 + (col == 8 ? 0 : col) * 16; }
    { const int P = 64 * (wid + 3) + lane, d = (P / 9) & 63, col = P % 9; dp2 = Vb + d * 128 + (col == 8 ? 0 : col) * 16; }
    const unsigned st1 = wid < 5 ? 12288u : 8192u;
    const bool w3 = wid < 6;
#define AT_DMA_ONE(j, sl) do { const int sl_ = (sl); LAS unsigned char* d_ = lds + sl_ + wid * 1024; const int c1_ = sl_ == AT_DUMMY ? 0 : 8192; \
        __builtin_amdgcn_global_load_lds((const unsigned*)(dp0 + (size_t)(j) * 12288), (LAS unsigned*)d_, 16, 0, 0); \
        __builtin_amdgcn_global_load_lds((const unsigned*)(dp1 + (size_t)(j) * st1), (LAS unsigned*)(d_ + c1_), 16, 0, 0); \
        if (w3) __builtin_amdgcn_global_load_lds((const unsigned*)(dp2 + (size_t)(j) * 8192), (LAS unsigned*)(d_ + 2 * c1_), 16, 0, 0); } while (0)
#ifdef AT_PROBE_DMA2
#define AT_DMA(j, sl) do { AT_DMA_ONE(j, sl); AT_DMA_ONE(j, sl); } while (0)
#define AT_WAIT2() do { if (w3) asm volatile("s_waitcnt vmcnt(12)" ::: "memory"); else asm volatile("s_waitcnt vmcnt(8)" ::: "memory"); } while (0)
#else
#define AT_DMA(j, sl) AT_DMA_ONE(j, sl)
#define AT_WAIT2() do { if (w3) asm volatile("s_waitcnt vmcnt(6)" ::: "memory"); else asm volatile("s_waitcnt vmcnt(4)" ::: "memory"); } while (0)
#endif
#define AT_WAIT1() do { if (w3) asm volatile("s_waitcnt vmcnt(3)" ::: "memory"); else asm volatile("s_waitcnt vmcnt(2)" ::: "memory"); } while (0)
#define AT_WAIT_NEXT(t) do { if ((t) + 3 < NT) AT_WAIT2(); else if ((t) + 3 == NT) AT_WAIT1(); else VM_WAIT(); } while (0)
    AT_DMA(0, 0); AT_DMA(1, AT_SLOT); AT_DMA(2, 2 * AT_SLOT); AT_DMA(3, 3 * AT_SLOT);
#ifdef AT_PROBE_DMA2
    if (w3) asm volatile("s_waitcnt vmcnt(18)" ::: "memory"); else asm volatile("s_waitcnt vmcnt(12)" ::: "memory");
#else
    if (w3) asm volatile("s_waitcnt vmcnt(9)" ::: "memory"); else asm volatile("s_waitcnt vmcnt(6)" ::: "memory");
#endif
    LDS_BARRIER();
    float m_run = 0.f, l_run = 0.f;
    f32x16 o0, o1, negm;
#pragma unroll
    for (int r = 0; r < 16; ++r) { o0[r] = 0.f; o1[r] = 0.f; negm[r] = 0.f; }
    const unsigned kfr = (unsigned)(r32 * AT_KROW + hi * 16), vfr = (unsigned)(AT_KT + r32 * AT_VROW + hi * 64);
    if (grp) LDS_BARRIER();
    int slot = 0, wslot = 4;
    const int NTw = 4 * qb + (wid >> 1) + 1;
    TP_B(1);
    for (int t = 0; t < NTw; ++t) {
        const int jb = t - 4 * qb;
        const LAS unsigned char* sb = lds + slot * AT_SLOT;
        f32x16 p0, p1;
        TP_B(2);
        {
            const LAS unsigned char* kb = sb + kfr;
            bf16x8 ka[6], kc[6];
#pragma unroll
            for (int s = 0; s < 6; ++s) { ka[s] = *(const LAS bf16x8*)(kb + s * 32); kc[s] = *(const LAS bf16x8*)(kb + 32 * AT_KROW + s * 32); }
            __builtin_amdgcn_sched_barrier(0);
            __builtin_amdgcn_s_setprio(1);
            p0 = __builtin_amdgcn_mfma_f32_32x32x16_bf16(ka[0], qr[0], negm, 0, 0, 0);
            p1 = __builtin_amdgcn_mfma_f32_32x32x16_bf16(kc[0], qr[0], negm, 0, 0, 0);
#pragma unroll
            for (int s = 1; s < 6; ++s) {
                p0 = __builtin_amdgcn_mfma_f32_32x32x16_bf16(ka[s], qr[s], p0, 0, 0, 0);
                p1 = __builtin_amdgcn_mfma_f32_32x32x16_bf16(kc[s], qr[s], p1, 0, 0, 0);
            }
            __builtin_amdgcn_s_setprio(0);
#ifdef AT_PROBE_SEG1X2
            asm volatile("" : "+v"(p0), "+v"(p1));
            p0 = __builtin_amdgcn_mfma_f32_32x32x16_bf16(ka[0], qr[0], negm, 0, 0, 0);
            p1 = __builtin_amdgcn_mfma_f32_32x32x16_bf16(kc[0], qr[0], negm, 0, 0, 0);
#pragma unroll
            for (int s = 1; s < 6; ++s) {
                p0 = __builtin_amdgcn_mfma_f32_32x32x16_bf16(ka[s], qr[s], p0, 0, 0, 0);
                p1 = __builtin_amdgcn_mfma_f32_32x32x16_bf16(kc[s], qr[s], p1, 0, 0, 0);
            }
#endif
            asm volatile("" : "+v"(p0), "+v"(p1));
        }
        TP_E(2);
        TP_B(3);
        AT_WAIT2();
        TP_E(3);
        TP_B(4);
        LDS_BARRIER();
        TP_E(4);
        AT_DMA(min(t + 4, NT - 1), t + 4 < NT ? wslot * AT_SLOT : AT_DUMMY);
        TP_B(5);
        {
            const LAS unsigned char* vb = sb + vfr;
            bf16x8 va[4], vc2[4];
#pragma unroll
            for (int s = 0; s < 4; ++s) { va[s] = *(const LAS bf16x8*)(vb + s * 16); vc2[s] = *(const LAS bf16x8*)(vb + 32 * AT_VROW + s * 16); }
            if (jb >= 0 && wid < 2 * jb + 2) {
                const int qrel = 32 * wid + r32, kb0 = 64 * jb + 4 * hi;
#pragma unroll
                for (int r = 0; r < 16; ++r) { const int kv = kb0 + (r & 3) + 8 * (r >> 2); if (kv > qrel) p0[r] = -INFINITY; if (kv + 32 > qrel) p1[r] = -INFINITY; }
            }
            float mxa = __builtin_elementwise_maximum(p0[0], p0[1]), mxb = __builtin_elementwise_maximum(p1[0], p1[1]);
#pragma unroll
            for (int r = 2; r < 16; r += 2) {
                mxa = __builtin_elementwise_maximum(__builtin_elementwise_maximum(mxa, p0[r]), p0[r + 1]);
                mxb = __builtin_elementwise_maximum(__builtin_elementwise_maximum(mxb, p1[r]), p1[r + 1]);
            }
            float mx = __builtin_elementwise_maximum(mxa, mxb);
            {
                const u32x2 sw = __builtin_amdgcn_permlane32_swap(__float_as_uint(mx), __float_as_uint(mx), false, false);
                mx = __builtin_elementwise_maximum(__uint_as_float(sw.x), __uint_as_float(sw.y));
            }
            if (t == 0 || !__all(mx <= 8.f)) {
                const float delta = t == 0 ? mx : fmaxf(mx, 0.f), alpha = t == 0 ? 1.f : __builtin_amdgcn_exp2f(-delta);
                m_run += delta; l_run *= alpha;
#pragma unroll
                for (int r = 0; r < 16; ++r) { o0[r] *= alpha; o1[r] *= alpha; p0[r] -= delta; p1[r] -= delta; negm[r] = -m_run; }
            }
            float ps = 0.f;
#pragma unroll
            for (int r = 0; r < 16; ++r) { p0[r] = __builtin_amdgcn_exp2f(p0[r]); p1[r] = __builtin_amdgcn_exp2f(p1[r]); ps += p0[r]; ps += p1[r]; }
            l_run += ps;
#pragma unroll
            for (int s = 0; s < 4; ++s) {
                u32x4 pw;
                if (s < 2) { pw.x = cvt_pk_bf16(p0[8 * s + 0], p0[8 * s + 1]); pw.y = cvt_pk_bf16(p0[8 * s + 2], p0[8 * s + 3]); pw.z = cvt_pk_bf16(p0[8 * s + 4], p0[8 * s + 5]); pw.w = cvt_pk_bf16(p0[8 * s + 6], p0[8 * s + 7]); }
                else { const int q = s - 2; pw.x = cvt_pk_bf16(p1[8 * q + 0], p1[8 * q + 1]); pw.y = cvt_pk_bf16(p1[8 * q + 2], p1[8 * q + 3]); pw.z = cvt_pk_bf16(p1[8 * q + 4], p1[8 * q + 5]); pw.w = cvt_pk_bf16(p1[8 * q + 6], p1[8 * q + 7]); }
                const bf16x8 pb = __builtin_bit_cast(bf16x8, pw);
                o0 = __builtin_amdgcn_mfma_f32_32x32x16_bf16(va[s], pb, o0, 0, 0, 0);
                o1 = __builtin_amdgcn_mfma_f32_32x32x16_bf16(vc2[s], pb, o1, 0, 0, 0);
            }
        }
        TP_E(5);
        TP_B(6);
        LDS_BARRIER();
        TP_E(6);
        slot = slot == AT_NSLOT - 1 ? 0 : slot + 1; wslot = wslot == AT_NSLOT - 1 ? 0 : wslot + 1;
    }
    TP_E(1);
    for (int t = NTw; t < NT; ++t) {
        AT_WAIT2();
        LDS_BARRIER();
        AT_DMA(min(t + 4, NT - 1), t + 4 < NT ? wslot * AT_SLOT : AT_DUMMY);
        LDS_BARRIER();
        wslot = wslot == AT_NSLOT - 1 ? 0 : wslot + 1;
    }
    if (!grp) LDS_BARRIER();
    VM_WAIT();
#undef AT_DMA
#undef AT_DMA_ONE
#undef AT_WAIT2
#undef AT_WAIT1
#undef AT_WAIT_NEXT
    l_run += __shfl_xor(l_run, 32);
    const float inv = 1.f / l_run;
    const int b = bh >> 3, h = bh & 7;
    bf16_t* orow = act_ptr(F, A_YSA) + ((size_t)b * SEQ + qb * 256 + wid * 32 + r32) * 512 + h * 64;
#pragma unroll
    for (int g = 0; g < 4; ++g) {
        u32x2 w0, w1;
        w0.x = cvt_pk_bf16(o0[4 * g] * inv, o0[4 * g + 1] * inv); w0.y = cvt_pk_bf16(o0[4 * g + 2] * inv, o0[4 * g + 3] * inv);
        w1.x = cvt_pk_bf16(o1[4 * g] * inv, o1[4 * g + 1] * inv); w1.y = cvt_pk_bf16(o1[4 * g + 2] * inv, o1[4 * g + 3] * inv);
#ifdef AT_WT_STORE
        asm volatile("global_store_dwordx2 %0, %1, off sc0 sc1" :: "v"(orow + 8 * g + 4 * hi), "v"(w0) : "memory");
        asm volatile("global_store_dwordx2 %0, %1, off sc0 sc1" :: "v"(orow + 32 + 8 * g + 4 * hi), "v"(w1) : "memory");
#else
        *(u32x2*)(orow + 8 * g + 4 * hi) = w0; *(u32x2*)(orow + 32 + 8 * g + 4 * hi) = w1;
#endif
    }
    TP_E(0);
}

__device__ __forceinline__ float row16_sum(float x) {
    x += __int_as_float(__builtin_amdgcn_update_dpp(0, __float_as_int(x), 0x128, 0xf, 0xf, false));
    x += __int_as_float(__builtin_amdgcn_update_dpp(0, __float_as_int(x), 0x124, 0xf, 0xf, false));
    x += __int_as_float(__builtin_amdgcn_update_dpp(0, __float_as_int(x), 0x122, 0xf, 0xf, false));
    x += __int_as_float(__builtin_amdgcn_update_dpp(0, __float_as_int(x), 0x121, 0xf, 0xf, false));
    return x;
}
__device__ __forceinline__ unsigned short f2bf1(float x) { return (unsigned short)(cvt_pk_bf16(x, 0.f) & 0xffffu); }
__device__ __forceinline__ void gla_prep(Frame& F, int l, int unit) {
    bf16_t* gqkv = act_ptr(F, A_GQKV); const bf16_t* misc = act_ptr(F, A_MISC); float* eb = F.stats + SF_EB;
    const int c = F.tid & 255, ch = unit * 2 + (F.tid >> 8);
    const float* wg = F.in(I_WGLA) + (size_t)l * 16 * 256 + c; const float bias = F.in(I_BGLA)[l * 256 + c];
    float wcol[16];
#pragma unroll
    for (int r = 0; r < 16; ++r) wcol[r] = wg[r * 256];
    float bc = 0.f;
#pragma unroll 1
    for (int i0 = 0; i0 < 32; i0 += 8) {
        u32x4 l0[8], l1[8]; unsigned qv[8], kv[8];
#pragma unroll
        for (int i = 0; i < 8; ++i) {
            const size_t t = (size_t)ch * 32 + i0 + i;
            l0[i] = *(const u32x4*)(misc + t * 256 + 32); l1[i] = *(const u32x4*)(misc + t * 256 + 40);
            qv[i] = *(const unsigned short*)(gqkv + t * 1024 + c); kv[i] = *(const unsigned short*)(gqkv + t * 1024 + c + 256);
        }
#pragma unroll
        for (int i = 0; i < 8; ++i) asm volatile("" : "+v"(qv[i]), "+v"(kv[i]));
        unsigned short qo[8], ko[8];
#pragma unroll
        for (int i = 0; i < 8; ++i) {
            const float lr[16] = {bflo(l0[i].x), bfhi(l0[i].x), bflo(l0[i].y), bfhi(l0[i].y), bflo(l0[i].z), bfhi(l0[i].z), bflo(l0[i].w), bfhi(l0[i].w),
                                  bflo(l1[i].x), bfhi(l1[i].x), bflo(l1[i].y), bfhi(l1[i].y), bflo(l1[i].z), bfhi(l1[i].z), bflo(l1[i].w), bfhi(l1[i].w)};
            float z = bias;
#pragma unroll
            for (int r = 0; r < 16; ++r) z = fmaf(lr[r], wcol[r], z);
            const float zl = z * 1.4426950408889634f;
            const float sp = fmaxf(-zl, 0.f) + __log2f(1.f + __builtin_amdgcn_exp2f(-fabsf(zl)));
            bc -= sp * 0.0625f;
            const float eq = __builtin_amdgcn_exp2f(bc) * 0.125f, ek = __builtin_amdgcn_exp2f(-bc);
            qo[i] = f2bf1(__uint_as_float(qv[i] << 16) * eq);
            ko[i] = f2bf1(__uint_as_float(kv[i] << 16) * ek);
        }
#pragma unroll
        for (int i = 0; i < 8; ++i) {
            const size_t t = (size_t)ch * 32 + i0 + i;
            *(unsigned short*)(gqkv + t * 1024 + c) = qo[i]; *(unsigned short*)(gqkv + t * 1024 + c + 256) = ko[i];
        }
    }
    eb[(size_t)ch * 256 + c] = __builtin_amdgcn_exp2f(bc);
}
typedef short v4i16_t __attribute__((ext_vector_type(4)));
__device__ __forceinline__ v4i16_t lds_tr16(const LAS unsigned char* p) { return __builtin_amdgcn_ds_read_tr16_b64_v4i16((LAS v4i16_t*)p); }
constexpr int GW_K = 0, GW_Q = 4608, GW_V = 9216, GW_BYTES = 10240;
__device__ __forceinline__ void gla_unit(Frame& F, int l, int unit) {
    const int half = unit & 1, h = (unit >> 1) & 3, b = unit >> 3;
    volatile LAS int* prog = (volatile LAS int*)(F.lds + 4 * GW_BYTES);
    if (F.wave >= 4) {
        const int pw = F.wave - 4, tok = F.lane & 31, li = (F.lane >> 5) + 2 * (pw & 1);
        const size_t lo_ = (li == 0) ? (size_t)h * 128 : (li == 1) ? (size_t)512 + h * 128 : (li == 2) ? (size_t)1024 + h * 256 + half * 128 : (size_t)1024 + h * 256 + half * 128 + 64;
        const unsigned char* base_ = (const unsigned char*)act_ptr(F, A_GQKV) + lo_;
        unsigned keep = 0u;
        for (int m = (pw >> 1); m < SEQ / 32; m += 2) {
            while (m > prog[0] + 8) __builtin_amdgcn_s_sleep(8);
            const unsigned char* pp = base_ + ((size_t)b * SEQ + (size_t)m * 32 + tok) * 2048;
            asm volatile("global_load_dword %0, %1, off" : "+v"(keep) : "v"(pp) : "memory");
        }
        asm volatile("s_waitcnt vmcnt(0)" : "+v"(keep) :: "memory");
        return;
    }
    const int lane = F.lane, w = half * 4 + F.wave, l15 = lane & 15, q4 = lane >> 4;
    const bf16_t* gqkv = act_ptr(F, A_GQKV); const float* ebg = F.stats + SF_EB;
    bf16_t* ysb = act_ptr(F, A_YSB);
    LAS unsigned char* wl = F.lds + F.wave * GW_BYTES;
    f32x4 S[4];
#pragma unroll
    for (int i = 0; i < 4; ++i) S[i] = (f32x4){0.f, 0.f, 0.f, 0.f};
    if (F.tid == 0) prog[0] = 0;
    constexpr int GW2 = 4 * GW_BYTES;
    u32x4 kimgX[4], qimgX[4], vimgX, kimgY[4], qimgY[4], vimgY; f32x4 ebvX[4], ebvY[4];
#define GLA_LOAD1(n_, KI, QI, VI, EBV) do { const size_t tb_ = (size_t)b * SEQ + (size_t)(n_) * 32; \
        _Pragma("unroll") for (int i = 0; i < 4; ++i) { const int p_ = lane + 64 * i; const bf16_t* r_ = gqkv + (tb_ + (p_ >> 3)) * 1024 + h * 64 + (p_ & 7) * 8; QI[i] = *(const u32x4*)r_; KI[i] = *(const u32x4*)(r_ + 256); } \
        VI = *(const u32x4*)(gqkv + (tb_ + (lane >> 1)) * 1024 + 512 + h * 128 + 16 * w + (lane & 1) * 8); \
        _Pragma("unroll") for (int db = 0; db < 4; ++db) EBV[db] = *(const f32x4*)(ebg + (tb_ >> 5) * 256 + h * 64 + 16 * db + 4 * q4); } while (0)
#define GLA_LOAD(n_) do { GLA_LOAD1((n_), kimgX, qimgX, vimgX, ebvX); GLA_LOAD1((n_) + 1, kimgY, qimgY, vimgY, ebvY); } while (0)
    bf16x8 pa0X, pa1X, vbnX, kanX[4], qpxX[2], qpyX[2], pa0Y, pa1Y, vbnY, kanY[4], qpxY[2], qpyY[2]; f32x4 o0pX, o1pX, e4X[4], o0pY, o1pY, e4Y[4];
#define GLA_IMG(WL, KI, QI, VI, EBV, E4) do { \
        _Pragma("unroll") for (int i = 0; i < 4; ++i) { asm volatile("" : "+v"(KI[i]), "+v"(QI[i]), "+v"(EBV[i])); } \
        asm volatile("" : "+v"(VI)); \
        _Pragma("unroll") for (int i = 0; i < 4; ++i) { const int p_ = lane + 64 * i; *(LAS u32x4*)((WL) + GW_K + (p_ >> 3) * 144 + (p_ & 7) * 16) = KI[i]; *(LAS u32x4*)((WL) + GW_Q + (p_ >> 3) * 144 + (p_ & 7) * 16) = QI[i]; } \
        *(LAS u32x4*)((WL) + GW_V + (lane >> 1) * 32 + (lane & 1) * 16) = VI; \
        _Pragma("unroll") for (int db = 0; db < 4; ++db) E4[db] = EBV[db]; } while (0)
#define GLA_STAGE_P(WL, PA0, PA1, VBN, KAN, QPX, QPY, O0P, O1P) do { \
        f32x4 pt00 = {0.f, 0.f, 0.f, 0.f}, pt01 = pt00, pt11 = pt00; \
        _Pragma("unroll") for (int ks = 0; ks < 2; ++ks) { \
            const bf16x8 a0 = *(const LAS bf16x8*)((WL) + GW_K + l15 * 144 + ks * 64 + q4 * 16), a1 = *(const LAS bf16x8*)((WL) + GW_K + (16 + l15) * 144 + ks * 64 + q4 * 16); \
            const bf16x8 b0 = *(const LAS bf16x8*)((WL) + GW_Q + l15 * 144 + ks * 64 + q4 * 16), b1 = *(const LAS bf16x8*)((WL) + GW_Q + (16 + l15) * 144 + ks * 64 + q4 * 16); \
            pt00 = __builtin_amdgcn_mfma_f32_16x16x32_bf16(a0, b0, pt00, 0, 0, 0); \
            pt01 = __builtin_amdgcn_mfma_f32_16x16x32_bf16(a0, b1, pt01, 0, 0, 0); \
            pt11 = __builtin_amdgcn_mfma_f32_16x16x32_bf16(a1, b1, pt11, 0, 0, 0); \
            const LAS unsigned char* q0p = (WL) + GW_Q + l15 * 144 + ks * 64 + q4 * 8; const LAS unsigned char* q1p = q0p + 16 * 144; \
            const u32x2 x0 = *(const LAS u32x2*)(q0p), x1 = *(const LAS u32x2*)(q0p + 32), y0 = *(const LAS u32x2*)(q1p), y1 = *(const LAS u32x2*)(q1p + 32); \
            QPX[ks] = __builtin_bit_cast(bf16x8, (u32x4){x0.x, x0.y, x1.x, x1.y}); QPY[ks] = __builtin_bit_cast(bf16x8, (u32x4){y0.x, y0.y, y1.x, y1.y}); } \
        _Pragma("unroll") for (int r = 0; r < 4; ++r) { if (4 * q4 + r > l15) { pt00[r] = 0.f; pt11[r] = 0.f; } } \
        PA0 = __builtin_bit_cast(bf16x8, (u32x4){cvt_pk_bf16(pt00[0], pt00[1]), cvt_pk_bf16(pt00[2], pt00[3]), 0u, 0u}); \
        PA1 = __builtin_bit_cast(bf16x8, (u32x4){cvt_pk_bf16(pt01[0], pt01[1]), cvt_pk_bf16(pt01[2], pt01[3]), cvt_pk_bf16(pt11[0], pt11[1]), cvt_pk_bf16(pt11[2], pt11[3])}); \
        const LAS unsigned char* vt_ = (WL) + GW_V + (l15 >> 2) * 32 + (l15 & 3) * 8; \
        const v4i16_t vp0 = lds_tr16(vt_ + (4 * q4) * 32), vp1 = lds_tr16(vt_ + (16 + 4 * q4) * 32); \
        const v4i16_t vn0 = lds_tr16(vt_ + (8 * q4) * 32), vn1 = lds_tr16(vt_ + (8 * q4 + 4) * 32); \
        const bf16x8 vbp = (bf16x8){vp0[0], vp0[1], vp0[2], vp0[3], vp1[0], vp1[1], vp1[2], vp1[3]}; \
        VBN = (bf16x8){vn0[0], vn0[1], vn0[2], vn0[3], vn1[0], vn1[1], vn1[2], vn1[3]}; \
        _Pragma("unroll") for (int db = 0; db < 4; ++db) { \
            const LAS unsigned char* kt = (WL) + GW_K + (8 * q4 + (l15 >> 2)) * 144 + (16 * db + (l15 & 3) * 4) * 2; \
            const v4i16_t k0 = lds_tr16(kt), k1 = lds_tr16(kt + 4 * 144); \
            KAN[db] = (bf16x8){k0[0], k0[1], k0[2], k0[3], k1[0], k1[1], k1[2], k1[3]}; } \
        O0P = __builtin_amdgcn_mfma_f32_16x16x32_bf16(PA0, vbp, (f32x4){0.f, 0.f, 0.f, 0.f}, 0, 0, 0); \
        O1P = __builtin_amdgcn_mfma_f32_16x16x32_bf16(PA1, vbp, (f32x4){0.f, 0.f, 0.f, 0.f}, 0, 0, 0); \
    } while (0)
#define GLA_STAGE_S(T0, VBN, KAN, QPX, QPY, O0P, O1P, E4) do { \
        f32x4 o0 = O0P, o1 = O1P; \
        _Pragma("unroll") for (int ks = 0; ks < 2; ++ks) { \
            const bf16x8 sb = __builtin_bit_cast(bf16x8, (u32x4){cvt_pk_bf16(S[2 * ks][0], S[2 * ks][1]), cvt_pk_bf16(S[2 * ks][2], S[2 * ks][3]), cvt_pk_bf16(S[2 * ks + 1][0], S[2 * ks + 1][1]), cvt_pk_bf16(S[2 * ks + 1][2], S[2 * ks + 1][3])}); \
            o0 = __builtin_amdgcn_mfma_f32_16x16x32_bf16(QPX[ks], sb, o0, 0, 0, 0); \
            o1 = __builtin_amdgcn_mfma_f32_16x16x32_bf16(QPY[ks], sb, o1, 0, 0, 0); } \
        _Pragma("unroll") for (int db = 0; db < 4; ++db) { S[db] = __builtin_amdgcn_mfma_f32_16x16x32_bf16(KAN[db], VBN, S[db], 0, 0, 0); S[db] = S[db] * E4[db]; } \
        _Pragma("unroll") for (int r = 0; r < 4; ++r) { const size_t ta = (T0) + 4 * q4 + r, tb2 = ta + 16; \
            ysb[ta * 512 + h * 128 + 16 * w + l15] = f2bf1(o0[r]); ysb[tb2 * 512 + h * 128 + 16 * w + l15] = f2bf1(o1[r]); } \
    } while (0)
    LAS unsigned char* wl2 = F.lds + GW2 + 64 + F.wave * GW_BYTES;
    GLA_LOAD(0);
    for (int n = 0; n < SEQ / 32; n += 2) {
        const size_t t0 = (size_t)b * SEQ + (size_t)n * 32;
        if (F.tid == 0) prog[0] = n;
        GLA_IMG(wl, kimgX, qimgX, vimgX, ebvX, e4X);
        GLA_IMG(wl2, kimgY, qimgY, vimgY, ebvY, e4Y);
        { const int nn = (n + 2 < SEQ / 32) ? n + 2 : n; GLA_LOAD(nn); }
        GLA_STAGE_P(wl, pa0X, pa1X, vbnX, kanX, qpxX, qpyX, o0pX, o1pX);
        GLA_STAGE_P(wl2, pa0Y, pa1Y, vbnY, kanY, qpxY, qpyY, o0pY, o1pY);
        GLA_STAGE_S(t0, vbnX, kanX, qpxX, qpyX, o0pX, o1pX, e4X);
        GLA_STAGE_S(t0 + 32, vbnY, kanY, qpxY, qpyY, o0pY, o1pY, e4Y);
        asm volatile("s_waitcnt lgkmcnt(0)" ::: "memory");
    }
#undef GLA_LOAD1
#undef GLA_IMG
#undef GLA_STAGE_P
#undef GLA_STAGE_S
#undef GLA_LOAD
}
__device__ __forceinline__ void gla_finalize(Frame& F, int l) {
    bf16_t* ysb = act_ptr(F, A_YSB); const bf16_t* og = act_ptr(F, A_OG);
    const float* go = F.in(I_GGLAO) + l * 128;
    for (int i = F.vcu * 512 + F.tid; i < T * 64; i += F.G * 512) {
        const int t = i >> 6, c8 = i & 63, h = c8 >> 4, v0 = (c8 & 15) * 8;
        const u32x4 o = *(const u32x4*)(ysb + (size_t)t * 512 + c8 * 8), gte = *(const u32x4*)(og + (size_t)t * 512 + c8 * 8);
        const f32x4 g0 = *(const f32x4*)(go + v0), g1 = *(const f32x4*)(go + v0 + 4);
        const float ov[8] = {bflo(o.x), bfhi(o.x), bflo(o.y), bfhi(o.y), bflo(o.z), bfhi(o.z), bflo(o.w), bfhi(o.w)};
        const float ssq = row16_sum(((ov[0] * ov[0] + ov[1] * ov[1]) + (ov[2] * ov[2] + ov[3] * ov[3])) + ((ov[4] * ov[4] + ov[5] * ov[5]) + (ov[6] * ov[6] + ov[7] * ov[7])));
        const float r = rsqrtf(ssq * (1.f / 128.f) + EPS);
        const float gv[8] = {bflo(gte.x), bfhi(gte.x), bflo(gte.y), bfhi(gte.y), bflo(gte.z), bfhi(gte.z), bflo(gte.w), bfhi(gte.w)};
        float y[8];
#pragma unroll
        for (int e = 0; e < 8; ++e) y[e] = ov[e] * r * (e < 4 ? g0[e] : g1[e - 4]) * gv[e] * fast_sigmoid(gv[e]);
        u32x4 wv; wv.x = cvt_pk_bf16(y[0], y[1]); wv.y = cvt_pk_bf16(y[2], y[3]); wv.z = cvt_pk_bf16(y[4], y[5]); wv.w = cvt_pk_bf16(y[6], y[7]);
        *(u32x4*)(ysb + (size_t)t * 512 + c8 * 8) = wv;
    }
}

template <int W> __device__ __forceinline__ void pool_rows(const bf16_t* up, bf16_t* pooled, int t0, int s0, int c8) {
    u32x4 row[8 + W - 1];
#pragma unroll
    for (int i = 0; i < 8 + W - 1; ++i) {
        const int dt = i - (W - 1);
        const bool ok = (s0 + dt) >= 0;
        const u32x4 v = *(const u32x4*)(up + (size_t)(t0 + (ok ? dt : 0)) * 512 + c8 * 8);
        row[i] = ok ? v : (u32x4){0u, 0u, 0u, 0u};
    }
#pragma unroll
    for (int k = 0; k < 8; ++k) {
        float acc[8];
#pragma unroll
        for (int e = 0; e < 8; ++e) acc[e] = 0.f;
#pragma unroll
        for (int j = 0; j < W; ++j) { const u32x4 v = row[k + W - 1 - j];
            acc[0] += bflo(v.x); acc[1] += bfhi(v.x); acc[2] += bflo(v.y); acc[3] += bfhi(v.y); acc[4] += bflo(v.z); acc[5] += bfhi(v.z); acc[6] += bflo(v.w); acc[7] += bfhi(v.w); }
        const int sk = s0 + k, n = (sk + 1 < W) ? sk + 1 : W;
        const float rn = 1.f / (float)n; const u32x4 self = row[k + W - 1];
        u32x4 o; o.x = cvt_pk_bf16(acc[0] * rn - bflo(self.x), acc[1] * rn - bfhi(self.x)); o.y = cvt_pk_bf16(acc[2] * rn - bflo(self.y), acc[3] * rn - bfhi(self.y));
        o.z = cvt_pk_bf16(acc[4] * rn - bflo(self.z), acc[5] * rn - bfhi(self.z)); o.w = cvt_pk_bf16(acc[6] * rn - bflo(self.w), acc[7] * rn - bfhi(self.w));
        *(u32x4*)(pooled + (size_t)(t0 + k) * 512 + c8 * 8) = o;
    }
}
__device__ __forceinline__ void pool_unit(Frame& F, int unit) {
    const bf16_t* up = act_ptr(F, A_UP); bf16_t* pooled = act_ptr(F, A_POOLED);
    const int g = F.wave & 3, c8 = g * 16 + (F.lane & 15), tb = (F.lane >> 4) + 4 * (F.wave >> 2);
    const int t0 = unit * 64 + tb * 8, s0 = t0 % SEQ;
    if (g == 0) pool_rows<2>(up, pooled, t0, s0, c8);
    else if (g == 1) pool_rows<4>(up, pooled, t0, s0, c8);
    else if (g == 2) pool_rows<8>(up, pooled, t0, s0, c8);
    else pool_rows<16>(up, pooled, t0, s0, c8);
}

__device__ __forceinline__ void phase_mix(Frame& F, int lq, int bx) {
    const int l = lq & 1;
#ifndef REP_DMASK
#define REP_DMASK 7
#endif
    const int dm = (lq >= 2) ? (REP_DMASK) : 7;
    if (bx < 32 && (dm & 1)) gla_unit(F, l, bx);
    unsigned* head = F.ctl + CW_QUEUE + 64 * lq;
    unsigned long long tpsum = 0;
#ifdef AT_TPROBE
    const unsigned long long tq0 = __builtin_readcyclecounter();
#endif
    for (;;) {
        if (F.tid == 0) F.MISC[16] = __hip_atomic_fetch_add(head, 1u, RLX_AGENT);
        __syncthreads();
        const int idx = (int)F.MISC[16];
        __syncthreads();
        if (idx >= 512 + 256) break;
        if (idx < 512) { if (dm & 2) attn_unit(F, idx & 31, 15 - (idx >> 5), tpsum); }
        else { if (dm & 4) pool_unit(F, idx - 512); }
    }
#ifdef AT_TPROBE
    if (AT_TPROBE == 7) tpsum = __builtin_readcyclecounter() - tq0;
    if (lq >= 2 && (AT_TPWG < 0 || bx == AT_TPWG) && F.wave == AT_TPWAVE) { const unsigned long long ts = __builtin_readcyclecounter(); while (__builtin_readcyclecounter() - ts < 4ull * tpsum) __builtin_amdgcn_s_sleep(8); }
#endif
    if (bx >= 32 && lq < 2) {
        LAS float* scr = (LAS float*)(F.lds + F.wave * 16384);
        const int gw = (bx - 32) * 8 + F.wave, NGW = (F.G - 32) * 8;
        if (l == 0) { CONV_LOOP(15, mixer_seg(F, 1, si_)); fold_pool(F, 1, gw, NGW); CONV_LOOP(3, ffn_seg(F, si_)); }
        else { CONV_LOOP(12, moe_seg(F, (si_ >> 1) * 3 + (si_ & 1))); }
    }
}

__device__ __forceinline__ void phase_route1(Frame& F) {
    const bf16_t* x = (const bf16_t*)(F.ws + WS_XB); const float* rss = F.stats + SF_ROWSS + (size_t)3 * T * 16; const float* gf = F.in(I_GFFN) + D; const float* wr = F.in(I_WROUTER);
    unsigned* route = (unsigned*)(F.ws + WS_SLOT + SL_ROUTE); unsigned* wgcnt = F.ctl + CW_WGCNT;
    LAS float* lsel = (LAS float*)(F.lds);
    LAS int* lpos = (LAS int*)(F.lds + 2048);
    float wgt[2][8][8];
    {
        f32x4 wl[2][8][2], gl[2][2];
#pragma unroll
        for (int j = 0; j < 2; ++j) {
            const int c = 8 * F.lane + 512 * j;
            gl[j][0] = *(const f32x4*)(gf + c); gl[j][1] = *(const f32x4*)(gf + c + 4);
#pragma unroll
            for (int q = 0; q < 8; ++q) { wl[j][q][0] = *(const f32x4*)(wr + (size_t)(c + q) * 8); wl[j][q][1] = *(const f32x4*)(wr + (size_t)(c + q) * 8 + 4); }
        }
#pragma unroll
        for (int j = 0; j < 2; ++j)
#pragma unroll
            for (int q = 0; q < 8; ++q) { asm volatile("" : "+v"(wl[j][q][0]), "+v"(wl[j][q][1])); }
#pragma unroll
        for (int j = 0; j < 2; ++j)
#pragma unroll
            for (int q = 0; q < 8; ++q) {
                const float g = q < 4 ? gl[j][0][q] : gl[j][1][q - 4];
#pragma unroll
                for (int e = 0; e < 4; ++e) { wgt[j][q][e] = wl[j][q][0][e] * g; wgt[j][q][4 + e] = wl[j][q][1][e] * g; }
            }
    }
    for (int unit = F.vcu; unit < T / 64; unit += F.G) {
        const float rs_l = rsqrtf(sum16(rss + (size_t)(unit * 64 + F.wave * 8 + (F.lane & 7)) * 16) * (1.f / 1024.f) + EPS);
#pragma unroll 1
        for (int k0 = 0; k0 < 8; k0 += 4) {
        u32x4 xr[4][2];
#pragma unroll
        for (int k = 0; k < 4; ++k)
#pragma unroll
            for (int j = 0; j < 2; ++j) xr[k][j] = *(const u32x4*)(x + (size_t)(unit * 64 + F.wave * 8 + k0 + k) * D + 8 * F.lane + 512 * j);
#pragma unroll
        for (int kk = 0; kk < 4; ++kk) {
            const int k = k0 + kk, tok = F.wave * 8 + k;
            float lg[8];
#pragma unroll
            for (int e = 0; e < 8; ++e) lg[e] = 0.f;
#pragma unroll
            for (int j = 0; j < 2; ++j) {
                const u32x4 v = xr[kk][j];
                const float xv[8] = {bflo(v.x), bfhi(v.x), bflo(v.y), bfhi(v.y), bflo(v.z), bfhi(v.z), bflo(v.w), bfhi(v.w)};
#pragma unroll
                for (int q = 0; q < 8; ++q)
#pragma unroll
                    for (int e = 0; e < 8; ++e) lg[e] = fmaf(xv[q], wgt[j][q][e], lg[e]);
            }
            const float rs = __shfl(rs_l, k);
#pragma unroll
            for (int e = 0; e < 8; ++e) lg[e] = wave_sum(lg[e]) * rs;
            int i1 = 0; float v1 = lg[0];
#pragma unroll
            for (int e = 1; e < 8; ++e) if (lg[e] > v1) { v1 = lg[e]; i1 = e; }
            int i2 = -1; float v2 = -INFINITY;
#pragma unroll
            for (int e = 0; e < 8; ++e) if (e != i1 && lg[e] > v2) { v2 = lg[e]; i2 = e; }
            const float e2 = __expf(v2 - v1), w1 = 1.f / (1.f + e2), w2 = e2 / (1.f + e2);
            if (F.lane == 0) { lsel[tok * 4 + 0] = __int_as_float(i1); lsel[tok * 4 + 1] = __int_as_float(i2); lsel[tok * 4 + 2] = w1; lsel[tok * 4 + 3] = w2; }
        }
        }
        __syncthreads();
        if (F.tid < 8) {
            int cnt = 0;
            for (int tok = 0; tok < 64; ++tok) {
                const int e1 = __float_as_int(lsel[tok * 4 + 0]), e2 = __float_as_int(lsel[tok * 4 + 1]);
                if (e1 == F.tid) { lpos[tok * 2 + 0] = cnt; ++cnt; }
                if (e2 == F.tid) { lpos[tok * 2 + 1] = cnt; ++cnt; }
            }
            wgcnt[unit * 8 + F.tid] = (unsigned)cnt;
        }
        __syncthreads();
        if (F.tid < 64) {
            const int t = unit * 64 + F.tid;
            u32x4 a, b2;
            a.x = (unsigned)__float_as_int(lsel[F.tid * 4 + 0]); a.y = (unsigned)__float_as_int(lsel[F.tid * 4 + 1]); a.z = __float_as_uint(lsel[F.tid * 4 + 2]); a.w = __float_as_uint(lsel[F.tid * 4 + 3]);
            b2.x = (unsigned)lpos[F.tid * 2 + 0]; b2.y = (unsigned)lpos[F.tid * 2 + 1]; b2.z = 0u; b2.w = 0u;
            *(u32x4*)(route + (size_t)t * 8) = a; *(u32x4*)(route + (size_t)t * 8 + 4) = b2;
        }
        __syncthreads();
    }
}
__device__ __forceinline__ void moe_geometry(Frame& F, int unit, LAS int* geo) {
    const unsigned* wgcnt = F.ctl + CW_WGCNT;
    if (F.tid < 8) {
        int tot = 0, pre = 0;
        for (int c = 0; c < 256; ++c) { const int v = (int)wgcnt[c * 8 + F.tid]; if (c < unit) pre += v; tot += v; }
        geo[9 + F.tid] = tot; geo[17 + F.tid] = pre;
    }
    __syncthreads();
    if (F.tid == 0) { int acc = 0; for (int e = 0; e < 8; ++e) { geo[e] = acc; acc += (geo[9 + e] + 255) >> 8; } geo[8] = acc; }
    __syncthreads();
}
__device__ __forceinline__ void phase_route2(Frame& F) {
    const unsigned* route = (const unsigned*)(F.ws + WS_SLOT + SL_ROUTE);
    int* slot_tok = (int*)(F.ws + WS_SLOT + SL_TOK); float* slot_scale = (float*)(F.ws + WS_SLOT + SL_SCALE); float* slot_comb = (float*)(F.ws + WS_SLOT + SL_COMB);
    const float* rss = F.stats + SF_ROWSS + (size_t)3 * T * 16;
    const bf16_t* xb = (const bf16_t*)(F.ws + WS_XB); bf16_t* xg = act_ptr(F, A_XG);
    LAS int* geo = (LAS int*)(F.lds);
    for (int unit = F.vcu; unit < T / 64; unit += F.G) {
        moe_geometry(F, unit, geo);
        int slot_l = 0;
        if (F.lane < 16) {
            const int rix = F.wave * 16 + F.lane, tok = rix >> 1, ch = rix & 1, t = unit * 64 + tok;
            const unsigned e = route[(size_t)t * 8 + ch], pos = route[(size_t)t * 8 + 4 + ch];
            const float w = __uint_as_float(route[(size_t)t * 8 + 2 + ch]);
            const float sc = rsqrtf(sum16(rss + (size_t)t * 16) * (1.f / 1024.f) + EPS);
            slot_l = geo[e] * 256 + geo[17 + e] + (int)pos;
            ((int*)(F.ws + WS_TSLOT))[t * 2 + ch] = slot_l; slot_tok[slot_l] = t; slot_scale[slot_l] = sc; slot_comb[slot_l] = w;
        }
#pragma unroll
        for (int k0 = 0; k0 < 16; k0 += 8) {
            u32x4 r0[8], r1[8];
#pragma unroll
            for (int k = 0; k < 8; ++k) {
                const u32x4* src = (const u32x4*)(xb + (size_t)(unit * 64 + ((F.wave * 16 + k0 + k) >> 1)) * D);
                r0[k] = src[F.lane]; r1[k] = src[64 + F.lane];
            }
#pragma unroll
            for (int k = 0; k < 8; ++k) {
                const int slot = __shfl(slot_l, k0 + k);
                u32x4* dst = (u32x4*)(xg + (size_t)slot * D);
                dst[F.lane] = r0[k]; dst[64 + F.lane] = r1[k];
            }
        }
        if (unit == 0) {
            for (int e = 0; e < 8; ++e) { const int s0 = geo[e] * 256 + geo[9 + e], s1 = geo[e + 1] * 256;
                for (int s = s0 + F.tid; s < s1; s += 512) { slot_tok[s] = -1; slot_scale[s] = 0.f; slot_comb[s] = 0.f; } }
        }
        __syncthreads();
    }
}

struct Args { const void* in[25]; float* out; unsigned char* ws; int ph_lo, ph_hi, li, pad; };
constexpr int NPHASE = 22;
#ifndef PH_MASK
#define PH_MASK 0xFFF
#endif
#define PON(b) (((PH_MASK) >> (b)) & 1)

__global__ void __launch_bounds__(512, 2) mega_fwd(Args args) {
    extern __shared__ __attribute__((aligned(16))) unsigned char lds_raw[];
    Frame F;
    F.lds = (LAS unsigned char*)lds_raw;
    F.MISC = (volatile LAS unsigned*)(F.lds + MISC_OFF);
    F.tid = threadIdx.x; F.lane = F.tid & 63; F.wave = __builtin_amdgcn_readfirstlane(F.tid >> 6);
    F.G = gridDim.x; { const int bx = blockIdx.x; F.vcu = (F.G % 8 == 0) ? (bx % 8) * (F.G / 8) + bx / 8 : bx; }
    { const CAS Args* ap0 = (const CAS Args*)__builtin_amdgcn_kernarg_segment_ptr(); F.ws = ap0->ws; F.ctl = (unsigned*)(F.ws + WS_CTL); F.ctlf = (float*)(F.ws + WS_CTL); F.stats = (float*)(F.ws + WS_STATS); }
    F.inp = nullptr; F.out = nullptr;
    for (int u = F.tid; u < (LDS_BYTES - LDSCTL_OFF) / 4; u += 512) ((LAS unsigned*)(F.lds + LDSCTL_OFF))[u] = 0u;
    __syncthreads();
    XcdBarrier bar = xcd_barrier_post(F.ctl + CW_BAR + args.li * XCD_BAR_WORDS, F.MISC + 8);
    const int lo = args.ph_lo, hi = args.ph_hi;
    const int cblk0 = (int)blockIdx.x, wave0 = F.wave, vcu0 = F.vcu, G0 = F.G;
#ifndef REP_MASK
#define REP_MASK 0
#endif
#pragma unroll 1
    for (int ph2 = 2 * lo; ph2 < 2 * hi; ++ph2) {
        const int ph = ph2 >> 1, rpt = ph2 & 1;
        if (rpt && !((REP_MASK >> ph) & 1)) continue;
        int cblk = cblk0; { int wv_ = wave0, vc_ = vcu0, g_ = G0; asm volatile("" : "+s"(wv_), "+s"(vc_), "+s"(g_), "+s"(cblk)); F.wave = wv_; F.vcu = vc_; F.G = g_; }
        { int ln_; asm volatile("v_mbcnt_lo_u32_b32 %0, -1, 0\n\tv_mbcnt_hi_u32_b32 %0, -1, %0" : "=v"(ln_)); F.lane = ln_; F.tid = F.wave * 64 + ln_; }
        { const CAS Args* ap = (const CAS Args*)__builtin_amdgcn_kernarg_segment_ptr(); asm volatile("" : "+s"(ap)); F.inp = ap->in; F.out = ap->out; unsigned char* w_ = ap->ws; F.ws = w_; F.ctl = (unsigned*)(w_ + WS_CTL); F.ctlf = (float*)(w_ + WS_CTL); F.stats = (float*)(w_ + WS_STATS); }
        const int l = ph >= 10 ? 1 : 0, q = ph == 0 ? -1 : (l ? ph - 10 : ph - 1);
        unsigned char* wb = wblk(F, l);
        float* ssq = F.stats + SF_SSQ + (size_t)l * 2 * T * 4;
        const float* rss_in = F.stats + SF_ROWSS + (size_t)(l == 0 ? 0 : 2) * T * 16;
        float* rss_mid = F.stats + SF_ROWSS + (size_t)(l == 0 ? 1 : 3) * T * 16;
        if (q == -1) {
            if (PON(11)) p0_prologue(F);
        } else if (q == 0 && PON(0)) {
            pg8::SchedGrid S{(const char*)(F.ws + WS_XB), (const char*)(wb + WO_IN), (size_t)256 * 1024 * 2, (size_t)256 * 1024 * 2, 0, 64, 11, F.G, cblk, 1 << 30};
            { pg8::Unit u0; if (S.next(0, u0)) fill_rs(F, rss_in, u0.pm); }
            pg8::EpiProj E{act_ptr(F, A_CQKV), act_ptr(F, A_GQKV), act_ptr(F, A_OG), act_ptr(F, A_UP), act_ptr(F, A_MISC), (const LAS float*)(F.lds + RS_OFF), ssq};
            pg8::gemm_phase<pg8::EpiProj, pg8::SchedGrid, true, true>(F.lds, F.wave, 1024, 1024, S, E);
        } else if (q == 1 && PON(1)) {
            pg8::SchedGrid S{(const char*)act_ptr(F, A_CQKV), (const char*)(wb + WO_UP), (size_t)256 * 512 * 2, (size_t)256 * 256 * 2, (size_t)256 * 2, 64, 7, F.G, cblk, 3};
            pg8::EpiUp E{act_ptr(F, A_QKVRAW), ssq};
            pg8::gemm_phase<pg8::EpiUp, pg8::SchedGrid, true, true>(F.lds, F.wave, 512, 256, S, E);
        } else if (q == 2 && PON(2)) {
            phase_prep(F, l, rpt);
        } else if (q == 3 && PON(3)) {
            phase_mix(F, l + 2 * rpt, cblk);
        } else if (q == 4 && PON(4)) {
            pg8::SchedGrid S{(const char*)(F.ws + WS_XB), (const char*)(wb + WO_G), (size_t)256 * 1024 * 2, (size_t)256 * 1024 * 2, 0, 64, 12, F.G, cblk, 1 << 30};
            { pg8::Unit u0; if (S.next(0, u0)) fill_rs(F, rss_in, u0.pm); }
            pg8::EpiGate E{F.ws + WS_ACTS, (const LAS float*)(F.lds + RS_OFF)};
            pg8::gemm_phase<pg8::EpiGate, pg8::SchedGrid, true, true>(F.lds, F.wave, 1024, 1024, S, E);
            if (!rpt) gla_finalize(F, l);
        } else if (q == 5 && PON(5)) {
            pg8::SchedMerge S{(const char*)(F.ws + WS_ACTS), (const char*)(wb + WO_BR), F.G, cblk};
            pg8::EpiMerge E{F.ws + WS_ACTS, act_ptr(F, A_MERGED)};
            pg8::gemm_phase<pg8::EpiMerge, pg8::SchedMerge, true, true>(F.lds, F.wave, 512, 512, S, E);
        } else if (q == 6 && PON(6)) {
            pg8::SchedGrid S{(const char*)act_ptr(F, A_MERGED), (const char*)(wb + WO_OUT), (size_t)256 * 1024 * 2, (size_t)256 * 1024 * 2, 0, 64, 4, F.G, cblk, 1 << 30, MERGED_HI_DELTA};
            pg8::EpiResid E{(bf16_t*)(F.ws + WS_XB), rss_mid};
            pg8::gemm_phase<pg8::EpiResid, pg8::SchedGrid, true, true>(F.lds, F.wave, 1024, 1024, S, E);
        } else if (l == 0 && q == 7 && PON(7)) {
            pg8::SchedGrid S{(const char*)(F.ws + WS_XB), (const char*)(wb + WO_FGU), (size_t)256 * 1024 * 2, (size_t)256 * 1024 * 2, 0, 64, 22, F.G, cblk, 1 << 30};
            if (F.G == 256) S.split_from = 1280;
            { pg8::Unit u0; if (S.next(0, u0)) fill_rs(F, rss_mid, u0.pm); }
            pg8::EpiSwiglu<false> E{act_ptr(F, A_ACT), DFF, (const LAS float*)(F.lds + RS_OFF), nullptr, nullptr};
            pg8::gemm_phase<pg8::EpiSwiglu<false>, pg8::SchedGrid, true, true>(F.lds, F.wave, 1024, 1024, S, E);
        } else if (l == 0 && q == 8 && PON(8)) {
            pg8::SchedGrid S{(const char*)act_ptr(F, A_ACT), (const char*)(wb + WO_FD), (size_t)256 * DFF * 2, (size_t)256 * DFF * 2, 0, 64, 4, F.G, cblk, 1 << 30};
            pg8::EpiResid E{(bf16_t*)(F.ws + WS_XB), F.stats + SF_ROWSS + (size_t)2 * T * 16};
            pg8::gemm_phase<pg8::EpiResid, pg8::SchedGrid, true, true>(F.lds, F.wave, DFF, DFF, S, E);
        } else if (q == 7 && PON(9)) {
            phase_route1(F);
            __syncthreads();
            LAS float* scr = (LAS float*)(F.lds + F.wave * 16384);
            const int gw = F.vcu * 8 + F.wave, NGW = F.G * 8;
            CONV_LOOP(12, moe_seg(F, (si_ < 4) ? (6 + (si_ >> 1)) * 3 + (si_ & 1) : (si_ - 4) * 3 + 2));
        } else if (q == 8 && PON(9)) {
            phase_route2(F);
        } else if (q == 9 && PON(10)) {
            unsigned char* wm = F.ws + WS_W0;
            LAS int* geo = (LAS int*)(F.lds + RING_BYTES + 512);
            moe_geometry(F, 0, geo);
            pg8::SchedMoe S; S.A = (const char*)act_ptr(F, A_XG); S.B = (const char*)(wm + WO_MGU); S.a_tile = (size_t)256 * 1024 * 2; S.b_tile = (size_t)256 * 1024 * 2; S.b_exp = (size_t)2816 * 1024 * 2;
            S.nN = 11; S.G = F.G; S.c = cblk;
            S.t1 = __builtin_amdgcn_readfirstlane(geo[1]); S.t2 = __builtin_amdgcn_readfirstlane(geo[2]); S.t3 = __builtin_amdgcn_readfirstlane(geo[3]); S.t4 = __builtin_amdgcn_readfirstlane(geo[4]);
            S.t5 = __builtin_amdgcn_readfirstlane(geo[5]); S.t6 = __builtin_amdgcn_readfirstlane(geo[6]); S.t7 = __builtin_amdgcn_readfirstlane(geo[7]); S.MT = __builtin_amdgcn_readfirstlane(geo[8]);
            pg8::EpiSwiglu<true> E{act_ptr(F, A_ACTE), DEXP, (const LAS float*)nullptr, (const float*)(F.ws + WS_SLOT + SL_SCALE), (const float*)(F.ws + WS_SLOT + SL_COMB)};
            pg8::gemm_phase<pg8::EpiSwiglu<true>, pg8::SchedMoe, true, true>(F.lds, F.wave, 1024, 1024, S, E);
        } else if (q == 10 && PON(10)) {
            unsigned char* wm = F.ws + WS_W0;
            LAS int* geo = (LAS int*)(F.lds + RING_BYTES + 512);
            moe_geometry(F, 0, geo);
            pg8::SchedMoe S; S.A = (const char*)act_ptr(F, A_ACTE); S.B = (const char*)(wm + WO_MD); S.a_tile = (size_t)256 * DEXP * 2; S.b_tile = (size_t)256 * DEXP * 2; S.b_exp = (size_t)1024 * DEXP * 2;
            S.nN = 4; S.G = F.G; S.c = cblk;
            S.t1 = __builtin_amdgcn_readfirstlane(geo[1]); S.t2 = __builtin_amdgcn_readfirstlane(geo[2]); S.t3 = __builtin_amdgcn_readfirstlane(geo[3]); S.t4 = __builtin_amdgcn_readfirstlane(geo[4]);
            S.t5 = __builtin_amdgcn_readfirstlane(geo[5]); S.t6 = __builtin_amdgcn_readfirstlane(geo[6]); S.t7 = __builtin_amdgcn_readfirstlane(geo[7]); S.MT = __builtin_amdgcn_readfirstlane(geo[8]);
            { const int nt = S.MT * 4, rem = nt % F.G; if (rem > 0 && 2 * rem <= F.G) S.split_from = nt - rem; }
            pg8::EpiMoeDown E{act_ptr(F, A_Y)};
            pg8::gemm_phase<pg8::EpiMoeDown, pg8::SchedMoe, true, true>(F.lds, F.wave, DEXP, DEXP, S, E);
        }
        else if (q == 11) {
            const int* tslot = (const int*)(F.ws + WS_TSLOT); const bf16_t* y = act_ptr(F, A_Y);
            const int tstep = F.G * 8;
            for (int tb = F.vcu * 8 + F.wave; tb < T; tb += 4 * tstep) {
                int sl = 0;
                { const int tt = tb + (F.lane >> 1) * tstep; if (F.lane < 8 && tt < T) sl = tslot[tt * 2 + (F.lane & 1)]; }
                u32x4 av[4][2], bv[4][2], xv4[4][2];
#pragma unroll
                for (int k = 0; k < 4; ++k) {
                    const int t = tb + k * tstep, tc = t < T ? t : tb;
                    const int s0 = __shfl(sl, 2 * k), s1 = __shfl(sl, 2 * k + 1);
                    const bf16_t* xbr = (const bf16_t*)(F.ws + WS_XB) + (size_t)tc * D;
#pragma unroll
                    for (int j = 0; j < 2; ++j) {
                        av[k][j] = *((const u32x4*)(y + (size_t)s0 * D) + 64 * j + F.lane); bv[k][j] = *((const u32x4*)(y + (size_t)s1 * D) + 64 * j + F.lane);
                        xv4[k][j] = *((const u32x4*)xbr + 64 * j + F.lane);
                    }
                }
#pragma unroll
                for (int k = 0; k < 4; ++k) {
                    const int t = tb + k * tstep; if (t >= T) break;
                    f32x4* xo = (f32x4*)(F.out + (size_t)t * D) + F.lane * 2;
#pragma unroll
                    for (int j = 0; j < 2; ++j) {
                        const u32x4 a = av[k][j], bq = bv[k][j], xv = xv4[k][j];
                        f32x4 x0 = {bflo(xv.x), bfhi(xv.x), bflo(xv.y), bfhi(xv.y)}, x1 = {bflo(xv.z), bfhi(xv.z), bflo(xv.w), bfhi(xv.w)};
                        x0[0] += bflo(a.x) + bflo(bq.x); x0[1] += bfhi(a.x) + bfhi(bq.x); x0[2] += bflo(a.y) + bflo(bq.y); x0[3] += bfhi(a.y) + bfhi(bq.y);
                        x1[0] += bflo(a.z) + bflo(bq.z); x1[1] += bfhi(a.z) + bfhi(bq.z); x1[2] += bflo(a.w) + bflo(bq.w); x1[3] += bfhi(a.w) + bfhi(bq.w);
                        xo[128 * j] = x0; xo[128 * j + 1] = x1;
                    }
                }
            }
        }
        if (ph + 1 < hi || (!rpt && ((REP_MASK >> ph) & 1))) xcd_barrier(bar);
    }
}


#ifdef DBG_PH
__global__ void dbg_dump(const unsigned char* ws, float* out) {
    const size_t i = (size_t)blockIdx.x * 256 + threadIdx.x;
    float v = 0.f;
    const bf16_t* a0 = (const bf16_t*)(ws + WS_ACTS + DBG_A0); const bf16_t* a1 = (const bf16_t*)(ws + WS_ACTS + DBG_A1);
    if (i < (size_t)DBG_N0) v += __uint_as_float((unsigned)a0[i] << 16);
    if (i < (size_t)DBG_N1) v += 3.f * __uint_as_float((unsigned)a1[i] << 16);
    out[i] = v;
}
#endif

extern "C" void kernel_launch(void* const* d_in, const int* in_sizes, int n_in, void* d_out, int out_size, void* d_ws, size_t ws_size, hipStream_t stream) {
    static int grid = 0;
    if (grid == 0) {
        if (n_in != 25 || out_size != T * D || ws_size < WS_END) { fprintf(stderr, "kernel_launch: unexpected sizes (n_in %d out %d ws %zu)\n", n_in, out_size, ws_size); grid = -1; return; }
        int dev = 0, cus = 0;
        if (hipGetDevice(&dev) != hipSuccess || hipDeviceGetAttribute(&cus, hipDeviceAttributeMultiprocessorCount, dev) != hipSuccess) { grid = -1; return; }
        if (hipFuncSetAttribute((const void*)mega_fwd, hipFuncAttributeMaxDynamicSharedMemorySize, LDS_BYTES) != hipSuccess) { grid = -1; return; }
        int per_cu = 0;
        (void)hipOccupancyMaxActiveBlocksPerMultiprocessor(&per_cu, (const void*)mega_fwd, 512, LDS_BYTES);
        (void)hipGetLastError();
        grid = cus;
    }
    if (grid < 0) return;
    (void)hipMemsetAsync((char*)d_ws + WS_CTL, 0, CTL_BYTES, stream);
    Args a{};
    for (int i = 0; i < 25; ++i) a.in[i] = d_in[i];
    a.out = (float*)d_out; a.ws = (unsigned char*)d_ws; a.ph_lo = 0; a.ph_hi = NPHASE; a.li = 0; a.pad = 0;
#ifdef DBG_PH
    a.ph_hi = DBG_PH;
#endif
    void* kargs[] = {&a};
    hipError_t e = hipLaunchCooperativeKernel((const void*)mega_fwd, dim3(grid), dim3(512), kargs, LDS_BYTES, stream);
    if (e != hipSuccess) fprintf(stderr, "cooperative launch failed: %s (grid %d)\n", hipGetErrorString(e), grid);
#ifdef DBG_PH
    hipLaunchKernelGGL(dbg_dump, dim3(T * 1024 / 256), dim3(256), 0, stream, (const unsigned char*)d_ws, (float*)d_out);
#endif
}
```

```cpp
#include <hip/hip_runtime.h>
#include <cstdint>
#include <cstdio>

#define LAS __attribute__((address_space(3)))
#define CAS __attribute__((address_space(4)))
typedef const void* GPtr;
typedef unsigned short bf16_t;
typedef short bf16x8 __attribute__((ext_vector_type(8)));
typedef float f32x4 __attribute__((ext_vector_type(4)));
typedef float f32x16 __attribute__((ext_vector_type(16)));
typedef unsigned u32x4 __attribute__((ext_vector_type(4)));
typedef unsigned u32x2 __attribute__((ext_vector_type(2)));

constexpr int T = 16384, SEQ = 4096, NB = 4, D = 1024, DIN = 5680, DFF = 2816, DEXP = 1408, NEXP = 8;
constexpr int NPROJ = 2816;
constexpr float EPS = 1e-6f;
constexpr int MAXSLOT = 34816;

constexpr size_t MiB = 1u << 20;
constexpr size_t WS_CTL = 0, CTL_BYTES = 128 * 1024;
constexpr size_t WS_SLOT = 2 * MiB;
constexpr size_t WS_ROPE = 3 * MiB;
constexpr size_t WS_XB = 5 * MiB;
constexpr size_t WS_W1 = 37 * MiB;
constexpr size_t WS_W0 = 55 * MiB;
constexpr size_t WS_ACTS = 89 * MiB;
constexpr size_t WS_STATS = 283 * MiB;
constexpr size_t WS_END = 291 * MiB;
constexpr size_t WO_IN = 0, WO_G = 5632 * 1024, WO_UP = WO_G + 6 * MiB, WO_BR = WO_UP + 1792 * 256 * 2, WO_OUT = WO_BR + 3 * MiB, WO_FGU = WO_OUT + 2 * MiB, WO_FD = WO_FGU + 11 * MiB;
constexpr size_t WO_MGU = 0, WO_MD = 44 * MiB;
constexpr size_t A_OG = 0, A_GQKV = 16 * MiB, A_UP = 48 * MiB, A_MISC = 64 * MiB, A_CQKV = 72 * MiB, A_VT = 72 * MiB, A_QKVRAW = 88 * MiB;
constexpr size_t A_YSA = 96 * MiB, A_POOLED = 112 * MiB, A_YSB = 128 * MiB, A_QH = 144 * MiB, A_KH = 168 * MiB;
constexpr size_t A_G0 = 16 * MiB, A_G1 = 48 * MiB, A_G2 = 144 * MiB, A_ACT = 0;
constexpr size_t A_MERGED = 0;
constexpr long long MERGED_HI_DELTA = (long long)(64 * MiB);
constexpr size_t A_XG = 32 * MiB, A_ACTE = 100 * MiB, A_Y = 32 * MiB;
constexpr int CW_TMO = 0, CW_BAR = 4096, CW_QUEUE = 16384, CW_WGCNT = 20480;
static_assert((size_t)(CW_WGCNT + 2048) * 4 <= CTL_BYTES, "ctl");
constexpr size_t SF_SSQ = 0;
constexpr size_t SF_ROWSS = (size_t)2 * 2 * T * 4;
constexpr size_t SF_OSS = SF_ROWSS + (size_t)4 * T * 16;
constexpr size_t SF_EB = SF_OSS + (size_t)T * 32;
static_assert((SF_EB + (size_t)(T / 32) * 256) * 4 <= 8 * MiB, "stats");
constexpr size_t SL_TOK = 0, SL_SCALE = 139264, SL_COMB = 2 * 139264, SL_ROUTE = 3 * 139264;
constexpr size_t WS_TSLOT = 1 * MiB;

constexpr int RING_BYTES = 131072, LDSCTL_OFF = RING_BYTES, MISC_OFF = LDSCTL_OFF + 320, LDS_BYTES = 147456;
constexpr int RS_OFF = RING_BYTES + 1024;

#define LDS_WAIT() asm volatile("s_waitcnt lgkmcnt(0)" ::: "memory")
#define VM_WAIT() asm volatile("s_waitcnt vmcnt(0)" ::: "memory")
#define LDS_BARRIER() do { asm volatile("s_waitcnt lgkmcnt(0)" ::: "memory"); __builtin_amdgcn_s_barrier(); asm volatile("" ::: "memory"); } while (0)
#define RLX_AGENT __ATOMIC_RELAXED, __HIP_MEMORY_SCOPE_AGENT
typedef float f32x2_t __attribute__((ext_vector_type(2))); typedef __bf16 bf16x2_t __attribute__((ext_vector_type(2)));
__device__ __forceinline__ unsigned cvt_pk_bf16(float lo, float hi) { f32x2_t v = {lo, hi}; bf16x2_t b = __builtin_convertvector(v, bf16x2_t); return __builtin_bit_cast(unsigned, b); }
__device__ __forceinline__ float bflo(unsigned u) { return __uint_as_float(u << 16); }
__device__ __forceinline__ float bfhi(unsigned u) { return __uint_as_float(u & 0xffff0000u); }
__device__ __forceinline__ float wave_sum(float v) {
#pragma unroll
    for (int o = 1; o < 64; o <<= 1) v += __shfl_xor(v, o);
    return v;
}
__device__ __forceinline__ float sum16(const float* p) { const f32x4 a = *(const f32x4*)p, b = *(const f32x4*)(p + 4), c = *(const f32x4*)(p + 8), d = *(const f32x4*)(p + 12);
    return (((a[0] + a[1]) + (a[2] + a[3])) + ((b[0] + b[1]) + (b[2] + b[3]))) + (((c[0] + c[1]) + (c[2] + c[3])) + ((d[0] + d[1]) + (d[2] + d[3]))); }
__device__ __forceinline__ float sum4(const float* p) { const f32x4 a = *(const f32x4*)p; return (a[0] + a[1]) + (a[2] + a[3]); }
__device__ __forceinline__ float fast_sigmoid(float z) { return __builtin_amdgcn_rcpf(1.f + __builtin_amdgcn_exp2f(-1.4426950408889634f * z)); }

namespace pg8 {
constexpr int BM = 256, BK = 64, HALF = 128, HTB = HALF * BK * 2, STAGE_BYTES = 8 * HTB, NXCD = 8, WGM = 8;
__host__ __device__ __forceinline__ int lds_byte(int r, int c) { const int st = (r >> 4) * 2 + (c >> 5), rr = r & 15, cc = c & 31, ob = rr * 64 + cc * 2; return st * 1024 + (ob ^ (((ob >> 9) & 1) << 5)); }
__host__ __device__ __forceinline__ void stage_rc(int b, int& R, int& C) { const int st = b / 1024, sb = b % 1024, swz = sb ^ (((sb >> 9) & 1) << 5); R = (st >> 1) * 16 + swz / 64; C = (st & 1) * 32 + (swz % 64) / 2; }
__host__ __device__ __forceinline__ int perm32(int rho) { const int n = rho >> 4, i = rho & 15; return 8 * (i >> 2) + 4 * n + (i & 3); }

struct Unit { const char* a; const char* b; int pm, pn, kind, half; };
__device__ __forceinline__ void tile_map(int L, int nM, int nN, int& pm, int& pn) {
    const int nwg = nM * nN; int wgid = L;
    { const int q = nwg / NXCD, r = nwg % NXCD, xcd = wgid % NXCD, off = wgid / NXCD; wgid = (xcd < r ? xcd * (q + 1) : r * (q + 1) + (xcd - r) * q) + off; }
    const int nig = WGM * nN, gid = wgid / nig, fm = gid * WGM, gsz = (nM - fm) < WGM ? (nM - fm) : WGM;
    pm = fm + ((wgid % nig) % gsz); pn = (wgid % nig) / gsz;
}

template <class Epi, class Sched, bool ALIGN_EPI, bool SP2>
__device__ __forceinline__ void gemm_phase(LAS unsigned char* lds, const int wave_in, const int lda, const int K, const Sched& S, const Epi& E) {
    int ln_; asm volatile("v_mbcnt_lo_u32_b32 %0, -1, 0\n\tv_mbcnt_hi_u32_b32 %0, -1, %0" : "=v"(ln_));
    const int tid = wave_in * 64 + ln_, wid = __builtin_amdgcn_readfirstlane(tid >> 6), lane = tid & 63, wr = wid >> 2, wc = wid & 3, fr = lane & 15, fq = lane >> 4;
    const int nt = K / BK;
    unsigned voffA[2], voffB[2];
#pragma unroll
    for (int i = 0; i < 2; ++i) { int R, C; stage_rc(tid * 16 + i * 8192, R, C); const int Rb = Epi::PERM ? ((R & ~31) + perm32(R & 31)) : R;
        voffA[i] = (unsigned)(R * lda + C) * 2u; voffB[i] = (unsigned)(Rb * K + C) * 2u; }
    const size_t kstep = (size_t)(BK * 2);
    const size_t hstepA = (size_t)HALF * lda * 2, hstepB = (size_t)HALF * K * 2;
    const unsigned ldsw = (unsigned)wid * 1024u;
    const int aoff = lds_byte(wr * 64 + fr, fq * 8), boff = lds_byte(wc * 32 + fr, fq * 8);
#define PG8_SA(b, h) (((b) * 2 + (h)) * HTB)
#define PG8_SB(b, h) ((4 + (b) * 2 + (h)) * HTB)
#define PG8_STAGE(bufoff, gbase, voff) do { _Pragma("unroll") for (int _i = 0; _i < 2; ++_i) \
        __builtin_amdgcn_global_load_lds((const unsigned*)((const char*)(gbase) + (voff)[_i]), (LAS unsigned*)(lds + (bufoff) + ldsw + _i * 8192), 16, 0, 0); } while (0)
#define PG8_LDA(dst, b, h) do { _Pragma("unroll") for (int m = 0; m < 4; ++m) _Pragma("unroll") for (int k = 0; k < 2; ++k) dst[m][k] = *(const LAS bf16x8*)(lds + PG8_SA(b, h) + aoff + m * 2048 + k * 1024); } while (0)
#define PG8_LDB(dst, b, h) do { _Pragma("unroll") for (int n = 0; n < 2; ++n) _Pragma("unroll") for (int k = 0; k < 2; ++k) dst[n][k] = *(const LAS bf16x8*)(lds + PG8_SB(b, h) + boff + n * 2048 + k * 1024); } while (0)
#define PG8_MMA(ai, bj, At, Bt) do { __builtin_amdgcn_s_setprio(1); _Pragma("unroll") for (int m = 0; m < 4; ++m) _Pragma("unroll") for (int n = 0; n < 2; ++n) _Pragma("unroll") for (int k = 0; k < 2; ++k) \
        acc[ai][bj][m][n] = __builtin_amdgcn_mfma_f32_16x16x32_bf16(Bt[n][k], At[m][k], acc[ai][bj][m][n], 0, 0, 0); __builtin_amdgcn_s_setprio(0); } while (0)
#define PG8_WAIT_V(n) asm volatile("s_waitcnt vmcnt(" #n ")" ::: "memory")
#define PG8_WAIT_L(n) asm volatile("s_waitcnt lgkmcnt(" #n ")" ::: "memory")
#define PG8_BAR __builtin_amdgcn_s_barrier()
#define PG8_SCHED __builtin_amdgcn_sched_barrier(0)
    Unit cur, nxt; int ui = 0;
    if (!S.next(0, cur)) return;
    f32x4 acc[2][2][4][2];
#pragma unroll
    for (int a = 0; a < 2; ++a)
#pragma unroll
        for (int b = 0; b < 2; ++b)
#pragma unroll
            for (int m = 0; m < 4; ++m)
#pragma unroll
                for (int n = 0; n < 2; ++n) acc[a][b][m][n] = (f32x4){0.f, 0.f, 0.f, 0.f};
    bf16x8 At[4][2], B0[2][2], B1[2][2];
    const char* cA = cur.a; const char* cB = cur.b;
    if constexpr (SP2) {
        PG8_STAGE(PG8_SB(0, 0), cB, voffB); PG8_STAGE(PG8_SB(0, 1), cB + hstepB, voffB); PG8_STAGE(PG8_SA(0, 0), cA, voffA); PG8_STAGE(PG8_SA(0, 1), cA + hstepA, voffA);
        if (wr == 1) PG8_BAR;
        PG8_WAIT_V(2); PG8_BAR;
        PG8_STAGE(PG8_SB(1, 0), cB + kstep, voffB); PG8_STAGE(PG8_SA(1, 0), cA + kstep, voffA); PG8_STAGE(PG8_SB(1, 1), cB + hstepB + kstep, voffB);
        PG8_WAIT_V(6); PG8_BAR;
    } else {
        PG8_STAGE(PG8_SB(0, 0), cB, voffB); PG8_STAGE(PG8_SA(0, 0), cA, voffA); PG8_STAGE(PG8_SB(0, 1), cB + hstepB, voffB); PG8_STAGE(PG8_SA(0, 1), cA + hstepA, voffA);
        if (wr == 1) PG8_BAR;
        PG8_WAIT_V(4); PG8_BAR;
        PG8_STAGE(PG8_SB(1, 0), cB + kstep, voffB); PG8_STAGE(PG8_SA(1, 0), cA + kstep, voffA); PG8_STAGE(PG8_SB(1, 1), cB + hstepB + kstep, voffB);
        PG8_WAIT_V(6); PG8_BAR;
    }
    for (;;) {
        const bool has_next = S.next(ui + 1, nxt);
        const bool do0 = cur.half != 2, do1 = cur.half != 1;
        const char* nA = has_next ? nxt.a : cA; const char* nB = has_next ? nxt.b : cB;
#pragma unroll 1
        for (int t = 0; t < nt; t += 2) {
            const bool last = (t == nt - 2);
            const char* a1 = cA + (size_t)(t + 1) * kstep;
            const char* a2 = last ? nA : cA + (size_t)(t + 2) * kstep; const char* b2 = last ? nB : cB + (size_t)(t + 2) * kstep;
            const char* a3 = a2 + kstep; const char* b3 = b2 + kstep;
            if constexpr (SP2) {
            PG8_LDB(B0, 0, 0); PG8_LDB(B1, 0, 1); PG8_SCHED; PG8_LDA(At, 0, 0); PG8_STAGE(PG8_SA(1, 1), a1 + hstepA, voffA);
            PG8_WAIT_V(8); PG8_WAIT_L(0); PG8_BAR; if (do0) { PG8_MMA(0, 0, At, B0); PG8_MMA(0, 1, At, B1); } PG8_BAR; PG8_SCHED;
            PG8_LDA(At, 0, 1); PG8_STAGE(PG8_SB(0, 0), b2, voffB); PG8_STAGE(PG8_SB(0, 1), b2 + hstepB, voffB); PG8_STAGE(PG8_SA(0, 0), a2, voffA);
            PG8_WAIT_V(8); PG8_WAIT_L(0); PG8_BAR; if (do1) { PG8_MMA(1, 0, At, B0); PG8_MMA(1, 1, At, B1); } PG8_BAR; PG8_SCHED;
            PG8_LDB(B0, 1, 0); PG8_LDB(B1, 1, 1); PG8_SCHED; PG8_LDA(At, 1, 0); PG8_STAGE(PG8_SA(0, 1), a2 + hstepA, voffA);
            PG8_WAIT_V(8); PG8_WAIT_L(0); PG8_BAR; if (do0) { PG8_MMA(0, 0, At, B0); PG8_MMA(0, 1, At, B1); } PG8_BAR; PG8_SCHED;
            PG8_LDA(At, 1, 1); PG8_STAGE(PG8_SB(1, 0), b3, voffB); PG8_STAGE(PG8_SB(1, 1), b3 + hstepB, voffB); PG8_STAGE(PG8_SA(1, 0), a3, voffA);
            PG8_WAIT_V(8); PG8_WAIT_L(0); PG8_BAR; if (do1) { PG8_MMA(1, 0, At, B0); PG8_MMA(1, 1, At, B1); } PG8_BAR; PG8_SCHED;
            } else {
            PG8_LDB(B0, 0, 0); PG8_SCHED; PG8_LDA(At, 0, 0); PG8_STAGE(PG8_SA(1, 1), a1 + hstepA, voffA);
            PG8_WAIT_L(8); PG8_BAR; PG8_WAIT_L(0); PG8_MMA(0, 0, At, B0); PG8_BAR; PG8_SCHED;
            PG8_LDB(B1, 0, 1); PG8_STAGE(PG8_SB(0, 0), b2, voffB);
            PG8_BAR; PG8_WAIT_L(0); PG8_MMA(0, 1, At, B1); PG8_BAR;
            PG8_LDA(At, 0, 1); PG8_STAGE(PG8_SA(0, 0), a2, voffA);
            PG8_BAR; PG8_WAIT_L(0); PG8_MMA(1, 0, At, B0); PG8_BAR; PG8_SCHED;
            PG8_STAGE(PG8_SB(0, 1), b2 + hstepB, voffB);
            PG8_WAIT_V(6); PG8_BAR; PG8_MMA(1, 1, At, B1); PG8_BAR;
            PG8_LDB(B0, 1, 0); PG8_SCHED; PG8_LDA(At, 1, 0); PG8_STAGE(PG8_SA(0, 1), a2 + hstepA, voffA);
            PG8_WAIT_L(8); PG8_BAR; PG8_WAIT_L(0); PG8_MMA(0, 0, At, B0); PG8_BAR; PG8_SCHED;
            PG8_LDB(B1, 1, 1); PG8_STAGE(PG8_SB(1, 0), b3, voffB);
            PG8_BAR; PG8_WAIT_L(0); PG8_MMA(0, 1, At, B1); PG8_BAR;
            PG8_LDA(At, 1, 1); PG8_STAGE(PG8_SA(1, 0), a3, voffA);
            PG8_BAR; PG8_WAIT_L(0); PG8_MMA(1, 0, At, B0); PG8_BAR; PG8_SCHED;
            PG8_STAGE(PG8_SB(1, 1), b3 + hstepB, voffB);
            PG8_WAIT_V(6); PG8_BAR; PG8_MMA(1, 1, At, B1); PG8_BAR;
            }
        }
        if constexpr (ALIGN_EPI) { if (wr == 0) PG8_BAR; }
        E(acc, cur, wr, wc, fr, fq);
        if (!has_next) break;
        if (!E.keep(cur)) {
#pragma unroll
            for (int a = 0; a < 2; ++a)
#pragma unroll
                for (int b = 0; b < 2; ++b)
#pragma unroll
                    for (int m = 0; m < 4; ++m)
#pragma unroll
                        for (int n = 0; n < 2; ++n) acc[a][b][m][n] = (f32x4){0.f, 0.f, 0.f, 0.f};
        }
        cur = nxt; cA = nA; cB = nB; ++ui;
        if constexpr (ALIGN_EPI) { if (wr == 1) PG8_BAR; }
    }
    PG8_WAIT_V(0);
    if constexpr (!ALIGN_EPI) { if (wr == 0) PG8_BAR; }
    PG8_BAR;
#undef PG8_SA
#undef PG8_SB
#undef PG8_STAGE
#undef PG8_LDA
#undef PG8_LDB
#undef PG8_MMA
#undef PG8_WAIT_V
#undef PG8_WAIT_L
#undef PG8_BAR
#undef PG8_SCHED
}

typedef f32x4 Acc[2][2][4][2];

struct EpiProj {
    static constexpr bool PERM = true;
    bf16_t *cqkv, *gqkv, *og, *up, *misc; const LAS float* rs_tab; float* ssq;
    __device__ __forceinline__ bool keep(const Unit&) const { return false; }
    __device__ __forceinline__ void operator()(Acc& acc, const Unit& u, int wr, int wc, int fr, int fq) const {
        const int row0 = u.pm * BM + wr * 64 + fr;
        bf16_t* dst; int ld, coff; const int pn = u.pn;
        if (pn < 2) { dst = cqkv; ld = 512; coff = pn * 256; }
        else if (pn < 6) { dst = gqkv; ld = 1024; coff = (pn - 2) * 256; }
        else if (pn < 8) { dst = og; ld = 512; coff = (pn - 6) * 256; }
        else if (pn < 10) { dst = up; ld = 512; coff = (pn - 8) * 256; }
        else { dst = misc; ld = 256; coff = 0; }
        const int col0 = coff + wc * 32 + 8 * fq;
#pragma unroll
        for (int ai = 0; ai < 2; ++ai)
#pragma unroll
            for (int m = 0; m < 4; ++m) { if (u.half && ai != u.half - 1) continue;
                const int row = row0 + ai * HALF + m * 16;
                const float rs = rs_tab[wr * 64 + fr + ai * HALF + m * 16];
                float ss = 0.f;
#pragma unroll
                for (int bj = 0; bj < 2; ++bj) {
                    const f32x4 v0 = acc[ai][bj][m][0] * rs, v1 = acc[ai][bj][m][1] * rs;
                    ss += (v0[0] * v0[0] + v0[1] * v0[1]) + (v0[2] * v0[2] + v0[3] * v0[3]) + (v1[0] * v1[0] + v1[1] * v1[1]) + (v1[2] * v1[2] + v1[3] * v1[3]);
                    u32x4 w; w.x = cvt_pk_bf16(v0[0], v0[1]); w.y = cvt_pk_bf16(v0[2], v0[3]); w.z = cvt_pk_bf16(v1[0], v1[1]); w.w = cvt_pk_bf16(v1[2], v1[3]);
                    *(u32x4*)(dst + (size_t)row * ld + col0 + bj * HALF) = w;
                }
                if (pn < 2) { ss += __shfl_xor(ss, 16); ss += __shfl_xor(ss, 32); if (fq == 0) ssq[((size_t)pn * T + row) * 4 + wc] = ss; }
            }
    }
};
struct EpiUp {
    static constexpr bool PERM = true;
    bf16_t* out; const float* ssq;
    __device__ __forceinline__ bool keep(const Unit&) const { return false; }
    __device__ __forceinline__ void operator()(Acc& acc, const Unit& u, int wr, int wc, int fr, int fq) const {
        const int row0 = u.pm * BM + wr * 64 + fr, col0 = u.pn * BM + wc * 32 + 8 * fq;
        const float* sq = ssq + (u.pn < 3 ? (size_t)0 : (size_t)T * 4);
        f32x4 sqv[2][4];
#pragma unroll
        for (int ai = 0; ai < 2; ++ai)
#pragma unroll
            for (int m = 0; m < 4; ++m) sqv[ai][m] = *(const f32x4*)(sq + (size_t)(row0 + ai * HALF + m * 16) * 4);
#pragma unroll
        for (int ai = 0; ai < 2; ++ai)
#pragma unroll
            for (int m = 0; m < 4; ++m) { if (u.half && ai != u.half - 1) continue;
                const int row = row0 + ai * HALF + m * 16;
                const float rs = rsqrtf(((sqv[ai][m][0] + sqv[ai][m][1]) + (sqv[ai][m][2] + sqv[ai][m][3])) * (1.f / 256.f) + EPS);
#pragma unroll
                for (int bj = 0; bj < 2; ++bj) {
                    const f32x4 v0 = acc[ai][bj][m][0] * rs, v1 = acc[ai][bj][m][1] * rs;
                    u32x4 w; w.x = cvt_pk_bf16(v0[0], v0[1]); w.y = cvt_pk_bf16(v0[2], v0[3]); w.z = cvt_pk_bf16(v1[0], v1[1]); w.w = cvt_pk_bf16(v1[2], v1[3]);
                    *(u32x4*)(out + (size_t)row * 1792 + col0 + bj * HALF) = w;
                }
            }
    }
};
struct EpiGate {
    static constexpr bool PERM = true;
    unsigned char* acts; const LAS float* rs_tab;
    __device__ __forceinline__ bool keep(const Unit&) const { return false; }
    __device__ __forceinline__ void operator()(Acc& acc, const Unit& u, int wr, int wc, int fr, int fq) const {
        const int row0 = u.pm * BM + wr * 64 + fr, pl = u.pn >> 2, col0 = (u.pn & 3) * BM + wc * 32 + 8 * fq;
        bf16_t* dst = (bf16_t*)(acts + ((long long)A_G0 + (long long)(pl == 1) * (long long)(A_G1 - A_G0) + (long long)(pl == 2) * (long long)(A_G2 - A_G0)));
#pragma unroll
        for (int ai = 0; ai < 2; ++ai)
#pragma unroll
            for (int m = 0; m < 4; ++m) { if (u.half && ai != u.half - 1) continue;
                const int row = row0 + ai * HALF + m * 16;
                const float rs = rs_tab[wr * 64 + fr + ai * HALF + m * 16];
#pragma unroll
                for (int bj = 0; bj < 2; ++bj) {
                    f32x4 v0 = acc[ai][bj][m][0] * rs, v1 = acc[ai][bj][m][1] * rs;
#ifndef DBG_NOSIG
#pragma unroll
                    for (int e = 0; e < 4; ++e) { v0[e] = fast_sigmoid(fminf(fmaxf(v0[e], -60.f), 60.f)); v1[e] = fast_sigmoid(fminf(fmaxf(v1[e], -60.f), 60.f)); }
#endif
                    u32x4 w; w.x = cvt_pk_bf16(v0[0], v0[1]); w.y = cvt_pk_bf16(v0[2], v0[3]); w.z = cvt_pk_bf16(v1[0], v1[1]); w.w = cvt_pk_bf16(v1[2], v1[3]);
                    *(u32x4*)(dst + (size_t)row * 1024 + col0 + bj * HALF) = w;
                }
            }
    }
};
struct EpiMerge {
    static constexpr bool PERM = true;
    const unsigned char* acts; bf16_t* merged;
    __device__ __forceinline__ bool keep(const Unit& u) const { return u.kind < 2; }
    __device__ __forceinline__ void operator()(Acc& acc, const Unit& u, int wr, int wc, int fr, int fq) const {
        const int row0 = u.pm * BM + wr * 64 + fr, col0 = u.pn * BM + wc * 32 + 8 * fq, n = u.kind;
        const bf16_t* gn = (const bf16_t*)(acts + ((long long)A_G0 + (long long)(n == 1) * (long long)(A_G1 - A_G0) + (long long)(n == 2) * (long long)(A_G2 - A_G0)));
        const bf16_t* gd = (const bf16_t*)(acts + ((long long)A_G1 + (long long)(n != 0) * (long long)(A_G2 - A_G1)));
        if (n < 2) {
#pragma unroll
            for (int ai = 0; ai < 2; ++ai) {
                if (u.half && ai != u.half - 1) continue;
                u32x4 sn[4][2], sd[4][2];
#pragma unroll
                for (int m = 0; m < 4; ++m)
#pragma unroll
                    for (int bj = 0; bj < 2; ++bj) {
                        const size_t off = (size_t)(row0 + ai * HALF + m * 16) * 1024 + col0 + bj * HALF;
                        sn[m][bj] = *(const u32x4*)(gn + off); sd[m][bj] = *(const u32x4*)(gd + off);
                    }
#pragma unroll
                for (int m = 0; m < 4; ++m)
#pragma unroll
                    for (int bj = 0; bj < 2; ++bj) {
                        const u32x4 s = sn[m][bj], d = sd[m][bj];
                        f32x4 f0 = {bflo(s.x), bfhi(s.x), bflo(s.y), bfhi(s.y)}, f1 = {bflo(s.z), bfhi(s.z), bflo(s.w), bfhi(s.w)};
                        const f32x4 d0 = {bflo(d.x), bfhi(d.x), bflo(d.y), bfhi(d.y)}, d1 = {bflo(d.z), bfhi(d.z), bflo(d.w), bfhi(d.w)};
#pragma unroll
                        for (int e = 0; e < 4; ++e) { f0[e] *= __builtin_amdgcn_rcpf(d0[e]); f1[e] *= __builtin_amdgcn_rcpf(d1[e]); }
                        acc[ai][bj][m][0] = acc[ai][bj][m][0] * f0; acc[ai][bj][m][1] = acc[ai][bj][m][1] * f1;
                    }
            }
        } else {
#pragma unroll
            for (int ai = 0; ai < 2; ++ai) {
                if (u.half && ai != u.half - 1) continue;
                u32x4 sn[4][2];
#pragma unroll
                for (int m = 0; m < 4; ++m)
#pragma unroll
                    for (int bj = 0; bj < 2; ++bj) sn[m][bj] = *(const u32x4*)(gn + (size_t)(row0 + ai * HALF + m * 16) * 1024 + col0 + bj * HALF);
#pragma unroll
                for (int m = 0; m < 4; ++m)
#pragma unroll
                    for (int bj = 0; bj < 2; ++bj) {
                        const int row = row0 + ai * HALF + m * 16; const size_t off = (size_t)row * 1024 + col0 + bj * HALF;
                        const u32x4 s = sn[m][bj];
                        const f32x4 f0 = {bflo(s.x), bfhi(s.x), bflo(s.y), bfhi(s.y)}, f1 = {bflo(s.z), bfhi(s.z), bflo(s.w), bfhi(s.w)};
                        const f32x4 v0 = acc[ai][bj][m][0] * f0, v1 = acc[ai][bj][m][1] * f1;
                        u32x4 w; w.x = cvt_pk_bf16(v0[0], v0[1]); w.y = cvt_pk_bf16(v0[2], v0[3]); w.z = cvt_pk_bf16(v1[0], v1[1]); w.w = cvt_pk_bf16(v1[2], v1[3]);
                        *(u32x4*)((unsigned char*)(merged + off) + (row >= 8192 ? MERGED_HI_DELTA : 0)) = w;
                    }
            }
        }
    }
};
struct EpiResid {
    static constexpr bool PERM = true;
    bf16_t* xb; float* rowss_next;
    __device__ __forceinline__ bool keep(const Unit&) const { return false; }
    __device__ __forceinline__ void operator()(Acc& acc, const Unit& u, int wr, int wc, int fr, int fq) const {
        const int row0 = u.pm * BM + wr * 64 + fr, col0 = u.pn * BM + wc * 32 + 8 * fq;
#pragma unroll
        for (int ai = 0; ai < 2; ++ai) {
            if (u.half && ai != u.half - 1) continue;
            u32x4 ov[4][2];
#pragma unroll
            for (int m = 0; m < 4; ++m)
#pragma unroll
                for (int bj = 0; bj < 2; ++bj) ov[m][bj] = *(const u32x4*)(xb + (size_t)(row0 + ai * HALF + m * 16) * D + col0 + bj * HALF);
#pragma unroll
            for (int m = 0; m < 4; ++m) {
                const int row = row0 + ai * HALF + m * 16; float ss = 0.f;
#pragma unroll
                for (int bj = 0; bj < 2; ++bj) {
                    bf16_t* p = xb + (size_t)row * D + col0 + bj * HALF;
                    const u32x4 o = ov[m][bj];
                    const f32x4 v0 = (f32x4){bflo(o.x), bfhi(o.x), bflo(o.y), bfhi(o.y)} + acc[ai][bj][m][0], v1 = (f32x4){bflo(o.z), bfhi(o.z), bflo(o.w), bfhi(o.w)} + acc[ai][bj][m][1];
                    ss += ((v0[0] * v0[0] + v0[1] * v0[1]) + (v0[2] * v0[2] + v0[3] * v0[3])) + ((v1[0] * v1[0] + v1[1] * v1[1]) + (v1[2] * v1[2] + v1[3] * v1[3]));
                    u32x4 w; w.x = cvt_pk_bf16(v0[0], v0[1]); w.y = cvt_pk_bf16(v0[2], v0[3]); w.z = cvt_pk_bf16(v1[0], v1[1]); w.w = cvt_pk_bf16(v1[2], v1[3]);
                    *(u32x4*)p = w;
                }
                ss += __shfl_xor(ss, 16); ss += __shfl_xor(ss, 32); if (fq == 0) rowss_next[(size_t)row * 16 + u.pn * 4 + wc] = ss;
            }
        }
    }
};
template <bool MOE> struct EpiSwiglu {
    static constexpr bool PERM = true;
    bf16_t* act; int ld; const LAS float* rs_tab; const float* slot_scale; const float* slot_comb;
    __device__ __forceinline__ bool keep(const Unit&) const { return false; }
    __device__ __forceinline__ void operator()(Acc& acc, const Unit& u, int wr, int wc, int fr, int fq) const {
        const int row0 = u.pm * BM + wr * 64 + fr, col0 = u.pn * HALF + wc * 32 + 8 * fq;
        float rsv[2][4], cbv[2][4];
#pragma unroll
        for (int ai = 0; ai < 2; ++ai)
#pragma unroll
            for (int m = 0; m < 4; ++m) {
                if (MOE) { rsv[ai][m] = slot_scale[row0 + ai * HALF + m * 16]; cbv[ai][m] = slot_comb[row0 + ai * HALF + m * 16]; }
                else { rsv[ai][m] = rs_tab[wr * 64 + fr + ai * HALF + m * 16]; cbv[ai][m] = 1.f; }
            }
#pragma unroll
        for (int ai = 0; ai < 2; ++ai)
#pragma unroll
            for (int m = 0; m < 4; ++m) { if (u.half && ai != u.half - 1) continue;
                const int row = row0 + ai * HALF + m * 16;
                const float rs = rsv[ai][m], cb = cbv[ai][m];
                f32x4 o[2];
#pragma unroll
                for (int n = 0; n < 2; ++n) {
                    const f32x4 g = acc[ai][0][m][n] * rs, uu = acc[ai][1][m][n] * rs;
#pragma unroll
                    for (int e = 0; e < 4; ++e) o[n][e] = g[e] * fast_sigmoid(g[e]) * uu[e] * cb;
                }
                u32x4 w; w.x = cvt_pk_bf16(o[0][0], o[0][1]); w.y = cvt_pk_bf16(o[0][2], o[0][3]); w.z = cvt_pk_bf16(o[1][0], o[1][1]); w.w = cvt_pk_bf16(o[1][2], o[1][3]);
                *(u32x4*)(act + (size_t)row * ld + col0) = w;
            }
    }
};
struct EpiMoeDown {
    static constexpr bool PERM = true;
    bf16_t* y;
    __device__ __forceinline__ bool keep(const Unit&) const { return false; }
    __device__ __forceinline__ void operator()(Acc& acc, const Unit& u, int wr, int wc, int fr, int fq) const {
        const int row0 = u.pm * BM + wr * 64 + fr, col0 = u.pn * BM + wc * 32 + 8 * fq;
#pragma unroll
        for (int ai = 0; ai < 2; ++ai)
#pragma unroll
            for (int m = 0; m < 4; ++m) { if (u.half && ai != u.half - 1) continue;
                const int row = row0 + ai * HALF + m * 16;
#pragma unroll
                for (int bj = 0; bj < 2; ++bj) {
                    const f32x4 v0 = acc[ai][bj][m][0], v1 = acc[ai][bj][m][1];
                    u32x4 w; w.x = cvt_pk_bf16(v0[0], v0[1]); w.y = cvt_pk_bf16(v0[2], v0[3]); w.z = cvt_pk_bf16(v1[0], v1[1]); w.w = cvt_pk_bf16(v1[2], v1[3]);
                    *(u32x4*)(y + (size_t)row * D + col0 + bj * HALF) = w;
                }
            }
    }
};

struct SchedGrid {
    const char* A; const char* B; size_t a_tile, b_tile, a_alt; int nM, nN, G, c, alt_from; long long a_hi = 0;
    int split_from = 1 << 30;
    __device__ __forceinline__ bool next(int i, Unit& u) const {
        int L = i * G + c, hf = 0;
        if (L >= split_from) { const int nl = nM * nN - split_from, j = L - split_from; if (j >= 2 * nl) return false; hf = 1 + j / nl; L = split_from + j % nl; }
        if (L >= nM * nN) return false;
        int pm, pn; tile_map(L, nM, nN, pm, pn);
        u.pm = pm; u.pn = pn; u.kind = 0; u.half = hf; u.a = A + (size_t)pm * a_tile + (pn >= alt_from ? a_alt : 0) + (pm >= 32 ? a_hi : 0); u.b = B + (size_t)pn * b_tile; return true;
    }
};
struct SchedMerge {
    const char* acts; const char* wbr; int G, c;
    __device__ __forceinline__ bool next(int i, Unit& u) const {
        const int ti = i / 3, n = i - ti * 3, L = ti * G + c; if (L >= 256) return false;
        int pm, pn; tile_map(L, 64, 4, pm, pn);
        u.pm = pm; u.pn = pn; u.kind = n; u.half = 0; u.a = acts + ((long long)A_YSA + (long long)(n == 1) * ((long long)A_YSB - (long long)A_YSA) + (long long)(n == 2) * ((long long)A_POOLED - (long long)A_YSA)) + (size_t)pm * (256 * 512 * 2); u.b = wbr + (size_t)n * (1024 * 512 * 2) + (size_t)pn * (256 * 512 * 2); return true;
    }
};
struct SchedMoe {
    const char* A; const char* B; size_t a_tile, b_tile, b_exp; int MT, nN, G, c; int t1, t2, t3, t4, t5, t6, t7;
    int split_from = 1 << 30;
    __device__ __forceinline__ bool next(int i, Unit& u) const {
        int L = i * G + c, hf = 0;
        if (L >= split_from) { const int nl = MT * nN - split_from, j = L - split_from; if (j >= 2 * nl) return false; hf = 1 + j / nl; L = split_from + j % nl; }
        if (L >= MT * nN) return false;
        int pm, pn; tile_map(L, MT, nN, pm, pn);
        const int e = (pm >= t1) + (pm >= t2) + (pm >= t3) + (pm >= t4) + (pm >= t5) + (pm >= t6) + (pm >= t7);
        u.pm = pm; u.pn = pn; u.kind = e; u.half = hf; u.a = A + (size_t)pm * a_tile; u.b = B + (size_t)e * b_exp + (size_t)pn * b_tile; return true;
    }
};
}

#define XB_TMO      128
#define XB_XCNT(j)  (256  + 64 * (j))
#define XB_XSUB(j)  (1280 + 64 * (j))
#define XB_XGEN(j)  (2304 + 64 * (j))
#define XB_TOP      3328
#define XB_TOPGEN   3392
#define XCD_BAR_WORDS 3456
#define XB_SPIN_CAP (1u << 18)
__device__ __forceinline__ unsigned xb_ld(unsigned* p)              { return __hip_atomic_load(p, __ATOMIC_RELAXED, __HIP_MEMORY_SCOPE_AGENT); }
__device__ __forceinline__ unsigned xb_add(unsigned* p, unsigned v) { return __hip_atomic_fetch_add(p, v, __ATOMIC_RELAXED, __HIP_MEMORY_SCOPE_AGENT); }
__device__ __forceinline__ unsigned xb_xcc_id() { return (unsigned)__builtin_amdgcn_s_getreg((3 << 11) | 20) & 0xFu; }
#define XB_SPIN(cond, bar) do { unsigned _sp = 0; while (cond) { __builtin_amdgcn_s_sleep(1); \
    if ((++_sp & 255u) == 0u) { if (xb_ld(&(bar)[XB_TMO])) break; if (_sp > XB_SPIN_CAP) { atomicAdd(&(bar)[XB_TMO], 1u); break; } } } } while (0)
struct XcdBarrier { unsigned* bar; unsigned x; volatile LAS unsigned* st; };
__device__ __forceinline__ XcdBarrier xcd_barrier_post(unsigned* bar, volatile LAS unsigned* st) {
    XcdBarrier b; b.bar = bar; b.x = xb_xcc_id(); b.st = st;
    if (threadIdx.x == 0) (void)xb_add(&bar[XB_XCNT(b.x)], 1u);
    return b;
}
__device__ __forceinline__ void xcd_barrier_complete(unsigned* bar, unsigned x, unsigned& nloc, unsigned& nx) {
    const unsigned G = gridDim.x * gridDim.y * gridDim.z;
    unsigned sum, cnt, mine, sp = 0u;
    for (;;) {
        sum = 0u; cnt = 0u; mine = 0u;
#pragma unroll
        for (unsigned j = 0; j < 16; ++j) { const unsigned c = xb_ld(&bar[XB_XCNT(j)]); sum += c; cnt += (c > 0u) ? 1u : 0u; mine = (j == x) ? c : mine; }
        if (sum == G) break;
        __builtin_amdgcn_s_sleep(1);
        if ((++sp & 255u) == 0u) { if (xb_ld(&bar[XB_TMO])) break; if (sp > XB_SPIN_CAP) { atomicAdd(&bar[XB_TMO], 1u); break; } }
    }
    nloc = mine > 0u ? mine : 1u; nx = cnt > 0u ? cnt : 1u;
}
__device__ __forceinline__ void xcd_barrier(const XcdBarrier& b) {
    asm volatile("s_waitcnt vmcnt(0)" ::: "memory");
    __syncthreads();
    if (threadIdx.x == 0) {
        unsigned* bar = b.bar;
        __builtin_amdgcn_s_waitcnt(0);
        unsigned nloc = b.st[0], nx = b.st[1];
        if (nloc == 0u) { xcd_barrier_complete(bar, b.x, nloc, nx); b.st[0] = nloc; b.st[1] = nx; }
        const unsigned old = xb_add(&bar[XB_XSUB(b.x)], 1u);
        const unsigned gen = old / nloc;
        if (old + 1u == (gen + 1u) * nloc) {
            __builtin_amdgcn_fence(__ATOMIC_RELEASE, "agent");
            asm volatile("s_waitcnt vmcnt(0)" ::: "memory");
            const unsigned og = xb_add(&bar[XB_TOP], 1u);
            const unsigned tg = og / nx;
            if (og + 1u == (tg + 1u) * nx) xb_add(&bar[XB_TOPGEN], 1u);
            else XB_SPIN(xb_ld(&bar[XB_TOPGEN]) == tg, bar);
            __builtin_amdgcn_fence(__ATOMIC_ACQUIRE, "agent");
            xb_add(&bar[XB_XGEN(b.x)], 1u);
            asm volatile("s_waitcnt vmcnt(0)" ::: "memory");
        } else {
            XB_SPIN(xb_ld(&bar[XB_XGEN(b.x)]) == gen, bar);
            __builtin_amdgcn_fence(__ATOMIC_ACQUIRE, "agent");
            asm volatile("s_waitcnt vmcnt(0)" ::: "memory");
        }
    }
    __syncthreads();
}

struct Frame {
    LAS unsigned char* lds;
    volatile LAS unsigned* MISC;
    unsigned* ctl; float* ctlf; float* stats;
    unsigned char* ws;
    int tid, lane, wave, vcu, G;
    const CAS GPtr* inp;
    float* out;
    __device__ __forceinline__ const float* in(int i) const { return (const float*)inp[i]; }
};
enum { I_X = 0, I_POS, I_GMIX, I_WIN, I_GCQ, I_WUQ, I_GCKV, I_WUKV, I_GQKQ, I_GQKK, I_WGLA, I_BGLA, I_GGLAO, I_WPOOL, I_PSCALE, I_WBR, I_WOUT, I_GFFN, I_WFG, I_WFU, I_WFD, I_WROUTER, I_WEG, I_WEU, I_WED };

__device__ __forceinline__ bf16_t* act_ptr(const Frame& F, size_t off) { return (bf16_t*)(F.ws + WS_ACTS + off); }
__device__ __forceinline__ unsigned char* wblk(const Frame& F, int layer) { return F.ws + (layer == 0 ? WS_W0 : WS_W1); }

__device__ __forceinline__ void fill_rs(Frame& F, const float* rowss, int pm) {
    if (F.tid < 256) ((LAS float*)(F.lds + RS_OFF))[F.tid] = rsqrtf(sum16(rowss + ((size_t)pm * 256 + F.tid) * 16) * (1.f / 1024.f) + EPS);
    __syncthreads();
}
struct ConvSeg { const float* src; int ld, K, width, col0; bf16_t* dst; int row0, inter; const float* gain; };
typedef short v4i16c_t __attribute__((ext_vector_type(4)));
__device__ __forceinline__ int seg_items(const ConvSeg& s) { return (s.K >> 6) * ((s.width + 63) >> 6); }
__device__ __forceinline__ void conv_load(const ConvSeg& s, int item, int lane, f32x4 (&v)[16], float (&gv)[16]) {
    const int nblk = (s.width + 63) >> 6, kb = item / nblk, nb = item - kb * nblk, k0 = kb * 64, n0 = nb * 64;
    const int kq = lane >> 4, n4 = (lane & 15) * 4; const bool ok = n0 + n4 < s.width;
    const float* p = s.src + (size_t)(k0 + kq) * s.ld + s.col0 + n0 + n4;
#pragma unroll
    for (int i = 0; i < 16; ++i) v[i] = ok ? *(const f32x4*)(p + (size_t)(4 * i) * s.ld) : (f32x4){0.f, 0.f, 0.f, 0.f};
    const bool hg = s.gain != nullptr; const float* gp = hg ? s.gain + k0 + kq : s.src;
#pragma unroll
    for (int i = 0; i < 16; ++i) { const float g = gp[hg ? 4 * i : 0]; gv[i] = hg ? g : 1.f; }
}
__device__ __forceinline__ void conv_store(const ConvSeg& s, int item, LAS unsigned char* scr, int lane, const f32x4 (&v)[16], const float (&gv)[16]) {
    const int nblk = (s.width + 63) >> 6, kb = item / nblk, nb = item - kb * nblk, k0 = kb * 64, n0 = nb * 64;
    const int kq = lane >> 4, n4 = (lane & 15) * 4;
#pragma unroll
    for (int i = 0; i < 16; ++i) {
        const f32x4 x = v[i] * gv[i];
        *(LAS u32x2*)(scr + (4 * i + kq) * 136 + n4 * 2) = (u32x2){cvt_pk_bf16(x[0], x[1]), cvt_pk_bf16(x[2], x[3])};
    }
    LDS_WAIT();
    const int g = lane >> 4, i16 = lane & 15;
#pragma unroll
    for (int nb16 = 0; nb16 < 4; ++nb16)
#pragma unroll
        for (int kh = 0; kh < 2; ++kh) {
            const int c = kh * 4 + g;
            const LAS unsigned char* a = scr + (8 * c + (i16 >> 2)) * 136 + (nb16 * 16 + (i16 & 3) * 4) * 2;
            const v4i16c_t lo = __builtin_amdgcn_ds_read_tr16_b64_v4i16((LAS v4i16c_t*)a), hi = __builtin_amdgcn_ds_read_tr16_b64_v4i16((LAS v4i16c_t*)(a + 4 * 136));
            const int nq = n0 + nb16 * 16 + i16;
            if (nq < s.width) {
                const int drow = s.row0 + (s.inter ? ((nq >> 7) * 256 + (nq & 127)) : nq);
                typedef short s16x8_t __attribute__((ext_vector_type(8)));
                *(s16x8_t*)(s.dst + (size_t)drow * s.K + k0 + 8 * c) = (s16x8_t){lo[0], lo[1], lo[2], lo[3], hi[0], hi[1], hi[2], hi[3]};
            }
        }
    LDS_WAIT();
}
__device__ __forceinline__ ConvSeg mixer_seg(const Frame& F, int l, int idx) {
    unsigned char* wb = wblk(F, l);
    ConvSeg s; s.inter = 0; s.row0 = 0; s.col0 = 0;
    if (idx < 10) {
        int c0, wd, r0;
        switch (idx) {
            case 0: c0 = 0; wd = 256; r0 = 0; break;
            case 1: c0 = 256; wd = 256; r0 = 256; break;
            case 2: c0 = 544; wd = 256; r0 = 512; break;
            case 3: c0 = 800; wd = 256; r0 = 768; break;
            case 4: c0 = 1056; wd = 512; r0 = 1024; break;
            case 5: c0 = 1584; wd = 512; r0 = 1536; break;
            case 6: c0 = 2096; wd = 512; r0 = 2048; break;
            case 7: c0 = 512; wd = 32; r0 = 2560; break;
            case 8: c0 = 1568; wd = 16; r0 = 2592; break;
            default: c0 = 2608; wd = 3072; r0 = 0; break;
        }
        s.src = F.in(I_WIN) + (size_t)l * D * DIN; s.ld = DIN; s.K = D; s.width = wd; s.col0 = c0;
        s.dst = (bf16_t*)(wb + (idx == 9 ? WO_G : WO_IN)); s.row0 = r0; s.gain = F.in(I_GMIX) + l * D;
    } else if (idx == 10) { s.src = F.in(I_WUQ) + (size_t)l * 256 * 768; s.ld = 768; s.K = 256; s.width = 768; s.dst = (bf16_t*)(wb + WO_UP); s.gain = F.in(I_GCQ) + l * 256; }
    else if (idx == 11) { s.src = F.in(I_WUKV) + (size_t)l * 256 * 1024; s.ld = 1024; s.K = 256; s.width = 1024; s.dst = (bf16_t*)(wb + WO_UP); s.row0 = 768; s.gain = F.in(I_GCKV) + l * 256; }
    else if (idx < 14) { const int n = idx - 12; s.src = F.in(I_WBR) + (size_t)(l * 3 + n) * 512 * D; s.ld = D; s.K = 512; s.width = D; s.dst = (bf16_t*)(wb + WO_BR) + (size_t)n * 1024 * 512; s.gain = nullptr; }
    else { s.src = F.in(I_WOUT) + (size_t)l * D * D; s.ld = D; s.K = D; s.width = D; s.dst = (bf16_t*)(wb + WO_OUT); s.gain = nullptr; }
    return s;
}
__device__ __forceinline__ ConvSeg ffn_seg(const Frame& F, int idx) {
    unsigned char* wb = F.ws + WS_W0; ConvSeg s; s.col0 = 0; s.inter = 0; s.row0 = 0;
    if (idx < 2) { s.src = F.in(idx == 0 ? I_WFG : I_WFU); s.ld = DFF; s.K = D; s.width = DFF; s.dst = (bf16_t*)(wb + WO_FGU); s.row0 = idx * 128; s.inter = 1; s.gain = F.in(I_GFFN); }
    else { s.src = F.in(I_WFD); s.ld = D; s.K = DFF; s.width = D; s.dst = (bf16_t*)(wb + WO_FD); s.gain = nullptr; }
    return s;
}
__device__ __forceinline__ ConvSeg moe_seg(const Frame& F, int idx) {
    unsigned char* wb = F.ws + WS_W0; const int e = idx / 3, k = idx - e * 3; ConvSeg s; s.col0 = 0; s.inter = 0; s.row0 = 0;
    if (k < 2) { s.src = F.in(k == 0 ? I_WEG : I_WEU) + (size_t)e * D * DEXP; s.ld = DEXP; s.K = D; s.width = DEXP; s.dst = (bf16_t*)(wb + WO_MGU) + (size_t)e * 2816 * 1024; s.row0 = k * 128; s.inter = 1; s.gain = F.in(I_GFFN) + D; }
    else { s.src = F.in(I_WED) + (size_t)e * DEXP * D; s.ld = D; s.K = DEXP; s.width = D; s.dst = (bf16_t*)(wb + WO_MD) + (size_t)e * 1024 * 1408; s.gain = nullptr; }
    return s;
}
#define CONV_LOCATE(NSEG, GETSEG, IT, SEGOUT, IDXOUT) do { int r_ = (IT); for (int si_ = 0; si_ < (NSEG); ++si_) { const ConvSeg sg_ = GETSEG; const int n_ = seg_items(sg_); SEGOUT = sg_; IDXOUT = r_; if (r_ < n_) break; r_ -= n_; } } while (0)
#define CONV_LOOP(NSEG, GETSEG) do { int total_ = 0; for (int si_ = 0; si_ < (NSEG); ++si_) { const ConvSeg sg_ = GETSEG; total_ += seg_items(sg_); } \
        int it_ = gw; if (it_ < total_) { ConvSeg cs_; int ci_ = 0; f32x4 va_[16]; float ga_[16]; CONV_LOCATE(NSEG, GETSEG, it_, cs_, ci_); conv_load(cs_, ci_, F.lane, va_, ga_); \
        for (;;) { const int nx_ = it_ + NGW; const bool hn_ = nx_ < total_; ConvSeg ns_; int ni_ = 0; f32x4 vb_[16]; float gb_[16]; CONV_LOCATE(NSEG, GETSEG, (hn_ ? nx_ : it_), ns_, ni_); conv_load(ns_, ni_, F.lane, vb_, gb_); \
            _Pragma("unroll") for (int q_ = 0; q_ < 16; ++q_) { asm volatile("" : "+v"(va_[q_])); asm volatile("" : "+v"(ga_[q_])); } \
            conv_store(cs_, ci_, (LAS unsigned char*)scr, F.lane, va_, ga_); if (!hn_) break; \
            _Pragma("unroll") for (int q_ = 0; q_ < 16; ++q_) { va_[q_] = vb_[q_]; ga_[q_] = gb_[q_]; } cs_ = ns_; ci_ = ni_; it_ = nx_; } } } while (0)
__device__ __forceinline__ void fold_pool(const Frame& F, int l, int gw, int NGW) {
    const float* wp = F.in(I_WPOOL) + (size_t)l * 4 * 128 * 128; const float* ps = F.in(I_PSCALE) + l * 512; const float* wb2 = F.in(I_WBR) + (size_t)(l * 3 + 2) * 512 * D;
    bf16_t* dst = (bf16_t*)(wblk(F, l) + WO_BR) + (size_t)2 * 1024 * 512;
    LAS float* sw = (LAS float*)(F.lds + F.wave * 16384);
    for (int it = gw; it < 1024; it += NGW) {
        const int db = it & 15, g = (it >> 4) & 3, cb = it >> 6, d = db * 64 + F.lane, c0 = cb * 8;
        {
            const float* wrow = wp + (size_t)(g * 128 + c0) * 128 + F.lane * 16;
            const f32x4 r0 = *(const f32x4*)wrow, r1 = *(const f32x4*)(wrow + 4), r2 = *(const f32x4*)(wrow + 8), r3 = *(const f32x4*)(wrow + 12);
            const float p0 = ps[g * 128 + 2 * F.lane], p1 = ps[g * 128 + 2 * F.lane + 1];
            LAS f32x4* o = (LAS f32x4*)(sw + F.lane * 16); o[0] = r0; o[1] = r1; o[2] = r2; o[3] = r3;
            sw[1024 + 2 * F.lane] = p0; sw[1024 + 2 * F.lane + 1] = p1;
        }
        LDS_WAIT();
        float a[8];
#pragma unroll
        for (int i = 0; i < 8; ++i) a[i] = 0.f;
#pragma unroll 1
        for (int j0 = 0; j0 < 128; j0 += 16) {
            float wv[16];
#pragma unroll
            for (int jj = 0; jj < 16; ++jj) wv[jj] = wb2[(size_t)(g * 128 + j0 + jj) * D + d];
#pragma unroll
            for (int jj = 0; jj < 16; ++jj) asm volatile("" : "+v"(wv[jj]));
#pragma unroll
            for (int j4 = 0; j4 < 16; j4 += 4) {
                const f32x4 sc = *(const LAS f32x4*)(sw + 1024 + j0 + j4);
                f32x4 w4;
#pragma unroll
                for (int e = 0; e < 4; ++e) w4[e] = wv[j4 + e] * sc[e];
#pragma unroll
                for (int i = 0; i < 8; ++i) {
                    const f32x4 pr = *(const LAS f32x4*)(sw + i * 128 + j0 + j4);
#pragma unroll
                    for (int e = 0; e < 4; ++e) a[i] = fmaf(pr[e], w4[e], a[i]);
                }
            }
        }
        u32x4 o; o.x = cvt_pk_bf16(a[0], a[1]); o.y = cvt_pk_bf16(a[2], a[3]); o.z = cvt_pk_bf16(a[4], a[5]); o.w = cvt_pk_bf16(a[6], a[7]);
        *(u32x4*)(dst + (size_t)d * 512 + g * 128 + c0) = o;
        LDS_WAIT();
    }
}

__device__ __forceinline__ void p0_prologue(Frame& F) {
    LAS float* scr = (LAS float*)(F.lds + F.wave * 16384);
    const int gw = F.vcu * 8 + F.wave, NGW = F.G * 8;
    { bf16_t* xb = (bf16_t*)(F.ws + WS_XB); float* rss = F.stats + SF_ROWSS;
      for (int m0 = gw; m0 < T; m0 += 4 * NGW) {
          f32x4 v[4][4];
#pragma unroll
          for (int r = 0; r < 4; ++r) { const int m = m0 + r * NGW < T ? m0 + r * NGW : m0; const f32x4* xr = (const f32x4*)(F.in(I_X) + (size_t)m * D) + F.lane;
#pragma unroll
              for (int j = 0; j < 4; ++j) v[r][j] = xr[64 * j]; }
#pragma unroll
          for (int r = 0; r < 4; ++r)
#pragma unroll
              for (int j = 0; j < 4; ++j) asm volatile("" : "+v"(v[r][j]));
#pragma unroll
          for (int r = 0; r < 4; ++r) { const int m = m0 + r * NGW; if (m >= T) break; float s = 0.f;
              unsigned long long* o8 = (unsigned long long*)(xb + (size_t)m * D) + F.lane;
#pragma unroll
              for (int j = 0; j < 4; ++j) { const f32x4 w = v[r][j]; s += (w[0] * w[0] + w[1] * w[1]) + (w[2] * w[2] + w[3] * w[3]);
                  o8[64 * j] = (unsigned long long)cvt_pk_bf16(w[0], w[1]) | ((unsigned long long)cvt_pk_bf16(w[2], w[3]) << 32); }
              s = wave_sum(s); if (F.lane < 16) rss[(size_t)m * 16 + F.lane] = (F.lane == 0) ? s : 0.f; }
      } }
    { float* rt = (float*)(F.ws + WS_ROPE); const int* pos = (const int*)F.in(I_POS);
      for (int i = F.vcu * 512 + F.tid; i < T * 16; i += F.G * 512) {
          const int t = i >> 4, k = i & 15; const float inv = powf(10000.f, -(float)k / 16.f), ang = (float)pos[t] * inv;
          rt[t * 32 + k] = cosf(ang); rt[t * 32 + 16 + k] = sinf(ang);
      } }
    CONV_LOOP(15, mixer_seg(F, 0, si_));
    fold_pool(F, 0, gw, NGW);
}

__device__ __forceinline__ void gla_prep(Frame& F, int l, int unit);
__device__ __forceinline__ void phase_prep(Frame& F, int l, int rpt = 0) {
    const bf16_t* raw = act_ptr(F, A_QKVRAW); const bf16_t* misc = act_ptr(F, A_MISC);
    bf16_t* QH = act_ptr(F, A_QH); bf16_t* KH = act_ptr(F, A_KH); bf16_t* VT = act_ptr(F, A_VT);
    const float* rope = (const float*)(F.ws + WS_ROPE);
    const float* gq = F.in(I_GQKQ) + l * 96; const float* gk = F.in(I_GQKK) + l * 96;
    LAS bf16_t* vt = (LAS bf16_t*)F.lds;
    LAS float* gls = (LAS float*)(F.lds + 81920);
    if (F.tid < 192) gls[F.tid] = F.tid < 96 ? gq[F.tid] : gk[F.tid - 96];
    __syncthreads();
    for (int unit = F.vcu; unit < T / 64; unit += F.G) {
        const int t0 = unit * 64, b = t0 / SEQ, s0 = t0 % SEQ;
        if (!rpt) gla_prep(F, l, unit);
#pragma unroll 1
        for (int it = F.tid; it < 1024; it += 512) {
            const int which = it & 1, h = (it >> 1) & 7, tok = it >> 4, t = t0 + tok;
            const bf16_t* nope = raw + (size_t)t * 1792 + (which ? 768 + h * 128 : h * 96);
            const bf16_t* rp = which ? misc + (size_t)t * 256 : nope + 64;
            const LAS float* g = gls + which * 96;
            u32x4 c[12];
#pragma unroll
            for (int i = 0; i < 8; ++i) c[i] = *(const u32x4*)(nope + 8 * i);
#pragma unroll
            for (int i = 0; i < 4; ++i) c[8 + i] = *(const u32x4*)(rp + 8 * i);
            float ss = 0.f;
#pragma unroll
            for (int i = 0; i < 12; ++i) {
                const float a0 = bflo(c[i].x), a1 = bfhi(c[i].x), a2 = bflo(c[i].y), a3 = bfhi(c[i].y), a4 = bflo(c[i].z), a5 = bfhi(c[i].z), a6 = bflo(c[i].w), a7 = bfhi(c[i].w);
                ss += (a0 * a0 + a1 * a1) + (a2 * a2 + a3 * a3) + (a4 * a4 + a5 * a5) + (a6 * a6 + a7 * a7);
            }
            float r = rsqrtf(ss * (1.f / 96.f) + EPS);
            if (!which) r *= 0.14724444f;
            bf16_t* dst = (which ? KH : QH) + ((size_t)(b * 8 + h) * SEQ + s0 + tok) * 96;
#pragma unroll
            for (int i = 0; i < 8; ++i) {
                if ((i & 1) == 0) __builtin_amdgcn_sched_barrier(0);
                const f32x4 g0 = *(const LAS f32x4*)(g + 8 * i), g1 = *(const LAS f32x4*)(g + 8 * i + 4);
                u32x4 o; o.x = cvt_pk_bf16(bflo(c[i].x) * r * g0[0], bfhi(c[i].x) * r * g0[1]); o.y = cvt_pk_bf16(bflo(c[i].y) * r * g0[2], bfhi(c[i].y) * r * g0[3]);
                o.z = cvt_pk_bf16(bflo(c[i].z) * r * g1[0], bfhi(c[i].z) * r * g1[1]); o.w = cvt_pk_bf16(bflo(c[i].w) * r * g1[2], bfhi(c[i].w) * r * g1[3]);
                *(u32x4*)(dst + 8 * i) = o;
            }
#pragma unroll
            for (int hh = 0; hh < 2; ++hh) {
                const u32x4 x1c = c[8 + hh], x2c = c[10 + hh];
                float x1[8] = {bflo(x1c.x), bfhi(x1c.x), bflo(x1c.y), bfhi(x1c.y), bflo(x1c.z), bfhi(x1c.z), bflo(x1c.w), bfhi(x1c.w)};
                float x2[8] = {bflo(x2c.x), bfhi(x2c.x), bflo(x2c.y), bfhi(x2c.y), bflo(x2c.z), bfhi(x2c.z), bflo(x2c.w), bfhi(x2c.w)};
                float o1[8], o2[8];
#pragma unroll
                for (int i = 0; i < 8; ++i) {
                    const int k = hh * 8 + i; const float cs = rope[(size_t)t * 32 + k], sn = rope[(size_t)t * 32 + 16 + k];
                    const float a = x1[i] * r * g[64 + k], bb = x2[i] * r * g[80 + k];
                    o1[i] = a * cs - bb * sn; o2[i] = bb * cs + a * sn;
                }
                u32x4 w1, w2; w1.x = cvt_pk_bf16(o1[0], o1[1]); w1.y = cvt_pk_bf16(o1[2], o1[3]); w1.z = cvt_pk_bf16(o1[4], o1[5]); w1.w = cvt_pk_bf16(o1[6], o1[7]);
                w2.x = cvt_pk_bf16(o2[0], o2[1]); w2.y = cvt_pk_bf16(o2[2], o2[3]); w2.z = cvt_pk_bf16(o2[4], o2[5]); w2.w = cvt_pk_bf16(o2[6], o2[7]);
                *(u32x4*)(dst + 64 + hh * 8) = w1; *(u32x4*)(dst + 80 + hh * 8) = w2;
            }
        }
        {
            const int tok = F.tid >> 3, cc = F.tid & 7;
            u32x4 vr[8];
#pragma unroll
            for (int h = 0; h < 8; ++h) vr[h] = *(const u32x4*)(raw + (size_t)(t0 + tok) * 1792 + 768 + h * 128 + 64 + cc * 8);
#pragma unroll
            for (int h = 0; h < 8; ++h) *(LAS u32x4*)(F.lds + h * 9216 + tok * 144 + cc * 16) = vr[h];
            __syncthreads();
            const int db = F.wave & 3, c = (F.wave >> 2) * 4 + (F.lane >> 4), i16 = F.lane & 15;
#pragma unroll
            for (int h = 0; h < 8; ++h) {
                const LAS unsigned char* a = F.lds + h * 9216 + (8 * c + (i16 >> 2)) * 144 + (16 * db + (i16 & 3) * 4) * 2;
                const v4i16c_t lo = __builtin_amdgcn_ds_read_tr16_b64_v4i16((LAS v4i16c_t*)a), hi = __builtin_amdgcn_ds_read_tr16_b64_v4i16((LAS v4i16c_t*)(a + 4 * 144));
                typedef short s16x8_t __attribute__((ext_vector_type(8)));
                bf16_t* vrow = VT + (((size_t)(b * 8 + h) * (SEQ / 64) + (s0 >> 6)) * 64 + 16 * db + i16) * 64;
                *(v4i16c_t*)(vrow + 4 * c) = lo; *(v4i16c_t*)(vrow + 32 + 4 * c) = hi;
            }
            __syncthreads();
        }
    }
}

constexpr int AT_KROW = 208, AT_KT = 64 * AT_KROW, AT_VROW = 144, AT_VTB = 64 * AT_VROW, AT_SLOT = AT_KT + AT_VTB, AT_NSLOT = 5, AT_DUMMY = AT_NSLOT * AT_SLOT;
static_assert(AT_KT == 13 * 1024 && AT_VTB == 9 * 1024 && AT_DUMMY + 8 * 1024 <= RING_BYTES, "attention ring");
#ifdef AT_TPROBE
#define TP_B(k) do { if (AT_TPROBE == (k)) tp0 = __builtin_readcyclecounter(); } while (0)
#define TP_E(k) do { if (AT_TPROBE == (k)) tpacc += __builtin_readcyclecounter() - tp0; } while (0)
#else
#define TP_B(k) do {} while (0)
#define TP_E(k) do {} while (0)
#endif
__device__ __forceinline__ void attn_unit(Frame& F, int bh, int qb, unsigned long long& tpacc) {
#ifdef AT_TPROBE
    unsigned long long tp0 = 0;
#endif
    TP_B(0);
    const int lane = F.lane, wid = F.wave, r32 = lane & 31, hi = lane >> 5, grp = wid >> 2;
    const bf16_t* QHp = act_ptr(F, A_QH) + ((size_t)bh * SEQ + qb * 256 + wid * 32) * 96;
    const char* Kb = (const char*)(act_ptr(F, A_KH) + (size_t)bh * SEQ * 96);
    const char* Vb = (const char*)(act_ptr(F, A_VT) + (size_t)bh * 64 * SEQ);
    LAS unsigned char* lds = F.lds;
    bf16x8 qr[6];
#pragma unroll
    for (int s = 0; s < 6; ++s) qr[s] = *(const bf16x8*)(QHp + (size_t)r32 * 96 + 16 * s + 8 * hi);
    const int NT = 4 * (qb + 1);
    const char *dp0, *dp1, *dp2;
    { const int P = 64 * wid + lane, row = P / 13, col = P % 13; dp0 = Kb + row * 192 + (col == 12 ? 0 : col) * 16; }
    if (wid < 5) { const int P = 64 * (wid + 8) + lane, row = P / 13, col = P % 13; dp1 = Kb + row * 192 + (col == 12 ? 0 : col) * 16; }
    else { const int P = 64 * (wid - 5) + lane, d = P / 9, col = P % 9; dp1 = Vb + d * 128 + (col == 8 ? 0 : col) * 16; }
    { const int P = 64 * (wid + 3) + lane, d = (P / 9) & 63, col = P % 9; dp2 = Vb + d * 128 + (col == 8 ? 0 : col) * 16; }
    const unsigned st1 = wid < 5 ? 12288u : 8192u;
    const bool w3 = wid < 6;
#define AT_DMA_ONE(j, sl) do { const int sl_ = (sl); LAS unsigned char* d_ = lds + sl_ + wid * 1024; const int c1_ = sl_ == AT_DUMMY ? 0 : 8192; \
        __builtin_amdgcn_global_load_lds((const unsigned*)(dp0 + (size_t)(j) * 12288), (LAS unsigned*)d_, 16, 0, 0); \
        __builtin_amdgcn_global_load_lds((const unsigned*)(dp1 + (size_t)(j) * st1), (LAS unsigned*)(d_ + c1_), 16, 0, 0); \
        if (w3) __builtin_amdgcn_global_load_lds((const unsigned*)(dp2 + (size_t)(j) * 8192), (LAS unsigned*)(d_ + 2 * c1_), 16, 0, 0); } while (0)
#ifdef AT_PROBE_DMA2
#define AT_DMA(j, sl) do { AT_DMA_ONE(j, sl); AT_DMA_ONE(j, sl); } while (0)
#define AT_WAIT2() do { if (w3) asm volatile("s_waitcnt vmcnt(12)" ::: "memory"); else asm volatile("s_waitcnt vmcnt(8)" ::: "memory"); } while (0)
#else
#define AT_DMA(j, sl) AT_DMA_ONE(j, sl)
#define AT_WAIT2() do { if (w3) asm volatile("s_waitcnt vmcnt(6)" ::: "memory"); else asm volatile("s_waitcnt vmcnt(4)" ::: "memory"); } while (0)
#endif
#define AT_WAIT1() do { if (w3) asm volatile("s_waitcnt vmcnt(3)" ::: "memory"); else asm volatile("s_waitcnt vmcnt(2)" ::: "memory"); } while (0)
#define AT_WAIT_NEXT(t) do { if ((t) + 3 < NT) AT_WAIT2(); else if ((t) + 3 == NT) AT_WAIT1(); else VM_WAIT(); } while (0)
    AT_DMA(0, 0); AT_DMA(1, AT_SLOT); AT_DMA(2, 2 * AT_SLOT); AT_DMA(3, 3 * AT_SLOT);
#ifdef AT_PROBE_DMA2
    if (w3) asm volatile("s_waitcnt vmcnt(18)" ::: "memory"); else asm volatile("s_waitcnt vmcnt(12)" ::: "memory");
#else
    if (w3) asm volatile("s_waitcnt vmcnt(9)" ::: "memory"); else asm volatile("s_waitcnt vmcnt(6)" ::: "memory");
#endif
    LDS_BARRIER();
    float m_run = 0.f, l_run = 0.f;
    f32x16 o0, o1, negm;
#pragma unroll
    for (int r = 0; r < 16; ++r) { o0[r] = 0.f; o1[r] = 0.f; negm[r] = 0.f; }
    const unsigned kfr = (unsigned)(r32 * AT_KROW + hi * 16), vfr = (unsigned)(AT_KT + r32 * AT_VROW + hi * 64);
    if (grp) LDS_BARRIER();
    int slot = 0, wslot = 4;
    const int NTw = 4 * qb + (wid >> 1) + 1;
    TP_B(1);
    for (int t = 0; t < NTw; ++t) {
        const int jb = t - 4 * qb;
        const LAS unsigned char* sb = lds + slot * AT_SLOT;
        f32x16 p0, p1;
        TP_B(2);
        {
            const LAS unsigned char* kb = sb + kfr;
            bf16x8 ka[6], kc[6];
#pragma unroll
            for (int s = 0; s < 6; ++s) { ka[s] = *(const LAS bf16x8*)(kb + s * 32); kc[s] = *(const LAS bf16x8*)(kb + 32 * AT_KROW + s * 32); }
            __builtin_amdgcn_sched_barrier(0);
            __builtin_amdgcn_s_setprio(1);
            p0 = __builtin_amdgcn_mfma_f32_32x32x16_bf16(ka[0], qr[0], negm, 0, 0, 0);
            p1 = __builtin_amdgcn_mfma_f32_32x32x16_bf16(kc[0], qr[0], negm, 0, 0, 0);
#pragma unroll
            for (int s = 1; s < 6; ++s) {
                p0 = __builtin_amdgcn_mfma_f32_32x32x16_bf16(ka[s], qr[s], p0, 0, 0, 0);
                p1 = __builtin_amdgcn_mfma_f32_32x32x16_bf16(kc[s], qr[s], p1, 0, 0, 0);
            }
            __builtin_amdgcn_s_setprio(0);
#ifdef AT_PROBE_SEG1X2
            asm volatile("" : "+v"(p0), "+v"(p1));
            p0 = __builtin_amdgcn_mfma_f32_32x32x16_bf16(ka[0], qr[0], negm, 0, 0, 0);
            p1 = __builtin_amdgcn_mfma_f32_32x32x16_bf16(kc[0], qr[0], negm, 0, 0, 0);
#pragma unroll
            for (int s = 1; s < 6; ++s) {
                p0 = __builtin_amdgcn_mfma_f32_32x32x16_bf16(ka[s], qr[s], p0, 0, 0, 0);
                p1 = __builtin_amdgcn_mfma_f32_32x32x16_bf16(kc[s], qr[s], p1, 0, 0, 0);
            }
#endif
            asm volatile("" : "+v"(p0), "+v"(p1));
        }
        TP_E(2);
        TP_B(3);
        AT_WAIT2();
        TP_E(3);
        TP_B(4);
        LDS_BARRIER();
        TP_E(4);
        AT_DMA(min(t + 4, NT - 1), t + 4 < NT ? wslot * AT_SLOT : AT_DUMMY);
        TP_B(5);
        {
            const LAS unsigned char* vb = sb + vfr;
            bf16x8 va[4], vc2[4];
#pragma unroll
            for (int s = 0; s < 4; ++s) { va[s] = *(const LAS bf16x8*)(vb + s * 16); vc2[s] = *(const LAS bf16x8*)(vb + 32 * AT_VROW + s * 16); }
            if (jb >= 0 && wid < 2 * jb + 2) {
                const int qrel = 32 * wid + r32, kb0 = 64 * jb + 4 * hi;
#pragma unroll
                for (int r = 0; r < 16; ++r) { const int kv = kb0 + (r & 3) + 8 * (r >> 2); if (kv > qrel) p0[r] = -INFINITY; if (kv + 32 > qrel) p1[r] = -INFINITY; }
            }
            float mxa = __builtin_elementwise_maximum(p0[0], p0[1]), mxb = __builtin_elementwise_maximum(p1[0], p1[1]);
#pragma unroll
            for (int r = 2; r < 16; r += 2) {
                mxa = __builtin_elementwise_maximum(__builtin_elementwise_maximum(mxa, p0[r]), p0[r + 1]);
                mxb = __builtin_elementwise_maximum(__builtin_elementwise_maximum(mxb, p1[r]), p1[r + 1]);
            }
            float mx = __builtin_elementwise_maximum(mxa, mxb);
            {
                const u32x2 sw = __builtin_amdgcn_permlane32_swap(__float_as_uint(mx), __float_as_uint(mx), false, false);
                mx = __builtin_elementwise_maximum(__uint_as_float(sw.x), __uint_as_float(sw.y));
            }
            if (t == 0 || !__all(mx <= 8.f)) {
                const float delta = t == 0 ? mx : fmaxf(mx, 0.f), alpha = t == 0 ? 1.f : __builtin_amdgcn_exp2f(-delta);
                m_run += delta; l_run *= alpha;
#pragma unroll
                for (int r = 0; r < 16; ++r) { o0[r] *= alpha; o1[r] *= alpha; p0[r] -= delta; p1[r] -= delta; negm[r] = -m_run; }
            }
            float ps = 0.f;
#pragma unroll
            for (int r = 0; r < 16; ++r) { p0[r] = __builtin_amdgcn_exp2f(p0[r]); p1[r] = __builtin_amdgcn_exp2f(p1[r]); ps += p0[r]; ps += p1[r]; }
            l_run += ps;
#pragma unroll
            for (int s = 0; s < 4; ++s) {
                u32x4 pw;
                if (s < 2) { pw.x = cvt_pk_bf16(p0[8 * s + 0], p0[8 * s + 1]); pw.y = cvt_pk_bf16(p0[8 * s + 2], p0[8 * s + 3]); pw.z = cvt_pk_bf16(p0[8 * s + 4], p0[8 * s + 5]); pw.w = cvt_pk_bf16(p0[8 * s + 6], p0[8 * s + 7]); }
                else { const int q = s - 2; pw.x = cvt_pk_bf16(p1[8 * q + 0], p1[8 * q + 1]); pw.y = cvt_pk_bf16(p1[8 * q + 2], p1[8 * q + 3]); pw.z = cvt_pk_bf16(p1[8 * q + 4], p1[8 * q + 5]); pw.w = cvt_pk_bf16(p1[8 * q + 6], p1[8 * q + 7]); }
                const bf16x8 pb = __builtin_bit_cast(bf16x8, pw);
                o0 = __builtin_amdgcn_mfma_f32_32x32x16_bf16(va[s], pb, o0, 0, 0, 0);
                o1 = __builtin_amdgcn_mfma_f32_32x32x16_bf16(vc2[s], pb, o1, 0, 0, 0);
            }
        }
        TP_E(5);
        TP_B(6);
        LDS_BARRIER();
        TP_E(6);
        slot = slot == AT_NSLOT - 1 ? 0 : slot + 1; wslot = wslot == AT_NSLOT - 1 ? 0 : wslot + 1;
    }
    TP_E(1);
    for (int t = NTw; t < NT; ++t) {
        AT_WAIT2();
        LDS_BARRIER();
        AT_DMA(min(t + 4, NT - 1), t + 4 < NT ? wslot * AT_SLOT : AT_DUMMY);
        LDS_BARRIER();
        wslot = wslot == AT_NSLOT - 1 ? 0 : wslot + 1;
    }
    if (!grp) LDS_BARRIER();
    VM_WAIT();
#undef AT_DMA
#undef AT_DMA_ONE
#undef AT_WAIT2
#undef AT_WAIT1
#undef AT_WAIT_NEXT
    l_run += __shfl_xor(l_run, 32);
    const float inv = 1.f / l_run;
    const int b = bh >> 3, h = bh & 7;
    bf16_t* orow = act_ptr(F, A_YSA) + ((size_t)b * SEQ + qb * 256 + wid * 32 + r32) * 512 + h * 64;
#pragma unroll
    for (int g = 0; g < 4; ++g) {
        u32x2 w0, w1;
        w0.x = cvt_pk_bf16(o0[4 * g] * inv, o0[4 * g + 1] * inv); w0.y = cvt_pk_bf16(o0[4 * g + 2] * inv, o0[4 * g + 3] * inv);
        w1.x = cvt_pk_bf16(o1[4 * g] * inv, o1[4 * g + 1] * inv); w1.y = cvt_pk_bf16(o1[4 * g + 2] * inv, o1[4 * g + 3] * inv);
#ifdef AT_WT_STORE
        asm volatile("global_store_dwordx2 %0, %1, off sc0 sc1" :: "v"(orow + 8 * g + 4 * hi), "v"(w0) : "memory");
        asm volatile("global_store_dwordx2 %0, %1, off sc0 sc1" :: "v"(orow + 32 + 8 * g + 4 * hi), "v"(w1) : "memory");
#else
        *(u32x2*)(orow + 8 * g + 4 * hi) = w0; *(u32x2*)(orow + 32 + 8 * g + 4 * hi) = w1;
#endif
    }
    TP_E(0);
}

__device__ __forceinline__ float row16_sum(float x) {
    x += __int_as_float(__builtin_amdgcn_update_dpp(0, __float_as_int(x), 0x128, 0xf, 0xf, false));
    x += __int_as_float(__builtin_amdgcn_update_dpp(0, __float_as_int(x), 0x124, 0xf, 0xf, false));
    x += __int_as_float(__builtin_amdgcn_update_dpp(0, __float_as_int(x), 0x122, 0xf, 0xf, false));
    x += __int_as_float(__builtin_amdgcn_update_dpp(0, __float_as_int(x), 0x121, 0xf, 0xf, false));
    return x;
}
__device__ __forceinline__ unsigned short f2bf1(float x) { return (unsigned short)(cvt_pk_bf16(x, 0.f) & 0xffffu); }
__device__ __forceinline__ void gla_prep(Frame& F, int l, int unit) {
    bf16_t* gqkv = act_ptr(F, A_GQKV); const bf16_t* misc = act_ptr(F, A_MISC); float* eb = F.stats + SF_EB;
    const int c = F.tid & 255, ch = unit * 2 + (F.tid >> 8);
    const float* wg = F.in(I_WGLA) + (size_t)l * 16 * 256 + c; const float bias = F.in(I_BGLA)[l * 256 + c];
    float wcol[16];
#pragma unroll
    for (int r = 0; r < 16; ++r) wcol[r] = wg[r * 256];
    float bc = 0.f;
#pragma unroll 1
    for (int i0 = 0; i0 < 32; i0 += 8) {
        u32x4 l0[8], l1[8]; unsigned qv[8], kv[8];
#pragma unroll
        for (int i = 0; i < 8; ++i) {
            const size_t t = (size_t)ch * 32 + i0 + i;
            l0[i] = *(const u32x4*)(misc + t * 256 + 32); l1[i] = *(const u32x4*)(misc + t * 256 + 40);
            qv[i] = *(const unsigned short*)(gqkv + t * 1024 + c); kv[i] = *(const unsigned short*)(gqkv + t * 1024 + c + 256);
        }
#pragma unroll
        for (int i = 0; i < 8; ++i) asm volatile("" : "+v"(qv[i]), "+v"(kv[i]));
        unsigned short qo[8], ko[8];
#pragma unroll
        for (int i = 0; i < 8; ++i) {
            const float lr[16] = {bflo(l0[i].x), bfhi(l0[i].x), bflo(l0[i].y), bfhi(l0[i].y), bflo(l0[i].z), bfhi(l0[i].z), bflo(l0[i].w), bfhi(l0[i].w),
                                  bflo(l1[i].x), bfhi(l1[i].x), bflo(l1[i].y), bfhi(l1[i].y), bflo(l1[i].z), bfhi(l1[i].z), bflo(l1[i].w), bfhi(l1[i].w)};
            float z = bias;
#pragma unroll
            for (int r = 0; r < 16; ++r) z = fmaf(lr[r], wcol[r], z);
            const float zl = z * 1.4426950408889634f;
            const float sp = fmaxf(-zl, 0.f) + __log2f(1.f + __builtin_amdgcn_exp2f(-fabsf(zl)));
            bc -= sp * 0.0625f;
            const float eq = __builtin_amdgcn_exp2f(bc) * 0.125f, ek = __builtin_amdgcn_exp2f(-bc);
            qo[i] = f2bf1(__uint_as_float(qv[i] << 16) * eq);
            ko[i] = f2bf1(__uint_as_float(kv[i] << 16) * ek);
        }
#pragma unroll
        for (int i = 0; i < 8; ++i) {
            const size_t t = (size_t)ch * 32 + i0 + i;
            *(unsigned short*)(gqkv + t * 1024 + c) = qo[i]; *(unsigned short*)(gqkv + t * 1024 + c + 256) = ko[i];
        }
    }
    eb[(size_t)ch * 256 + c] = __builtin_amdgcn_exp2f(bc);
}
typedef short v4i16_t __attribute__((ext_vector_type(4)));
__device__ __forceinline__ v4i16_t lds_tr16(const LAS unsigned char* p) { return __builtin_amdgcn_ds_read_tr16_b64_v4i16((LAS v4i16_t*)p); }
constexpr int GW_K = 0, GW_Q = 4608, GW_V = 9216, GW_BYTES = 10240;
__device__ __forceinline__ void gla_unit(Frame& F, int l, int unit) {
    const int half = unit & 1, h = (unit >> 1) & 3, b = unit >> 3;
    volatile LAS int* prog = (volatile LAS int*)(F.lds + 4 * GW_BYTES);
    if (F.wave >= 4) {
        const int pw = F.wave - 4, tok = F.lane & 31, li = (F.lane >> 5) + 2 * (pw & 1);
        const size_t lo_ = (li == 0) ? (size_t)h * 128 : (li == 1) ? (size_t)512 + h * 128 : (li == 2) ? (size_t)1024 + h * 256 + half * 128 : (size_t)1024 + h * 256 + half * 128 + 64;
        const unsigned char* base_ = (const unsigned char*)act_ptr(F, A_GQKV) + lo_;
        unsigned keep = 0u;
        for (int m = (pw >> 1); m < SEQ / 32; m += 2) {
            while (m > prog[0] + 8) __builtin_amdgcn_s_sleep(8);
            const unsigned char* pp = base_ + ((size_t)b * SEQ + (size_t)m * 32 + tok) * 2048;
            asm volatile("global_load_dword %0, %1, off" : "+v"(keep) : "v"(pp) : "memory");
        }
        asm volatile("s_waitcnt vmcnt(0)" : "+v"(keep) :: "memory");
        return;
    }
    const int lane = F.lane, w = half * 4 + F.wave, l15 = lane & 15, q4 = lane >> 4;
    const bf16_t* gqkv = act_ptr(F, A_GQKV); const float* ebg = F.stats + SF_EB;
    bf16_t* ysb = act_ptr(F, A_YSB);
    LAS unsigned char* wl = F.lds + F.wave * GW_BYTES;
    f32x4 S[4];
#pragma unroll
    for (int i = 0; i < 4; ++i) S[i] = (f32x4){0.f, 0.f, 0.f, 0.f};
    if (F.tid == 0) prog[0] = 0;
    constexpr int GW2 = 4 * GW_BYTES;
    u32x4 kimgX[4], qimgX[4], vimgX, kimgY[4], qimgY[4], vimgY; f32x4 ebvX[4], ebvY[4];
#define GLA_LOAD1(n_, KI, QI, VI, EBV) do { const size_t tb_ = (size_t)b * SEQ + (size_t)(n_) * 32; \
        _Pragma("unroll") for (int i = 0; i < 4; ++i) { const int p_ = lane + 64 * i; const bf16_t* r_ = gqkv + (tb_ + (p_ >> 3)) * 1024 + h * 64 + (p_ & 7) * 8; QI[i] = *(const u32x4*)r_; KI[i] = *(const u32x4*)(r_ + 256); } \
        VI = *(const u32x4*)(gqkv + (tb_ + (lane >> 1)) * 1024 + 512 + h * 128 + 16 * w + (lane & 1) * 8); \
        _Pragma("unroll") for (int db = 0; db < 4; ++db) EBV[db] = *(const f32x4*)(ebg + (tb_ >> 5) * 256 + h * 64 + 16 * db + 4 * q4); } while (0)
#define GLA_LOAD(n_) do { GLA_LOAD1((n_), kimgX, qimgX, vimgX, ebvX); GLA_LOAD1((n_) + 1, kimgY, qimgY, vimgY, ebvY); } while (0)
    bf16x8 pa0X, pa1X, vbnX, kanX[4], qpxX[2], qpyX[2], pa0Y, pa1Y, vbnY, kanY[4], qpxY[2], qpyY[2]; f32x4 o0pX, o1pX, e4X[4], o0pY, o1pY, e4Y[4];
#define GLA_IMG(WL, KI, QI, VI, EBV, E4) do { \
        _Pragma("unroll") for (int i = 0; i < 4; ++i) { asm volatile("" : "+v"(KI[i]), "+v"(QI[i]), "+v"(EBV[i])); } \
        asm volatile("" : "+v"(VI)); \
        _Pragma("unroll") for (int i = 0; i < 4; ++i) { const int p_ = lane + 64 * i; *(LAS u32x4*)((WL) + GW_K + (p_ >> 3) * 144 + (p_ & 7) * 16) = KI[i]; *(LAS u32x4*)((WL) + GW_Q + (p_ >> 3) * 144 + (p_ & 7) * 16) = QI[i]; } \
        *(LAS u32x4*)((WL) + GW_V + (lane >> 1) * 32 + (lane & 1) * 16) = VI; \
        _Pragma("unroll") for (int db = 0; db < 4; ++db) E4[db] = EBV[db]; } while (0)
#define GLA_STAGE_P(WL, PA0, PA1, VBN, KAN, QPX, QPY, O0P, O1P) do { \
        f32x4 pt00 = {0.f, 0.f, 0.f, 0.f}, pt01 = pt00, pt11 = pt00; \
        _Pragma("unroll") for (int ks = 0; ks < 2; ++ks) { \
            const bf16x8 a0 = *(const LAS bf16x8*)((WL) + GW_K + l15 * 144 + ks * 64 + q4 * 16), a1 = *(const LAS bf16x8*)((WL) + GW_K + (16 + l15) * 144 + ks * 64 + q4 * 16); \
            const bf16x8 b0 = *(const LAS bf16x8*)((WL) + GW_Q + l15 * 144 + ks * 64 + q4 * 16), b1 = *(const LAS bf16x8*)((WL) + GW_Q + (16 + l15) * 144 + ks * 64 + q4 * 16); \
            pt00 = __builtin_amdgcn_mfma_f32_16x16x32_bf16(a0, b0, pt00, 0, 0, 0); \
            pt01 = __builtin_amdgcn_mfma_f32_16x16x32_bf16(a0, b1, pt01, 0, 0, 0); \
            pt11 = __builtin_amdgcn_mfma_f32_16x16x32_bf16(a1, b1, pt11, 0, 0, 0); \
            const LAS unsigned char* q0p = (WL) + GW_Q + l15 * 144 + ks * 64 + q4 * 8; const LAS unsigned char* q1p = q0p + 16 * 144; \
            const u32x2 x0 = *(const LAS u32x2*)(q0p), x1 = *(const LAS u32x2*)(q0p + 32), y0 = *(const LAS u32x2*)(q1p), y1 = *(const LAS u32x2*)(q1p + 32); \
            QPX[ks] = __builtin_bit_cast(bf16x8, (u32x4){x0.x, x0.y, x1.x, x1.y}); QPY[ks] = __builtin_bit_cast(bf16x8, (u32x4){y0.x, y0.y, y1.x, y1.y}); } \
        _Pragma("unroll") for (int r = 0; r < 4; ++r) { if (4 * q4 + r > l15) { pt00[r] = 0.f; pt11[r] = 0.f; } } \
        PA0 = __builtin_bit_cast(bf16x8, (u32x4){cvt_pk_bf16(pt00[0], pt00[1]), cvt_pk_bf16(pt00[2], pt00[3]), 0u, 0u}); \
        PA1 = __builtin_bit_cast(bf16x8, (u32x4){cvt_pk_bf16(pt01[0], pt01[1]), cvt_pk_bf16(pt01[2], pt01[3]), cvt_pk_bf16(pt11[0], pt11[1]), cvt_pk_bf16(pt11[2], pt11[3])}); \
        const LAS unsigned char* vt_ = (WL) + GW_V + (l15 >> 2) * 32 + (l15 & 3) * 8; \
        const v4i16_t vp0 = lds_tr16(vt_ + (4 * q4) * 32), vp1 = lds_tr16(vt_ + (16 + 4 * q4) * 32); \
        const v4i16_t vn0 = lds_tr16(vt_ + (8 * q4) * 32), vn1 = lds_tr16(vt_ + (8 * q4 + 4) * 32); \
        const bf16x8 vbp = (bf16x8){vp0[0], vp0[1], vp0[2], vp0[3], vp1[0], vp1[1], vp1[2], vp1[3]}; \
        VBN = (bf16x8){vn0[0], vn0[1], vn0[2], vn0[3], vn1[0], vn1[1], vn1[2], vn1[3]}; \
        _Pragma("unroll") for (int db = 0; db < 4; ++db) { \
            const LAS unsigned char* kt = (WL) + GW_K + (8 * q4 + (l15 >> 2)) * 144 + (16 * db + (l15 & 3) * 4) * 2; \
            const v4i16_t k0 = lds_tr16(kt), k1 = lds_tr16(kt + 4 * 144); \
            KAN[db] = (bf16x8){k0[0], k0[1], k0[2], k0[3], k1[0], k1[1], k1[2], k1[3]}; } \
        O0P = __builtin_amdgcn_mfma_f32_16x16x32_bf16(PA0, vbp, (f32x4){0.f, 0.f, 0.f, 0.f}, 0, 0, 0); \
        O1P = __builtin_amdgcn_mfma_f32_16x16x32_bf16(PA1, vbp, (f32x4){0.f, 0.f, 0.f, 0.f}, 0, 0, 0); \
    } while (0)
#define GLA_STAGE_S(T0, VBN, KAN, QPX, QPY, O0P, O1P, E4) do { \
        f32x4 o0 = O0P, o1 = O1P; \
        _Pragma("unroll") for (int ks = 0; ks < 2; ++ks) { \
            const bf16x8 sb = __builtin_bit_cast(bf16x8, (u32x4){cvt_pk_bf16(S[2 * ks][0], S[2 * ks][1]), cvt_pk_bf16(S[2 * ks][2], S[2 * ks][3]), cvt_pk_bf16(S[2 * ks + 1][0], S[2 * ks + 1][1]), cvt_pk_bf16(S[2 * ks + 1][2], S[2 * ks + 1][3])}); \
            o0 = __builtin_amdgcn_mfma_f32_16x16x32_bf16(QPX[ks], sb, o0, 0, 0, 0); \
            o1 = __builtin_amdgcn_mfma_f32_16x16x32_bf16(QPY[ks], sb, o1, 0, 0, 0); } \
        _Pragma("unroll") for (int db = 0; db < 4; ++db) { S[db] = __builtin_amdgcn_mfma_f32_16x16x32_bf16(KAN[db], VBN, S[db], 0, 0, 0); S[db] = S[db] * E4[db]; } \
        _Pragma("unroll") for (int r = 0; r < 4; ++r) { const size_t ta = (T0) + 4 * q4 + r, tb2 = ta + 16; \
            ysb[ta * 512 + h * 128 + 16 * w + l15] = f2bf1(o0[r]); ysb[tb2 * 512 + h * 128 + 16 * w + l15] = f2bf1(o1[r]); } \
    } while (0)
    LAS unsigned char* wl2 = F.lds + GW2 + 64 + F.wave * GW_BYTES;
    GLA_LOAD(0);
    for (int n = 0; n < SEQ / 32; n += 2) {
        const size_t t0 = (size_t)b * SEQ + (size_t)n * 32;
        if (F.tid == 0) prog[0] = n;
        GLA_IMG(wl, kimgX, qimgX, vimgX, ebvX, e4X);
        GLA_IMG(wl2, kimgY, qimgY, vimgY, ebvY, e4Y);
        { const int nn = (n + 2 < SEQ / 32) ? n + 2 : n; GLA_LOAD(nn); }
        GLA_STAGE_P(wl, pa0X, pa1X, vbnX, kanX, qpxX, qpyX, o0pX, o1pX);
        GLA_STAGE_P(wl2, pa0Y, pa1Y, vbnY, kanY, qpxY, qpyY, o0pY, o1pY);
        GLA_STAGE_S(t0, vbnX, kanX, qpxX, qpyX, o0pX, o1pX, e4X);
        GLA_STAGE_S(t0 + 32, vbnY, kanY, qpxY, qpyY, o0pY, o1pY, e4Y);
        asm volatile("s_waitcnt lgkmcnt(0)" ::: "memory");
    }
#undef GLA_LOAD1
#undef GLA_IMG
#undef GLA_STAGE_P
#undef GLA_STAGE_S
#undef GLA_LOAD
}
__device__ __forceinline__ void gla_finalize(Frame& F, int l) {
    bf16_t* ysb = act_ptr(F, A_YSB); const bf16_t* og = act_ptr(F, A_OG);
    const float* go = F.in(I_GGLAO) + l * 128;
    for (int i = F.vcu * 512 + F.tid; i < T * 64; i += F.G * 512) {
        const int t = i >> 6, c8 = i & 63, h = c8 >> 4, v0 = (c8 & 15) * 8;
        const u32x4 o = *(const u32x4*)(ysb + (size_t)t * 512 + c8 * 8), gte = *(const u32x4*)(og + (size_t)t * 512 + c8 * 8);
        const f32x4 g0 = *(const f32x4*)(go + v0), g1 = *(const f32x4*)(go + v0 + 4);
        const float ov[8] = {bflo(o.x), bfhi(o.x), bflo(o.y), bfhi(o.y), bflo(o.z), bfhi(o.z), bflo(o.w), bfhi(o.w)};
        const float ssq = row16_sum(((ov[0] * ov[0] + ov[1] * ov[1]) + (ov[2] * ov[2] + ov[3] * ov[3])) + ((ov[4] * ov[4] + ov[5] * ov[5]) + (ov[6] * ov[6] + ov[7] * ov[7])));
        const float r = rsqrtf(ssq * (1.f / 128.f) + EPS);
        const float gv[8] = {bflo(gte.x), bfhi(gte.x), bflo(gte.y), bfhi(gte.y), bflo(gte.z), bfhi(gte.z), bflo(gte.w), bfhi(gte.w)};
        float y[8];
#pragma unroll
        for (int e = 0; e < 8; ++e) y[e] = ov[e] * r * (e < 4 ? g0[e] : g1[e - 4]) * gv[e] * fast_sigmoid(gv[e]);
        u32x4 wv; wv.x = cvt_pk_bf16(y[0], y[1]); wv.y = cvt_pk_bf16(y[2], y[3]); wv.z = cvt_pk_bf16(y[4], y[5]); wv.w = cvt_pk_bf16(y[6], y[7]);
        *(u32x4*)(ysb + (size_t)t * 512 + c8 * 8) = wv;
    }
}

template <int W> __device__ __forceinline__ void pool_rows(const bf16_t* up, bf16_t* pooled, int t0, int s0, int c8) {
    u32x4 row[8 + W - 1];
#pragma unroll
    for (int i = 0; i < 8 + W - 1; ++i) {
        const int dt = i - (W - 1);
        const bool ok = (s0 + dt) >= 0;
        const u32x4 v = *(const u32x4*)(up + (size_t)(t0 + (ok ? dt : 0)) * 512 + c8 * 8);
        row[i] = ok ? v : (u32x4){0u, 0u, 0u, 0u};
    }
#pragma unroll
    for (int k = 0; k < 8; ++k) {
        float acc[8];
#pragma unroll
        for (int e = 0; e < 8; ++e) acc[e] = 0.f;
#pragma unroll
        for (int j = 0; j < W; ++j) { const u32x4 v = row[k + W - 1 - j];
            acc[0] += bflo(v.x); acc[1] += bfhi(v.x); acc[2] += bflo(v.y); acc[3] += bfhi(v.y); acc[4] += bflo(v.z); acc[5] += bfhi(v.z); acc[6] += bflo(v.w); acc[7] += bfhi(v.w); }
        const int sk = s0 + k, n = (sk + 1 < W) ? sk + 1 : W;
        const float rn = 1.f / (float)n; const u32x4 self = row[k + W - 1];
        u32x4 o; o.x = cvt_pk_bf16(acc[0] * rn - bflo(self.x), acc[1] * rn - bfhi(self.x)); o.y = cvt_pk_bf16(acc[2] * rn - bflo(self.y), acc[3] * rn - bfhi(self.y));
        o.z = cvt_pk_bf16(acc[4] * rn - bflo(self.z), acc[5] * rn - bfhi(self.z)); o.w = cvt_pk_bf16(acc[6] * rn - bflo(self.w), acc[7] * rn - bfhi(self.w));
        *(u32x4*)(pooled + (size_t)(t0 + k) * 512 + c8 * 8) = o;
    }
}
__device__ __forceinline__ void pool_unit(Frame& F, int unit) {
    const bf16_t* up = act_ptr(F, A_UP); bf16_t* pooled = act_ptr(F, A_POOLED);
    const int g = F.wave & 3, c8 = g * 16 + (F.lane & 15), tb = (F.lane >> 4) + 4 * (F.wave >> 2);
    const int t0 = unit * 64 + tb * 8, s0 = t0 % SEQ;
    if (g == 0) pool_rows<2>(up, pooled, t0, s0, c8);
    else if (g == 1) pool_rows<4>(up, pooled, t0, s0, c8);
    else if (g == 2) pool_rows<8>(up, pooled, t0, s0, c8);
    else pool_rows<16>(up, pooled, t0, s0, c8);
}

__device__ __forceinline__ void phase_mix(Frame& F, int lq, int bx) {
    const int l = lq & 1;
#ifndef REP_DMASK
#define REP_DMASK 7
#endif
    const int dm = (lq >= 2) ? (REP_DMASK) : 7;
    if (bx < 32 && (dm & 1)) gla_unit(F, l, bx);
    unsigned* head = F.ctl + CW_QUEUE + 64 * lq;
    unsigned long long tpsum = 0;
#ifdef AT_TPROBE
    const unsigned long long tq0 = __builtin_readcyclecounter();
#endif
    for (;;) {
        if (F.tid == 0) F.MISC[16] = __hip_atomic_fetch_add(head, 1u, RLX_AGENT);
        __syncthreads();
        const int idx = (int)F.MISC[16];
        __syncthreads();
        if (idx >= 512 + 256) break;
        if (idx < 512) { if (dm & 2) attn_unit(F, idx & 31, 15 - (idx >> 5), tpsum); }
        else { if (dm & 4) pool_unit(F, idx - 512); }
    }
#ifdef AT_TPROBE
    if (AT_TPROBE == 7) tpsum = __builtin_readcyclecounter() - tq0;
    if (lq >= 2 && (AT_TPWG < 0 || bx == AT_TPWG) && F.wave == AT_TPWAVE) { const unsigned long long ts = __builtin_readcyclecounter(); while (__builtin_readcyclecounter() - ts < 4ull * tpsum) __builtin_amdgcn_s_sleep(8); }
#endif
    if (bx >= 32 && lq < 2) {
        LAS float* scr = (LAS float*)(F.lds + F.wave * 16384);
        const int gw = (bx - 32) * 8 + F.wave, NGW = (F.G - 32) * 8;
        if (l == 0) { CONV_LOOP(15, mixer_seg(F, 1, si_)); fold_pool(F, 1, gw, NGW); CONV_LOOP(3, ffn_seg(F, si_)); }
        else { CONV_LOOP(12, moe_seg(F, (si_ >> 1) * 3 + (si_ & 1))); }
    }
}

__device__ __forceinline__ void phase_route1(Frame& F) {
    const bf16_t* x = (const bf16_t*)(F.ws + WS_XB); const float* rss = F.stats + SF_ROWSS + (size_t)3 * T * 16; const float* gf = F.in(I_GFFN) + D; const float* wr = F.in(I_WROUTER);
    unsigned* route = (unsigned*)(F.ws + WS_SLOT + SL_ROUTE); unsigned* wgcnt = F.ctl + CW_WGCNT;
    LAS float* lsel = (LAS float*)(F.lds);
    LAS int* lpos = (LAS int*)(F.lds + 2048);
    float wgt[2][8][8];
    {
        f32x4 wl[2][8][2], gl[2][2];
#pragma unroll
        for (int j = 0; j < 2; ++j) {
            const int c = 8 * F.lane + 512 * j;
            gl[j][0] = *(const f32x4*)(gf + c); gl[j][1] = *(const f32x4*)(gf + c + 4);
#pragma unroll
            for (int q = 0; q < 8; ++q) { wl[j][q][0] = *(const f32x4*)(wr + (size_t)(c + q) * 8); wl[j][q][1] = *(const f32x4*)(wr + (size_t)(c + q) * 8 + 4); }
        }
#pragma unroll
        for (int j = 0; j < 2; ++j)
#pragma unroll
            for (int q = 0; q < 8; ++q) { asm volatile("" : "+v"(wl[j][q][0]), "+v"(wl[j][q][1])); }
#pragma unroll
        for (int j = 0; j < 2; ++j)
#pragma unroll
            for (int q = 0; q < 8; ++q) {
                const float g = q < 4 ? gl[j][0][q] : gl[j][1][q - 4];
#pragma unroll
                for (int e = 0; e < 4; ++e) { wgt[j][q][e] = wl[j][q][0][e] * g; wgt[j][q][4 + e] = wl[j][q][1][e] * g; }
            }
    }
    for (int unit = F.vcu; unit < T / 64; unit += F.G) {
        const float rs_l = rsqrtf(sum16(rss + (size_t)(unit * 64 + F.wave * 8 + (F.lane & 7)) * 16) * (1.f / 1024.f) + EPS);
#pragma unroll 1
        for (int k0 = 0; k0 < 8; k0 += 4) {
        u32x4 xr[4][2];
#pragma unroll
        for (int k = 0; k < 4; ++k)
#pragma unroll
            for (int j = 0; j < 2; ++j) xr[k][j] = *(const u32x4*)(x + (size_t)(unit * 64 + F.wave * 8 + k0 + k) * D + 8 * F.lane + 512 * j);
#pragma unroll
        for (int kk = 0; kk < 4; ++kk) {
            const int k = k0 + kk, tok = F.wave * 8 + k;
            float lg[8];
#pragma unroll
            for (int e = 0; e < 8; ++e) lg[e] = 0.f;
#pragma unroll
            for (int j = 0; j < 2; ++j) {
                const u32x4 v = xr[kk][j];
                const float xv[8] = {bflo(v.x), bfhi(v.x), bflo(v.y), bfhi(v.y), bflo(v.z), bfhi(v.z), bflo(v.w), bfhi(v.w)};
#pragma unroll
                for (int q = 0; q < 8; ++q)
#pragma unroll
                    for (int e = 0; e < 8; ++e) lg[e] = fmaf(xv[q], wgt[j][q][e], lg[e]);
            }
            const float rs = __shfl(rs_l, k);
#pragma unroll
            for (int e = 0; e < 8; ++e) lg[e] = wave_sum(lg[e]) * rs;
            int i1 = 0; float v1 = lg[0];
#pragma unroll
            for (int e = 1; e < 8; ++e) if (lg[e] > v1) { v1 = lg[e]; i1 = e; }
            int i2 = -1; float v2 = -INFINITY;
#pragma unroll
            for (int e = 0; e < 8; ++e) if (e != i1 && lg[e] > v2) { v2 = lg[e]; i2 = e; }
            const float e2 = __expf(v2 - v1), w1 = 1.f / (1.f + e2), w2 = e2 / (1.f + e2);
            if (F.lane == 0) { lsel[tok * 4 + 0] = __int_as_float(i1); lsel[tok * 4 + 1] = __int_as_float(i2); lsel[tok * 4 + 2] = w1; lsel[tok * 4 + 3] = w2; }
        }
        }
        __syncthreads();
        if (F.tid < 8) {
            int cnt = 0;
            for (int tok = 0; tok < 64; ++tok) {
                const int e1 = __float_as_int(lsel[tok * 4 + 0]), e2 = __float_as_int(lsel[tok * 4 + 1]);
                if (e1 == F.tid) { lpos[tok * 2 + 0] = cnt; ++cnt; }
                if (e2 == F.tid) { lpos[tok * 2 + 1] = cnt; ++cnt; }
            }
            wgcnt[unit * 8 + F.tid] = (unsigned)cnt;
        }
        __syncthreads();
        if (F.tid < 64) {
            const int t = unit * 64 + F.tid;
            u32x4 a, b2;
            a.x = (unsigned)__float_as_int(lsel[F.tid * 4 + 0]); a.y = (unsigned)__float_as_int(lsel[F.tid * 4 + 1]); a.z = __float_as_uint(lsel[F.tid * 4 + 2]); a.w = __float_as_uint(lsel[F.tid * 4 + 3]);
            b2.x = (unsigned)lpos[F.tid * 2 + 0]; b2.y = (unsigned)lpos[F.tid * 2 + 1]; b2.z = 0u; b2.w = 0u;
            *(u32x4*)(route + (size_t)t * 8) = a; *(u32x4*)(route + (size_t)t * 8 + 4) = b2;
        }
        __syncthreads();
    }
}
__device__ __forceinline__ void moe_geometry(Frame& F, int unit, LAS int* geo) {
    const unsigned* wgcnt = F.ctl + CW_WGCNT;
    int tv[8], pv[8];
    if (F.tid < 256) {
        const u32x4 c0 = *(const u32x4*)(wgcnt + F.tid * 8), c1 = *(const u32x4*)(wgcnt + F.tid * 8 + 4);
        tv[0] = (int)c0.x; tv[1] = (int)c0.y; tv[2] = (int)c0.z; tv[3] = (int)c0.w; tv[4] = (int)c1.x; tv[5] = (int)c1.y; tv[6] = (int)c1.z; tv[7] = (int)c1.w;
    } else {
#pragma unroll
        for (int e = 0; e < 8; ++e) tv[e] = 0;
    }
#pragma unroll
    for (int e = 0; e < 8; ++e) pv[e] = (F.tid < unit) ? tv[e] : 0;
#pragma unroll
    for (int e = 0; e < 8; ++e) {
#pragma unroll
        for (int o = 1; o < 64; o <<= 1) { tv[e] += __shfl_xor(tv[e], o); pv[e] += __shfl_xor(pv[e], o); }
    }
    LAS int* part = geo + 32;
    if (F.lane == 0 && F.wave < 4) {
#pragma unroll
        for (int e = 0; e < 8; ++e) { part[F.wave * 16 + e] = tv[e]; part[F.wave * 16 + 8 + e] = pv[e]; }
    }
    __syncthreads();
    if (F.tid < 8) {
        int tot = 0, pre = 0;
#pragma unroll
        for (int w = 0; w < 4; ++w) { tot += part[w * 16 + F.tid]; pre += part[w * 16 + 8 + F.tid]; }
        geo[9 + F.tid] = tot; geo[17 + F.tid] = pre;
    }
    __syncthreads();
    if (F.tid == 0) { int acc = 0; for (int e = 0; e < 8; ++e) { geo[e] = acc; acc += (geo[9 + e] + 255) >> 8; } geo[8] = acc; }
    __syncthreads();
}
__device__ __forceinline__ void phase_route2(Frame& F) {
    const unsigned* route = (const unsigned*)(F.ws + WS_SLOT + SL_ROUTE);
    int* slot_tok = (int*)(F.ws + WS_SLOT + SL_TOK); float* slot_scale = (float*)(F.ws + WS_SLOT + SL_SCALE); float* slot_comb = (float*)(F.ws + WS_SLOT + SL_COMB);
    const float* rss = F.stats + SF_ROWSS + (size_t)3 * T * 16;
    const bf16_t* xb = (const bf16_t*)(F.ws + WS_XB); bf16_t* xg = act_ptr(F, A_XG);
    LAS int* geo = (LAS int*)(F.lds);
    for (int unit = F.vcu; unit < T / 64; unit += F.G) {
        moe_geometry(F, unit, geo);
        int slot_l = 0;
        if (F.lane < 16) {
            const int rix = F.wave * 16 + F.lane, tok = rix >> 1, ch = rix & 1, t = unit * 64 + tok;
            const unsigned e = route[(size_t)t * 8 + ch], pos = route[(size_t)t * 8 + 4 + ch];
            const float w = __uint_as_float(route[(size_t)t * 8 + 2 + ch]);
            const float sc = rsqrtf(sum16(rss + (size_t)t * 16) * (1.f / 1024.f) + EPS);
            slot_l = geo[e] * 256 + geo[17 + e] + (int)pos;
            ((int*)(F.ws + WS_TSLOT))[t * 2 + ch] = slot_l; slot_tok[slot_l] = t; slot_scale[slot_l] = sc; slot_comb[slot_l] = w;
        }
#pragma unroll
        for (int k0 = 0; k0 < 16; k0 += 8) {
            u32x4 r0[8], r1[8];
#pragma unroll
            for (int k = 0; k < 8; ++k) {
                const u32x4* src = (const u32x4*)(xb + (size_t)(unit * 64 + ((F.wave * 16 + k0 + k) >> 1)) * D);
                r0[k] = src[F.lane]; r1[k] = src[64 + F.lane];
            }
#pragma unroll
            for (int k = 0; k < 8; ++k) {
                const int slot = __shfl(slot_l, k0 + k);
                u32x4* dst = (u32x4*)(xg + (size_t)slot * D);
                dst[F.lane] = r0[k]; dst[64 + F.lane] = r1[k];
            }
        }
        if (unit == 0) {
            for (int e = 0; e < 8; ++e) { const int s0 = geo[e] * 256 + geo[9 + e], s1 = geo[e + 1] * 256;
                for (int s = s0 + F.tid; s < s1; s += 512) { slot_tok[s] = -1; slot_scale[s] = 0.f; slot_comb[s] = 0.f; } }
        }
        __syncthreads();
    }
}

struct Args { const void* in[25]; float* out; unsigned char* ws; int ph_lo, ph_hi, li, pad; };
constexpr int NPHASE = 22;
#ifndef PH_MASK
#define PH_MASK 0xFFF
#endif
#define PON(b) (((PH_MASK) >> (b)) & 1)

__global__ void __launch_bounds__(512, 2) mega_fwd(Args args) {
    extern __shared__ __attribute__((aligned(16))) unsigned char lds_raw[];
    Frame F;
    F.lds = (LAS unsigned char*)lds_raw;
    F.MISC = (volatile LAS unsigned*)(F.lds + MISC_OFF);
    F.tid = threadIdx.x; F.lane = F.tid & 63; F.wave = __builtin_amdgcn_readfirstlane(F.tid >> 6);
    F.G = gridDim.x; { const int bx = blockIdx.x; F.vcu = (F.G % 8 == 0) ? (bx % 8) * (F.G / 8) + bx / 8 : bx; }
    { const CAS Args* ap0 = (const CAS Args*)__builtin_amdgcn_kernarg_segment_ptr(); F.ws = ap0->ws; F.ctl = (unsigned*)(F.ws + WS_CTL); F.ctlf = (float*)(F.ws + WS_CTL); F.stats = (float*)(F.ws + WS_STATS); }
    F.inp = nullptr; F.out = nullptr;
    for (int u = F.tid; u < (LDS_BYTES - LDSCTL_OFF) / 4; u += 512) ((LAS unsigned*)(F.lds + LDSCTL_OFF))[u] = 0u;
    __syncthreads();
    XcdBarrier bar = xcd_barrier_post(F.ctl + CW_BAR + args.li * XCD_BAR_WORDS, F.MISC + 8);
    const int lo = args.ph_lo, hi = args.ph_hi;
    const int cblk0 = (int)blockIdx.x, wave0 = F.wave, vcu0 = F.vcu, G0 = F.G;
#ifndef REP_MASK
#define REP_MASK 0
#endif
#pragma unroll 1
    for (int ph2 = 2 * lo; ph2 < 2 * hi; ++ph2) {
        const int ph = ph2 >> 1, rpt = ph2 & 1;
        if (rpt && !((REP_MASK >> ph) & 1)) continue;
        int cblk = cblk0; { int wv_ = wave0, vc_ = vcu0, g_ = G0; asm volatile("" : "+s"(wv_), "+s"(vc_), "+s"(g_), "+s"(cblk)); F.wave = wv_; F.vcu = vc_; F.G = g_; }
        { int ln_; asm volatile("v_mbcnt_lo_u32_b32 %0, -1, 0\n\tv_mbcnt_hi_u32_b32 %0, -1, %0" : "=v"(ln_)); F.lane = ln_; F.tid = F.wave * 64 + ln_; }
        { const CAS Args* ap = (const CAS Args*)__builtin_amdgcn_kernarg_segment_ptr(); asm volatile("" : "+s"(ap)); F.inp = ap->in; F.out = ap->out; unsigned char* w_ = ap->ws; F.ws = w_; F.ctl = (unsigned*)(w_ + WS_CTL); F.ctlf = (float*)(w_ + WS_CTL); F.stats = (float*)(w_ + WS_STATS); }
        const int l = ph >= 10 ? 1 : 0, q = ph == 0 ? -1 : (l ? ph - 10 : ph - 1);
        unsigned char* wb = wblk(F, l);
        float* ssq = F.stats + SF_SSQ + (size_t)l * 2 * T * 4;
        const float* rss_in = F.stats + SF_ROWSS + (size_t)(l == 0 ? 0 : 2) * T * 16;
        float* rss_mid = F.stats + SF_ROWSS + (size_t)(l == 0 ? 1 : 3) * T * 16;
        if (q == -1) {
            if (PON(11)) p0_prologue(F);
        } else if (q == 0 && PON(0)) {
            pg8::SchedGrid S{(const char*)(F.ws + WS_XB), (const char*)(wb + WO_IN), (size_t)256 * 1024 * 2, (size_t)256 * 1024 * 2, 0, 64, 11, F.G, cblk, 1 << 30};
            { pg8::Unit u0; if (S.next(0, u0)) fill_rs(F, rss_in, u0.pm); }
            pg8::EpiProj E{act_ptr(F, A_CQKV), act_ptr(F, A_GQKV), act_ptr(F, A_OG), act_ptr(F, A_UP), act_ptr(F, A_MISC), (const LAS float*)(F.lds + RS_OFF), ssq};
            pg8::gemm_phase<pg8::EpiProj, pg8::SchedGrid, true, true>(F.lds, F.wave, 1024, 1024, S, E);
        } else if (q == 1 && PON(1)) {
            pg8::SchedGrid S{(const char*)act_ptr(F, A_CQKV), (const char*)(wb + WO_UP), (size_t)256 * 512 * 2, (size_t)256 * 256 * 2, (size_t)256 * 2, 64, 7, F.G, cblk, 3};
            pg8::EpiUp E{act_ptr(F, A_QKVRAW), ssq};
            pg8::gemm_phase<pg8::EpiUp, pg8::SchedGrid, true, true>(F.lds, F.wave, 512, 256, S, E);
        } else if (q == 2 && PON(2)) {
            phase_prep(F, l, rpt);
        } else if (q == 3 && PON(3)) {
            phase_mix(F, l + 2 * rpt, cblk);
        } else if (q == 4 && PON(4)) {
            pg8::SchedGrid S{(const char*)(F.ws + WS_XB), (const char*)(wb + WO_G), (size_t)256 * 1024 * 2, (size_t)256 * 1024 * 2, 0, 64, 12, F.G, cblk, 1 << 30};
            { pg8::Unit u0; if (S.next(0, u0)) fill_rs(F, rss_in, u0.pm); }
            pg8::EpiGate E{F.ws + WS_ACTS, (const LAS float*)(F.lds + RS_OFF)};
            pg8::gemm_phase<pg8::EpiGate, pg8::SchedGrid, true, true>(F.lds, F.wave, 1024, 1024, S, E);
            if (!rpt) gla_finalize(F, l);
        } else if (q == 5 && PON(5)) {
            pg8::SchedMerge S{(const char*)(F.ws + WS_ACTS), (const char*)(wb + WO_BR), F.G, cblk};
            pg8::EpiMerge E{F.ws + WS_ACTS, act_ptr(F, A_MERGED)};
            pg8::gemm_phase<pg8::EpiMerge, pg8::SchedMerge, true, true>(F.lds, F.wave, 512, 512, S, E);
        } else if (q == 6 && PON(6)) {
            pg8::SchedGrid S{(const char*)act_ptr(F, A_MERGED), (const char*)(wb + WO_OUT), (size_t)256 * 1024 * 2, (size_t)256 * 1024 * 2, 0, 64, 4, F.G, cblk, 1 << 30, MERGED_HI_DELTA};
            pg8::EpiResid E{(bf16_t*)(F.ws + WS_XB), rss_mid};
            pg8::gemm_phase<pg8::EpiResid, pg8::SchedGrid, true, true>(F.lds, F.wave, 1024, 1024, S, E);
        } else if (l == 0 && q == 7 && PON(7)) {
            pg8::SchedGrid S{(const char*)(F.ws + WS_XB), (const char*)(wb + WO_FGU), (size_t)256 * 1024 * 2, (size_t)256 * 1024 * 2, 0, 64, 22, F.G, cblk, 1 << 30};
            if (F.G == 256) S.split_from = 1280;
            { pg8::Unit u0; if (S.next(0, u0)) fill_rs(F, rss_mid, u0.pm); }
            pg8::EpiSwiglu<false> E{act_ptr(F, A_ACT), DFF, (const LAS float*)(F.lds + RS_OFF), nullptr, nullptr};
            pg8::gemm_phase<pg8::EpiSwiglu<false>, pg8::SchedGrid, true, true>(F.lds, F.wave, 1024, 1024, S, E);
        } else if (l == 0 && q == 8 && PON(8)) {
            pg8::SchedGrid S{(const char*)act_ptr(F, A_ACT), (const char*)(wb + WO_FD), (size_t)256 * DFF * 2, (size_t)256 * DFF * 2, 0, 64, 4, F.G, cblk, 1 << 30};
            pg8::EpiResid E{(bf16_t*)(F.ws + WS_XB), F.stats + SF_ROWSS + (size_t)2 * T * 16};
            pg8::gemm_phase<pg8::EpiResid, pg8::SchedGrid, true, true>(F.lds, F.wave, DFF, DFF, S, E);
        } else if (q == 7 && PON(9)) {
            phase_route1(F);
            __syncthreads();
            LAS float* scr = (LAS float*)(F.lds + F.wave * 16384);
            const int gw = F.vcu * 8 + F.wave, NGW = F.G * 8;
            CONV_LOOP(12, moe_seg(F, (si_ < 4) ? (6 + (si_ >> 1)) * 3 + (si_ & 1) : (si_ - 4) * 3 + 2));
        } else if (q == 8 && PON(9)) {
            phase_route2(F);
        } else if (q == 9 && PON(10)) {
            unsigned char* wm = F.ws + WS_W0;
            LAS int* geo = (LAS int*)(F.lds + RING_BYTES + 512);
            moe_geometry(F, 0, geo);
            pg8::SchedMoe S; S.A = (const char*)act_ptr(F, A_XG); S.B = (const char*)(wm + WO_MGU); S.a_tile = (size_t)256 * 1024 * 2; S.b_tile = (size_t)256 * 1024 * 2; S.b_exp = (size_t)2816 * 1024 * 2;
            S.nN = 11; S.G = F.G; S.c = cblk;
            S.t1 = __builtin_amdgcn_readfirstlane(geo[1]); S.t2 = __builtin_amdgcn_readfirstlane(geo[2]); S.t3 = __builtin_amdgcn_readfirstlane(geo[3]); S.t4 = __builtin_amdgcn_readfirstlane(geo[4]);
            S.t5 = __builtin_amdgcn_readfirstlane(geo[5]); S.t6 = __builtin_amdgcn_readfirstlane(geo[6]); S.t7 = __builtin_amdgcn_readfirstlane(geo[7]); S.MT = __builtin_amdgcn_readfirstlane(geo[8]);
            pg8::EpiSwiglu<true> E{act_ptr(F, A_ACTE), DEXP, (const LAS float*)nullptr, (const float*)(F.ws + WS_SLOT + SL_SCALE), (const float*)(F.ws + WS_SLOT + SL_COMB)};
            pg8::gemm_phase<pg8::EpiSwiglu<true>, pg8::SchedMoe, true, true>(F.lds, F.wave, 1024, 1024, S, E);
        } else if (q == 10 && PON(10)) {
            unsigned char* wm = F.ws + WS_W0;
            LAS int* geo = (LAS int*)(F.lds + RING_BYTES + 512);
            moe_geometry(F, 0, geo);
            pg8::SchedMoe S; S.A = (const char*)act_ptr(F, A_ACTE); S.B = (const char*)(wm + WO_MD); S.a_tile = (size_t)256 * DEXP * 2; S.b_tile = (size_t)256 * DEXP * 2; S.b_exp = (size_t)1024 * DEXP * 2;
            S.nN = 4; S.G = F.G; S.c = cblk;
            S.t1 = __builtin_amdgcn_readfirstlane(geo[1]); S.t2 = __builtin_amdgcn_readfirstlane(geo[2]); S.t3 = __builtin_amdgcn_readfirstlane(geo[3]); S.t4 = __builtin_amdgcn_readfirstlane(geo[4]);
            S.t5 = __builtin_amdgcn_readfirstlane(geo[5]); S.t6 = __builtin_amdgcn_readfirstlane(geo[6]); S.t7 = __builtin_amdgcn_readfirstlane(geo[7]); S.MT = __builtin_amdgcn_readfirstlane(geo[8]);
            { const int nt = S.MT * 4, rem = nt % F.G; if (rem > 0 && 2 * rem <= F.G) S.split_from = nt - rem; }
            pg8::EpiMoeDown E{act_ptr(F, A_Y)};
            pg8::gemm_phase<pg8::EpiMoeDown, pg8::SchedMoe, true, true>(F.lds, F.wave, DEXP, DEXP, S, E);
        }
        else if (q == 11) {
            const int* tslot = (const int*)(F.ws + WS_TSLOT); const bf16_t* y = act_ptr(F, A_Y);
            const int tstep = F.G * 8;
            for (int tb = F.vcu * 8 + F.wave; tb < T; tb += 4 * tstep) {
                int sl = 0;
                { const int tt = tb + (F.lane >> 1) * tstep; if (F.lane < 8 && tt < T) sl = tslot[tt * 2 + (F.lane & 1)]; }
                u32x4 av[4][2], bv[4][2], xv4[4][2];
#pragma unroll
                for (int k = 0; k < 4; ++k) {
                    const int t = tb + k * tstep, tc = t < T ? t : tb;
                    const int s0 = __shfl(sl, 2 * k), s1 = __shfl(sl, 2 * k + 1);
                    const bf16_t* xbr = (const bf16_t*)(F.ws + WS_XB) + (size_t)tc * D;
#pragma unroll
                    for (int j = 0; j < 2; ++j) {
                        av[k][j] = *((const u32x4*)(y + (size_t)s0 * D) + 64 * j + F.lane); bv[k][j] = *((const u32x4*)(y + (size_t)s1 * D) + 64 * j + F.lane);
                        xv4[k][j] = *((const u32x4*)xbr + 64 * j + F.lane);
                    }
                }
#pragma unroll
                for (int k = 0; k < 4; ++k) {
                    const int t = tb + k * tstep; if (t >= T) break;
                    f32x4* xo = (f32x4*)(F.out + (size_t)t * D) + F.lane * 2;
#pragma unroll
                    for (int j = 0; j < 2; ++j) {
                        const u32x4 a = av[k][j], bq = bv[k][j], xv = xv4[k][j];
                        f32x4 x0 = {bflo(xv.x), bfhi(xv.x), bflo(xv.y), bfhi(xv.y)}, x1 = {bflo(xv.z), bfhi(xv.z), bflo(xv.w), bfhi(xv.w)};
                        x0[0] += bflo(a.x) + bflo(bq.x); x0[1] += bfhi(a.x) + bfhi(bq.x); x0[2] += bflo(a.y) + bflo(bq.y); x0[3] += bfhi(a.y) + bfhi(bq.y);
                        x1[0] += bflo(a.z) + bflo(bq.z); x1[1] += bfhi(a.z) + bfhi(bq.z); x1[2] += bflo(a.w) + bflo(bq.w); x1[3] += bfhi(a.w) + bfhi(bq.w);
                        xo[128 * j] = x0; xo[128 * j + 1] = x1;
                    }
                }
            }
        }
        if (ph + 1 < hi || (!rpt && ((REP_MASK >> ph) & 1))) xcd_barrier(bar);
    }
}


#ifdef DBG_PH
__global__ void dbg_dump(const unsigned char* ws, float* out) {
    const size_t i = (size_t)blockIdx.x * 256 + threadIdx.x;
    float v = 0.f;
    const bf16_t* a0 = (const bf16_t*)(ws + WS_ACTS + DBG_A0); const bf16_t* a1 = (const bf16_t*)(ws + WS_ACTS + DBG_A1);
    if (i < (size_t)DBG_N0) v += __uint_as_float((unsigned)a0[i] << 16);
    if (i < (size_t)DBG_N1) v += 3.f * __uint_as_float((unsigned)a1[i] << 16);
    out[i] = v;
}
#endif

extern "C" void kernel_launch(void* const* d_in, const int* in_sizes, int n_in, void* d_out, int out_size, void* d_ws, size_t ws_size, hipStream_t stream) {
    static int grid = 0;
    if (grid == 0) {
        if (n_in != 25 || out_size != T * D || ws_size < WS_END) { fprintf(stderr, "kernel_launch: unexpected sizes (n_in %d out %d ws %zu)\n", n_in, out_size, ws_size); grid = -1; return; }
        int dev = 0, cus = 0;
        if (hipGetDevice(&dev) != hipSuccess || hipDeviceGetAttribute(&cus, hipDeviceAttributeMultiprocessorCount, dev) != hipSuccess) { grid = -1; return; }
        if (hipFuncSetAttribute((const void*)mega_fwd, hipFuncAttributeMaxDynamicSharedMemorySize, LDS_BYTES) != hipSuccess) { grid = -1; return; }
        int per_cu = 0;
        (void)hipOccupancyMaxActiveBlocksPerMultiprocessor(&per_cu, (const void*)mega_fwd, 512, LDS_BYTES);
        (void)hipGetLastError();
        grid = cus;
    }
    if (grid < 0) return;
    (void)hipMemsetAsync((char*)d_ws + WS_CTL, 0, CTL_BYTES, stream);
    Args a{};
    for (int i = 0; i < 25; ++i) a.in[i] = d_in[i];
    a.out = (float*)d_out; a.ws = (unsigned char*)d_ws; a.ph_lo = 0; a.ph_hi = NPHASE; a.li = 0; a.pad = 0;
#ifdef DBG_PH
    a.ph_hi = DBG_PH;
#endif
    void* kargs[] = {&a};
    hipError_t e = hipLaunchCooperativeKernel((const void*)mega_fwd, dim3(grid), dim3(512), kargs, LDS_BYTES, stream);
    if (e != hipSuccess) fprintf(stderr, "cooperative launch failed: %s (grid %d)\n", hipGetErrorString(e), grid);
#ifdef DBG_PH
    hipLaunchKernelGGL(dbg_dump, dim3(T * 1024 / 256), dim3(256), 0, stream, (const unsigned char*)d_ws, (float*)d_out);
#endif
}
```

```cpp
#include <hip/hip_runtime.h>
#include <cstdint>
#include <cstdio>

#define LAS __attribute__((address_space(3)))
#define CAS __attribute__((address_space(4)))
typedef const void* GPtr;
typedef unsigned short bf16_t;
typedef short bf16x8 __attribute__((ext_vector_type(8)));
typedef float f32x4 __attribute__((ext_vector_type(4)));
typedef float f32x16 __attribute__((ext_vector_type(16)));
typedef unsigned u32x4 __attribute__((ext_vector_type(4)));
typedef unsigned u32x2 __attribute__((ext_vector_type(2)));

constexpr int T = 16384, SEQ = 4096, NB = 4, D = 1024, DIN = 5680, DFF = 2816, DEXP = 1408, NEXP = 8;
constexpr int NPROJ = 2816;
constexpr float EPS = 1e-6f;
constexpr int MAXSLOT = 34816;

constexpr size_t MiB = 1u << 20;
constexpr size_t WS_CTL = 0, CTL_BYTES = 128 * 1024;
constexpr size_t WS_SLOT = 2 * MiB;
constexpr size_t WS_ROPE = 3 * MiB;
constexpr size_t WS_XB = 5 * MiB;
constexpr size_t WS_W1 = 37 * MiB;
constexpr size_t WS_W0 = 55 * MiB;
constexpr size_t WS_ACTS = 89 * MiB;
constexpr size_t WS_STATS = 283 * MiB;
constexpr size_t WS_END = 291 * MiB;
constexpr size_t WO_IN = 0, WO_G = 5632 * 1024, WO_UP = WO_G + 6 * MiB, WO_BR = WO_UP + 1792 * 256 * 2, WO_OUT = WO_BR + 3 * MiB, WO_FGU = WO_OUT + 2 * MiB, WO_FD = WO_FGU + 11 * MiB;
constexpr size_t WO_MGU = 0, WO_MD = 44 * MiB;
constexpr size_t A_OG = 0, A_GQKV = 16 * MiB, A_UP = 48 * MiB, A_MISC = 64 * MiB, A_CQKV = 72 * MiB, A_VT = 72 * MiB, A_QKVRAW = 88 * MiB;
constexpr size_t A_YSA = 96 * MiB, A_POOLED = 112 * MiB, A_YSB = 128 * MiB, A_QH = 144 * MiB, A_KH = 168 * MiB;
constexpr size_t A_G0 = 16 * MiB, A_G1 = 48 * MiB, A_G2 = 144 * MiB, A_ACT = 0;
constexpr size_t A_MERGED = 0;
constexpr long long MERGED_HI_DELTA = (long long)(64 * MiB);
constexpr size_t A_XG = 32 * MiB, A_ACTE = 100 * MiB, A_Y = 32 * MiB;
constexpr int CW_TMO = 0, CW_BAR = 4096, CW_QUEUE = 16384, CW_WGCNT = 20480;
static_assert((size_t)(CW_WGCNT + 2048) * 4 <= CTL_BYTES, "ctl");
constexpr size_t SF_SSQ = 0;
constexpr size_t SF_ROWSS = (size_t)2 * 2 * T * 4;
constexpr size_t SF_OSS = SF_ROWSS + (size_t)4 * T * 16;
constexpr size_t SF_EB = SF_OSS + (size_t)T * 32;
static_assert((SF_EB + (size_t)(T / 32) * 256) * 4 <= 8 * MiB, "stats");
constexpr size_t SL_TOK = 0, SL_SCALE = 139264, SL_COMB = 2 * 139264, SL_ROUTE = 3 * 139264;
constexpr size_t WS_TSLOT = 1 * MiB;

constexpr int RING_BYTES = 131072, LDSCTL_OFF = RING_BYTES, MISC_OFF = LDSCTL_OFF + 320, LDS_BYTES = 147456;
constexpr int RS_OFF = RING_BYTES + 1024;

#define LDS_WAIT() asm volatile("s_waitcnt lgkmcnt(0)" ::: "memory")
#define VM_WAIT() asm volatile("s_waitcnt vmcnt(0)" ::: "memory")
#define LDS_BARRIER() do { asm volatile("s_waitcnt lgkmcnt(0)" ::: "memory"); __builtin_amdgcn_s_barrier(); asm volatile("" ::: "memory"); } while (0)
#define RLX_AGENT __ATOMIC_RELAXED, __HIP_MEMORY_SCOPE_AGENT
typedef float f32x2_t __attribute__((ext_vector_type(2))); typedef __bf16 bf16x2_t __attribute__((ext_vector_type(2)));
__device__ __forceinline__ unsigned cvt_pk_bf16(float lo, float hi) { f32x2_t v = {lo, hi}; bf16x2_t b = __builtin_convertvector(v, bf16x2_t); return __builtin_bit_cast(unsigned, b); }
__device__ __forceinline__ float bflo(unsigned u) { return __uint_as_float(u << 16); }
__device__ __forceinline__ float bfhi(unsigned u) { return __uint_as_float(u & 0xffff0000u); }
__device__ __forceinline__ float wave_sum(float v) {
#pragma unroll
    for (int o = 1; o < 64; o <<= 1) v += __shfl_xor(v, o);
    return v;
}
__device__ __forceinline__ float sum16(const float* p) { const f32x4 a = *(const f32x4*)p, b = *(const f32x4*)(p + 4), c = *(const f32x4*)(p + 8), d = *(const f32x4*)(p + 12);
    return (((a[0] + a[1]) + (a[2] + a[3])) + ((b[0] + b[1]) + (b[2] + b[3]))) + (((c[0] + c[1]) + (c[2] + c[3])) + ((d[0] + d[1]) + (d[2] + d[3]))); }
__device__ __forceinline__ float sum4(const float* p) { const f32x4 a = *(const f32x4*)p; return (a[0] + a[1]) + (a[2] + a[3]); }
__device__ __forceinline__ float fast_sigmoid(float z) { return __builtin_amdgcn_rcpf(1.f + __builtin_amdgcn_exp2f(-1.4426950408889634f * z)); }

namespace pg8 {
constexpr int BM = 256, BK = 64, HALF = 128, HTB = HALF * BK * 2, STAGE_BYTES = 8 * HTB, NXCD = 8, WGM = 8;
__host__ __device__ __forceinline__ int lds_byte(int r, int c) { const int st = (r >> 4) * 2 + (c >> 5), rr = r & 15, cc = c & 31, ob = rr * 64 + cc * 2; return st * 1024 + (ob ^ (((ob >> 9) & 1) << 5)); }
__host__ __device__ __forceinline__ void stage_rc(int b, int& R, int& C) { const int st = b / 1024, sb = b % 1024, swz = sb ^ (((sb >> 9) & 1) << 5); R = (st >> 1) * 16 + swz / 64; C = (st & 1) * 32 + (swz % 64) / 2; }
__host__ __device__ __forceinline__ int perm32(int rho) { const int n = rho >> 4, i = rho & 15; return 8 * (i >> 2) + 4 * n + (i & 3); }

struct Unit { const char* a; const char* b; int pm, pn, kind, half; };
__device__ __forceinline__ void tile_map(int L, int nM, int nN, int& pm, int& pn) {
    const int nwg = nM * nN; int wgid = L;
    { const int q = nwg / NXCD, r = nwg % NXCD, xcd = wgid % NXCD, off = wgid / NXCD; wgid = (xcd < r ? xcd * (q + 1) : r * (q + 1) + (xcd - r) * q) + off; }
    const int nig = WGM * nN, gid = wgid / nig, fm = gid * WGM, gsz = (nM - fm) < WGM ? (nM - fm) : WGM;
    pm = fm + ((wgid % nig) % gsz); pn = (wgid % nig) / gsz;
}

template <class Epi, class Sched, bool ALIGN_EPI, bool SP2>
__device__ __forceinline__ void gemm_phase(LAS unsigned char* lds, const int wave_in, const int lda, const int K, const Sched& S, const Epi& E) {
    int ln_; asm volatile("v_mbcnt_lo_u32_b32 %0, -1, 0\n\tv_mbcnt_hi_u32_b32 %0, -1, %0" : "=v"(ln_));
    const int tid = wave_in * 64 + ln_, wid = __builtin_amdgcn_readfirstlane(tid >> 6), lane = tid & 63, wr = wid >> 2, wc = wid & 3, fr = lane & 15, fq = lane >> 4;
    const int nt = K / BK;
    constexpr bool GATHER = Sched::GATHER;
    unsigned voffA[2], voffA1[2], voffB[2];
#pragma unroll
    for (int i = 0; i < 2; ++i) { int R, C; stage_rc(tid * 16 + i * 8192, R, C); const int Rb = Epi::PERM ? ((R & ~31) + perm32(R & 31)) : R;
        voffA[i] = (unsigned)(R * lda + C) * 2u; voffB[i] = (unsigned)(Rb * K + C) * 2u; voffA1[i] = voffA[i]; }
    LAS int* idl = (LAS int*)(lds + RING_BYTES + 4096);
    const size_t kstep = (size_t)(BK * 2);
    const size_t hstepA = GATHER ? (size_t)0 : (size_t)HALF * lda * 2, hstepB = (size_t)HALF * K * 2;
    auto gather_ids = [&](const Unit& u, int (&tk)[4]) {
#pragma unroll
        for (int i = 0; i < 2; ++i) { int R, C; stage_rc(tid * 16 + i * 8192, R, C);
            if constexpr (GATHER) { tk[i] = S.rowmap[u.pm * BM + R]; tk[2 + i] = S.rowmap[u.pm * BM + HALF + R]; } else { tk[i] = 0; tk[2 + i] = 0; } }
    };
    auto gather_offs = [&](const int (&tk)[4], unsigned (&o0)[2], unsigned (&o1)[2]) {
#pragma unroll
        for (int i = 0; i < 2; ++i) { int R, C; stage_rc(tid * 16 + i * 8192, R, C); o0[i] = (unsigned)((tk[i] < 0 ? 0 : tk[i]) * lda + C) * 2u; o1[i] = (unsigned)((tk[2 + i] < 0 ? 0 : tk[2 + i]) * lda + C) * 2u; }
    };
    const unsigned ldsw = (unsigned)wid * 1024u;
    const int aoff = lds_byte(wr * 64 + fr, fq * 8), boff = lds_byte(wc * 32 + fr, fq * 8);
#define PG8_SA(b, h) (((b) * 2 + (h)) * HTB)
#define PG8_SB(b, h) ((4 + (b) * 2 + (h)) * HTB)
#define PG8_STAGE(bufoff, gbase, voff) do { _Pragma("unroll") for (int _i = 0; _i < 2; ++_i) \
        __builtin_amdgcn_global_load_lds((const unsigned*)((const char*)(gbase) + (voff)[_i]), (LAS unsigned*)(lds + (bufoff) + ldsw + _i * 8192), 16, 0, 0); } while (0)
#define PG8_STAGEA(b, h, gbase) PG8_STAGE(PG8_SA(b, h), gbase, ((GATHER && (h)) ? voffA1 : voffA))
#define PG8_LDA(dst, b, h) do { _Pragma("unroll") for (int m = 0; m < 4; ++m) _Pragma("unroll") for (int k = 0; k < 2; ++k) dst[m][k] = *(const LAS bf16x8*)(lds + PG8_SA(b, h) + aoff + m * 2048 + k * 1024); } while (0)
#define PG8_LDB(dst, b, h) do { _Pragma("unroll") for (int n = 0; n < 2; ++n) _Pragma("unroll") for (int k = 0; k < 2; ++k) dst[n][k] = *(const LAS bf16x8*)(lds + PG8_SB(b, h) + boff + n * 2048 + k * 1024); } while (0)
#define PG8_MMA(ai, bj, At, Bt) do { __builtin_amdgcn_s_setprio(1); _Pragma("unroll") for (int m = 0; m < 4; ++m) _Pragma("unroll") for (int n = 0; n < 2; ++n) _Pragma("unroll") for (int k = 0; k < 2; ++k) \
        acc[ai][bj][m][n] = __builtin_amdgcn_mfma_f32_16x16x32_bf16(Bt[n][k], At[m][k], acc[ai][bj][m][n], 0, 0, 0); __builtin_amdgcn_s_setprio(0); } while (0)
#define PG8_WAIT_V(n) asm volatile("s_waitcnt vmcnt(" #n ")" ::: "memory")
#define PG8_WAIT_L(n) asm volatile("s_waitcnt lgkmcnt(" #n ")" ::: "memory")
#define PG8_BAR __builtin_amdgcn_s_barrier()
#define PG8_SCHED __builtin_amdgcn_sched_barrier(0)
    Unit cur, nxt; int ui = 0;
    if (!S.next(0, cur)) return;
    if constexpr (GATHER) { int tk0[4]; gather_ids(cur, tk0); gather_offs(tk0, voffA, voffA1); }
    f32x4 acc[2][2][4][2];
#pragma unroll
    for (int a = 0; a < 2; ++a)
#pragma unroll
        for (int b = 0; b < 2; ++b)
#pragma unroll
            for (int m = 0; m < 4; ++m)
#pragma unroll
                for (int n = 0; n < 2; ++n) acc[a][b][m][n] = (f32x4){0.f, 0.f, 0.f, 0.f};
    bf16x8 At[4][2], B0[2][2], B1[2][2];
    const char* cA = cur.a; const char* cB = cur.b;
    if constexpr (SP2) {
        PG8_STAGE(PG8_SB(0, 0), cB, voffB); PG8_STAGE(PG8_SB(0, 1), cB + hstepB, voffB); PG8_STAGEA(0, 0, cA); PG8_STAGEA(0, 1, cA + hstepA);
        if (wr == 1) PG8_BAR;
        PG8_WAIT_V(2); PG8_BAR;
        PG8_STAGE(PG8_SB(1, 0), cB + kstep, voffB); PG8_STAGEA(1, 0, cA + kstep); PG8_STAGE(PG8_SB(1, 1), cB + hstepB + kstep, voffB);
        PG8_WAIT_V(6); PG8_BAR;
    } else {
        PG8_STAGE(PG8_SB(0, 0), cB, voffB); PG8_STAGEA(0, 0, cA); PG8_STAGE(PG8_SB(0, 1), cB + hstepB, voffB); PG8_STAGEA(0, 1, cA + hstepA);
        if (wr == 1) PG8_BAR;
        PG8_WAIT_V(4); PG8_BAR;
        PG8_STAGE(PG8_SB(1, 0), cB + kstep, voffB); PG8_STAGEA(1, 0, cA + kstep); PG8_STAGE(PG8_SB(1, 1), cB + hstepB + kstep, voffB);
        PG8_WAIT_V(6); PG8_BAR;
    }
    for (;;) {
        const bool has_next = S.next(ui + 1, nxt);
        if constexpr (GATHER) { if (has_next) {
#pragma unroll
            for (int k = 0; k < 4; ++k) { int R, C; stage_rc(tid * 16 + (k & 1) * 8192, R, C);
                __builtin_amdgcn_global_load_lds((const unsigned*)(S.rowmap + nxt.pm * BM + (k >> 1) * HALF + R), (LAS unsigned*)(idl + k * 512 + wid * 64), 4, 0, 0); } } }
        const bool do0 = cur.half != 2, do1 = cur.half != 1;
        const char* nA = has_next ? nxt.a : cA; const char* nB = has_next ? nxt.b : cB;
#pragma unroll 1
        for (int t = 0; t < nt; t += 2) {
            const bool last = (t == nt - 2);
            const char* a1 = cA + (size_t)(t + 1) * kstep;
            const char* a2 = last ? nA : cA + (size_t)(t + 2) * kstep; const char* b2 = last ? nB : cB + (size_t)(t + 2) * kstep;
            const char* a3 = a2 + kstep; const char* b3 = b2 + kstep;
            if constexpr (SP2) {
            PG8_LDB(B0, 0, 0); PG8_LDB(B1, 0, 1); PG8_SCHED; PG8_LDA(At, 0, 0); PG8_STAGEA(1, 1, a1 + hstepA);
            PG8_WAIT_V(8); PG8_WAIT_L(0); PG8_BAR; if (do0) { PG8_MMA(0, 0, At, B0); PG8_MMA(0, 1, At, B1); } PG8_BAR; PG8_SCHED;
            if constexpr (GATHER) { if (last && has_next) { int tk[4];
#pragma unroll
                for (int k = 0; k < 4; ++k) tk[k] = idl[k * 512 + tid];
                gather_offs(tk, voffA, voffA1); } }
            PG8_LDA(At, 0, 1); PG8_STAGE(PG8_SB(0, 0), b2, voffB); PG8_STAGE(PG8_SB(0, 1), b2 + hstepB, voffB); PG8_STAGEA(0, 0, a2);
            PG8_WAIT_V(8); PG8_WAIT_L(0); PG8_BAR; if (do1) { PG8_MMA(1, 0, At, B0); PG8_MMA(1, 1, At, B1); } PG8_BAR; PG8_SCHED;
            PG8_LDB(B0, 1, 0); PG8_LDB(B1, 1, 1); PG8_SCHED; PG8_LDA(At, 1, 0); PG8_STAGEA(0, 1, a2 + hstepA);
            PG8_WAIT_V(8); PG8_WAIT_L(0); PG8_BAR; if (do0) { PG8_MMA(0, 0, At, B0); PG8_MMA(0, 1, At, B1); } PG8_BAR; PG8_SCHED;
            PG8_LDA(At, 1, 1); PG8_STAGE(PG8_SB(1, 0), b3, voffB); PG8_STAGE(PG8_SB(1, 1), b3 + hstepB, voffB); PG8_STAGEA(1, 0, a3);
            PG8_WAIT_V(8); PG8_WAIT_L(0); PG8_BAR; if (do1) { PG8_MMA(1, 0, At, B0); PG8_MMA(1, 1, At, B1); } PG8_BAR; PG8_SCHED;
            } else {
            PG8_LDB(B0, 0, 0); PG8_SCHED; PG8_LDA(At, 0, 0); PG8_STAGEA(1, 1, a1 + hstepA);
            PG8_WAIT_L(8); PG8_BAR; PG8_WAIT_L(0); PG8_MMA(0, 0, At, B0); PG8_BAR; PG8_SCHED;
            PG8_LDB(B1, 0, 1); PG8_STAGE(PG8_SB(0, 0), b2, voffB);
            PG8_BAR; PG8_WAIT_L(0); PG8_MMA(0, 1, At, B1); PG8_BAR;
            PG8_LDA(At, 0, 1); PG8_STAGEA(0, 0, a2);
            PG8_BAR; PG8_WAIT_L(0); PG8_MMA(1, 0, At, B0); PG8_BAR; PG8_SCHED;
            PG8_STAGE(PG8_SB(0, 1), b2 + hstepB, voffB);
            PG8_WAIT_V(6); PG8_BAR; PG8_MMA(1, 1, At, B1); PG8_BAR;
            PG8_LDB(B0, 1, 0); PG8_SCHED; PG8_LDA(At, 1, 0); PG8_STAGEA(0, 1, a2 + hstepA);
            PG8_WAIT_L(8); PG8_BAR; PG8_WAIT_L(0); PG8_MMA(0, 0, At, B0); PG8_BAR; PG8_SCHED;
            PG8_LDB(B1, 1, 1); PG8_STAGE(PG8_SB(1, 0), b3, voffB);
            PG8_BAR; PG8_WAIT_L(0); PG8_MMA(0, 1, At, B1); PG8_BAR;
            PG8_LDA(At, 1, 1); PG8_STAGEA(1, 0, a3);
            PG8_BAR; PG8_WAIT_L(0); PG8_MMA(1, 0, At, B0); PG8_BAR; PG8_SCHED;
            PG8_STAGE(PG8_SB(1, 1), b3 + hstepB, voffB);
            PG8_WAIT_V(6); PG8_BAR; PG8_MMA(1, 1, At, B1); PG8_BAR;
            }
        }
        if constexpr (ALIGN_EPI) { if (wr == 0) PG8_BAR; }
        E(acc, cur, wr, wc, fr, fq);
        if (!has_next) break;
        if (!E.keep(cur)) {
#pragma unroll
            for (int a = 0; a < 2; ++a)
#pragma unroll
                for (int b = 0; b < 2; ++b)
#pragma unroll
                    for (int m = 0; m < 4; ++m)
#pragma unroll
                        for (int n = 0; n < 2; ++n) acc[a][b][m][n] = (f32x4){0.f, 0.f, 0.f, 0.f};
        }
        cur = nxt; cA = nA; cB = nB; ++ui;
        if constexpr (ALIGN_EPI) { if (wr == 1) PG8_BAR; }
    }
    PG8_WAIT_V(0);
    if constexpr (!ALIGN_EPI) { if (wr == 0) PG8_BAR; }
    PG8_BAR;
#undef PG8_SA
#undef PG8_SB
#undef PG8_STAGE
#undef PG8_STAGEA
#undef PG8_LDA
#undef PG8_LDB
#undef PG8_MMA
#undef PG8_WAIT_V
#undef PG8_WAIT_L
#undef PG8_BAR
#undef PG8_SCHED
}

typedef f32x4 Acc[2][2][4][2];

struct EpiProj {
    static constexpr bool PERM = true;
    bf16_t *cqkv, *gqkv, *og, *up, *misc; const LAS float* rs_tab; float* ssq;
    __device__ __forceinline__ bool keep(const Unit&) const { return false; }
    __device__ __forceinline__ void operator()(Acc& acc, const Unit& u, int wr, int wc, int fr, int fq) const {
        const int row0 = u.pm * BM + wr * 64 + fr;
        bf16_t* dst; int ld, coff; const int pn = u.pn;
        if (pn < 2) { dst = cqkv; ld = 512; coff = pn * 256; }
        else if (pn < 6) { dst = gqkv; ld = 1024; coff = (pn - 2) * 256; }
        else if (pn < 8) { dst = og; ld = 512; coff = (pn - 6) * 256; }
        else if (pn < 10) { dst = up; ld = 512; coff = (pn - 8) * 256; }
        else { dst = misc; ld = 256; coff = 0; }
        const int col0 = coff + wc * 32 + 8 * fq;
#pragma unroll
        for (int ai = 0; ai < 2; ++ai)
#pragma unroll
            for (int m = 0; m < 4; ++m) { if (u.half && ai != u.half - 1) continue;
                const int row = row0 + ai * HALF + m * 16;
                const float rs = rs_tab[wr * 64 + fr + ai * HALF + m * 16];
                float ss = 0.f;
#pragma unroll
                for (int bj = 0; bj < 2; ++bj) {
                    const f32x4 v0 = acc[ai][bj][m][0] * rs, v1 = acc[ai][bj][m][1] * rs;
                    ss += (v0[0] * v0[0] + v0[1] * v0[1]) + (v0[2] * v0[2] + v0[3] * v0[3]) + (v1[0] * v1[0] + v1[1] * v1[1]) + (v1[2] * v1[2] + v1[3] * v1[3]);
                    u32x4 w; w.x = cvt_pk_bf16(v0[0], v0[1]); w.y = cvt_pk_bf16(v0[2], v0[3]); w.z = cvt_pk_bf16(v1[0], v1[1]); w.w = cvt_pk_bf16(v1[2], v1[3]);
                    *(u32x4*)(dst + (size_t)row * ld + col0 + bj * HALF) = w;
                }
                if (pn < 2) { ss += __shfl_xor(ss, 16); ss += __shfl_xor(ss, 32); if (fq == 0) ssq[((size_t)pn * T + row) * 4 + wc] = ss; }
            }
    }
};
struct EpiUp {
    static constexpr bool PERM = true;
    bf16_t* out; const float* ssq;
    __device__ __forceinline__ bool keep(const Unit&) const { return false; }
    __device__ __forceinline__ void operator()(Acc& acc, const Unit& u, int wr, int wc, int fr, int fq) const {
        const int row0 = u.pm * BM + wr * 64 + fr, col0 = u.pn * BM + wc * 32 + 8 * fq;
        const float* sq = ssq + (u.pn < 3 ? (size_t)0 : (size_t)T * 4);
        f32x4 sqv[2][4];
#pragma unroll
        for (int ai = 0; ai < 2; ++ai)
#pragma unroll
            for (int m = 0; m < 4; ++m) sqv[ai][m] = *(const f32x4*)(sq + (size_t)(row0 + ai * HALF + m * 16) * 4);
#pragma unroll
        for (int ai = 0; ai < 2; ++ai)
#pragma unroll
            for (int m = 0; m < 4; ++m) { if (u.half && ai != u.half - 1) continue;
                const int row = row0 + ai * HALF + m * 16;
                const float rs = rsqrtf(((sqv[ai][m][0] + sqv[ai][m][1]) + (sqv[ai][m][2] + sqv[ai][m][3])) * (1.f / 256.f) + EPS);
#pragma unroll
                for (int bj = 0; bj < 2; ++bj) {
                    const f32x4 v0 = acc[ai][bj][m][0] * rs, v1 = acc[ai][bj][m][1] * rs;
                    u32x4 w; w.x = cvt_pk_bf16(v0[0], v0[1]); w.y = cvt_pk_bf16(v0[2], v0[3]); w.z = cvt_pk_bf16(v1[0], v1[1]); w.w = cvt_pk_bf16(v1[2], v1[3]);
                    *(u32x4*)(out + (size_t)row * 1792 + col0 + bj * HALF) = w;
                }
            }
    }
};
struct EpiGate {
    static constexpr bool PERM = true;
    unsigned char* acts; const LAS float* rs_tab;
    __device__ __forceinline__ bool keep(const Unit&) const { return false; }
    __device__ __forceinline__ void operator()(Acc& acc, const Unit& u, int wr, int wc, int fr, int fq) const {
        const int row0 = u.pm * BM + wr * 64 + fr, pl = u.pn >> 2, col0 = (u.pn & 3) * BM + wc * 32 + 8 * fq;
        bf16_t* dst = (bf16_t*)(acts + ((long long)A_G0 + (long long)(pl == 1) * (long long)(A_G1 - A_G0) + (long long)(pl == 2) * (long long)(A_G2 - A_G0)));
#pragma unroll
        for (int ai = 0; ai < 2; ++ai)
#pragma unroll
            for (int m = 0; m < 4; ++m) { if (u.half && ai != u.half - 1) continue;
                const int row = row0 + ai * HALF + m * 16;
                const float rs = rs_tab[wr * 64 + fr + ai * HALF + m * 16];
#pragma unroll
                for (int bj = 0; bj < 2; ++bj) {
                    f32x4 v0 = acc[ai][bj][m][0] * rs, v1 = acc[ai][bj][m][1] * rs;
#ifndef DBG_NOSIG
#pragma unroll
                    for (int e = 0; e < 4; ++e) { v0[e] = fast_sigmoid(fminf(fmaxf(v0[e], -60.f), 60.f)); v1[e] = fast_sigmoid(fminf(fmaxf(v1[e], -60.f), 60.f)); }
#endif
                    u32x4 w; w.x = cvt_pk_bf16(v0[0], v0[1]); w.y = cvt_pk_bf16(v0[2], v0[3]); w.z = cvt_pk_bf16(v1[0], v1[1]); w.w = cvt_pk_bf16(v1[2], v1[3]);
                    *(u32x4*)(dst + (size_t)row * 1024 + col0 + bj * HALF) = w;
                }
            }
    }
};
struct EpiMerge {
    static constexpr bool PERM = true;
    const unsigned char* acts; bf16_t* merged;
    __device__ __forceinline__ bool keep(const Unit& u) const { return u.kind < 2; }
    __device__ __forceinline__ void operator()(Acc& acc, const Unit& u, int wr, int wc, int fr, int fq) const {
        const int row0 = u.pm * BM + wr * 64 + fr, col0 = u.pn * BM + wc * 32 + 8 * fq, n = u.kind;
        const bf16_t* gn = (const bf16_t*)(acts + ((long long)A_G0 + (long long)(n == 1) * (long long)(A_G1 - A_G0) + (long long)(n == 2) * (long long)(A_G2 - A_G0)));
        const bf16_t* gd = (const bf16_t*)(acts + ((long long)A_G1 + (long long)(n != 0) * (long long)(A_G2 - A_G1)));
        if (n < 2) {
#pragma unroll
            for (int ai = 0; ai < 2; ++ai) {
                if (u.half && ai != u.half - 1) continue;
                u32x4 sn[4][2], sd[4][2];
#pragma unroll
                for (int m = 0; m < 4; ++m)
#pragma unroll
                    for (int bj = 0; bj < 2; ++bj) {
                        const size_t off = (size_t)(row0 + ai * HALF + m * 16) * 1024 + col0 + bj * HALF;
                        sn[m][bj] = *(const u32x4*)(gn + off); sd[m][bj] = *(const u32x4*)(gd + off);
                    }
#pragma unroll
                for (int m = 0; m < 4; ++m)
#pragma unroll
                    for (int bj = 0; bj < 2; ++bj) {
                        const u32x4 s = sn[m][bj], d = sd[m][bj];
                        f32x4 f0 = {bflo(s.x), bfhi(s.x), bflo(s.y), bfhi(s.y)}, f1 = {bflo(s.z), bfhi(s.z), bflo(s.w), bfhi(s.w)};
                        const f32x4 d0 = {bflo(d.x), bfhi(d.x), bflo(d.y), bfhi(d.y)}, d1 = {bflo(d.z), bfhi(d.z), bflo(d.w), bfhi(d.w)};
#pragma unroll
                        for (int e = 0; e < 4; ++e) { f0[e] *= __builtin_amdgcn_rcpf(d0[e]); f1[e] *= __builtin_amdgcn_rcpf(d1[e]); }
                        acc[ai][bj][m][0] = acc[ai][bj][m][0] * f0; acc[ai][bj][m][1] = acc[ai][bj][m][1] * f1;
                    }
            }
        } else {
#pragma unroll
            for (int ai = 0; ai < 2; ++ai) {
                if (u.half && ai != u.half - 1) continue;
                u32x4 sn[4][2];
#pragma unroll
                for (int m = 0; m < 4; ++m)
#pragma unroll
                    for (int bj = 0; bj < 2; ++bj) sn[m][bj] = *(const u32x4*)(gn + (size_t)(row0 + ai * HALF + m * 16) * 1024 + col0 + bj * HALF);
#pragma unroll
                for (int m = 0; m < 4; ++m)
#pragma unroll
                    for (int bj = 0; bj < 2; ++bj) {
                        const int row = row0 + ai * HALF + m * 16; const size_t off = (size_t)row * 1024 + col0 + bj * HALF;
                        const u32x4 s = sn[m][bj];
                        const f32x4 f0 = {bflo(s.x), bfhi(s.x), bflo(s.y), bfhi(s.y)}, f1 = {bflo(s.z), bfhi(s.z), bflo(s.w), bfhi(s.w)};
                        const f32x4 v0 = acc[ai][bj][m][0] * f0, v1 = acc[ai][bj][m][1] * f1;
                        u32x4 w; w.x = cvt_pk_bf16(v0[0], v0[1]); w.y = cvt_pk_bf16(v0[2], v0[3]); w.z = cvt_pk_bf16(v1[0], v1[1]); w.w = cvt_pk_bf16(v1[2], v1[3]);
                        *(u32x4*)((unsigned char*)(merged + off) + (row >= 8192 ? MERGED_HI_DELTA : 0)) = w;
                    }
            }
        }
    }
};
struct EpiResid {
    static constexpr bool PERM = true;
    bf16_t* xb; float* rowss_next;
    __device__ __forceinline__ bool keep(const Unit&) const { return false; }
    __device__ __forceinline__ void operator()(Acc& acc, const Unit& u, int wr, int wc, int fr, int fq) const {
        const int row0 = u.pm * BM + wr * 64 + fr, col0 = u.pn * BM + wc * 32 + 8 * fq;
#pragma unroll
        for (int ai = 0; ai < 2; ++ai) {
            if (u.half && ai != u.half - 1) continue;
            u32x4 ov[4][2];
#pragma unroll
            for (int m = 0; m < 4; ++m)
#pragma unroll
                for (int bj = 0; bj < 2; ++bj) ov[m][bj] = *(const u32x4*)(xb + (size_t)(row0 + ai * HALF + m * 16) * D + col0 + bj * HALF);
#pragma unroll
            for (int m = 0; m < 4; ++m) {
                const int row = row0 + ai * HALF + m * 16; float ss = 0.f;
#pragma unroll
                for (int bj = 0; bj < 2; ++bj) {
                    bf16_t* p = xb + (size_t)row * D + col0 + bj * HALF;
                    const u32x4 o = ov[m][bj];
                    const f32x4 v0 = (f32x4){bflo(o.x), bfhi(o.x), bflo(o.y), bfhi(o.y)} + acc[ai][bj][m][0], v1 = (f32x4){bflo(o.z), bfhi(o.z), bflo(o.w), bfhi(o.w)} + acc[ai][bj][m][1];
                    ss += ((v0[0] * v0[0] + v0[1] * v0[1]) + (v0[2] * v0[2] + v0[3] * v0[3])) + ((v1[0] * v1[0] + v1[1] * v1[1]) + (v1[2] * v1[2] + v1[3] * v1[3]));
                    u32x4 w; w.x = cvt_pk_bf16(v0[0], v0[1]); w.y = cvt_pk_bf16(v0[2], v0[3]); w.z = cvt_pk_bf16(v1[0], v1[1]); w.w = cvt_pk_bf16(v1[2], v1[3]);
                    *(u32x4*)p = w;
                }
                ss += __shfl_xor(ss, 16); ss += __shfl_xor(ss, 32); if (fq == 0) rowss_next[(size_t)row * 16 + u.pn * 4 + wc] = ss;
            }
        }
    }
};
template <bool MOE> struct EpiSwiglu {
    static constexpr bool PERM = true;
    bf16_t* act; int ld; const LAS float* rs_tab; const float* slot_scale; const float* slot_comb;
    __device__ __forceinline__ bool keep(const Unit&) const { return false; }
    __device__ __forceinline__ void operator()(Acc& acc, const Unit& u, int wr, int wc, int fr, int fq) const {
        const int row0 = u.pm * BM + wr * 64 + fr, col0 = u.pn * HALF + wc * 32 + 8 * fq;
        float rsv[2][4], cbv[2][4];
#pragma unroll
        for (int ai = 0; ai < 2; ++ai)
#pragma unroll
            for (int m = 0; m < 4; ++m) {
                if (MOE) { rsv[ai][m] = slot_scale[row0 + ai * HALF + m * 16]; cbv[ai][m] = slot_comb[row0 + ai * HALF + m * 16]; }
                else { rsv[ai][m] = rs_tab[wr * 64 + fr + ai * HALF + m * 16]; cbv[ai][m] = 1.f; }
            }
#pragma unroll
        for (int ai = 0; ai < 2; ++ai)
#pragma unroll
            for (int m = 0; m < 4; ++m) { if (u.half && ai != u.half - 1) continue;
                const int row = row0 + ai * HALF + m * 16;
                const float rs = rsv[ai][m], cb = cbv[ai][m];
                f32x4 o[2];
#pragma unroll
                for (int n = 0; n < 2; ++n) {
                    const f32x4 g = acc[ai][0][m][n] * rs, uu = acc[ai][1][m][n] * rs;
#pragma unroll
                    for (int e = 0; e < 4; ++e) o[n][e] = g[e] * fast_sigmoid(g[e]) * uu[e] * cb;
                }
                u32x4 w; w.x = cvt_pk_bf16(o[0][0], o[0][1]); w.y = cvt_pk_bf16(o[0][2], o[0][3]); w.z = cvt_pk_bf16(o[1][0], o[1][1]); w.w = cvt_pk_bf16(o[1][2], o[1][3]);
                *(u32x4*)(act + (size_t)row * ld + col0) = w;
            }
    }
};
struct EpiMoeDown {
    static constexpr bool PERM = true;
    bf16_t* y;
    __device__ __forceinline__ bool keep(const Unit&) const { return false; }
    __device__ __forceinline__ void operator()(Acc& acc, const Unit& u, int wr, int wc, int fr, int fq) const {
        const int row0 = u.pm * BM + wr * 64 + fr, col0 = u.pn * BM + wc * 32 + 8 * fq;
#pragma unroll
        for (int ai = 0; ai < 2; ++ai)
#pragma unroll
            for (int m = 0; m < 4; ++m) { if (u.half && ai != u.half - 1) continue;
                const int row = row0 + ai * HALF + m * 16;
#pragma unroll
                for (int bj = 0; bj < 2; ++bj) {
                    const f32x4 v0 = acc[ai][bj][m][0], v1 = acc[ai][bj][m][1];
                    u32x4 w; w.x = cvt_pk_bf16(v0[0], v0[1]); w.y = cvt_pk_bf16(v0[2], v0[3]); w.z = cvt_pk_bf16(v1[0], v1[1]); w.w = cvt_pk_bf16(v1[2], v1[3]);
                    *(u32x4*)(y + (size_t)row * D + col0 + bj * HALF) = w;
                }
            }
    }
};

struct SchedGrid {
    static constexpr bool GATHER = false;
    const char* A; const char* B; size_t a_tile, b_tile, a_alt; int nM, nN, G, c, alt_from; long long a_hi = 0;
    int split_from = 1 << 30;
    __device__ __forceinline__ bool next(int i, Unit& u) const {
        int L = i * G + c, hf = 0;
        if (L >= split_from) { const int nl = nM * nN - split_from, j = L - split_from; if (j >= 2 * nl) return false; hf = 1 + j / nl; L = split_from + j % nl; }
        if (L >= nM * nN) return false;
        int pm, pn; tile_map(L, nM, nN, pm, pn);
        u.pm = pm; u.pn = pn; u.kind = 0; u.half = hf; u.a = A + (size_t)pm * a_tile + (pn >= alt_from ? a_alt : 0) + (pm >= 32 ? a_hi : 0); u.b = B + (size_t)pn * b_tile; return true;
    }
};
struct SchedMerge {
    static constexpr bool GATHER = false;
    const char* acts; const char* wbr; int G, c;
    __device__ __forceinline__ bool next(int i, Unit& u) const {
        const int ti = i / 3, n = i - ti * 3, L = ti * G + c; if (L >= 256) return false;
        int pm, pn; tile_map(L, 64, 4, pm, pn);
        u.pm = pm; u.pn = pn; u.kind = n; u.half = 0; u.a = acts + ((long long)A_YSA + (long long)(n == 1) * ((long long)A_YSB - (long long)A_YSA) + (long long)(n == 2) * ((long long)A_POOLED - (long long)A_YSA)) + (size_t)pm * (256 * 512 * 2); u.b = wbr + (size_t)n * (1024 * 512 * 2) + (size_t)pn * (256 * 512 * 2); return true;
    }
};
template <bool GATHER_> struct SchedMoeT {
    static constexpr bool GATHER = GATHER_;
    const int* rowmap = nullptr;
    const char* A; const char* B; size_t a_tile, b_tile, b_exp; int MT, nN, G, c; int t1, t2, t3, t4, t5, t6, t7;
    int split_from = 1 << 30;
    __device__ __forceinline__ bool next(int i, Unit& u) const {
        int L = i * G + c, hf = 0;
        if (L >= split_from) { const int nl = MT * nN - split_from, j = L - split_from; if (j >= 2 * nl) return false; hf = 1 + j / nl; L = split_from + j % nl; }
        if (L >= MT * nN) return false;
        int pm, pn; tile_map(L, MT, nN, pm, pn);
        const int e = (pm >= t1) + (pm >= t2) + (pm >= t3) + (pm >= t4) + (pm >= t5) + (pm >= t6) + (pm >= t7);
        u.pm = pm; u.pn = pn; u.kind = e; u.half = hf; u.a = A + (GATHER_ ? (size_t)0 : (size_t)pm * a_tile); u.b = B + (size_t)e * b_exp + (size_t)pn * b_tile; return true;
    }
};
typedef SchedMoeT<false> SchedMoe;
}

#define XB_TMO      128
#define XB_XCNT(j)  (256  + 64 * (j))
#define XB_XSUB(j)  (1280 + 64 * (j))
#define XB_XGEN(j)  (2304 + 64 * (j))
#define XB_TOP      3328
#define XB_TOPGEN   3392
#define XCD_BAR_WORDS 3456
#define XB_SPIN_CAP (1u << 18)
__device__ __forceinline__ unsigned xb_ld(unsigned* p)              { return __hip_atomic_load(p, __ATOMIC_RELAXED, __HIP_MEMORY_SCOPE_AGENT); }
__device__ __forceinline__ unsigned xb_add(unsigned* p, unsigned v) { return __hip_atomic_fetch_add(p, v, __ATOMIC_RELAXED, __HIP_MEMORY_SCOPE_AGENT); }
__device__ __forceinline__ unsigned xb_xcc_id() { return (unsigned)__builtin_amdgcn_s_getreg((3 << 11) | 20) & 0xFu; }
#define XB_SPIN(cond, bar) do { unsigned _sp = 0; while (cond) { __builtin_amdgcn_s_sleep(1); \
    if ((++_sp & 255u) == 0u) { if (xb_ld(&(bar)[XB_TMO])) break; if (_sp > XB_SPIN_CAP) { atomicAdd(&(bar)[XB_TMO], 1u); break; } } } } while (0)
struct XcdBarrier { unsigned* bar; unsigned x; volatile LAS unsigned* st; };
__device__ __forceinline__ XcdBarrier xcd_barrier_post(unsigned* bar, volatile LAS unsigned* st) {
    XcdBarrier b; b.bar = bar; b.x = xb_xcc_id(); b.st = st;
    if (threadIdx.x == 0) (void)xb_add(&bar[XB_XCNT(b.x)], 1u);
    return b;
}
__device__ __forceinline__ void xcd_barrier_complete(unsigned* bar, unsigned x, unsigned& nloc, unsigned& nx) {
    const unsigned G = gridDim.x * gridDim.y * gridDim.z;
    unsigned sum, cnt, mine, sp = 0u;
    for (;;) {
        sum = 0u; cnt = 0u; mine = 0u;
#pragma unroll
        for (unsigned j = 0; j < 16; ++j) { const unsigned c = xb_ld(&bar[XB_XCNT(j)]); sum += c; cnt += (c > 0u) ? 1u : 0u; mine = (j == x) ? c : mine; }
        if (sum == G) break;
        __builtin_amdgcn_s_sleep(1);
        if ((++sp & 255u) == 0u) { if (xb_ld(&bar[XB_TMO])) break; if (sp > XB_SPIN_CAP) { atomicAdd(&bar[XB_TMO], 1u); break; } }
    }
    nloc = mine > 0u ? mine : 1u; nx = cnt > 0u ? cnt : 1u;
}
__device__ __forceinline__ void xcd_barrier(const XcdBarrier& b) {
    asm volatile("s_waitcnt vmcnt(0)" ::: "memory");
    __syncthreads();
    if (threadIdx.x == 0) {
        unsigned* bar = b.bar;
        __builtin_amdgcn_s_waitcnt(0);
        unsigned nloc = b.st[0], nx = b.st[1];
        if (nloc == 0u) { xcd_barrier_complete(bar, b.x, nloc, nx); b.st[0] = nloc; b.st[1] = nx; }
        const unsigned old = xb_add(&bar[XB_XSUB(b.x)], 1u);
        const unsigned gen = old / nloc;
        if (old + 1u == (gen + 1u) * nloc) {
            __builtin_amdgcn_fence(__ATOMIC_RELEASE, "agent");
            asm volatile("s_waitcnt vmcnt(0)" ::: "memory");
            const unsigned og = xb_add(&bar[XB_TOP], 1u);
            const unsigned tg = og / nx;
            if (og + 1u == (tg + 1u) * nx) xb_add(&bar[XB_TOPGEN], 1u);
            else XB_SPIN(xb_ld(&bar[XB_TOPGEN]) == tg, bar);
            __builtin_amdgcn_fence(__ATOMIC_ACQUIRE, "agent");
            xb_add(&bar[XB_XGEN(b.x)], 1u);
            asm volatile("s_waitcnt vmcnt(0)" ::: "memory");
        } else {
            XB_SPIN(xb_ld(&bar[XB_XGEN(b.x)]) == gen, bar);
            __builtin_amdgcn_fence(__ATOMIC_ACQUIRE, "agent");
            asm volatile("s_waitcnt vmcnt(0)" ::: "memory");
        }
    }
    __syncthreads();
}

struct Frame {
    LAS unsigned char* lds;
    volatile LAS unsigned* MISC;
    unsigned* ctl; float* ctlf; float* stats;
    unsigned char* ws;
    int tid, lane, wave, vcu, G;
    const CAS GPtr* inp;
    float* out;
    __device__ __forceinline__ const float* in(int i) const { return (const float*)inp[i]; }
};
enum { I_X = 0, I_POS, I_GMIX, I_WIN, I_GCQ, I_WUQ, I_GCKV, I_WUKV, I_GQKQ, I_GQKK, I_WGLA, I_BGLA, I_GGLAO, I_WPOOL, I_PSCALE, I_WBR, I_WOUT, I_GFFN, I_WFG, I_WFU, I_WFD, I_WROUTER, I_WEG, I_WEU, I_WED };

__device__ __forceinline__ bf16_t* act_ptr(const Frame& F, size_t off) { return (bf16_t*)(F.ws + WS_ACTS + off); }
__device__ __forceinline__ unsigned char* wblk(const Frame& F, int layer) { return F.ws + (layer == 0 ? WS_W0 : WS_W1); }

__device__ __forceinline__ void fill_rs(Frame& F, const float* rowss, int pm) {
    if (F.tid < 256) ((LAS float*)(F.lds + RS_OFF))[F.tid] = rsqrtf(sum16(rowss + ((size_t)pm * 256 + F.tid) * 16) * (1.f / 1024.f) + EPS);
    __syncthreads();
}
struct ConvSeg { const float* src; int ld, K, width, col0; bf16_t* dst; int row0, inter; const float* gain; };
typedef short v4i16c_t __attribute__((ext_vector_type(4)));
__device__ __forceinline__ int seg_items(const ConvSeg& s) { return (s.K >> 6) * ((s.width + 63) >> 6); }
__device__ __forceinline__ void conv_load(const ConvSeg& s, int item, int lane, f32x4 (&v)[16], float (&gv)[16]) {
    const int nblk = (s.width + 63) >> 6, kb = item / nblk, nb = item - kb * nblk, k0 = kb * 64, n0 = nb * 64;
    const int kq = lane >> 4, n4 = (lane & 15) * 4; const bool ok = n0 + n4 < s.width;
    const float* p = s.src + (size_t)(k0 + kq) * s.ld + s.col0 + n0 + n4;
#pragma unroll
    for (int i = 0; i < 16; ++i) v[i] = ok ? *(const f32x4*)(p + (size_t)(4 * i) * s.ld) : (f32x4){0.f, 0.f, 0.f, 0.f};
    const bool hg = s.gain != nullptr; const float* gp = hg ? s.gain + k0 + kq : s.src;
#pragma unroll
    for (int i = 0; i < 16; ++i) { const float g = gp[hg ? 4 * i : 0]; gv[i] = hg ? g : 1.f; }
}
__device__ __forceinline__ void conv_store(const ConvSeg& s, int item, LAS unsigned char* scr, int lane, const f32x4 (&v)[16], const float (&gv)[16]) {
    const int nblk = (s.width + 63) >> 6, kb = item / nblk, nb = item - kb * nblk, k0 = kb * 64, n0 = nb * 64;
    const int kq = lane >> 4, n4 = (lane & 15) * 4;
#pragma unroll
    for (int i = 0; i < 16; ++i) {
        const f32x4 x = v[i] * gv[i];
        *(LAS u32x2*)(scr + (4 * i + kq) * 136 + n4 * 2) = (u32x2){cvt_pk_bf16(x[0], x[1]), cvt_pk_bf16(x[2], x[3])};
    }
    LDS_WAIT();
    const int g = lane >> 4, i16 = lane & 15;
#pragma unroll
    for (int nb16 = 0; nb16 < 4; ++nb16)
#pragma unroll
        for (int kh = 0; kh < 2; ++kh) {
            const int c = kh * 4 + g;
            const LAS unsigned char* a = scr + (8 * c + (i16 >> 2)) * 136 + (nb16 * 16 + (i16 & 3) * 4) * 2;
            const v4i16c_t lo = __builtin_amdgcn_ds_read_tr16_b64_v4i16((LAS v4i16c_t*)a), hi = __builtin_amdgcn_ds_read_tr16_b64_v4i16((LAS v4i16c_t*)(a + 4 * 136));
            const int nq = n0 + nb16 * 16 + i16;
            if (nq < s.width) {
                const int drow = s.row0 + (s.inter ? ((nq >> 7) * 256 + (nq & 127)) : nq);
                typedef short s16x8_t __attribute__((ext_vector_type(8)));
                *(s16x8_t*)(s.dst + (size_t)drow * s.K + k0 + 8 * c) = (s16x8_t){lo[0], lo[1], lo[2], lo[3], hi[0], hi[1], hi[2], hi[3]};
            }
        }
    LDS_WAIT();
}
__device__ __forceinline__ ConvSeg mixer_seg(const Frame& F, int l, int idx) {
    unsigned char* wb = wblk(F, l);
    ConvSeg s; s.inter = 0; s.row0 = 0; s.col0 = 0;
    if (idx < 10) {
        int c0, wd, r0;
        switch (idx) {
            case 0: c0 = 0; wd = 256; r0 = 0; break;
            case 1: c0 = 256; wd = 256; r0 = 256; break;
            case 2: c0 = 544; wd = 256; r0 = 512; break;
            case 3: c0 = 800; wd = 256; r0 = 768; break;
            case 4: c0 = 1056; wd = 512; r0 = 1024; break;
            case 5: c0 = 1584; wd = 512; r0 = 1536; break;
            case 6: c0 = 2096; wd = 512; r0 = 2048; break;
            case 7: c0 = 512; wd = 32; r0 = 2560; break;
            case 8: c0 = 1568; wd = 16; r0 = 2592; break;
            default: c0 = 2608; wd = 3072; r0 = 0; break;
        }
        s.src = F.in(I_WIN) + (size_t)l * D * DIN; s.ld = DIN; s.K = D; s.width = wd; s.col0 = c0;
        s.dst = (bf16_t*)(wb + (idx == 9 ? WO_G : WO_IN)); s.row0 = r0; s.gain = F.in(I_GMIX) + l * D;
    } else if (idx == 10) { s.src = F.in(I_WUQ) + (size_t)l * 256 * 768; s.ld = 768; s.K = 256; s.width = 768; s.dst = (bf16_t*)(wb + WO_UP); s.gain = F.in(I_GCQ) + l * 256; }
    else if (idx == 11) { s.src = F.in(I_WUKV) + (size_t)l * 256 * 1024; s.ld = 1024; s.K = 256; s.width = 1024; s.dst = (bf16_t*)(wb + WO_UP); s.row0 = 768; s.gain = F.in(I_GCKV) + l * 256; }
    else if (idx < 14) { const int n = idx - 12; s.src = F.in(I_WBR) + (size_t)(l * 3 + n) * 512 * D; s.ld = D; s.K = 512; s.width = D; s.dst = (bf16_t*)(wb + WO_BR) + (size_t)n * 1024 * 512; s.gain = nullptr; }
    else { s.src = F.in(I_WOUT) + (size_t)l * D * D; s.ld = D; s.K = D; s.width = D; s.dst = (bf16_t*)(wb + WO_OUT); s.gain = nullptr; }
    return s;
}
__device__ __forceinline__ ConvSeg ffn_seg(const Frame& F, int idx) {
    unsigned char* wb = F.ws + WS_W0; ConvSeg s; s.col0 = 0; s.inter = 0; s.row0 = 0;
    if (idx < 2) { s.src = F.in(idx == 0 ? I_WFG : I_WFU); s.ld = DFF; s.K = D; s.width = DFF; s.dst = (bf16_t*)(wb + WO_FGU); s.row0 = idx * 128; s.inter = 1; s.gain = F.in(I_GFFN); }
    else { s.src = F.in(I_WFD); s.ld = D; s.K = DFF; s.width = D; s.dst = (bf16_t*)(wb + WO_FD); s.gain = nullptr; }
    return s;
}
__device__ __forceinline__ ConvSeg moe_seg(const Frame& F, int idx) {
    unsigned char* wb = F.ws + WS_W0; const int e = idx / 3, k = idx - e * 3; ConvSeg s; s.col0 = 0; s.inter = 0; s.row0 = 0;
    if (k < 2) { s.src = F.in(k == 0 ? I_WEG : I_WEU) + (size_t)e * D * DEXP; s.ld = DEXP; s.K = D; s.width = DEXP; s.dst = (bf16_t*)(wb + WO_MGU) + (size_t)e * 2816 * 1024; s.row0 = k * 128; s.inter = 1; s.gain = F.in(I_GFFN) + D; }
    else { s.src = F.in(I_WED) + (size_t)e * DEXP * D; s.ld = D; s.K = DEXP; s.width = D; s.dst = (bf16_t*)(wb + WO_MD) + (size_t)e * 1024 * 1408; s.gain = nullptr; }
    return s;
}
#define CONV_LOCATE(NSEG, GETSEG, IT, SEGOUT, IDXOUT) do { int r_ = (IT); for (int si_ = 0; si_ < (NSEG); ++si_) { const ConvSeg sg_ = GETSEG; const int n_ = seg_items(sg_); SEGOUT = sg_; IDXOUT = r_; if (r_ < n_) break; r_ -= n_; } } while (0)
#define CONV_LOOP(NSEG, GETSEG) do { int total_ = 0; for (int si_ = 0; si_ < (NSEG); ++si_) { const ConvSeg sg_ = GETSEG; total_ += seg_items(sg_); } \
        int it_ = gw; if (it_ < total_) { ConvSeg cs_; int ci_ = 0; f32x4 va_[16]; float ga_[16]; CONV_LOCATE(NSEG, GETSEG, it_, cs_, ci_); conv_load(cs_, ci_, F.lane, va_, ga_); \
        for (;;) { const int nx_ = it_ + NGW; const bool hn_ = nx_ < total_; ConvSeg ns_; int ni_ = 0; f32x4 vb_[16]; float gb_[16]; CONV_LOCATE(NSEG, GETSEG, (hn_ ? nx_ : it_), ns_, ni_); conv_load(ns_, ni_, F.lane, vb_, gb_); \
            _Pragma("unroll") for (int q_ = 0; q_ < 16; ++q_) { asm volatile("" : "+v"(va_[q_])); asm volatile("" : "+v"(ga_[q_])); } \
            conv_store(cs_, ci_, (LAS unsigned char*)scr, F.lane, va_, ga_); if (!hn_) break; \
            _Pragma("unroll") for (int q_ = 0; q_ < 16; ++q_) { va_[q_] = vb_[q_]; ga_[q_] = gb_[q_]; } cs_ = ns_; ci_ = ni_; it_ = nx_; } } } while (0)
__device__ __forceinline__ void fold_pool(const Frame& F, int l, int gw, int NGW) {
    const float* wp = F.in(I_WPOOL) + (size_t)l * 4 * 128 * 128; const float* ps = F.in(I_PSCALE) + l * 512; const float* wb2 = F.in(I_WBR) + (size_t)(l * 3 + 2) * 512 * D;
    bf16_t* dst = (bf16_t*)(wblk(F, l) + WO_BR) + (size_t)2 * 1024 * 512;
    LAS float* sw = (LAS float*)(F.lds + F.wave * 16384);
    for (int it = gw; it < 1024; it += NGW) {
        const int db = it & 15, g = (it >> 4) & 3, cb = it >> 6, d = db * 64 + F.lane, c0 = cb * 8;
        {
            const float* wrow = wp + (size_t)(g * 128 + c0) * 128 + F.lane * 16;
            const f32x4 r0 = *(const f32x4*)wrow, r1 = *(const f32x4*)(wrow + 4), r2 = *(const f32x4*)(wrow + 8), r3 = *(const f32x4*)(wrow + 12);
            const float p0 = ps[g * 128 + 2 * F.lane], p1 = ps[g * 128 + 2 * F.lane + 1];
            LAS f32x4* o = (LAS f32x4*)(sw + F.lane * 16); o[0] = r0; o[1] = r1; o[2] = r2; o[3] = r3;
            sw[1024 + 2 * F.lane] = p0; sw[1024 + 2 * F.lane + 1] = p1;
        }
        LDS_WAIT();
        float a[8];
#pragma unroll
        for (int i = 0; i < 8; ++i) a[i] = 0.f;
#pragma unroll 1
        for (int j0 = 0; j0 < 128; j0 += 16) {
            float wv[16];
#pragma unroll
            for (int jj = 0; jj < 16; ++jj) wv[jj] = wb2[(size_t)(g * 128 + j0 + jj) * D + d];
#pragma unroll
            for (int jj = 0; jj < 16; ++jj) asm volatile("" : "+v"(wv[jj]));
#pragma unroll
            for (int j4 = 0; j4 < 16; j4 += 4) {
                const f32x4 sc = *(const LAS f32x4*)(sw + 1024 + j0 + j4);
                f32x4 w4;
#pragma unroll
                for (int e = 0; e < 4; ++e) w4[e] = wv[j4 + e] * sc[e];
#pragma unroll
                for (int i = 0; i < 8; ++i) {
                    const f32x4 pr = *(const LAS f32x4*)(sw + i * 128 + j0 + j4);
#pragma unroll
                    for (int e = 0; e < 4; ++e) a[i] = fmaf(pr[e], w4[e], a[i]);
                }
            }
        }
        u32x4 o; o.x = cvt_pk_bf16(a[0], a[1]); o.y = cvt_pk_bf16(a[2], a[3]); o.z = cvt_pk_bf16(a[4], a[5]); o.w = cvt_pk_bf16(a[6], a[7]);
        *(u32x4*)(dst + (size_t)d * 512 + g * 128 + c0) = o;
        LDS_WAIT();
    }
}

__device__ __forceinline__ void p0_prologue(Frame& F) {
    LAS float* scr = (LAS float*)(F.lds + F.wave * 16384);
    const int gw = F.vcu * 8 + F.wave, NGW = F.G * 8;
    { bf16_t* xb = (bf16_t*)(F.ws + WS_XB); float* rss = F.stats + SF_ROWSS;
      for (int m0 = gw; m0 < T; m0 += 4 * NGW) {
          f32x4 v[4][4];
#pragma unroll
          for (int r = 0; r < 4; ++r) { const int m = m0 + r * NGW < T ? m0 + r * NGW : m0; const f32x4* xr = (const f32x4*)(F.in(I_X) + (size_t)m * D) + F.lane;
#pragma unroll
              for (int j = 0; j < 4; ++j) v[r][j] = xr[64 * j]; }
#pragma unroll
          for (int r = 0; r < 4; ++r)
#pragma unroll
              for (int j = 0; j < 4; ++j) asm volatile("" : "+v"(v[r][j]));
#pragma unroll
          for (int r = 0; r < 4; ++r) { const int m = m0 + r * NGW; if (m >= T) break; float s = 0.f;
              unsigned long long* o8 = (unsigned long long*)(xb + (size_t)m * D) + F.lane;
#pragma unroll
              for (int j = 0; j < 4; ++j) { const f32x4 w = v[r][j]; s += (w[0] * w[0] + w[1] * w[1]) + (w[2] * w[2] + w[3] * w[3]);
                  o8[64 * j] = (unsigned long long)cvt_pk_bf16(w[0], w[1]) | ((unsigned long long)cvt_pk_bf16(w[2], w[3]) << 32); }
              s = wave_sum(s); if (F.lane < 16) rss[(size_t)m * 16 + F.lane] = (F.lane == 0) ? s : 0.f; }
      } }
    { float* rt = (float*)(F.ws + WS_ROPE); const int* pos = (const int*)F.in(I_POS);
      for (int i = F.vcu * 512 + F.tid; i < T * 16; i += F.G * 512) {
          const int t = i >> 4, k = i & 15; const float inv = powf(10000.f, -(float)k / 16.f), ang = (float)pos[t] * inv;
          rt[t * 32 + k] = cosf(ang); rt[t * 32 + 16 + k] = sinf(ang);
      } }
    CONV_LOOP(15, mixer_seg(F, 0, si_));
    fold_pool(F, 0, gw, NGW);
}

__device__ __forceinline__ void gla_prep(Frame& F, int l, int unit);
__device__ __forceinline__ void phase_prep(Frame& F, int l, int rpt = 0) {
    const bf16_t* raw = act_ptr(F, A_QKVRAW); const bf16_t* misc = act_ptr(F, A_MISC);
    bf16_t* QH = act_ptr(F, A_QH); bf16_t* KH = act_ptr(F, A_KH); bf16_t* VT = act_ptr(F, A_VT);
    const float* rope = (const float*)(F.ws + WS_ROPE);
    const float* gq = F.in(I_GQKQ) + l * 96; const float* gk = F.in(I_GQKK) + l * 96;
    LAS bf16_t* vt = (LAS bf16_t*)F.lds;
    LAS float* gls = (LAS float*)(F.lds + 81920);
    if (F.tid < 192) gls[F.tid] = F.tid < 96 ? gq[F.tid] : gk[F.tid - 96];
    __syncthreads();
    for (int unit = F.vcu; unit < T / 64; unit += F.G) {
        const int t0 = unit * 64, b = t0 / SEQ, s0 = t0 % SEQ;
        if (!rpt) gla_prep(F, l, unit);
#pragma unroll 1
        for (int it = F.tid; it < 1024; it += 512) {
            const int which = it & 1, h = (it >> 1) & 7, tok = it >> 4, t = t0 + tok;
            const bf16_t* nope = raw + (size_t)t * 1792 + (which ? 768 + h * 128 : h * 96);
            const bf16_t* rp = which ? misc + (size_t)t * 256 : nope + 64;
            const LAS float* g = gls + which * 96;
            u32x4 c[12];
#pragma unroll
            for (int i = 0; i < 8; ++i) c[i] = *(const u32x4*)(nope + 8 * i);
#pragma unroll
            for (int i = 0; i < 4; ++i) c[8 + i] = *(const u32x4*)(rp + 8 * i);
            float ss = 0.f;
#pragma unroll
            for (int i = 0; i < 12; ++i) {
                const float a0 = bflo(c[i].x), a1 = bfhi(c[i].x), a2 = bflo(c[i].y), a3 = bfhi(c[i].y), a4 = bflo(c[i].z), a5 = bfhi(c[i].z), a6 = bflo(c[i].w), a7 = bfhi(c[i].w);
                ss += (a0 * a0 + a1 * a1) + (a2 * a2 + a3 * a3) + (a4 * a4 + a5 * a5) + (a6 * a6 + a7 * a7);
            }
            float r = rsqrtf(ss * (1.f / 96.f) + EPS);
            if (!which) r *= 0.14724444f;
            bf16_t* dst = (which ? KH : QH) + ((size_t)(b * 8 + h) * SEQ + s0 + tok) * 96;
#pragma unroll
            for (int i = 0; i < 8; ++i) {
                if ((i & 1) == 0) __builtin_amdgcn_sched_barrier(0);
                const f32x4 g0 = *(const LAS f32x4*)(g + 8 * i), g1 = *(const LAS f32x4*)(g + 8 * i + 4);
                u32x4 o; o.x = cvt_pk_bf16(bflo(c[i].x) * r * g0[0], bfhi(c[i].x) * r * g0[1]); o.y = cvt_pk_bf16(bflo(c[i].y) * r * g0[2], bfhi(c[i].y) * r * g0[3]);
                o.z = cvt_pk_bf16(bflo(c[i].z) * r * g1[0], bfhi(c[i].z) * r * g1[1]); o.w = cvt_pk_bf16(bflo(c[i].w) * r * g1[2], bfhi(c[i].w) * r * g1[3]);
                *(u32x4*)(dst + 8 * i) = o;
            }
#pragma unroll
            for (int hh = 0; hh < 2; ++hh) {
                const u32x4 x1c = c[8 + hh], x2c = c[10 + hh];
                float x1[8] = {bflo(x1c.x), bfhi(x1c.x), bflo(x1c.y), bfhi(x1c.y), bflo(x1c.z), bfhi(x1c.z), bflo(x1c.w), bfhi(x1c.w)};
                float x2[8] = {bflo(x2c.x), bfhi(x2c.x), bflo(x2c.y), bfhi(x2c.y), bflo(x2c.z), bfhi(x2c.z), bflo(x2c.w), bfhi(x2c.w)};
                float o1[8], o2[8];
#pragma unroll
                for (int i = 0; i < 8; ++i) {
                    const int k = hh * 8 + i; const float cs = rope[(size_t)t * 32 + k], sn = rope[(size_t)t * 32 + 16 + k];
                    const float a = x1[i] * r * g[64 + k], bb = x2[i] * r * g[80 + k];
                    o1[i] = a * cs - bb * sn; o2[i] = bb * cs + a * sn;
                }
                u32x4 w1, w2; w1.x = cvt_pk_bf16(o1[0], o1[1]); w1.y = cvt_pk_bf16(o1[2], o1[3]); w1.z = cvt_pk_bf16(o1[4], o1[5]); w1.w = cvt_pk_bf16(o1[6], o1[7]);
                w2.x = cvt_pk_bf16(o2[0], o2[1]); w2.y = cvt_pk_bf16(o2[2], o2[3]); w2.z = cvt_pk_bf16(o2[4], o2[5]); w2.w = cvt_pk_bf16(o2[6], o2[7]);
                *(u32x4*)(dst + 64 + hh * 8) = w1; *(u32x4*)(dst + 80 + hh * 8) = w2;
            }
        }
        {
            const int tok = F.tid >> 3, cc = F.tid & 7;
            u32x4 vr[8];
#pragma unroll
            for (int h = 0; h < 8; ++h) vr[h] = *(const u32x4*)(raw + (size_t)(t0 + tok) * 1792 + 768 + h * 128 + 64 + cc * 8);
#pragma unroll
            for (int h = 0; h < 8; ++h) *(LAS u32x4*)(F.lds + h * 9216 + tok * 144 + cc * 16) = vr[h];
            __syncthreads();
            const int db = F.wave & 3, c = (F.wave >> 2) * 4 + (F.lane >> 4), i16 = F.lane & 15;
#pragma unroll
            for (int h = 0; h < 8; ++h) {
                const LAS unsigned char* a = F.lds + h * 9216 + (8 * c + (i16 >> 2)) * 144 + (16 * db + (i16 & 3) * 4) * 2;
                const v4i16c_t lo = __builtin_amdgcn_ds_read_tr16_b64_v4i16((LAS v4i16c_t*)a), hi = __builtin_amdgcn_ds_read_tr16_b64_v4i16((LAS v4i16c_t*)(a + 4 * 144));
                typedef short s16x8_t __attribute__((ext_vector_type(8)));
                bf16_t* vrow = VT + (((size_t)(b * 8 + h) * (SEQ / 64) + (s0 >> 6)) * 64 + 16 * db + i16) * 64;
                *(v4i16c_t*)(vrow + 4 * c) = lo; *(v4i16c_t*)(vrow + 32 + 4 * c) = hi;
            }
            __syncthreads();
        }
    }
}

constexpr int AT_KROW = 208, AT_KT = 64 * AT_KROW, AT_VROW = 144, AT_VTB = 64 * AT_VROW, AT_SLOT = AT_KT + AT_VTB, AT_NSLOT = 5, AT_DUMMY = AT_NSLOT * AT_SLOT;
static_assert(AT_KT == 13 * 1024 && AT_VTB == 9 * 1024 && AT_DUMMY + 8 * 1024 <= RING_BYTES, "attention ring");
#ifdef AT_TPROBE
#define TP_B(k) do { if (AT_TPROBE == (k)) tp0 = __builtin_readcyclecounter(); } while (0)
#define TP_E(k) do { if (AT_TPROBE == (k)) tpacc += __builtin_readcyclecounter() - tp0; } while (0)
#else
#define TP_B(k) do {} while (0)
#define TP_E(k) do {} while (0)
#endif
__device__ __forceinline__ void attn_unit(Frame& F, int bh, int qb, unsigned long long& tpacc) {
#ifdef AT_TPROBE
    unsigned long long tp0 = 0;
#endif
    TP_B(0);
    const int lane = F.lane, wid = F.wave, r32 = lane & 31, hi = lane >> 5, grp = wid >> 2;
    const bf16_t* QHp = act_ptr(F, A_QH) + ((size_t)bh * SEQ + qb * 256 + wid * 32) * 96;
    const char* Kb = (const char*)(act_ptr(F, A_KH) + (size_t)bh * SEQ * 96);
    const char* Vb = (const char*)(act_ptr(F, A_VT) + (size_t)bh * 64 * SEQ);
    LAS unsigned char* lds = F.lds;
    bf16x8 qr[6];
#pragma unroll
    for (int s = 0; s < 6; ++s) qr[s] = *(const bf16x8*)(QHp + (size_t)r32 * 96 + 16 * s + 8 * hi);
    const int NT = 4 * (qb + 1);
    const char *dp0, *dp1, *dp2;
    { const int P = 64 * wid + lane, row = P / 13, col = P % 13; dp0 = Kb + row * 192 + (col == 12 ? 0 : col) * 16; }
    if (wid < 5) { const int P = 64 * (wid + 8) + lane, row = P / 13, col = P % 13; dp1 = Kb + row * 192 + (col == 12 ? 0 : col) * 16; }
    else { const int P = 64 * (wid - 5) + lane, d = P / 9, col = P % 9; dp1 = Vb + d * 128 + (col == 8 ? 0 : col) * 16; }
    { const int P = 64 * (wid + 3) + lane, d = (P / 9) & 63, col = P % 9; dp2 = Vb + d * 128 + (col == 8 ? 0 : col) * 16; }
    const unsigned st1 = wid < 5 ? 12288u : 8192u;
    const bool w3 = wid < 6;
#define AT_DMA_ONE(j, sl) do { const int sl_ = (sl); LAS unsigned char* d_ = lds + sl_ + wid * 1024; const int c1_ = sl_ == AT_DUMMY ? 0 : 8192; \
        __builtin_amdgcn_global_load_lds((const unsigned*)(dp0 + (size_t)(j) * 12288), (LAS unsigned*)d_, 16, 0, 0); \
        __builtin_amdgcn_global_load_lds((const unsigned*)(dp1 + (size_t)(j) * st1), (LAS unsigned*)(d_ + c1_), 16, 0, 0); \
        if (w3) __builtin_amdgcn_global_load_lds((const unsigned*)(dp2 + (size_t)(j) * 8192), (LAS unsigned*)(d_ + 2 * c1_), 16, 0, 0); } while (0)
#ifdef AT_PROBE_DMA2
#define AT_DMA(j, sl) do { AT_DMA_ONE(j, sl); AT_DMA_ONE(j, sl); } while (0)
#define AT_WAIT2() do { if (w3) asm volatile("s_waitcnt vmcnt(12)" ::: "memory"); else asm volatile("s_waitcnt vmcnt(8)" ::: "memory"); } while (0)
#else
#define AT_DMA(j, sl) AT_DMA_ONE(j, sl)
#define AT_WAIT2() do { if (w3) asm volatile("s_waitcnt vmcnt(6)" ::: "memory"); else asm volatile("s_waitcnt vmcnt(4)" ::: "memory"); } while (0)
#endif
#define AT_WAIT1() do { if (w3) asm volatile("s_waitcnt vmcnt(3)" ::: "memory"); else asm volatile("s_waitcnt vmcnt(2)" ::: "memory"); } while (0)
#define AT_WAIT_NEXT(t) do { if ((t) + 3 < NT) AT_WAIT2(); else if ((t) + 3 == NT) AT_WAIT1(); else VM_WAIT(); } while (0)
    AT_DMA(0, 0); AT_DMA(1, AT_SLOT); AT_DMA(2, 2 * AT_SLOT); AT_DMA(3, 3 * AT_SLOT);
#ifdef AT_PROBE_DMA2
    if (w3) asm volatile("s_waitcnt vmcnt(18)" ::: "memory"); else asm volatile("s_waitcnt vmcnt(12)" ::: "memory");
#else
    if (w3) asm volatile("s_waitcnt vmcnt(9)" ::: "memory"); else asm volatile("s_waitcnt vmcnt(6)" ::: "memory");
#endif
    LDS_BARRIER();
    float m_run = 0.f, l_run = 0.f;
    f32x16 o0, o1, negm;
#pragma unroll
    for (int r = 0; r < 16; ++r) { o0[r] = 0.f; o1[r] = 0.f; negm[r] = 0.f; }
    const unsigned kfr = (unsigned)(r32 * AT_KROW + hi * 16), vfr = (unsigned)(AT_KT + r32 * AT_VROW + hi * 64);
    if (grp) LDS_BARRIER();
    int slot = 0, wslot = 4;
    const int NTw = 4 * qb + (wid >> 1) + 1;
    TP_B(1);
    for (int t = 0; t < NTw; ++t) {
        const int jb = t - 4 * qb;
        const LAS unsigned char* sb = lds + slot * AT_SLOT;
        f32x16 p0, p1;
        TP_B(2);
        {
            const LAS unsigned char* kb = sb + kfr;
            bf16x8 ka[6], kc[6];
#pragma unroll
            for (int s = 0; s < 6; ++s) { ka[s] = *(const LAS bf16x8*)(kb + s * 32); kc[s] = *(const LAS bf16x8*)(kb + 32 * AT_KROW + s * 32); }
            __builtin_amdgcn_sched_barrier(0);
            __builtin_amdgcn_s_setprio(1);
            p0 = __builtin_amdgcn_mfma_f32_32x32x16_bf16(ka[0], qr[0], negm, 0, 0, 0);
            p1 = __builtin_amdgcn_mfma_f32_32x32x16_bf16(kc[0], qr[0], negm, 0, 0, 0);
#pragma unroll
            for (int s = 1; s < 6; ++s) {
                p0 = __builtin_amdgcn_mfma_f32_32x32x16_bf16(ka[s], qr[s], p0, 0, 0, 0);
                p1 = __builtin_amdgcn_mfma_f32_32x32x16_bf16(kc[s], qr[s], p1, 0, 0, 0);
            }
            __builtin_amdgcn_s_setprio(0);
#ifdef AT_PROBE_SEG1X2
            asm volatile("" : "+v"(p0), "+v"(p1));
            p0 = __builtin_amdgcn_mfma_f32_32x32x16_bf16(ka[0], qr[0], negm, 0, 0, 0);
            p1 = __builtin_amdgcn_mfma_f32_32x32x16_bf16(kc[0], qr[0], negm, 0, 0, 0);
#pragma unroll
            for (int s = 1; s < 6; ++s) {
                p0 = __builtin_amdgcn_mfma_f32_32x32x16_bf16(ka[s], qr[s], p0, 0, 0, 0);
                p1 = __builtin_amdgcn_mfma_f32_32x32x16_bf16(kc[s], qr[s], p1, 0, 0, 0);
            }
#endif
            asm volatile("" : "+v"(p0), "+v"(p1));
        }
        TP_E(2);
        TP_B(3);
        AT_WAIT2();
        TP_E(3);
        TP_B(4);
        LDS_BARRIER();
        TP_E(4);
        AT_DMA(min(t + 4, NT - 1), t + 4 < NT ? wslot * AT_SLOT : AT_DUMMY);
        TP_B(5);
        {
            const LAS unsigned char* vb = sb + vfr;
            bf16x8 va[4], vc2[4];
#pragma unroll
            for (int s = 0; s < 4; ++s) { va[s] = *(const LAS bf16x8*)(vb + s * 16); vc2[s] = *(const LAS bf16x8*)(vb + 32 * AT_VROW + s * 16); }
            if (jb >= 0 && wid < 2 * jb + 2) {
                const int qrel = 32 * wid + r32, kb0 = 64 * jb + 4 * hi;
#pragma unroll
                for (int r = 0; r < 16; ++r) { const int kv = kb0 + (r & 3) + 8 * (r >> 2); if (kv > qrel) p0[r] = -INFINITY; if (kv + 32 > qrel) p1[r] = -INFINITY; }
            }
            float mxa = __builtin_elementwise_maximum(p0[0], p0[1]), mxb = __builtin_elementwise_maximum(p1[0], p1[1]);
#pragma unroll
            for (int r = 2; r < 16; r += 2) {
                mxa = __builtin_elementwise_maximum(__builtin_elementwise_maximum(mxa, p0[r]), p0[r + 1]);
                mxb = __builtin_elementwise_maximum(__builtin_elementwise_maximum(mxb, p1[r]), p1[r + 1]);
            }
            float mx = __builtin_elementwise_maximum(mxa, mxb);
            {
                const u32x2 sw = __builtin_amdgcn_permlane32_swap(__float_as_uint(mx), __float_as_uint(mx), false, false);
                mx = __builtin_elementwise_maximum(__uint_as_float(sw.x), __uint_as_float(sw.y));
            }
            if (t == 0 || !__all(mx <= 8.f)) {
                const float delta = t == 0 ? mx : fmaxf(mx, 0.f), alpha = t == 0 ? 1.f : __builtin_amdgcn_exp2f(-delta);
                m_run += delta; l_run *= alpha;
#pragma unroll
                for (int r = 0; r < 16; ++r) { o0[r] *= alpha; o1[r] *= alpha; p0[r] -= delta; p1[r] -= delta; negm[r] = -m_run; }
            }
            float ps = 0.f;
#pragma unroll
            for (int r = 0; r < 16; ++r) { p0[r] = __builtin_amdgcn_exp2f(p0[r]); p1[r] = __builtin_amdgcn_exp2f(p1[r]); ps += p0[r]; ps += p1[r]; }
            l_run += ps;
#pragma unroll
            for (int s = 0; s < 4; ++s) {
                u32x4 pw;
                if (s < 2) { pw.x = cvt_pk_bf16(p0[8 * s + 0], p0[8 * s + 1]); pw.y = cvt_pk_bf16(p0[8 * s + 2], p0[8 * s + 3]); pw.z = cvt_pk_bf16(p0[8 * s + 4], p0[8 * s + 5]); pw.w = cvt_pk_bf16(p0[8 * s + 6], p0[8 * s + 7]); }
                else { const int q = s - 2; pw.x = cvt_pk_bf16(p1[8 * q + 0], p1[8 * q + 1]); pw.y = cvt_pk_bf16(p1[8 * q + 2], p1[8 * q + 3]); pw.z = cvt_pk_bf16(p1[8 * q + 4], p1[8 * q + 5]); pw.w = cvt_pk_bf16(p1[8 * q + 6], p1[8 * q + 7]); }
                const bf16x8 pb = __builtin_bit_cast(bf16x8, pw);
                o0 = __builtin_amdgcn_mfma_f32_32x32x16_bf16(va[s], pb, o0, 0, 0, 0);
                o1 = __builtin_amdgcn_mfma_f32_32x32x16_bf16(vc2[s], pb, o1, 0, 0, 0);
            }
        }
        TP_E(5);
        TP_B(6);
        LDS_BARRIER();
        TP_E(6);
        slot = slot == AT_NSLOT - 1 ? 0 : slot + 1; wslot = wslot == AT_NSLOT - 1 ? 0 : wslot + 1;
    }
    TP_E(1);
    for (int t = NTw; t < NT; ++t) {
        AT_WAIT2();
        LDS_BARRIER();
        AT_DMA(min(t + 4, NT - 1), t + 4 < NT ? wslot * AT_SLOT : AT_DUMMY);
        LDS_BARRIER();
        wslot = wslot == AT_NSLOT - 1 ? 0 : wslot + 1;
    }
    if (!grp) LDS_BARRIER();
    VM_WAIT();
#undef AT_DMA
#undef AT_DMA_ONE
#undef AT_WAIT2
#undef AT_WAIT1
#undef AT_WAIT_NEXT
    l_run += __shfl_xor(l_run, 32);
    const float inv = 1.f / l_run;
    const int b = bh >> 3, h = bh & 7;
    bf16_t* orow = act_ptr(F, A_YSA) + ((size_t)b * SEQ + qb * 256 + wid * 32 + r32) * 512 + h * 64;
#pragma unroll
    for (int g = 0; g < 4; ++g) {
        u32x2 w0, w1;
        w0.x = cvt_pk_bf16(o0[4 * g] * inv, o0[4 * g + 1] * inv); w0.y = cvt_pk_bf16(o0[4 * g + 2] * inv, o0[4 * g + 3] * inv);
        w1.x = cvt_pk_bf16(o1[4 * g] * inv, o1[4 * g + 1] * inv); w1.y = cvt_pk_bf16(o1[4 * g + 2] * inv, o1[4 * g + 3] * inv);
#ifdef AT_WT_STORE
        asm volatile("global_store_dwordx2 %0, %1, off sc0 sc1" :: "v"(orow + 8 * g + 4 * hi), "v"(w0) : "memory");
        asm volatile("global_store_dwordx2 %0, %1, off sc0 sc1" :: "v"(orow + 32 + 8 * g + 4 * hi), "v"(w1) : "memory");
#else
        *(u32x2*)(orow + 8 * g + 4 * hi) = w0; *(u32x2*)(orow + 32 + 8 * g + 4 * hi) = w1;
#endif
    }
    TP_E(0);
}

__device__ __forceinline__ float row16_sum(float x) {
    x += __int_as_float(__builtin_amdgcn_update_dpp(0, __float_as_int(x), 0x128, 0xf, 0xf, false));
    x += __int_as_float(__builtin_amdgcn_update_dpp(0, __float_as_int(x), 0x124, 0xf, 0xf, false));
    x += __int_as_float(__builtin_amdgcn_update_dpp(0, __float_as_int(x), 0x122, 0xf, 0xf, false));
    x += __int_as_float(__builtin_amdgcn_update_dpp(0, __float_as_int(x), 0x121, 0xf, 0xf, false));
    return x;
}
__device__ __forceinline__ unsigned short f2bf1(float x) { return (unsigned short)(cvt_pk_bf16(x, 0.f) & 0xffffu); }
__device__ __forceinline__ void gla_prep(Frame& F, int l, int unit) {
    bf16_t* gqkv = act_ptr(F, A_GQKV); const bf16_t* misc = act_ptr(F, A_MISC); float* eb = F.stats + SF_EB;
    const int c = F.tid & 255, ch = unit * 2 + (F.tid >> 8);
    const float* wg = F.in(I_WGLA) + (size_t)l * 16 * 256 + c; const float bias = F.in(I_BGLA)[l * 256 + c];
    float wcol[16];
#pragma unroll
    for (int r = 0; r < 16; ++r) wcol[r] = wg[r * 256];
    float bc = 0.f;
#pragma unroll 1
    for (int i0 = 0; i0 < 32; i0 += 8) {
        u32x4 l0[8], l1[8]; unsigned qv[8], kv[8];
#pragma unroll
        for (int i = 0; i < 8; ++i) {
            const size_t t = (size_t)ch * 32 + i0 + i;
            l0[i] = *(const u32x4*)(misc + t * 256 + 32); l1[i] = *(const u32x4*)(misc + t * 256 + 40);
            qv[i] = *(const unsigned short*)(gqkv + t * 1024 + c); kv[i] = *(const unsigned short*)(gqkv + t * 1024 + c + 256);
        }
#pragma unroll
        for (int i = 0; i < 8; ++i) asm volatile("" : "+v"(qv[i]), "+v"(kv[i]));
        unsigned short qo[8], ko[8];
#pragma unroll
        for (int i = 0; i < 8; ++i) {
            const float lr[16] = {bflo(l0[i].x), bfhi(l0[i].x), bflo(l0[i].y), bfhi(l0[i].y), bflo(l0[i].z), bfhi(l0[i].z), bflo(l0[i].w), bfhi(l0[i].w),
                                  bflo(l1[i].x), bfhi(l1[i].x), bflo(l1[i].y), bfhi(l1[i].y), bflo(l1[i].z), bfhi(l1[i].z), bflo(l1[i].w), bfhi(l1[i].w)};
            float z = bias;
#pragma unroll
            for (int r = 0; r < 16; ++r) z = fmaf(lr[r], wcol[r], z);
            const float zl = z * 1.4426950408889634f;
            const float sp = fmaxf(-zl, 0.f) + __log2f(1.f + __builtin_amdgcn_exp2f(-fabsf(zl)));
            bc -= sp * 0.0625f;
            const float eq = __builtin_amdgcn_exp2f(bc) * 0.125f, ek = __builtin_amdgcn_exp2f(-bc);
            qo[i] = f2bf1(__uint_as_float(qv[i] << 16) * eq);
            ko[i] = f2bf1(__uint_as_float(kv[i] << 16) * ek);
        }
#pragma unroll
        for (int i = 0; i < 8; ++i) {
            const size_t t = (size_t)ch * 32 + i0 + i;
            *(unsigned short*)(gqkv + t * 1024 + c) = qo[i]; *(unsigned short*)(gqkv + t * 1024 + c + 256) = ko[i];
        }
    }
    eb[(size_t)ch * 256 + c] = __builtin_amdgcn_exp2f(bc);
}
typedef short v4i16_t __attribute__((ext_vector_type(4)));
__device__ __forceinline__ v4i16_t lds_tr16(const LAS unsigned char* p) { return __builtin_amdgcn_ds_read_tr16_b64_v4i16((LAS v4i16_t*)p); }
constexpr int GW_K = 0, GW_Q = 4608, GW_V = 9216, GW_BYTES = 10240;
__device__ __forceinline__ void gla_unit(Frame& F, int l, int unit) {
    const int half = unit & 1, h = (unit >> 1) & 3, b = unit >> 3;
    volatile LAS int* prog = (volatile LAS int*)(F.lds + 4 * GW_BYTES);
    if (F.wave >= 4) {
        const int pw = F.wave - 4, tok = F.lane & 31, li = (F.lane >> 5) + 2 * (pw & 1);
        const size_t lo_ = (li == 0) ? (size_t)h * 128 : (li == 1) ? (size_t)512 + h * 128 : (li == 2) ? (size_t)1024 + h * 256 + half * 128 : (size_t)1024 + h * 256 + half * 128 + 64;
        const unsigned char* base_ = (const unsigned char*)act_ptr(F, A_GQKV) + lo_;
        unsigned keep = 0u;
        for (int m = (pw >> 1); m < SEQ / 32; m += 2) {
            while (m > prog[0] + 8) __builtin_amdgcn_s_sleep(8);
            const unsigned char* pp = base_ + ((size_t)b * SEQ + (size_t)m * 32 + tok) * 2048;
            asm volatile("global_load_dword %0, %1, off" : "+v"(keep) : "v"(pp) : "memory");
        }
        asm volatile("s_waitcnt vmcnt(0)" : "+v"(keep) :: "memory");
        return;
    }
    const int lane = F.lane, w = half * 4 + F.wave, l15 = lane & 15, q4 = lane >> 4;
    const bf16_t* gqkv = act_ptr(F, A_GQKV); const float* ebg = F.stats + SF_EB;
    bf16_t* ysb = act_ptr(F, A_YSB);
    LAS unsigned char* wl = F.lds + F.wave * GW_BYTES;
    f32x4 S[4];
#pragma unroll
    for (int i = 0; i < 4; ++i) S[i] = (f32x4){0.f, 0.f, 0.f, 0.f};
    if (F.tid == 0) prog[0] = 0;
    constexpr int GW2 = 4 * GW_BYTES;
    u32x4 kimgX[4], qimgX[4], vimgX, kimgY[4], qimgY[4], vimgY; f32x4 ebvX[4], ebvY[4];
#define GLA_LOAD1(n_, KI, QI, VI, EBV) do { const size_t tb_ = (size_t)b * SEQ + (size_t)(n_) * 32; \
        _Pragma("unroll") for (int i = 0; i < 4; ++i) { const int p_ = lane + 64 * i; const bf16_t* r_ = gqkv + (tb_ + (p_ >> 3)) * 1024 + h * 64 + (p_ & 7) * 8; QI[i] = *(const u32x4*)r_; KI[i] = *(const u32x4*)(r_ + 256); } \
        VI = *(const u32x4*)(gqkv + (tb_ + (lane >> 1)) * 1024 + 512 + h * 128 + 16 * w + (lane & 1) * 8); \
        _Pragma("unroll") for (int db = 0; db < 4; ++db) EBV[db] = *(const f32x4*)(ebg + (tb_ >> 5) * 256 + h * 64 + 16 * db + 4 * q4); } while (0)
#define GLA_LOAD(n_) do { GLA_LOAD1((n_), kimgX, qimgX, vimgX, ebvX); GLA_LOAD1((n_) + 1, kimgY, qimgY, vimgY, ebvY); } while (0)
    bf16x8 pa0X, pa1X, vbnX, kanX[4], qpxX[2], qpyX[2], pa0Y, pa1Y, vbnY, kanY[4], qpxY[2], qpyY[2]; f32x4 o0pX, o1pX, e4X[4], o0pY, o1pY, e4Y[4];
#define GLA_IMG(WL, KI, QI, VI, EBV, E4) do { \
        _Pragma("unroll") for (int i = 0; i < 4; ++i) { asm volatile("" : "+v"(KI[i]), "+v"(QI[i]), "+v"(EBV[i])); } \
        asm volatile("" : "+v"(VI)); \
        _Pragma("unroll") for (int i = 0; i < 4; ++i) { const int p_ = lane + 64 * i; *(LAS u32x4*)((WL) + GW_K + (p_ >> 3) * 144 + (p_ & 7) * 16) = KI[i]; *(LAS u32x4*)((WL) + GW_Q + (p_ >> 3) * 144 + (p_ & 7) * 16) = QI[i]; } \
        *(LAS u32x4*)((WL) + GW_V + (lane >> 1) * 32 + (lane & 1) * 16) = VI; \
        _Pragma("unroll") for (int db = 0; db < 4; ++db) E4[db] = EBV[db]; } while (0)
#define GLA_STAGE_P(WL, PA0, PA1, VBN, KAN, QPX, QPY, O0P, O1P) do { \
        f32x4 pt00 = {0.f, 0.f, 0.f, 0.f}, pt01 = pt00, pt11 = pt00; \
        _Pragma("unroll") for (int ks = 0; ks < 2; ++ks) { \
            const bf16x8 a0 = *(const LAS bf16x8*)((WL) + GW_K + l15 * 144 + ks * 64 + q4 * 16), a1 = *(const LAS bf16x8*)((WL) + GW_K + (16 + l15) * 144 + ks * 64 + q4 * 16); \
            const bf16x8 b0 = *(const LAS bf16x8*)((WL) + GW_Q + l15 * 144 + ks * 64 + q4 * 16), b1 = *(const LAS bf16x8*)((WL) + GW_Q + (16 + l15) * 144 + ks * 64 + q4 * 16); \
            pt00 = __builtin_amdgcn_mfma_f32_16x16x32_bf16(a0, b0, pt00, 0, 0, 0); \
            pt01 = __builtin_amdgcn_mfma_f32_16x16x32_bf16(a0, b1, pt01, 0, 0, 0); \
            pt11 = __builtin_amdgcn_mfma_f32_16x16x32_bf16(a1, b1, pt11, 0, 0, 0); \
            const LAS unsigned char* q0p = (WL) + GW_Q + l15 * 144 + ks * 64 + q4 * 8; const LAS unsigned char* q1p = q0p + 16 * 144; \
            const u32x2 x0 = *(const LAS u32x2*)(q0p), x1 = *(const LAS u32x2*)(q0p + 32), y0 = *(const LAS u32x2*)(q1p), y1 = *(const LAS u32x2*)(q1p + 32); \
            QPX[ks] = __builtin_bit_cast(bf16x8, (u32x4){x0.x, x0.y, x1.x, x1.y}); QPY[ks] = __builtin_bit_cast(bf16x8, (u32x4){y0.x, y0.y, y1.x, y1.y}); } \
        _Pragma("unroll") for (int r = 0; r < 4; ++r) { if (4 * q4 + r > l15) { pt00[r] = 0.f; pt11[r] = 0.f; } } \
        PA0 = __builtin_bit_cast(bf16x8, (u32x4){cvt_pk_bf16(pt00[0], pt00[1]), cvt_pk_bf16(pt00[2], pt00[3]), 0u, 0u}); \
        PA1 = __builtin_bit_cast(bf16x8, (u32x4){cvt_pk_bf16(pt01[0], pt01[1]), cvt_pk_bf16(pt01[2], pt01[3]), cvt_pk_bf16(pt11[0], pt11[1]), cvt_pk_bf16(pt11[2], pt11[3])}); \
        const LAS unsigned char* vt_ = (WL) + GW_V + (l15 >> 2) * 32 + (l15 & 3) * 8; \
        const v4i16_t vp0 = lds_tr16(vt_ + (4 * q4) * 32), vp1 = lds_tr16(vt_ + (16 + 4 * q4) * 32); \
        const v4i16_t vn0 = lds_tr16(vt_ + (8 * q4) * 32), vn1 = lds_tr16(vt_ + (8 * q4 + 4) * 32); \
        const bf16x8 vbp = (bf16x8){vp0[0], vp0[1], vp0[2], vp0[3], vp1[0], vp1[1], vp1[2], vp1[3]}; \
        VBN = (bf16x8){vn0[0], vn0[1], vn0[2], vn0[3], vn1[0], vn1[1], vn1[2], vn1[3]}; \
        _Pragma("unroll") for (int db = 0; db < 4; ++db) { \
            const LAS unsigned char* kt = (WL) + GW_K + (8 * q4 + (l15 >> 2)) * 144 + (16 * db + (l15 & 3) * 4) * 2; \
            const v4i16_t k0 = lds_tr16(kt), k1 = lds_tr16(kt + 4 * 144); \
            KAN[db] = (bf16x8){k0[0], k0[1], k0[2], k0[3], k1[0], k1[1], k1[2], k1[3]}; } \
        O0P = __builtin_amdgcn_mfma_f32_16x16x32_bf16(PA0, vbp, (f32x4){0.f, 0.f, 0.f, 0.f}, 0, 0, 0); \
        O1P = __builtin_amdgcn_mfma_f32_16x16x32_bf16(PA1, vbp, (f32x4){0.f, 0.f, 0.f, 0.f}, 0, 0, 0); \
    } while (0)
#define GLA_STAGE_S(T0, VBN, KAN, QPX, QPY, O0P, O1P, E4) do { \
        f32x4 o0 = O0P, o1 = O1P; \
        _Pragma("unroll") for (int ks = 0; ks < 2; ++ks) { \
            const bf16x8 sb = __builtin_bit_cast(bf16x8, (u32x4){cvt_pk_bf16(S[2 * ks][0], S[2 * ks][1]), cvt_pk_bf16(S[2 * ks][2], S[2 * ks][3]), cvt_pk_bf16(S[2 * ks + 1][0], S[2 * ks + 1][1]), cvt_pk_bf16(S[2 * ks + 1][2], S[2 * ks + 1][3])}); \
            o0 = __builtin_amdgcn_mfma_f32_16x16x32_bf16(QPX[ks], sb, o0, 0, 0, 0); \
            o1 = __builtin_amdgcn_mfma_f32_16x16x32_bf16(QPY[ks], sb, o1, 0, 0, 0); } \
        _Pragma("unroll") for (int db = 0; db < 4; ++db) { S[db] = __builtin_amdgcn_mfma_f32_16x16x32_bf16(KAN[db], VBN, S[db], 0, 0, 0); S[db] = S[db] * E4[db]; } \
        _Pragma("unroll") for (int r = 0; r < 4; ++r) { const size_t ta = (T0) + 4 * q4 + r, tb2 = ta + 16; \
            ysb[ta * 512 + h * 128 + 16 * w + l15] = f2bf1(o0[r]); ysb[tb2 * 512 + h * 128 + 16 * w + l15] = f2bf1(o1[r]); } \
    } while (0)
    LAS unsigned char* wl2 = F.lds + GW2 + 64 + F.wave * GW_BYTES;
    GLA_LOAD(0);
    for (int n = 0; n < SEQ / 32; n += 2) {
        const size_t t0 = (size_t)b * SEQ + (size_t)n * 32;
        if (F.tid == 0) prog[0] = n;
        GLA_IMG(wl, kimgX, qimgX, vimgX, ebvX, e4X);
        GLA_IMG(wl2, kimgY, qimgY, vimgY, ebvY, e4Y);
        { const int nn = (n + 2 < SEQ / 32) ? n + 2 : n; GLA_LOAD(nn); }
        GLA_STAGE_P(wl, pa0X, pa1X, vbnX, kanX, qpxX, qpyX, o0pX, o1pX);
        GLA_STAGE_P(wl2, pa0Y, pa1Y, vbnY, kanY, qpxY, qpyY, o0pY, o1pY);
        GLA_STAGE_S(t0, vbnX, kanX, qpxX, qpyX, o0pX, o1pX, e4X);
        GLA_STAGE_S(t0 + 32, vbnY, kanY, qpxY, qpyY, o0pY, o1pY, e4Y);
        asm volatile("s_waitcnt lgkmcnt(0)" ::: "memory");
    }
#undef GLA_LOAD1
#undef GLA_IMG
#undef GLA_STAGE_P
#undef GLA_STAGE_S
#undef GLA_LOAD
}
__device__ __forceinline__ void gla_finalize(Frame& F, int l) {
    bf16_t* ysb = act_ptr(F, A_YSB); const bf16_t* og = act_ptr(F, A_OG);
    const float* go = F.in(I_GGLAO) + l * 128;
    const int istep = F.G * 512, c8 = F.tid & 63, v0 = (c8 & 15) * 8;
    const f32x4 g0 = *(const f32x4*)(go + v0), g1 = *(const f32x4*)(go + v0 + 4);
    for (int i0 = F.vcu * 512 + F.tid; i0 < T * 64; i0 += 4 * istep) {
        u32x4 ov4[4], gt4[4];
#pragma unroll
        for (int k = 0; k < 4; ++k) {
            const int i = i0 + k * istep < T * 64 ? i0 + k * istep : i0; const int t = i >> 6;
            ov4[k] = *(const u32x4*)(ysb + (size_t)t * 512 + c8 * 8); gt4[k] = *(const u32x4*)(og + (size_t)t * 512 + c8 * 8);
        }
#pragma unroll
        for (int k = 0; k < 4; ++k) asm volatile("" : "+v"(ov4[k]), "+v"(gt4[k]));
#pragma unroll
        for (int k = 0; k < 4; ++k) {
            const int i = i0 + k * istep; const int t = i >> 6;
            const u32x4 o = ov4[k], gte = gt4[k];
            const float ov[8] = {bflo(o.x), bfhi(o.x), bflo(o.y), bfhi(o.y), bflo(o.z), bfhi(o.z), bflo(o.w), bfhi(o.w)};
            const float ssq = row16_sum(((ov[0] * ov[0] + ov[1] * ov[1]) + (ov[2] * ov[2] + ov[3] * ov[3])) + ((ov[4] * ov[4] + ov[5] * ov[5]) + (ov[6] * ov[6] + ov[7] * ov[7])));
            const float r = rsqrtf(ssq * (1.f / 128.f) + EPS);
            const float gv[8] = {bflo(gte.x), bfhi(gte.x), bflo(gte.y), bfhi(gte.y), bflo(gte.z), bfhi(gte.z), bflo(gte.w), bfhi(gte.w)};
            float y[8];
#pragma unroll
            for (int e = 0; e < 8; ++e) y[e] = ov[e] * r * (e < 4 ? g0[e] : g1[e - 4]) * gv[e] * fast_sigmoid(gv[e]);
            u32x4 wv; wv.x = cvt_pk_bf16(y[0], y[1]); wv.y = cvt_pk_bf16(y[2], y[3]); wv.z = cvt_pk_bf16(y[4], y[5]); wv.w = cvt_pk_bf16(y[6], y[7]);
            if (i < T * 64) *(u32x4*)(ysb + (size_t)t * 512 + c8 * 8) = wv;
        }
    }
}

template <int W> __device__ __forceinline__ void pool_rows(const bf16_t* up, bf16_t* pooled, int t0, int s0, int c8) {
    u32x4 row[8 + W - 1];
#pragma unroll
    for (int i = 0; i < 8 + W - 1; ++i) {
        const int dt = i - (W - 1);
        const bool ok = (s0 + dt) >= 0;
        const u32x4 v = *(const u32x4*)(up + (size_t)(t0 + (ok ? dt : 0)) * 512 + c8 * 8);
        row[i] = ok ? v : (u32x4){0u, 0u, 0u, 0u};
    }
#pragma unroll
    for (int k = 0; k < 8; ++k) {
        float acc[8];
#pragma unroll
        for (int e = 0; e < 8; ++e) acc[e] = 0.f;
#pragma unroll
        for (int j = 0; j < W; ++j) { const u32x4 v = row[k + W - 1 - j];
            acc[0] += bflo(v.x); acc[1] += bfhi(v.x); acc[2] += bflo(v.y); acc[3] += bfhi(v.y); acc[4] += bflo(v.z); acc[5] += bfhi(v.z); acc[6] += bflo(v.w); acc[7] += bfhi(v.w); }
        const int sk = s0 + k, n = (sk + 1 < W) ? sk + 1 : W;
        const float rn = 1.f / (float)n; const u32x4 self = row[k + W - 1];
        u32x4 o; o.x = cvt_pk_bf16(acc[0] * rn - bflo(self.x), acc[1] * rn - bfhi(self.x)); o.y = cvt_pk_bf16(acc[2] * rn - bflo(self.y), acc[3] * rn - bfhi(self.y));
        o.z = cvt_pk_bf16(acc[4] * rn - bflo(self.z), acc[5] * rn - bfhi(self.z)); o.w = cvt_pk_bf16(acc[6] * rn - bflo(self.w), acc[7] * rn - bfhi(self.w));
        *(u32x4*)(pooled + (size_t)(t0 + k) * 512 + c8 * 8) = o;
    }
}
__device__ __forceinline__ void pool_unit(Frame& F, int unit) {
    const bf16_t* up = act_ptr(F, A_UP); bf16_t* pooled = act_ptr(F, A_POOLED);
    const int g = F.wave & 3, c8 = g * 16 + (F.lane & 15), tb = (F.lane >> 4) + 4 * (F.wave >> 2);
    const int t0 = unit * 64 + tb * 8, s0 = t0 % SEQ;
    if (g == 0) pool_rows<2>(up, pooled, t0, s0, c8);
    else if (g == 1) pool_rows<4>(up, pooled, t0, s0, c8);
    else if (g == 2) pool_rows<8>(up, pooled, t0, s0, c8);
    else pool_rows<16>(up, pooled, t0, s0, c8);
}

__device__ __forceinline__ void phase_mix(Frame& F, int lq, int bx) {
    const int l = lq & 1;
#ifndef REP_DMASK
#define REP_DMASK 7
#endif
    const int dm = (lq >= 2) ? (REP_DMASK) : 7;
    if (bx < 32 && (dm & 1)) gla_unit(F, l, bx);
    unsigned* head = F.ctl + CW_QUEUE + 64 * lq;
    unsigned long long tpsum = 0;
#ifdef AT_TPROBE
    const unsigned long long tq0 = __builtin_readcyclecounter();
#endif
    for (;;) {
        if (F.tid == 0) F.MISC[16] = __hip_atomic_fetch_add(head, 1u, RLX_AGENT);
        __syncthreads();
        const int idx = (int)F.MISC[16];
        __syncthreads();
        if (idx >= 512 + 256) break;
        if (idx < 512) { if (dm & 2) attn_unit(F, idx & 31, 15 - (idx >> 5), tpsum); }
        else { if (dm & 4) pool_unit(F, idx - 512); }
    }
#ifdef AT_TPROBE
    if (AT_TPROBE == 7) tpsum = __builtin_readcyclecounter() - tq0;
    if (lq >= 2 && (AT_TPWG < 0 || bx == AT_TPWG) && F.wave == AT_TPWAVE) { const unsigned long long ts = __builtin_readcyclecounter(); while (__builtin_readcyclecounter() - ts < 4ull * tpsum) __builtin_amdgcn_s_sleep(8); }
#endif
    if (bx >= 32 && lq < 2) {
        LAS float* scr = (LAS float*)(F.lds + F.wave * 16384);
        const int gw = (bx - 32) * 8 + F.wave, NGW = (F.G - 32) * 8;
        if (l == 0) { CONV_LOOP(15, mixer_seg(F, 1, si_)); fold_pool(F, 1, gw, NGW); CONV_LOOP(3, ffn_seg(F, si_)); }
        else { CONV_LOOP(12, moe_seg(F, (si_ >> 1) * 3 + (si_ & 1))); }
    }
}

__device__ __forceinline__ void phase_route1(Frame& F) {
    const bf16_t* x = (const bf16_t*)(F.ws + WS_XB); const float* rss = F.stats + SF_ROWSS + (size_t)3 * T * 16; const float* gf = F.in(I_GFFN) + D; const float* wr = F.in(I_WROUTER);
    unsigned* route = (unsigned*)(F.ws + WS_SLOT + SL_ROUTE); unsigned* wgcnt = F.ctl + CW_WGCNT;
    LAS float* lsel = (LAS float*)(F.lds);
    LAS int* lpos = (LAS int*)(F.lds + 2048);
    float wgt[2][8][8];
    {
        f32x4 wl[2][8][2], gl[2][2];
#pragma unroll
        for (int j = 0; j < 2; ++j) {
            const int c = 8 * F.lane + 512 * j;
            gl[j][0] = *(const f32x4*)(gf + c); gl[j][1] = *(const f32x4*)(gf + c + 4);
#pragma unroll
            for (int q = 0; q < 8; ++q) { wl[j][q][0] = *(const f32x4*)(wr + (size_t)(c + q) * 8); wl[j][q][1] = *(const f32x4*)(wr + (size_t)(c + q) * 8 + 4); }
        }
#pragma unroll
        for (int j = 0; j < 2; ++j)
#pragma unroll
            for (int q = 0; q < 8; ++q) { asm volatile("" : "+v"(wl[j][q][0]), "+v"(wl[j][q][1])); }
#pragma unroll
        for (int j = 0; j < 2; ++j)
#pragma unroll
            for (int q = 0; q < 8; ++q) {
                const float g = q < 4 ? gl[j][0][q] : gl[j][1][q - 4];
#pragma unroll
                for (int e = 0; e < 4; ++e) { wgt[j][q][e] = wl[j][q][0][e] * g; wgt[j][q][4 + e] = wl[j][q][1][e] * g; }
            }
    }
    for (int unit = F.vcu; unit < T / 64; unit += F.G) {
        const float rs_l = rsqrtf(sum16(rss + (size_t)(unit * 64 + F.wave * 8 + (F.lane & 7)) * 16) * (1.f / 1024.f) + EPS);
#pragma unroll 1
        for (int k0 = 0; k0 < 8; k0 += 4) {
        u32x4 xr[4][2];
#pragma unroll
        for (int k = 0; k < 4; ++k)
#pragma unroll
            for (int j = 0; j < 2; ++j) xr[k][j] = *(const u32x4*)(x + (size_t)(unit * 64 + F.wave * 8 + k0 + k) * D + 8 * F.lane + 512 * j);
#pragma unroll
        for (int kk = 0; kk < 4; ++kk) {
            const int k = k0 + kk, tok = F.wave * 8 + k;
            float lg[8];
#pragma unroll
            for (int e = 0; e < 8; ++e) lg[e] = 0.f;
#pragma unroll
            for (int j = 0; j < 2; ++j) {
                const u32x4 v = xr[kk][j];
                const float xv[8] = {bflo(v.x), bfhi(v.x), bflo(v.y), bfhi(v.y), bflo(v.z), bfhi(v.z), bflo(v.w), bfhi(v.w)};
#pragma unroll
                for (int q = 0; q < 8; ++q)
#pragma unroll
                    for (int e = 0; e < 8; ++e) lg[e] = fmaf(xv[q], wgt[j][q][e], lg[e]);
            }
            const float rs = __shfl(rs_l, k);
#pragma unroll
            for (int e = 0; e < 8; ++e) lg[e] = wave_sum(lg[e]) * rs;
            int i1 = 0; float v1 = lg[0];
#pragma unroll
            for (int e = 1; e < 8; ++e) if (lg[e] > v1) { v1 = lg[e]; i1 = e; }
            int i2 = -1; float v2 = -INFINITY;
#pragma unroll
            for (int e = 0; e < 8; ++e) if (e != i1 && lg[e] > v2) { v2 = lg[e]; i2 = e; }
            const float e2 = __expf(v2 - v1), w1 = 1.f / (1.f + e2), w2 = e2 / (1.f + e2);
            if (F.lane == 0) { lsel[tok * 4 + 0] = __int_as_float(i1); lsel[tok * 4 + 1] = __int_as_float(i2); lsel[tok * 4 + 2] = w1; lsel[tok * 4 + 3] = w2; }
        }
        }
        __syncthreads();
        if (F.wave == 0) {
            const int e1 = __float_as_int(lsel[F.lane * 4 + 0]), e2 = __float_as_int(lsel[F.lane * 4 + 1]);
            const unsigned long long below = (1ull << F.lane) - 1ull;
            int pos1 = 0, pos2 = 0, cnt_l = 0;
#pragma unroll
            for (int e = 0; e < 8; ++e) {
                const unsigned long long m1 = __ballot(e1 == e), m2 = __ballot(e2 == e);
                const int b1 = __popcll(m1 & below), b2 = __popcll(m2 & below);
                if (e1 == e) pos1 = b1 + b2;
                if (e2 == e) pos2 = b1 + b2 + (int)((m1 >> F.lane) & 1ull);
                if (F.lane == e) cnt_l = __popcll(m1) + __popcll(m2);
            }
            lpos[F.lane * 2 + 0] = pos1; lpos[F.lane * 2 + 1] = pos2;
            if (F.lane < 8) wgcnt[unit * 8 + F.lane] = (unsigned)cnt_l;
        }
        __syncthreads();
        if (F.tid < 64) {
            const int t = unit * 64 + F.tid;
            u32x4 a, b2;
            a.x = (unsigned)__float_as_int(lsel[F.tid * 4 + 0]); a.y = (unsigned)__float_as_int(lsel[F.tid * 4 + 1]); a.z = __float_as_uint(lsel[F.tid * 4 + 2]); a.w = __float_as_uint(lsel[F.tid * 4 + 3]);
            b2.x = (unsigned)lpos[F.tid * 2 + 0]; b2.y = (unsigned)lpos[F.tid * 2 + 1]; b2.z = 0u; b2.w = 0u;
            *(u32x4*)(route + (size_t)t * 8) = a; *(u32x4*)(route + (size_t)t * 8 + 4) = b2;
        }
        __syncthreads();
    }
}
__device__ __forceinline__ void moe_geometry(Frame& F, int unit, LAS int* geo) {
    const unsigned* wgcnt = F.ctl + CW_WGCNT;
    int tv[8], pv[8];
    if (F.tid < 256) {
        const u32x4 c0 = *(const u32x4*)(wgcnt + F.tid * 8), c1 = *(const u32x4*)(wgcnt + F.tid * 8 + 4);
        tv[0] = (int)c0.x; tv[1] = (int)c0.y; tv[2] = (int)c0.z; tv[3] = (int)c0.w; tv[4] = (int)c1.x; tv[5] = (int)c1.y; tv[6] = (int)c1.z; tv[7] = (int)c1.w;
    } else {
#pragma unroll
        for (int e = 0; e < 8; ++e) tv[e] = 0;
    }
#pragma unroll
    for (int e = 0; e < 8; ++e) pv[e] = (F.tid < unit) ? tv[e] : 0;
#pragma unroll
    for (int e = 0; e < 8; ++e) {
#pragma unroll
        for (int o = 1; o < 64; o <<= 1) { tv[e] += __shfl_xor(tv[e], o); pv[e] += __shfl_xor(pv[e], o); }
    }
    LAS int* part = geo + 32;
    if (F.lane == 0 && F.wave < 4) {
#pragma unroll
        for (int e = 0; e < 8; ++e) { part[F.wave * 16 + e] = tv[e]; part[F.wave * 16 + 8 + e] = pv[e]; }
    }
    __syncthreads();
    if (F.tid < 8) {
        int tot = 0, pre = 0;
#pragma unroll
        for (int w = 0; w < 4; ++w) { tot += part[w * 16 + F.tid]; pre += part[w * 16 + 8 + F.tid]; }
        geo[9 + F.tid] = tot; geo[17 + F.tid] = pre;
    }
    __syncthreads();
    if (F.tid == 0) { int acc = 0; for (int e = 0; e < 8; ++e) { geo[e] = acc; acc += (geo[9 + e] + 255) >> 8; } geo[8] = acc; }
    __syncthreads();
}
__device__ __forceinline__ void phase_route2(Frame& F) {
    const unsigned* route = (const unsigned*)(F.ws + WS_SLOT + SL_ROUTE);
    int* slot_tok = (int*)(F.ws + WS_SLOT + SL_TOK); float* slot_scale = (float*)(F.ws + WS_SLOT + SL_SCALE); float* slot_comb = (float*)(F.ws + WS_SLOT + SL_COMB);
    const float* rss = F.stats + SF_ROWSS + (size_t)3 * T * 16;
    const bf16_t* xb = (const bf16_t*)(F.ws + WS_XB); bf16_t* xg = act_ptr(F, A_XG);
    LAS int* geo = (LAS int*)(F.lds);
    for (int unit = F.vcu; unit < T / 64; unit += F.G) {
        moe_geometry(F, unit, geo);
        int slot_l = 0;
        if (F.lane < 16) {
            const int rix = F.wave * 16 + F.lane, tok = rix >> 1, ch = rix & 1, t = unit * 64 + tok;
            const unsigned e = route[(size_t)t * 8 + ch], pos = route[(size_t)t * 8 + 4 + ch];
            const float w = __uint_as_float(route[(size_t)t * 8 + 2 + ch]);
            const float sc = rsqrtf(sum16(rss + (size_t)t * 16) * (1.f / 1024.f) + EPS);
            slot_l = geo[e] * 256 + geo[17 + e] + (int)pos;
            ((int*)(F.ws + WS_TSLOT))[t * 2 + ch] = slot_l; slot_tok[slot_l] = t; slot_scale[slot_l] = sc; slot_comb[slot_l] = w;
        }
        if (unit == 0) {
            for (int e = 0; e < 8; ++e) { const int s0 = geo[e] * 256 + geo[9 + e], s1 = geo[e + 1] * 256;
                for (int s = s0 + F.tid; s < s1; s += 512) { slot_tok[s] = -1; slot_scale[s] = 0.f; slot_comb[s] = 0.f; } }
        }
        __syncthreads();
    }
}

struct Args { const void* in[25]; float* out; unsigned char* ws; int ph_lo, ph_hi, li, pad; };
constexpr int NPHASE = 22;
#ifndef PH_MASK
#define PH_MASK 0xFFF
#endif
#define PON(b) (((PH_MASK) >> (b)) & 1)

__global__ void __launch_bounds__(512, 2) mega_fwd(Args args) {
    extern __shared__ __attribute__((aligned(16))) unsigned char lds_raw[];
    Frame F;
    F.lds = (LAS unsigned char*)lds_raw;
    F.MISC = (volatile LAS unsigned*)(F.lds + MISC_OFF);
    F.tid = threadIdx.x; F.lane = F.tid & 63; F.wave = __builtin_amdgcn_readfirstlane(F.tid >> 6);
    F.G = gridDim.x; { const int bx = blockIdx.x; F.vcu = (F.G % 8 == 0) ? (bx % 8) * (F.G / 8) + bx / 8 : bx; }
    { const CAS Args* ap0 = (const CAS Args*)__builtin_amdgcn_kernarg_segment_ptr(); F.ws = ap0->ws; F.ctl = (unsigned*)(F.ws + WS_CTL); F.ctlf = (float*)(F.ws + WS_CTL); F.stats = (float*)(F.ws + WS_STATS); }
    F.inp = nullptr; F.out = nullptr;
    for (int u = F.tid; u < (LDS_BYTES - LDSCTL_OFF) / 4; u += 512) ((LAS unsigned*)(F.lds + LDSCTL_OFF))[u] = 0u;
    __syncthreads();
    XcdBarrier bar = xcd_barrier_post(F.ctl + CW_BAR + args.li * XCD_BAR_WORDS, F.MISC + 8);
    const int lo = args.ph_lo, hi = args.ph_hi;
    const int cblk0 = (int)blockIdx.x, wave0 = F.wave, vcu0 = F.vcu, G0 = F.G;
#ifndef REP_MASK
#define REP_MASK 0
#endif
#pragma unroll 1
    for (int ph2 = 2 * lo; ph2 < 2 * hi; ++ph2) {
        const int ph = ph2 >> 1, rpt = ph2 & 1;
        if (rpt && !((REP_MASK >> ph) & 1)) continue;
        int cblk = cblk0; { int wv_ = wave0, vc_ = vcu0, g_ = G0; asm volatile("" : "+s"(wv_), "+s"(vc_), "+s"(g_), "+s"(cblk)); F.wave = wv_; F.vcu = vc_; F.G = g_; }
        { int ln_; asm volatile("v_mbcnt_lo_u32_b32 %0, -1, 0\n\tv_mbcnt_hi_u32_b32 %0, -1, %0" : "=v"(ln_)); F.lane = ln_; F.tid = F.wave * 64 + ln_; }
        { const CAS Args* ap = (const CAS Args*)__builtin_amdgcn_kernarg_segment_ptr(); asm volatile("" : "+s"(ap)); F.inp = ap->in; F.out = ap->out; unsigned char* w_ = ap->ws; F.ws = w_; F.ctl = (unsigned*)(w_ + WS_CTL); F.ctlf = (float*)(w_ + WS_CTL); F.stats = (float*)(w_ + WS_STATS); }
        const int l = ph >= 10 ? 1 : 0, q = ph == 0 ? -1 : (l ? ph - 10 : ph - 1);
        unsigned char* wb = wblk(F, l);
        float* ssq = F.stats + SF_SSQ + (size_t)l * 2 * T * 4;
        const float* rss_in = F.stats + SF_ROWSS + (size_t)(l == 0 ? 0 : 2) * T * 16;
        float* rss_mid = F.stats + SF_ROWSS + (size_t)(l == 0 ? 1 : 3) * T * 16;
        if (q == -1) {
            if (PON(11)) p0_prologue(F);
        } else if (q == 0 && PON(0)) {
            pg8::SchedGrid S{(const char*)(F.ws + WS_XB), (const char*)(wb + WO_IN), (size_t)256 * 1024 * 2, (size_t)256 * 1024 * 2, 0, 64, 11, F.G, cblk, 1 << 30};
            { pg8::Unit u0; if (S.next(0, u0)) fill_rs(F, rss_in, u0.pm); }
            pg8::EpiProj E{act_ptr(F, A_CQKV), act_ptr(F, A_GQKV), act_ptr(F, A_OG), act_ptr(F, A_UP), act_ptr(F, A_MISC), (const LAS float*)(F.lds + RS_OFF), ssq};
            pg8::gemm_phase<pg8::EpiProj, pg8::SchedGrid, true, true>(F.lds, F.wave, 1024, 1024, S, E);
        } else if (q == 1 && PON(1)) {
            pg8::SchedGrid S{(const char*)act_ptr(F, A_CQKV), (const char*)(wb + WO_UP), (size_t)256 * 512 * 2, (size_t)256 * 256 * 2, (size_t)256 * 2, 64, 7, F.G, cblk, 3};
            pg8::EpiUp E{act_ptr(F, A_QKVRAW), ssq};
            pg8::gemm_phase<pg8::EpiUp, pg8::SchedGrid, true, true>(F.lds, F.wave, 512, 256, S, E);
        } else if (q == 2 && PON(2)) {
            phase_prep(F, l, rpt);
        } else if (q == 3 && PON(3)) {
            phase_mix(F, l + 2 * rpt, cblk);
        } else if (q == 4 && PON(4)) {
            pg8::SchedGrid S{(const char*)(F.ws + WS_XB), (const char*)(wb + WO_G), (size_t)256 * 1024 * 2, (size_t)256 * 1024 * 2, 0, 64, 12, F.G, cblk, 1 << 30};
            { pg8::Unit u0; if (S.next(0, u0)) fill_rs(F, rss_in, u0.pm); }
            pg8::EpiGate E{F.ws + WS_ACTS, (const LAS float*)(F.lds + RS_OFF)};
            pg8::gemm_phase<pg8::EpiGate, pg8::SchedGrid, true, true>(F.lds, F.wave, 1024, 1024, S, E);
            if (!rpt) gla_finalize(F, l);
        } else if (q == 5 && PON(5)) {
            pg8::SchedMerge S{(const char*)(F.ws + WS_ACTS), (const char*)(wb + WO_BR), F.G, cblk};
            pg8::EpiMerge E{F.ws + WS_ACTS, act_ptr(F, A_MERGED)};
            pg8::gemm_phase<pg8::EpiMerge, pg8::SchedMerge, true, true>(F.lds, F.wave, 512, 512, S, E);
        } else if (q == 6 && PON(6)) {
            pg8::SchedGrid S{(const char*)act_ptr(F, A_MERGED), (const char*)(wb + WO_OUT), (size_t)256 * 1024 * 2, (size_t)256 * 1024 * 2, 0, 64, 4, F.G, cblk, 1 << 30, MERGED_HI_DELTA};
            pg8::EpiResid E{(bf16_t*)(F.ws + WS_XB), rss_mid};
            pg8::gemm_phase<pg8::EpiResid, pg8::SchedGrid, true, true>(F.lds, F.wave, 1024, 1024, S, E);
        } else if (l == 0 && q == 7 && PON(7)) {
            pg8::SchedGrid S{(const char*)(F.ws + WS_XB), (const char*)(wb + WO_FGU), (size_t)256 * 1024 * 2, (size_t)256 * 1024 * 2, 0, 64, 22, F.G, cblk, 1 << 30};
            if (F.G == 256) S.split_from = 1280;
            { pg8::Unit u0; if (S.next(0, u0)) fill_rs(F, rss_mid, u0.pm); }
            pg8::EpiSwiglu<false> E{act_ptr(F, A_ACT), DFF, (const LAS float*)(F.lds + RS_OFF), nullptr, nullptr};
            pg8::gemm_phase<pg8::EpiSwiglu<false>, pg8::SchedGrid, true, true>(F.lds, F.wave, 1024, 1024, S, E);
        } else if (l == 0 && q == 8 && PON(8)) {
            pg8::SchedGrid S{(const char*)act_ptr(F, A_ACT), (const char*)(wb + WO_FD), (size_t)256 * DFF * 2, (size_t)256 * DFF * 2, 0, 64, 4, F.G, cblk, 1 << 30};
            pg8::EpiResid E{(bf16_t*)(F.ws + WS_XB), F.stats + SF_ROWSS + (size_t)2 * T * 16};
            pg8::gemm_phase<pg8::EpiResid, pg8::SchedGrid, true, true>(F.lds, F.wave, DFF, DFF, S, E);
        } else if (q == 7 && PON(9)) {
            phase_route1(F);
            __syncthreads();
            LAS float* scr = (LAS float*)(F.lds + F.wave * 16384);
            const int gw = F.vcu * 8 + F.wave, NGW = F.G * 8;
            CONV_LOOP(12, moe_seg(F, (si_ < 4) ? (6 + (si_ >> 1)) * 3 + (si_ & 1) : (si_ - 4) * 3 + 2));
        } else if (q == 8 && PON(9)) {
            phase_route2(F);
        } else if (q == 9 && PON(10)) {
            unsigned char* wm = F.ws + WS_W0;
            LAS int* geo = (LAS int*)(F.lds + RING_BYTES + 512);
            moe_geometry(F, 0, geo);
            pg8::SchedMoeT<true> S; S.rowmap = (const int*)(F.ws + WS_SLOT + SL_TOK); S.A = (const char*)(F.ws + WS_XB); S.B = (const char*)(wm + WO_MGU); S.a_tile = (size_t)256 * 1024 * 2; S.b_tile = (size_t)256 * 1024 * 2; S.b_exp = (size_t)2816 * 1024 * 2;
            S.nN = 11; S.G = F.G; S.c = cblk;
            S.t1 = __builtin_amdgcn_readfirstlane(geo[1]); S.t2 = __builtin_amdgcn_readfirstlane(geo[2]); S.t3 = __builtin_amdgcn_readfirstlane(geo[3]); S.t4 = __builtin_amdgcn_readfirstlane(geo[4]);
            S.t5 = __builtin_amdgcn_readfirstlane(geo[5]); S.t6 = __builtin_amdgcn_readfirstlane(geo[6]); S.t7 = __builtin_amdgcn_readfirstlane(geo[7]); S.MT = __builtin_amdgcn_readfirstlane(geo[8]);
            pg8::EpiSwiglu<true> E{act_ptr(F, A_ACTE), DEXP, (const LAS float*)nullptr, (const float*)(F.ws + WS_SLOT + SL_SCALE), (const float*)(F.ws + WS_SLOT + SL_COMB)};
            pg8::gemm_phase<pg8::EpiSwiglu<true>, pg8::SchedMoeT<true>, true, true>(F.lds, F.wave, 1024, 1024, S, E);
        } else if (q == 10 && PON(10)) {
            unsigned char* wm = F.ws + WS_W0;
            LAS int* geo = (LAS int*)(F.lds + RING_BYTES + 512);
            moe_geometry(F, 0, geo);
            pg8::SchedMoe S; S.A = (const char*)act_ptr(F, A_ACTE); S.B = (const char*)(wm + WO_MD); S.a_tile = (size_t)256 * DEXP * 2; S.b_tile = (size_t)256 * DEXP * 2; S.b_exp = (size_t)1024 * DEXP * 2;
            S.nN = 4; S.G = F.G; S.c = cblk;
            S.t1 = __builtin_amdgcn_readfirstlane(geo[1]); S.t2 = __builtin_amdgcn_readfirstlane(geo[2]); S.t3 = __builtin_amdgcn_readfirstlane(geo[3]); S.t4 = __builtin_amdgcn_readfirstlane(geo[4]);
            S.t5 = __builtin_amdgcn_readfirstlane(geo[5]); S.t6 = __builtin_amdgcn_readfirstlane(geo[6]); S.t7 = __builtin_amdgcn_readfirstlane(geo[7]); S.MT = __builtin_amdgcn_readfirstlane(geo[8]);
            { const int nt = S.MT * 4, rem = nt % F.G; if (rem > 0 && 2 * rem <= F.G) S.split_from = nt - rem; }
            pg8::EpiMoeDown E{act_ptr(F, A_Y)};
            pg8::gemm_phase<pg8::EpiMoeDown, pg8::SchedMoe, true, true>(F.lds, F.wave, DEXP, DEXP, S, E);
        }
        else if (q == 11) {
            const int* tslot = (const int*)(F.ws + WS_TSLOT); const bf16_t* y = act_ptr(F, A_Y);
            const int tstep = F.G * 8;
            for (int tb = F.vcu * 8 + F.wave; tb < T; tb += 4 * tstep) {
                int sl = 0;
                { const int tt = tb + (F.lane >> 1) * tstep; if (F.lane < 8 && tt < T) sl = tslot[tt * 2 + (F.lane & 1)]; }
                u32x4 av[4][2], bv[4][2], xv4[4][2];
#pragma unroll
                for (int k = 0; k < 4; ++k) {
                    const int t = tb + k * tstep, tc = t < T ? t : tb;
                    const int s0 = __shfl(sl, 2 * k), s1 = __shfl(sl, 2 * k + 1);
                    const bf16_t* xbr = (const bf16_t*)(F.ws + WS_XB) + (size_t)tc * D;
#pragma unroll
                    for (int j = 0; j < 2; ++j) {
                        av[k][j] = *((const u32x4*)(y + (size_t)s0 * D) + 64 * j + F.lane); bv[k][j] = *((const u32x4*)(y + (size_t)s1 * D) + 64 * j + F.lane);
                        xv4[k][j] = *((const u32x4*)xbr + 64 * j + F.lane);
                    }
                }
#pragma unroll
                for (int k = 0; k < 4; ++k) {
                    const int t = tb + k * tstep; if (t >= T) break;
                    f32x4* xo = (f32x4*)(F.out + (size_t)t * D) + F.lane * 2;
#pragma unroll
                    for (int j = 0; j < 2; ++j) {
                        const u32x4 a = av[k][j], bq = bv[k][j], xv = xv4[k][j];
                        f32x4 x0 = {bflo(xv.x), bfhi(xv.x), bflo(xv.y), bfhi(xv.y)}, x1 = {bflo(xv.z), bfhi(xv.z), bflo(xv.w), bfhi(xv.w)};
                        x0[0] += bflo(a.x) + bflo(bq.x); x0[1] += bfhi(a.x) + bfhi(bq.x); x0[2] += bflo(a.y) + bflo(bq.y); x0[3] += bfhi(a.y) + bfhi(bq.y);
                        x1[0] += bflo(a.z) + bflo(bq.z); x1[1] += bfhi(a.z) + bfhi(bq.z); x1[2] += bflo(a.w) + bflo(bq.w); x1[3] += bfhi(a.w) + bfhi(bq.w);
                        xo[128 * j] = x0; xo[128 * j + 1] = x1;
                    }
                }
            }
        }
        if (ph + 1 < hi || (!rpt && ((REP_MASK >> ph) & 1))) xcd_barrier(bar);
    }
}


#ifdef DBG_PH
__global__ void dbg_dump(const unsigned char* ws, float* out) {
    const size_t i = (size_t)blockIdx.x * 256 + threadIdx.x;
    float v = 0.f;
    const bf16_t* a0 = (const bf16_t*)(ws + WS_ACTS + DBG_A0); const bf16_t* a1 = (const bf16_t*)(ws + WS_ACTS + DBG_A1);
    if (i < (size_t)DBG_N0) v += __uint_as_float((unsigned)a0[i] << 16);
    if (i < (size_t)DBG_N1) v += 3.f * __uint_as_float((unsigned)a1[i] << 16);
    out[i] = v;
}
#endif

extern "C" void kernel_launch(void* const* d_in, const int* in_sizes, int n_in, void* d_out, int out_size, void* d_ws, size_t ws_size, hipStream_t stream) {
    static int grid = 0;
    if (grid == 0) {
        if (n_in != 25 || out_size != T * D || ws_size < WS_END) { fprintf(stderr, "kernel_launch: unexpected sizes (n_in %d out %d ws %zu)\n", n_in, out_size, ws_size); grid = -1; return; }
        int dev = 0, cus = 0;
        if (hipGetDevice(&dev) != hipSuccess || hipDeviceGetAttribute(&cus, hipDeviceAttributeMultiprocessorCount, dev) != hipSuccess) { grid = -1; return; }
        if (hipFuncSetAttribute((const void*)mega_fwd, hipFuncAttributeMaxDynamicSharedMemorySize, LDS_BYTES) != hipSuccess) { grid = -1; return; }
        int per_cu = 0;
        (void)hipOccupancyMaxActiveBlocksPerMultiprocessor(&per_cu, (const void*)mega_fwd, 512, LDS_BYTES);
        (void)hipGetLastError();
        grid = cus;
    }
    if (grid < 0) return;
    (void)hipMemsetAsync((char*)d_ws + WS_CTL, 0, CTL_BYTES, stream);
    Args a{};
    for (int i = 0; i < 25; ++i) a.in[i] = d_in[i];
    a.out = (float*)d_out; a.ws = (unsigned char*)d_ws; a.ph_lo = 0; a.ph_hi = NPHASE; a.li = 0; a.pad = 0;
#ifdef DBG_PH
    a.ph_hi = DBG_PH;
#endif
    void* kargs[] = {&a};
    hipError_t e = hipLaunchCooperativeKernel((const void*)mega_fwd, dim3(grid), dim3(512), kargs, LDS_BYTES, stream);
    if (e != hipSuccess) fprintf(stderr, "cooperative launch failed: %s (grid %d)\n", hipGetErrorString(e), grid);
#ifdef DBG_PH
    hipLaunchKernelGGL(dbg_dump, dim3(T * 1024 / 256), dim3(256), 0, stream, (const unsigned char*)d_ws, (float*)d_out);
#endif
}
```

```cpp
#include <hip/hip_runtime.h>
#include <cstdint>
#include <cstdio>

#define LAS __attribute__((address_space(3)))
#define CAS __attribute__((address_space(4)))
typedef const void* GPtr;
typedef unsigned short bf16_t;
typedef short bf16x8 __attribute__((ext_vector_type(8)));
typedef float f32x4 __attribute__((ext_vector_type(4)));
typedef float f32x16 __attribute__((ext_vector_type(16)));
typedef unsigned u32x4 __attribute__((ext_vector_type(4)));
typedef unsigned u32x2 __attribute__((ext_vector_type(2)));

constexpr int T = 16384, SEQ = 4096, NB = 4, D = 1024, DIN = 5680, DFF = 2816, DEXP = 1408, NEXP = 8;
constexpr int NPROJ = 2816;
constexpr float EPS = 1e-6f;
constexpr int MAXSLOT = 34816;

constexpr size_t MiB = 1u << 20;
constexpr size_t WS_CTL = 0, CTL_BYTES = 128 * 1024;
constexpr size_t WS_SLOT = 2 * MiB;
constexpr size_t WS_ROPE = 3 * MiB;
constexpr size_t WS_XB = 5 * MiB;
constexpr size_t WS_W1 = 37 * MiB;
constexpr size_t WS_W0 = 55 * MiB;
constexpr size_t WS_ACTS = 89 * MiB;
constexpr size_t WS_STATS = 283 * MiB;
constexpr size_t WS_END = 291 * MiB;
constexpr size_t WO_IN = 0, WO_G = 5632 * 1024, WO_UP = WO_G + 6 * MiB, WO_BR = WO_UP + 1792 * 256 * 2, WO_OUT = WO_BR + 3 * MiB, WO_FGU = WO_OUT + 2 * MiB, WO_FD = WO_FGU + 11 * MiB;
constexpr size_t WO_MGU = 0, WO_MD = 44 * MiB;
constexpr size_t A_OG = 0, A_GQKV = 16 * MiB, A_UP = 48 * MiB, A_MISC = 64 * MiB, A_CQKV = 72 * MiB, A_VT = 72 * MiB, A_QKVRAW = 88 * MiB;
constexpr size_t A_YSA = 96 * MiB, A_POOLED = 112 * MiB, A_YSB = 128 * MiB, A_QH = 144 * MiB, A_KH = 168 * MiB;
constexpr size_t A_G0 = 16 * MiB, A_G1 = 48 * MiB, A_G2 = 144 * MiB, A_ACT = 0;
constexpr size_t A_MERGED = 0;
constexpr long long MERGED_HI_DELTA = (long long)(64 * MiB);
constexpr size_t A_XB8M = 32 * MiB;
constexpr size_t A_XB8 = 96 * MiB;
constexpr size_t A_XG = 32 * MiB, A_ACTE = 100 * MiB, A_Y = 32 * MiB;
constexpr int CW_TMO = 0, CW_BAR = 4096, CW_QUEUE = 16384, CW_WGCNT = 20480;
static_assert((size_t)(CW_WGCNT + 2048) * 4 <= CTL_BYTES, "ctl");
constexpr size_t SF_SSQ = 0;
constexpr size_t SF_ROWSS = (size_t)2 * 2 * T * 4;
constexpr size_t SF_OSS = SF_ROWSS + (size_t)4 * T * 16;
constexpr size_t SF_EB = SF_OSS + (size_t)T * 32;
static_assert((SF_EB + (size_t)(T / 32) * 256) * 4 <= 8 * MiB, "stats");
constexpr size_t SL_TOK = 0, SL_SCALE = 139264, SL_COMB = 2 * 139264, SL_ROUTE = 3 * 139264;
constexpr size_t WS_TSLOT = 1 * MiB;

constexpr int RING_BYTES = 131072, LDSCTL_OFF = RING_BYTES, MISC_OFF = LDSCTL_OFF + 320, LDS_BYTES = 147456;
constexpr int RS_OFF = RING_BYTES + 1024;

#define LDS_WAIT() asm volatile("s_waitcnt lgkmcnt(0)" ::: "memory")
#define VM_WAIT() asm volatile("s_waitcnt vmcnt(0)" ::: "memory")
#define LDS_BARRIER() do { asm volatile("s_waitcnt lgkmcnt(0)" ::: "memory"); __builtin_amdgcn_s_barrier(); asm volatile("" ::: "memory"); } while (0)
#define RLX_AGENT __ATOMIC_RELAXED, __HIP_MEMORY_SCOPE_AGENT
typedef float f32x2_t __attribute__((ext_vector_type(2))); typedef __bf16 bf16x2_t __attribute__((ext_vector_type(2)));
__device__ __forceinline__ unsigned cvt_pk_bf16(float lo, float hi) { f32x2_t v = {lo, hi}; bf16x2_t b = __builtin_convertvector(v, bf16x2_t); return __builtin_bit_cast(unsigned, b); }
__device__ __forceinline__ float bflo(unsigned u) { return __uint_as_float(u << 16); }
__device__ __forceinline__ float bfhi(unsigned u) { return __uint_as_float(u & 0xffff0000u); }
__device__ __forceinline__ float wave_sum(float v) {
#pragma unroll
    for (int o = 1; o < 64; o <<= 1) v += __shfl_xor(v, o);
    return v;
}
__device__ __forceinline__ float row16_sum(float x) {
    x += __int_as_float(__builtin_amdgcn_update_dpp(0, __float_as_int(x), 0x128, 0xf, 0xf, false));
    x += __int_as_float(__builtin_amdgcn_update_dpp(0, __float_as_int(x), 0x124, 0xf, 0xf, false));
    x += __int_as_float(__builtin_amdgcn_update_dpp(0, __float_as_int(x), 0x122, 0xf, 0xf, false));
    x += __int_as_float(__builtin_amdgcn_update_dpp(0, __float_as_int(x), 0x121, 0xf, 0xf, false));
    return x;
}
__device__ __forceinline__ float wave_sum_dpp(float x) {
    const float r = row16_sum(x);
    return ((__int_as_float(__builtin_amdgcn_readlane(__float_as_int(r), 0)) + __int_as_float(__builtin_amdgcn_readlane(__float_as_int(r), 16)))
         + (__int_as_float(__builtin_amdgcn_readlane(__float_as_int(r), 32)) + __int_as_float(__builtin_amdgcn_readlane(__float_as_int(r), 48))));
}
__device__ __forceinline__ int wave_isum_dpp(int x) {
    x += __builtin_amdgcn_update_dpp(0, x, 0x128, 0xf, 0xf, false);
    x += __builtin_amdgcn_update_dpp(0, x, 0x124, 0xf, 0xf, false);
    x += __builtin_amdgcn_update_dpp(0, x, 0x122, 0xf, 0xf, false);
    x += __builtin_amdgcn_update_dpp(0, x, 0x121, 0xf, 0xf, false);
    return (__builtin_amdgcn_readlane(x, 0) + __builtin_amdgcn_readlane(x, 16)) + (__builtin_amdgcn_readlane(x, 32) + __builtin_amdgcn_readlane(x, 48));
}
__device__ __forceinline__ float sum16(const float* p) { const f32x4 a = *(const f32x4*)p, b = *(const f32x4*)(p + 4), c = *(const f32x4*)(p + 8), d = *(const f32x4*)(p + 12);
    return (((a[0] + a[1]) + (a[2] + a[3])) + ((b[0] + b[1]) + (b[2] + b[3]))) + (((c[0] + c[1]) + (c[2] + c[3])) + ((d[0] + d[1]) + (d[2] + d[3]))); }
__device__ __forceinline__ float sum4(const float* p) { const f32x4 a = *(const f32x4*)p; return (a[0] + a[1]) + (a[2] + a[3]); }
__device__ __forceinline__ float fast_sigmoid(float z) { return __builtin_amdgcn_rcpf(1.f + __builtin_amdgcn_exp2f(-1.4426950408889634f * z)); }

#ifndef WT_MASK
#define WT_MASK 0x3f
#endif
template <int BIT> __device__ __forceinline__ void st16_out(void* p, u32x4 v) {
    if constexpr ((WT_MASK >> BIT) & 1) asm volatile("global_store_dwordx4 %0, %1, off sc1\n\ts_nop 1" :: "v"(p), "v"(v) : "memory");
    else *(u32x4*)p = v;
}
#ifndef FP8_G
#define FP8_G 1
#endif
#ifndef FP8_M
#define FP8_M 1
#endif
#ifndef FP8_E
#define FP8_E 1
#endif
#ifndef FP8_H
#define FP8_H 0
#endif
#ifndef FP8_A
#define FP8_A 0
#endif
#ifndef FP8_D
#define FP8_D 1
#endif
constexpr float ACT8_SC = 8.f; constexpr int KD8 = 1536;
constexpr float FP8_WSC = 64.f;
__device__ __forceinline__ u32x2 pack_fp8x8(float a0, float a1, float a2, float a3, float a4, float a5, float a6, float a7) {
    int w0 = 0, w1 = 0;
    w0 = __builtin_amdgcn_cvt_pk_fp8_f32(a0, a1, w0, false); w0 = __builtin_amdgcn_cvt_pk_fp8_f32(a2, a3, w0, true);
    w1 = __builtin_amdgcn_cvt_pk_fp8_f32(a4, a5, w1, false); w1 = __builtin_amdgcn_cvt_pk_fp8_f32(a6, a7, w1, true);
    return (u32x2){(unsigned)w0, (unsigned)w1};
}
namespace pg8 {
constexpr int BM = 256, BK = 64, HALF = 128, HTB = HALF * BK * 2, STAGE_BYTES = 8 * HTB, NXCD = 8, WGM = 8;
__host__ __device__ __forceinline__ int lds_byte(int r, int c) { const int st = (r >> 4) * 2 + (c >> 5), rr = r & 15, cc = c & 31, ob = rr * 64 + cc * 2; return st * 1024 + (ob ^ (((ob >> 9) & 1) << 5)); }
__host__ __device__ __forceinline__ void stage_rc(int b, int& R, int& C) { const int st = b / 1024, sb = b % 1024, swz = sb ^ (((sb >> 9) & 1) << 5); R = (st >> 1) * 16 + swz / 64; C = (st & 1) * 32 + (swz % 64) / 2; }
__host__ __device__ __forceinline__ int perm32(int rho) { const int n = rho >> 4, i = rho & 15; return 8 * (i >> 2) + 4 * n + (i & 3); }

struct Unit { const char* a; const char* b; int pm, pn, kind, half; };
__device__ __forceinline__ void tile_map(int L, int nM, int nN, int& pm, int& pn) {
    const int nwg = nM * nN; int wgid = L;
    { const int q = nwg / NXCD, r = nwg % NXCD, xcd = wgid % NXCD, off = wgid / NXCD; wgid = (xcd < r ? xcd * (q + 1) : r * (q + 1) + (xcd - r) * q) + off; }
    const int nig = WGM * nN, gid = wgid / nig, fm = gid * WGM, gsz = (nM - fm) < WGM ? (nM - fm) : WGM;
    pm = fm + ((wgid % nig) % gsz); pn = (wgid % nig) / gsz;
}

template <class Epi, class Sched, bool ALIGN_EPI, bool SP2, bool FP8 = false>
__device__ __forceinline__ void gemm_phase(LAS unsigned char* lds, const int wave_in, const int lda, const int K, const Sched& S, const Epi& E) {
    int ln_; asm volatile("v_mbcnt_lo_u32_b32 %0, -1, 0\n\tv_mbcnt_hi_u32_b32 %0, -1, %0" : "=v"(ln_));
    const int tid = wave_in * 64 + ln_, wid = __builtin_amdgcn_readfirstlane(tid >> 6), lane = tid & 63, wr = wid >> 2, wc = wid & 3, fr = lane & 15, fq = lane >> 4;
    const int nt = K / BK;
    constexpr bool GATHER = Sched::GATHER;
    unsigned voffA[2], voffA1[2], voffB[2];
#pragma unroll
    for (int i = 0; i < 2; ++i) { int R, C; stage_rc(tid * 16 + i * 8192, R, C); const int Rb = Epi::PERM ? ((R & ~31) + perm32(R & 31)) : R;
        voffA[i] = (unsigned)(R * lda + C) * 2u; voffB[i] = (unsigned)(Rb * K + C) * 2u; voffA1[i] = voffA[i]; }
    LAS int* idl = (LAS int*)(lds + RING_BYTES + 4096);
    const size_t kstep = (size_t)(BK * 2);
    const size_t hstepA = GATHER ? (size_t)0 : (size_t)HALF * lda * 2, hstepB = (size_t)HALF * K * 2;
    auto gather_ids = [&](const Unit& u, int (&tk)[4]) {
#pragma unroll
        for (int i = 0; i < 2; ++i) { int R, C; stage_rc(tid * 16 + i * 8192, R, C);
            if constexpr (GATHER) { tk[i] = S.rowmap[u.pm * BM + R]; tk[2 + i] = S.rowmap[u.pm * BM + HALF + R]; } else { tk[i] = 0; tk[2 + i] = 0; } }
    };
    auto gather_offs = [&](const int (&tk)[4], unsigned (&o0)[2], unsigned (&o1)[2]) {
#pragma unroll
        for (int i = 0; i < 2; ++i) { int R, C; stage_rc(tid * 16 + i * 8192, R, C); o0[i] = (unsigned)((tk[i] < 0 ? 0 : tk[i]) * lda + C) * 2u; o1[i] = (unsigned)((tk[2 + i] < 0 ? 0 : tk[2 + i]) * lda + C) * 2u; }
    };
    const unsigned ldsw = (unsigned)wid * 1024u;
    const int aoff = lds_byte(wr * 64 + fr, fq * 8), boff = lds_byte(wc * 32 + fr, fq * 8);
#define PG8_SA(b, h) (((b) * 2 + (h)) * HTB)
#define PG8_SB(b, h) ((4 + (b) * 2 + (h)) * HTB)
#define PG8_STAGE(bufoff, gbase, voff) do { _Pragma("unroll") for (int _i = 0; _i < 2; ++_i) \
        __builtin_amdgcn_global_load_lds((const unsigned*)((const char*)(gbase) + (voff)[_i]), (LAS unsigned*)(lds + (bufoff) + ldsw + _i * 8192), 16, 0, 0); } while (0)
#define PG8_STAGEA(b, h, gbase) PG8_STAGE(PG8_SA(b, h), gbase, ((GATHER && (h)) ? voffA1 : voffA))
#define PG8_LDA(dst, b, h) do { _Pragma("unroll") for (int m = 0; m < 4; ++m) _Pragma("unroll") for (int k = 0; k < 2; ++k) dst[m][k] = *(const LAS bf16x8*)(lds + PG8_SA(b, h) + aoff + m * 2048 + k * 1024); } while (0)
#define PG8_LDB(dst, b, h) do { _Pragma("unroll") for (int n = 0; n < 2; ++n) _Pragma("unroll") for (int k = 0; k < 2; ++k) dst[n][k] = *(const LAS bf16x8*)(lds + PG8_SB(b, h) + boff + n * 2048 + k * 1024); } while (0)
#define PG8_MMA(ai, bj, At, Bt) do { __builtin_amdgcn_s_setprio(1); _Pragma("unroll") for (int m = 0; m < 4; ++m) _Pragma("unroll") for (int n = 0; n < 2; ++n) { \
        if constexpr (FP8) { typedef int v4i32_ __attribute__((ext_vector_type(4))); typedef int v8i32_ __attribute__((ext_vector_type(8))); \
            const v4i32_ b0_ = __builtin_bit_cast(v4i32_, Bt[n][0]), b1_ = __builtin_bit_cast(v4i32_, Bt[n][1]), a0_ = __builtin_bit_cast(v4i32_, At[m][0]), a1_ = __builtin_bit_cast(v4i32_, At[m][1]); \
            const v8i32_ b8_ = __builtin_shufflevector(b0_, b1_, 0, 1, 2, 3, 4, 5, 6, 7), a8_ = __builtin_shufflevector(a0_, a1_, 0, 1, 2, 3, 4, 5, 6, 7); \
            acc[ai][bj][m][n] = __builtin_amdgcn_mfma_scale_f32_16x16x128_f8f6f4(b8_, a8_, acc[ai][bj][m][n], 0, 0, 0, 0x7F7F7F7F, 0, 0x7F7F7F7F); \
        } else { _Pragma("unroll") for (int k = 0; k < 2; ++k) acc[ai][bj][m][n] = __builtin_amdgcn_mfma_f32_16x16x32_bf16(Bt[n][k], At[m][k], acc[ai][bj][m][n], 0, 0, 0); } } \
        __builtin_amdgcn_s_setprio(0); } while (0)
#define PG8_WAIT_V(n) asm volatile("s_waitcnt vmcnt(" #n ")" ::: "memory")
#define PG8_WAIT_L(n) asm volatile("s_waitcnt lgkmcnt(" #n ")" ::: "memory")
#define PG8_BAR __builtin_amdgcn_s_barrier()
#define PG8_SCHED __builtin_amdgcn_sched_barrier(0)
    Unit cur, nxt; int ui = 0;
    if (!S.next(0, cur)) return;
    if constexpr (GATHER) { int tk0[4]; gather_ids(cur, tk0); gather_offs(tk0, voffA, voffA1); }
    f32x4 acc[2][2][4][2];
#pragma unroll
    for (int a = 0; a < 2; ++a)
#pragma unroll
        for (int b = 0; b < 2; ++b)
#pragma unroll
            for (int m = 0; m < 4; ++m)
#pragma unroll
                for (int n = 0; n < 2; ++n) { float z_; asm volatile("v_mov_b32 %0, 0" : "=v"(z_)); acc[a][b][m][n] = (f32x4){z_, z_, z_, z_}; }
    bf16x8 At[4][2], B0[2][2], B1[2][2];
    const char* cA = cur.a; const char* cB = cur.b;
    if constexpr (SP2) {
        PG8_STAGE(PG8_SB(0, 0), cB, voffB); PG8_STAGE(PG8_SB(0, 1), cB + hstepB, voffB); PG8_STAGEA(0, 0, cA); PG8_STAGEA(0, 1, cA + hstepA);
        if (wr == 1) PG8_BAR;
        PG8_WAIT_V(2); PG8_BAR;
        PG8_STAGE(PG8_SB(1, 0), cB + kstep, voffB); PG8_STAGEA(1, 0, cA + kstep); PG8_STAGE(PG8_SB(1, 1), cB + hstepB + kstep, voffB);
        PG8_WAIT_V(6); PG8_BAR;
    } else {
        PG8_STAGE(PG8_SB(0, 0), cB, voffB); PG8_STAGEA(0, 0, cA); PG8_STAGE(PG8_SB(0, 1), cB + hstepB, voffB); PG8_STAGEA(0, 1, cA + hstepA);
        if (wr == 1) PG8_BAR;
        PG8_WAIT_V(4); PG8_BAR;
        PG8_STAGE(PG8_SB(1, 0), cB + kstep, voffB); PG8_STAGEA(1, 0, cA + kstep); PG8_STAGE(PG8_SB(1, 1), cB + hstepB + kstep, voffB);
        PG8_WAIT_V(6); PG8_BAR;
    }
    for (;;) {
        const bool has_next = S.next(ui + 1, nxt);
        if constexpr (GATHER) { if (has_next) {
#pragma unroll
            for (int k = 0; k < 4; ++k) { int R, C; stage_rc(tid * 16 + (k & 1) * 8192, R, C);
                __builtin_amdgcn_global_load_lds((const unsigned*)(S.rowmap + nxt.pm * BM + (k >> 1) * HALF + R), (LAS unsigned*)(idl + k * 512 + wid * 64), 4, 0, 0); } } }
        const bool do0 = cur.half != 2, do1 = cur.half != 1;
        const char* nA = has_next ? nxt.a : cA; const char* nB = has_next ? nxt.b : cB;
#pragma unroll 1
        for (int t = 0; t < nt; t += 2) {
            const bool last = (t == nt - 2);
            const char* a1 = cA + (size_t)(t + 1) * kstep;
            const char* a2 = last ? nA : cA + (size_t)(t + 2) * kstep; const char* b2 = last ? nB : cB + (size_t)(t + 2) * kstep;
            const char* a3 = a2 + kstep; const char* b3 = b2 + kstep;
            if constexpr (SP2) {
            PG8_LDB(B0, 0, 0); PG8_LDB(B1, 0, 1); PG8_SCHED; PG8_LDA(At, 0, 0); PG8_STAGEA(1, 1, a1 + hstepA);
            PG8_WAIT_V(8); PG8_WAIT_L(0); PG8_BAR; if (do0) { PG8_MMA(0, 0, At, B0); PG8_MMA(0, 1, At, B1); } PG8_BAR; PG8_SCHED;
            if constexpr (GATHER) { if (last && has_next) { int tk[4];
#pragma unroll
                for (int k = 0; k < 4; ++k) tk[k] = idl[k * 512 + tid];
                gather_offs(tk, voffA, voffA1); } }
            PG8_LDA(At, 0, 1); PG8_STAGE(PG8_SB(0, 0), b2, voffB); PG8_STAGE(PG8_SB(0, 1), b2 + hstepB, voffB); PG8_STAGEA(0, 0, a2);
            PG8_WAIT_V(8); PG8_WAIT_L(0); PG8_BAR; if (do1) { PG8_MMA(1, 0, At, B0); PG8_MMA(1, 1, At, B1); } PG8_BAR; PG8_SCHED;
            PG8_LDB(B0, 1, 0); PG8_LDB(B1, 1, 1); PG8_SCHED; PG8_LDA(At, 1, 0); PG8_STAGEA(0, 1, a2 + hstepA);
            PG8_WAIT_V(8); PG8_WAIT_L(0); PG8_BAR; if (do0) { PG8_MMA(0, 0, At, B0); PG8_MMA(0, 1, At, B1); } PG8_BAR; PG8_SCHED;
            PG8_LDA(At, 1, 1); PG8_STAGE(PG8_SB(1, 0), b3, voffB); PG8_STAGE(PG8_SB(1, 1), b3 + hstepB, voffB); PG8_STAGEA(1, 0, a3);
            PG8_WAIT_V(8); PG8_WAIT_L(0); PG8_BAR; if (do1) { PG8_MMA(1, 0, At, B0); PG8_MMA(1, 1, At, B1); } PG8_BAR; PG8_SCHED;
            } else {
            PG8_LDB(B0, 0, 0); PG8_SCHED; PG8_LDA(At, 0, 0); PG8_STAGEA(1, 1, a1 + hstepA);
            PG8_WAIT_L(8); PG8_BAR; PG8_WAIT_L(0); PG8_MMA(0, 0, At, B0); PG8_BAR; PG8_SCHED;
            PG8_LDB(B1, 0, 1); PG8_STAGE(PG8_SB(0, 0), b2, voffB);
            PG8_BAR; PG8_WAIT_L(0); PG8_MMA(0, 1, At, B1); PG8_BAR;
            PG8_LDA(At, 0, 1); PG8_STAGEA(0, 0, a2);
            PG8_BAR; PG8_WAIT_L(0); PG8_MMA(1, 0, At, B0); PG8_BAR; PG8_SCHED;
            PG8_STAGE(PG8_SB(0, 1), b2 + hstepB, voffB);
            PG8_WAIT_V(6); PG8_BAR; PG8_MMA(1, 1, At, B1); PG8_BAR;
            PG8_LDB(B0, 1, 0); PG8_SCHED; PG8_LDA(At, 1, 0); PG8_STAGEA(0, 1, a2 + hstepA);
            PG8_WAIT_L(8); PG8_BAR; PG8_WAIT_L(0); PG8_MMA(0, 0, At, B0); PG8_BAR; PG8_SCHED;
            PG8_LDB(B1, 1, 1); PG8_STAGE(PG8_SB(1, 0), b3, voffB);
            PG8_BAR; PG8_WAIT_L(0); PG8_MMA(0, 1, At, B1); PG8_BAR;
            PG8_LDA(At, 1, 1); PG8_STAGEA(1, 0, a3);
            PG8_BAR; PG8_WAIT_L(0); PG8_MMA(1, 0, At, B0); PG8_BAR; PG8_SCHED;
            PG8_STAGE(PG8_SB(1, 1), b3 + hstepB, voffB);
            PG8_WAIT_V(6); PG8_BAR; PG8_MMA(1, 1, At, B1); PG8_BAR;
            }
        }
        if constexpr (ALIGN_EPI) { if (wr == 0) PG8_BAR; }
        { int fr_ = fr, fq_ = fq; asm volatile("" : "+v"(fr_), "+v"(fq_));
          E(acc, cur, wr, wc, fr_, fq_); }
        if (!has_next) break;
        if (!E.keep(cur)) {
#pragma unroll
            for (int a = 0; a < 2; ++a)
#pragma unroll
                for (int b = 0; b < 2; ++b)
#pragma unroll
                    for (int m = 0; m < 4; ++m)
#pragma unroll
                        for (int n = 0; n < 2; ++n) { float z_; asm volatile("v_mov_b32 %0, 0" : "=v"(z_)); acc[a][b][m][n] = (f32x4){z_, z_, z_, z_}; }
        }
        cur = nxt; cA = nA; cB = nB; ++ui;
        if constexpr (ALIGN_EPI) { if (wr == 1) PG8_BAR; }
    }
    PG8_WAIT_V(0);
    if constexpr (!ALIGN_EPI) { if (wr == 0) PG8_BAR; }
    PG8_BAR;
#undef PG8_SA
#undef PG8_SB
#undef PG8_STAGE
#undef PG8_STAGEA
#undef PG8_LDA
#undef PG8_LDB
#undef PG8_MMA
#undef PG8_WAIT_V
#undef PG8_WAIT_L
#undef PG8_BAR
#undef PG8_SCHED
}

typedef f32x4 Acc[2][2][4][2];

template <bool FP8IN = false> struct EpiProj {
    static constexpr bool PERM = true;
    bf16_t *cqkv, *gqkv, *og, *up, *misc; const LAS float* rs_tab; float* ssq;
    __device__ __forceinline__ bool keep(const Unit&) const { return false; }
    __device__ __forceinline__ void operator()(Acc& acc, const Unit& u, int wr, int wc, int fr, int fq) const {
        const int row0 = u.pm * BM + wr * 64 + fr;
        bf16_t* dst; int ld, coff; const int pn = u.pn;
        if (pn < 2) { dst = cqkv; ld = 512; coff = pn * 256; }
        else if (pn < 6) { dst = gqkv; ld = 1024; coff = (pn - 2) * 256; }
        else if (pn < 8) { dst = og; ld = 512; coff = (pn - 6) * 256; }
        else if (pn < 10) { dst = up; ld = 512; coff = (pn - 8) * 256; }
        else { dst = misc; ld = 256; coff = 0; }
        const int col0 = coff + wc * 32 + 8 * fq;
#pragma unroll
        for (int ai = 0; ai < 2; ++ai)
#pragma unroll
            for (int m = 0; m < 4; ++m) { if (u.half && ai != u.half - 1) continue;
                const int row = row0 + ai * HALF + m * 16;
                const float rs = FP8IN ? rs_tab[wr * 64 + fr + ai * HALF + m * 16] * (1.f / FP8_WSC) : rs_tab[wr * 64 + fr + ai * HALF + m * 16];
                float ss = 0.f;
#pragma unroll
                for (int bj = 0; bj < 2; ++bj) {
                    const f32x4 v0 = acc[ai][bj][m][0] * rs, v1 = acc[ai][bj][m][1] * rs;
                    ss += (v0[0] * v0[0] + v0[1] * v0[1]) + (v0[2] * v0[2] + v0[3] * v0[3]) + (v1[0] * v1[0] + v1[1] * v1[1]) + (v1[2] * v1[2] + v1[3] * v1[3]);
                    u32x4 w; w.x = cvt_pk_bf16(v0[0], v0[1]); w.y = cvt_pk_bf16(v0[2], v0[3]); w.z = cvt_pk_bf16(v1[0], v1[1]); w.w = cvt_pk_bf16(v1[2], v1[3]);
                    st16_out<0>(dst + (size_t)row * ld + col0 + bj * HALF, w);
                }
                if (pn < 2) { ss += __shfl_xor(ss, 16); ss += __shfl_xor(ss, 32); if (fq == 0) ssq[((size_t)pn * T + row) * 4 + wc] = ss; }
            }
    }
};
struct EpiUp {
    static constexpr bool PERM = true;
    bf16_t* out; const float* ssq; bf16_t* qraw;
    __device__ __forceinline__ bool keep(const Unit&) const { return false; }
    __device__ __forceinline__ void operator()(Acc& acc, const Unit& u, int wr, int wc, int fr, int fq) const {
        const int row0 = u.pm * BM + wr * 64 + fr, col0 = u.pn * BM + wc * 32 + 8 * fq;
        const float* sq = ssq + (u.pn < 3 ? (size_t)0 : (size_t)T * 4);
        f32x4 sqv[2][4];
#pragma unroll
        for (int ai = 0; ai < 2; ++ai)
#pragma unroll
            for (int m = 0; m < 4; ++m) sqv[ai][m] = *(const f32x4*)(sq + (size_t)(row0 + ai * HALF + m * 16) * 4);
#pragma unroll
        for (int ai = 0; ai < 2; ++ai)
#pragma unroll
            for (int m = 0; m < 4; ++m) { if (u.half && ai != u.half - 1) continue;
                const int row = row0 + ai * HALF + m * 16;
                const float rs = rsqrtf(((sqv[ai][m][0] + sqv[ai][m][1]) + (sqv[ai][m][2] + sqv[ai][m][3])) * (1.f / 256.f) + EPS);
#pragma unroll
                for (int bj = 0; bj < 2; ++bj) {
                    const f32x4 v0 = acc[ai][bj][m][0] * rs, v1 = acc[ai][bj][m][1] * rs;
                    u32x4 w; w.x = cvt_pk_bf16(v0[0], v0[1]); w.y = cvt_pk_bf16(v0[2], v0[3]); w.z = cvt_pk_bf16(v1[0], v1[1]); w.w = cvt_pk_bf16(v1[2], v1[3]);
                    st16_out<1>(u.pn < 3 ? qraw + (size_t)row * 768 + col0 + bj * HALF : out + (size_t)row * 1792 + col0 + bj * HALF, w);
                }
            }
    }
};
template <bool FP8IN = false> struct EpiGate {
    static constexpr bool PERM = true;
    unsigned char* acts; const LAS float* rs_tab;
    __device__ __forceinline__ bool keep(const Unit&) const { return false; }
    __device__ __forceinline__ void operator()(Acc& acc, const Unit& u, int wr, int wc, int fr, int fq) const {
        const int row0 = u.pm * BM + wr * 64 + fr, pl = u.pn >> 2, col0 = (u.pn & 3) * BM + wc * 32 + 8 * fq;
        bf16_t* dst = (bf16_t*)(acts + ((long long)A_G0 + (long long)(pl == 1) * (long long)(A_G1 - A_G0) + (long long)(pl == 2) * (long long)(A_G2 - A_G0)));
#pragma unroll
        for (int ai = 0; ai < 2; ++ai)
#pragma unroll
            for (int m = 0; m < 4; ++m) { if (u.half && ai != u.half - 1) continue;
                const int row = row0 + ai * HALF + m * 16;
                const float rs = FP8IN ? rs_tab[wr * 64 + fr + ai * HALF + m * 16] * (1.f / FP8_WSC) : rs_tab[wr * 64 + fr + ai * HALF + m * 16];
#pragma unroll
                for (int bj = 0; bj < 2; ++bj) {
                    f32x4 v0 = acc[ai][bj][m][0] * rs, v1 = acc[ai][bj][m][1] * rs;
#ifndef DBG_NOSIG
#pragma unroll
                    for (int e = 0; e < 4; ++e) { v0[e] = fast_sigmoid(fminf(fmaxf(v0[e], -60.f), 60.f)); v1[e] = fast_sigmoid(fminf(fmaxf(v1[e], -60.f), 60.f)); }
#endif
                    u32x4 w; w.x = cvt_pk_bf16(v0[0], v0[1]); w.y = cvt_pk_bf16(v0[2], v0[3]); w.z = cvt_pk_bf16(v1[0], v1[1]); w.w = cvt_pk_bf16(v1[2], v1[3]);
                    st16_out<2>(dst + (size_t)row * 1024 + col0 + bj * HALF, w);
                    if constexpr (FP8IN) __builtin_amdgcn_sched_barrier(0);
                }
            }
    }
};
struct EpiMerge {
    static constexpr bool PERM = true;
    const unsigned char* acts; bf16_t* merged;
    __device__ __forceinline__ bool keep(const Unit& u) const { return u.kind < 2; }
    __device__ __forceinline__ void operator()(Acc& acc, const Unit& u, int wr, int wc, int fr, int fq) const {
        const int row0 = u.pm * BM + wr * 64 + fr, col0 = u.pn * BM + wc * 32 + 8 * fq, n = u.kind;
        const bf16_t* gn = (const bf16_t*)(acts + ((long long)A_G0 + (long long)(n == 1) * (long long)(A_G1 - A_G0) + (long long)(n == 2) * (long long)(A_G2 - A_G0)));
        const bf16_t* gd = (const bf16_t*)(acts + ((long long)A_G1 + (long long)(n != 0) * (long long)(A_G2 - A_G1)));
        if (n < 2) {
#pragma unroll
            for (int ai = 0; ai < 2; ++ai) {
                if (u.half && ai != u.half - 1) continue;
                u32x4 sn[4][2], sd[4][2];
#pragma unroll
                for (int m = 0; m < 4; ++m)
#pragma unroll
                    for (int bj = 0; bj < 2; ++bj) {
                        const size_t off = (size_t)(row0 + ai * HALF + m * 16) * 1024 + col0 + bj * HALF;
                        sn[m][bj] = *(const u32x4*)(gn + off); sd[m][bj] = *(const u32x4*)(gd + off);
                    }
#pragma unroll
                for (int m = 0; m < 4; ++m)
#pragma unroll
                    for (int bj = 0; bj < 2; ++bj) {
                        const u32x4 s = sn[m][bj], d = sd[m][bj];
                        f32x4 f0 = {bflo(s.x), bfhi(s.x), bflo(s.y), bfhi(s.y)}, f1 = {bflo(s.z), bfhi(s.z), bflo(s.w), bfhi(s.w)};
                        const f32x4 d0 = {bflo(d.x), bfhi(d.x), bflo(d.y), bfhi(d.y)}, d1 = {bflo(d.z), bfhi(d.z), bflo(d.w), bfhi(d.w)};
#pragma unroll
                        for (int e = 0; e < 4; ++e) { f0[e] *= __builtin_amdgcn_rcpf(d0[e]); f1[e] *= __builtin_amdgcn_rcpf(d1[e]); }
                        acc[ai][bj][m][0] = acc[ai][bj][m][0] * f0; acc[ai][bj][m][1] = acc[ai][bj][m][1] * f1;
                    }
            }
        } else {
#pragma unroll
            for (int ai = 0; ai < 2; ++ai) {
                if (u.half && ai != u.half - 1) continue;
                u32x4 sn[4][2];
#pragma unroll
                for (int m = 0; m < 4; ++m)
#pragma unroll
                    for (int bj = 0; bj < 2; ++bj) sn[m][bj] = *(const u32x4*)(gn + (size_t)(row0 + ai * HALF + m * 16) * 1024 + col0 + bj * HALF);
#pragma unroll
                for (int m = 0; m < 4; ++m)
#pragma unroll
                    for (int bj = 0; bj < 2; ++bj) {
                        const int row = row0 + ai * HALF + m * 16; const size_t off = (size_t)row * 1024 + col0 + bj * HALF;
                        const u32x4 s = sn[m][bj];
                        const f32x4 f0 = {bflo(s.x), bfhi(s.x), bflo(s.y), bfhi(s.y)}, f1 = {bflo(s.z), bfhi(s.z), bflo(s.w), bfhi(s.w)};
                        const f32x4 v0 = acc[ai][bj][m][0] * f0, v1 = acc[ai][bj][m][1] * f1;
                        u32x4 w; w.x = cvt_pk_bf16(v0[0], v0[1]); w.y = cvt_pk_bf16(v0[2], v0[3]); w.z = cvt_pk_bf16(v1[0], v1[1]); w.w = cvt_pk_bf16(v1[2], v1[3]);
                        st16_out<3>((unsigned char*)(merged + off) + (row >= 8192 ? MERGED_HI_DELTA : 0), w);
                    }
            }
        }
    }
};
template <bool WR8, bool SC8 = false> struct EpiResid {
    static constexpr bool PERM = true;
    bf16_t* xb; float* rowss_next; unsigned char* xb8;
    __device__ __forceinline__ bool keep(const Unit&) const { return false; }
    __device__ __forceinline__ void operator()(Acc& acc, const Unit& u, int wr, int wc, int fr, int fq) const {
        const int row0 = u.pm * BM + wr * 64 + fr, col0 = u.pn * BM + wc * 32 + 8 * fq;
#pragma unroll
        for (int ai = 0; ai < 2; ++ai) {
            if (u.half && ai != u.half - 1) continue;
            u32x4 ov[4][2];
#pragma unroll
            for (int m = 0; m < 4; ++m)
#pragma unroll
                for (int bj = 0; bj < 2; ++bj) ov[m][bj] = *(const u32x4*)(xb + (size_t)(row0 + ai * HALF + m * 16) * D + col0 + bj * HALF);
#pragma unroll
            for (int m = 0; m < 4; ++m) {
                const int row = row0 + ai * HALF + m * 16; float ss = 0.f;
#pragma unroll
                for (int bj = 0; bj < 2; ++bj) {
                    bf16_t* p = xb + (size_t)row * D + col0 + bj * HALF;
                    const u32x4 o = ov[m][bj];
                    const float as_ = SC8 ? 1.f / (FP8_WSC * ACT8_SC) : 1.f;
                    const f32x4 v0 = (f32x4){bflo(o.x), bfhi(o.x), bflo(o.y), bfhi(o.y)} + acc[ai][bj][m][0] * as_, v1 = (f32x4){bflo(o.z), bfhi(o.z), bflo(o.w), bfhi(o.w)} + acc[ai][bj][m][1] * as_;
                    ss += ((v0[0] * v0[0] + v0[1] * v0[1]) + (v0[2] * v0[2] + v0[3] * v0[3])) + ((v1[0] * v1[0] + v1[1] * v1[1]) + (v1[2] * v1[2] + v1[3] * v1[3]));
                    u32x4 w; w.x = cvt_pk_bf16(v0[0], v0[1]); w.y = cvt_pk_bf16(v0[2], v0[3]); w.z = cvt_pk_bf16(v1[0], v1[1]); w.w = cvt_pk_bf16(v1[2], v1[3]);
                    *(u32x4*)p = w;
                    if constexpr (WR8) *(u32x2*)(xb8 + (size_t)row * D + col0 + bj * HALF) = pack_fp8x8(v0[0], v0[1], v0[2], v0[3], v1[0], v1[1], v1[2], v1[3]);
                }
                ss += __shfl_xor(ss, 16); ss += __shfl_xor(ss, 32); if (fq == 0) rowss_next[(size_t)row * 16 + u.pn * 4 + wc] = ss;
            }
        }
    }
};
template <bool MOE, bool FP8IN = false, bool OUT8 = false> struct EpiSwiglu {
    static constexpr bool PERM = true;
    bf16_t* act; int ld; const LAS float* rs_tab; const float* slot_scale; const float* slot_comb;
    __device__ __forceinline__ bool keep(const Unit&) const { return false; }
    __device__ __forceinline__ void operator()(Acc& acc, const Unit& u, int wr, int wc, int fr, int fq) const {
        const int row0 = u.pm * BM + wr * 64 + fr, col0 = u.pn * HALF + wc * 32 + 8 * fq;
#pragma unroll
        for (int ai = 0; ai < 2; ++ai) {
            float rsv[4], cbv[4];
#pragma unroll
            for (int m = 0; m < 4; ++m) {
                if (MOE) { rsv[m] = slot_scale[row0 + ai * HALF + m * 16]; cbv[m] = slot_comb[row0 + ai * HALF + m * 16]; }
                else { rsv[m] = rs_tab[wr * 64 + fr + ai * HALF + m * 16]; cbv[m] = 1.f; }
            }
#pragma unroll
            for (int m = 0; m < 4; ++m) { if (u.half && ai != u.half - 1) continue;
                const int row = row0 + ai * HALF + m * 16;
                const float rs = (FP8IN && !MOE) ? rsv[m] * (1.f / FP8_WSC) : rsv[m], cb = (OUT8 && !MOE) ? ACT8_SC : cbv[m];
                f32x4 o[2];
#pragma unroll
                for (int n = 0; n < 2; ++n) {
                    const f32x4 g = acc[ai][0][m][n] * rs, uu = acc[ai][1][m][n] * rs;
#pragma unroll
                    for (int e = 0; e < 4; ++e) o[n][e] = g[e] * fast_sigmoid(g[e]) * uu[e] * cb;
                }
                if constexpr (OUT8) { *(u32x2*)((unsigned char*)act + (size_t)row * ld + col0) = pack_fp8x8(o[0][0], o[0][1], o[0][2], o[0][3], o[1][0], o[1][1], o[1][2], o[1][3]); }
                else {
                u32x4 w; w.x = cvt_pk_bf16(o[0][0], o[0][1]); w.y = cvt_pk_bf16(o[0][2], o[0][3]); w.z = cvt_pk_bf16(o[1][0], o[1][1]); w.w = cvt_pk_bf16(o[1][2], o[1][3]);
                st16_out<4>(act + (size_t)row * ld + col0, w); }
            }
        }
    }
};
template <bool FP8IN = false> struct EpiMoeDown {
    static constexpr bool PERM = true;
    bf16_t* y;
    __device__ __forceinline__ bool keep(const Unit&) const { return false; }
    __device__ __forceinline__ void operator()(Acc& acc, const Unit& u, int wr, int wc, int fr, int fq) const {
        const int row0 = u.pm * BM + wr * 64 + fr, col0 = u.pn * BM + wc * 32 + 8 * fq;
#pragma unroll
        for (int ai = 0; ai < 2; ++ai)
#pragma unroll
            for (int m = 0; m < 4; ++m) { if (u.half && ai != u.half - 1) continue;
                const int row = row0 + ai * HALF + m * 16;
#pragma unroll
                for (int bj = 0; bj < 2; ++bj) {
                    const f32x4 v0 = acc[ai][bj][m][0], v1 = acc[ai][bj][m][1];
                    u32x4 w; w.x = cvt_pk_bf16(v0[0], v0[1]); w.y = cvt_pk_bf16(v0[2], v0[3]); w.z = cvt_pk_bf16(v1[0], v1[1]); w.w = cvt_pk_bf16(v1[2], v1[3]);
                    st16_out<5>(y + (size_t)row * D + col0 + bj * HALF, w);
                }
            }
    }
};

struct SchedGrid {
    static constexpr bool GATHER = false;
    const char* A; const char* B; size_t a_tile, b_tile, a_alt; int nM, nN, G, c, alt_from; long long a_hi = 0;
    int split_from = 1 << 30;
    __device__ __forceinline__ bool next(int i, Unit& u) const {
        int L = i * G + c, hf = 0;
        if (L >= split_from) { const int nl = nM * nN - split_from, j = L - split_from; if (j >= 2 * nl) return false; hf = 1 + j / nl; L = split_from + j % nl; }
        if (L >= nM * nN) return false;
        int pm, pn; tile_map(L, nM, nN, pm, pn);
        u.pm = pm; u.pn = pn; u.kind = 0; u.half = hf; u.a = A + (size_t)pm * a_tile + (pn >= alt_from ? a_alt : 0) + (pm >= 32 ? a_hi : 0); u.b = B + (size_t)pn * b_tile; return true;
    }
};
struct SchedMerge {
    static constexpr bool GATHER = false;
    const char* acts; const char* wbr; int G, c;
    __device__ __forceinline__ bool next(int i, Unit& u) const {
        const int ti = i / 3, n = i - ti * 3, L = ti * G + c; if (L >= 256) return false;
        int pm, pn; tile_map(L, 64, 4, pm, pn);
        u.pm = pm; u.pn = pn; u.kind = n; u.half = 0; u.a = acts + ((long long)A_YSA + (long long)(n == 1) * ((long long)A_YSB - (long long)A_YSA) + (long long)(n == 2) * ((long long)A_POOLED - (long long)A_YSA)) + (size_t)pm * (256 * 512 * 2); u.b = wbr + (size_t)n * (1024 * 512 * 2) + (size_t)pn * (256 * 512 * 2); return true;
    }
};
template <bool GATHER_> struct SchedMoeT {
    static constexpr bool GATHER = GATHER_;
    const int* rowmap = nullptr;
    const char* A; const char* B; size_t a_tile, b_tile, b_exp; int MT, nN, G, c; int t1, t2, t3, t4, t5, t6, t7;
    int split_from = 1 << 30;
    __device__ __forceinline__ bool next(int i, Unit& u) const {
        int L = i * G + c, hf = 0;
        if (L >= split_from) { const int nl = MT * nN - split_from, j = L - split_from; if (j >= 2 * nl) return false; hf = 1 + j / nl; L = split_from + j % nl; }
        if (L >= MT * nN) return false;
        int pm, pn; tile_map(L, MT, nN, pm, pn);
        const int e = (pm >= t1) + (pm >= t2) + (pm >= t3) + (pm >= t4) + (pm >= t5) + (pm >= t6) + (pm >= t7);
        u.pm = pm; u.pn = pn; u.kind = e; u.half = hf; u.a = A + (GATHER_ ? (size_t)0 : (size_t)pm * a_tile); u.b = B + (size_t)e * b_exp + (size_t)pn * b_tile; return true;
    }
};
typedef SchedMoeT<false> SchedMoe;
}

#define XB_TMO      128
#define XB_XCNT(j)  (256  + 64 * (j))
#define XB_XSUB(j)  (1280 + 64 * (j))
#define XB_XGEN(j)  (2304 + 64 * (j))
#define XB_TOP      3328
#define XB_TOPGEN   3392
#define XCD_BAR_WORDS 3456
#define XB_SPIN_CAP (1u << 18)
__device__ __forceinline__ unsigned xb_ld(unsigned* p)              { return __hip_atomic_load(p, __ATOMIC_RELAXED, __HIP_MEMORY_SCOPE_AGENT); }
__device__ __forceinline__ unsigned xb_add(unsigned* p, unsigned v) { return __hip_atomic_fetch_add(p, v, __ATOMIC_RELAXED, __HIP_MEMORY_SCOPE_AGENT); }
__device__ __forceinline__ unsigned xb_xcc_id() { return (unsigned)__builtin_amdgcn_s_getreg((3 << 11) | 20) & 0xFu; }
#define XB_SPIN(cond, bar) do { unsigned _sp = 0; while (cond) { __builtin_amdgcn_s_sleep(1); \
    if ((++_sp & 255u) == 0u) { if (xb_ld(&(bar)[XB_TMO])) break; if (_sp > XB_SPIN_CAP) { atomicAdd(&(bar)[XB_TMO], 1u); break; } } } } while (0)
struct XcdBarrier { unsigned* bar; unsigned x; volatile LAS unsigned* st; };
__device__ __forceinline__ XcdBarrier xcd_barrier_post(unsigned* bar, volatile LAS unsigned* st) {
    XcdBarrier b; b.bar = bar; b.x = xb_xcc_id(); b.st = st;
    if (threadIdx.x == 0) (void)xb_add(&bar[XB_XCNT(b.x)], 1u);
    return b;
}
__device__ __forceinline__ void xcd_barrier_complete(unsigned* bar, unsigned x, unsigned& nloc, unsigned& nx) {
    const unsigned G = gridDim.x * gridDim.y * gridDim.z;
    unsigned sum, cnt, mine, sp = 0u;
    for (;;) {
        sum = 0u; cnt = 0u; mine = 0u;
#pragma unroll
        for (unsigned j = 0; j < 16; ++j) { const unsigned c = xb_ld(&bar[XB_XCNT(j)]); sum += c; cnt += (c > 0u) ? 1u : 0u; mine = (j == x) ? c : mine; }
        if (sum == G) break;
        __builtin_amdgcn_s_sleep(1);
        if ((++sp & 255u) == 0u) { if (xb_ld(&bar[XB_TMO])) break; if (sp > XB_SPIN_CAP) { atomicAdd(&bar[XB_TMO], 1u); break; } }
    }
    nloc = mine > 0u ? mine : 1u; nx = cnt > 0u ? cnt : 1u;
}
__device__ __forceinline__ void xcd_barrier_protocol(const XcdBarrier& b);
__device__ __forceinline__ void xcd_barrier(const XcdBarrier& b) {
    asm volatile("s_waitcnt vmcnt(0)" ::: "memory");
    __syncthreads();
    xcd_barrier_protocol(b);
    __syncthreads();
}
__device__ __forceinline__ void xcd_barrier_protocol(const XcdBarrier& b) {
    if (threadIdx.x == 0) {
        unsigned* bar = b.bar;
        __builtin_amdgcn_s_waitcnt(0);
        unsigned nloc = b.st[0], nx = b.st[1];
        if (nloc == 0u) { xcd_barrier_complete(bar, b.x, nloc, nx); b.st[0] = nloc; b.st[1] = nx; }
        const unsigned old = xb_add(&bar[XB_XSUB(b.x)], 1u);
        const unsigned gen = old / nloc;
        if (old + 1u == (gen + 1u) * nloc) {
            __builtin_amdgcn_fence(__ATOMIC_RELEASE, "agent");
            asm volatile("s_waitcnt vmcnt(0)" ::: "memory");
            const unsigned og = xb_add(&bar[XB_TOP], 1u);
            const unsigned tg = og / nx;
            if (og + 1u == (tg + 1u) * nx) xb_add(&bar[XB_TOPGEN], 1u);
            else XB_SPIN(xb_ld(&bar[XB_TOPGEN]) == tg, bar);
            __builtin_amdgcn_fence(__ATOMIC_ACQUIRE, "agent");
            xb_add(&bar[XB_XGEN(b.x)], 1u);
            asm volatile("s_waitcnt vmcnt(0)" ::: "memory");
        } else {
            XB_SPIN(xb_ld(&bar[XB_XGEN(b.x)]) == gen, bar);
            __builtin_amdgcn_fence(__ATOMIC_ACQUIRE, "agent");
            asm volatile("s_waitcnt vmcnt(0)" ::: "memory");
        }
    }
}

struct Frame {
    LAS unsigned char* lds;
    volatile LAS unsigned* MISC;
    unsigned* ctl; float* ctlf; float* stats;
    unsigned char* ws;
    int tid, lane, wave, vcu, G;
    const CAS GPtr* inp;
    float* out;
    __device__ __forceinline__ const float* in(int i) const { return (const float*)inp[i]; }
};
enum { I_X = 0, I_POS, I_GMIX, I_WIN, I_GCQ, I_WUQ, I_GCKV, I_WUKV, I_GQKQ, I_GQKK, I_WGLA, I_BGLA, I_GGLAO, I_WPOOL, I_PSCALE, I_WBR, I_WOUT, I_GFFN, I_WFG, I_WFU, I_WFD, I_WROUTER, I_WEG, I_WEU, I_WED };

__device__ __forceinline__ bf16_t* act_ptr(const Frame& F, size_t off) { return (bf16_t*)(F.ws + WS_ACTS + off); }
__device__ __forceinline__ unsigned char* wblk(const Frame& F, int layer) { return F.ws + (layer == 0 ? WS_W0 : WS_W1); }

__device__ __forceinline__ void fill_rs(Frame& F, const float* rowss, int pm) {
    if (F.tid < 256) ((LAS float*)(F.lds + RS_OFF))[F.tid] = rsqrtf(sum16(rowss + ((size_t)pm * 256 + F.tid) * 16) * (1.f / 1024.f) + EPS);
    __syncthreads();
}
struct ConvSeg { const float* src; int ld, K, width, col0; bf16_t* dst; int row0, inter; const float* gain; int fp8 = 0; };
typedef short v4i16c_t __attribute__((ext_vector_type(4)));
__device__ __forceinline__ float bfs16(short u) { return __uint_as_float((unsigned)(unsigned short)u << 16); }
__device__ __forceinline__ int seg_items(const ConvSeg& s) { return (s.K >> 6) * ((s.width + 63) >> 6); }
__device__ __forceinline__ void conv_load(const ConvSeg& s, int item, int lane, f32x4 (&v)[16], float (&gv)[16]) {
    const int nblk = (s.width + 63) >> 6, kb = item / nblk, nb = item - kb * nblk, k0 = kb * 64, n0 = nb * 64;
    const int kq = lane >> 4, n4 = (lane & 15) * 4; const bool ok = n0 + n4 < s.width;
    const float* p = s.src + (size_t)(k0 + kq) * s.ld + s.col0 + n0 + n4;
#pragma unroll
    for (int i = 0; i < 16; ++i) v[i] = ok ? __builtin_nontemporal_load((const f32x4*)(p + (size_t)(4 * i) * s.ld)) : (f32x4){0.f, 0.f, 0.f, 0.f};
    const bool hg = s.gain != nullptr; const float* gp = hg ? s.gain + k0 + kq : s.src;
#pragma unroll
    for (int i = 0; i < 16; ++i) { const float g = gp[hg ? 4 * i : 0]; gv[i] = hg ? g : 1.f; }
}
__device__ __forceinline__ void conv_store(const ConvSeg& s, int item, LAS unsigned char* scr, int lane, const f32x4 (&v)[16], const float (&gv)[16]) {
    const int nblk = (s.width + 63) >> 6, kb = item / nblk, nb = item - kb * nblk, k0 = kb * 64, n0 = nb * 64;
    const int kq = lane >> 4, n4 = (lane & 15) * 4;
#pragma unroll
    for (int i = 0; i < 16; ++i) {
        const f32x4 x = v[i] * gv[i];
        *(LAS u32x2*)(scr + (4 * i + kq) * 136 + n4 * 2) = (u32x2){cvt_pk_bf16(x[0], x[1]), cvt_pk_bf16(x[2], x[3])};
    }
    LDS_WAIT();
    const int g = lane >> 4, i16 = lane & 15;
#pragma unroll
    for (int nb16 = 0; nb16 < 4; ++nb16)
#pragma unroll
        for (int kh = 0; kh < 2; ++kh) {
            const int c = kh * 4 + g;
            const LAS unsigned char* a = scr + (8 * c + (i16 >> 2)) * 136 + (nb16 * 16 + (i16 & 3) * 4) * 2;
            const v4i16c_t lo = __builtin_amdgcn_ds_read_tr16_b64_v4i16((LAS v4i16c_t*)a), hi = __builtin_amdgcn_ds_read_tr16_b64_v4i16((LAS v4i16c_t*)(a + 4 * 136));
            const int nq = n0 + nb16 * 16 + i16;
            if (nq < s.width) {
                const int drow = s.row0 + (s.inter ? ((nq >> 7) * 256 + (nq & 127)) : nq);
                typedef short s16x8_t __attribute__((ext_vector_type(8)));
                if (s.fp8) *(u32x2*)((unsigned char*)s.dst + (size_t)drow * (s.fp8 == 2 ? KD8 : s.K) + k0 + 8 * c) = pack_fp8x8(bfs16(lo[0]) * FP8_WSC, bfs16(lo[1]) * FP8_WSC, bfs16(lo[2]) * FP8_WSC, bfs16(lo[3]) * FP8_WSC,
                                                                                                             bfs16(hi[0]) * FP8_WSC, bfs16(hi[1]) * FP8_WSC, bfs16(hi[2]) * FP8_WSC, bfs16(hi[3]) * FP8_WSC);
                else
                *(s16x8_t*)(s.dst + (size_t)drow * s.K + k0 + 8 * c) = (s16x8_t){lo[0], lo[1], lo[2], lo[3], hi[0], hi[1], hi[2], hi[3]};
            }
        }
    LDS_WAIT();
}
__device__ __forceinline__ ConvSeg mixer_seg(const Frame& F, int l, int idx) {
    unsigned char* wb = wblk(F, l);
    ConvSeg s; s.inter = 0; s.row0 = 0; s.col0 = 0;
    if (idx < 10) {
        int c0, wd, r0;
        switch (idx) {
            case 0: c0 = 0; wd = 256; r0 = 0; break;
            case 1: c0 = 256; wd = 256; r0 = 256; break;
            case 2: c0 = 544; wd = 256; r0 = 512; break;
            case 3: c0 = 800; wd = 256; r0 = 768; break;
            case 4: c0 = 1056; wd = 512; r0 = 1024; break;
            case 5: c0 = 1584; wd = 512; r0 = 1536; break;
            case 6: c0 = 2096; wd = 512; r0 = 2048; break;
            case 7: c0 = 512; wd = 32; r0 = 2560; break;
            case 8: c0 = 1568; wd = 16; r0 = 2592; break;
            default: c0 = 2608; wd = 3072; r0 = 0; break;
        }
        s.src = F.in(I_WIN) + (size_t)l * D * DIN; s.ld = DIN; s.K = D; s.width = wd; s.col0 = c0;
        s.dst = (bf16_t*)(wb + (idx == 9 ? WO_G : WO_IN)); s.row0 = r0; s.gain = F.in(I_GMIX) + l * D; if (idx == 9) s.fp8 = FP8_E; else if (l == 1) s.fp8 = (FP8_A && FP8_E) ? 1 : 0;
    } else if (idx == 10) { s.src = F.in(I_WUQ) + (size_t)l * 256 * 768; s.ld = 768; s.K = 256; s.width = 768; s.dst = (bf16_t*)(wb + WO_UP); s.gain = F.in(I_GCQ) + l * 256; }
    else if (idx == 11) { s.src = F.in(I_WUKV) + (size_t)l * 256 * 1024; s.ld = 1024; s.K = 256; s.width = 1024; s.dst = (bf16_t*)(wb + WO_UP); s.row0 = 768; s.gain = F.in(I_GCKV) + l * 256; }
    else if (idx < 14) { const int n = idx - 12; s.src = F.in(I_WBR) + (size_t)(l * 3 + n) * 512 * D; s.ld = D; s.K = 512; s.width = D; s.dst = (bf16_t*)(wb + WO_BR) + (size_t)n * 1024 * 512; s.gain = nullptr; }
    else { s.src = F.in(I_WOUT) + (size_t)l * D * D; s.ld = D; s.K = D; s.width = D; s.dst = (bf16_t*)(wb + WO_OUT); s.gain = nullptr; }
    return s;
}
__device__ __forceinline__ ConvSeg ffn_seg(const Frame& F, int idx) {
    unsigned char* wb = F.ws + WS_W0; ConvSeg s; s.col0 = 0; s.inter = 0; s.row0 = 0;
    if (idx < 2) { s.src = F.in(idx == 0 ? I_WFG : I_WFU); s.ld = DFF; s.K = D; s.width = DFF; s.dst = (bf16_t*)(wb + WO_FGU); s.row0 = idx * 128; s.inter = 1; s.gain = F.in(I_GFFN); s.fp8 = FP8_G; }
    else { s.src = F.in(I_WFD); s.ld = D; s.K = DFF; s.width = D; s.dst = (bf16_t*)(wb + WO_FD); s.gain = nullptr; s.fp8 = FP8_H; }
    return s;
}
__device__ __forceinline__ ConvSeg moe_seg(const Frame& F, int idx) {
    unsigned char* wb = F.ws + WS_W0; const int e = idx / 3, k = idx - e * 3; ConvSeg s; s.col0 = 0; s.inter = 0; s.row0 = 0;
    if (k < 2) { s.src = F.in(k == 0 ? I_WEG : I_WEU) + (size_t)e * D * DEXP; s.ld = DEXP; s.K = D; s.width = DEXP; s.dst = FP8_M ? (bf16_t*)(wb + WO_MGU + (size_t)e * 2816 * 1024) : (bf16_t*)(wb + WO_MGU) + (size_t)e * 2816 * 1024; s.row0 = k * 128; s.inter = 1; s.gain = F.in(I_GFFN) + D; s.fp8 = FP8_M; }
    else { s.src = F.in(I_WED) + (size_t)e * DEXP * D; s.ld = D; s.K = DEXP; s.width = D; s.dst = (bf16_t*)(wb + WO_MD) + (size_t)e * 1024 * 1408; s.gain = nullptr;
           if (FP8_D) { s.dst = (bf16_t*)(wb + WO_MD + (size_t)e * 1024 * KD8); s.fp8 = 2; } }
    return s;
}
#define CONV_LOCATE(NSEG, GETSEG, IT, SEGOUT, IDXOUT) do { int r_ = (IT); for (int si_ = 0; si_ < (NSEG); ++si_) { const ConvSeg sg_ = GETSEG; const int n_ = seg_items(sg_); SEGOUT = sg_; IDXOUT = r_; if (r_ < n_) break; r_ -= n_; } } while (0)
#define CONV_LOOP(NSEG, GETSEG) do { int total_ = 0; for (int si_ = 0; si_ < (NSEG); ++si_) { const ConvSeg sg_ = GETSEG; total_ += seg_items(sg_); } \
        int it_ = gw; if (it_ < total_) { ConvSeg cs_; int ci_ = 0; f32x4 va_[16]; float ga_[16]; CONV_LOCATE(NSEG, GETSEG, it_, cs_, ci_); conv_load(cs_, ci_, F.lane, va_, ga_); \
        for (;;) { const int nx_ = it_ + NGW; const bool hn_ = nx_ < total_; ConvSeg ns_; int ni_ = 0; f32x4 vb_[16]; float gb_[16]; CONV_LOCATE(NSEG, GETSEG, (hn_ ? nx_ : it_), ns_, ni_); conv_load(ns_, ni_, F.lane, vb_, gb_); \
            _Pragma("unroll") for (int q_ = 0; q_ < 16; ++q_) { asm volatile("" : "+v"(va_[q_])); asm volatile("" : "+v"(ga_[q_])); } \
            conv_store(cs_, ci_, (LAS unsigned char*)scr, F.lane, va_, ga_); if (!hn_) break; \
            _Pragma("unroll") for (int q_ = 0; q_ < 16; ++q_) { va_[q_] = vb_[q_]; ga_[q_] = gb_[q_]; } cs_ = ns_; ci_ = ni_; it_ = nx_; } } } while (0)
constexpr int BG_CUR_OFF = LDSCTL_OFF + 448;
#define BG_BODY(NSEG, GETSEG) do { int total_ = 0; for (int si_ = 0; si_ < (NSEG); ++si_) { const ConvSeg sg_ = GETSEG; total_ += seg_items(sg_); } \
        const int it_ = (bx * nw + (F.wave - 1)) + (int)cur[F.wave] * (F.G * nw); \
        if (it_ < total_) { ConvSeg cs_; int ci_ = 0; f32x4 va_[16]; float ga_[16]; CONV_LOCATE(NSEG, GETSEG, it_, cs_, ci_); conv_load(cs_, ci_, F.lane, va_, ga_); \
            conv_store(cs_, ci_, (LAS unsigned char*)(F.lds + F.wave * 16384), F.lane, va_, ga_); if (F.lane == 0) cur[F.wave] = cur[F.wave] + 1u; did = true; } } while (0)
__device__ __forceinline__ ConvSeg mixer_seg(const Frame& F, int l, int idx);
__device__ __forceinline__ ConvSeg ffn_seg(const Frame& F, int idx);
__device__ __forceinline__ ConvSeg moe_seg(const Frame& F, int idx);
__device__ __forceinline__ bool bg_step(Frame& F, int job, int bx) {
    const int nw = job <= 2 ? 4 : 7;
    if (F.wave > nw) return false;
    volatile LAS unsigned* cur = (volatile LAS unsigned*)(F.lds + BG_CUR_OFF);
    if (cur[8 + F.wave] != (unsigned)job) { if (F.lane == 0) { cur[F.wave] = 0u; cur[8 + F.wave] = (unsigned)job; } }
    bool did = false;
    if (job == 1) BG_BODY(22, (si_ < 4 ? mixer_seg(F, 0, si_ == 0 ? 9 : 11 + si_) : si_ < 7 ? ffn_seg(F, si_ - 4) : mixer_seg(F, 1, si_ - 7)));
    else if (job == 2) BG_BODY((FP8_M ? 16 : 12), moe_seg(F, (si_ >> 1) * 3 + (si_ & 1)));
    else if (job == 3) BG_BODY(4, moe_seg(F, (6 + (si_ >> 1)) * 3 + (si_ & 1)));
    else if (job == 4) BG_BODY(8, moe_seg(F, si_ * 3 + 2));
    return did;
}
__device__ __forceinline__ void bg_finish(Frame& F, int job, int bx) { if (F.wave > 0) { while (bg_step(F, job, bx)) {} } }
__device__ __forceinline__ void fold_pool(const Frame& F, int l, int gw, int NGW) {
    const float* wp = F.in(I_WPOOL) + (size_t)l * 4 * 128 * 128; const float* ps = F.in(I_PSCALE) + l * 512; const float* wb2 = F.in(I_WBR) + (size_t)(l * 3 + 2) * 512 * D;
    bf16_t* dst = (bf16_t*)(wblk(F, l) + WO_BR) + (size_t)2 * 1024 * 512;
    LAS float* sw = (LAS float*)(F.lds + F.wave * 16384);
    for (int it = gw; it < 1024; it += NGW) {
        const int db = it & 15, g = (it >> 4) & 3, cb = it >> 6, d = db * 64 + F.lane, c0 = cb * 8;
        {
            const float* wrow = wp + (size_t)(g * 128 + c0) * 128 + F.lane * 16;
            const f32x4 r0 = *(const f32x4*)wrow, r1 = *(const f32x4*)(wrow + 4), r2 = *(const f32x4*)(wrow + 8), r3 = *(const f32x4*)(wrow + 12);
            const float p0 = ps[g * 128 + 2 * F.lane], p1 = ps[g * 128 + 2 * F.lane + 1];
            LAS f32x4* o = (LAS f32x4*)(sw + F.lane * 16); o[0] = r0; o[1] = r1; o[2] = r2; o[3] = r3;
            sw[1024 + 2 * F.lane] = p0; sw[1024 + 2 * F.lane + 1] = p1;
        }
        LDS_WAIT();
        float a[8];
#pragma unroll
        for (int i = 0; i < 8; ++i) a[i] = 0.f;
#pragma unroll 1
        for (int j0 = 0; j0 < 128; j0 += 16) {
            float wv[16];
#pragma unroll
            for (int jj = 0; jj < 16; ++jj) wv[jj] = wb2[(size_t)(g * 128 + j0 + jj) * D + d];
#pragma unroll
            for (int jj = 0; jj < 16; ++jj) asm volatile("" : "+v"(wv[jj]));
#pragma unroll
            for (int j4 = 0; j4 < 16; j4 += 4) {
                const f32x4 sc = *(const LAS f32x4*)(sw + 1024 + j0 + j4);
                f32x4 w4;
#pragma unroll
                for (int e = 0; e < 4; ++e) w4[e] = wv[j4 + e] * sc[e];
#pragma unroll
                for (int i = 0; i < 8; ++i) {
                    const f32x4 pr = *(const LAS f32x4*)(sw + i * 128 + j0 + j4);
#pragma unroll
                    for (int e = 0; e < 4; ++e) a[i] = fmaf(pr[e], w4[e], a[i]);
                }
            }
        }
        u32x4 o; o.x = cvt_pk_bf16(a[0], a[1]); o.y = cvt_pk_bf16(a[2], a[3]); o.z = cvt_pk_bf16(a[4], a[5]); o.w = cvt_pk_bf16(a[6], a[7]);
        *(u32x4*)(dst + (size_t)d * 512 + g * 128 + c0) = o;
        LDS_WAIT();
    }
}

__device__ __forceinline__ void p0_prologue(Frame& F) {
    LAS float* scr = (LAS float*)(F.lds + F.wave * 16384);
    const int gw = F.vcu * 8 + F.wave, NGW = F.G * 8;
    { bf16_t* xb = (bf16_t*)(F.ws + WS_XB); float* rss = F.stats + SF_ROWSS;
      for (int m0 = gw; m0 < T; m0 += 4 * NGW) {
          f32x4 v[4][4];
#pragma unroll
          for (int r = 0; r < 4; ++r) { const int m = m0 + r * NGW < T ? m0 + r * NGW : m0; const f32x4* xr = (const f32x4*)(F.in(I_X) + (size_t)m * D) + F.lane;
#pragma unroll
              for (int j = 0; j < 4; ++j) v[r][j] = __builtin_nontemporal_load(xr + 64 * j); }
#pragma unroll
          for (int r = 0; r < 4; ++r)
#pragma unroll
              for (int j = 0; j < 4; ++j) asm volatile("" : "+v"(v[r][j]));
#pragma unroll
          for (int r = 0; r < 4; ++r) { const int m = m0 + r * NGW; if (m >= T) break; float s = 0.f;
              unsigned long long* o8 = (unsigned long long*)(xb + (size_t)m * D) + F.lane;
#pragma unroll
              for (int j = 0; j < 4; ++j) { const f32x4 w = v[r][j]; s += (w[0] * w[0] + w[1] * w[1]) + (w[2] * w[2] + w[3] * w[3]);
                  o8[64 * j] = (unsigned long long)cvt_pk_bf16(w[0], w[1]) | ((unsigned long long)cvt_pk_bf16(w[2], w[3]) << 32);
                  if (FP8_E) { int q8 = 0; q8 = __builtin_amdgcn_cvt_pk_fp8_f32(w[0], w[1], q8, false); q8 = __builtin_amdgcn_cvt_pk_fp8_f32(w[2], w[3], q8, true); ((int*)((unsigned char*)F.out + (size_t)m * D))[64 * j + F.lane] = q8; } }
              s = wave_sum_dpp(s); if (F.lane < 16) rss[(size_t)m * 16 + F.lane] = (F.lane == 0) ? s : 0.f; }
      } }
    { float* rt = (float*)(F.ws + WS_ROPE); const int* pos = (const int*)F.in(I_POS);
      for (int i = F.vcu * 512 + F.tid; i < T * 16; i += F.G * 512) {
          const int t = i >> 4, k = i & 15; const float inv = powf(10000.f, -(float)k / 16.f), ang = (float)pos[t] * inv;
          rt[t * 32 + k] = cosf(ang); rt[t * 32 + 16 + k] = sinf(ang);
      } }
    if (F.G == 256) { CONV_LOOP(11, mixer_seg(F, 0, si_ < 9 ? si_ : si_ + 1)); }
    else { CONV_LOOP(15, mixer_seg(F, 0, si_)); }
    fold_pool(F, 0, gw, NGW);
}

__device__ __forceinline__ void gla_prep(Frame& F, int l, int unit);
__device__ __forceinline__ void phase_prep(Frame& F, int l, int rpt = 0) {
    const bf16_t* raw = act_ptr(F, A_QKVRAW); const bf16_t* misc = act_ptr(F, A_MISC);
    bf16_t* QH = act_ptr(F, A_QH); bf16_t* KH = act_ptr(F, A_KH); bf16_t* VT = act_ptr(F, A_VT);
    const float* rope = (const float*)(F.ws + WS_ROPE);
    const float* gq = F.in(I_GQKQ) + l * 96; const float* gk = F.in(I_GQKK) + l * 96;
    LAS bf16_t* vt = (LAS bf16_t*)F.lds;
    LAS float* gls = (LAS float*)(F.lds + 81920);
    if (F.tid < 192) gls[F.tid] = F.tid < 96 ? gq[F.tid] : gk[F.tid - 96];
    __syncthreads();
    for (int unit = F.vcu; unit < T / 64; unit += F.G) {
        const int t0 = unit * 64, b = t0 / SEQ, s0 = t0 % SEQ;
        if (!rpt) gla_prep(F, l, unit);
        {
            const int it = F.tid; constexpr int which = 1; const int h = it & 7, tok = it >> 3, t = t0 + tok;
            const bf16_t* nope = raw + (size_t)t * 1792 + (which ? 768 + h * 128 : h * 96);
            const bf16_t* rp = which ? misc + (size_t)t * 256 : nope + 64;
            const LAS float* g = gls + which * 96;
            u32x4 c[12];
#pragma unroll
            for (int i = 0; i < 8; ++i) c[i] = *(const u32x4*)(nope + 8 * i);
#pragma unroll
            for (int i = 0; i < 4; ++i) c[8 + i] = *(const u32x4*)(rp + 8 * i);
            float ss = 0.f;
#pragma unroll
            for (int i = 0; i < 12; ++i) {
                const float a0 = bflo(c[i].x), a1 = bfhi(c[i].x), a2 = bflo(c[i].y), a3 = bfhi(c[i].y), a4 = bflo(c[i].z), a5 = bfhi(c[i].z), a6 = bflo(c[i].w), a7 = bfhi(c[i].w);
                ss += (a0 * a0 + a1 * a1) + (a2 * a2 + a3 * a3) + (a4 * a4 + a5 * a5) + (a6 * a6 + a7 * a7);
            }
            float r = rsqrtf(ss * (1.f / 96.f) + EPS);
            if (!which) r *= 0.14724444f;
            bf16_t* dst = (which ? KH : QH) + ((size_t)(b * 8 + h) * SEQ + s0 + tok) * 96;
#pragma unroll
            for (int i = 0; i < 8; ++i) {
                if ((i & 1) == 0) __builtin_amdgcn_sched_barrier(0);
                const f32x4 g0 = *(const LAS f32x4*)(g + 8 * i), g1 = *(const LAS f32x4*)(g + 8 * i + 4);
                u32x4 o; o.x = cvt_pk_bf16(bflo(c[i].x) * r * g0[0], bfhi(c[i].x) * r * g0[1]); o.y = cvt_pk_bf16(bflo(c[i].y) * r * g0[2], bfhi(c[i].y) * r * g0[3]);
                o.z = cvt_pk_bf16(bflo(c[i].z) * r * g1[0], bfhi(c[i].z) * r * g1[1]); o.w = cvt_pk_bf16(bflo(c[i].w) * r * g1[2], bfhi(c[i].w) * r * g1[3]);
                *(u32x4*)(dst + 8 * i) = o;
            }
#pragma unroll
            for (int hh = 0; hh < 2; ++hh) {
                const u32x4 x1c = c[8 + hh], x2c = c[10 + hh];
                float x1[8] = {bflo(x1c.x), bfhi(x1c.x), bflo(x1c.y), bfhi(x1c.y), bflo(x1c.z), bfhi(x1c.z), bflo(x1c.w), bfhi(x1c.w)};
                float x2[8] = {bflo(x2c.x), bfhi(x2c.x), bflo(x2c.y), bfhi(x2c.y), bflo(x2c.z), bfhi(x2c.z), bflo(x2c.w), bfhi(x2c.w)};
                float o1[8], o2[8];
#pragma unroll
                for (int i = 0; i < 8; ++i) {
                    const int k = hh * 8 + i; const float cs = rope[(size_t)t * 32 + k], sn = rope[(size_t)t * 32 + 16 + k];
                    const float a = x1[i] * r * g[64 + k], bb = x2[i] * r * g[80 + k];
                    o1[i] = a * cs - bb * sn; o2[i] = bb * cs + a * sn;
                }
                u32x4 w1, w2; w1.x = cvt_pk_bf16(o1[0], o1[1]); w1.y = cvt_pk_bf16(o1[2], o1[3]); w1.z = cvt_pk_bf16(o1[4], o1[5]); w1.w = cvt_pk_bf16(o1[6], o1[7]);
                w2.x = cvt_pk_bf16(o2[0], o2[1]); w2.y = cvt_pk_bf16(o2[2], o2[3]); w2.z = cvt_pk_bf16(o2[4], o2[5]); w2.w = cvt_pk_bf16(o2[6], o2[7]);
                *(u32x4*)(dst + 64 + hh * 8) = w1; *(u32x4*)(dst + 80 + hh * 8) = w2;
            }
        }
        {
            const int tok = F.tid >> 3, cc = F.tid & 7;
            u32x4 vr[8];
#pragma unroll
            for (int h = 0; h < 8; ++h) vr[h] = *(const u32x4*)(raw + (size_t)(t0 + tok) * 1792 + 768 + h * 128 + 64 + cc * 8);
#pragma unroll
            for (int h = 0; h < 8; ++h) *(LAS u32x4*)(F.lds + h * 9216 + tok * 144 + cc * 16) = vr[h];
            __syncthreads();
            const int db = F.wave & 3, c = (F.wave >> 2) * 4 + (F.lane >> 4), i16 = F.lane & 15;
#pragma unroll
            for (int h = 0; h < 8; ++h) {
                const LAS unsigned char* a = F.lds + h * 9216 + (8 * c + (i16 >> 2)) * 144 + (16 * db + (i16 & 3) * 4) * 2;
                const v4i16c_t lo = __builtin_amdgcn_ds_read_tr16_b64_v4i16((LAS v4i16c_t*)a), hi = __builtin_amdgcn_ds_read_tr16_b64_v4i16((LAS v4i16c_t*)(a + 4 * 144));
                typedef short s16x8_t __attribute__((ext_vector_type(8)));
                bf16_t* vrow = VT + (((size_t)(b * 8 + h) * (SEQ / 64) + (s0 >> 6)) * 64 + 16 * db + i16) * 64;
                *(v4i16c_t*)(vrow + 4 * c) = lo; *(v4i16c_t*)(vrow + 32 + 4 * c) = hi;
            }
            __syncthreads();
        }
    }
}

constexpr int AT_KROW = 208, AT_KT = 64 * AT_KROW, AT_VROW = 144, AT_VTB = 64 * AT_VROW, AT_SLOT = AT_KT + AT_VTB, AT_NSLOT = 5, AT_DUMMY = AT_NSLOT * AT_SLOT;
static_assert(AT_KT == 13 * 1024 && AT_VTB == 9 * 1024 && AT_DUMMY + 8 * 1024 <= RING_BYTES, "attention ring");
#ifdef AT_TPROBE
#define TP_B(k) do { if (AT_TPROBE == (k)) tp0 = __builtin_readcyclecounter(); } while (0)
#define TP_E(k) do { if (AT_TPROBE == (k)) tpacc += __builtin_readcyclecounter() - tp0; } while (0)
#else
#define TP_B(k) do {} while (0)
#define TP_E(k) do {} while (0)
#endif
__device__ __forceinline__ void attn_unit(Frame& F, int l, int bh, int qb, unsigned long long& tpacc) {
#ifdef AT_TPROBE
    unsigned long long tp0 = 0;
#endif
    TP_B(0);
    const int lane = F.lane, wid = F.wave, r32 = lane & 31, hi = lane >> 5, grp = wid >> 2;

    const char* Kb = (const char*)(act_ptr(F, A_KH) + (size_t)bh * SEQ * 96);
    const char* Vb = (const char*)(act_ptr(F, A_VT) + (size_t)bh * 64 * SEQ);
    LAS unsigned char* lds = F.lds;
    bf16x8 qr[6];
    {
        const size_t trow = (size_t)(bh >> 3) * SEQ + qb * 256 + wid * 32 + r32;
        const bf16_t* qraw = act_ptr(F, A_QH) + trow * 768 + (bh & 7) * 96 + 8 * hi;
        const float* gq = F.in(I_GQKQ) + l * 96 + 8 * hi; const float* rp = (const float*)(F.ws + WS_ROPE) + trow * 32 + 8 * hi;
        u32x4 qx[6]; f32x4 gv[12], cs[2], sn[2];
#pragma unroll
        for (int s = 0; s < 6; ++s) { qx[s] = *(const u32x4*)(qraw + 16 * s); gv[2 * s] = *(const f32x4*)(gq + 16 * s); gv[2 * s + 1] = *(const f32x4*)(gq + 16 * s + 4); }
        cs[0] = *(const f32x4*)rp; cs[1] = *(const f32x4*)(rp + 4); sn[0] = *(const f32x4*)(rp + 16); sn[1] = *(const f32x4*)(rp + 20);
        float xv[6][8]; float ss = 0.f;
#pragma unroll
        for (int s = 0; s < 6; ++s) {
            xv[s][0] = bflo(qx[s].x); xv[s][1] = bfhi(qx[s].x); xv[s][2] = bflo(qx[s].y); xv[s][3] = bfhi(qx[s].y); xv[s][4] = bflo(qx[s].z); xv[s][5] = bfhi(qx[s].z); xv[s][6] = bflo(qx[s].w); xv[s][7] = bfhi(qx[s].w);
            ss += ((xv[s][0] * xv[s][0] + xv[s][1] * xv[s][1]) + (xv[s][2] * xv[s][2] + xv[s][3] * xv[s][3])) + ((xv[s][4] * xv[s][4] + xv[s][5] * xv[s][5]) + (xv[s][6] * xv[s][6] + xv[s][7] * xv[s][7]));
        }
        { const u32x2 sw = __builtin_amdgcn_permlane32_swap(__float_as_uint(ss), __float_as_uint(ss), false, false); ss = __uint_as_float(sw.x) + __uint_as_float(sw.y); }
        const float r = rsqrtf(ss * (1.f / 96.f) + EPS) * 0.14724444f;
#pragma unroll
        for (int s = 0; s < 4; ++s) {
            float y[8];
#pragma unroll
            for (int j = 0; j < 8; ++j) y[j] = xv[s][j] * r * gv[2 * s + (j >> 2)][j & 3];
            qr[s] = __builtin_bit_cast(bf16x8, (u32x4){cvt_pk_bf16(y[0], y[1]), cvt_pk_bf16(y[2], y[3]), cvt_pk_bf16(y[4], y[5]), cvt_pk_bf16(y[6], y[7])});
        }
        float o1[8], o2[8];
#pragma unroll
        for (int j = 0; j < 8; ++j) {
            const float a = xv[4][j] * r * gv[8 + (j >> 2)][j & 3], bb = xv[5][j] * r * gv[10 + (j >> 2)][j & 3], c_ = cs[j >> 2][j & 3], s_ = sn[j >> 2][j & 3];
            o1[j] = a * c_ - bb * s_; o2[j] = bb * c_ + a * s_;
        }
        qr[4] = __builtin_bit_cast(bf16x8, (u32x4){cvt_pk_bf16(o1[0], o1[1]), cvt_pk_bf16(o1[2], o1[3]), cvt_pk_bf16(o1[4], o1[5]), cvt_pk_bf16(o1[6], o1[7])});
        qr[5] = __builtin_bit_cast(bf16x8, (u32x4){cvt_pk_bf16(o2[0], o2[1]), cvt_pk_bf16(o2[2], o2[3]), cvt_pk_bf16(o2[4], o2[5]), cvt_pk_bf16(o2[6], o2[7])});
    }
    const int NT = 4 * (qb + 1);
    const char *dp0, *dp1, *dp2;
    { const int P = 64 * wid + lane, row = P / 13, col = P % 13; dp0 = Kb + row * 192 + (col == 12 ? 0 : col) * 16; }
    if (wid < 5) { const int P = 64 * (wid + 8) + lane, row = P / 13, col = P % 13; dp1 = Kb + row * 192 + (col == 12 ? 0 : col) * 16; }
    else { const int P = 64 * (wid - 5) + lane, d = P / 9, col = P % 9; dp1 = Vb + d * 128 + (col == 8 ? 0 : col) * 16; }
    { const int P = 64 * (wid + 3) + lane, d = (P / 9) & 63, col = P % 9; dp2 = Vb + d * 128 + (col == 8 ? 0 : col) * 16; }
    const unsigned st1 = wid < 5 ? 12288u : 8192u;
    const bool w3 = wid < 6;
#define AT_DMA_ONE(j, sl) do { const int sl_ = (sl); LAS unsigned char* d_ = lds + sl_ + wid * 1024; const int c1_ = sl_ == AT_DUMMY ? 0 : 8192; \
        __builtin_amdgcn_global_load_lds((const unsigned*)(dp0 + (size_t)(j) * 12288), (LAS unsigned*)d_, 16, 0, 0); \
        __builtin_amdgcn_global_load_lds((const unsigned*)(dp1 + (size_t)(j) * st1), (LAS unsigned*)(d_ + c1_), 16, 0, 0); \
        if (w3) __builtin_amdgcn_global_load_lds((const unsigned*)(dp2 + (size_t)(j) * 8192), (LAS unsigned*)(d_ + 2 * c1_), 16, 0, 0); } while (0)
#ifdef AT_PROBE_DMA2
#define AT_DMA(j, sl) do { AT_DMA_ONE(j, sl); AT_DMA_ONE(j, sl); } while (0)
#define AT_WAIT2() do { if (w3) asm volatile("s_waitcnt vmcnt(12)" ::: "memory"); else asm volatile("s_waitcnt vmcnt(8)" ::: "memory"); } while (0)
#else
#define AT_DMA(j, sl) AT_DMA_ONE(j, sl)
#define AT_WAIT2() do { if (w3) asm volatile("s_waitcnt vmcnt(6)" ::: "memory"); else asm volatile("s_waitcnt vmcnt(4)" ::: "memory"); } while (0)
#endif
#define AT_WAIT1() do { if (w3) asm volatile("s_waitcnt vmcnt(3)" ::: "memory"); else asm volatile("s_waitcnt vmcnt(2)" ::: "memory"); } while (0)
#define AT_WAIT_NEXT(t) do { if ((t) + 3 < NT) AT_WAIT2(); else if ((t) + 3 == NT) AT_WAIT1(); else VM_WAIT(); } while (0)
    AT_DMA(0, 0); AT_DMA(1, AT_SLOT); AT_DMA(2, 2 * AT_SLOT); AT_DMA(3, 3 * AT_SLOT);
#ifdef AT_PROBE_DMA2
    if (w3) asm volatile("s_waitcnt vmcnt(18)" ::: "memory"); else asm volatile("s_waitcnt vmcnt(12)" ::: "memory");
#else
    if (w3) asm volatile("s_waitcnt vmcnt(9)" ::: "memory"); else asm volatile("s_waitcnt vmcnt(6)" ::: "memory");
#endif
    LDS_BARRIER();
    float m_run = 0.f, l_run = 0.f;
    f32x16 o0, o1, negm;
#pragma unroll
    for (int r = 0; r < 16; ++r) { o0[r] = 0.f; o1[r] = 0.f; negm[r] = 0.f; }
    const unsigned kfr = (unsigned)(r32 * AT_KROW + hi * 16), vfr = (unsigned)(AT_KT + r32 * AT_VROW + hi * 64);
    if (grp) LDS_BARRIER();
    int slot = 0, wslot = 4;
    const int NTw = 4 * qb + (wid >> 1) + 1;
    TP_B(1);
    for (int t = 0; t < NTw; ++t) {
        const int jb = t - 4 * qb;
        const LAS unsigned char* sb = lds + slot * AT_SLOT;
        f32x16 p0, p1;
        TP_B(2);
        {
            const LAS unsigned char* kb = sb + kfr;
            bf16x8 ka[6], kc[6];
#pragma unroll
            for (int s = 0; s < 6; ++s) { ka[s] = *(const LAS bf16x8*)(kb + s * 32); kc[s] = *(const LAS bf16x8*)(kb + 32 * AT_KROW + s * 32); }
            __builtin_amdgcn_sched_barrier(0);
            __builtin_amdgcn_s_setprio(1);
            p0 = __builtin_amdgcn_mfma_f32_32x32x16_bf16(ka[0], qr[0], negm, 0, 0, 0);
            p1 = __builtin_amdgcn_mfma_f32_32x32x16_bf16(kc[0], qr[0], negm, 0, 0, 0);
#pragma unroll
            for (int s = 1; s < 6; ++s) {
                p0 = __builtin_amdgcn_mfma_f32_32x32x16_bf16(ka[s], qr[s], p0, 0, 0, 0);
                p1 = __builtin_amdgcn_mfma_f32_32x32x16_bf16(kc[s], qr[s], p1, 0, 0, 0);
            }
            __builtin_amdgcn_s_setprio(0);
#ifdef AT_PROBE_SEG1X2
            asm volatile("" : "+v"(p0), "+v"(p1));
            p0 = __builtin_amdgcn_mfma_f32_32x32x16_bf16(ka[0], qr[0], negm, 0, 0, 0);
            p1 = __builtin_amdgcn_mfma_f32_32x32x16_bf16(kc[0], qr[0], negm, 0, 0, 0);
#pragma unroll
            for (int s = 1; s < 6; ++s) {
                p0 = __builtin_amdgcn_mfma_f32_32x32x16_bf16(ka[s], qr[s], p0, 0, 0, 0);
                p1 = __builtin_amdgcn_mfma_f32_32x32x16_bf16(kc[s], qr[s], p1, 0, 0, 0);
            }
#endif
            asm volatile("" : "+v"(p0), "+v"(p1));
        }
        TP_E(2);
        TP_B(3);
        AT_WAIT2();
        TP_E(3);
        TP_B(4);
        LDS_BARRIER();
        TP_E(4);
        AT_DMA(min(t + 4, NT - 1), t + 4 < NT ? wslot * AT_SLOT : AT_DUMMY);
        TP_B(5);
        {
            const LAS unsigned char* vb = sb + vfr;
            bf16x8 va[4], vc2[4];
#pragma unroll
            for (int s = 0; s < 4; ++s) { va[s] = *(const LAS bf16x8*)(vb + s * 16); vc2[s] = *(const LAS bf16x8*)(vb + 32 * AT_VROW + s * 16); }
            if (jb >= 0 && wid < 2 * jb + 2) {
                const int qrel = 32 * wid + r32, kb0 = 64 * jb + 4 * hi;
#pragma unroll
                for (int r = 0; r < 16; ++r) { const int kv = kb0 + (r & 3) + 8 * (r >> 2); if (kv > qrel) p0[r] = -INFINITY; if (kv + 32 > qrel) p1[r] = -INFINITY; }
            }
            float mxa = __builtin_elementwise_maximum(p0[0], p0[1]), mxb = __builtin_elementwise_maximum(p1[0], p1[1]);
#pragma unroll
            for (int r = 2; r < 16; r += 2) {
                mxa = __builtin_elementwise_maximum(__builtin_elementwise_maximum(mxa, p0[r]), p0[r + 1]);
                mxb = __builtin_elementwise_maximum(__builtin_elementwise_maximum(mxb, p1[r]), p1[r + 1]);
            }
            float mx = __builtin_elementwise_maximum(mxa, mxb);
            {
                const u32x2 sw = __builtin_amdgcn_permlane32_swap(__float_as_uint(mx), __float_as_uint(mx), false, false);
                mx = __builtin_elementwise_maximum(__uint_as_float(sw.x), __uint_as_float(sw.y));
            }
            if (t == 0 || !__all(mx <= 8.f)) {
                const float delta = t == 0 ? mx : fmaxf(mx, 0.f), alpha = t == 0 ? 1.f : __builtin_amdgcn_exp2f(-delta);
                m_run += delta; l_run *= alpha;
#pragma unroll
                for (int r = 0; r < 16; ++r) { o0[r] *= alpha; o1[r] *= alpha; p0[r] -= delta; p1[r] -= delta; negm[r] = -m_run; }
            }
            float ps = 0.f;
#pragma unroll
            for (int r = 0; r < 16; ++r) { p0[r] = __builtin_amdgcn_exp2f(p0[r]); p1[r] = __builtin_amdgcn_exp2f(p1[r]); ps += p0[r]; ps += p1[r]; }
            l_run += ps;
#pragma unroll
            for (int s = 0; s < 4; ++s) {
                u32x4 pw;
                if (s < 2) { pw.x = cvt_pk_bf16(p0[8 * s + 0], p0[8 * s + 1]); pw.y = cvt_pk_bf16(p0[8 * s + 2], p0[8 * s + 3]); pw.z = cvt_pk_bf16(p0[8 * s + 4], p0[8 * s + 5]); pw.w = cvt_pk_bf16(p0[8 * s + 6], p0[8 * s + 7]); }
                else { const int q = s - 2; pw.x = cvt_pk_bf16(p1[8 * q + 0], p1[8 * q + 1]); pw.y = cvt_pk_bf16(p1[8 * q + 2], p1[8 * q + 3]); pw.z = cvt_pk_bf16(p1[8 * q + 4], p1[8 * q + 5]); pw.w = cvt_pk_bf16(p1[8 * q + 6], p1[8 * q + 7]); }
                const bf16x8 pb = __builtin_bit_cast(bf16x8, pw);
                o0 = __builtin_amdgcn_mfma_f32_32x32x16_bf16(va[s], pb, o0, 0, 0, 0);
                o1 = __builtin_amdgcn_mfma_f32_32x32x16_bf16(vc2[s], pb, o1, 0, 0, 0);
            }
        }
        TP_E(5);
        TP_B(6);
        LDS_BARRIER();
        TP_E(6);
        slot = slot == AT_NSLOT - 1 ? 0 : slot + 1; wslot = wslot == AT_NSLOT - 1 ? 0 : wslot + 1;
    }
    TP_E(1);
    for (int t = NTw; t < NT; ++t) {
        AT_WAIT2();
        LDS_BARRIER();
        AT_DMA(min(t + 4, NT - 1), t + 4 < NT ? wslot * AT_SLOT : AT_DUMMY);
        LDS_BARRIER();
        wslot = wslot == AT_NSLOT - 1 ? 0 : wslot + 1;
    }
    if (!grp) LDS_BARRIER();
    VM_WAIT();
#undef AT_DMA
#undef AT_DMA_ONE
#undef AT_WAIT2
#undef AT_WAIT1
#undef AT_WAIT_NEXT
    l_run += __shfl_xor(l_run, 32);
    const float inv = 1.f / l_run;
    const int b = bh >> 3, h = bh & 7;
    bf16_t* orow = act_ptr(F, A_YSA) + ((size_t)b * SEQ + qb * 256 + wid * 32 + r32) * 512 + h * 64;
#pragma unroll
    for (int g = 0; g < 4; ++g) {
        u32x2 w0, w1;
        w0.x = cvt_pk_bf16(o0[4 * g] * inv, o0[4 * g + 1] * inv); w0.y = cvt_pk_bf16(o0[4 * g + 2] * inv, o0[4 * g + 3] * inv);
        w1.x = cvt_pk_bf16(o1[4 * g] * inv, o1[4 * g + 1] * inv); w1.y = cvt_pk_bf16(o1[4 * g + 2] * inv, o1[4 * g + 3] * inv);
#ifdef AT_WT_STORE
        asm volatile("global_store_dwordx2 %0, %1, off sc0 sc1" :: "v"(orow + 8 * g + 4 * hi), "v"(w0) : "memory");
        asm volatile("global_store_dwordx2 %0, %1, off sc0 sc1" :: "v"(orow + 32 + 8 * g + 4 * hi), "v"(w1) : "memory");
#else
        *(u32x2*)(orow + 8 * g + 4 * hi) = w0; *(u32x2*)(orow + 32 + 8 * g + 4 * hi) = w1;
#endif
    }
    TP_E(0);
}

__device__ __forceinline__ unsigned short f2bf1(float x) { return (unsigned short)(cvt_pk_bf16(x, 0.f) & 0xffffu); }
__device__ __forceinline__ void gla_prep(Frame& F, int l, int unit) {
    bf16_t* gqkv = act_ptr(F, A_GQKV); const bf16_t* misc = act_ptr(F, A_MISC); float* eb = F.stats + SF_EB;
    const int c = F.tid & 255, ch = unit * 2 + (F.tid >> 8);
    const float* wg = F.in(I_WGLA) + (size_t)l * 16 * 256 + c; const float bias = F.in(I_BGLA)[l * 256 + c];
    float wcol[16];
#pragma unroll
    for (int r = 0; r < 16; ++r) wcol[r] = wg[r * 256];
    float bc = 0.f;
    LAS unsigned char* lrs = F.lds + 90112;
    __syncthreads();
    if (F.tid < 128) *(LAS u32x4*)(lrs + F.tid * 16) = *(const u32x4*)(misc + ((size_t)unit * 64 + (F.tid >> 1)) * 256 + 32 + (F.tid & 1) * 8);
    __syncthreads();
#pragma unroll 1
    for (int i0 = 0; i0 < 32; i0 += 16) {
        unsigned qv[16], kv[16];
#pragma unroll
        for (int i = 0; i < 16; ++i) { const size_t t = (size_t)ch * 32 + i0 + i; qv[i] = *(const unsigned short*)(gqkv + t * 1024 + c); kv[i] = *(const unsigned short*)(gqkv + t * 1024 + c + 256); }
#pragma unroll
        for (int i = 0; i < 16; ++i) asm volatile("" : "+v"(qv[i]), "+v"(kv[i]));
#pragma unroll
        for (int i = 0; i < 16; ++i) {
            if ((i & 3) == 0) __builtin_amdgcn_sched_barrier(0);
            const u32x4 l0 = *(const LAS u32x4*)(lrs + ((F.tid >> 8) * 32 + i0 + i) * 32), l1 = *(const LAS u32x4*)(lrs + ((F.tid >> 8) * 32 + i0 + i) * 32 + 16);
            const float lr[16] = {bflo(l0.x), bfhi(l0.x), bflo(l0.y), bfhi(l0.y), bflo(l0.z), bfhi(l0.z), bflo(l0.w), bfhi(l0.w),
                                  bflo(l1.x), bfhi(l1.x), bflo(l1.y), bfhi(l1.y), bflo(l1.z), bfhi(l1.z), bflo(l1.w), bfhi(l1.w)};
            float z = bias;
#pragma unroll
            for (int r = 0; r < 16; ++r) z = fmaf(lr[r], wcol[r], z);
            const float zl = z * 1.4426950408889634f;
            const float sp = fmaxf(-zl, 0.f) + __log2f(1.f + __builtin_amdgcn_exp2f(-fabsf(zl)));
            bc -= sp * 0.0625f;
            const float eq = __builtin_amdgcn_exp2f(bc) * 0.125f, ek = __builtin_amdgcn_exp2f(-bc);
            qv[i] = f2bf1(__uint_as_float(qv[i] << 16) * eq);
            kv[i] = f2bf1(__uint_as_float(kv[i] << 16) * ek);
        }
#pragma unroll
        for (int i = 0; i < 16; ++i) { const size_t t = (size_t)ch * 32 + i0 + i; *(unsigned short*)(gqkv + t * 1024 + c) = (unsigned short)qv[i]; *(unsigned short*)(gqkv + t * 1024 + c + 256) = (unsigned short)kv[i]; }
    }
    eb[(size_t)ch * 256 + c] = __builtin_amdgcn_exp2f(bc);
}
typedef short v4i16_t __attribute__((ext_vector_type(4)));
__device__ __forceinline__ v4i16_t lds_tr16(const LAS unsigned char* p) { return __builtin_amdgcn_ds_read_tr16_b64_v4i16((LAS v4i16_t*)p); }
constexpr int GW_K = 0, GW_Q = 4608, GW_V = 9216, GW_BYTES = 10240;
__device__ __forceinline__ void gla_unit(Frame& F, int l, int unit) {
    const int half = unit & 1, h = (unit >> 1) & 3, b = unit >> 3;
    volatile LAS int* prog = (volatile LAS int*)(F.lds + 4 * GW_BYTES);
    if (F.wave >= 4) {
        const int pw = F.wave - 4, tok = F.lane & 31, li = (F.lane >> 5) + 2 * (pw & 1);
        const size_t lo_ = (li == 0) ? (size_t)h * 128 : (li == 1) ? (size_t)512 + h * 128 : (li == 2) ? (size_t)1024 + h * 256 + half * 128 : (size_t)1024 + h * 256 + half * 128 + 64;
        const unsigned char* base_ = (const unsigned char*)act_ptr(F, A_GQKV) + lo_;
        unsigned keep = 0u;
        for (int m = (pw >> 1); m < SEQ / 32; m += 2) {
            while (m > prog[0] + 8) __builtin_amdgcn_s_sleep(8);
            const unsigned char* pp = base_ + ((size_t)b * SEQ + (size_t)m * 32 + tok) * 2048;
            asm volatile("global_load_dword %0, %1, off" : "+v"(keep) : "v"(pp) : "memory");
        }
        asm volatile("s_waitcnt vmcnt(0)" : "+v"(keep) :: "memory");
        return;
    }
    const int lane = F.lane, w = half * 4 + F.wave, l15 = lane & 15, q4 = lane >> 4;
    const bf16_t* gqkv = act_ptr(F, A_GQKV); const float* ebg = F.stats + SF_EB;
    bf16_t* ysb = act_ptr(F, A_YSB);
    LAS unsigned char* wl = F.lds + F.wave * GW_BYTES;
    f32x4 S[4];
#pragma unroll
    for (int i = 0; i < 4; ++i) S[i] = (f32x4){0.f, 0.f, 0.f, 0.f};
    if (F.tid == 0) prog[0] = 0;
    constexpr int GW2 = 4 * GW_BYTES;
    u32x4 kimgX[4], qimgX[4], vimgX, kimgY[4], qimgY[4], vimgY; f32x4 ebvX[4], ebvY[4];
#define GLA_LOAD1(n_, KI, QI, VI, EBV) do { const size_t tb_ = (size_t)b * SEQ + (size_t)(n_) * 32; \
        _Pragma("unroll") for (int i = 0; i < 4; ++i) { const int p_ = lane + 64 * i; const bf16_t* r_ = gqkv + (tb_ + (p_ >> 3)) * 1024 + h * 64 + (p_ & 7) * 8; QI[i] = *(const u32x4*)r_; KI[i] = *(const u32x4*)(r_ + 256); } \
        VI = *(const u32x4*)(gqkv + (tb_ + (lane >> 1)) * 1024 + 512 + h * 128 + 16 * w + (lane & 1) * 8); \
        _Pragma("unroll") for (int db = 0; db < 4; ++db) EBV[db] = *(const f32x4*)(ebg + (tb_ >> 5) * 256 + h * 64 + 16 * db + 4 * q4); } while (0)
#define GLA_LOAD(n_) do { GLA_LOAD1((n_), kimgX, qimgX, vimgX, ebvX); GLA_LOAD1((n_) + 1, kimgY, qimgY, vimgY, ebvY); } while (0)
    bf16x8 pa0X, pa1X, vbnX, kanX[4], qpxX[2], qpyX[2], pa0Y, pa1Y, vbnY, kanY[4], qpxY[2], qpyY[2]; f32x4 o0pX, o1pX, e4X[4], o0pY, o1pY, e4Y[4];
#define GLA_IMG(WL, KI, QI, VI, EBV, E4) do { \
        _Pragma("unroll") for (int i = 0; i < 4; ++i) { asm volatile("" : "+v"(KI[i]), "+v"(QI[i]), "+v"(EBV[i])); } \
        asm volatile("" : "+v"(VI)); \
        _Pragma("unroll") for (int i = 0; i < 4; ++i) { const int p_ = lane + 64 * i; *(LAS u32x4*)((WL) + GW_K + (p_ >> 3) * 144 + (p_ & 7) * 16) = KI[i]; *(LAS u32x4*)((WL) + GW_Q + (p_ >> 3) * 144 + (p_ & 7) * 16) = QI[i]; } \
        *(LAS u32x4*)((WL) + GW_V + (lane >> 1) * 32 + (lane & 1) * 16) = VI; \
        _Pragma("unroll") for (int db = 0; db < 4; ++db) E4[db] = EBV[db]; } while (0)
#define GLA_STAGE_P(WL, PA0, PA1, VBN, KAN, QPX, QPY, O0P, O1P) do { \
        f32x4 pt00 = {0.f, 0.f, 0.f, 0.f}, pt01 = pt00, pt11 = pt00; \
        _Pragma("unroll") for (int ks = 0; ks < 2; ++ks) { \
            const bf16x8 a0 = *(const LAS bf16x8*)((WL) + GW_K + l15 * 144 + ks * 64 + q4 * 16), a1 = *(const LAS bf16x8*)((WL) + GW_K + (16 + l15) * 144 + ks * 64 + q4 * 16); \
            const bf16x8 b0 = *(const LAS bf16x8*)((WL) + GW_Q + l15 * 144 + ks * 64 + q4 * 16), b1 = *(const LAS bf16x8*)((WL) + GW_Q + (16 + l15) * 144 + ks * 64 + q4 * 16); \
            pt00 = __builtin_amdgcn_mfma_f32_16x16x32_bf16(a0, b0, pt00, 0, 0, 0); \
            pt01 = __builtin_amdgcn_mfma_f32_16x16x32_bf16(a0, b1, pt01, 0, 0, 0); \
            pt11 = __builtin_amdgcn_mfma_f32_16x16x32_bf16(a1, b1, pt11, 0, 0, 0); \
            const LAS unsigned char* q0p = (WL) + GW_Q + l15 * 144 + ks * 64 + q4 * 8; const LAS unsigned char* q1p = q0p + 16 * 144; \
            const u32x2 x0 = *(const LAS u32x2*)(q0p), x1 = *(const LAS u32x2*)(q0p + 32), y0 = *(const LAS u32x2*)(q1p), y1 = *(const LAS u32x2*)(q1p + 32); \
            QPX[ks] = __builtin_bit_cast(bf16x8, (u32x4){x0.x, x0.y, x1.x, x1.y}); QPY[ks] = __builtin_bit_cast(bf16x8, (u32x4){y0.x, y0.y, y1.x, y1.y}); } \
        _Pragma("unroll") for (int r = 0; r < 4; ++r) { if (4 * q4 + r > l15) { pt00[r] = 0.f; pt11[r] = 0.f; } } \
        PA0 = __builtin_bit_cast(bf16x8, (u32x4){cvt_pk_bf16(pt00[0], pt00[1]), cvt_pk_bf16(pt00[2], pt00[3]), 0u, 0u}); \
        PA1 = __builtin_bit_cast(bf16x8, (u32x4){cvt_pk_bf16(pt01[0], pt01[1]), cvt_pk_bf16(pt01[2], pt01[3]), cvt_pk_bf16(pt11[0], pt11[1]), cvt_pk_bf16(pt11[2], pt11[3])}); \
        const LAS unsigned char* vt_ = (WL) + GW_V + (l15 >> 2) * 32 + (l15 & 3) * 8; \
        const v4i16_t vp0 = lds_tr16(vt_ + (4 * q4) * 32), vp1 = lds_tr16(vt_ + (16 + 4 * q4) * 32); \
        const v4i16_t vn0 = lds_tr16(vt_ + (8 * q4) * 32), vn1 = lds_tr16(vt_ + (8 * q4 + 4) * 32); \
        const bf16x8 vbp = (bf16x8){vp0[0], vp0[1], vp0[2], vp0[3], vp1[0], vp1[1], vp1[2], vp1[3]}; \
        VBN = (bf16x8){vn0[0], vn0[1], vn0[2], vn0[3], vn1[0], vn1[1], vn1[2], vn1[3]}; \
        _Pragma("unroll") for (int db = 0; db < 4; ++db) { \
            const LAS unsigned char* kt = (WL) + GW_K + (8 * q4 + (l15 >> 2)) * 144 + (16 * db + (l15 & 3) * 4) * 2; \
            const v4i16_t k0 = lds_tr16(kt), k1 = lds_tr16(kt + 4 * 144); \
            KAN[db] = (bf16x8){k0[0], k0[1], k0[2], k0[3], k1[0], k1[1], k1[2], k1[3]}; } \
        O0P = __builtin_amdgcn_mfma_f32_16x16x32_bf16(PA0, vbp, (f32x4){0.f, 0.f, 0.f, 0.f}, 0, 0, 0); \
        O1P = __builtin_amdgcn_mfma_f32_16x16x32_bf16(PA1, vbp, (f32x4){0.f, 0.f, 0.f, 0.f}, 0, 0, 0); \
    } while (0)
#define GLA_STAGE_S(T0, VBN, KAN, QPX, QPY, O0P, O1P, E4) do { \
        f32x4 o0 = O0P, o1 = O1P; \
        _Pragma("unroll") for (int ks = 0; ks < 2; ++ks) { \
            const bf16x8 sb = __builtin_bit_cast(bf16x8, (u32x4){cvt_pk_bf16(S[2 * ks][0], S[2 * ks][1]), cvt_pk_bf16(S[2 * ks][2], S[2 * ks][3]), cvt_pk_bf16(S[2 * ks + 1][0], S[2 * ks + 1][1]), cvt_pk_bf16(S[2 * ks + 1][2], S[2 * ks + 1][3])}); \
            o0 = __builtin_amdgcn_mfma_f32_16x16x32_bf16(QPX[ks], sb, o0, 0, 0, 0); \
            o1 = __builtin_amdgcn_mfma_f32_16x16x32_bf16(QPY[ks], sb, o1, 0, 0, 0); } \
        _Pragma("unroll") for (int db = 0; db < 4; ++db) { S[db] = __builtin_amdgcn_mfma_f32_16x16x32_bf16(KAN[db], VBN, S[db], 0, 0, 0); S[db] = S[db] * E4[db]; } \
        _Pragma("unroll") for (int r = 0; r < 4; ++r) { const size_t ta = (T0) + 4 * q4 + r, tb2 = ta + 16; \
            ysb[ta * 512 + h * 128 + 16 * w + l15] = f2bf1(o0[r]); ysb[tb2 * 512 + h * 128 + 16 * w + l15] = f2bf1(o1[r]); } \
    } while (0)
    LAS unsigned char* wl2 = F.lds + GW2 + 64 + F.wave * GW_BYTES;
    GLA_LOAD(0);
    for (int n = 0; n < SEQ / 32; n += 2) {
        const size_t t0 = (size_t)b * SEQ + (size_t)n * 32;
        if (F.tid == 0) prog[0] = n;
        GLA_IMG(wl, kimgX, qimgX, vimgX, ebvX, e4X);
        GLA_IMG(wl2, kimgY, qimgY, vimgY, ebvY, e4Y);
        { const int nn = (n + 2 < SEQ / 32) ? n + 2 : n; GLA_LOAD(nn); }
        GLA_STAGE_P(wl, pa0X, pa1X, vbnX, kanX, qpxX, qpyX, o0pX, o1pX);
        GLA_STAGE_P(wl2, pa0Y, pa1Y, vbnY, kanY, qpxY, qpyY, o0pY, o1pY);
        GLA_STAGE_S(t0, vbnX, kanX, qpxX, qpyX, o0pX, o1pX, e4X);
        GLA_STAGE_S(t0 + 32, vbnY, kanY, qpxY, qpyY, o0pY, o1pY, e4Y);
        asm volatile("s_waitcnt lgkmcnt(0)" ::: "memory");
    }
#undef GLA_LOAD1
#undef GLA_IMG
#undef GLA_STAGE_P
#undef GLA_STAGE_S
#undef GLA_LOAD
}
constexpr int G2_K = 0, G2_Q = 4608, G2_V = 9216, G2_E = 13312, G2_SLOT = 13568, G2_NS = 8, G2_FLAGS = G2_NS * G2_SLOT;
static_assert(G2_FLAGS + 64 <= RING_BYTES, "gla ring");
__device__ __forceinline__ void gla_unit2(Frame& F, int l, int unit) {
    const int half = unit & 1, h = (unit >> 1) & 3, b = unit >> 3, lane = F.lane;
    const bf16_t* gqkv = act_ptr(F, A_GQKV); const float* ebg = F.stats + SF_EB;
    volatile LAS unsigned* ready = (volatile LAS unsigned*)(F.lds + G2_FLAGS); volatile LAS unsigned* done = ready + G2_NS;
    if (F.tid < 2 * G2_NS) ready[F.tid] = 0u;
    __syncthreads();
    constexpr int NCH = SEQ / 32;
    if (F.wave >= 4) {
        const int pw = F.wave - 4;
        u32x4 kq[4], qq[4], vv[4], kq2[4], qq2[4], vv2[4]; f32x4 ee, ee2;
#define G2_LOAD(m_, KQ, QQ, VV, EE) do { const size_t tb_ = (size_t)b * SEQ + (size_t)(m_) * 32; \
            _Pragma("unroll") for (int i = 0; i < 4; ++i) { const int p = lane + 64 * i; const bf16_t* r = gqkv + (tb_ + (p >> 3)) * 1024 + h * 64 + (p & 7) * 8; QQ[i] = *(const u32x4*)r; KQ[i] = *(const u32x4*)(r + 256); \
                VV[i] = *(const u32x4*)(gqkv + (tb_ + (p >> 3)) * 1024 + 512 + h * 128 + half * 64 + (p & 7) * 8); } \
            EE = *(const f32x4*)(ebg + (tb_ >> 5) * 256 + h * 64 + (lane & 15) * 4); } while (0)
        G2_LOAD(pw, kq, qq, vv, ee);
        for (int m = pw; m < NCH; m += 4) {
            { const int mn = m + 4 < NCH ? m + 4 : m; G2_LOAD(mn, kq2, qq2, vv2, ee2); }
            const int s = m & (G2_NS - 1); const unsigned round = (unsigned)(m / G2_NS);
            while (done[s] < 4u * round) __builtin_amdgcn_s_sleep(1);
            asm volatile("" ::: "memory");
#pragma unroll
            for (int i = 0; i < 4; ++i) asm volatile("" : "+v"(kq[i]), "+v"(qq[i]), "+v"(vv[i]));
            asm volatile("" : "+v"(ee));
            LAS unsigned char* sl = F.lds + s * G2_SLOT;
#pragma unroll
            for (int i = 0; i < 4; ++i) { const int p = lane + 64 * i;
                *(LAS u32x4*)(sl + G2_K + (p >> 3) * 144 + (p & 7) * 16) = kq[i]; *(LAS u32x4*)(sl + G2_Q + (p >> 3) * 144 + (p & 7) * 16) = qq[i];
                *(LAS u32x4*)(sl + G2_V + ((p & 7) >> 1) * 1024 + (p >> 3) * 32 + (p & 1) * 16) = vv[i]; }
            if (lane < 16) *(LAS f32x4*)(sl + G2_E + lane * 16) = ee;
            asm volatile("s_waitcnt lgkmcnt(0)" ::: "memory");
            if (lane == 0) ready[s] = round + 1u;
#pragma unroll
            for (int i = 0; i < 4; ++i) { kq[i] = kq2[i]; qq[i] = qq2[i]; vv[i] = vv2[i]; }
            ee = ee2;
        }
#undef G2_LOAD
        return;
    }
    const int w = half * 4 + F.wave, l15 = lane & 15, q4 = lane >> 4;
    bf16_t* ysb = act_ptr(F, A_YSB);
    f32x4 S[4];
#pragma unroll
    for (int i = 0; i < 4; ++i) S[i] = (f32x4){0.f, 0.f, 0.f, 0.f};
    bf16x8 pa0X, pa1X, vbnX, kanX[4], qpxX[2], qpyX[2], pa0Y, pa1Y, vbnY, kanY[4], qpxY[2], qpyY[2]; f32x4 o0pX, o1pX, e4X[4], o0pY, o1pY, e4Y[4];
#define G2_STAGE_P(SL, PA0, PA1, VBN, KAN, QPX, QPY, O0P, O1P, E4) do { \
        f32x4 pt00 = {0.f, 0.f, 0.f, 0.f}, pt01 = pt00, pt11 = pt00; \
        _Pragma("unroll") for (int ks = 0; ks < 2; ++ks) { \
            const bf16x8 a0 = *(const LAS bf16x8*)((SL) + G2_K + l15 * 144 + ks * 64 + q4 * 16), a1 = *(const LAS bf16x8*)((SL) + G2_K + (16 + l15) * 144 + ks * 64 + q4 * 16); \
            const bf16x8 b0 = *(const LAS bf16x8*)((SL) + G2_Q + l15 * 144 + ks * 64 + q4 * 16), b1 = *(const LAS bf16x8*)((SL) + G2_Q + (16 + l15) * 144 + ks * 64 + q4 * 16); \
            pt00 = __builtin_amdgcn_mfma_f32_16x16x32_bf16(a0, b0, pt00, 0, 0, 0); \
            pt01 = __builtin_amdgcn_mfma_f32_16x16x32_bf16(a0, b1, pt01, 0, 0, 0); \
            pt11 = __builtin_amdgcn_mfma_f32_16x16x32_bf16(a1, b1, pt11, 0, 0, 0); \
            const LAS unsigned char* q0p = (SL) + G2_Q + l15 * 144 + ks * 64 + q4 * 8; const LAS unsigned char* q1p = q0p + 16 * 144; \
            const u32x2 x0 = *(const LAS u32x2*)(q0p), x1 = *(const LAS u32x2*)(q0p + 32), y0 = *(const LAS u32x2*)(q1p), y1 = *(const LAS u32x2*)(q1p + 32); \
            QPX[ks] = __builtin_bit_cast(bf16x8, (u32x4){x0.x, x0.y, x1.x, x1.y}); QPY[ks] = __builtin_bit_cast(bf16x8, (u32x4){y0.x, y0.y, y1.x, y1.y}); } \
        _Pragma("unroll") for (int r = 0; r < 4; ++r) { if (4 * q4 + r > l15) { pt00[r] = 0.f; pt11[r] = 0.f; } } \
        PA0 = __builtin_bit_cast(bf16x8, (u32x4){cvt_pk_bf16(pt00[0], pt00[1]), cvt_pk_bf16(pt00[2], pt00[3]), 0u, 0u}); \
        PA1 = __builtin_bit_cast(bf16x8, (u32x4){cvt_pk_bf16(pt01[0], pt01[1]), cvt_pk_bf16(pt01[2], pt01[3]), cvt_pk_bf16(pt11[0], pt11[1]), cvt_pk_bf16(pt11[2], pt11[3])}); \
        const LAS unsigned char* vt_ = (SL) + G2_V + F.wave * 1024 + (l15 >> 2) * 32 + (l15 & 3) * 8; \
        const v4i16_t vp0 = lds_tr16(vt_ + (4 * q4) * 32), vp1 = lds_tr16(vt_ + (16 + 4 * q4) * 32); \
        const v4i16_t vn0 = lds_tr16(vt_ + (8 * q4) * 32), vn1 = lds_tr16(vt_ + (8 * q4 + 4) * 32); \
        const bf16x8 vbp = (bf16x8){vp0[0], vp0[1], vp0[2], vp0[3], vp1[0], vp1[1], vp1[2], vp1[3]}; \
        VBN = (bf16x8){vn0[0], vn0[1], vn0[2], vn0[3], vn1[0], vn1[1], vn1[2], vn1[3]}; \
        _Pragma("unroll") for (int db = 0; db < 4; ++db) { \
            const LAS unsigned char* kt = (SL) + G2_K + (8 * q4 + (l15 >> 2)) * 144 + (16 * db + (l15 & 3) * 4) * 2; \
            const v4i16_t k0 = lds_tr16(kt), k1 = lds_tr16(kt + 4 * 144); \
            KAN[db] = (bf16x8){k0[0], k0[1], k0[2], k0[3], k1[0], k1[1], k1[2], k1[3]}; \
            E4[db] = *(const LAS f32x4*)((SL) + G2_E + (16 * db + 4 * q4) * 4); } \
        O0P = __builtin_amdgcn_mfma_f32_16x16x32_bf16(PA0, vbp, (f32x4){0.f, 0.f, 0.f, 0.f}, 0, 0, 0); \
        O1P = __builtin_amdgcn_mfma_f32_16x16x32_bf16(PA1, vbp, (f32x4){0.f, 0.f, 0.f, 0.f}, 0, 0, 0); \
    } while (0)
#define G2_STAGE_S(T0, VBN, KAN, QPX, QPY, O0P, O1P, E4) do { \
        f32x4 o0 = O0P, o1 = O1P; \
        _Pragma("unroll") for (int ks = 0; ks < 2; ++ks) { \
            const bf16x8 sb = __builtin_bit_cast(bf16x8, (u32x4){cvt_pk_bf16(S[2 * ks][0], S[2 * ks][1]), cvt_pk_bf16(S[2 * ks][2], S[2 * ks][3]), cvt_pk_bf16(S[2 * ks + 1][0], S[2 * ks + 1][1]), cvt_pk_bf16(S[2 * ks + 1][2], S[2 * ks + 1][3])}); \
            o0 = __builtin_amdgcn_mfma_f32_16x16x32_bf16(QPX[ks], sb, o0, 0, 0, 0); \
            o1 = __builtin_amdgcn_mfma_f32_16x16x32_bf16(QPY[ks], sb, o1, 0, 0, 0); } \
        _Pragma("unroll") for (int db = 0; db < 4; ++db) { S[db] = __builtin_amdgcn_mfma_f32_16x16x32_bf16(KAN[db], VBN, S[db], 0, 0, 0); S[db] = S[db] * E4[db]; } \
        _Pragma("unroll") for (int r = 0; r < 4; ++r) { const size_t ta = (T0) + 4 * q4 + r, tb2 = ta + 16; \
            ysb[ta * 512 + h * 128 + 16 * w + l15] = f2bf1(o0[r]); ysb[tb2 * 512 + h * 128 + 16 * w + l15] = f2bf1(o1[r]); } \
    } while (0)
    for (int n = 0; n < NCH; n += 2) {
        const size_t t0 = (size_t)b * SEQ + (size_t)n * 32;
        const int s0 = n & (G2_NS - 1), s1 = s0 + 1; const unsigned want = (unsigned)(n / G2_NS) + 1u;
        while (ready[s0] < want) __builtin_amdgcn_s_sleep(1);
        while (ready[s1] < want) __builtin_amdgcn_s_sleep(1);
        asm volatile("" ::: "memory");
        const LAS unsigned char* slX = F.lds + s0 * G2_SLOT; const LAS unsigned char* slY = F.lds + s1 * G2_SLOT;
        G2_STAGE_P(slX, pa0X, pa1X, vbnX, kanX, qpxX, qpyX, o0pX, o1pX, e4X);
        G2_STAGE_P(slY, pa0Y, pa1Y, vbnY, kanY, qpxY, qpyY, o0pY, o1pY, e4Y);
        asm volatile("s_waitcnt lgkmcnt(0)" ::: "memory");
        if (lane == 0) { __hip_atomic_fetch_add((LAS unsigned*)&done[s0], 1u, __ATOMIC_RELAXED, __HIP_MEMORY_SCOPE_WORKGROUP); __hip_atomic_fetch_add((LAS unsigned*)&done[s1], 1u, __ATOMIC_RELAXED, __HIP_MEMORY_SCOPE_WORKGROUP); }
        G2_STAGE_S(t0, vbnX, kanX, qpxX, qpyX, o0pX, o1pX, e4X);
        G2_STAGE_S(t0 + 32, vbnY, kanY, qpxY, qpyY, o0pY, o1pY, e4Y);
    }
#undef G2_STAGE_P
#undef G2_STAGE_S
}
__device__ __forceinline__ void gla_finalize(Frame& F, int l) {
    bf16_t* ysb = act_ptr(F, A_YSB); const bf16_t* og = act_ptr(F, A_OG);
    const float* go = F.in(I_GGLAO) + l * 128;
    const int istep = F.G * 512, c8 = F.tid & 63, v0 = (c8 & 15) * 8;
    const f32x4 g0 = *(const f32x4*)(go + v0), g1 = *(const f32x4*)(go + v0 + 4);
    for (int i0 = F.vcu * 512 + F.tid; i0 < T * 64; i0 += 4 * istep) {
        u32x4 ov4[4], gt4[4];
#pragma unroll
        for (int k = 0; k < 4; ++k) {
            const int i = i0 + k * istep < T * 64 ? i0 + k * istep : i0; const int t = i >> 6;
            ov4[k] = *(const u32x4*)(ysb + (size_t)t * 512 + c8 * 8); gt4[k] = *(const u32x4*)(og + (size_t)t * 512 + c8 * 8);
        }
#pragma unroll
        for (int k = 0; k < 4; ++k) asm volatile("" : "+v"(ov4[k]), "+v"(gt4[k]));
#pragma unroll
        for (int k = 0; k < 4; ++k) {
            const int i = i0 + k * istep; const int t = i >> 6;
            const u32x4 o = ov4[k], gte = gt4[k];
            const float ov[8] = {bflo(o.x), bfhi(o.x), bflo(o.y), bfhi(o.y), bflo(o.z), bfhi(o.z), bflo(o.w), bfhi(o.w)};
            const float ssq = row16_sum(((ov[0] * ov[0] + ov[1] * ov[1]) + (ov[2] * ov[2] + ov[3] * ov[3])) + ((ov[4] * ov[4] + ov[5] * ov[5]) + (ov[6] * ov[6] + ov[7] * ov[7])));
            const float r = rsqrtf(ssq * (1.f / 128.f) + EPS);
            const float gv[8] = {bflo(gte.x), bfhi(gte.x), bflo(gte.y), bfhi(gte.y), bflo(gte.z), bfhi(gte.z), bflo(gte.w), bfhi(gte.w)};
            float y[8];
#pragma unroll
            for (int e = 0; e < 8; ++e) y[e] = ov[e] * r * (e < 4 ? g0[e] : g1[e - 4]) * gv[e] * fast_sigmoid(gv[e]);
            u32x4 wv; wv.x = cvt_pk_bf16(y[0], y[1]); wv.y = cvt_pk_bf16(y[2], y[3]); wv.z = cvt_pk_bf16(y[4], y[5]); wv.w = cvt_pk_bf16(y[6], y[7]);
            if (i < T * 64) *(u32x4*)(ysb + (size_t)t * 512 + c8 * 8) = wv;
        }
    }
}

template <int W> __device__ __forceinline__ void pool_rows(const bf16_t* up, bf16_t* pooled, int t0, int s0, int c8) {
    u32x4 row[8 + W - 1];
#pragma unroll
    for (int i = 0; i < 8 + W - 1; ++i) {
        const int dt = i - (W - 1);
        const bool ok = (s0 + dt) >= 0;
        const u32x4 v = *(const u32x4*)(up + (size_t)(t0 + (ok ? dt : 0)) * 512 + c8 * 8);
        row[i] = ok ? v : (u32x4){0u, 0u, 0u, 0u};
    }
#pragma unroll
    for (int k = 0; k < 8; ++k) {
        float acc[8];
#pragma unroll
        for (int e = 0; e < 8; ++e) acc[e] = 0.f;
#pragma unroll
        for (int j = 0; j < W; ++j) { const u32x4 v = row[k + W - 1 - j];
            acc[0] += bflo(v.x); acc[1] += bfhi(v.x); acc[2] += bflo(v.y); acc[3] += bfhi(v.y); acc[4] += bflo(v.z); acc[5] += bfhi(v.z); acc[6] += bflo(v.w); acc[7] += bfhi(v.w); }
        const int sk = s0 + k, n = (sk + 1 < W) ? sk + 1 : W;
        const float rn = 1.f / (float)n; const u32x4 self = row[k + W - 1];
        u32x4 o; o.x = cvt_pk_bf16(acc[0] * rn - bflo(self.x), acc[1] * rn - bfhi(self.x)); o.y = cvt_pk_bf16(acc[2] * rn - bflo(self.y), acc[3] * rn - bfhi(self.y));
        o.z = cvt_pk_bf16(acc[4] * rn - bflo(self.z), acc[5] * rn - bfhi(self.z)); o.w = cvt_pk_bf16(acc[6] * rn - bflo(self.w), acc[7] * rn - bfhi(self.w));
        *(u32x4*)(pooled + (size_t)(t0 + k) * 512 + c8 * 8) = o;
    }
}
__device__ __forceinline__ void pool_unit(Frame& F, int unit) {
    const bf16_t* up = act_ptr(F, A_UP); bf16_t* pooled = act_ptr(F, A_POOLED);
    const int g = F.wave & 3, c8 = g * 16 + (F.lane & 15), tb = (F.lane >> 4) + 4 * (F.wave >> 2);
    const int t0 = unit * 64 + tb * 8, s0 = t0 % SEQ;
    if (g == 0) pool_rows<2>(up, pooled, t0, s0, c8);
    else if (g == 1) pool_rows<4>(up, pooled, t0, s0, c8);
    else if (g == 2) pool_rows<8>(up, pooled, t0, s0, c8);
    else pool_rows<16>(up, pooled, t0, s0, c8);
}

__device__ __forceinline__ void phase_mix(Frame& F, int lq, int bx) {
    const int l = lq & 1;
#ifndef REP_DMASK
#define REP_DMASK 7
#endif
    const int dm = (lq >= 2) ? (REP_DMASK) : 7;
#ifdef GLA_OLD
    if (bx < 32 && (dm & 1)) gla_unit(F, l, bx);
#else
    if (bx < 32 && (dm & 1)) { gla_unit2(F, l, bx); __syncthreads(); }
#endif
    unsigned* head = F.ctl + CW_QUEUE + 64 * lq;
    unsigned long long tpsum = 0;
#ifdef AT_TPROBE
    const unsigned long long tq0 = __builtin_readcyclecounter();
#endif
    const bool stat = F.G == 256;
    if (stat && (dm & 2)) {
        const int k = (bx - 32) >> 3, j = k % 7, bh = bx < 32 ? bx : (bx & 7) * 4 + k / 7;
        for (int u = 0; u < 2; ++u) { attn_unit(F, l, bh, bx < 32 ? 1 - u : (u == 0 ? 15 - j : 2 + j), tpsum); __syncthreads(); }
    }
    const int nattn = stat ? 0 : 512;
    for (;;) {
        if (F.tid == 0) F.MISC[16] = __hip_atomic_fetch_add(head, 1u, RLX_AGENT);
        __syncthreads();
        const int idx = (int)F.MISC[16];
        __syncthreads();
        if (idx >= nattn + 256) break;
        if (idx < nattn) { if (dm & 2) attn_unit(F, l, idx & 31, 15 - (idx >> 5), tpsum); }
        else { if (dm & 4) pool_unit(F, idx - nattn); }
    }
#ifdef AT_TPROBE
    if (AT_TPROBE == 7) tpsum = __builtin_readcyclecounter() - tq0;
    if (lq >= 2 && (AT_TPWG < 0 || bx == AT_TPWG) && F.wave == AT_TPWAVE) { const unsigned long long ts = __builtin_readcyclecounter(); while (__builtin_readcyclecounter() - ts < 4ull * tpsum) __builtin_amdgcn_s_sleep(8); }
#endif
    if (lq < 2) {
        LAS float* scr = (LAS float*)(F.lds + F.wave * 16384);
        const bool two = stat && bx < 32;
        if (stat || bx >= 32) {
            for (int r = 0; r < (two ? 2 : 1); ++r) {
                const int vwg = stat ? (bx >= 32 ? bx - 32 : 224 + 2 * bx + r) : bx - 32;
                const int gw = vwg * 8 + F.wave, NGW = (stat ? 288 : F.G - 32) * 8;
                if (stat) {
                    if (l == 0) fold_pool(F, 1, gw, NGW);
                } else {
                    if (l == 0) { CONV_LOOP(15, mixer_seg(F, 1, si_)); fold_pool(F, 1, gw, NGW); CONV_LOOP(3, ffn_seg(F, si_)); }
                    else { CONV_LOOP(12, moe_seg(F, (si_ >> 1) * 3 + (si_ & 1))); }
                }
            }
        }
    }
}

__device__ __forceinline__ void phase_route1(Frame& F) {
    const bf16_t* x = (const bf16_t*)(F.ws + WS_XB); const float* rss = F.stats + SF_ROWSS + (size_t)3 * T * 16; const float* gf = F.in(I_GFFN) + D; const float* wr = F.in(I_WROUTER);
    unsigned* route = (unsigned*)(F.ws + WS_SLOT + SL_ROUTE); unsigned* wgcnt = F.ctl + CW_WGCNT;
    LAS float* lsel = (LAS float*)(F.lds);
    LAS int* lpos = (LAS int*)(F.lds + 2048);
    float wgt[2][8][8];
    {
        f32x4 wl[2][8][2], gl[2][2];
#pragma unroll
        for (int j = 0; j < 2; ++j) {
            const int c = 8 * F.lane + 512 * j;
            gl[j][0] = *(const f32x4*)(gf + c); gl[j][1] = *(const f32x4*)(gf + c + 4);
#pragma unroll
            for (int q = 0; q < 8; ++q) { wl[j][q][0] = *(const f32x4*)(wr + (size_t)(c + q) * 8); wl[j][q][1] = *(const f32x4*)(wr + (size_t)(c + q) * 8 + 4); }
        }
#pragma unroll
        for (int j = 0; j < 2; ++j)
#pragma unroll
            for (int q = 0; q < 8; ++q) { asm volatile("" : "+v"(wl[j][q][0]), "+v"(wl[j][q][1])); }
#pragma unroll
        for (int j = 0; j < 2; ++j)
#pragma unroll
            for (int q = 0; q < 8; ++q) {
                const float g = q < 4 ? gl[j][0][q] : gl[j][1][q - 4];
#pragma unroll
                for (int e = 0; e < 4; ++e) { wgt[j][q][e] = wl[j][q][0][e] * g; wgt[j][q][4 + e] = wl[j][q][1][e] * g; }
            }
    }
    for (int unit = F.vcu; unit < T / 64; unit += F.G) {
        const float rs_l = rsqrtf(sum16(rss + (size_t)(unit * 64 + F.wave * 8 + (F.lane & 7)) * 16) * (1.f / 1024.f) + EPS);
#pragma unroll 1
        for (int k0 = 0; k0 < 8; k0 += 4) {
        u32x4 xr[4][2];
#pragma unroll
        for (int k = 0; k < 4; ++k)
#pragma unroll
            for (int j = 0; j < 2; ++j) xr[k][j] = *(const u32x4*)(x + (size_t)(unit * 64 + F.wave * 8 + k0 + k) * D + 8 * F.lane + 512 * j);
#pragma unroll
        for (int kk = 0; kk < 4; ++kk) {
            const int k = k0 + kk, tok = F.wave * 8 + k;
            float lg[8];
#pragma unroll
            for (int e = 0; e < 8; ++e) lg[e] = 0.f;
#pragma unroll
            for (int j = 0; j < 2; ++j) {
                const u32x4 v = xr[kk][j];
                const float xv[8] = {bflo(v.x), bfhi(v.x), bflo(v.y), bfhi(v.y), bflo(v.z), bfhi(v.z), bflo(v.w), bfhi(v.w)};
#pragma unroll
                for (int q = 0; q < 8; ++q)
#pragma unroll
                    for (int e = 0; e < 8; ++e) lg[e] = fmaf(xv[q], wgt[j][q][e], lg[e]);
            }
            const float rs = __shfl(rs_l, k);
#pragma unroll
            for (int e = 0; e < 8; ++e) lg[e] = wave_sum_dpp(lg[e]) * rs;
            int i1 = 0; float v1 = lg[0];
#pragma unroll
            for (int e = 1; e < 8; ++e) if (lg[e] > v1) { v1 = lg[e]; i1 = e; }
            int i2 = -1; float v2 = -INFINITY;
#pragma unroll
            for (int e = 0; e < 8; ++e) if (e != i1 && lg[e] > v2) { v2 = lg[e]; i2 = e; }
            const float e2 = __expf(v2 - v1), w1 = 1.f / (1.f + e2), w2 = e2 / (1.f + e2);
            if (F.lane == 0) { lsel[tok * 4 + 0] = __int_as_float(i1); lsel[tok * 4 + 1] = __int_as_float(i2); lsel[tok * 4 + 2] = w1; lsel[tok * 4 + 3] = w2; }
        }
        }
        __syncthreads();
        if (F.wave == 0) {
            const int e1 = __float_as_int(lsel[F.lane * 4 + 0]), e2 = __float_as_int(lsel[F.lane * 4 + 1]);
            const unsigned long long below = (1ull << F.lane) - 1ull;
            int pos1 = 0, pos2 = 0, cnt_l = 0;
#pragma unroll
            for (int e = 0; e < 8; ++e) {
                const unsigned long long m1 = __ballot(e1 == e), m2 = __ballot(e2 == e);
                const int b1 = __popcll(m1 & below), b2 = __popcll(m2 & below);
                if (e1 == e) pos1 = b1 + b2;
                if (e2 == e) pos2 = b1 + b2 + (int)((m1 >> F.lane) & 1ull);
                if (F.lane == e) cnt_l = __popcll(m1) + __popcll(m2);
            }
            lpos[F.lane * 2 + 0] = pos1; lpos[F.lane * 2 + 1] = pos2;
            if (F.lane < 8) wgcnt[unit * 8 + F.lane] = (unsigned)cnt_l;
        }
        __syncthreads();
        if (F.tid < 64) {
            const int t = unit * 64 + F.tid;
            u32x4 a, b2;
            a.x = (unsigned)__float_as_int(lsel[F.tid * 4 + 0]); a.y = (unsigned)__float_as_int(lsel[F.tid * 4 + 1]); a.z = __float_as_uint(lsel[F.tid * 4 + 2]); a.w = __float_as_uint(lsel[F.tid * 4 + 3]);
            b2.x = (unsigned)lpos[F.tid * 2 + 0]; b2.y = (unsigned)lpos[F.tid * 2 + 1]; b2.z = 0u; b2.w = 0u;
            *(u32x4*)(route + (size_t)t * 8) = a; *(u32x4*)(route + (size_t)t * 8 + 4) = b2;
        }
        __syncthreads();
    }
}
__device__ __forceinline__ void moe_geometry(Frame& F, int unit, LAS int* geo) {
    const unsigned* wgcnt = F.ctl + CW_WGCNT;
    int tv[8], pv[8];
    if (F.tid < 256) {
        const u32x4 c0 = *(const u32x4*)(wgcnt + F.tid * 8), c1 = *(const u32x4*)(wgcnt + F.tid * 8 + 4);
        tv[0] = (int)c0.x; tv[1] = (int)c0.y; tv[2] = (int)c0.z; tv[3] = (int)c0.w; tv[4] = (int)c1.x; tv[5] = (int)c1.y; tv[6] = (int)c1.z; tv[7] = (int)c1.w;
    } else {
#pragma unroll
        for (int e = 0; e < 8; ++e) tv[e] = 0;
    }
#pragma unroll
    for (int e = 0; e < 8; ++e) pv[e] = (F.tid < unit) ? tv[e] : 0;
#pragma unroll
    for (int e = 0; e < 8; ++e) { tv[e] = wave_isum_dpp(tv[e]); pv[e] = wave_isum_dpp(pv[e]); }
    LAS int* part = geo + 32;
    if (F.lane == 0 && F.wave < 4) {
#pragma unroll
        for (int e = 0; e < 8; ++e) { part[F.wave * 16 + e] = tv[e]; part[F.wave * 16 + 8 + e] = pv[e]; }
    }
    __syncthreads();
    if (F.tid < 8) {
        int tot = 0, pre = 0;
#pragma unroll
        for (int w = 0; w < 4; ++w) { tot += part[w * 16 + F.tid]; pre += part[w * 16 + 8 + F.tid]; }
        geo[9 + F.tid] = tot; geo[17 + F.tid] = pre;
    }
    __syncthreads();
    if (F.tid == 0) { int acc = 0; for (int e = 0; e < 8; ++e) { geo[e] = acc; acc += (geo[9 + e] + 255) >> 8; } geo[8] = acc; }
    __syncthreads();
}
__device__ __forceinline__ void phase_route2(Frame& F) {
    const unsigned* route = (const unsigned*)(F.ws + WS_SLOT + SL_ROUTE);
    int* slot_tok = (int*)(F.ws + WS_SLOT + SL_TOK); float* slot_scale = (float*)(F.ws + WS_SLOT + SL_SCALE); float* slot_comb = (float*)(F.ws + WS_SLOT + SL_COMB);
    const float* rss = F.stats + SF_ROWSS + (size_t)3 * T * 16;
    const bf16_t* xb = (const bf16_t*)(F.ws + WS_XB); bf16_t* xg = act_ptr(F, A_XG);
    LAS int* geo = (LAS int*)(F.lds);
    for (int unit = F.vcu; unit < T / 64; unit += F.G) {
        moe_geometry(F, unit, geo);
        int slot_l = 0;
        if (F.lane < 16) {
            const int rix = F.wave * 16 + F.lane, tok = rix >> 1, ch = rix & 1, t = unit * 64 + tok;
            const unsigned e = route[(size_t)t * 8 + ch], pos = route[(size_t)t * 8 + 4 + ch];
            const float w = __uint_as_float(route[(size_t)t * 8 + 2 + ch]);
            const float sc = rsqrtf(sum16(rss + (size_t)t * 16) * (1.f / 1024.f) + EPS);
            slot_l = geo[e] * 256 + geo[17 + e] + (int)pos;
            ((int*)(F.ws + WS_TSLOT))[t * 2 + ch] = slot_l; slot_tok[slot_l] = t; slot_scale[slot_l] = FP8_M ? sc * (1.f / FP8_WSC) : sc; slot_comb[slot_l] = (FP8_M && FP8_D) ? w * ACT8_SC : w;
        }
        if (unit == 0) {
            for (int e = 0; e < 8; ++e) { const int s0 = geo[e] * 256 + geo[9 + e], s1 = geo[e + 1] * 256;
                for (int s = s0 + F.tid; s < s1; s += 512) { slot_tok[s] = -1; slot_scale[s] = 0.f; slot_comb[s] = 0.f; } }
        }
        __syncthreads();
    }
    if (FP8_D) {
        unsigned char* a8 = (unsigned char*)act_ptr(F, A_ACTE); unsigned char* w8 = F.ws + WS_W0 + WO_MD;
        for (int i = F.vcu * 512 + F.tid; i < (MAXSLOT + 8 * 1024) * 8; i += F.G * 512) { const int r = i >> 3, pc = i & 7;
            unsigned char* p = r < MAXSLOT ? a8 + (size_t)r * KD8 : w8 + (size_t)(r - MAXSLOT) * KD8;
            unsigned z_; asm volatile("v_mov_b32 %0, 0" : "=v"(z_));
            *(u32x4*)(p + DEXP + pc * 16) = (u32x4){z_, z_, z_, z_}; }
    }
}

struct Args { const void* in[25]; float* out; unsigned char* ws; int ph_lo, ph_hi, li, pad; };
constexpr int NPHASE = 22;
#ifndef PH_MASK
#define PH_MASK 0xFFF
#endif
#define PON(b) (((PH_MASK) >> (b)) & 1)

__global__ void __launch_bounds__(512, 2) mega_fwd(Args args) {
    extern __shared__ __attribute__((aligned(16))) unsigned char lds_raw[];
    Frame F;
    F.lds = (LAS unsigned char*)lds_raw;
    F.MISC = (volatile LAS unsigned*)(F.lds + MISC_OFF);
    F.tid = threadIdx.x; F.lane = F.tid & 63; F.wave = __builtin_amdgcn_readfirstlane(F.tid >> 6);
    F.G = gridDim.x; { const int bx = blockIdx.x; F.vcu = (F.G % 8 == 0) ? (bx % 8) * (F.G / 8) + bx / 8 : bx; }
    { const CAS Args* ap0 = (const CAS Args*)__builtin_amdgcn_kernarg_segment_ptr(); F.ws = ap0->ws; F.ctl = (unsigned*)(F.ws + WS_CTL); F.ctlf = (float*)(F.ws + WS_CTL); F.stats = (float*)(F.ws + WS_STATS); }
    F.inp = nullptr; F.out = nullptr;
    for (int u = F.tid; u < (LDS_BYTES - LDSCTL_OFF) / 4; u += 512) ((LAS unsigned*)(F.lds + LDSCTL_OFF))[u] = 0u;
    __syncthreads();
    XcdBarrier bar = xcd_barrier_post(F.ctl + CW_BAR + args.li * XCD_BAR_WORDS, F.MISC + 8);
    const int lo = args.ph_lo, hi = args.ph_hi;
    const int cblk0 = (int)blockIdx.x, wave0 = F.wave, vcu0 = F.vcu, G0 = F.G;
#ifndef REP_MASK
#define REP_MASK 0
#endif
#pragma unroll 1
    for (int ph2 = 2 * lo; ph2 < 2 * hi; ++ph2) {
        const int ph = ph2 >> 1, rpt = ph2 & 1;
        if (rpt && !((REP_MASK >> ph) & 1)) continue;
        int cblk = cblk0; { int wv_ = wave0, vc_ = vcu0, g_ = G0; asm volatile("" : "+s"(wv_), "+s"(vc_), "+s"(g_), "+s"(cblk)); F.wave = wv_; F.vcu = vc_; F.G = g_; }
        { int ln_; asm volatile("v_mbcnt_lo_u32_b32 %0, -1, 0\n\tv_mbcnt_hi_u32_b32 %0, -1, %0" : "=v"(ln_)); F.lane = ln_; F.tid = F.wave * 64 + ln_; }
        { const CAS Args* ap = (const CAS Args*)__builtin_amdgcn_kernarg_segment_ptr(); asm volatile("" : "+s"(ap)); F.inp = ap->in; F.out = ap->out; unsigned char* w_ = ap->ws; F.ws = w_; F.ctl = (unsigned*)(w_ + WS_CTL); F.ctlf = (float*)(w_ + WS_CTL); F.stats = (float*)(w_ + WS_STATS); }
        const int l = ph >= 10 ? 1 : 0, q = ph == 0 ? -1 : (l ? ph - 10 : ph - 1);
        unsigned char* wb = wblk(F, l);
        float* ssq = F.stats + SF_SSQ + (size_t)l * 2 * T * 4;
        const float* rss_in = F.stats + SF_ROWSS + (size_t)(l == 0 ? 0 : 2) * T * 16;
        float* rss_mid = F.stats + SF_ROWSS + (size_t)(l == 0 ? 1 : 3) * T * 16;
        if (q == -1) {
            if (PON(11)) p0_prologue(F);
        } else if (q == 0 && PON(0)) {
            if (FP8_A && FP8_E && l == 1) {
            pg8::SchedGrid S{(const char*)F.out + (size_t)T * D, (const char*)(wb + WO_IN), (size_t)256 * 1024, (size_t)256 * 1024, 0, 64, 11, F.G, cblk, 1 << 30};
            { int sf_ = 1 << 30; asm volatile("" : "+s"(sf_)); S.split_from = sf_; }
            { pg8::Unit u0; if (S.next(0, u0)) fill_rs(F, rss_in, u0.pm); }
            pg8::EpiProj<true> E{act_ptr(F, A_CQKV), act_ptr(F, A_GQKV), act_ptr(F, A_OG), act_ptr(F, A_UP), act_ptr(F, A_MISC), (const LAS float*)(F.lds + RS_OFF), ssq};
            pg8::gemm_phase<pg8::EpiProj<true>, pg8::SchedGrid, true, true, true>(F.lds, F.wave, 512, 512, S, E);
            } else {
            pg8::SchedGrid S{(const char*)(F.ws + WS_XB), (const char*)(wb + WO_IN), (size_t)256 * 1024 * 2, (size_t)256 * 1024 * 2, 0, 64, 11, F.G, cblk, 1 << 30};
            { pg8::Unit u0; if (S.next(0, u0)) fill_rs(F, rss_in, u0.pm); }
            pg8::EpiProj<false> E{act_ptr(F, A_CQKV), act_ptr(F, A_GQKV), act_ptr(F, A_OG), act_ptr(F, A_UP), act_ptr(F, A_MISC), (const LAS float*)(F.lds + RS_OFF), ssq};
            pg8::gemm_phase<pg8::EpiProj<false>, pg8::SchedGrid, true, true>(F.lds, F.wave, 1024, 1024, S, E);
            }
        } else if (q == 1 && PON(1)) {
            pg8::SchedGrid S{(const char*)act_ptr(F, A_CQKV), (const char*)(wb + WO_UP), (size_t)256 * 512 * 2, (size_t)256 * 256 * 2, (size_t)256 * 2, 64, 7, F.G, cblk, 3};
            pg8::EpiUp E{act_ptr(F, A_QKVRAW), ssq, act_ptr(F, A_QH)};
            pg8::gemm_phase<pg8::EpiUp, pg8::SchedGrid, true, true>(F.lds, F.wave, 512, 256, S, E);
        } else if (q == 2 && PON(2)) {
            phase_prep(F, l, rpt);
        } else if (q == 3 && PON(3)) {
            phase_mix(F, l + 2 * rpt, cblk);
        } else if (q == 4 && PON(4)) {
#if FP8_E
            pg8::SchedGrid S{(const char*)F.out + (size_t)l * T * D, (const char*)(wb + WO_G), (size_t)256 * 1024, (size_t)256 * 1024, 0, 64, 12, F.G, cblk, 1 << 30};
            { int sf_ = 1 << 30; asm volatile("" : "+s"(sf_)); S.split_from = sf_; }
            { pg8::Unit u0; if (S.next(0, u0)) fill_rs(F, rss_in, u0.pm); }
            pg8::EpiGate<true> E{F.ws + WS_ACTS, (const LAS float*)(F.lds + RS_OFF)};
            pg8::gemm_phase<pg8::EpiGate<true>, pg8::SchedGrid, true, true, true>(F.lds, F.wave, 512, 512, S, E);
#else
            pg8::SchedGrid S{(const char*)(F.ws + WS_XB), (const char*)(wb + WO_G), (size_t)256 * 1024 * 2, (size_t)256 * 1024 * 2, 0, 64, 12, F.G, cblk, 1 << 30};
            { pg8::Unit u0; if (S.next(0, u0)) fill_rs(F, rss_in, u0.pm); }
            pg8::EpiGate<false> E{F.ws + WS_ACTS, (const LAS float*)(F.lds + RS_OFF)};
            pg8::gemm_phase<pg8::EpiGate<false>, pg8::SchedGrid, true, true>(F.lds, F.wave, 1024, 1024, S, E);
#endif
            if (!rpt) { { int ln_; asm volatile("v_mbcnt_lo_u32_b32 %0, -1, 0\n\tv_mbcnt_hi_u32_b32 %0, -1, %0" : "=v"(ln_)); F.lane = ln_; F.tid = F.wave * 64 + ln_; }
                        gla_finalize(F, l); }
        } else if (q == 5 && PON(5)) {
            pg8::SchedMerge S{(const char*)(F.ws + WS_ACTS), (const char*)(wb + WO_BR), F.G, cblk};
            pg8::EpiMerge E{F.ws + WS_ACTS, act_ptr(F, A_MERGED)};
            pg8::gemm_phase<pg8::EpiMerge, pg8::SchedMerge, true, true>(F.lds, F.wave, 512, 512, S, E);
        } else if (q == 6 && PON(6)) {
            pg8::SchedGrid S{(const char*)act_ptr(F, A_MERGED), (const char*)(wb + WO_OUT), (size_t)256 * 1024 * 2, (size_t)256 * 1024 * 2, 0, 64, 4, F.G, cblk, 1 << 30, MERGED_HI_DELTA};
            if ((FP8_G && l == 0) || (FP8_M && l == 1)) { pg8::EpiResid<true> E{(bf16_t*)(F.ws + WS_XB), rss_mid, F.ws + WS_ACTS + (l == 0 ? A_XB8 : A_XB8M)}; pg8::gemm_phase<pg8::EpiResid<true>, pg8::SchedGrid, true, true>(F.lds, F.wave, 1024, 1024, S, E); }
            else { pg8::EpiResid<false> E{(bf16_t*)(F.ws + WS_XB), rss_mid, nullptr}; pg8::gemm_phase<pg8::EpiResid<false>, pg8::SchedGrid, true, true>(F.lds, F.wave, 1024, 1024, S, E); }
            if (F.G == 256 && !rpt && l == 0) { __syncthreads(); bg_finish(F, 1, cblk); }
        } else if (l == 0 && q == 7 && PON(7)) {
#if FP8_G
            pg8::SchedGrid S{(const char*)(F.ws + WS_ACTS + A_XB8), (const char*)(wb + WO_FGU), (size_t)256 * 1024, (size_t)256 * 1024, 0, 64, 22, F.G, cblk, 1 << 30};
#else
            pg8::SchedGrid S{(const char*)(F.ws + WS_XB), (const char*)(wb + WO_FGU), (size_t)256 * 1024 * 2, (size_t)256 * 1024 * 2, 0, 64, 22, F.G, cblk, 1 << 30};
#endif
            if (F.G == 256) S.split_from = 1280;
            { pg8::Unit u0; if (S.next(0, u0)) fill_rs(F, rss_mid, u0.pm); }
#if FP8_G
            pg8::EpiSwiglu<false, true, FP8_H != 0> E{act_ptr(F, A_ACT), DFF, (const LAS float*)(F.lds + RS_OFF), nullptr, nullptr};
            pg8::gemm_phase<pg8::EpiSwiglu<false, true, FP8_H != 0>, pg8::SchedGrid, true, true, true>(F.lds, F.wave, 512, 512, S, E);
#else
            pg8::EpiSwiglu<false, false, FP8_H != 0> E{act_ptr(F, A_ACT), DFF, (const LAS float*)(F.lds + RS_OFF), nullptr, nullptr};
            pg8::gemm_phase<pg8::EpiSwiglu<false, false, FP8_H != 0>, pg8::SchedGrid, true, true>(F.lds, F.wave, 1024, 1024, S, E);
#endif
        } else if (l == 0 && q == 8 && PON(8)) {
#if FP8_H
            pg8::SchedGrid S{(const char*)act_ptr(F, A_ACT), (const char*)(wb + WO_FD), (size_t)256 * DFF, (size_t)256 * DFF, 0, 64, 4, F.G, cblk, 1 << 30};
            { int sf_ = 1 << 30; asm volatile("" : "+s"(sf_)); S.split_from = sf_; }
            pg8::EpiResid<FP8_E != 0, true> E{(bf16_t*)(F.ws + WS_XB), F.stats + SF_ROWSS + (size_t)2 * T * 16, (unsigned char*)F.out + (size_t)T * D};
            pg8::gemm_phase<pg8::EpiResid<FP8_E != 0, true>, pg8::SchedGrid, true, true, true>(F.lds, F.wave, DFF / 2, DFF / 2, S, E);
#else
            pg8::SchedGrid S{(const char*)act_ptr(F, A_ACT), (const char*)(wb + WO_FD), (size_t)256 * DFF * 2, (size_t)256 * DFF * 2, 0, 64, 4, F.G, cblk, 1 << 30};
            pg8::EpiResid<FP8_E != 0> E{(bf16_t*)(F.ws + WS_XB), F.stats + SF_ROWSS + (size_t)2 * T * 16, (unsigned char*)F.out + (size_t)T * D};
            pg8::gemm_phase<pg8::EpiResid<FP8_E != 0>, pg8::SchedGrid, true, true>(F.lds, F.wave, DFF, DFF, S, E);
#endif
        } else if (q == 7 && PON(9)) {
#ifdef R1_REP_NOROUTE
            if (!rpt)
#endif
            phase_route1(F);
            __syncthreads();
            LAS float* scr = (LAS float*)(F.lds + F.wave * 16384);
            const int gw = F.vcu * 8 + F.wave, NGW = F.G * 8;
#ifdef R1_REP_NOCONV
            if (!rpt)
#endif
            if (F.G == 256) { if (!rpt) bg_finish(F, 2, cblk); }
            else
            CONV_LOOP(12, moe_seg(F, (si_ < 4) ? (6 + (si_ >> 1)) * 3 + (si_ & 1) : (si_ - 4) * 3 + 2));
        } else if (q == 8 && PON(9)) {
            phase_route2(F);
            if (F.G == 256 && !rpt && !FP8_M) { __syncthreads(); bg_finish(F, 3, cblk); }
        } else if (q == 9 && PON(10)) {
            unsigned char* wm = F.ws + WS_W0;
            LAS int* geo = (LAS int*)(F.lds + RING_BYTES + 512);
            moe_geometry(F, 0, geo);
            pg8::SchedMoeT<true> S; S.rowmap = (const int*)(F.ws + WS_SLOT + SL_TOK); S.A = (const char*)(FP8_M ? F.ws + WS_ACTS + A_XB8M : F.ws + WS_XB); S.B = (const char*)(wm + WO_MGU); S.a_tile = (size_t)256 * 1024 * 2; S.b_tile = (size_t)256 * 1024 * (FP8_M ? 1 : 2); S.b_exp = (size_t)2816 * 1024 * (FP8_M ? 1 : 2);
            S.nN = 11; S.G = F.G; S.c = cblk;
            S.t1 = __builtin_amdgcn_readfirstlane(geo[1]); S.t2 = __builtin_amdgcn_readfirstlane(geo[2]); S.t3 = __builtin_amdgcn_readfirstlane(geo[3]); S.t4 = __builtin_amdgcn_readfirstlane(geo[4]);
            S.t5 = __builtin_amdgcn_readfirstlane(geo[5]); S.t6 = __builtin_amdgcn_readfirstlane(geo[6]); S.t7 = __builtin_amdgcn_readfirstlane(geo[7]); S.MT = __builtin_amdgcn_readfirstlane(geo[8]);
#if FP8_M
            pg8::EpiSwiglu<true, true, FP8_D != 0> E{act_ptr(F, A_ACTE), FP8_D ? KD8 : DEXP, (const LAS float*)nullptr, (const float*)(F.ws + WS_SLOT + SL_SCALE), (const float*)(F.ws + WS_SLOT + SL_COMB)};
            pg8::gemm_phase<pg8::EpiSwiglu<true, true, FP8_D != 0>, pg8::SchedMoeT<true>, true, true, true>(F.lds, F.wave, 512, 512, S, E);
#else
            pg8::EpiSwiglu<true> E{act_ptr(F, A_ACTE), DEXP, (const LAS float*)nullptr, (const float*)(F.ws + WS_SLOT + SL_SCALE), (const float*)(F.ws + WS_SLOT + SL_COMB)};
            pg8::gemm_phase<pg8::EpiSwiglu<true>, pg8::SchedMoeT<true>, true, true>(F.lds, F.wave, 1024, 1024, S, E);
#endif
            if (F.G == 256 && !rpt) { __syncthreads(); bg_finish(F, 4, cblk); }
        } else if (q == 10 && PON(10)) {
            unsigned char* wm = F.ws + WS_W0;
            LAS int* geo = (LAS int*)(F.lds + RING_BYTES + 512);
            moe_geometry(F, 0, geo);
            pg8::SchedMoe S; S.A = (const char*)act_ptr(F, A_ACTE); S.B = (const char*)(wm + WO_MD); S.a_tile = (size_t)256 * DEXP * 2; S.b_tile = (size_t)256 * DEXP * 2; S.b_exp = (size_t)1024 * DEXP * 2;
            S.nN = 4; S.G = F.G; S.c = cblk;
            S.t1 = __builtin_amdgcn_readfirstlane(geo[1]); S.t2 = __builtin_amdgcn_readfirstlane(geo[2]); S.t3 = __builtin_amdgcn_readfirstlane(geo[3]); S.t4 = __builtin_amdgcn_readfirstlane(geo[4]);
            S.t5 = __builtin_amdgcn_readfirstlane(geo[5]); S.t6 = __builtin_amdgcn_readfirstlane(geo[6]); S.t7 = __builtin_amdgcn_readfirstlane(geo[7]); S.MT = __builtin_amdgcn_readfirstlane(geo[8]);
            { const int nt = S.MT * 4, rem = nt % F.G; if (rem > 0 && 2 * rem <= F.G) S.split_from = nt - rem; }
#if FP8_M && FP8_D
            S.a_tile = (size_t)256 * KD8; S.b_tile = (size_t)256 * KD8; S.b_exp = (size_t)1024 * KD8;
            pg8::EpiMoeDown<true> E{act_ptr(F, A_Y)};
            pg8::gemm_phase<pg8::EpiMoeDown<true>, pg8::SchedMoe, true, true, true>(F.lds, F.wave, KD8 / 2, KD8 / 2, S, E);
#else
            pg8::EpiMoeDown<false> E{act_ptr(F, A_Y)};
            pg8::gemm_phase<pg8::EpiMoeDown<false>, pg8::SchedMoe, true, true>(F.lds, F.wave, DEXP, DEXP, S, E);
#endif
        }
        else if (q == 11) {
            const int* tslot = (const int*)(F.ws + WS_TSLOT); const bf16_t* y = act_ptr(F, A_Y);
            const int tstep = F.G * 8;
            for (int tb = F.vcu * 8 + F.wave; tb < T; tb += 4 * tstep) {
                int sl = 0;
                { const int tt = tb + (F.lane >> 1) * tstep; if (F.lane < 8 && tt < T) sl = tslot[tt * 2 + (F.lane & 1)]; }
                u32x4 av[4][2], bv[4][2], xv4[4][2];
#pragma unroll
                for (int k = 0; k < 4; ++k) {
                    const int t = tb + k * tstep, tc = t < T ? t : tb;
                    const int s0 = __shfl(sl, 2 * k), s1 = __shfl(sl, 2 * k + 1);
                    const bf16_t* xbr = (const bf16_t*)(F.ws + WS_XB) + (size_t)tc * D;
#pragma unroll
                    for (int j = 0; j < 2; ++j) {
                        av[k][j] = *((const u32x4*)(y + (size_t)s0 * D) + 64 * j + F.lane); bv[k][j] = *((const u32x4*)(y + (size_t)s1 * D) + 64 * j + F.lane);
                        xv4[k][j] = *((const u32x4*)xbr + 64 * j + F.lane);
                    }
                }
#pragma unroll
                for (int k = 0; k < 4; ++k) {
                    const int t = tb + k * tstep; if (t >= T) break;
                    f32x4* xo = (f32x4*)(F.out + (size_t)t * D) + F.lane * 2;
#pragma unroll
                    for (int j = 0; j < 2; ++j) {
                        const u32x4 a = av[k][j], bq = bv[k][j], xv = xv4[k][j];
                        f32x4 x0 = {bflo(xv.x), bfhi(xv.x), bflo(xv.y), bfhi(xv.y)}, x1 = {bflo(xv.z), bfhi(xv.z), bflo(xv.w), bfhi(xv.w)};
                        constexpr float ys = (FP8_M && FP8_D) ? 1.f / (FP8_WSC * ACT8_SC) : 1.f;
                        x0[0] += (bflo(a.x) + bflo(bq.x)) * ys; x0[1] += (bfhi(a.x) + bfhi(bq.x)) * ys; x0[2] += (bflo(a.y) + bflo(bq.y)) * ys; x0[3] += (bfhi(a.y) + bfhi(bq.y)) * ys;
                        x1[0] += (bflo(a.z) + bflo(bq.z)) * ys; x1[1] += (bfhi(a.z) + bfhi(bq.z)) * ys; x1[2] += (bflo(a.w) + bflo(bq.w)) * ys; x1[3] += (bfhi(a.w) + bfhi(bq.w)) * ys;
                        __builtin_nontemporal_store(x0, xo + 128 * j); __builtin_nontemporal_store(x1, xo + 128 * j + 1);
                    }
                }
            }
        }
        if (ph + 1 < hi || (!rpt && ((REP_MASK >> ph) & 1))) {
            const int job = (F.G == 256 && !rpt) ? ((ph <= 6) ? 1 : (ph >= 10 && ph <= 16) ? 2 : ph == 17 ? (FP8_M ? 4 : 3) : ph == 18 ? 4 : 0) : 0;
            asm volatile("s_waitcnt vmcnt(0)" ::: "memory");
            __syncthreads();
            if (F.wave == 0) xcd_barrier_protocol(bar); else if (job) (void)bg_step(F, job, cblk);
            __syncthreads();
        }
    }
}


#ifdef DBG_PH
__global__ void dbg_dump(const unsigned char* ws, float* out) {
    const size_t i = (size_t)blockIdx.x * 256 + threadIdx.x;
    float v = 0.f;
    const bf16_t* a0 = (const bf16_t*)(ws + WS_ACTS + DBG_A0); const bf16_t* a1 = (const bf16_t*)(ws + WS_ACTS + DBG_A1);
    if (i < (size_t)DBG_N0) v += __uint_as_float((unsigned)a0[i] << 16);
    if (i < (size_t)DBG_N1) v += 3.f * __uint_as_float((unsigned)a1[i] << 16);
    out[i] = v;
}
#endif

extern "C" void kernel_launch(void* const* d_in, const int* in_sizes, int n_in, void* d_out, int out_size, void* d_ws, size_t ws_size, hipStream_t stream) {
    static int grid = 0;
    if (grid == 0) {
        if (n_in != 25 || out_size != T * D || ws_size < WS_END) { fprintf(stderr, "kernel_launch: unexpected sizes (n_in %d out %d ws %zu)\n", n_in, out_size, ws_size); grid = -1; return; }
        int dev = 0, cus = 0;
        if (hipGetDevice(&dev) != hipSuccess || hipDeviceGetAttribute(&cus, hipDeviceAttributeMultiprocessorCount, dev) != hipSuccess) { grid = -1; return; }
        if (hipFuncSetAttribute((const void*)mega_fwd, hipFuncAttributeMaxDynamicSharedMemorySize, LDS_BYTES) != hipSuccess) { grid = -1; return; }
        int per_cu = 0;
        (void)hipOccupancyMaxActiveBlocksPerMultiprocessor(&per_cu, (const void*)mega_fwd, 512, LDS_BYTES);
        (void)hipGetLastError();
        grid = cus;
    }
    if (grid < 0) return;
    (void)hipMemsetAsync((char*)d_ws + WS_CTL, 0, CTL_BYTES, stream);
    Args a{};
    for (int i = 0; i < 25; ++i) a.in[i] = d_in[i];
    a.out = (float*)d_out; a.ws = (unsigned char*)d_ws; a.ph_lo = 0; a.ph_hi = NPHASE; a.li = 0; a.pad = 0;
#ifdef DBG_PH
    a.ph_hi = DBG_PH;
#endif
    void* kargs[] = {&a};
    hipError_t e = hipLaunchCooperativeKernel((const void*)mega_fwd, dim3(grid), dim3(512), kargs, LDS_BYTES, stream);
    if (e != hipSuccess) fprintf(stderr, "cooperative launch failed: %s (grid %d)\n", hipGetErrorString(e), grid);
#ifdef DBG_PH
    hipLaunchKernelGGL(dbg_dump, dim3(T * 1024 / 256), dim3(256), 0, stream, (const unsigned char*)d_ws, (float*)d_out);
#endif
}
```
